# Optimizing an MI355X kernel written in HIP

```python
import math
import jax
import jax.numpy as jnp
from jax import lax
import numpy as np

D_MODEL = 4096
BATCH = 4
SEQ = 4096
DEPTH = 2

GRID_W = 64
CTX_LEN = 256
MIX_W = D_MODEL
HALF_W = MIX_W // 2
Q_BLOCK = 128
ROPE_THETA = 10000.0
NEG_INF = -1e30
A_HEAD = 64
A_HEADS = HALF_W // A_HEAD
A_LORA_W = 96
A_LORA_A = 96
A_LORA_G = 256
RWKV_GN_EPS = 64e-5
COLS_A = 3 * HALF_W + 2 * A_LORA_W + 2 * A_LORA_A + A_LORA_G
B_DK = 64
B_DV = 2 * B_DK
B_HEADS = HALF_W // B_DV
COLS_B = 3 * HALF_W
C_HEAD = 64
C_HEADS = HALF_W // C_HEAD
C_KV_HEADS = C_HEADS // 8
C_GROUP = C_HEADS // C_KV_HEADS
WINDOW = 128
COLS_C = HALF_W + 2 * C_KV_HEADS * C_HEAD
D_DK = 128
D_DV = 256
D_HEADS = HALF_W // D_DV
RET_CHUNK = 128
COLS_D = 2 * D_HEADS * D_DK + 2 * HALF_W
COLS_EVEN = COLS_A + COLS_B
COLS_ODD = COLS_C + COLS_D
D_FF = ((8 * D_MODEL // 3 + 255) // 256) * 256
N_EVEN = (DEPTH + 1) // 2
N_ODD = DEPTH // 2

kernel_name = 'hybrid_rwkv7_diffattn_swa_retention_dit'


def _split(t, sizes):
    return jnp.split(t, [int(s) for s in np.cumsum(sizes)[:-1]], axis=-1)


def rms_norm(x, eps=1e-6):
    xf = x.astype(jnp.float32)
    return (xf * lax.rsqrt(jnp.mean(xf * xf, axis=-1, keepdims=True) + eps)).astype(x.dtype)


def centred_shift(z):
    zp = jnp.pad(z, ((0, 0), (1, 1), (0, 0)))
    return 0.5 * (zp[:, :-2] + zp[:, 2:])


def dwconv3(z, w, b):
    zp = jnp.pad(z, ((0, 0), (1, 1), (0, 0)))
    return zp[:, :-2] * w[0] + zp[:, 1:-1] * w[1] + zp[:, 2:] * w[2] + b


def axial_rope(n, dim):
    rows = n // GRID_W
    row = jnp.repeat(jnp.arange(rows, dtype=jnp.float32), GRID_W)
    col = jnp.tile(jnp.arange(GRID_W, dtype=jnp.float32), rows)
    quarter = dim // 4
    inv = ROPE_THETA ** (-jnp.arange(quarter, dtype=jnp.float32) / quarter)
    ang = jnp.concatenate([row[:, None] * inv, col[:, None] * inv], axis=-1)
    return jnp.cos(ang), jnp.sin(ang)


def seq_rope(pos, dim):
    inv = ROPE_THETA ** (-jnp.linspace(0.0, 1.0, dim // 2, dtype=jnp.float32))
    ang = pos[:, None] * inv
    return jnp.cos(ang), jnp.sin(ang)


def apply_rope(x, cos, sin):
    x1, x2 = jnp.split(x, 2, axis=-1)
    return jnp.concatenate([x1 * cos - x2 * sin, x2 * cos + x1 * sin], axis=-1).astype(x.dtype)


def rwkv7_prep(pa, ap):
    B, n, _ = pa.shape
    pa = pa.astype(jnp.float32)
    pa = pa + ap['mu'] * (centred_shift(pa) - pa)
    r, k, v, w1f, w1b, a1f, a1b, g1 = _split(
        pa, [HALF_W] * 3 + [A_LORA_W] * 2 + [A_LORA_A] * 2 + [A_LORA_G])
    heads = lambda t: t.reshape(B, n, A_HEADS, A_HEAD)
    kk = heads(k * ap['k_k'])
    kk = kk * lax.rsqrt(jnp.sum(kk * kk, axis=-1, keepdims=True) + 1e-12)
    dirs = []
    for d, (w1, a1) in enumerate(((w1f, a1f), (w1b, a1b))):
        w = ap['w0'][d] + jnp.tanh(w1) @ ap['w2'][d]
        decay = jnp.exp(-jnp.exp(-jax.nn.softplus(-w) - 0.5))
        a = jax.nn.sigmoid(ap['a0'][d] + a1 @ ap['a2'][d])
        kd = k * (1.0 + (a - 1.0) * ap['k_a'])
        dirs.append((heads(decay), heads(kd), heads(a)))
    return {'r': heads(r), 'v': heads(v), 'kk': kk, 'g1': g1, 'dirs': dirs}


def rwkv7_scan(S0, decay, k, v, kk, a, r, reverse):
    emit = r is not None
    tm = lambda t: jnp.moveaxis(t, 1, 0)
    xs = (tm(decay), tm(k), tm(v), tm(kk), tm(a)) + ((tm(r),) if emit else ())

    def step(S, inp):
        w_t, k_t, v_t, kk_t, a_t = inp[:5]
        S = (S * w_t[:, :, None, :]
             - jnp.einsum('bhvk,bhk->bhv', S, kk_t)[..., None] * (kk_t * a_t)[:, :, None, :]
             + v_t[..., None] * k_t[:, :, None, :])
        y = jnp.einsum('bhvk,bhk->bhv', S, inp[5]) if emit else None
        return S, y

    S, ys = lax.scan(step, S0, xs, reverse=reverse)
    return S, (jnp.moveaxis(ys, 0, 1) if emit else None)


def rwkv7_out(y, st, ap):
    B, n = y.shape[:2]
    mu = jnp.mean(y, axis=-1, keepdims=True)
    var = jnp.mean(jnp.square(y - mu), axis=-1, keepdims=True)
    y = ((y - mu) * lax.rsqrt(var + RWKV_GN_EPS)).reshape(B, n, HALF_W) * ap['ln_w'] + ap['ln_b']
    k_sum = st['dirs'][0][1] + st['dirs'][1][1]
    bonus = jnp.sum(st['r'] * k_sum * ap['r_k'], axis=-1, keepdims=True) * st['v']
    g = jax.nn.sigmoid(st['g1']) @ ap['g2']
    return (y + bonus.reshape(B, n, HALF_W)) * g


def rwkv7_mix(pa_lat, pa_ctx, ap, need_ctx):
    lat, ctx = rwkv7_prep(pa_lat, ap), rwkv7_prep(pa_ctx, ap)
    S0 = jnp.zeros((pa_lat.shape[0], A_HEADS, A_HEAD, A_HEAD), jnp.float32)
    ys_lat, ys_ctx = [], []
    for d, rev in enumerate((False, True)):
        dec_c, k_c, a_c = ctx['dirs'][d]
        S_c, y_c = rwkv7_scan(S0, dec_c, k_c, ctx['v'], ctx['kk'], a_c,
                              ctx['r'] if need_ctx else None, rev)
        dec_l, k_l, a_l = lat['dirs'][d]
        _, y_l = rwkv7_scan(S_c, dec_l, k_l, lat['v'], lat['kk'], a_l, lat['r'], rev)
        ys_lat.append(y_l)
        ys_ctx.append(y_c)
    out_lat = rwkv7_out(ys_lat[0] + ys_lat[1], lat, ap)
    out_ctx = rwkv7_out(ys_ctx[0] + ys_ctx[1], ctx, ap) if need_ctx else None
    return out_lat, out_ctx


def diff_attend(q, k, v, lam):
    s = jnp.einsum('bqhcd,bkhcd->bhcqk', q, k).astype(jnp.float32) * (B_DK ** -0.5)
    p = jax.nn.softmax(s, axis=-1)
    a = p[:, :, 0] - lam * p[:, :, 1]
    return jnp.einsum('bhqk,bkhd->bqhd', a.astype(v.dtype), v)


def diff_attn_mix(pb_lat, pb_ctx, lam_vecs, subln, layer_idx, cos, sin, need_ctx):
    B, S, _ = pb_lat.shape

    def qkv(p):
        n = p.shape[1]
        q, k, v = _split(p, [HALF_W] * 3)
        return (q.reshape(B, n, B_HEADS, 2, B_DK), k.reshape(B, n, B_HEADS, 2, B_DK),
                v.reshape(B, n, B_HEADS, B_DV))

    ql, kl, vl = qkv(pb_lat)
    qc, kc, vc = qkv(pb_ctx)
    cs, sn = cos[:, None, None, :], sin[:, None, None, :]
    ql, kl = apply_rope(ql, cs, sn), apply_rope(kl, cs, sn)
    lam_init = 0.8 - 0.6 * math.exp(-0.3 * layer_idx)
    lv = lam_vecs.astype(jnp.float32)
    lam = jnp.exp(jnp.sum(lv[0] * lv[1])) - jnp.exp(jnp.sum(lv[2] * lv[3])) + lam_init
    k_all = jnp.concatenate([kl, kc], axis=1)
    v_all = jnp.concatenate([vl, vc], axis=1)
    nb = S // Q_BLOCK
    qb = jnp.moveaxis(ql.reshape(B, nb, Q_BLOCK, B_HEADS, 2, B_DK), 1, 0)
    yl = lax.map(lambda q: diff_attend(q, k_all, v_all, lam), qb)
    yl = jnp.moveaxis(yl, 0, 1).reshape(B, S, B_HEADS, B_DV)
    post = lambda y: (rms_norm(y, 1e-5) * subln * (1.0 - lam_init)).reshape(B, y.shape[1], HALF_W)
    return post(yl), (post(diff_attend(qc, kc, vc, lam)) if need_ctx else None)


def window_mix(pc_lat, pc_ctx, sink, cos, sin, need_ctx):
    B, S, _ = pc_lat.shape

    def qkv(p):
        n = p.shape[1]
        q, k, v = _split(p, [HALF_W, C_KV_HEADS * C_HEAD, C_KV_HEADS * C_HEAD])
        return (q.reshape(B, n, C_KV_HEADS, C_GROUP, C_HEAD), k.reshape(B, n, C_KV_HEADS, C_HEAD),
                v.reshape(B, n, C_KV_HEADS, C_HEAD))

    ql, kl, vl = qkv(pc_lat)
    qc, kc, vc = qkv(pc_ctx)
    ql = apply_rope(ql, cos[:, None, None, :], sin[:, None, None, :])
    kl = apply_rope(kl, cos[:, None, :], sin[:, None, :])
    scale = C_HEAD ** -0.5
    sink_f = sink.astype(jnp.float32).reshape(C_KV_HEADS, C_GROUP)[None, :, :, None, None]

    def sink_softmax_mix(scores, values):
        s = jnp.concatenate(scores + [jnp.broadcast_to(sink_f, scores[0].shape[:-1] + (1,))], axis=-1)
        p = jax.nn.softmax(s, axis=-1)
        out, start = 0.0, 0
        for sc, val in zip(scores, values):
            m = sc.shape[-1]
            out = out + jnp.einsum('bgrqk,bkgd->bqgrd', p[..., start:start + m].astype(val.dtype), val)
            start += m
        return out

    nb = S // WINDOW

    def band(t):
        tp = jnp.pad(t, ((0, 0), (WINDOW, WINDOW), (0, 0), (0, 0))).reshape(B, nb + 2, WINDOW, C_KV_HEADS, C_HEAD)
        return jnp.moveaxis(jnp.concatenate([tp[:, :-2], tp[:, 1:-1], tp[:, 2:]], axis=2), 1, 0)

    qi = jnp.arange(WINDOW)[:, None]
    kj = jnp.arange(3 * WINDOW)[None, :] - WINDOW
    key_pos = (jnp.arange(nb) * WINDOW)[:, None, None] + kj[None]
    valid = (jnp.abs(kj - qi) <= WINDOW)[None] & (key_pos >= 0) & (key_pos < S)
    qb = jnp.moveaxis(ql.reshape(B, nb, WINDOW, C_KV_HEADS, C_GROUP, C_HEAD), 1, 0)

    def block(args):
        q, kb, vb, ok = args
        s_win = jnp.einsum('bqgrd,bkgd->bgrqk', q, kb).astype(jnp.float32) * scale
        s_win = jnp.where(ok, s_win, NEG_INF)
        s_ctx = jnp.einsum('bqgrd,bkgd->bgrqk', q, kc).astype(jnp.float32) * scale
        return sink_softmax_mix([s_win, s_ctx], [vb, vc])

    y_lat = jnp.moveaxis(lax.map(block, (qb, band(kl), band(vl), valid)), 0, 1).reshape(B, S, HALF_W)
    y_ctx = None
    if need_ctx:
        s = jnp.einsum('bqgrd,bkgd->bgrqk', qc, kc).astype(jnp.float32) * scale
        y_ctx = sink_softmax_mix([s], [vc]).reshape(B, qc.shape[1], HALF_W)
    return y_lat, y_ctx


def retention_scan(q, k, v, log_gamma, S0, reverse):
    emit = q is not None
    B, n = k.shape[:2]
    nc = n // RET_CHUNK
    flip = (lambda t: jnp.flip(t, 1)) if reverse else (lambda t: t)
    chunks = lambda t: jnp.moveaxis(flip(t).reshape(B, nc, RET_CHUNK, *t.shape[2:]), 1, 0)
    idx = jnp.arange(RET_CHUNK, dtype=jnp.float32)
    lg = log_gamma[:, None]
    rel = idx[:, None] - idx[None, :]
    decay_mat = jnp.where(rel >= 0, jnp.exp(lg[:, :, None] * jnp.maximum(rel, 0.0)), 0.0)
    q_dec = jnp.exp(lg * (idx + 1.0)).T
    k_dec = jnp.exp(lg * (RET_CHUNK - 1.0 - idx)).T
    chunk_dec = jnp.exp(log_gamma * RET_CHUNK)
    xs = (chunks(k), chunks(v)) + ((chunks(q),) if emit else ())

    def step(S, inp):
        kc, vc = inp[0], inp[1]
        S_new = S * chunk_dec[None, :, None, None] + jnp.einsum('bchd,bche->bhde', kc * k_dec[None, :, :, None], vc)
        if not emit:
            return S_new, None
        qc = inp[2]
        att = jnp.einsum('bqhd,bkhd->bhqk', qc, kc) * decay_mat[None]
        y = (jnp.einsum('bhqk,bkhe->bqhe', att, vc)
             + jnp.einsum('bqhd,bhde->bqhe', qc * q_dec[None, :, :, None], S))
        return S_new, y

    S, ys = lax.scan(step, S0, xs)
    if not emit:
        return S, None
    ys = jnp.moveaxis(ys, 0, 1).reshape(B, n, D_HEADS, D_DV)
    return S, flip(ys)


def retention_mix(pd_lat, pd_ctx, decay_e, rope_lat, rope_ctx, need_ctx):
    B = pd_lat.shape[0]

    def prep(p, rope):
        n = p.shape[1]
        cs, sn = rope[0][:, None, :], rope[1][:, None, :]
        q, k, v, g = _split(p.astype(jnp.float32), [D_HEADS * D_DK] * 2 + [HALF_W] * 2)
        q = apply_rope(q.reshape(B, n, D_HEADS, D_DK), cs, sn) * (D_DK ** -0.5)
        k = apply_rope(k.reshape(B, n, D_HEADS, D_DK), cs, sn)
        return q, k, v.reshape(B, n, D_HEADS, D_DV), g

    ql, kl, vl, gl = prep(pd_lat, rope_lat)
    qc, kc, vc, gc = prep(pd_ctx, rope_ctx)
    S0 = jnp.zeros((B, D_HEADS, D_DK, D_DV), jnp.float32)
    ys_lat, ys_ctx = [], []
    for d, rev in enumerate((False, True)):
        log_gamma = jnp.log1p(-jnp.exp2(-decay_e[d].astype(jnp.float32)))
        S_c, y_c = retention_scan(qc if need_ctx else None, kc, vc, log_gamma, S0, rev)
        _, y_l = retention_scan(ql, kl, vl, log_gamma, S_c, rev)
        ys_lat.append(y_l)
        ys_ctx.append(y_c)
    post = lambda y, g: rms_norm(y).reshape(B, y.shape[1], HALF_W) * jax.nn.silu(g)
    y_ctx = post(ys_ctx[0] + ys_ctx[1], gc) if need_ctx else None
    return post(ys_lat[0] + ys_lat[1], gl), y_ctx


def conv_glu(h, w_in, conv_w, conv_b, w_out):
    gate, up = jnp.split(h @ w_in, 2, axis=-1)
    return (jax.nn.silu(dwconv3(gate, conv_w, conv_b)) * up) @ w_out


def setup_inputs(seed: int = 0):
    key = jax.random.key(seed)
    keys = iter(jax.random.split(key, 32))

    def nrm(shape, scale):
        return jax.random.normal(next(keys), shape, jnp.float32) * scale

    def unif(shape, lo, hi):
        return jax.random.uniform(next(keys), shape, jnp.float32, lo, hi)

    D = D_MODEL
    return {
        'x': nrm((BATCH, SEQ, D), 1.0),
        'c': nrm((BATCH, D), 1.0),
        'ctx': nrm((BATCH, CTX_LEN, D), 1.0),
        'c_ctx': nrm((D,), 1.0),
        'w_mod': nrm((DEPTH, D, 6 * D), D ** -0.5),
        'b_mod': nrm((DEPTH, 6 * D), 0.02),
        'w_in_even': nrm((N_EVEN, D, COLS_EVEN), D ** -0.5),
        'rwkv_mu': unif((N_EVEN, COLS_A), 0.0, 1.0),
        'rwkv_w0': unif((N_EVEN, 2, HALF_W), -6.0, -1.0),
        'rwkv_w2': nrm((N_EVEN, 2, A_LORA_W, HALF_W), 0.5 * A_LORA_W ** -0.5),
        'rwkv_a0': nrm((N_EVEN, 2, HALF_W), 0.1),
        'rwkv_a2': nrm((N_EVEN, 2, A_LORA_A, HALF_W), 0.5 * A_LORA_A ** -0.5),
        'rwkv_g2': nrm((N_EVEN, A_LORA_G, HALF_W), A_LORA_G ** -0.5),
        'rwkv_k_k': 0.85 + nrm((N_EVEN, HALF_W), 0.05),
        'rwkv_k_a': 1.0 + nrm((N_EVEN, HALF_W), 0.05),
        'rwkv_r_k': nrm((N_EVEN, A_HEADS, A_HEAD), 0.1),
        'rwkv_ln_w': 1.0 + nrm((N_EVEN, HALF_W), 0.02),
        'rwkv_ln_b': nrm((N_EVEN, HALF_W), 0.02),
        'diff_lambda': nrm((N_EVEN, 4, B_DK), 0.1),
        'diff_subln': 1.0 + nrm((N_EVEN, B_DV), 0.02),
        'w_in_odd': nrm((N_ODD, D, COLS_ODD), D ** -0.5),
        'swa_sink': nrm((N_ODD, C_HEADS), 0.5),
        'ret_decay': 5.0 + jnp.arange(D_HEADS, dtype=jnp.float32) + nrm((N_ODD, 2, D_HEADS), 0.1),
        'w_mix_out': nrm((DEPTH, MIX_W, D), MIX_W ** -0.5),
        'w_ffn_in': nrm((DEPTH, D, 2 * D_FF), D ** -0.5),
        'ffn_conv_w': nrm((DEPTH, 3, D_FF), 3 ** -0.5),
        'ffn_conv_b': nrm((DEPTH, D_FF), 0.02),
        'w_ffn_out': nrm((DEPTH, D_FF, D), D_FF ** -0.5),
        'final_norm': 1.0 + nrm((D,), 0.02),
    }


def reference(x, c, ctx, c_ctx, w_mod, b_mod, w_in_even, rwkv_mu, rwkv_w0, rwkv_w2, rwkv_a0, rwkv_a2,
              rwkv_g2, rwkv_k_k, rwkv_k_a, rwkv_r_k, rwkv_ln_w, rwkv_ln_b, diff_lambda, diff_subln,
              w_in_odd, swa_sink, ret_decay, w_mix_out, w_ffn_in, ffn_conv_w, ffn_conv_b, w_ffn_out,
              final_norm):
    S = x.shape[1]
    L = ctx.shape[1]
    cos_b, sin_b = axial_rope(S, B_DK)
    cos_c, sin_c = axial_rope(S, C_HEAD)
    rope_ret_ctx = seq_rope(jnp.arange(L, dtype=jnp.float32), D_DK)
    rope_ret_lat = seq_rope(L + jnp.arange(S, dtype=jnp.float32), D_DK)
    silu_c = jax.nn.silu(c)
    silu_cc = jax.nn.silu(c_ctx)[None]
    h_lat, h_ctx = x, ctx
    for l in range(DEPTH):
        need_ctx = l < DEPTH - 1
        m_lat = jnp.split((silu_c @ w_mod[l] + b_mod[l])[:, None, :], 6, axis=-1)
        m_ctx = jnp.split((silu_cc @ w_mod[l] + b_mod[l])[:, None, :], 6, axis=-1)
        a_lat = rms_norm(h_lat) * (1.0 + m_lat[1]) + m_lat[0]
        a_ctx = rms_norm(h_ctx) * (1.0 + m_ctx[1]) + m_ctx[0]
        if l % 2 == 0:
            e = l // 2
            p_lat, p_ctx = a_lat @ w_in_even[e], a_ctx @ w_in_even[e]
            ap = dict(mu=rwkv_mu[e], w0=rwkv_w0[e], w2=rwkv_w2[e], a0=rwkv_a0[e], a2=rwkv_a2[e],
                      g2=rwkv_g2[e], k_k=rwkv_k_k[e], k_a=rwkv_k_a[e], r_k=rwkv_r_k[e],
                      ln_w=rwkv_ln_w[e], ln_b=rwkv_ln_b[e])
            y1_l, y1_c = rwkv7_mix(p_lat[..., :COLS_A], p_ctx[..., :COLS_A], ap, need_ctx)
            y2_l, y2_c = diff_attn_mix(p_lat[..., COLS_A:], p_ctx[..., COLS_A:], diff_lambda[e],
                                       diff_subln[e], l, cos_b, sin_b, need_ctx)
        else:
            o = l // 2
            p_lat, p_ctx = a_lat @ w_in_odd[o], a_ctx @ w_in_odd[o]
            y1_l, y1_c = window_mix(p_lat[..., :COLS_C], p_ctx[..., :COLS_C], swa_sink[o],
                                    cos_c, sin_c, need_ctx)
            y2_l, y2_c = retention_mix(p_lat[..., COLS_C:], p_ctx[..., COLS_C:], ret_decay[o],
                                       rope_ret_lat, rope_ret_ctx, need_ctx)
        h_lat = h_lat + m_lat[2] * (jnp.concatenate([y1_l, y2_l], axis=-1) @ w_mix_out[l])
        f_lat = rms_norm(h_lat) * (1.0 + m_lat[4]) + m_lat[3]
        h_lat = h_lat + m_lat[5] * conv_glu(f_lat, w_ffn_in[l], ffn_conv_w[l], ffn_conv_b[l], w_ffn_out[l])
        if need_ctx:
            h_ctx = h_ctx + m_ctx[2] * (jnp.concatenate([y1_c, y2_c], axis=-1) @ w_mix_out[l])
            f_ctx = rms_norm(h_ctx) * (1.0 + m_ctx[4]) + m_ctx[3]
            h_ctx = h_ctx + m_ctx[5] * conv_glu(f_ctx, w_ffn_in[l], ffn_conv_w[l], ffn_conv_b[l], w_ffn_out[l])
    return rms_norm(h_lat) * final_norm
```

```cpp
#include <hip/hip_runtime.h>
#include <cstdio>
#include <cstdint>

#define LAS __attribute__((address_space(3)))
#define DI __device__ __forceinline__
typedef unsigned short bf16_t;
typedef _Float16 h16;
typedef short bf16x8 __attribute__((ext_vector_type(8)));
typedef float f32x4 __attribute__((ext_vector_type(4)));
typedef int i32x4 __attribute__((ext_vector_type(4)));
typedef float f32x2 __attribute__((ext_vector_type(2)));
typedef float f32x16 __attribute__((ext_vector_type(16)));
typedef unsigned u32x4 __attribute__((ext_vector_type(4)));
typedef unsigned u32x2 __attribute__((ext_vector_type(2)));
typedef __bf16 bf16x2_n __attribute__((ext_vector_type(2)));
typedef _Float16 h16x2_n __attribute__((ext_vector_type(2)));

constexpr int D = 4096, NB = 4, SEQ = 4096, CTXL = 256;
constexpr int TL = NB * SEQ, TC = NB * CTXL, TT = TL + TC;
constexpr int DFF = 11008;
constexpr int HALF_W = 2048;
constexpr int COLS_A = 6784, COLS_A_PAD = 6912, COLS_B = 6144, NE = COLS_A_PAD + COLS_B;
constexpr int COLS_C = 2560, COLS_D = 6144, NO = COLS_C + COLS_D;
constexpr int NKEY = SEQ + CTXL;
constexpr int LORA_K = 1280, LORA_KU = 256, LORA_N = 5 * 2048;
constexpr int NTHREADS = 512;

constexpr size_t al256(size_t x) { return (x + 255) & ~(size_t)255; }
constexpr size_t WS_CTL = 0;
constexpr size_t CTL_CMAX = 65536;
constexpr int CM_FFI = 0, CM_INO = 2 * 2 * 11008, CM_INE = CM_INO + 8704, CM_MIX = CM_INE + 13056, CM_END = CM_MIX + 2 * 4096;
constexpr size_t CTL_BYTES = CTL_CMAX + (((size_t)CM_END * 4 + 255) & ~(size_t)255);
constexpr size_t WS_MOD = WS_CTL + CTL_BYTES;
constexpr size_t WS_SCAL = WS_MOD + al256((size_t)2 * 5 * 6 * D * 4);
constexpr size_t WS_CS = WS_SCAL + 256;
constexpr size_t WS_AXC = WS_CS + (((size_t)CM_END * 4 + 255) & ~(size_t)255);
constexpr size_t WS_AXS = WS_AXC + (size_t)SEQ * 32 * 4;
constexpr size_t WS_RTC = WS_AXS + (size_t)SEQ * 32 * 4;
constexpr size_t WS_RTS = WS_RTC + (size_t)NKEY * 64 * 4;
constexpr size_t WS_W = WS_RTS + (size_t)NKEY * 64 * 4;
constexpr size_t W_IN = 0;
constexpr size_t W_MIX = W_IN + (size_t)NE * D * 2;
constexpr size_t W_FFI = W_MIX + (size_t)D * D * 2;
constexpr size_t W_FFO = W_FFI + (size_t)2 * DFF * D * 2;
constexpr size_t W_LORA = W_FFO + (size_t)D * DFF * 2;
constexpr size_t W_BYTES = W_LORA + (size_t)LORA_N * LORA_K * 2;
constexpr size_t WS_H = WS_W + al256(W_BYTES);
constexpr size_t WS_XN = WS_H + (size_t)TT * D * 4;
constexpr size_t WS_W1 = WS_XN + (size_t)TT * D * 2;
constexpr size_t W1_MIX = 0, W1_FFI = W1_MIX + (size_t)D * D * 2, W1_FFO = W1_FFI + (size_t)2 * DFF * D * 2, W1_BYTES = W1_FFO + (size_t)D * DFF * 2;
constexpr size_t WS_ARENA = WS_W1 + al256(W1_BYTES);
constexpr size_t SZ16 = (size_t)TT * 2048 * 2;
constexpr size_t MOD_FLOATS = (size_t)2 * 5 * 6 * D;
constexpr size_t AR_XQ = 0, AR_XQS = (size_t)80 << 20;
constexpr size_t AR_MODP = 0;
constexpr size_t AR_PA = 0;
constexpr size_t AR_K = AR_PA + (size_t)TT * COLS_A_PAD * 2;
constexpr size_t AR_LA = AR_K + SZ16;
constexpr size_t RW_NCH = 136;
constexpr size_t CH_BYTES = 24576;
constexpr size_t AR_CH = 0;
constexpr size_t AR_CH_END = AR_CH + (size_t)256 * RW_NCH * CH_BYTES;
constexpr size_t AR_PB = AR_CH_END;
constexpr size_t AR_VT = AR_PB + (size_t)TT * COLS_B * 2;
constexpr size_t AR_R = AR_VT + (size_t)NB * 16 * 128 * NKEY * 2;
constexpr size_t AR_KK = AR_R + SZ16;
constexpr size_t AR_V = AR_KK + SZ16;
constexpr size_t AR_OMW = AR_V + SZ16;
constexpr size_t AR_BB = AR_OMW + 2 * SZ16;
constexpr size_t AR_KD = AR_BB + 2 * SZ16;
constexpr size_t AR_G = AR_KD + 2 * SZ16;
constexpr size_t AR_Y = AR_G + SZ16;
constexpr size_t AR_EVEN_END = AR_Y + 2 * SZ16;
static_assert(AR_LA + (size_t)TT * LORA_K * 2 <= AR_CH_END, "PA|K|LA must sit under the chunk matrices");
constexpr size_t AR_GU = 0;
constexpr size_t AR_SG = 0, AR_SU = AR_SG + (size_t)(TT / 64) * 4 * DFF * 2;
constexpr size_t AR_HID = AR_GU + (size_t)TT * 2 * DFF * 2;
constexpr size_t AR_FFN_END = AR_HID + (size_t)TT * DFF * 2;
constexpr size_t AR_P1 = 0;
constexpr size_t AR_VTC = AR_P1 + (size_t)TT * NO * 2;
constexpr size_t AR_RU = AR_VTC + (size_t)NB * 4 * 64 * NKEY * 2;
constexpr size_t AR_RS = AR_RU + (size_t)NB * 8 * 2 * 34 * 256 * 128 * 4;
constexpr size_t AR_ODD_END = AR_RS + (size_t)NB * 8 * 2 * 32 * 256 * 128 * 2;
constexpr size_t AR_SLAB = (size_t)1300 << 20;
constexpr size_t AR_SLAB_END = AR_SLAB + (size_t)4 * TC * D * 4;
static_assert(AR_SLAB >= AR_FFN_END, "slab overlaps the FFN buffers");
constexpr size_t cmax(size_t a, size_t b) { return a > b ? a : b; }
constexpr size_t AR_BYTES = cmax(cmax(AR_EVEN_END, AR_FFN_END), AR_ODD_END);
constexpr size_t WS_END = WS_ARENA + AR_BYTES;
static_assert(WS_END <= (size_t)3221225472ull, "workspace plan exceeds 4 x the largest input tensor");
static_assert(AR_SLAB_END <= AR_BYTES, "slab outside the arena");

DI float bf2f(bf16_t x) { return __uint_as_float((unsigned)x << 16); }
DI bf16_t f2bf(float x) { return __builtin_bit_cast(unsigned short, (__bf16)x); }
DI unsigned pk_bf16(float lo, float hi) { f32x2 v = {lo, hi}; return __builtin_bit_cast(unsigned, __builtin_convertvector(v, bf16x2_n)); }
DI unsigned pk_f16(float lo, float hi) { f32x2 v = {lo, hi}; return __builtin_bit_cast(unsigned, __builtin_convertvector(v, h16x2_n)); }
DI float bflo(unsigned w) { return __uint_as_float(w << 16); }
DI float bfhi(unsigned w) { return __uint_as_float(w & 0xffff0000u); }
DI float h16lo(unsigned w) { return (float)__builtin_bit_cast(h16x2_n, w)[0]; }
DI float h16hi(unsigned w) { return (float)__builtin_bit_cast(h16x2_n, w)[1]; }
DI float silu_f(float x) { return x * __builtin_amdgcn_rcpf(1.0f + __expf(-x)); }
DI float sigmoid_f(float x) { return __builtin_amdgcn_rcpf(1.0f + __expf(-x)); }
DI float wave_sum(float v) {
#pragma unroll
    for (int o = 32; o >= 1; o >>= 1) v += __shfl_xor(v, o);
    return v;
}
DI void load8f(const float* p, float (&o)[8]) { const f32x4 a = *(const f32x4*)p, b = *(const f32x4*)(p + 4);
#pragma unroll
    for (int j = 0; j < 4; ++j) { o[j] = a[j]; o[4 + j] = b[j]; } }
DI int row_modidx(int row) { return row < TL ? (row >> 12) : 4; }

#define XB_TMO      128
#define XB_XCNT(j)  (256  + 64 * (j))
#define XB_XSUB(j)  (1280 + 64 * (j))
#define XB_XGEN(j)  (2304 + 64 * (j))
#define XB_TOP      3328
#define XB_TOPGEN   3392
#define XCD_BAR_WORDS 3456
#define XB_SPIN_CAP (1u << 22)

__device__ __forceinline__ unsigned xb_ld(unsigned* p)              { return __hip_atomic_load(p, __ATOMIC_RELAXED, __HIP_MEMORY_SCOPE_AGENT); }
__device__ __forceinline__ unsigned xb_add(unsigned* p, unsigned v) { return __hip_atomic_fetch_add(p, v, __ATOMIC_RELAXED, __HIP_MEMORY_SCOPE_AGENT); }
__device__ __forceinline__ unsigned xb_xcc_id() { return (unsigned)__builtin_amdgcn_s_getreg((3 << 11) | 20) & 0xFu; }
#define XB_SPIN(cond, bar) do { unsigned _sp = 0; while (cond) { __builtin_amdgcn_s_sleep(1); \
    if ((++_sp & 255u) == 0u) { if (xb_ld(&(bar)[XB_TMO])) break; if (_sp > XB_SPIN_CAP) { atomicAdd(&(bar)[XB_TMO], 1u); break; } } } } while (0)

struct XcdBarrier {
    unsigned* bar; unsigned x;
    volatile LAS unsigned* st;
};

__device__ __forceinline__ XcdBarrier xcd_barrier_post(unsigned* bar, volatile LAS unsigned* st) {
    XcdBarrier b; b.bar = bar; b.x = xb_xcc_id(); b.st = st;
    if (threadIdx.x == 0) (void)xb_add(&bar[XB_XCNT(b.x)], 1u);
    return b;
}
__device__ __forceinline__ void xcd_barrier_complete(unsigned* bar, unsigned x, unsigned& nloc, unsigned& nx) {
    const unsigned G = gridDim.x * gridDim.y * gridDim.z;
    unsigned sum, cnt, mine, sp = 0u;
    for (;;) {
        sum = 0u; cnt = 0u; mine = 0u;
#pragma unroll
        for (unsigned j = 0; j < 16; ++j) { const unsigned c = xb_ld(&bar[XB_XCNT(j)]); sum += c; cnt += (c > 0u) ? 1u : 0u; mine = (j == x) ? c : mine; }
        if (sum == G) break;
        __builtin_amdgcn_s_sleep(1);
        if ((++sp & 255u) == 0u) { if (xb_ld(&bar[XB_TMO])) break; if (sp > XB_SPIN_CAP) { atomicAdd(&bar[XB_TMO], 1u); break; } }
    }
    nloc = mine > 0u ? mine : 1u; nx = cnt > 0u ? cnt : 1u;
}

__device__ __forceinline__ void xcd_barrier(const XcdBarrier& b) {
    asm volatile("s_waitcnt vmcnt(0)" ::: "memory");
    __syncthreads();
    if (threadIdx.x == 0) {
        unsigned* bar = b.bar;
        __builtin_amdgcn_s_waitcnt(0);
        unsigned nloc = b.st[0], nx = b.st[1];
        if (nloc == 0u) { xcd_barrier_complete(bar, b.x, nloc, nx); b.st[0] = nloc; b.st[1] = nx; }
        const unsigned old = xb_add(&bar[XB_XSUB(b.x)], 1u);
        const unsigned gen = old / nloc;
        if (old + 1u == (gen + 1u) * nloc) {
            __builtin_amdgcn_fence(__ATOMIC_RELEASE, "agent");
            asm volatile("s_waitcnt vmcnt(0)" ::: "memory");
            const unsigned og = xb_add(&bar[XB_TOP], 1u);
            const unsigned tg = og / nx;
            if (og + 1u == (tg + 1u) * nx) xb_add(&bar[XB_TOPGEN], 1u);
            else XB_SPIN(xb_ld(&bar[XB_TOPGEN]) == tg, bar);
            __builtin_amdgcn_fence(__ATOMIC_ACQUIRE, "agent");
            xb_add(&bar[XB_XGEN(b.x)], 1u);
            asm volatile("s_waitcnt vmcnt(0)" ::: "memory");
        } else {
            XB_SPIN(xb_ld(&bar[XB_XGEN(b.x)]) == gen, bar);
            __builtin_amdgcn_fence(__ATOMIC_ACQUIRE, "agent");
            asm volatile("s_waitcnt vmcnt(0)" ::: "memory");
        }
    }
    __syncthreads();
}

namespace pg8 {
#define PG8_LAS __attribute__((address_space(3)))
constexpr int BM = 256, BK = 64, HALF = 128, HTB = HALF * BK * 2  , STAGE_BYTES = 8 * HTB, NXCD = 8, WGM = 4;

__host__ __device__ __forceinline__ int lds_byte(int r, int c) { const int st = (r >> 4) * 2 + (c >> 5), rr = r & 15, cc = c & 31, ob = rr * 64 + cc * 2; return st * 1024 + (ob ^ (((ob >> 9) & 1) << 5)); }
__host__ __device__ __forceinline__ void stage_rc(int b, int& R, int& C) { const int st = b / 1024, sb = b % 1024, swz = sb ^ (((sb >> 9) & 1) << 5); R = (st >> 1) * 16 + swz / 64; C = (st & 1) * 32 + (swz % 64) / 2; }
__host__ __device__ __forceinline__ int perm32(int rho) { const int n = rho >> 4, i = rho & 15; return 8 * (i >> 2) + 4 * n + (i & 3); }

struct Unit { int pm, pn, koff, nt, part; };
struct Gemm { const bf16_t* A; const bf16_t* Bt; int M, N, K; };

struct StaticOrder {
    int nM, nN, nwg, G, c, ntk;
    __host__ __device__ void init(int M, int N, int G_, int c_, int K_ = 0) { nM = M / BM; nN = N / BM; nwg = nM * nN; G = G_; c = c_; ntk = K_ / BK; }
    __host__ __device__ bool next(int i, Unit& u) const {
        const long L = (long)i * G + c; if (L >= nwg) return false;
        int wgid = (int)L; { const int q = nwg / NXCD, r = nwg % NXCD, xcd = wgid % NXCD, off = wgid / NXCD; wgid = (xcd < r ? xcd * (q + 1) : r * (q + 1) + (xcd - r) * q) + off; }
        const int nig = WGM * nN, gid = wgid / nig, fm = gid * WGM, gsz = (nM - fm) < WGM ? (nM - fm) : WGM;
        u.pm = fm + ((wgid % nig) % gsz); u.pn = (wgid % nig) / gsz; u.koff = 0; u.nt = ntk; u.part = -1; return true;
    }
    __device__ __forceinline__ void a_ready(const Unit&) const {}
    __device__ __forceinline__ void done(const Unit&) const {}
};


template <class Epi, class Sched>
__device__ __forceinline__ void gemm_phase(PG8_LAS unsigned char* lds, const Gemm g, const Sched& S, const Epi& E) {
    const int tid = threadIdx.x, wid = __builtin_amdgcn_readfirstlane(tid >> 6), lane = tid & 63, wr = wid >> 2, wc = wid & 3, fr = lane & 15, fq = lane >> 4;
    const int K = g.K;
    unsigned voffA[2], voffB[2];
#pragma unroll
    for (int i = 0; i < 2; ++i) { int R, C; stage_rc(tid * 16 + i * 8192, R, C); const int Rb = Epi::PERM ? ((R & ~31) + perm32(R & 31)) : R;
        voffA[i] = (unsigned)(R * K + C) * 2u; voffB[i] = (unsigned)(Rb * K + C) * 2u; }
    const size_t kstep = (size_t)(BK * 2);
    const size_t hstep = (size_t)HALF * K * 2;
    const size_t tstep = 2 * hstep;
    const unsigned ldsw = (unsigned)wid * 1024u;
    const int aoff = lds_byte(wr * 64 + fr, fq * 8), boff = lds_byte(wc * 32 + fr, fq * 8);
#define PG8_SA(b, h) (((b) * 2 + (h)) * HTB)
#define PG8_SB(b, h) ((4 + (b) * 2 + (h)) * HTB)
#define PG8_STAGE(bufoff, gbase, voff) do { _Pragma("unroll") for (int _i = 0; _i < 2; ++_i) \
        __builtin_amdgcn_global_load_lds((const unsigned*)((const char*)(gbase) + (voff)[_i]), (PG8_LAS unsigned*)(lds + (bufoff) + ldsw + _i * 8192), 16, 0, 0); } while (0)
#define PG8_LDA(dst, b, h) do { _Pragma("unroll") for (int m = 0; m < 4; ++m) _Pragma("unroll") for (int k = 0; k < 2; ++k) dst[m][k] = *(const PG8_LAS bf16x8*)(lds + PG8_SA(b, h) + aoff + m * 2048 + k * 1024); } while (0)
#define PG8_LDB(dst, b, h) do { _Pragma("unroll") for (int n = 0; n < 2; ++n) _Pragma("unroll") for (int k = 0; k < 2; ++k) dst[n][k] = *(const PG8_LAS bf16x8*)(lds + PG8_SB(b, h) + boff + n * 2048 + k * 1024); } while (0)
#define PG8_MMA(ai, bj, At, Bt) do { __builtin_amdgcn_s_setprio(1); _Pragma("unroll") for (int m = 0; m < 4; ++m) _Pragma("unroll") for (int n = 0; n < 2; ++n) _Pragma("unroll") for (int k = 0; k < 2; ++k) \
        { if constexpr (Epi::I8) acc[ai][bj][m][n] = __builtin_bit_cast(f32x4, __builtin_amdgcn_mfma_i32_16x16x64_i8(__builtin_bit_cast(i32x4, Bt[n][k]), __builtin_bit_cast(i32x4, At[m][k]), __builtin_bit_cast(i32x4, acc[ai][bj][m][n]), 0, 0, 0)); \
          else acc[ai][bj][m][n] = __builtin_amdgcn_mfma_f32_16x16x32_bf16(Bt[n][k], At[m][k], acc[ai][bj][m][n], 0, 0, 0); } __builtin_amdgcn_s_setprio(0); } while (0)
#define PG8_WAIT_V(n) asm volatile("s_waitcnt vmcnt(" #n ")" ::: "memory")
#define PG8_WAIT_L(n) asm volatile("s_waitcnt lgkmcnt(" #n ")" ::: "memory")
#define PG8_BAR __builtin_amdgcn_s_barrier()
#define PG8_SCHED __builtin_amdgcn_sched_barrier(0)
    Unit cur, nxt; int ui = 0;
    if (!S.next(0, cur)) return;
    f32x4 acc[2][2][4][2];
#pragma unroll
    for (int a = 0; a < 2; ++a)
#pragma unroll
        for (int b = 0; b < 2; ++b)
#pragma unroll
            for (int m = 0; m < 4; ++m)
#pragma unroll
                for (int n = 0; n < 2; ++n) acc[a][b][m][n] = (f32x4){0.f, 0.f, 0.f, 0.f};
    bf16x8 At[4][2], B0[2][2], B1[2][2];
    const char* cA = (const char*)g.A + (size_t)cur.pm * tstep + cur.koff; const char* cB = (const char*)g.Bt + (size_t)cur.pn * tstep + cur.koff;
    S.a_ready(cur);
    PG8_STAGE(PG8_SB(0, 0), cB, voffB); PG8_STAGE(PG8_SB(0, 1), cB + hstep, voffB); PG8_STAGE(PG8_SA(0, 0), cA, voffA); PG8_STAGE(PG8_SA(0, 1), cA + hstep, voffA);
    if (wr == 1) PG8_BAR;
    PG8_WAIT_V(2); PG8_BAR;
    PG8_STAGE(PG8_SB(1, 0), cB + kstep, voffB); PG8_STAGE(PG8_SA(1, 0), cA + kstep, voffA); PG8_STAGE(PG8_SB(1, 1), cB + hstep + kstep, voffB);
    PG8_WAIT_V(6); PG8_BAR;
    for (;;) {
        const bool has_next = S.next(ui + 1, nxt);
        const char* nA = has_next ? (const char*)g.A + (size_t)nxt.pm * tstep + nxt.koff : cA; const char* nB = has_next ? (const char*)g.Bt + (size_t)nxt.pn * tstep + nxt.koff : cB;
        const int nt = cur.nt;
        for (int t = 0; t < nt; t += 2) {
            const bool last = (t == nt - 2);
            const char* a1 = cA + (size_t)(t + 1) * kstep;
            const char* a2 = last ? nA : cA + (size_t)(t + 2) * kstep; const char* b2 = last ? nB : cB + (size_t)(t + 2) * kstep;
            const char* a3 = a2 + kstep; const char* b3 = b2 + kstep;
            if (last && has_next) S.a_ready(nxt);
            PG8_LDB(B0, 0, 0); PG8_LDB(B1, 0, 1); PG8_SCHED; PG8_LDA(At, 0, 0); PG8_STAGE(PG8_SA(1, 1), a1 + hstep, voffA);
            PG8_WAIT_V(8); PG8_WAIT_L(0); PG8_BAR; PG8_MMA(0, 0, At, B0); PG8_MMA(0, 1, At, B1); PG8_BAR; PG8_SCHED;
            PG8_LDA(At, 0, 1); PG8_STAGE(PG8_SB(0, 0), b2, voffB); PG8_STAGE(PG8_SB(0, 1), b2 + hstep, voffB); PG8_STAGE(PG8_SA(0, 0), a2, voffA);
            PG8_WAIT_V(8); PG8_WAIT_L(0); PG8_BAR; PG8_MMA(1, 0, At, B0); PG8_MMA(1, 1, At, B1); PG8_BAR; PG8_SCHED;
            PG8_LDB(B0, 1, 0); PG8_LDB(B1, 1, 1); PG8_SCHED; PG8_LDA(At, 1, 0); PG8_STAGE(PG8_SA(0, 1), a2 + hstep, voffA);
            PG8_WAIT_V(8); PG8_WAIT_L(0); PG8_BAR; PG8_MMA(0, 0, At, B0); PG8_MMA(0, 1, At, B1); PG8_BAR; PG8_SCHED;
            PG8_LDA(At, 1, 1); PG8_STAGE(PG8_SB(1, 0), b3, voffB); PG8_STAGE(PG8_SB(1, 1), b3 + hstep, voffB); PG8_STAGE(PG8_SA(1, 0), a3, voffA);
            PG8_WAIT_V(8); PG8_WAIT_L(0); PG8_BAR; PG8_MMA(1, 0, At, B0); PG8_MMA(1, 1, At, B1); PG8_BAR; PG8_SCHED;
        }
        if (wr == 0) PG8_BAR;
        if constexpr (Epi::I8) E.prescale(acc, cur, wr, wc, fr, fq);
        if constexpr (!Epi::AFTER_DRAIN) { E(acc, cur, wr, wc, fr, fq); S.done(cur); }
        if (!has_next) break;
#pragma unroll
        for (int a = 0; a < 2; ++a)
#pragma unroll
            for (int b = 0; b < 2; ++b)
#pragma unroll
                for (int m = 0; m < 4; ++m)
#pragma unroll
                    for (int n = 0; n < 2; ++n) acc[a][b][m][n] = (f32x4){0.f, 0.f, 0.f, 0.f};
        cur = nxt; cA = nA; cB = nB; ++ui;
        if (wr == 1) PG8_BAR;
    }
    PG8_WAIT_V(0);
    PG8_BAR;
    if constexpr (Epi::AFTER_DRAIN) { E.fused(acc, cur, wr, wc, fr, fq, lds, wid, lane); S.done(cur); }
#undef PG8_SA
#undef PG8_SB
#undef PG8_STAGE
#undef PG8_LDA
#undef PG8_LDB
#undef PG8_MMA
#undef PG8_WAIT_V
#undef PG8_WAIT_L
#undef PG8_BAR
#undef PG8_SCHED
}

}

#ifndef INO_I8
#define INO_I8 0
#endif
#ifndef MIX_I8
#define MIX_I8 1
#endif
#ifndef FFN_I8
#define FFN_I8 1
#endif
struct Args { const float* in[29]; float* out; unsigned char* ws; int ph_lo, ph_hi; };
struct Ctx {
    const float* in[29]; float* out; unsigned char* ws; unsigned char* ar;
    LAS unsigned char* lds;
    int tid, lane, wave;
};
enum { I_X = 0, I_C, I_CTX, I_CCTX, I_WMOD, I_BMOD, I_WINE, I_MU, I_W0, I_W2, I_A0, I_A2, I_G2, I_KK, I_KA, I_RK, I_LNW, I_LNB, I_LAM, I_SUBLN,
       I_WINO, I_SINK, I_RDEC, I_WMIX, I_WFFI, I_CONVW, I_CONVB, I_WFFO, I_FNORM };

__device__ __forceinline__ void p_mod(const Ctx& c) {
    LAS float* sc = (LAS float*)c.lds;
    LAS float* red = sc + 5 * 4096;
    const int tid = c.tid, lane = c.lane, w = c.wave;
    for (int i = tid; i < 5 * 4096; i += NTHREADS) { const int r = i >> 12, k = i & 4095; const float v = r < 4 ? c.in[I_C][r * 4096 + k] : c.in[I_CCTX][k]; sc[i] = silu_f(v); }
    __syncthreads();
    float* MODP = (float*)(c.ar + AR_MODP);
    for (int u = blockIdx.x; u < 768; u += gridDim.x) {
        const int kp = u & 3, cg = (u >> 2) % 96, l = u / 384;
        const int k0 = kp * 1024 + w * 128;
        const float* wp = c.in[I_WMOD] + ((size_t)l * 4096 + k0) * 24576 + cg * 256 + lane * 4;
        f32x4 acc[5];
#pragma unroll
        for (int r = 0; r < 5; ++r) acc[r] = (f32x4){0.f, 0.f, 0.f, 0.f};
#pragma unroll 2
        for (int k = 0; k < 128; k += 4) {
            f32x4 wv[4];
#pragma unroll
            for (int j = 0; j < 4; ++j) wv[j] = __builtin_nontemporal_load((const f32x4*)(wp + (size_t)(k + j) * 24576));
#pragma unroll
            for (int r = 0; r < 5; ++r) { const f32x4 s4 = *(const LAS f32x4*)(sc + r * 4096 + k0 + k);
#pragma unroll
                for (int j = 0; j < 4; ++j) acc[r] += wv[j] * s4[j]; }
        }
#pragma unroll
        for (int r = 0; r < 5; ++r) *(LAS f32x4*)(red + (w * 5 + r) * 256 + lane * 4) = acc[r];
        __syncthreads();
        for (int idx = tid; idx < 5 * 256; idx += NTHREADS) { const int r = idx >> 8, col = idx & 255; float s = 0.f;
#pragma unroll
            for (int q = 0; q < 8; ++q) s += red[(q * 5 + r) * 256 + col];
            if (kp == 0) s += c.in[I_BMOD][l * 24576 + cg * 256 + col];
            MODP[(size_t)kp * MOD_FLOATS + ((size_t)l * 5 + r) * 24576 + cg * 256 + col] = s; }
        __syncthreads();
    }
}

__device__ __forceinline__ void p_mod_finalize(const Ctx& c) {
    const float* MODP = (const float*)(c.ar + AR_MODP); float* MOD = (float*)(c.ws + WS_MOD);
    for (size_t i = ((size_t)blockIdx.x * NTHREADS + c.tid) * 4; i < MOD_FLOATS; i += (size_t)gridDim.x * NTHREADS * 4)
        *(f32x4*)(MOD + i) = (*(const f32x4*)(MODP + i) + *(const f32x4*)(MODP + MOD_FLOATS + i)) + (*(const f32x4*)(MODP + 2 * MOD_FLOATS + i) + *(const f32x4*)(MODP + 3 * MOD_FLOATS + i));
}
DI int perm64(int m) { const int within = m & 255, rho = within & 127; return (m & ~255) + (rho >> 5) * 64 + (within >> 7) * 32 + (rho & 31); }
DI int perm128(int m) { const int within = m & 255, rho = within & 127; return (m & ~255) + (rho >> 6) * 128 + (within >> 7) * 64 + (rho & 63); }
DI int in_odd_src(int n) { return n < 2304 ? perm64(n) : (n < 2560 ? n : (n < 4608 ? 2560 + perm128(n - 2560) : n)); }
__device__ __forceinline__ int p_convert_job(const Ctx& c, const float* __restrict__ src, int src_ld, int K, int n0, int ncnt, bf16_t* __restrict__ dst, int dn0, int base, int nperm = 0) {
    LAS unsigned short* T = (LAS unsigned short*)c.lds;
    const int tid = c.tid, tk = K / 64, tn = ncnt / 128, nt = tk * tn, G = (int)gridDim.x;
    int first = (int)blockIdx.x - (base % G); if (first < 0) first += G;
    const int kr = tid >> 3, c16 = (tid & 7) * 16, wn = tid >> 2, k16 = (tid & 3) * 16;
    f32x4 v[4], vn[4];
    if (first < nt) { const int nn = (first / tk) * 128 + c16; const float* p = src + (size_t)((first % tk) * 64 + kr) * src_ld + n0 + (nn < nperm ? perm64(nn) : nn);
#pragma unroll
        for (int i = 0; i < 4; ++i) v[i] = __builtin_nontemporal_load((const f32x4*)(p + 4 * i)); }
    for (int t = first; t < nt; t += G) {
        const int t2 = t + G;
        if (t2 < nt) { const int nn = (t2 / tk) * 128 + c16; const float* p = src + (size_t)((t2 % tk) * 64 + kr) * src_ld + n0 + (nn < nperm ? perm64(nn) : nn);
#pragma unroll
            for (int i = 0; i < 4; ++i) vn[i] = __builtin_nontemporal_load((const f32x4*)(p + 4 * i)); }
#pragma unroll
        for (int i = 0; i < 4; ++i)
#pragma unroll
            for (int j = 0; j < 4; ++j) T[(c16 + 4 * i + j) * 72 + kr] = f2bf(v[i][j]);
        __syncthreads();
        { const u32x4 a = *(const LAS u32x4*)(T + wn * 72 + k16), b = *(const LAS u32x4*)(T + wn * 72 + k16 + 8);
          bf16_t* q = dst + (size_t)(dn0 + (t / tk) * 128 + wn) * K + (t % tk) * 64 + k16;
          *(u32x4*)q = a; *(u32x4*)(q + 8) = b; }
        __syncthreads();
#pragma unroll
        for (int i = 0; i < 4; ++i) v[i] = vn[i];
    }
    return base + nt;
}
DI void conv_wave_tile(const float* __restrict__ src, int src_ld, int k0, int nsrc, int n0, bf16_t* __restrict__ dst, int K, int lane) {
    float v[32];
    const float* p = src + (size_t)k0 * src_ld + nsrc;
#pragma unroll
    for (int kk = 0; kk < 32; ++kk) v[kk] = __builtin_nontemporal_load(p + (size_t)kk * src_ld);
    bf16_t* q = dst + (size_t)(n0 + lane) * K + k0;
#pragma unroll
    for (int g = 0; g < 4; ++g) { u32x4 w; w.x = pk_bf16(v[8 * g], v[8 * g + 1]); w.y = pk_bf16(v[8 * g + 2], v[8 * g + 3]); w.z = pk_bf16(v[8 * g + 4], v[8 * g + 5]); w.w = pk_bf16(v[8 * g + 6], v[8 * g + 7]);
        *(u32x4*)(q + 8 * g) = w; }
}
DI unsigned pk_i8x4(float a, float b, float c2, float d) { const int ia = (int)rintf(a), ib = (int)rintf(b), ic = (int)rintf(c2), id = (int)rintf(d);
    return ((unsigned)ia & 255u) | (((unsigned)ib & 255u) << 8) | (((unsigned)ic & 255u) << 16) | ((unsigned)id << 24); }
template <class T> DI void fwht32(T (&v)[32]) {
#pragma unroll
    for (int h = 1; h < 32; h <<= 1)
#pragma unroll
        for (int i = 0; i < 32; i += 2 * h)
#pragma unroll
            for (int j = i; j < i + h; ++j) { const T a = v[j], b = v[j + h]; v[j] = a + b; v[j + h] = a - b; }
}
DI unsigned* i8_cmax(const Ctx& c, int off) { return (unsigned*)(c.ws + WS_CTL + CTL_CMAX) + off; }
DI float* i8_cs(const Ctx& c, int off) { return (float*)(c.ws + WS_CS) + off; }
DI void conv_wave_tile_q8(const float* __restrict__ src, int src_ld, int k0, int nsrc, int n0, unsigned char* __restrict__ dst, int K, int lane, const unsigned* cmax, float* cs) {
    float v[32];
    const float* p = src + (size_t)k0 * src_ld + nsrc;
#pragma unroll
    for (int kk = 0; kk < 32; ++kk) v[kk] = __builtin_nontemporal_load(p + (size_t)kk * src_ld);
    const float cm = __uint_as_float(cmax[nsrc]); const float qs = cm > 0.f ? 127.0f / cm : 0.f;
    if (k0 == 0) cs[n0 + lane] = cm * (1.0f / 127.0f);
    fwht32(v);
    unsigned char* q = dst + (size_t)(n0 + lane) * K + k0;
#pragma unroll
    for (int g = 0; g < 2; ++g) { u32x4 w;
#pragma unroll
        for (int j = 0; j < 4; ++j) w[j] = pk_i8x4(v[16 * g + 4 * j] * 0.03125f * qs, v[16 * g + 4 * j + 1] * 0.03125f * qs, v[16 * g + 4 * j + 2] * 0.03125f * qs, v[16 * g + 4 * j + 3] * 0.03125f * qs);
        *(u32x4*)(q + 16 * g) = w; }
}
__device__ __forceinline__ int p_wcolmax_job(const Ctx& c, const float* __restrict__ src0, int ld, int K, unsigned* cmax, int base) {
    LAS float* red = (LAS float*)c.lds;
    const int ncg = (ld + 255) / 256, nko = K / 1024, nitem = ncg * nko, G = (int)gridDim.x;
    int first = (int)blockIdx.x - (base % G); if (first < 0) first += G;
#pragma unroll 1
    for (int it = first; it < nitem; it += G) {
        const int cg = it % ncg, ko = it / ncg, col = cg * 256 + c.lane * 4;
        f32x4 mx = {0.f, 0.f, 0.f, 0.f};
        if (col < ld) {
#pragma unroll 1
            for (int t = 0; t < 4; ++t) {
                f32x4 v[32]; const float* p = src0 + (size_t)(ko * 1024 + c.wave * 128 + t * 32) * ld + col;
#pragma unroll
                for (int kk = 0; kk < 32; ++kk) v[kk] = __builtin_nontemporal_load((const f32x4*)(p + (size_t)kk * ld));
                fwht32(v);
#pragma unroll
                for (int kk = 0; kk < 32; ++kk)
#pragma unroll
                    for (int j = 0; j < 4; ++j) mx[j] = fmaxf(mx[j], fabsf(v[kk][j]));
            }
        }
        *(LAS f32x4*)(red + c.wave * 256 + c.lane * 4) = mx;
        __syncthreads();
        if (c.tid < 256) { float m = red[c.tid];
#pragma unroll
            for (int w = 1; w < 8; ++w) m = fmaxf(m, red[w * 256 + c.tid]);
            const int cc = cg * 256 + c.tid; if (cc < ld) atomicMax(cmax + cc, __float_as_uint(m * 0.03125f)); }
        __syncthreads();
    }
    return base + nitem;
}
__device__ __forceinline__ void p_wcolmax(const Ctx& c) {
    int base = 0;
    __syncthreads();
    if (FFN_I8) { base = p_wcolmax_job(c, c.in[I_WFFI], 2 * DFF, D, i8_cmax(c, CM_FFI), base); base = p_wcolmax_job(c, c.in[I_WFFI] + (size_t)D * 2 * DFF, 2 * DFF, D, i8_cmax(c, CM_FFI + 2 * DFF), base); }
    if (INO_I8) base = p_wcolmax_job(c, c.in[I_WINO], NO, D, i8_cmax(c, CM_INO), base);
    if (MIX_I8) { base = p_wcolmax_job(c, c.in[I_WMIX], D, D, i8_cmax(c, CM_MIX), base); base = p_wcolmax_job(c, c.in[I_WMIX] + (size_t)D * D, D, D, i8_cmax(c, CM_MIX + D), base); }
}
__device__ __forceinline__ void p_weights_layer0(const Ctx& c) {
    bf16_t* W = (bf16_t*)(c.ws + WS_W);
    {   constexpr int T_IN = (4096 / 32) * ((COLS_A + COLS_B) / 64), T_MIX = (4096 / 32) * (4096 / 64), T_L96 = 3 * (2048 / 64), T_LG = 8 * (2048 / 64);
        constexpr int E0 = T_IN, E1 = E0, E2 = E1 + 4 * T_L96, E3 = E2 + T_LG;
        bf16_t* L = (bf16_t*)((unsigned char*)W + W_LORA);
        for (int t = blockIdx.x * 8 + c.wave; t < E3; t += gridDim.x * 8) {
            if (t < E0) { const int kt = t & 127, g = t >> 7, n = g * 64 + c.lane;
                const int nsrc = n < COLS_A ? n : COLS_A + (n - COLS_A < 4096 ? perm64(n - COLS_A) : n - COLS_A);
                conv_wave_tile(c.in[I_WINE], COLS_A + COLS_B, kt * 32, nsrc, n < COLS_A ? g * 64 : g * 64 + (COLS_A_PAD - COLS_A), (bf16_t*)((unsigned char*)W + W_IN), 4096, c.lane); }
            else if (t < E1) { const int tl = t - E0, kt = tl & 127, g = tl >> 7;
                conv_wave_tile(c.in[I_WMIX], 4096, kt * 32, g * 64 + c.lane, g * 64, (bf16_t*)((unsigned char*)W + W_MIX), 4096, c.lane); }
            else if (t < E2) { const int tl = t - E1, type = tl / T_L96, r2 = tl % T_L96, kt = r2 % 3, g = r2 / 3;
                const float* src = (type < 2 ? c.in[I_W2] + (size_t)type * 96 * 2048 : c.in[I_A2] + (size_t)(type - 2) * 96 * 2048);
                conv_wave_tile(src, 2048, kt * 32, g * 64 + c.lane, g * 64, L + (size_t)type * 2048 * LORA_K + type * LORA_KU, LORA_K, c.lane); }
            else { const int tl = t - E2, kt = tl & 7, g = tl >> 3;
                conv_wave_tile(c.in[I_G2], 2048, kt * 32, g * 64 + c.lane, g * 64, L + (size_t)4 * 2048 * LORA_K + 4 * LORA_KU, LORA_K, c.lane); }
        }
    }
    const size_t gtid = (size_t)blockIdx.x * NTHREADS + c.tid, gn = (size_t)gridDim.x * NTHREADS;
    { u32x4* z = (u32x4*)((unsigned char*)W + W_IN + (size_t)COLS_A * 4096 * 2); const size_t n16 = (size_t)(COLS_A_PAD - COLS_A) * 4096 * 2 / 16;
      for (size_t i = gtid; i < n16; i += gn) z[i] = (u32x4){0u, 0u, 0u, 0u}; }
    { bf16_t* L = (bf16_t*)((unsigned char*)W + W_LORA);
      for (size_t i = gtid; i < (size_t)4 * 2048 * 20; i += gn) { const int n = (int)(i / 20), ch = (int)(i % 20), type = n >> 11;
          *(u32x4*)(L + (size_t)n * LORA_K + type * LORA_KU + 96 + ch * 8) = (u32x4){0u, 0u, 0u, 0u}; } }
    { float* axc = (float*)(c.ws + WS_AXC); float* axs = (float*)(c.ws + WS_AXS);
      for (size_t i = gtid; i < (size_t)SEQ * 32; i += gn) { const int pos = (int)(i >> 5), a = (int)(i & 31), q = a & 15;
          const float inv = powf(10000.0f, -(float)q / 16.0f); const float p = (a < 16) ? (float)(pos >> 6) : (float)(pos & 63);
          float sn, cs; sincosf(p * inv, &sn, &cs); axc[i] = cs; axs[i] = sn; } }
    { float* rtc = (float*)(c.ws + WS_RTC); float* rts = (float*)(c.ws + WS_RTS);
      for (size_t i = gtid; i < (size_t)NKEY * 64; i += gn) { const int pos = (int)(i >> 6), a = (int)(i & 63);
          const float t = (float)a / 63.0f; const float inv = powf(10000.0f, -t);
          float sn, cs; sincosf((float)pos * inv, &sn, &cs); rtc[i] = cs; rts[i] = sn; } }
    if (gtid == 0) { const float* lv = c.in[I_LAM]; float s01 = 0.f, s23 = 0.f;
        for (int i = 0; i < 64; ++i) { s01 += lv[i] * lv[64 + i]; s23 += lv[128 + i] * lv[192 + i]; }
        ((float*)(c.ws + WS_SCAL))[0] = expf(s01) - expf(s23) + 0.2f; }
}
constexpr int CONV_SPLIT = 128192;
__device__ __forceinline__ void p_convert_deferred(const Ctx& c, int worker, int nworkers, int tlo, int thi) {
    unsigned char* W = c.ws + WS_W; unsigned char* W1 = c.ws + WS_W1;
    constexpr int T_FFI = (4096 / 32) * (2 * DFF / 64), T_FFO = (DFF / 32) * (4096 / 64), T_IN1 = (4096 / 32) * (NO / 64), T_MIX = (4096 / 32) * (4096 / 64);
    constexpr int EM = T_MIX, E0 = EM + T_FFI, E1 = E0 + T_FFO, E2 = E1 + T_IN1, E3 = E2 + T_MIX, E4 = E3 + T_FFI, E5 = E4 + T_FFO;
    const int tend = thi < E5 ? thi : E5;
    for (int t = tlo + worker; t < tend; t += nworkers) {
        const float* src; int ld, K, tl; bf16_t* dst; int mixl = -1;
        if (t < EM) { src = c.in[I_WMIX]; ld = 4096; K = 4096; tl = t; dst = (bf16_t*)(W + W_MIX); mixl = 0; }
        else if (t < E0) { src = c.in[I_WFFI]; ld = 2 * DFF; K = 4096; tl = t - EM; dst = (bf16_t*)(W + W_FFI); }
        else if (t < E1) { src = c.in[I_WFFO]; ld = 4096; K = DFF; tl = t - E0; dst = (bf16_t*)(W + W_FFO); }
        else if (t < E2) { src = c.in[I_WINO]; ld = NO; K = 4096; tl = t - E1; dst = (bf16_t*)(W + W_IN); }
        else if (t < E3) { src = c.in[I_WMIX] + (size_t)4096 * 4096; ld = 4096; K = 4096; tl = t - E2; dst = (bf16_t*)(W1 + W1_MIX); mixl = 1; }
        else if (t < E4) { src = c.in[I_WFFI] + (size_t)4096 * 2 * DFF; ld = 2 * DFF; K = 4096; tl = t - E3; dst = (bf16_t*)(W1 + W1_FFI); }
        else { src = c.in[I_WFFO] + (size_t)DFF * 4096; ld = 4096; K = DFF; tl = t - E4; dst = (bf16_t*)(W1 + W1_FFO); }
        const int tk = K / 32, kt = tl % tk, ntile = tl / tk;
        int ncol = ntile * 64;
        if (ld == 2 * DFF) { const int tile = ncol >> 8, within = ncol & 255; ncol = within < 128 ? 128 * tile + within : DFF + 128 * tile + (within - 128); }
        const int nsrc = (ld == NO) ? in_odd_src(ntile * 64 + c.lane) : ncol + c.lane;
        if (FFN_I8 && ld == 2 * DFF) { const int off = CM_FFI + (t < E0 ? 0 : 2 * DFF); conv_wave_tile_q8(src, ld, kt * 32, nsrc, ntile * 64, (unsigned char*)dst, K, c.lane, i8_cmax(c, off), i8_cs(c, off)); }
        else if (MIX_I8 && mixl >= 0) conv_wave_tile_q8(src, ld, kt * 32, nsrc, ntile * 64, (unsigned char*)dst, K, c.lane, i8_cmax(c, CM_MIX + mixl * D), i8_cs(c, CM_MIX + mixl * D));
        else if (INO_I8 && ld == NO) conv_wave_tile_q8(src, ld, kt * 32, nsrc, ntile * 64, (unsigned char*)dst, K, c.lane, i8_cmax(c, CM_INO), i8_cs(c, CM_INO));
        else conv_wave_tile(src, ld, kt * 32, nsrc, ntile * 64, dst, K, c.lane);
    }
}

__device__ __forceinline__ void p_ctx_fix(const Ctx& c, const float* srcc, const float* gate, const float* slab, float* H) {
    for (int row = blockIdx.x * 8 + c.wave; row < TT; row += gridDim.x * 8) {
        if (row < TL) continue;
        const size_t ro = (size_t)(row - TL) * D;
#pragma unroll 4
        for (int i = 0; i < 16; ++i) { const int col = i * 256 + c.lane * 4;
            const f32x4 s4 = (*(const f32x4*)(slab + ro + col) + *(const f32x4*)(slab + (size_t)TC * D + ro + col)) + (*(const f32x4*)(slab + (size_t)2 * TC * D + ro + col) + *(const f32x4*)(slab + (size_t)3 * TC * D + ro + col));
            *(f32x4*)(H + (size_t)row * D + col) = *(const f32x4*)(srcc + ro + col) + *(const f32x4*)(gate + col) * s4; }
    }
}
template <int NPARTS = 1, bool Q8 = false>
__device__ __forceinline__ void p_norm_mod(const Ctx& c, const float* hl, const float* hc, int nrows, const float* mod, int shift_chunk, int scale_chunk) {
    bf16_t* XN = (bf16_t*)(c.ws + WS_XN);
    for (int row = blockIdx.x * 8 + c.wave; row < nrows; row += gridDim.x * 8) {
        const float* src = row < TL ? hl + (size_t)row * D : hc + (size_t)(row - TL) * D;
        f32x4 v[16]; float ss = 0.f;
#pragma unroll
        for (int i = 0; i < 16; ++i) { v[i] = *(const f32x4*)(src + i * 256 + c.lane * 4); ss += v[i][0] * v[i][0] + v[i][1] * v[i][1] + v[i][2] * v[i][2] + v[i][3] * v[i][3]; }
        ss = wave_sum(ss);
        const float rs = rsqrtf(ss * (1.0f / 4096.0f) + 1e-6f);
        const float* mp = mod + (size_t)row_modidx(row) * 24576;
        bf16_t* dst = XN + (size_t)row * D;
        if constexpr (Q8) {
            float mx = 0.f;
#pragma unroll
            for (int i = 0; i < 16; ++i) { const int col = i * 256 + c.lane * 4;
                const f32x4 sh = *(const f32x4*)(mp + shift_chunk * 4096 + col), sc = *(const f32x4*)(mp + scale_chunk * 4096 + col);
#pragma unroll
                for (int j = 0; j < 4; ++j) v[i][j] = v[i][j] * rs * (1.f + sc[j]) + sh[j];
                { const float a0 = v[i][0] + v[i][1], a1 = v[i][0] - v[i][1], a2 = v[i][2] + v[i][3], a3 = v[i][2] - v[i][3];
                  v[i][0] = a0 + a2; v[i][1] = a1 + a3; v[i][2] = a0 - a2; v[i][3] = a1 - a3; }
#pragma unroll
                for (int j = 0; j < 4; ++j) { float x = v[i][j];
                    { const float t = __int_as_float(__builtin_amdgcn_update_dpp(0, __float_as_int(x), 0xB1, 0xF, 0xF, false)); x = (c.lane & 1) ? t - x : x + t; }
                    { const float t = __int_as_float(__builtin_amdgcn_update_dpp(0, __float_as_int(x), 0x4E, 0xF, 0xF, false)); x = (c.lane & 2) ? t - x : x + t; }
                    { const float t = __int_as_float(__builtin_amdgcn_ds_swizzle(__float_as_int(x), 0x101F)); x = (c.lane & 4) ? t - x : x + t; }
                    v[i][j] = x; mx = fmaxf(mx, fabsf(x)); } }
#pragma unroll
            for (int o = 32; o >= 1; o >>= 1) mx = fmaxf(mx, __shfl_xor(mx, o));
            const float qs = mx > 0.f ? 127.0f / mx : 0.f;
            unsigned char* d8 = (unsigned char*)XN + (size_t)row * D;
#pragma unroll
            for (int i = 0; i < 16; ++i) *(unsigned*)(d8 + i * 256 + c.lane * 4) = pk_i8x4(v[i][0] * qs, v[i][1] * qs, v[i][2] * qs, v[i][3] * qs);
            if (c.lane == 0) ((float*)(c.ws + WS_XN + (size_t)TT * D))[row] = mx * (1.0f / 127.0f);
            continue;
        }
#pragma unroll
        for (int i = 0; i < 16; ++i) { const int col = i * 256 + c.lane * 4;
            f32x4 sh = *(const f32x4*)(mp + shift_chunk * 4096 + col), sc = *(const f32x4*)(mp + scale_chunk * 4096 + col);
            if constexpr (NPARTS == 4) {
                sh = (sh + *(const f32x4*)(mp + MOD_FLOATS + shift_chunk * 4096 + col)) + (*(const f32x4*)(mp + 2 * MOD_FLOATS + shift_chunk * 4096 + col) + *(const f32x4*)(mp + 3 * MOD_FLOATS + shift_chunk * 4096 + col));
                sc = (sc + *(const f32x4*)(mp + MOD_FLOATS + scale_chunk * 4096 + col)) + (*(const f32x4*)(mp + 2 * MOD_FLOATS + scale_chunk * 4096 + col) + *(const f32x4*)(mp + 3 * MOD_FLOATS + scale_chunk * 4096 + col)); }
            u32x2 w; w.x = pk_bf16(v[i][0] * rs * (1.f + sc[0]) + sh[0], v[i][1] * rs * (1.f + sc[1]) + sh[1]);
            w.y = pk_bf16(v[i][2] * rs * (1.f + sc[2]) + sh[2], v[i][3] * rs * (1.f + sc[3]) + sh[3]);
            *(u32x2*)(dst + col) = w; }
    }
}
__device__ __forceinline__ void p_final_norm(const Ctx& c) {
    const float* H = (const float*)(c.ws + WS_H);
    for (int row = blockIdx.x * 8 + c.wave; row < TL; row += gridDim.x * 8) {
        const float* src = H + (size_t)row * D;
        f32x4 v[16]; float ss = 0.f;
#pragma unroll
        for (int i = 0; i < 16; ++i) { v[i] = *(const f32x4*)(src + i * 256 + c.lane * 4); ss += v[i][0] * v[i][0] + v[i][1] * v[i][1] + v[i][2] * v[i][2] + v[i][3] * v[i][3]; }
        ss = wave_sum(ss);
        const float rs = rsqrtf(ss * (1.0f / 4096.0f) + 1e-6f);
        float* dst = c.out + (size_t)row * D;
#pragma unroll
        for (int i = 0; i < 16; ++i) { const int col = i * 256 + c.lane * 4; const f32x4 g = *(const f32x4*)(c.in[I_FNORM] + col);
            *(f32x4*)(dst + col) = v[i] * rs * g; }
    }
}

DI void rope_store(const f32x4 (&acc)[2][2][4][2], int ai, int m, const float* tc, const float* ts, bool rot, float scale, bf16_t* o1p, bf16_t* o2p) {
    float o1[8], o2[8];
#pragma unroll
    for (int n = 0; n < 2; ++n) { f32x4 cs = {1.f, 1.f, 1.f, 1.f}, sn = {0.f, 0.f, 0.f, 0.f};
        if (rot) { cs = *(const f32x4*)(tc + 4 * n); sn = *(const f32x4*)(ts + 4 * n); }
#pragma unroll
        for (int e = 0; e < 4; ++e) { const float x1 = acc[ai][0][m][n][e], x2 = acc[ai][1][m][n][e];
            o1[4 * n + e] = (x1 * cs[e] - x2 * sn[e]) * scale; o2[4 * n + e] = (x2 * cs[e] + x1 * sn[e]) * scale; } }
    u32x4 w1, w2; w1.x = pk_bf16(o1[0], o1[1]); w1.y = pk_bf16(o1[2], o1[3]); w1.z = pk_bf16(o1[4], o1[5]); w1.w = pk_bf16(o1[6], o1[7]);
    w2.x = pk_bf16(o2[0], o2[1]); w2.y = pk_bf16(o2[2], o2[3]); w2.z = pk_bf16(o2[4], o2[5]); w2.w = pk_bf16(o2[6], o2[7]);
    *(u32x4*)o1p = w1; *(u32x4*)o2p = w2;
}
DI void plain_store(const f32x4 (&acc)[2][2][4][2], int ai, int m, bf16_t* rowp) {
#pragma unroll
    for (int bj = 0; bj < 2; ++bj) { const f32x4 v0 = acc[ai][bj][m][0], v1 = acc[ai][bj][m][1];
        u32x4 w; w.x = pk_bf16(v0[0], v0[1]); w.y = pk_bf16(v0[2], v0[3]); w.z = pk_bf16(v1[0], v1[1]); w.w = pk_bf16(v1[2], v1[3]);
        *(u32x4*)(rowp + bj * 128) = w; }
}
DI void i8_prescale(f32x4 (&acc)[2][2][4][2], const float* SA, const float* CS, const pg8::Unit& u, int wr, int wc, int fr, int fq) {
    f32x4 cs[2][2];
#pragma unroll
    for (int bj = 0; bj < 2; ++bj)
#pragma unroll
        for (int n = 0; n < 2; ++n) cs[bj][n] = *(const f32x4*)(CS + u.pn * 256 + bj * 128 + wc * 32 + 8 * fq + 4 * n);
#pragma unroll
    for (int ai = 0; ai < 2; ++ai)
#pragma unroll
        for (int m = 0; m < 4; ++m) { const float s = SA[u.pm * 256 + ai * 128 + wr * 64 + 16 * m + fr];
#pragma unroll
            for (int bj = 0; bj < 2; ++bj)
#pragma unroll
                for (int n = 0; n < 2; ++n)
#pragma unroll
                    for (int e = 0; e < 4; ++e) acc[ai][bj][m][n][e] = (float)__float_as_int(acc[ai][bj][m][n][e]) * (s * cs[bj][n][e]); }
}
DI void i8_prescale_np(f32x4 (&acc)[2][2][4][2], const float* SA, const float* CS, const pg8::Unit& u, int wr, int wc, int fr, int fq) {
    f32x4 cs[2][2];
#pragma unroll
    for (int bj = 0; bj < 2; ++bj)
#pragma unroll
        for (int n = 0; n < 2; ++n) cs[bj][n] = *(const f32x4*)(CS + u.pn * 256 + wc * 32 + 4 * fq + bj * 128 + n * 16);
#pragma unroll
    for (int ai = 0; ai < 2; ++ai)
#pragma unroll
        for (int m = 0; m < 4; ++m) { const float s = SA[u.pm * 256 + ai * 128 + wr * 64 + 16 * m + fr];
#pragma unroll
            for (int bj = 0; bj < 2; ++bj)
#pragma unroll
                for (int n = 0; n < 2; ++n)
#pragma unroll
                    for (int e = 0; e < 4; ++e) acc[ai][bj][m][n][e] = (float)__float_as_int(acc[ai][bj][m][n][e]) * (s * cs[bj][n][e]); }
}
struct EpiInEven {
    static constexpr bool PERM = true, AFTER_DRAIN = false, I8 = false;
    bf16_t* PA; bf16_t* PB; const float* axc; const float* axs;
    DI void operator()(const f32x4 (&acc)[2][2][4][2], const pg8::Unit& u, int wr, int wc, int fr, int fq) const {
        const int row0 = u.pm * 256 + wr * 64 + fr, tq = u.pn - COLS_A_PAD / 256;
#pragma unroll
        for (int ai = 0; ai < 2; ++ai)
#pragma unroll
            for (int m = 0; m < 4; ++m) { const int row = row0 + ai * 128 + m * 16;
                if (tq < 0) plain_store(acc, ai, m, PA + (size_t)row * COLS_A_PAD + u.pn * 256 + wc * 32 + 8 * fq);
                else if (tq >= 16) plain_store(acc, ai, m, PB + (size_t)row * COLS_B + tq * 256 + wc * 32 + 8 * fq);
                else { const int pos = row & 4095; bf16_t* o = PB + (size_t)row * COLS_B + tq * 256 + wc * 64 + 8 * fq;
                    rope_store(acc, ai, m, axc + pos * 32 + 8 * fq, axs + pos * 32 + 8 * fq, row < TL, tq < 8 ? 0.18033688011112042f : 1.0f, o, o + 32); } }
    }
};
struct EpiInOdd {
    static constexpr bool PERM = true, AFTER_DRAIN = false, I8 = (INO_I8 != 0);
    bf16_t* P1; const float* axc; const float* axs; const float* rtc; const float* rts; const float* SA; const float* CS;
    DI void prescale(f32x4 (&acc)[2][2][4][2], const pg8::Unit& u, int wr, int wc, int fr, int fq) const { i8_prescale(acc, SA, CS, u, wr, wc, fr, fq); }
    DI void operator()(const f32x4 (&acc)[2][2][4][2], const pg8::Unit& u, int wr, int wc, int fr, int fq) const {
        const int row0 = u.pm * 256 + wr * 64 + fr, pn = u.pn;
#pragma unroll
        for (int ai = 0; ai < 2; ++ai)
#pragma unroll
            for (int m = 0; m < 4; ++m) { const int row = row0 + ai * 128 + m * 16; const bool lat = row < TL; const int pos = lat ? (row & 4095) : ((row - TL) & 255);
                if (pn < 9) { bf16_t* o = P1 + (size_t)row * NO + pn * 256 + wc * 64 + 8 * fq;
                    rope_store(acc, ai, m, axc + pos * 32 + 8 * fq, axs + pos * 32 + 8 * fq, lat, pn < 8 ? 0.18033688011112042f : 1.0f, o, o + 32); }
                else if (pn >= 10 && pn < 18) { const int rp = lat ? CTXL + pos : pos, i0 = 32 * (wc & 1) + 8 * fq; bf16_t* o = P1 + (size_t)row * NO + pn * 256 + (wc >> 1) * 128 + i0;
                    rope_store(acc, ai, m, rtc + rp * 64 + i0, rts + rp * 64 + i0, true, pn < 14 ? 0.08838834764831845f : 1.0f, o, o + 64); }
                else plain_store(acc, ai, m, P1 + (size_t)row * NO + pn * 256 + wc * 32 + 8 * fq); }
    }
};
struct CtxSplitOrder {
    int G, c, nNn, pa, pb;
    __device__ void init(int N, int G_, int c_, int K_) { G = G_; c = c_; nNn = N / 256; pa = ((K_ / 64 / 4) + 1) & ~1; pb = (K_ / 64 - 2 * pa) / 2; }
    __device__ bool next(int i, pg8::Unit& u) const {
        const long L = (long)i * G + c; if (L >= 4 * nNn * 4) return false;
        const int j = (int)L, part = j & 3, tile = j >> 2; u.pm = 64 + (tile & 3); u.pn = tile >> 2; u.part = part;
        u.koff = (part < 2 ? part * pa : 2 * pa + (part - 2) * pb) * 128; u.nt = part < 2 ? pa : pb; return true; }
    __device__ __forceinline__ void a_ready(const pg8::Unit&) const {}
    __device__ __forceinline__ void done(const pg8::Unit&) const {}
};
template <bool Q8>
struct EpiSlabT {
    static constexpr bool PERM = false, AFTER_DRAIN = false, I8 = Q8;
    float* slab; const float* SA; const float* CS;
    DI void prescale(f32x4 (&acc)[2][2][4][2], const pg8::Unit& u, int wr, int wc, int fr, int fq) const { i8_prescale_np(acc, SA, CS, u, wr, wc, fr, fq); }
    DI void operator()(const f32x4 (&acc)[2][2][4][2], const pg8::Unit& u, int wr, int wc, int fr, int fq) const {
        const int row0 = u.pm * 256 + wr * 64 + fr, col0 = u.pn * 256 + wc * 32 + 4 * fq;
        float* sb = slab + ((size_t)u.part * TC + (row0 - TL)) * D + col0;
#pragma unroll
        for (int ai = 0; ai < 2; ++ai)
#pragma unroll
            for (int m = 0; m < 4; ++m)
#pragma unroll
                for (int bj = 0; bj < 2; ++bj)
#pragma unroll
                    for (int n = 0; n < 2; ++n) *(f32x4*)(sb + (size_t)(ai * 128 + m * 16) * D + bj * 128 + n * 16) = acc[ai][bj][m][n];
    }
};
struct LatThenCtxOrder : pg8::StaticOrder {
    int nNn;
    __device__ void init2(int N, int G_, int c_, int K_) { init(TL, N, G_, c_, K_); nNn = N / 256; }
    __device__ bool next(int i, pg8::Unit& u) const {
        const long L = (long)i * G + c; if (L < nwg) return pg8::StaticOrder::next(i, u);
        const int j = (int)(L - nwg); if (j >= 4 * nNn) return false;
        u.pm = 64 + (j & 3); u.pn = j >> 2; u.koff = 0; u.nt = ntk; u.part = -1; return true; }
};
struct LoraOrder : LatThenCtxOrder {
    __device__ bool next(int i, pg8::Unit& u) const { if (!LatThenCtxOrder::next(i, u)) return false; u.koff = (u.pn >> 3) * (LORA_KU * 2); u.nt = LORA_KU / 64; return true; }
};
struct OddInOrder : pg8::StaticOrder {
    __device__ void init2(int G_, int c_, int K_) { init(TL, NO, G_, c_, K_); }
    __device__ bool next(int i, pg8::Unit& u) const {
        const long L = (long)i * G + c; if (L < nwg) return pg8::StaticOrder::next(i, u);
        const int j = (int)(L - nwg); if (j >= 4 * 14) return false;
        const int idx = j >> 2; u.pm = 64 + (j & 3); u.pn = idx < 2 ? 8 + idx : 12 + idx; u.koff = 0; u.nt = ntk; u.part = -1; return true; }
};
template <bool Q8>
struct EpiResModT {
    static constexpr bool PERM = false, AFTER_DRAIN = false, I8 = Q8;
    const float* Rlat; const float* Rctx; float* Hout; const float* mod;
    const float* SA; const float* CS;
    DI void prescale(f32x4 (&acc)[2][2][4][2], const pg8::Unit& u, int wr, int wc, int fr, int fq) const { i8_prescale_np(acc, SA, CS, u, wr, wc, fr, fq); }
    DI void operator()(const f32x4 (&acc)[2][2][4][2], const pg8::Unit& u, int wr, int wc, int fr, int fq) const {
        const int row0 = u.pm * 256 + wr * 64 + fr, col0 = u.pn * 256 + wc * 32 + 4 * fq;
        const float* mp = mod + (size_t)(u.pm < 64 ? (u.pm >> 4) : 4) * 24576 + col0;
        f32x4 mv[2][2];
#pragma unroll
        for (int bj = 0; bj < 2; ++bj)
#pragma unroll
            for (int n = 0; n < 2; ++n) mv[bj][n] = *(const f32x4*)(mp + bj * 128 + n * 16);
        const float* sbase = (u.pm < 64) ? Rlat + (size_t)row0 * D : Rctx + (size_t)(row0 - TL) * D;
        float* dbase = Hout + (size_t)row0 * D;
#pragma unroll
        for (int ai = 0; ai < 2; ++ai)
#pragma unroll
            for (int m = 0; m < 4; ++m) { const size_t ro = (size_t)(ai * 128 + m * 16) * D + col0;
#pragma unroll
                for (int bj = 0; bj < 2; ++bj)
#pragma unroll
                    for (int n = 0; n < 2; ++n) { const f32x4 r = *(const f32x4*)(sbase + ro + bj * 128 + n * 16);
                        *(f32x4*)(dbase + ro + bj * 128 + n * 16) = r + mv[bj][n] * acc[ai][bj][m][n]; } }
    }
};

typedef EpiResModT<false> EpiResMod;
typedef EpiSlabT<false> EpiSlab;
struct EpiConvGlu {
    static constexpr bool PERM = true, AFTER_DRAIN = false, I8 = (FFN_I8 != 0);
    bf16_t* HID; bf16_t* SG; bf16_t* SU; const float* cw; const float* cb; const float* SA; const float* CS;
    DI void prescale(f32x4 (&acc)[2][2][4][2], const pg8::Unit& u, int wr, int wc, int fr, int fq) const { i8_prescale(acc, SA, CS, u, wr, wc, fr, fq); }
    DI void operator()(const f32x4 (&acc)[2][2][4][2], const pg8::Unit& u, int wr, int wc, int fr, int fq) const {
        const int col = u.pn * 128 + wc * 32 + 8 * fq;
#pragma unroll
        for (int ai = 0; ai < 2; ++ai) {
            const int rowb = u.pm * 256 + ai * 128 + wr * 64;
#pragma unroll
            for (int n = 0; n < 2; ++n) {
                const f32x4 w0 = *(const f32x4*)(cw + col + 4 * n), w1 = *(const f32x4*)(cw + DFF + col + 4 * n), w2 = *(const f32x4*)(cw + 2 * DFF + col + 4 * n), bb = *(const f32x4*)(cb + col + 4 * n);
                unsigned outp[4][2];
#pragma unroll
                for (int ep = 0; ep < 2; ++ep) { float o[4][2];
#pragma unroll
                    for (int e2 = 0; e2 < 2; ++e2) { const int e = 2 * ep + e2; float P[4], N[4];
#pragma unroll
                        for (int m = 0; m < 4; ++m) { const int vi = __float_as_int(acc[ai][0][m][n][e]);
                            P[m] = __int_as_float(__builtin_amdgcn_update_dpp(0, vi, 0x121, 0xF, 0xF, false)); N[m] = __int_as_float(__builtin_amdgcn_update_dpp(0, vi, 0x12F, 0xF, 0xF, false)); }
#pragma unroll
                        for (int m = 0; m < 4; ++m) { const float prev = fr > 0 ? P[m] : (m > 0 ? P[m - 1] : 0.f), next = fr < 15 ? N[m] : (m < 3 ? N[m + 1] : 0.f);
                            const float x = w0[e] * prev + w1[e] * acc[ai][0][m][n][e] + w2[e] * next + bb[e];
                            o[m][e2] = silu_f(x) * acc[ai][1][m][n][e]; } }
#pragma unroll
                    for (int m = 0; m < 4; ++m) outp[m][ep] = pk_bf16(o[m][0], o[m][1]); }
#pragma unroll
                for (int m = 0; m < 4; ++m) { const int rho = 16 * m + fr, row = rowb + rho;
                    if (rho != 0 && rho != 63) { u32x2 w = {outp[m][0], outp[m][1]}; *(u32x2*)(HID + (size_t)row * DFF + col + 4 * n) = w; }
                    if (m == 0 || m == 3) { if (rho <= 1 || rho >= 62) { const int slot = rho <= 1 ? rho : rho - 60;
                            u32x2 g; g.x = pk_bf16(acc[ai][0][m][n][0], acc[ai][0][m][n][1]); g.y = pk_bf16(acc[ai][0][m][n][2], acc[ai][0][m][n][3]);
                            *(u32x2*)(SG + ((size_t)(row >> 6) * 4 + slot) * DFF + col + 4 * n) = g;
                            if (rho == 0 || rho == 63) { u32x2 q; q.x = pk_bf16(acc[ai][1][m][n][0], acc[ai][1][m][n][1]); q.y = pk_bf16(acc[ai][1][m][n][2], acc[ai][1][m][n][3]);
                                *(u32x2*)(SU + ((size_t)(row >> 6) * 2 + (rho == 63 ? 1 : 0)) * DFF + col + 4 * n) = q; } } }
                }
            }
        }
    }
};
__device__ __forceinline__ void p_conv_fix(const Ctx& c, int l, int nrows) {
    const bf16_t* SG = (const bf16_t*)(c.ar + AR_SG); const bf16_t* SU = (const bf16_t*)(c.ar + AR_SU); bf16_t* HID = (bf16_t*)(c.ar + AR_HID);
    const float* cw = c.in[I_CONVW] + (size_t)l * 3 * DFF; const float* cb = c.in[I_CONVB] + (size_t)l * DFF;
    const int nitems = (nrows / 64) * 2 * 22;
    const u32x4 z4 = {0u, 0u, 0u, 0u};
    for (int item = blockIdx.x * 8 + c.wave; item < nitems; item += gridDim.x * 8) {
        const int ch = item % 22, kw = item / 22, kb = kw >> 1, last = kw & 1, col = ch * 512 + c.lane * 8;
        if (col >= DFF) continue;
        const int row = kb * 64 + (last ? 63 : 0);
        int pos, len; if (row < TL) { pos = row & 4095; len = 4096; } else { pos = (row - TL) & 255; len = 256; }
        u32x4 gp, gc, gn;
        if (!last) { gp = pos > 0 ? *(const u32x4*)(SG + ((size_t)(kb - 1) * 4 + 3) * DFF + col) : z4; gc = *(const u32x4*)(SG + ((size_t)kb * 4 + 0) * DFF + col); gn = *(const u32x4*)(SG + ((size_t)kb * 4 + 1) * DFF + col); }
        else { gp = *(const u32x4*)(SG + ((size_t)kb * 4 + 2) * DFF + col); gc = *(const u32x4*)(SG + ((size_t)kb * 4 + 3) * DFF + col); gn = pos < len - 1 ? *(const u32x4*)(SG + ((size_t)(kb + 1) * 4 + 0) * DFF + col) : z4; }
        const u32x4 up = *(const u32x4*)(SU + ((size_t)kb * 2 + last) * DFF + col);
        float w0[8], w1[8], w2[8], bb[8]; load8f(cw + col, w0); load8f(cw + DFF + col, w1); load8f(cw + 2 * DFF + col, w2); load8f(cb + col, bb);
        float o[8];
#pragma unroll
        for (int j = 0; j < 4; ++j) {
            const float x0 = bflo(gp[j]) * w0[2 * j] + bflo(gc[j]) * w1[2 * j] + bflo(gn[j]) * w2[2 * j] + bb[2 * j];
            const float x1 = bfhi(gp[j]) * w0[2 * j + 1] + bfhi(gc[j]) * w1[2 * j + 1] + bfhi(gn[j]) * w2[2 * j + 1] + bb[2 * j + 1];
            o[2 * j] = silu_f(x0) * bflo(up[j]); o[2 * j + 1] = silu_f(x1) * bfhi(up[j]); }
        u32x4 w; w.x = pk_bf16(o[0], o[1]); w.y = pk_bf16(o[2], o[3]); w.z = pk_bf16(o[4], o[5]); w.w = pk_bf16(o[6], o[7]);
        *(u32x4*)(HID + (size_t)row * DFF + col) = w;
    }
}

DI void unpack8(const u32x4 w, float (&o)[8]) {
#pragma unroll
    for (int j = 0; j < 4; ++j) { o[2 * j] = bflo(w[j]); o[2 * j + 1] = bfhi(w[j]); }
}
DI u32x4 pack8_bf16(const float (&o)[8]) { u32x4 w; w.x = pk_bf16(o[0], o[1]); w.y = pk_bf16(o[2], o[3]); w.z = pk_bf16(o[4], o[5]); w.w = pk_bf16(o[6], o[7]); return w; }
DI u32x4 pack8_f16(const float (&o)[8]) { u32x4 w; w.x = pk_f16(o[0], o[1]); w.y = pk_f16(o[2], o[3]); w.z = pk_f16(o[4], o[5]); w.w = pk_f16(o[6], o[7]); return w; }
DI void unpack8_f16(const u32x4 w, float (&o)[8]) {
#pragma unroll
    for (int j = 0; j < 4; ++j) { o[2 * j] = h16lo(w[j]); o[2 * j + 1] = h16hi(w[j]); }
}
DI void row_pos(int row, int& pos, int& len) { if (row < TL) { pos = row & 4095; len = 4096; } else { pos = (row - TL) & 255; len = 256; } }

__device__ __forceinline__ void p_rwkv_prepA(const Ctx& c) {
    const bf16_t* PA = (const bf16_t*)(c.ar + AR_PA);
    h16* R16 = (h16*)(c.ar + AR_R); h16* KK16 = (h16*)(c.ar + AR_KK); h16* V16 = (h16*)(c.ar + AR_V); bf16_t* K16 = (bf16_t*)(c.ar + AR_K); bf16_t* LA = (bf16_t*)(c.ar + AR_LA);
    const float* mu = c.in[I_MU]; const float* k_k = c.in[I_KK];
    const int lane = c.lane;
    for (int row = blockIdx.x * 8 + c.wave; row < TT; row += gridDim.x * 8) {
        int pos, len; row_pos(row, pos, len);
        const bool hasp = pos > 0, hasn = pos < len - 1;
        const bf16_t* pc = PA + (size_t)row * COLS_A_PAD;
        for (int it = 0; it < 14; ++it) {
            const int col = it * 512 + lane * 8;
            if (col >= COLS_A) break;
            float cur[8], prv[8], nxt[8], m8[8], mx[8];
            unpack8(*(const u32x4*)(pc + col), cur);
            if (hasp) unpack8(*(const u32x4*)(pc - COLS_A_PAD + col), prv); else {
#pragma unroll
                for (int j = 0; j < 8; ++j) prv[j] = 0.f; }
            if (hasn) unpack8(*(const u32x4*)(pc + COLS_A_PAD + col), nxt); else {
#pragma unroll
                for (int j = 0; j < 8; ++j) nxt[j] = 0.f; }
            load8f(mu + col, m8);
#pragma unroll
            for (int j = 0; j < 8; ++j) mx[j] = cur[j] + m8[j] * (0.5f * (prv[j] + nxt[j]) - cur[j]);
            if (it < 4) {
                *(u32x4*)(R16 + (size_t)row * 2048 + col) = pack8_f16(mx);
            } else if (it < 8) {
                const int j0 = col - 2048;
                *(u32x4*)(K16 + (size_t)row * 2048 + j0) = pack8_bf16(mx);
                float kk8[8], x[8]; load8f(k_k + j0, kk8); float ss = 0.f;
#pragma unroll
                for (int j = 0; j < 8; ++j) { x[j] = mx[j] * kk8[j]; ss += x[j] * x[j]; }
                ss += __shfl_xor(ss, 1); ss += __shfl_xor(ss, 2); ss += __shfl_xor(ss, 4);
                const float rn = rsqrtf(ss + 1e-12f);
#pragma unroll
                for (int j = 0; j < 8; ++j) x[j] *= rn;
                *(u32x4*)(KK16 + (size_t)row * 2048 + j0) = pack8_f16(x);
            } else if (it < 12) {
                *(u32x4*)(V16 + (size_t)row * 2048 + (col - 4096)) = pack8_f16(mx);
            } else {
                const int q0 = col - 6144; float o[8];
#pragma unroll
                for (int j = 0; j < 8; ++j) o[j] = q0 < 192 ? (1.0f - 2.0f * __builtin_amdgcn_rcpf(1.0f + __expf(2.0f * mx[j]))) : (q0 < 384 ? mx[j] : sigmoid_f(mx[j]));
                const int seg = q0 < 384 ? q0 / 96 : 4, off = q0 - (seg < 4 ? seg * 96 : 384);
                *(u32x4*)(LA + (size_t)row * LORA_K + seg * LORA_KU + off) = pack8_bf16(o);
            }
        }
        {
            const u32x4 z4 = {0u, 0u, 0u, 0u};
            for (int z = lane; z < 80; z += 64) *(u32x4*)(LA + (size_t)row * LORA_K + (z / 20) * LORA_KU + 96 + (z % 20) * 8) = z4; }
    }
}

DI int kperm16(int o) { return (o & ~12) | ((o >> 1) & 4) | ((o << 1) & 8); }
template <int DVW  , int NHEAD>
__device__ __forceinline__ void p_build_vt(const Ctx& c, const bf16_t* P, int ldp, int vcol0, bf16_t* VT) {
    constexpr int NSLAB = (DVW * NHEAD) / 512 > 0 ? (DVW * NHEAD) / 512 : 1;
    constexpr int SLABW = (DVW * NHEAD) < 512 ? (DVW * NHEAD) : 512;
    LAS unsigned short* T = (LAS unsigned short*)c.lds;
    const int tid = c.tid;
    for (int item = blockIdx.x; item < (TT / 64) * NSLAB; item += gridDim.x) {
        const int kg = item / NSLAB, slab = item % NSLAB;
        const int row0 = kg * 64;
        int b, key0; if (row0 < TL) { b = row0 >> 12; key0 = row0 & 4095; } else { b = (row0 - TL) >> 8; key0 = 4096 + ((row0 - TL) & 255); }
        { const int key = tid >> 3, part = tid & 7; const int kp = (key & ~15) | kperm16(key & 15);
          constexpr int CPT = SLABW / 8;
          const bf16_t* src = P + (size_t)(row0 + key) * ldp + vcol0 + slab * SLABW + part * CPT;
#pragma unroll
          for (int e = 0; e < CPT / 8; ++e) { const u32x4 w = *(const u32x4*)(src + e * 8);
#pragma unroll
              for (int j = 0; j < 4; ++j) { T[(part * CPT + e * 8 + 2 * j) * 72 + kp] = (unsigned short)(w[j] & 0xffffu); T[(part * CPT + e * 8 + 2 * j + 1) * 72 + kp] = (unsigned short)(w[j] >> 16); } }
        }
        __syncthreads();
        for (int q = tid; q < SLABW * 8; q += NTHREADS) { const int col = q >> 3, ch = q & 7;
            const u32x4 w = *(const LAS u32x4*)(T + col * 72 + ch * 8);
            const int gc = slab * SLABW + col, head = gc / DVW, dv = gc % DVW;
            *(u32x4*)(VT + (((size_t)b * NHEAD + head) * DVW + dv) * NKEY + key0 + ch * 8) = w; }
        __syncthreads();
    }
}

struct EpiLora {
    static constexpr bool PERM = true, AFTER_DRAIN = false, I8 = false;
    const float* w0; const float* a0; const float* k_a; const bf16_t* K16; const h16* KK16; h16* OMW; h16* BB; h16* KD; bf16_t* G;
    DI void operator()(const f32x4 (&acc)[2][2][4][2], const pg8::Unit& u, int wr, int wc, int fr, int fq) const {
        const int type = u.pn >> 3, row0 = u.pm * 256 + wr * 64 + fr;
#pragma unroll
        for (int bj = 0; bj < 2; ++bj) {
            const int jc = (u.pn & 7) * 256 + bj * 128 + wc * 32 + 8 * fq;
            if (type < 2) {
                float w8[8]; load8f(w0 + type * 2048 + jc, w8);
#pragma unroll
                for (int ai = 0; ai < 2; ++ai)
#pragma unroll
                    for (int m = 0; m < 4; ++m) { const int row = row0 + ai * 128 + m * 16; float o[8];
#pragma unroll
                        for (int i = 0; i < 8; ++i) { const float w = w8[i] + (i < 4 ? acc[ai][bj][m][0][i & 3] : acc[ai][bj][m][1][i & 3]);
                            o[i] = 1.0f - __expf(-0.60653066f * sigmoid_f(w)); }
                        *(u32x4*)(OMW + ((size_t)type * TT + row) * 2048 + jc) = pack8_f16(o); }
            } else if (type < 4) {
                const int d = type - 2; float a8[8], ka8[8]; load8f(a0 + d * 2048 + jc, a8); load8f(k_a + jc, ka8);
#pragma unroll
                for (int ai = 0; ai < 2; ++ai)
#pragma unroll
                    for (int m = 0; m < 4; ++m) { const int row = row0 + ai * 128 + m * 16; float kd[8], bb[8], k8[8], kk8[8];
                        unpack8(*(const u32x4*)(K16 + (size_t)row * 2048 + jc), k8); unpack8_f16(*(const u32x4*)(KK16 + (size_t)row * 2048 + jc), kk8);
#pragma unroll
                        for (int i = 0; i < 8; ++i) { const float a = sigmoid_f(a8[i] + (i < 4 ? acc[ai][bj][m][0][i & 3] : acc[ai][bj][m][1][i & 3]));
                            kd[i] = k8[i] * (1.0f + (a - 1.0f) * ka8[i]); bb[i] = kk8[i] * a; }
                        *(u32x4*)(KD + ((size_t)d * TT + row) * 2048 + jc) = pack8_f16(kd);
                        *(u32x4*)(BB + ((size_t)d * TT + row) * 2048 + jc) = pack8_f16(bb); }
            } else {
#pragma unroll
                for (int ai = 0; ai < 2; ++ai)
#pragma unroll
                    for (int m = 0; m < 4; ++m) { const int row = row0 + ai * 128 + m * 16; float o[8];
#pragma unroll
                        for (int i = 0; i < 8; ++i) o[i] = (i < 4 ? acc[ai][bj][m][0][i & 3] : acc[ai][bj][m][1][i & 3]);
                        *(u32x4*)(G + (size_t)row * 2048 + jc) = pack8_bf16(o); }
            }
        }
    }
};

#define MFMA32(a, b, cacc) __builtin_amdgcn_mfma_f32_32x32x16_bf16((a), (b), (cacc), 0, 0, 0)
DI bf16x8 ld_frag(const bf16_t* p) { return __builtin_bit_cast(bf16x8, *(const u32x4*)p); }
DI bf16x8 pack_p(const f32x16& x, int s) { u32x4 w; w.x = pk_bf16(x[8 * s], x[8 * s + 1]); w.y = pk_bf16(x[8 * s + 2], x[8 * s + 3]); w.z = pk_bf16(x[8 * s + 4], x[8 * s + 5]); w.w = pk_bf16(x[8 * s + 6], x[8 * s + 7]); return __builtin_bit_cast(bf16x8, w); }
constexpr float LOG2E = 1.44269504088896f;

DI void fwht8x4(float (&x)[8], int lane) {
#pragma unroll
    for (int h = 1; h < 8; h <<= 1)
#pragma unroll
        for (int i = 0; i < 8; i += 2 * h)
#pragma unroll
            for (int j = i; j < i + h; ++j) { const float a = x[j], b = x[j + h]; x[j] = a + b; x[j + h] = a - b; }
#pragma unroll
    for (int j = 0; j < 8; ++j) { float v = x[j];
        { const float t = __int_as_float(__builtin_amdgcn_update_dpp(0, __float_as_int(v), 0xB1, 0xF, 0xF, false)); v = (lane & 1) ? t - v : v + t; }
        { const float t = __int_as_float(__builtin_amdgcn_update_dpp(0, __float_as_int(v), 0x4E, 0xF, 0xF, false)); v = (lane & 2) ? t - v : v + t; }
        x[j] = v; }
}
DI float wave_max(float v) {
#pragma unroll
    for (int o = 32; o >= 1; o >>= 1) v = fmaxf(v, __shfl_xor(v, o));
    return v;
}
__device__ __forceinline__ void p_rwkv_out(const Ctx& c, int nrows) {
    const bf16_t* Yf = (const bf16_t*)(c.ar + AR_Y); const bf16_t* Yb = Yf + (size_t)TT * 2048;
    const h16* R16 = (const h16*)(c.ar + AR_R); const h16* V16 = (const h16*)(c.ar + AR_V);
    const h16* KDf = (const h16*)(c.ar + AR_KD); const h16* KDb = KDf + (size_t)TT * 2048;
    const bf16_t* G = (const bf16_t*)(c.ar + AR_G); bf16_t* MIX = (bf16_t*)(c.ws + WS_XN);
    const float* r_k = c.in[I_RK]; const float* ln_w = c.in[I_LNW]; const float* ln_b = c.in[I_LNB];
    const int lane = c.lane;
    for (int row = blockIdx.x * 8 + c.wave; row < nrows; row += gridDim.x * 8) {
        float ov[4][8];
#pragma unroll
        for (int it = 0; it < 4; ++it) {
            const int col = it * 512 + lane * 8; const size_t o = (size_t)row * 2048 + col;
            float yf[8], yb[8], y[8], r8[8], v8[8], kf[8], kb[8], g8[8], rk8[8], lw[8], lb[8];
            unpack8(*(const u32x4*)(Yf + o), yf); unpack8(*(const u32x4*)(Yb + o), yb);
            unpack8_f16(*(const u32x4*)(R16 + o), r8); unpack8_f16(*(const u32x4*)(V16 + o), v8);
            unpack8_f16(*(const u32x4*)(KDf + o), kf); unpack8_f16(*(const u32x4*)(KDb + o), kb);
            unpack8(*(const u32x4*)(G + o), g8);
            load8f(r_k + col, rk8); load8f(ln_w + col, lw); load8f(ln_b + col, lb);
            float sm = 0.f, bn = 0.f;
#pragma unroll
            for (int j = 0; j < 8; ++j) { y[j] = yf[j] + yb[j]; sm += y[j]; bn += r8[j] * (kf[j] + kb[j]) * rk8[j]; }
            sm += __shfl_xor(sm, 1); sm += __shfl_xor(sm, 2); sm += __shfl_xor(sm, 4);
            bn += __shfl_xor(bn, 1); bn += __shfl_xor(bn, 2); bn += __shfl_xor(bn, 4);
            const float mean = sm * (1.0f / 64.0f); float vs = 0.f;
#pragma unroll
            for (int j = 0; j < 8; ++j) { const float dlt = y[j] - mean; vs += dlt * dlt; }
            vs += __shfl_xor(vs, 1); vs += __shfl_xor(vs, 2); vs += __shfl_xor(vs, 4);
            const float rs = rsqrtf(vs * (1.0f / 64.0f) + 64e-5f);
            float o8[8];
#pragma unroll
            for (int j = 0; j < 8; ++j) o8[j] = ((y[j] - mean) * rs * lw[j] + lb[j] + bn * v8[j]) * g8[j];
            if (MIX_I8) {
#pragma unroll
                for (int j = 0; j < 8; ++j) ov[it][j] = o8[j]; }
            else *(u32x4*)(MIX + (size_t)row * D + col) = pack8_bf16(o8);
        }
        if (MIX_I8) {
            float av[4][8]; float mx = 0.f;
#pragma unroll
            for (int it = 0; it < 4; ++it) { unpack8(*(const u32x4*)(MIX + (size_t)row * D + 2048 + it * 512 + lane * 8), av[it]);
                fwht8x4(ov[it], lane); fwht8x4(av[it], lane);
#pragma unroll
                for (int j = 0; j < 8; ++j) mx = fmaxf(mx, fmaxf(fabsf(ov[it][j]), fabsf(av[it][j]))); }
            mx = wave_max(mx);
            const float qs = mx > 0.f ? 127.0f / mx : 0.f;
            unsigned char* xq = c.ar + AR_XQ + (size_t)row * D;
#pragma unroll
            for (int it = 0; it < 4; ++it) {
                u32x2 w0 = {pk_i8x4(ov[it][0] * qs, ov[it][1] * qs, ov[it][2] * qs, ov[it][3] * qs), pk_i8x4(ov[it][4] * qs, ov[it][5] * qs, ov[it][6] * qs, ov[it][7] * qs)};
                u32x2 w1 = {pk_i8x4(av[it][0] * qs, av[it][1] * qs, av[it][2] * qs, av[it][3] * qs), pk_i8x4(av[it][4] * qs, av[it][5] * qs, av[it][6] * qs, av[it][7] * qs)};
                *(u32x2*)(xq + it * 512 + lane * 8) = w0; *(u32x2*)(xq + 2048 + it * 512 + lane * 8) = w1; }
            if (lane == 0) ((float*)(c.ar + AR_XQS))[row] = mx * (1.0f / 127.0f);
        }
    }
}
__device__ __forceinline__ void p_quant_mix(const Ctx& c, int nrows) {
    const bf16_t* MIX = (const bf16_t*)(c.ws + WS_XN); const int lane = c.lane;
    for (int row = blockIdx.x * 8 + c.wave; row < nrows; row += gridDim.x * 8) {
        float x[8][8]; float mx = 0.f;
#pragma unroll
        for (int it = 0; it < 8; ++it) { unpack8(*(const u32x4*)(MIX + (size_t)row * D + it * 512 + lane * 8), x[it]); fwht8x4(x[it], lane);
#pragma unroll
            for (int j = 0; j < 8; ++j) mx = fmaxf(mx, fabsf(x[it][j])); }
        mx = wave_max(mx);
        const float qs = mx > 0.f ? 127.0f / mx : 0.f;
        unsigned char* xq = c.ar + AR_XQ + (size_t)row * D;
#pragma unroll
        for (int it = 0; it < 8; ++it) { u32x2 w = {pk_i8x4(x[it][0] * qs, x[it][1] * qs, x[it][2] * qs, x[it][3] * qs), pk_i8x4(x[it][4] * qs, x[it][5] * qs, x[it][6] * qs, x[it][7] * qs)};
            *(u32x2*)(xq + it * 512 + lane * 8) = w; }
        if (lane == 0) ((float*)(c.ar + AR_XQS))[row] = mx * (1.0f / 127.0f);
    }
}

constexpr int K1_WAVE_LDS = 35328;
constexpr size_t TT_ROWS2048 = (size_t)TT * 2048;
#define WAVE_SYNC() do { asm volatile("s_waitcnt lgkmcnt(0)" ::: "memory"); __builtin_amdgcn_wave_barrier(); } while (0)
DI int rw_row(int b, int dir, int t) { return t < CTXL ? TL + b * CTXL + (dir ? (CTXL - 1 - t) : t) : b * SEQ + (dir ? (SEQ - 1 - (t - CTXL)) : (t - CTXL)); }
DI float bfu(unsigned short x) { return __uint_as_float((unsigned)x << 16); }
DI bf16x8 colfrag_nat(const LAS unsigned short* T, int col, int t0) { u32x4 w;
#pragma unroll
    for (int j = 0; j < 4; ++j) w[j] = (unsigned)T[(t0 + 2 * j) * 64 + col] | ((unsigned)T[(t0 + 2 * j + 1) * 64 + col] << 16);
    return __builtin_bit_cast(bf16x8, w); }
DI bf16x8 colfrag_nat_scaled(const LAS unsigned short* T, int col, int t0, float sc) { u32x4 w;
#pragma unroll
    for (int j = 0; j < 4; ++j) w[j] = pk_bf16(bfu(T[(t0 + 2 * j) * 64 + col]) * sc, bfu(T[(t0 + 2 * j + 1) * 64 + col]) * sc);
    return __builtin_bit_cast(bf16x8, w); }
DI bf16x8 colfrag_pk_scaled(const LAS unsigned short* T, int col, int s, int hh, float sc) { u32x4 w;
#pragma unroll
    for (int j2 = 0; j2 < 4; ++j2) { const int j = 2 * j2, t = 16 * s + 8 * (j >> 2) + 4 * hh + (j & 3);
        w[j2] = pk_bf16(bfu(T[t * 64 + col]) * sc, bfu(T[(t + 1) * 64 + col]) * sc); }
    return __builtin_bit_cast(bf16x8, w); }
DI bf16x8 rowfrag_nat(const LAS unsigned short* A, int row, int s, int hh) { const LAS u32x2* p = (const LAS u32x2*)(A + row * 40 + 16 * s + 8 * hh); const u32x2 a = p[0], b = p[1];
    u32x4 w = {a.x, a.y, b.x, b.y}; return __builtin_bit_cast(bf16x8, w); }
DI bf16x8 rowfrag_pk(const LAS unsigned short* A, int row, int s, int hh) { const u32x2 a = *(const LAS u32x2*)(A + row * 40 + 16 * s + 4 * hh), b = *(const LAS u32x2*)(A + row * 40 + 16 * s + 8 + 4 * hh);
    u32x4 w = {a.x, a.y, b.x, b.y}; return __builtin_bit_cast(bf16x8, w); }
DI u32x4 pack_pu(const f32x16& x, int s) { u32x4 w; w.x = pk_bf16(x[8 * s], x[8 * s + 1]); w.y = pk_bf16(x[8 * s + 2], x[8 * s + 3]); w.z = pk_bf16(x[8 * s + 4], x[8 * s + 5]); w.w = pk_bf16(x[8 * s + 6], x[8 * s + 7]); return w; }

__device__ __forceinline__ void rwkv_k1_chunk(const Ctx& c, LAS unsigned char* wl, int seq, int ch) {
    const int dir = seq & 1, h = (seq >> 1) & 31, b = seq >> 6;
    const int lane = c.lane, r = lane & 31, hh = lane >> 5;
    LAS unsigned short* TA = (LAS unsigned short*)wl; LAS unsigned short* TB = TA + 2048; LAS unsigned short* TK = TB + 2048; LAS unsigned short* TR = TK + 2048; LAS unsigned short* TVv = TR + 2048;
    LAS float* GC = (LAS float*)(wl + 20480); LAS float* LAB = (LAS float*)(wl + 20736);
    LAS unsigned short* TTi = (LAS unsigned short*)(wl + 24832); LAS unsigned short* TAK = TTi + 1280; LAS unsigned short* TRB = TAK + 1280; LAS unsigned short* TRK = TRB + 1280;
    const h16* KK = (const h16*)(c.ar + AR_KK); const h16* RR = (const h16*)(c.ar + AR_R); const h16* VV = (const h16*)(c.ar + AR_V);
    const h16* OM = (const h16*)(c.ar + AR_OMW) + (size_t)dir * TT_ROWS2048; const h16* BBp = (const h16*)(c.ar + AR_BB) + (size_t)dir * TT_ROWS2048; const h16* KDp = (const h16*)(c.ar + AR_KD) + (size_t)dir * TT_ROWS2048;
    {   LAS unsigned short* TO = (LAS unsigned short*)LAB;
        u32x4 ld[6][4];
#pragma unroll
        for (int i = 0; i < 4; ++i) { const int tau = (lane >> 3) + 8 * i; const size_t off = (size_t)rw_row(b, dir, ch * 32 + tau) * 2048 + h * 64 + (lane & 7) * 8;
            ld[0][i] = *(const u32x4*)(KK + off); ld[1][i] = *(const u32x4*)(BBp + off); ld[2][i] = *(const u32x4*)(KDp + off);
            ld[3][i] = *(const u32x4*)(RR + off); ld[4][i] = *(const u32x4*)(VV + off); ld[5][i] = *(const u32x4*)(OM + off); }
#pragma unroll
        for (int i = 0; i < 4; ++i) { const int o = ((lane >> 3) + 8 * i) * 64 + (lane & 7) * 8;
            *(LAS u32x4*)(TA + o) = ld[0][i]; *(LAS u32x4*)(TB + o) = ld[1][i]; *(LAS u32x4*)(TK + o) = ld[2][i];
            *(LAS u32x4*)(TR + o) = ld[3][i]; *(LAS u32x4*)(TVv + o) = ld[4][i]; *(LAS u32x4*)(TO + o) = ld[5][i]; }
    }
    WAVE_SYNC();
    {   const LAS h16* TO = (const LAS h16*)LAB;
        float g = 1.f;
#pragma unroll 8
        for (int tau = 0; tau < 32; ++tau) { const int o = tau * 64 + lane;
            const float omw = (float)TO[o], bb = (float)((const LAS h16*)TB)[o], kd = (float)((const LAS h16*)TK)[o], kk = (float)((const LAS h16*)TA)[o], rr = (float)((const LAS h16*)TR)[o], vv = (float)((const LAS h16*)TVv)[o];
            const float gp = g; g *= (1.0f - omw); const float ig = __builtin_amdgcn_rcpf(g);
            TA[o] = f2bf(kk * gp); TB[o] = f2bf(-bb * ig); TK[o] = f2bf(kd * ig); TR[o] = f2bf(rr * g); TVv[o] = f2bf(vv);
        }
        GC[lane] = g;
    }
    WAVE_SYNC();
    {   f32x16 ab, ak, rb, rk;
#pragma unroll
        for (int i = 0; i < 16; ++i) { ab[i] = 0.f; ak[i] = 0.f; rb[i] = 0.f; rk[i] = 0.f; }
#pragma unroll
        for (int ks = 0; ks < 4; ++ks) { const int o = r * 64 + 16 * ks + 8 * hh;
            const bf16x8 fa = *(const LAS bf16x8*)(TA + o), fb = *(const LAS bf16x8*)(TB + o), fk = *(const LAS bf16x8*)(TK + o), fr = *(const LAS bf16x8*)(TR + o);
            ab = MFMA32(fa, fb, ab); ak = MFMA32(fa, fk, ak); rb = MFMA32(fr, fb, rb); rk = MFMA32(fr, fk, rk); }
#pragma unroll
        for (int i = 0; i < 16; ++i) { const int tau = (i & 3) + 8 * (i >> 2) + 4 * hh;
            LAB[tau * 32 + r] = (r < tau) ? ab[i] : 0.f;
            TAK[tau * 40 + r] = f2bf((r < tau) ? ak[i] : 0.f); TRB[tau * 40 + r] = f2bf((r <= tau) ? rb[i] : 0.f); TRK[tau * 40 + r] = f2bf((r <= tau) ? rk[i] : 0.f); }
    }
    WAVE_SYNC();
    {   float Tc[32];
#pragma unroll
        for (int tau = 0; tau < 32; ++tau) { float acc = (r == tau) ? 1.f : 0.f;
#pragma unroll
            for (int q = 0; q < (tau + 3) / 4; ++q) { const f32x4 a4 = *(const LAS f32x4*)(LAB + tau * 32 + 4 * q);
#pragma unroll
                for (int e = 0; e < 4; ++e) if (4 * q + e < tau) acc = fmaf(a4[e], Tc[4 * q + e], acc); }
            Tc[tau] = acc; }
        if (hh == 0) {
#pragma unroll
            for (int tau = 0; tau < 32; ++tau) TTi[tau * 40 + r] = f2bf(Tc[tau]); }
    }
    WAVE_SYNC();
    f32x16 W1[2], Z[2]; bf16x8 Vn[2][2];
    {   bf16x8 tn[2], tp[2], akn[2];
#pragma unroll
        for (int s = 0; s < 2; ++s) { tn[s] = rowfrag_nat(TTi, r, s, hh); tp[s] = rowfrag_pk(TTi, r, s, hh); akn[s] = rowfrag_nat(TAK, r, s, hh); }
#pragma unroll
        for (int t2 = 0; t2 < 2; ++t2) {
#pragma unroll
            for (int i = 0; i < 16; ++i) W1[t2][i] = 0.f;
            f32x16 X;
#pragma unroll
            for (int i = 0; i < 16; ++i) X[i] = 0.f;
#pragma unroll
            for (int s = 0; s < 2; ++s) { Vn[t2][s] = colfrag_nat(TVv, 32 * t2 + r, 16 * s + 8 * hh);
                W1[t2] = MFMA32(tn[s], colfrag_nat(TA, 32 * t2 + r, 16 * s + 8 * hh), W1[t2]);
                X = MFMA32(akn[s], Vn[t2][s], X); }
#pragma unroll
            for (int i = 0; i < 16; ++i) Z[t2][i] = 0.f;
#pragma unroll
            for (int s = 0; s < 2; ++s) Z[t2] = MFMA32(tp[s], pack_p(X, s), Z[t2]);
        }
    }
    u32x4* CHp = (u32x4*)(c.ar + AR_CH + ((size_t)seq * RW_NCH + ch) * CH_BYTES) + lane;
    {   bf16x8 rbp[2], rkn[2];
#pragma unroll
        for (int s = 0; s < 2; ++s) { rbp[s] = rowfrag_pk(TRB, r, s, hh); rkn[s] = rowfrag_nat(TRK, r, s, hh); }
#pragma unroll
        for (int kt = 0; kt < 2; ++kt) { f32x16 GT;
#pragma unroll
            for (int g4 = 0; g4 < 4; ++g4) { const u32x2 w = *(const LAS u32x2*)(TR + r * 64 + 32 * kt + 8 * g4 + 4 * hh);
                GT[4 * g4] = bflo(w.x); GT[4 * g4 + 1] = bfhi(w.x); GT[4 * g4 + 2] = bflo(w.y); GT[4 * g4 + 3] = bfhi(w.y); }
#pragma unroll
            for (int s = 0; s < 2; ++s) GT = MFMA32(pack_p(W1[kt], s), rbp[s], GT);
#pragma unroll
            for (int s = 0; s < 2; ++s) CHp[(0 + kt * 2 + s) * 64] = pack_pu(GT, s); }
#pragma unroll
        for (int vt = 0; vt < 2; ++vt) { f32x16 Y0;
#pragma unroll
            for (int i = 0; i < 16; ++i) Y0[i] = 0.f;
#pragma unroll
            for (int s = 0; s < 2; ++s) { Y0 = MFMA32(pack_p(Z[vt], s), rbp[s], Y0); Y0 = MFMA32(Vn[vt][s], rkn[s], Y0); }
#pragma unroll
            for (int s = 0; s < 2; ++s) CHp[(4 + vt * 2 + s) * 64] = pack_pu(Y0, s); }
    }
#pragma unroll
    for (int k2 = 0; k2 < 2; ++k2) {
        const float gc = GC[32 * k2 + r];
        bf16x8 bhp[2], khn[2];
#pragma unroll
        for (int s = 0; s < 2; ++s) { bhp[s] = colfrag_pk_scaled(TB, 32 * k2 + r, s, hh, gc); khn[s] = colfrag_nat_scaled(TK, 32 * k2 + r, 16 * s + 8 * hh, gc); }
#pragma unroll
        for (int kt = 0; kt < 2; ++kt) { f32x16 PT;
#pragma unroll
            for (int i = 0; i < 16; ++i) PT[i] = (kt == k2 && ((i & 3) + 8 * (i >> 2) + 4 * hh) == r) ? gc : 0.f;
#pragma unroll
            for (int s = 0; s < 2; ++s) PT = MFMA32(pack_p(W1[kt], s), bhp[s], PT);
#pragma unroll
            for (int s = 0; s < 2; ++s) CHp[(8 + k2 * 4 + kt * 2 + s) * 64] = pack_pu(PT, s); }
#pragma unroll
        for (int vt = 0; vt < 2; ++vt) { f32x16 PS;
#pragma unroll
            for (int i = 0; i < 16; ++i) PS[i] = 0.f;
#pragma unroll
            for (int s = 0; s < 2; ++s) { PS = MFMA32(bhp[s], pack_p(Z[vt], s), PS); PS = MFMA32(khn[s], Vn[vt][s], PS); }
#pragma unroll
            for (int s = 0; s < 2; ++s) CHp[(16 + k2 * 4 + vt * 2 + s) * 64] = pack_pu(PS, s); }
    }
    WAVE_SYNC();
}

DI void unpack_acc(const u32x4 lo, const u32x4 hi, f32x16& x) {
#pragma unroll
    for (int j = 0; j < 4; ++j) { x[2 * j] = bflo(lo[j]); x[2 * j + 1] = bfhi(lo[j]); x[8 + 2 * j] = bflo(hi[j]); x[8 + 2 * j + 1] = bfhi(hi[j]); }
}
__device__ __forceinline__ void rwkv_seq_wave(const Ctx& c, int seq, int vt) {
    const int dir = seq & 1, h = (seq >> 1) & 31, b = seq >> 6;
    const int lane = c.lane, r = lane & 31, hh = lane >> 5;
    bf16_t* Y = (bf16_t*)(c.ar + AR_Y) + (size_t)dir * TT_ROWS2048;
    f32x16 M[2];
#pragma unroll
    for (int kt = 0; kt < 2; ++kt)
#pragma unroll
        for (int i = 0; i < 16; ++i) M[kt][i] = 0.f;
    const u32x4* CH0 = (const u32x4*)(c.ar + AR_CH + (size_t)seq * RW_NCH * CH_BYTES) + lane;
    u32x4 gf[4], pf[8], y0[2], ps[4];
#define RW_LOAD(chp) do { _Pragma("unroll") for (int q = 0; q < 4; ++q) gf[q] = (chp)[q * 64]; _Pragma("unroll") for (int q = 0; q < 2; ++q) y0[q] = (chp)[(4 + vt * 2 + q) * 64]; \
        _Pragma("unroll") for (int q = 0; q < 8; ++q) pf[q] = (chp)[(8 + q) * 64]; _Pragma("unroll") for (int k2 = 0; k2 < 2; ++k2) _Pragma("unroll") for (int s = 0; s < 2; ++s) ps[k2 * 2 + s] = (chp)[(16 + k2 * 4 + vt * 2 + s) * 64]; } while (0)
    RW_LOAD(CH0);
    for (int ch = 0; ch < (int)RW_NCH; ++ch) {
        bf16x8 mp[4];
#pragma unroll
        for (int kt = 0; kt < 2; ++kt)
#pragma unroll
            for (int s = 0; s < 2; ++s) mp[kt * 2 + s] = pack_p(M[kt], s);
        f32x16 Yc, Mn[2];
        unpack_acc(y0[0], y0[1], Yc); unpack_acc(ps[0], ps[1], Mn[0]); unpack_acc(ps[2], ps[3], Mn[1]);
#pragma unroll
        for (int q = 0; q < 4; ++q) Yc = MFMA32(mp[q], __builtin_bit_cast(bf16x8, gf[q]), Yc);
#pragma unroll
        for (int k2 = 0; k2 < 2; ++k2)
#pragma unroll
            for (int q = 0; q < 4; ++q) Mn[k2] = MFMA32(__builtin_bit_cast(bf16x8, pf[k2 * 4 + q]), mp[q], Mn[k2]);
        if (ch + 1 < (int)RW_NCH) { const u32x4* nx = CH0 + (size_t)(ch + 1) * (CH_BYTES / 16); RW_LOAD(nx); }
        M[0] = Mn[0]; M[1] = Mn[1];
        {   bf16_t* yp = Y + (size_t)rw_row(b, dir, ch * 32 + r) * 2048 + h * 64 + 32 * vt + 4 * hh;
#pragma unroll
            for (int g = 0; g < 4; ++g) { u32x2 w2; w2.x = pk_bf16(Yc[4 * g], Yc[4 * g + 1]); w2.y = pk_bf16(Yc[4 * g + 2], Yc[4 * g + 3]); *(u32x2*)(yp + 8 * g) = w2; } }
    }
#undef RW_LOAD
}

__device__ __forceinline__ void p_rwkv_k1_and_conv(const Ctx& c) {
    if (c.wave < 4) { LAS unsigned char* wl = c.lds + c.wave * K1_WAVE_LDS; const int w = blockIdx.x * 4 + c.wave, nw = gridDim.x * 4;
        for (int task = w; task < 256 * (int)RW_NCH; task += nw) rwkv_k1_chunk(c, wl, task / (int)RW_NCH, task % (int)RW_NCH); }
    else p_convert_deferred(c, blockIdx.x * 4 + (c.wave - 4), gridDim.x * 4, 0, CONV_SPLIT);
}
__device__ __forceinline__ void p_rwkv_seq_and_conv(const Ctx& c) {
    constexpr int NTASK = 512;
    const int G = (int)gridDim.x, task = c.wave * G + (int)blockIdx.x;
    if (task < NTASK) { for (int t = task; t < NTASK; t += G * 8) rwkv_seq_wave(c, t & 255, t >> 8); return; }
    int widx = 0, nworkers = 0;
    for (int w = 0; w < 8; ++w) { const int nsc = NTASK - w * G; const int sb = nsc <= 0 ? 0 : (nsc > G ? G : nsc);
        if (w < c.wave) widx += G - sb; else if (w == c.wave) widx += (int)blockIdx.x - sb;
        nworkers += G - sb; }
    p_convert_deferred(c, widx, nworkers, CONV_SPLIT, 1 << 30);
}

constexpr int DA_KBYTES = 64 * 256, DA_VBYTES = 128 * 128, DA_BUF = DA_KBYTES + DA_VBYTES;
constexpr int DA_COMB = 2 * DA_BUF;
__device__ __forceinline__ void dattn_block_item(const Ctx& c, int item) {
    const bf16_t* PB = (const bf16_t*)(c.ar + AR_PB); const bf16_t* VT = (const bf16_t*)(c.ar + AR_VT); bf16_t* MIX = (bf16_t*)(c.ws + WS_XN);
    const int lane = c.lane, r = lane & 31, hh = lane >> 5, w = c.wave, mp = w >> 2, qg = w & 3;
    int b, h, qrow0, t0, nt;
    if (item < NB * 16 * 32) { b = item >> 9; h = (item >> 5) & 15; qrow0 = b * SEQ + (item & 31) * 128; t0 = 0; nt = NKEY / 64; }
    else { const int i2 = item - NB * 16 * 32; b = i2 >> 5; h = (i2 >> 1) & 15; qrow0 = TL + b * CTXL + (i2 & 1) * 128; t0 = SEQ / 64; nt = CTXL / 64; }
    const bf16_t* VTh = VT + ((size_t)b * 16 + h) * 128 * NKEY;
    int krow_l[2], kchunk_l[2], vrow_l[2], vchunk_l[2];
#pragma unroll
    for (int i = 0; i < 2; ++i) { const int pk = 2 * w + i; krow_l[i] = 4 * pk + (lane >> 4); kchunk_l[i] = (lane & 15) ^ (krow_l[i] & 15);
        vrow_l[i] = 8 * pk + (lane >> 3); vchunk_l[i] = (lane & 7) ^ ((vrow_l[i] >> 1) & 7); }
#define DA_LOAD(t, buf) do { const int kx0 = (t0 + (t)) * 64; const int krow0 = kx0 < SEQ ? b * SEQ + kx0 : TL + b * CTXL + (kx0 - SEQ); \
        _Pragma("unroll") for (int i = 0; i < 2; ++i) { \
            __builtin_amdgcn_global_load_lds((const unsigned*)(PB + (size_t)(krow0 + krow_l[i]) * COLS_B + 2048 + h * 128 + kchunk_l[i] * 8), (LAS unsigned*)(c.lds + (buf) * DA_BUF + (2 * w + i) * 1024), 16, 0, 0); \
            __builtin_amdgcn_global_load_lds((const unsigned*)(VTh + (size_t)vrow_l[i] * NKEY + kx0 + vchunk_l[i] * 8), (LAS unsigned*)(c.lds + (buf) * DA_BUF + DA_KBYTES + (2 * w + i) * 1024), 16, 0, 0); } } while (0)
    bf16x8 q[4];
    { const bf16_t* qp = PB + (size_t)(qrow0 + 32 * qg + r) * COLS_B + h * 128 + mp * 64 + hh * 8;
#pragma unroll
      for (int ks = 0; ks < 4; ++ks) q[ks] = ld_frag(qp + ks * 16); }
    f32x16 O[4];
#pragma unroll
    for (int d = 0; d < 4; ++d)
#pragma unroll
        for (int i = 0; i < 16; ++i) O[d][i] = 0.f;
    float m = 0.f, l = 0.f;
    DA_LOAD(0, 0);
    __syncthreads();
    for (int t = 0; t < nt; ++t) {
        const int cur = t & 1;
        if (t + 1 < nt) DA_LOAD(t + 1, cur ^ 1);
        const LAS unsigned short* Kl = (const LAS unsigned short*)(c.lds + cur * DA_BUF); const LAS unsigned short* Vl = (const LAS unsigned short*)(c.lds + cur * DA_BUF + DA_KBYTES);
        f32x16 st[2];
        const float negm = -m;
#pragma unroll
        for (int sub = 0; sub < 2; ++sub) {
#pragma unroll
            for (int i = 0; i < 16; ++i) st[sub][i] = negm;
#pragma unroll
            for (int ks = 0; ks < 4; ++ks) st[sub] = MFMA32(*(const LAS bf16x8*)((const LAS unsigned char*)Kl + (32 * sub + r) * 256 + (((mp * 8 + ks * 2 + hh) ^ (r & 15)) << 4)), q[ks], st[sub]); }
        float mx = fmaxf(st[0][0], st[1][0]);
#pragma unroll
        for (int i = 1; i < 16; ++i) mx = fmaxf(mx, fmaxf(st[0][i], st[1][i]));
        mx = fmaxf(mx, __shfl_xor(mx, 32));
        if (!__all(mx <= 8.0f && mx >= -24.0f)) {
            const float alpha = __builtin_amdgcn_exp2f(-mx);
            m += mx; l *= alpha;
#pragma unroll
            for (int sub = 0; sub < 2; ++sub)
#pragma unroll
                for (int i = 0; i < 16; ++i) st[sub][i] -= mx;
#pragma unroll
            for (int d = 0; d < 4; ++d)
#pragma unroll
                for (int i = 0; i < 16; ++i) O[d][i] *= alpha;
        }
        float ps = 0.f;
#pragma unroll
        for (int sub = 0; sub < 2; ++sub)
#pragma unroll
            for (int i = 0; i < 16; ++i) { st[sub][i] = __builtin_amdgcn_exp2f(st[sub][i]); ps += st[sub][i]; }
        l += ps;
        bf16x8 P[4];
#pragma unroll
        for (int sub = 0; sub < 2; ++sub) { P[2 * sub] = pack_p(st[sub], 0); P[2 * sub + 1] = pack_p(st[sub], 1); }
#pragma unroll
        for (int d = 0; d < 4; ++d)
#pragma unroll
            for (int kk = 0; kk < 4; ++kk) O[d] = MFMA32(*(const LAS bf16x8*)((const LAS unsigned char*)Vl + (32 * d + r) * 128 + (((2 * kk + hh) ^ ((r >> 1) & 7)) << 4)), P[kk], O[d]);
        __syncthreads();
    }
#undef DA_LOAD
    LAS float* CB = (LAS float*)(c.lds + DA_COMB) + qg * 4096;
    l += __shfl_xor(l, 32);
    if (mp == 1) { const float sc = ((const float*)(c.ws + WS_SCAL))[0] / l;
#pragma unroll
        for (int d = 0; d < 4; ++d)
#pragma unroll
            for (int i = 0; i < 16; ++i) CB[(32 * d + (i & 3) + 8 * (i >> 2) + 4 * hh) * 32 + r] = O[d][i] * sc; }
    __syncthreads();
    if (mp == 0) { const float i0 = 1.0f / l; float ss = 0.f;
#pragma unroll
        for (int d = 0; d < 4; ++d)
#pragma unroll
            for (int i = 0; i < 16; ++i) { const float y = O[d][i] * i0 - CB[(32 * d + (i & 3) + 8 * (i >> 2) + 4 * hh) * 32 + r]; O[d][i] = y; ss += y * y; }
        ss += __shfl_xor(ss, 32);
        const float rs = rsqrtf(ss * (1.0f / 128.0f) + 1e-5f) * 0.8f;
        const float* subln = c.in[I_SUBLN];
        bf16_t* orow = MIX + (size_t)(qrow0 + 32 * qg + r) * D + 2048 + h * 128;
#pragma unroll
        for (int d = 0; d < 4; ++d)
#pragma unroll
            for (int g = 0; g < 4; ++g) { const int dv = 32 * d + 8 * g + 4 * hh; const f32x4 sl = *(const f32x4*)(subln + dv);
                u32x2 wv; wv.x = pk_bf16(O[d][4 * g] * rs * sl[0], O[d][4 * g + 1] * rs * sl[1]); wv.y = pk_bf16(O[d][4 * g + 2] * rs * sl[2], O[d][4 * g + 3] * rs * sl[3]);
                *(u32x2*)(orow + dv) = wv; } }
    __syncthreads();
}
__device__ __forceinline__ void p_dattn_block(const Ctx& c, bool need_ctx) {
    const int nitems = NB * 16 * 32 + (need_ctx ? NB * 16 * 2 : 0);
    const bool remap = gridDim.x == 256;
    for (int item = blockIdx.x; item < nitems; item += gridDim.x) {
        int it = item;
        if (remap && item < NB * 16 * 32) { const int k = item >> 8, x = item & 7, sl = (item & 255) >> 3; it = (((k << 3) + x) << 5) | sl; }
        dattn_block_item(c, it);
    }
}

constexpr int P1_CQ = 0, P1_CK = 2048, P1_CV = 2304, P1_DQ = 2560, P1_DK = 3584, P1_DV = 4608, P1_DG = 6656;

constexpr int SW_KLD = 72, SW_VLD = 40;
constexpr int SW_KBYTES = 32 * SW_KLD * 2, SW_VBYTES = 64 * SW_VLD * 2, SW_BUF = SW_KBYTES + SW_VBYTES;
__device__ __forceinline__ void swa_block_item(const Ctx& c, int item) {
    const bf16_t* P1 = (const bf16_t*)(c.ar + AR_P1); const bf16_t* VTC = (const bf16_t*)(c.ar + AR_VTC); bf16_t* MIX = (bf16_t*)(c.ws + WS_XN);
    const int tid = c.tid, lane = c.lane, r = lane & 31, hh = lane >> 5;
    const int b = item >> 9, g = (item >> 7) & 3, q0 = (item & 127) * 32, hq = g * 8 + c.wave;
    const int qpos = q0 + r;
    bf16x8 q[4]; { const bf16_t* qp = P1 + (size_t)(b * SEQ + qpos) * NO + P1_CQ + hq * 64 + hh * 8;
#pragma unroll
        for (int ks = 0; ks < 4; ++ks) q[ks] = ld_frag(qp + ks * 16); }
    const bf16_t* VTh = VTC + ((size_t)b * 4 + g) * 64 * NKEY;
    f32x16 O[2];
#pragma unroll
    for (int d = 0; d < 2; ++d)
#pragma unroll
        for (int i = 0; i < 16; ++i) O[d][i] = 0.f;
    float m = 0.f, l = 0.f;
    const int wt0 = (q0 - 128 < 0 ? 0 : q0 - 128) / 32, wt1 = (q0 + 160 > SEQ ? SEQ : q0 + 160) / 32;
    const int nwt = wt1 - wt0, ntl = nwt + 8;
    u32x4 sreg;
    const bool kside = tid < 256; const int t2 = tid & 255;
#define SWB_LOAD(ti) do { const bool win_ = (ti) < nwt; const int kx_ = (win_ ? wt0 + (ti) : (SEQ / 32) + ((ti) - nwt)) * 32; \
        sreg = kside ? *(const u32x4*)(P1 + (size_t)((win_ ? b * SEQ + kx_ : TL + b * CTXL + (kx_ - SEQ)) + (t2 >> 3)) * NO + P1_CK + g * 64 + (t2 & 7) * 8) \
                     : *(const u32x4*)(VTh + (size_t)(t2 >> 2) * NKEY + kx_ + (t2 & 3) * 8); } while (0)
#define SWB_STORE(buf) do { LAS unsigned short* base_ = (LAS unsigned short*)(c.lds + (buf) * SW_BUF); \
        if (kside) *(LAS u32x4*)(base_ + (t2 >> 3) * SW_KLD + (t2 & 7) * 8) = sreg; else *(LAS u32x4*)(base_ + SW_KBYTES / 2 + (t2 >> 2) * SW_VLD + (t2 & 3) * 8) = sreg; } while (0)
    SWB_LOAD(0); SWB_STORE(0);
    __syncthreads();
    for (int ti = 0; ti < ntl; ++ti) {
        const bool win = ti < nwt; const int kx0 = (win ? wt0 + ti : (SEQ / 32) + (ti - nwt)) * 32;
        if (ti + 1 < ntl) SWB_LOAD(ti + 1);
        const LAS unsigned short* Kl = (const LAS unsigned short*)(c.lds + (ti & 1) * SW_BUF); const LAS unsigned short* Vl = Kl + SW_KBYTES / 2;
        f32x16 st;
        const float negm = -m;
#pragma unroll
        for (int i = 0; i < 16; ++i) st[i] = negm;
#pragma unroll
        for (int ks = 0; ks < 4; ++ks) st = MFMA32(*(const LAS bf16x8*)(Kl + r * SW_KLD + ks * 16 + hh * 8), q[ks], st);
        if (win && (kx0 == q0 - 128 || kx0 == q0 + 128)) {
#pragma unroll
            for (int i = 0; i < 16; ++i) { const int kpos = kx0 + (i & 3) + 8 * (i >> 2) + 4 * hh; const int dl = kpos - qpos; if (dl > 128 || dl < -128) st[i] = -1e30f; }
        }
        float mx = st[0];
#pragma unroll
        for (int i = 1; i < 16; ++i) mx = fmaxf(mx, st[i]);
        mx = fmaxf(mx, __shfl_xor(mx, 32));
        if (!__all(mx <= 8.0f && mx >= -24.0f)) {
            const float alpha = __builtin_amdgcn_exp2f(-mx);
            m += mx; l *= alpha;
#pragma unroll
            for (int i = 0; i < 16; ++i) st[i] -= mx;
#pragma unroll
            for (int d = 0; d < 2; ++d)
#pragma unroll
                for (int i = 0; i < 16; ++i) O[d][i] *= alpha;
        }
        float ps = 0.f;
#pragma unroll
        for (int i = 0; i < 16; ++i) { st[i] = __builtin_amdgcn_exp2f(st[i]); ps += st[i]; }
        l += ps;
        const bf16x8 p0 = pack_p(st, 0), p1 = pack_p(st, 1);
#pragma unroll
        for (int d = 0; d < 2; ++d) { O[d] = MFMA32(*(const LAS bf16x8*)(Vl + (32 * d + r) * SW_VLD + 8 * hh), p0, O[d]); O[d] = MFMA32(*(const LAS bf16x8*)(Vl + (32 * d + r) * SW_VLD + 16 + 8 * hh), p1, O[d]); }
        if (ti + 1 < ntl) SWB_STORE((ti + 1) & 1);
        __syncthreads();
    }
#undef SWB_LOAD
#undef SWB_STORE
    l += __shfl_xor(l, 32);
    l += __builtin_amdgcn_exp2f(c.in[I_SINK][hq] * LOG2E - m);
    const float il = 1.0f / l;
    bf16_t* orow = MIX + (size_t)(b * SEQ + qpos) * D + hq * 64;
#pragma unroll
    for (int d = 0; d < 2; ++d)
#pragma unroll
        for (int gq = 0; gq < 4; ++gq) { const int dv = 32 * d + 8 * gq + 4 * hh;
            u32x2 w; w.x = pk_bf16(O[d][4 * gq] * il, O[d][4 * gq + 1] * il); w.y = pk_bf16(O[d][4 * gq + 2] * il, O[d][4 * gq + 3] * il);
            *(u32x2*)(orow + dv) = w; }
}

DI float ret_lg(const Ctx& c, int dir, int h) { return log1pf(-exp2f(-c.in[I_RDEC][dir * 8 + h])); }
DI int ret_row0(int b, int cidx) { return cidx < 2 ? TL + b * CTXL + cidx * 128 : b * SEQ + (cidx - 2) * 128; }
constexpr int TK_LD = 136, TV_LD = 264;
constexpr int RT_LD = 136;
DI void stage_chunk_T(const Ctx& c, const bf16_t* src, int ld_src, int ncols, LAS unsigned short* T) {
    const int tid = c.tid, row = tid >> 2, part = tid & 3, cpt = ncols / 4;
    const bf16_t* p = src + (size_t)row * ld_src + part * cpt;
    for (int e = 0; e < cpt / 8; ++e) { const u32x4 w = *(const u32x4*)(p + e * 8);
#pragma unroll
        for (int j = 0; j < 4; ++j) { T[(part * cpt + e * 8 + 2 * j) * RT_LD + row] = (unsigned short)(w[j] & 0xffffu); T[(part * cpt + e * 8 + 2 * j + 1) * RT_LD + row] = (unsigned short)(w[j] >> 16); } }
}
__device__ __forceinline__ void p_ret_local(const Ctx& c) {
    const bf16_t* P1 = (const bf16_t*)(c.ar + AR_P1); float* RU = (float*)(c.ar + AR_RU);
    LAS unsigned short* TK = (LAS unsigned short*)c.lds; LAS unsigned short* TV = TK + 128 * RT_LD;
    const int lane = c.lane, r = lane & 31, hh = lane >> 5, w = c.wave;
    for (int item = blockIdx.x; item < NB * 8 * 34; item += gridDim.x) {
        const int cidx = item % 34, h = (item / 34) & 7, b = item / (34 * 8);
        const int row0 = ret_row0(b, cidx);
        stage_chunk_T(c, P1 + (size_t)row0 * NO + P1_DK + h * 128, NO, 128, TK);
        stage_chunk_T(c, P1 + (size_t)row0 * NO + P1_DV + h * 256, NO, 256, TV);
        __syncthreads();
        for (int dir = 0; dir < 2; ++dir) {
            const float lg = ret_lg(c, dir, h);
            f32x16 af[4];
#pragma unroll
            for (int dt = 0; dt < 4; ++dt)
#pragma unroll
                for (int i = 0; i < 16; ++i) af[dt][i] = 0.f;
#pragma unroll 1
            for (int ks = 0; ks < 8; ++ks) {
                const int i0 = ks * 16 + hh * 8;
                float vf[8]; unpack8(*(const LAS u32x4*)(TV + (32 * w + r) * RT_LD + i0), vf);
#pragma unroll
                for (int j = 0; j < 8; ++j) vf[j] *= __expf(lg * (float)(dir ? (i0 + j) : (127 - (i0 + j))));
                const bf16x8 fa = __builtin_bit_cast(bf16x8, pack8_bf16(vf));
#pragma unroll
                for (int dt = 0; dt < 4; ++dt) af[dt] = MFMA32(*(const LAS bf16x8*)(TK + (32 * dt + r) * RT_LD + i0), fa, af[dt]);
            }
            float* U = RU + ((((size_t)b * 8 + h) * 2 + dir) * 34 + cidx) * 32768;
#pragma unroll
            for (int dt = 0; dt < 4; ++dt)
#pragma unroll
                for (int g = 0; g < 4; ++g) { f32x4 v4 = {af[dt][4 * g], af[dt][4 * g + 1], af[dt][4 * g + 2], af[dt][4 * g + 3]}; *(f32x4*)(U + (32 * w + r) * 128 + 32 * dt + 8 * g + 4 * hh) = v4; }
        }
        __syncthreads();
    }
}
__device__ __forceinline__ void p_ret_prefix(const Ctx& c) {
    const float* RU = (const float*)(c.ar + AR_RU); bf16_t* RS = (bf16_t*)(c.ar + AR_RS);
    const size_t gtid = (size_t)blockIdx.x * NTHREADS + c.tid, gn = (size_t)gridDim.x * NTHREADS;
    for (size_t idx = gtid; idx < (size_t)NB * 8 * 2 * 32768; idx += gn) {
        const int el = (int)(idx & 32767), bhd = (int)(idx >> 15), dir = bhd & 1, h = (bhd >> 1) & 7;
        const float cd = __expf(ret_lg(c, dir, h) * 128.0f);
        const float* U = RU + (size_t)bhd * 34 * 32768 + el; bf16_t* S = RS + (size_t)bhd * 32 * 32768 + el;
        float u[34];
#pragma unroll
        for (int ci = 0; ci < 34; ++ci) u[ci] = __builtin_nontemporal_load(U + (size_t)ci * 32768);
        float s = 0.f;
        if (dir == 0) {
#pragma unroll
            for (int ci = 0; ci < 34; ++ci) { if (ci >= 2) S[(size_t)(ci - 2) * 32768] = f2bf(s); s = s * cd + u[ci]; } }
        else { s = s * cd + u[1]; s = s * cd + u[0];
#pragma unroll
            for (int ci = 33; ci >= 2; --ci) { S[(size_t)(ci - 2) * 32768] = f2bf(s); s = s * cd + u[ci]; } }
    }
}
__device__ __forceinline__ void p_ret_out(const Ctx& c) {
    const bf16_t* P1 = (const bf16_t*)(c.ar + AR_P1); const bf16_t* RS = (const bf16_t*)(c.ar + AR_RS); bf16_t* MIX = (bf16_t*)(c.ws + WS_XN);
    LAS unsigned short* TV = (LAS unsigned short*)c.lds;
    LAS float* XS = (LAS float*)(c.lds + 256 * RT_LD * 2);
    const int lane = c.lane, r = lane & 31, hh = lane >> 5, w = c.wave, qt = w & 3, eh = w >> 2;
    for (int item = blockIdx.x; item < NB * 8 * 32; item += gridDim.x) {
        const int lc = item & 31, h = (item >> 5) & 7, b = item >> 8;
        const int row0 = b * SEQ + lc * 128;
        stage_chunk_T(c, P1 + (size_t)row0 * NO + P1_DV + h * 256, NO, 256, TV);
        __syncthreads();
        const float lgf = ret_lg(c, 0, h), lgb = ret_lg(c, 1, h);
        const int qi = qt * 32 + r;
        const bf16_t* qp = P1 + (size_t)(row0 + qi) * NO + P1_DQ + h * 128 + hh * 8;
        f32x16 Y[4];
#pragma unroll
        for (int et = 0; et < 4; ++et)
#pragma unroll
            for (int i = 0; i < 16; ++i) Y[et][i] = 0.f;
        {
            const float qdf = __expf(lgf * (float)(qi + 1)), qdb = __expf(lgb * (float)(128 - qi));
            const bf16_t* Sf = RS + ((((size_t)b * 8 + h) * 2 + 0) * 32 + lc) * 32768; const bf16_t* Sb = RS + ((((size_t)b * 8 + h) * 2 + 1) * 32 + lc) * 32768;
#pragma unroll 1
            for (int ks = 0; ks < 8; ++ks) {
                float x[8], xf[8], xb[8]; unpack8(*(const u32x4*)(qp + ks * 16), x);
#pragma unroll
                for (int j = 0; j < 8; ++j) { xf[j] = x[j] * qdf; xb[j] = x[j] * qdb; }
                const bf16x8 qf = __builtin_bit_cast(bf16x8, pack8_bf16(xf)), qb = __builtin_bit_cast(bf16x8, pack8_bf16(xb));
#pragma unroll
                for (int et = 0; et < 4; ++et) { const int e = eh * 128 + et * 32 + r;
                    Y[et] = MFMA32(ld_frag(Sf + (size_t)e * 128 + ks * 16 + hh * 8), qf, Y[et]);
                    Y[et] = MFMA32(ld_frag(Sb + (size_t)e * 128 + ks * 16 + hh * 8), qb, Y[et]); }
            }
        }
#pragma unroll 1
        for (int kt = 0; kt < 4; ++kt) {
            f32x16 st;
#pragma unroll
            for (int i = 0; i < 16; ++i) st[i] = 0.f;
            const bf16_t* kp = P1 + (size_t)(row0 + kt * 32 + r) * NO + P1_DK + h * 128 + hh * 8;
#pragma unroll
            for (int ks = 0; ks < 8; ++ks) st = MFMA32(ld_frag(kp + ks * 16), ld_frag(qp + ks * 16), st);
#pragma unroll
            for (int i = 0; i < 16; ++i) { const int ki = kt * 32 + (i & 3) + 8 * (i >> 2) + 4 * hh; const int dl = qi - ki;
                const float f = dl > 0 ? __expf(lgf * (float)dl) : (dl < 0 ? __expf(lgb * (float)(-dl)) : 2.0f); st[i] *= f; }
            const bf16x8 p0 = pack_p(st, 0), p1 = pack_p(st, 1);
#pragma unroll
            for (int et = 0; et < 4; ++et) { const int e = eh * 128 + et * 32 + r;
#pragma unroll
                for (int s = 0; s < 2; ++s) { const u32x2 lo = *(const LAS u32x2*)(TV + e * RT_LD + kt * 32 + 16 * s + 4 * hh), hi = *(const LAS u32x2*)(TV + e * RT_LD + kt * 32 + 16 * s + 8 + 4 * hh);
                    u32x4 vw = {lo.x, lo.y, hi.x, hi.y};
                    Y[et] = MFMA32(__builtin_bit_cast(bf16x8, vw), s == 0 ? p0 : p1, Y[et]); } }
        }
        float ss = 0.f;
#pragma unroll
        for (int et = 0; et < 4; ++et)
#pragma unroll
            for (int i = 0; i < 16; ++i) ss += Y[et][i] * Y[et][i];
        ss += __shfl_xor(ss, 32);
        if (hh == 0) XS[(eh * 4 + qt) * 32 + r] = ss;
        __syncthreads();
        const float tot = XS[(0 * 4 + qt) * 32 + r] + XS[(1 * 4 + qt) * 32 + r];
        const float rs = rsqrtf(tot * (1.0f / 256.0f) + 1e-6f);
        const bf16_t* gp = P1 + (size_t)(row0 + qi) * NO + P1_DG + h * 256; bf16_t* op = MIX + (size_t)(row0 + qi) * D + 2048 + h * 256;
#pragma unroll
        for (int et = 0; et < 4; ++et)
#pragma unroll
            for (int gq = 0; gq < 4; ++gq) { const int e = eh * 128 + et * 32 + 8 * gq + 4 * hh;
                const u32x2 gw = *(const u32x2*)(gp + e);
                const float g0 = bflo(gw.x), g1 = bfhi(gw.x), g2 = bflo(gw.y), g3 = bfhi(gw.y);
                u32x2 o; o.x = pk_bf16(Y[et][4 * gq] * rs * silu_f(g0), Y[et][4 * gq + 1] * rs * silu_f(g1)); o.y = pk_bf16(Y[et][4 * gq + 2] * rs * silu_f(g2), Y[et][4 * gq + 3] * rs * silu_f(g3));
                *(u32x2*)(op + e) = o; }
        __syncthreads();
    }
}

#define MK_PER_PHASE 0
#ifndef MK_PER_PHASE
#define MK_PER_PHASE 0
#endif
constexpr int N_PHASES = 25;
constexpr int LDS_STAGE = 4 * K1_WAVE_LDS;
constexpr int LDS_BYTES = LDS_STAGE + 256;

__global__ void __launch_bounds__(NTHREADS, 2) mk_fwd(Args a) {
    extern __shared__ __attribute__((aligned(16))) unsigned char smem[];
    Ctx c;
#pragma unroll
    for (int i = 0; i < 29; ++i) c.in[i] = a.in[i];
    c.out = a.out; c.ws = a.ws; c.ar = a.ws + WS_ARENA; c.lds = (LAS unsigned char*)smem;
    c.tid = threadIdx.x; c.lane = c.tid & 63; c.wave = __builtin_amdgcn_readfirstlane(c.tid >> 6);
    volatile LAS unsigned* xbw = (volatile LAS unsigned*)(c.lds + LDS_STAGE);
    if (c.tid < 4) xbw[c.tid] = 0u;
    __syncthreads();
    XcdBarrier bar; bar.bar = (unsigned*)(a.ws + WS_CTL); bar.x = 0; bar.st = xbw;
    if (!MK_PER_PHASE) bar = xcd_barrier_post((unsigned*)(a.ws + WS_CTL), xbw);
    const int lo = a.ph_lo, hi = a.ph_hi;
#ifndef PH_MASK
#define PH_MASK 0x1ffffffu
#endif
#define IN(k) (((PH_MASK >> (k)) & 1u) && lo <= (k) && (k) < hi)
#define SEAM(k) do { if (IN(k) && IN((k) + 1)) { xcd_barrier(bar); } } while (0)
    float* H = (float*)(c.ws + WS_H); const float* MOD = (const float*)(c.ws + WS_MOD);
    const bf16_t* XN = (const bf16_t*)(c.ws + WS_XN); unsigned char* W = c.ws + WS_W;
    LAS unsigned char* gl = c.lds; float* SLAB = (float*)(c.ar + AR_SLAB); unsigned char* W1 = c.ws + WS_W1;

    if (IN(0)) { p_mod(c); p_weights_layer0(c); p_wcolmax(c); }
    SEAM(0);
    if (IN(1)) { p_mod_finalize(c); p_norm_mod<4>(c, c.in[I_X], c.in[I_CTX], TT, (const float*)(c.ar + AR_MODP), 0, 1); }
    SEAM(1);
    if (IN(2)) { pg8::Gemm g{XN, (const bf16_t*)(W + W_IN), TT, NE, D}; LatThenCtxOrder S; S.init2(NE, gridDim.x, blockIdx.x, D);
        EpiInEven E{(bf16_t*)(c.ar + AR_PA), (bf16_t*)(c.ar + AR_PB), (const float*)(c.ws + WS_AXC), (const float*)(c.ws + WS_AXS)};
        pg8::gemm_phase(gl, g, S, E); }
    SEAM(2);
    if (IN(3)) { p_rwkv_prepA(c); p_build_vt<128, 16>(c, (const bf16_t*)(c.ar + AR_PB), COLS_B, 4096, (bf16_t*)(c.ar + AR_VT)); }
    SEAM(3);
    if (IN(4)) { pg8::Gemm g{(const bf16_t*)(c.ar + AR_LA), (const bf16_t*)(W + W_LORA), TT, LORA_N, LORA_K}; LoraOrder S; S.init2(LORA_N, gridDim.x, blockIdx.x, LORA_KU);
        EpiLora E{c.in[I_W0], c.in[I_A0], c.in[I_KA], (const bf16_t*)(c.ar + AR_K), (const h16*)(c.ar + AR_KK), (h16*)(c.ar + AR_OMW), (h16*)(c.ar + AR_BB), (h16*)(c.ar + AR_KD), (bf16_t*)(c.ar + AR_G)};
        pg8::gemm_phase(gl, g, S, E); }
    SEAM(4);
    if (IN(5)) {
#ifndef NO_DATTN
        p_dattn_block(c, true); __syncthreads();
#endif
#ifndef NO_K1
        p_rwkv_k1_and_conv(c);
#endif
    }
    SEAM(5);
    if (IN(6)) p_rwkv_seq_and_conv(c);
    SEAM(6);
    if (IN(7)) p_rwkv_out(c, TT);
    SEAM(7);
    if (IN(8)) { constexpr int KE = MIX_I8 ? D / 2 : D; const float* SAq = (const float*)(c.ar + AR_XQS);
        pg8::Gemm g{MIX_I8 ? (const bf16_t*)(c.ar + AR_XQ) : XN, (const bf16_t*)(W + W_MIX), TT, D, KE}; pg8::StaticOrder S; S.init(TL, D, gridDim.x, blockIdx.x, KE);
        EpiResModT<MIX_I8 != 0> E{c.in[I_X], c.in[I_CTX], H, MOD + 2 * 4096, SAq, i8_cs(c, CM_MIX)};
        pg8::gemm_phase(gl, g, S, E);
        CtxSplitOrder S2; S2.init(D, gridDim.x, blockIdx.x, KE); EpiSlabT<MIX_I8 != 0> E2{SLAB, SAq, i8_cs(c, CM_MIX)};
        pg8::gemm_phase(gl, g, S2, E2); }
    SEAM(8);
    if (IN(9)) { p_ctx_fix(c, c.in[I_CTX], MOD + 4 * 24576 + 2 * 4096, SLAB, H); p_norm_mod<1, FFN_I8 != 0>(c, H, H + (size_t)TL * D, TT, MOD, 3, 4); }
    SEAM(9);
    if (IN(10)) { constexpr int KE = FFN_I8 ? D / 2 : D;
        pg8::Gemm g{XN, (const bf16_t*)(W + W_FFI), TT, 2 * DFF, KE}; LatThenCtxOrder S; S.init2(2 * DFF, gridDim.x, blockIdx.x, KE);
        EpiConvGlu E{(bf16_t*)(c.ar + AR_HID), (bf16_t*)(c.ar + AR_SG), (bf16_t*)(c.ar + AR_SU), c.in[I_CONVW], c.in[I_CONVB], (const float*)(c.ws + WS_XN + (size_t)TT * D), i8_cs(c, CM_FFI)};
        pg8::gemm_phase(gl, g, S, E); }
    SEAM(10);
    if (IN(11)) p_conv_fix(c, 0, TT);
    SEAM(11);
    if (IN(12)) { pg8::Gemm g{(const bf16_t*)(c.ar + AR_HID), (const bf16_t*)(W + W_FFO), TT, D, DFF}; pg8::StaticOrder S; S.init(TL, D, gridDim.x, blockIdx.x, DFF);
        EpiResMod E{H, H + (size_t)TL * D, H, MOD + 5 * 4096};
        pg8::gemm_phase(gl, g, S, E);
        CtxSplitOrder S2; S2.init(D, gridDim.x, blockIdx.x, DFF); EpiSlab E2{SLAB};
        pg8::gemm_phase(gl, g, S2, E2); }
    SEAM(12);
    const float* MOD1 = MOD + 5 * 24576;
    if (IN(13)) { p_ctx_fix(c, H + (size_t)TL * D, MOD + 4 * 24576 + 5 * 4096, SLAB, H); p_norm_mod<1, INO_I8 != 0>(c, H, H + (size_t)TL * D, TT, MOD1, 0, 1); }
    SEAM(13);
    if (IN(14)) { constexpr int KE = INO_I8 ? D / 2 : D;
        pg8::Gemm g{XN, (const bf16_t*)(W + W_IN), TT, NO, KE}; OddInOrder S; S.init2(gridDim.x, blockIdx.x, KE);
        EpiInOdd E{(bf16_t*)(c.ar + AR_P1), (const float*)(c.ws + WS_AXC), (const float*)(c.ws + WS_AXS), (const float*)(c.ws + WS_RTC), (const float*)(c.ws + WS_RTS), (const float*)(c.ws + WS_XN + (size_t)TT * D), i8_cs(c, CM_INO)};
        pg8::gemm_phase(gl, g, S, E); }
    SEAM(14);
    if (IN(15)) { p_build_vt<64, 4>(c, (const bf16_t*)(c.ar + AR_P1), NO, P1_CV, (bf16_t*)(c.ar + AR_VTC)); }
    SEAM(15);
    if (IN(16)) { p_ret_local(c); for (int item = blockIdx.x; item < NB * 4 * 128; item += gridDim.x) swa_block_item(c, item); }
    SEAM(16);
    if (IN(17)) p_ret_prefix(c);
    SEAM(17);
    if (IN(18)) p_ret_out(c);
    SEAM(18);
    if (MIX_I8 && IN(18) && IN(19)) { p_quant_mix(c, TL); xcd_barrier(bar); }
    if (IN(19)) { constexpr int KE = MIX_I8 ? D / 2 : D;
        pg8::Gemm g{MIX_I8 ? (const bf16_t*)(c.ar + AR_XQ) : XN, (const bf16_t*)(W1 + W1_MIX), TL, D, KE}; pg8::StaticOrder S; S.init(TL, D, gridDim.x, blockIdx.x, KE);
        EpiResModT<MIX_I8 != 0> E{H, H + (size_t)TL * D, H, MOD1 + 2 * 4096, (const float*)(c.ar + AR_XQS), i8_cs(c, CM_MIX + D)};
        pg8::gemm_phase(gl, g, S, E); }
    SEAM(19);
    if (IN(20)) p_norm_mod<1, FFN_I8 != 0>(c, H, H + (size_t)TL * D, TL, MOD1, 3, 4);
    SEAM(20);
    if (IN(21)) { constexpr int KE = FFN_I8 ? D / 2 : D;
        pg8::Gemm g{XN, (const bf16_t*)(W1 + W1_FFI), TL, 2 * DFF, KE}; pg8::StaticOrder S; S.init(TL, 2 * DFF, gridDim.x, blockIdx.x, KE);
        EpiConvGlu E{(bf16_t*)(c.ar + AR_HID), (bf16_t*)(c.ar + AR_SG), (bf16_t*)(c.ar + AR_SU), c.in[I_CONVW] + (size_t)3 * DFF, c.in[I_CONVB] + DFF, (const float*)(c.ws + WS_XN + (size_t)TT * D), i8_cs(c, CM_FFI + 2 * DFF)};
        pg8::gemm_phase(gl, g, S, E); }
    SEAM(21);
    if (IN(22)) p_conv_fix(c, 1, TL);
    SEAM(22);
    if (IN(23)) { pg8::Gemm g{(const bf16_t*)(c.ar + AR_HID), (const bf16_t*)(W1 + W1_FFO), TL, D, DFF}; pg8::StaticOrder S; S.init(TL, D, gridDim.x, blockIdx.x, DFF);
        EpiResMod E{H, H + (size_t)TL * D, H, MOD1 + 5 * 4096};
        pg8::gemm_phase(gl, g, S, E); }
    SEAM(23);
    if (IN(24)) p_final_norm(c);
#undef IN
#undef SEAM
}

extern "C" void kernel_launch(void* const* d_in, const int* in_sizes, int n_in, void* d_out, int out_size, void* d_ws, size_t ws_size, hipStream_t stream) {
    static int grid = 0;
    if (grid == 0) {
        if (n_in != 29 || ws_size < WS_END) { fprintf(stderr, "kernel_launch: need 29 inputs and >= %zu bytes of workspace; got n_in %d, ws %zu; nothing launched\n", (size_t)WS_END, n_in, ws_size); grid = -1; return; }
        int dev = 0, cus = 0, per_cu = 0;
        if (hipGetDevice(&dev) != hipSuccess || hipDeviceGetAttribute(&cus, hipDeviceAttributeMultiprocessorCount, dev) != hipSuccess) { grid = -1; return; }
        if (hipFuncSetAttribute((const void*)mk_fwd, hipFuncAttributeMaxDynamicSharedMemorySize, LDS_BYTES) != hipSuccess) { fprintf(stderr, "kernel_launch: hipFuncSetAttribute failed\n"); grid = -1; return; }
        if (hipOccupancyMaxActiveBlocksPerMultiprocessor(&per_cu, (const void*)mk_fwd, NTHREADS, LDS_BYTES) != hipSuccess || per_cu < 1) { fprintf(stderr, "kernel_launch: occupancy query says %d blocks per CU\n", per_cu); per_cu = 1; }
        (void)hipGetLastError();
        grid = cus;
    }
    if (grid < 0) return;
    (void)hipMemsetAsync((char*)d_ws + WS_CTL, 0, CTL_BYTES, stream);
    Args a{};
    for (int i = 0; i < 29; ++i) a.in[i] = (const float*)d_in[i];
    a.out = (float*)d_out; a.ws = (unsigned char*)d_ws;
#if MK_PER_PHASE
    for (int p = 0; p < N_PHASES; ++p) { a.ph_lo = p; a.ph_hi = p + 1; hipLaunchKernelGGL(mk_fwd, dim3(grid), dim3(NTHREADS), LDS_BYTES, stream, a); }
#else
    a.ph_lo = 0; a.ph_hi = N_PHASES;
    hipLaunchKernelGGL(mk_fwd, dim3(grid), dim3(NTHREADS), LDS_BYTES, stream, a);
#endif
    (void)in_sizes; (void)out_size;
}
```

```cpp
#include <hip/hip_runtime.h>
#include <cstdio>
#include <cstdint>

#define LAS __attribute__((address_space(3)))
#define DI __device__ __forceinline__
typedef unsigned short bf16_t;
typedef _Float16 h16;
typedef short bf16x8 __attribute__((ext_vector_type(8)));
typedef float f32x4 __attribute__((ext_vector_type(4)));
typedef int i32x4 __attribute__((ext_vector_type(4)));
typedef float f32x2 __attribute__((ext_vector_type(2)));
typedef float f32x16 __attribute__((ext_vector_type(16)));
typedef unsigned u32x4 __attribute__((ext_vector_type(4)));
typedef unsigned u32x2 __attribute__((ext_vector_type(2)));
typedef __bf16 bf16x2_n __attribute__((ext_vector_type(2)));
typedef _Float16 h16x2_n __attribute__((ext_vector_type(2)));

constexpr int D = 4096, NB = 4, SEQ = 4096, CTXL = 256;
constexpr int TL = NB * SEQ, TC = NB * CTXL, TT = TL + TC;
constexpr int DFF = 11008;
constexpr int HALF_W = 2048;
constexpr int COLS_A = 6784, COLS_A_PAD = 6912, COLS_B = 6144, NE = COLS_A_PAD + COLS_B;
constexpr int COLS_C = 2560, COLS_D = 6144, NO = COLS_C + COLS_D;
constexpr int NKEY = SEQ + CTXL;
constexpr int LORA_K = 1280, LORA_KU = 256, LORA_N = 5 * 2048;
constexpr int NTHREADS = 512;

constexpr size_t al256(size_t x) { return (x + 255) & ~(size_t)255; }
constexpr size_t WS_CTL = 0;
constexpr size_t CTL_CMAX = 65536;
constexpr int CM_FFI = 0, CM_INO = 2 * 2 * 11008, CM_INE = CM_INO + 8704, CM_MIX = CM_INE + 13056, CM_FFO1 = CM_MIX + 2 * 4096, CM_FFO0 = CM_FFO1 + 4096, CM_END = CM_FFO0 + 4096;
constexpr size_t CTL_BYTES = CTL_CMAX + (((size_t)CM_END * 4 + 255) & ~(size_t)255);
constexpr size_t WS_MOD = WS_CTL + CTL_BYTES;
constexpr size_t WS_SCAL = WS_MOD + al256((size_t)2 * 5 * 6 * D * 4);
constexpr size_t WS_CS = WS_SCAL + 256;
constexpr size_t WS_AXC = WS_CS + (((size_t)CM_END * 4 + 255) & ~(size_t)255);
constexpr size_t WS_AXS = WS_AXC + (size_t)SEQ * 32 * 4;
constexpr size_t WS_RTC = WS_AXS + (size_t)SEQ * 32 * 4;
constexpr size_t WS_RTS = WS_RTC + (size_t)NKEY * 64 * 4;
constexpr size_t WS_W = WS_RTS + (size_t)NKEY * 64 * 4;
constexpr size_t W_IN = 0;
constexpr size_t W_MIX = W_IN + (size_t)NE * D * 2;
constexpr size_t W_FFI = W_MIX + (size_t)D * D * 2;
constexpr size_t W_FFO = W_FFI + (size_t)2 * DFF * D * 2;
constexpr size_t W_LORA = W_FFO + (size_t)D * DFF * 2;
constexpr size_t W_BYTES = W_LORA + (size_t)LORA_N * LORA_K * 2;
constexpr size_t WS_H = WS_W + al256(W_BYTES);
constexpr size_t WS_XN = WS_H + (size_t)TT * D * 4;
constexpr size_t WS_W1 = WS_XN + (size_t)TT * D * 2;
constexpr size_t W1_MIX = 0, W1_FFI = W1_MIX + (size_t)D * D * 2, W1_FFO = W1_FFI + (size_t)2 * DFF * D * 2, W1_BYTES = W1_FFO + (size_t)D * DFF * 2;
constexpr size_t WS_ARENA = WS_W1 + al256(W1_BYTES);
constexpr size_t SZ16 = (size_t)TT * 2048 * 2;
constexpr size_t MOD_FLOATS = (size_t)2 * 5 * 6 * D;
constexpr size_t AR_XQ = 0, AR_XQS = (size_t)80 << 20;
constexpr size_t AR_MODP = 0;
constexpr size_t AR_PA = 0;
constexpr size_t AR_K = AR_PA + (size_t)TT * COLS_A_PAD * 2;
constexpr size_t AR_LA = AR_K + SZ16;
constexpr size_t RW_NCH = 136;
constexpr size_t CH_BYTES = 24576;
constexpr size_t AR_CH = 0;
constexpr size_t AR_CH_END = AR_CH + (size_t)256 * RW_NCH * CH_BYTES;
constexpr size_t AR_PB = AR_CH_END;
constexpr size_t AR_VT = AR_PB + (size_t)TT * COLS_B * 2;
constexpr size_t AR_R = AR_VT + (size_t)NB * 16 * 128 * NKEY * 2;
constexpr size_t AR_KK = AR_R + SZ16;
constexpr size_t AR_V = AR_KK + SZ16;
constexpr size_t AR_OMW = AR_V + SZ16;
constexpr size_t AR_BB = AR_OMW + 2 * SZ16;
constexpr size_t AR_KD = AR_BB + 2 * SZ16;
constexpr size_t AR_G = AR_KD + 2 * SZ16;
constexpr size_t AR_Y = AR_G + SZ16;
constexpr size_t AR_EVEN_END = AR_Y + 2 * SZ16;
static_assert(AR_LA + (size_t)TT * LORA_K * 2 <= AR_CH_END, "PA|K|LA must sit under the chunk matrices");
constexpr size_t AR_GU = 0;
constexpr size_t AR_SG = 0, AR_SU = AR_SG + (size_t)(TT / 64) * 4 * DFF * 2;
constexpr size_t AR_HQ = (size_t)64 << 20, AR_HQS = (size_t)320 << 20;
constexpr size_t AR_HID = AR_GU + (size_t)TT * 2 * DFF * 2;
constexpr size_t AR_FFN_END = AR_HID + (size_t)TT * DFF * 2;
constexpr size_t AR_P1 = 0;
constexpr size_t AR_VTC = AR_P1 + (size_t)TT * NO * 2;
constexpr size_t AR_RU = AR_VTC + (size_t)NB * 4 * 64 * NKEY * 2;
constexpr size_t AR_RS = AR_RU + (size_t)NB * 8 * 2 * 34 * 256 * 128 * 4;
constexpr size_t AR_ODD_END = AR_RS + (size_t)NB * 8 * 2 * 32 * 256 * 128 * 2;
constexpr size_t AR_SLAB = (size_t)1300 << 20;
constexpr size_t AR_SLAB_END = AR_SLAB + (size_t)4 * TC * D * 4;
static_assert(AR_SLAB >= AR_FFN_END, "slab overlaps the FFN buffers");
constexpr size_t cmax(size_t a, size_t b) { return a > b ? a : b; }
constexpr size_t AR_BYTES = cmax(cmax(AR_EVEN_END, AR_FFN_END), AR_ODD_END);
constexpr size_t WS_END = WS_ARENA + AR_BYTES;
static_assert(WS_END <= (size_t)3221225472ull, "workspace plan exceeds 4 x the largest input tensor");
static_assert(AR_SLAB_END <= AR_BYTES, "slab outside the arena");

DI float bf2f(bf16_t x) { return __uint_as_float((unsigned)x << 16); }
DI bf16_t f2bf(float x) { return __builtin_bit_cast(unsigned short, (__bf16)x); }
DI unsigned pk_bf16(float lo, float hi) { f32x2 v = {lo, hi}; return __builtin_bit_cast(unsigned, __builtin_convertvector(v, bf16x2_n)); }
DI unsigned pk_f16(float lo, float hi) { f32x2 v = {lo, hi}; return __builtin_bit_cast(unsigned, __builtin_convertvector(v, h16x2_n)); }
DI float bflo(unsigned w) { return __uint_as_float(w << 16); }
DI float bfhi(unsigned w) { return __uint_as_float(w & 0xffff0000u); }
DI float h16lo(unsigned w) { return (float)__builtin_bit_cast(h16x2_n, w)[0]; }
DI float h16hi(unsigned w) { return (float)__builtin_bit_cast(h16x2_n, w)[1]; }
DI float silu_f(float x) { return x * __builtin_amdgcn_rcpf(1.0f + __expf(-x)); }
DI float sigmoid_f(float x) { return __builtin_amdgcn_rcpf(1.0f + __expf(-x)); }
DI float wave_sum(float v) {
#pragma unroll
    for (int o = 32; o >= 1; o >>= 1) v += __shfl_xor(v, o);
    return v;
}
DI void load8f(const float* p, float (&o)[8]) { const f32x4 a = *(const f32x4*)p, b = *(const f32x4*)(p + 4);
#pragma unroll
    for (int j = 0; j < 4; ++j) { o[j] = a[j]; o[4 + j] = b[j]; } }
DI int row_modidx(int row) { return row < TL ? (row >> 12) : 4; }

#define XB_TMO      128
#define XB_XCNT(j)  (256  + 64 * (j))
#define XB_XSUB(j)  (1280 + 64 * (j))
#define XB_XGEN(j)  (2304 + 64 * (j))
#define XB_TOP      3328
#define XB_TOPGEN   3392
#define XCD_BAR_WORDS 3456
#define XB_SPIN_CAP (1u << 22)

__device__ __forceinline__ unsigned xb_ld(unsigned* p)              { return __hip_atomic_load(p, __ATOMIC_RELAXED, __HIP_MEMORY_SCOPE_AGENT); }
__device__ __forceinline__ unsigned xb_add(unsigned* p, unsigned v) { return __hip_atomic_fetch_add(p, v, __ATOMIC_RELAXED, __HIP_MEMORY_SCOPE_AGENT); }
__device__ __forceinline__ unsigned xb_xcc_id() { return (unsigned)__builtin_amdgcn_s_getreg((3 << 11) | 20) & 0xFu; }
#define XB_SPIN(cond, bar) do { unsigned _sp = 0; while (cond) { __builtin_amdgcn_s_sleep(1); \
    if ((++_sp & 255u) == 0u) { if (xb_ld(&(bar)[XB_TMO])) break; if (_sp > XB_SPIN_CAP) { atomicAdd(&(bar)[XB_TMO], 1u); break; } } } } while (0)

struct XcdBarrier {
    unsigned* bar; unsigned x;
    volatile LAS unsigned* st;
};

__device__ __forceinline__ XcdBarrier xcd_barrier_post(unsigned* bar, volatile LAS unsigned* st) {
    XcdBarrier b; b.bar = bar; b.x = xb_xcc_id(); b.st = st;
    if (threadIdx.x == 0) (void)xb_add(&bar[XB_XCNT(b.x)], 1u);
    return b;
}
__device__ __forceinline__ void xcd_barrier_complete(unsigned* bar, unsigned x, unsigned& nloc, unsigned& nx) {
    const unsigned G = gridDim.x * gridDim.y * gridDim.z;
    unsigned sum, cnt, mine, sp = 0u;
    for (;;) {
        sum = 0u; cnt = 0u; mine = 0u;
#pragma unroll
        for (unsigned j = 0; j < 16; ++j) { const unsigned c = xb_ld(&bar[XB_XCNT(j)]); sum += c; cnt += (c > 0u) ? 1u : 0u; mine = (j == x) ? c : mine; }
        if (sum == G) break;
        __builtin_amdgcn_s_sleep(1);
        if ((++sp & 255u) == 0u) { if (xb_ld(&bar[XB_TMO])) break; if (sp > XB_SPIN_CAP) { atomicAdd(&bar[XB_TMO], 1u); break; } }
    }
    nloc = mine > 0u ? mine : 1u; nx = cnt > 0u ? cnt : 1u;
}

__device__ __forceinline__ void xcd_barrier(const XcdBarrier& b) {
    asm volatile("s_waitcnt vmcnt(0)" ::: "memory");
    __syncthreads();
    if (threadIdx.x == 0) {
        unsigned* bar = b.bar;
        __builtin_amdgcn_s_waitcnt(0);
        unsigned nloc = b.st[0], nx = b.st[1];
        if (nloc == 0u) { xcd_barrier_complete(bar, b.x, nloc, nx); b.st[0] = nloc; b.st[1] = nx; }
        const unsigned old = xb_add(&bar[XB_XSUB(b.x)], 1u);
        const unsigned gen = old / nloc;
        if (old + 1u == (gen + 1u) * nloc) {
            __builtin_amdgcn_fence(__ATOMIC_RELEASE, "agent");
            asm volatile("s_waitcnt vmcnt(0)" ::: "memory");
            const unsigned og = xb_add(&bar[XB_TOP], 1u);
            const unsigned tg = og / nx;
            if (og + 1u == (tg + 1u) * nx) xb_add(&bar[XB_TOPGEN], 1u);
            else XB_SPIN(xb_ld(&bar[XB_TOPGEN]) == tg, bar);
            __builtin_amdgcn_fence(__ATOMIC_ACQUIRE, "agent");
            xb_add(&bar[XB_XGEN(b.x)], 1u);
            asm volatile("s_waitcnt vmcnt(0)" ::: "memory");
        } else {
            XB_SPIN(xb_ld(&bar[XB_XGEN(b.x)]) == gen, bar);
            __builtin_amdgcn_fence(__ATOMIC_ACQUIRE, "agent");
            asm volatile("s_waitcnt vmcnt(0)" ::: "memory");
        }
    }
    __syncthreads();
}

namespace pg8 {
#define PG8_LAS __attribute__((address_space(3)))
constexpr int BM = 256, BK = 64, HALF = 128, HTB = HALF * BK * 2  , STAGE_BYTES = 8 * HTB, NXCD = 8, WGM = 4;

__host__ __device__ __forceinline__ int lds_byte(int r, int c) { const int st = (r >> 4) * 2 + (c >> 5), rr = r & 15, cc = c & 31, ob = rr * 64 + cc * 2; return st * 1024 + (ob ^ (((ob >> 9) & 1) << 5)); }
__host__ __device__ __forceinline__ void stage_rc(int b, int& R, int& C) { const int st = b / 1024, sb = b % 1024, swz = sb ^ (((sb >> 9) & 1) << 5); R = (st >> 1) * 16 + swz / 64; C = (st & 1) * 32 + (swz % 64) / 2; }
__host__ __device__ __forceinline__ int perm32(int rho) { const int n = rho >> 4, i = rho & 15; return 8 * (i >> 2) + 4 * n + (i & 3); }

struct Unit { int pm, pn, koff, nt, part; };
struct Gemm { const bf16_t* A; const bf16_t* Bt; int M, N, K; };

struct StaticOrder {
    int nM, nN, nwg, G, c, ntk;
    __host__ __device__ void init(int M, int N, int G_, int c_, int K_ = 0) { nM = M / BM; nN = N / BM; nwg = nM * nN; G = G_; c = c_; ntk = K_ / BK; }
    __host__ __device__ bool next(int i, Unit& u) const {
        const long L = (long)i * G + c; if (L >= nwg) return false;
        int wgid = (int)L; { const int q = nwg / NXCD, r = nwg % NXCD, xcd = wgid % NXCD, off = wgid / NXCD; wgid = (xcd < r ? xcd * (q + 1) : r * (q + 1) + (xcd - r) * q) + off; }
        const int nig = WGM * nN, gid = wgid / nig, fm = gid * WGM, gsz = (nM - fm) < WGM ? (nM - fm) : WGM;
        u.pm = fm + ((wgid % nig) % gsz); u.pn = (wgid % nig) / gsz; u.koff = 0; u.nt = ntk; u.part = -1; return true;
    }
    __device__ __forceinline__ void a_ready(const Unit&) const {}
    __device__ __forceinline__ void done(const Unit&) const {}
};


template <class Epi, class Sched>
__device__ __forceinline__ void gemm_phase(PG8_LAS unsigned char* lds, const Gemm g, const Sched& S, const Epi& E) {
    const int tid = threadIdx.x, wid = __builtin_amdgcn_readfirstlane(tid >> 6), lane = tid & 63, wr = wid >> 2, wc = wid & 3, fr = lane & 15, fq = lane >> 4;
    const int K = g.K;
    unsigned voffA[2], voffB[2];
#pragma unroll
    for (int i = 0; i < 2; ++i) { int R, C; stage_rc(tid * 16 + i * 8192, R, C); const int Rb = Epi::PERM ? ((R & ~31) + perm32(R & 31)) : R;
        voffA[i] = (unsigned)(R * K + C) * 2u; voffB[i] = (unsigned)(Rb * K + C) * 2u; }
    const size_t kstep = (size_t)(BK * 2);
    const size_t hstep = (size_t)HALF * K * 2;
    const size_t tstep = 2 * hstep;
    const unsigned ldsw = (unsigned)wid * 1024u;
    const int aoff = lds_byte(wr * 64 + fr, fq * 8), boff = lds_byte(wc * 32 + fr, fq * 8);
#define PG8_SA(b, h) (((b) * 2 + (h)) * HTB)
#define PG8_SB(b, h) ((4 + (b) * 2 + (h)) * HTB)
#define PG8_STAGE(bufoff, gbase, voff) do { _Pragma("unroll") for (int _i = 0; _i < 2; ++_i) \
        __builtin_amdgcn_global_load_lds((const unsigned*)((const char*)(gbase) + (voff)[_i]), (PG8_LAS unsigned*)(lds + (bufoff) + ldsw + _i * 8192), 16, 0, 0); } while (0)
#define PG8_LDA(dst, b, h) do { _Pragma("unroll") for (int m = 0; m < 4; ++m) _Pragma("unroll") for (int k = 0; k < 2; ++k) dst[m][k] = *(const PG8_LAS bf16x8*)(lds + PG8_SA(b, h) + aoff + m * 2048 + k * 1024); } while (0)
#define PG8_LDB(dst, b, h) do { _Pragma("unroll") for (int n = 0; n < 2; ++n) _Pragma("unroll") for (int k = 0; k < 2; ++k) dst[n][k] = *(const PG8_LAS bf16x8*)(lds + PG8_SB(b, h) + boff + n * 2048 + k * 1024); } while (0)
#define PG8_MMA(ai, bj, At, Bt) do { __builtin_amdgcn_s_setprio(1); _Pragma("unroll") for (int m = 0; m < 4; ++m) _Pragma("unroll") for (int n = 0; n < 2; ++n) _Pragma("unroll") for (int k = 0; k < 2; ++k) \
        { if constexpr (Epi::I8) acc[ai][bj][m][n] = __builtin_bit_cast(f32x4, __builtin_amdgcn_mfma_i32_16x16x64_i8(__builtin_bit_cast(i32x4, Bt[n][k]), __builtin_bit_cast(i32x4, At[m][k]), __builtin_bit_cast(i32x4, acc[ai][bj][m][n]), 0, 0, 0)); \
          else acc[ai][bj][m][n] = __builtin_amdgcn_mfma_f32_16x16x32_bf16(Bt[n][k], At[m][k], acc[ai][bj][m][n], 0, 0, 0); } __builtin_amdgcn_s_setprio(0); } while (0)
#define PG8_WAIT_V(n) asm volatile("s_waitcnt vmcnt(" #n ")" ::: "memory")
#define PG8_WAIT_L(n) asm volatile("s_waitcnt lgkmcnt(" #n ")" ::: "memory")
#define PG8_BAR __builtin_amdgcn_s_barrier()
#define PG8_SCHED __builtin_amdgcn_sched_barrier(0)
    Unit cur, nxt; int ui = 0;
    if (!S.next(0, cur)) return;
    f32x4 acc[2][2][4][2];
#pragma unroll
    for (int a = 0; a < 2; ++a)
#pragma unroll
        for (int b = 0; b < 2; ++b)
#pragma unroll
            for (int m = 0; m < 4; ++m)
#pragma unroll
                for (int n = 0; n < 2; ++n) acc[a][b][m][n] = (f32x4){0.f, 0.f, 0.f, 0.f};
    bf16x8 At[4][2], B0[2][2], B1[2][2];
    const char* cA = (const char*)g.A + (size_t)cur.pm * tstep + cur.koff; const char* cB = (const char*)g.Bt + (size_t)cur.pn * tstep + cur.koff;
    S.a_ready(cur);
    PG8_STAGE(PG8_SB(0, 0), cB, voffB); PG8_STAGE(PG8_SB(0, 1), cB + hstep, voffB); PG8_STAGE(PG8_SA(0, 0), cA, voffA); PG8_STAGE(PG8_SA(0, 1), cA + hstep, voffA);
    if (wr == 1) PG8_BAR;
    PG8_WAIT_V(2); PG8_BAR;
    PG8_STAGE(PG8_SB(1, 0), cB + kstep, voffB); PG8_STAGE(PG8_SA(1, 0), cA + kstep, voffA); PG8_STAGE(PG8_SB(1, 1), cB + hstep + kstep, voffB);
    PG8_WAIT_V(6); PG8_BAR;
    for (;;) {
        const bool has_next = S.next(ui + 1, nxt);
        const char* nA = has_next ? (const char*)g.A + (size_t)nxt.pm * tstep + nxt.koff : cA; const char* nB = has_next ? (const char*)g.Bt + (size_t)nxt.pn * tstep + nxt.koff : cB;
        const int nt = cur.nt;
        for (int t = 0; t < nt; t += 2) {
            const bool last = (t == nt - 2);
            const char* a1 = cA + (size_t)(t + 1) * kstep;
            const char* a2 = last ? nA : cA + (size_t)(t + 2) * kstep; const char* b2 = last ? nB : cB + (size_t)(t + 2) * kstep;
            const char* a3 = a2 + kstep; const char* b3 = b2 + kstep;
            if (last && has_next) S.a_ready(nxt);
            PG8_LDB(B0, 0, 0); PG8_LDB(B1, 0, 1); PG8_SCHED; PG8_LDA(At, 0, 0); PG8_STAGE(PG8_SA(1, 1), a1 + hstep, voffA);
            PG8_WAIT_V(8); PG8_WAIT_L(0); PG8_BAR; PG8_MMA(0, 0, At, B0); PG8_MMA(0, 1, At, B1); PG8_BAR; PG8_SCHED;
            PG8_LDA(At, 0, 1); PG8_STAGE(PG8_SB(0, 0), b2, voffB); PG8_STAGE(PG8_SB(0, 1), b2 + hstep, voffB); PG8_STAGE(PG8_SA(0, 0), a2, voffA);
            PG8_WAIT_V(8); PG8_WAIT_L(0); PG8_BAR; PG8_MMA(1, 0, At, B0); PG8_MMA(1, 1, At, B1); PG8_BAR; PG8_SCHED;
            PG8_LDB(B0, 1, 0); PG8_LDB(B1, 1, 1); PG8_SCHED; PG8_LDA(At, 1, 0); PG8_STAGE(PG8_SA(0, 1), a2 + hstep, voffA);
            PG8_WAIT_V(8); PG8_WAIT_L(0); PG8_BAR; PG8_MMA(0, 0, At, B0); PG8_MMA(0, 1, At, B1); PG8_BAR; PG8_SCHED;
            PG8_LDA(At, 1, 1); PG8_STAGE(PG8_SB(1, 0), b3, voffB); PG8_STAGE(PG8_SB(1, 1), b3 + hstep, voffB); PG8_STAGE(PG8_SA(1, 0), a3, voffA);
            PG8_WAIT_V(8); PG8_WAIT_L(0); PG8_BAR; PG8_MMA(1, 0, At, B0); PG8_MMA(1, 1, At, B1); PG8_BAR; PG8_SCHED;
        }
        if (wr == 0) PG8_BAR;
        if constexpr (Epi::I8) E.prescale(acc, cur, wr, wc, fr, fq);
        if constexpr (!Epi::AFTER_DRAIN) { E(acc, cur, wr, wc, fr, fq); S.done(cur); }
        if (!has_next) break;
#pragma unroll
        for (int a = 0; a < 2; ++a)
#pragma unroll
            for (int b = 0; b < 2; ++b)
#pragma unroll
                for (int m = 0; m < 4; ++m)
#pragma unroll
                    for (int n = 0; n < 2; ++n) acc[a][b][m][n] = (f32x4){0.f, 0.f, 0.f, 0.f};
        cur = nxt; cA = nA; cB = nB; ++ui;
        if (wr == 1) PG8_BAR;
    }
    PG8_WAIT_V(0);
    PG8_BAR;
    if constexpr (Epi::AFTER_DRAIN) { E.fused(acc, cur, wr, wc, fr, fq, lds, wid, lane); S.done(cur); }
#undef PG8_SA
#undef PG8_SB
#undef PG8_STAGE
#undef PG8_LDA
#undef PG8_LDB
#undef PG8_MMA
#undef PG8_WAIT_V
#undef PG8_WAIT_L
#undef PG8_BAR
#undef PG8_SCHED
}

}

#ifndef INO_I8
#define INO_I8 0
#endif
#ifndef FFO1_I8
#define FFO1_I8 1
#endif
#ifndef FFO0_I8
#define FFO0_I8 1
#endif
#ifndef MIX_I8
#define MIX_I8 0
#endif
#ifndef FFN_I8
#define FFN_I8 1
#endif
struct Args { const float* in[29]; float* out; unsigned char* ws; int ph_lo, ph_hi; };
struct Ctx {
    const float* in[29]; float* out; unsigned char* ws; unsigned char* ar;
    LAS unsigned char* lds;
    int tid, lane, wave;
};
enum { I_X = 0, I_C, I_CTX, I_CCTX, I_WMOD, I_BMOD, I_WINE, I_MU, I_W0, I_W2, I_A0, I_A2, I_G2, I_KK, I_KA, I_RK, I_LNW, I_LNB, I_LAM, I_SUBLN,
       I_WINO, I_SINK, I_RDEC, I_WMIX, I_WFFI, I_CONVW, I_CONVB, I_WFFO, I_FNORM };

__device__ __forceinline__ void p_mod(const Ctx& c) {
    LAS float* sc = (LAS float*)c.lds;
    LAS float* red = sc + 5 * 4096;
    const int tid = c.tid, lane = c.lane, w = c.wave;
    for (int i = tid; i < 5 * 4096; i += NTHREADS) { const int r = i >> 12, k = i & 4095; const float v = r < 4 ? c.in[I_C][r * 4096 + k] : c.in[I_CCTX][k]; sc[i] = silu_f(v); }
    __syncthreads();
    float* MODP = (float*)(c.ar + AR_MODP);
    for (int u = blockIdx.x; u < 768; u += gridDim.x) {
        const int kp = u & 3, cg = (u >> 2) % 96, l = u / 384;
        const int k0 = kp * 1024 + w * 128;
        const float* wp = c.in[I_WMOD] + ((size_t)l * 4096 + k0) * 24576 + cg * 256 + lane * 4;
        f32x4 acc[5];
#pragma unroll
        for (int r = 0; r < 5; ++r) acc[r] = (f32x4){0.f, 0.f, 0.f, 0.f};
#pragma unroll 2
        for (int k = 0; k < 128; k += 4) {
            f32x4 wv[4];
#pragma unroll
            for (int j = 0; j < 4; ++j) wv[j] = __builtin_nontemporal_load((const f32x4*)(wp + (size_t)(k + j) * 24576));
#pragma unroll
            for (int r = 0; r < 5; ++r) { const f32x4 s4 = *(const LAS f32x4*)(sc + r * 4096 + k0 + k);
#pragma unroll
                for (int j = 0; j < 4; ++j) acc[r] += wv[j] * s4[j]; }
        }
#pragma unroll
        for (int r = 0; r < 5; ++r) *(LAS f32x4*)(red + (w * 5 + r) * 256 + lane * 4) = acc[r];
        __syncthreads();
        for (int idx = tid; idx < 5 * 256; idx += NTHREADS) { const int r = idx >> 8, col = idx & 255; float s = 0.f;
#pragma unroll
            for (int q = 0; q < 8; ++q) s += red[(q * 5 + r) * 256 + col];
            if (kp == 0) s += c.in[I_BMOD][l * 24576 + cg * 256 + col];
            MODP[(size_t)kp * MOD_FLOATS + ((size_t)l * 5 + r) * 24576 + cg * 256 + col] = s; }
        __syncthreads();
    }
}

__device__ __forceinline__ void p_mod_finalize(const Ctx& c) {
    const float* MODP = (const float*)(c.ar + AR_MODP); float* MOD = (float*)(c.ws + WS_MOD);
    for (size_t i = ((size_t)blockIdx.x * NTHREADS + c.tid) * 4; i < MOD_FLOATS; i += (size_t)gridDim.x * NTHREADS * 4)
        *(f32x4*)(MOD + i) = (*(const f32x4*)(MODP + i) + *(const f32x4*)(MODP + MOD_FLOATS + i)) + (*(const f32x4*)(MODP + 2 * MOD_FLOATS + i) + *(const f32x4*)(MODP + 3 * MOD_FLOATS + i));
}
DI int perm64(int m) { const int within = m & 255, rho = within & 127; return (m & ~255) + (rho >> 5) * 64 + (within >> 7) * 32 + (rho & 31); }
DI int perm128(int m) { const int within = m & 255, rho = within & 127; return (m & ~255) + (rho >> 6) * 128 + (within >> 7) * 64 + (rho & 63); }
DI int in_odd_src(int n) { return n < 2304 ? perm64(n) : (n < 2560 ? n : (n < 4608 ? 2560 + perm128(n - 2560) : n)); }
__device__ __forceinline__ int p_convert_job(const Ctx& c, const float* __restrict__ src, int src_ld, int K, int n0, int ncnt, bf16_t* __restrict__ dst, int dn0, int base, int nperm = 0) {
    LAS unsigned short* T = (LAS unsigned short*)c.lds;
    const int tid = c.tid, tk = K / 64, tn = ncnt / 128, nt = tk * tn, G = (int)gridDim.x;
    int first = (int)blockIdx.x - (base % G); if (first < 0) first += G;
    const int kr = tid >> 3, c16 = (tid & 7) * 16, wn = tid >> 2, k16 = (tid & 3) * 16;
    f32x4 v[4], vn[4];
    if (first < nt) { const int nn = (first / tk) * 128 + c16; const float* p = src + (size_t)((first % tk) * 64 + kr) * src_ld + n0 + (nn < nperm ? perm64(nn) : nn);
#pragma unroll
        for (int i = 0; i < 4; ++i) v[i] = __builtin_nontemporal_load((const f32x4*)(p + 4 * i)); }
    for (int t = first; t < nt; t += G) {
        const int t2 = t + G;
        if (t2 < nt) { const int nn = (t2 / tk) * 128 + c16; const float* p = src + (size_t)((t2 % tk) * 64 + kr) * src_ld + n0 + (nn < nperm ? perm64(nn) : nn);
#pragma unroll
            for (int i = 0; i < 4; ++i) vn[i] = __builtin_nontemporal_load((const f32x4*)(p + 4 * i)); }
#pragma unroll
        for (int i = 0; i < 4; ++i)
#pragma unroll
            for (int j = 0; j < 4; ++j) T[(c16 + 4 * i + j) * 72 + kr] = f2bf(v[i][j]);
        __syncthreads();
        { const u32x4 a = *(const LAS u32x4*)(T + wn * 72 + k16), b = *(const LAS u32x4*)(T + wn * 72 + k16 + 8);
          bf16_t* q = dst + (size_t)(dn0 + (t / tk) * 128 + wn) * K + (t % tk) * 64 + k16;
          *(u32x4*)q = a; *(u32x4*)(q + 8) = b; }
        __syncthreads();
#pragma unroll
        for (int i = 0; i < 4; ++i) v[i] = vn[i];
    }
    return base + nt;
}
DI void conv_wave_tile(const float* __restrict__ src, int src_ld, int k0, int nsrc, int n0, bf16_t* __restrict__ dst, int K, int lane) {
    float v[32];
    const float* p = src + (size_t)k0 * src_ld + nsrc;
#pragma unroll
    for (int kk = 0; kk < 32; ++kk) v[kk] = __builtin_nontemporal_load(p + (size_t)kk * src_ld);
    bf16_t* q = dst + (size_t)(n0 + lane) * K + k0;
#pragma unroll
    for (int g = 0; g < 4; ++g) { u32x4 w; w.x = pk_bf16(v[8 * g], v[8 * g + 1]); w.y = pk_bf16(v[8 * g + 2], v[8 * g + 3]); w.z = pk_bf16(v[8 * g + 4], v[8 * g + 5]); w.w = pk_bf16(v[8 * g + 6], v[8 * g + 7]);
        *(u32x4*)(q + 8 * g) = w; }
}
DI unsigned pk_i8x4(float a, float b, float c2, float d) { const int ia = (int)rintf(a), ib = (int)rintf(b), ic = (int)rintf(c2), id = (int)rintf(d);
    return ((unsigned)ia & 255u) | (((unsigned)ib & 255u) << 8) | (((unsigned)ic & 255u) << 16) | ((unsigned)id << 24); }
template <class T> DI void fwht32(T (&v)[32]) {
#pragma unroll
    for (int h = 1; h < 32; h <<= 1)
#pragma unroll
        for (int i = 0; i < 32; i += 2 * h)
#pragma unroll
            for (int j = i; j < i + h; ++j) { const T a = v[j], b = v[j + h]; v[j] = a + b; v[j + h] = a - b; }
}
DI unsigned* i8_cmax(const Ctx& c, int off) { return (unsigned*)(c.ws + WS_CTL + CTL_CMAX) + off; }
DI float* i8_cs(const Ctx& c, int off) { return (float*)(c.ws + WS_CS) + off; }
DI void conv_wave_tile_q8(const float* __restrict__ src, int src_ld, int k0, int nsrc, int n0, unsigned char* __restrict__ dst, int K, int lane, const unsigned* cmax, float* cs) {
    float v[32];
    const float* p = src + (size_t)k0 * src_ld + nsrc;
#pragma unroll
    for (int kk = 0; kk < 32; ++kk) v[kk] = __builtin_nontemporal_load(p + (size_t)kk * src_ld);
    const float cm = __uint_as_float(cmax[nsrc]); const float qs = cm > 0.f ? 127.0f / cm : 0.f;
    if (k0 == 0) cs[n0 + lane] = cm * (1.0f / 127.0f);
    fwht32(v);
    unsigned char* q = dst + (size_t)(n0 + lane) * K + k0;
#pragma unroll
    for (int g = 0; g < 2; ++g) { u32x4 w;
#pragma unroll
        for (int j = 0; j < 4; ++j) w[j] = pk_i8x4(v[16 * g + 4 * j] * 0.03125f * qs, v[16 * g + 4 * j + 1] * 0.03125f * qs, v[16 * g + 4 * j + 2] * 0.03125f * qs, v[16 * g + 4 * j + 3] * 0.03125f * qs);
        *(u32x4*)(q + 16 * g) = w; }
}
__device__ __forceinline__ int p_wcolmax_job(const Ctx& c, const float* __restrict__ src0, int ld, int K, unsigned* cmax, int base) {
    LAS float* red = (LAS float*)c.lds;
    const int ncg = (ld + 255) / 256, nko = (K + 1023) / 1024, nitem = ncg * nko, G = (int)gridDim.x;
    int first = (int)blockIdx.x - (base % G); if (first < 0) first += G;
#pragma unroll 1
    for (int it = first; it < nitem; it += G) {
        const int cg = it % ncg, ko = it / ncg, col = cg * 256 + c.lane * 4;
        f32x4 mx = {0.f, 0.f, 0.f, 0.f};
        if (col < ld && ko * 1024 + c.wave * 128 < K) {
#pragma unroll 1
            for (int t = 0; t < 4; ++t) {
                f32x4 v[32]; const float* p = src0 + (size_t)(ko * 1024 + c.wave * 128 + t * 32) * ld + col;
#pragma unroll
                for (int kk = 0; kk < 32; ++kk) v[kk] = __builtin_nontemporal_load((const f32x4*)(p + (size_t)kk * ld));
                fwht32(v);
#pragma unroll
                for (int kk = 0; kk < 32; ++kk)
#pragma unroll
                    for (int j = 0; j < 4; ++j) mx[j] = fmaxf(mx[j], fabsf(v[kk][j]));
            }
        }
        *(LAS f32x4*)(red + c.wave * 256 + c.lane * 4) = mx;
        __syncthreads();
        if (c.tid < 256) { float m = red[c.tid];
#pragma unroll
            for (int w = 1; w < 8; ++w) m = fmaxf(m, red[w * 256 + c.tid]);
            const int cc = cg * 256 + c.tid; if (cc < ld) atomicMax(cmax + cc, __float_as_uint(m * 0.03125f)); }
        __syncthreads();
    }
    return base + nitem;
}
__device__ __forceinline__ void p_wcolmax(const Ctx& c) {
    int base = 0;
    __syncthreads();
    if (FFN_I8) { base = p_wcolmax_job(c, c.in[I_WFFI], 2 * DFF, D, i8_cmax(c, CM_FFI), base); base = p_wcolmax_job(c, c.in[I_WFFI] + (size_t)D * 2 * DFF, 2 * DFF, D, i8_cmax(c, CM_FFI + 2 * DFF), base); }
    if (INO_I8) base = p_wcolmax_job(c, c.in[I_WINO], NO, D, i8_cmax(c, CM_INO), base);
    if (FFO0_I8) base = p_wcolmax_job(c, c.in[I_WFFO], D, DFF, i8_cmax(c, CM_FFO0), base);
    if (FFO1_I8) base = p_wcolmax_job(c, c.in[I_WFFO] + (size_t)DFF * D, D, DFF, i8_cmax(c, CM_FFO1), base);
    if (MIX_I8) { base = p_wcolmax_job(c, c.in[I_WMIX], D, D, i8_cmax(c, CM_MIX), base); base = p_wcolmax_job(c, c.in[I_WMIX] + (size_t)D * D, D, D, i8_cmax(c, CM_MIX + D), base); }
}
__device__ __forceinline__ void p_weights_layer0(const Ctx& c) {
    bf16_t* W = (bf16_t*)(c.ws + WS_W);
    {   constexpr int T_IN = (4096 / 32) * ((COLS_A + COLS_B) / 64), T_MIX = (4096 / 32) * (4096 / 64), T_L96 = 3 * (2048 / 64), T_LG = 8 * (2048 / 64);
        constexpr int E0 = T_IN, E1 = E0, E2 = E1 + 4 * T_L96, E3 = E2 + T_LG;
        bf16_t* L = (bf16_t*)((unsigned char*)W + W_LORA);
        for (int t = blockIdx.x * 8 + c.wave; t < E3; t += gridDim.x * 8) {
            if (t < E0) { const int kt = t & 127, g = t >> 7, n = g * 64 + c.lane;
                const int nsrc = n < COLS_A ? n : COLS_A + (n - COLS_A < 4096 ? perm64(n - COLS_A) : n - COLS_A);
                conv_wave_tile(c.in[I_WINE], COLS_A + COLS_B, kt * 32, nsrc, n < COLS_A ? g * 64 : g * 64 + (COLS_A_PAD - COLS_A), (bf16_t*)((unsigned char*)W + W_IN), 4096, c.lane); }
            else if (t < E1) { const int tl = t - E0, kt = tl & 127, g = tl >> 7;
                conv_wave_tile(c.in[I_WMIX], 4096, kt * 32, g * 64 + c.lane, g * 64, (bf16_t*)((unsigned char*)W + W_MIX), 4096, c.lane); }
            else if (t < E2) { const int tl = t - E1, type = tl / T_L96, r2 = tl % T_L96, kt = r2 % 3, g = r2 / 3;
                const float* src = (type < 2 ? c.in[I_W2] + (size_t)type * 96 * 2048 : c.in[I_A2] + (size_t)(type - 2) * 96 * 2048);
                conv_wave_tile(src, 2048, kt * 32, g * 64 + c.lane, g * 64, L + (size_t)type * 2048 * LORA_K + type * LORA_KU, LORA_K, c.lane); }
            else { const int tl = t - E2, kt = tl & 7, g = tl >> 3;
                conv_wave_tile(c.in[I_G2], 2048, kt * 32, g * 64 + c.lane, g * 64, L + (size_t)4 * 2048 * LORA_K + 4 * LORA_KU, LORA_K, c.lane); }
        }
    }
    const size_t gtid = (size_t)blockIdx.x * NTHREADS + c.tid, gn = (size_t)gridDim.x * NTHREADS;
    { u32x4* z = (u32x4*)((unsigned char*)W + W_IN + (size_t)COLS_A * 4096 * 2); const size_t n16 = (size_t)(COLS_A_PAD - COLS_A) * 4096 * 2 / 16;
      for (size_t i = gtid; i < n16; i += gn) z[i] = (u32x4){0u, 0u, 0u, 0u}; }
    { bf16_t* L = (bf16_t*)((unsigned char*)W + W_LORA);
      for (size_t i = gtid; i < (size_t)4 * 2048 * 20; i += gn) { const int n = (int)(i / 20), ch = (int)(i % 20), type = n >> 11;
          *(u32x4*)(L + (size_t)n * LORA_K + type * LORA_KU + 96 + ch * 8) = (u32x4){0u, 0u, 0u, 0u}; } }
    { float* axc = (float*)(c.ws + WS_AXC); float* axs = (float*)(c.ws + WS_AXS);
      for (size_t i = gtid; i < (size_t)SEQ * 32; i += gn) { const int pos = (int)(i >> 5), a = (int)(i & 31), q = a & 15;
          const float inv = powf(10000.0f, -(float)q / 16.0f); const float p = (a < 16) ? (float)(pos >> 6) : (float)(pos & 63);
          float sn, cs; sincosf(p * inv, &sn, &cs); axc[i] = cs; axs[i] = sn; } }
    { float* rtc = (float*)(c.ws + WS_RTC); float* rts = (float*)(c.ws + WS_RTS);
      for (size_t i = gtid; i < (size_t)NKEY * 64; i += gn) { const int pos = (int)(i >> 6), a = (int)(i & 63);
          const float t = (float)a / 63.0f; const float inv = powf(10000.0f, -t);
          float sn, cs; sincosf((float)pos * inv, &sn, &cs); rtc[i] = cs; rts[i] = sn; } }
    if (gtid == 0) { const float* lv = c.in[I_LAM]; float s01 = 0.f, s23 = 0.f;
        for (int i = 0; i < 64; ++i) { s01 += lv[i] * lv[64 + i]; s23 += lv[128 + i] * lv[192 + i]; }
        ((float*)(c.ws + WS_SCAL))[0] = expf(s01) - expf(s23) + 0.2f; }
}
constexpr int CONV_SPLIT = 128192;
__device__ __forceinline__ void p_convert_deferred(const Ctx& c, int worker, int nworkers, int tlo, int thi) {
    unsigned char* W = c.ws + WS_W; unsigned char* W1 = c.ws + WS_W1;
    constexpr int T_FFI = (4096 / 32) * (2 * DFF / 64), T_FFO = (DFF / 32) * (4096 / 64), T_IN1 = (4096 / 32) * (NO / 64), T_MIX = (4096 / 32) * (4096 / 64);
    constexpr int EM = T_MIX, E0 = EM + T_FFI, E1 = E0 + T_FFO, E2 = E1 + T_IN1, E3 = E2 + T_MIX, E4 = E3 + T_FFI, E5 = E4 + T_FFO;
    const int tend = thi < E5 ? thi : E5;
    for (int t = tlo + worker; t < tend; t += nworkers) {
        const float* src; int ld, K, tl; bf16_t* dst; int mixl = -1;
        if (t < EM) { src = c.in[I_WMIX]; ld = 4096; K = 4096; tl = t; dst = (bf16_t*)(W + W_MIX); mixl = 0; }
        else if (t < E0) { src = c.in[I_WFFI]; ld = 2 * DFF; K = 4096; tl = t - EM; dst = (bf16_t*)(W + W_FFI); }
        else if (t < E1) { src = c.in[I_WFFO]; ld = 4096; K = DFF; tl = t - E0; dst = (bf16_t*)(W + W_FFO); mixl = 3; }
        else if (t < E2) { src = c.in[I_WINO]; ld = NO; K = 4096; tl = t - E1; dst = (bf16_t*)(W + W_IN); }
        else if (t < E3) { src = c.in[I_WMIX] + (size_t)4096 * 4096; ld = 4096; K = 4096; tl = t - E2; dst = (bf16_t*)(W1 + W1_MIX); mixl = 1; }
        else if (t < E4) { src = c.in[I_WFFI] + (size_t)4096 * 2 * DFF; ld = 2 * DFF; K = 4096; tl = t - E3; dst = (bf16_t*)(W1 + W1_FFI); }
        else { src = c.in[I_WFFO] + (size_t)DFF * 4096; ld = 4096; K = DFF; tl = t - E4; dst = (bf16_t*)(W1 + W1_FFO); mixl = 2; }
        const int tk = K / 32, kt = tl % tk, ntile = tl / tk;
        int ncol = ntile * 64;
        if (ld == 2 * DFF) { const int tile = ncol >> 8, within = ncol & 255; ncol = within < 128 ? 128 * tile + within : DFF + 128 * tile + (within - 128); }
        const int nsrc = (ld == NO) ? in_odd_src(ntile * 64 + c.lane) : ncol + c.lane;
        if (FFN_I8 && ld == 2 * DFF) { const int off = CM_FFI + (t < E0 ? 0 : 2 * DFF); conv_wave_tile_q8(src, ld, kt * 32, nsrc, ntile * 64, (unsigned char*)dst, K, c.lane, i8_cmax(c, off), i8_cs(c, off)); }
        else if (FFO0_I8 && mixl == 3) conv_wave_tile_q8(src, ld, kt * 32, nsrc, ntile * 64, (unsigned char*)dst, K, c.lane, i8_cmax(c, CM_FFO0), i8_cs(c, CM_FFO0));
        else if (FFO1_I8 && mixl == 2) conv_wave_tile_q8(src, ld, kt * 32, nsrc, ntile * 64, (unsigned char*)dst, K, c.lane, i8_cmax(c, CM_FFO1), i8_cs(c, CM_FFO1));
        else if (MIX_I8 && mixl >= 0 && mixl < 2) conv_wave_tile_q8(src, ld, kt * 32, nsrc, ntile * 64, (unsigned char*)dst, K, c.lane, i8_cmax(c, CM_MIX + mixl * D), i8_cs(c, CM_MIX + mixl * D));
        else if (INO_I8 && ld == NO) conv_wave_tile_q8(src, ld, kt * 32, nsrc, ntile * 64, (unsigned char*)dst, K, c.lane, i8_cmax(c, CM_INO), i8_cs(c, CM_INO));
        else conv_wave_tile(src, ld, kt * 32, nsrc, ntile * 64, dst, K, c.lane);
    }
}

__device__ __forceinline__ void p_ctx_fix(const Ctx& c, const float* srcc, const float* gate, const float* slab, float* H) {
    for (int row = blockIdx.x * 8 + c.wave; row < TT; row += gridDim.x * 8) {
        if (row < TL) continue;
        const size_t ro = (size_t)(row - TL) * D;
#pragma unroll 4
        for (int i = 0; i < 16; ++i) { const int col = i * 256 + c.lane * 4;
            const f32x4 s4 = (*(const f32x4*)(slab + ro + col) + *(const f32x4*)(slab + (size_t)TC * D + ro + col)) + (*(const f32x4*)(slab + (size_t)2 * TC * D + ro + col) + *(const f32x4*)(slab + (size_t)3 * TC * D + ro + col));
            *(f32x4*)(H + (size_t)row * D + col) = *(const f32x4*)(srcc + ro + col) + *(const f32x4*)(gate + col) * s4; }
    }
}
template <int NPARTS = 1, bool Q8 = false>
__device__ __forceinline__ void p_norm_mod(const Ctx& c, const float* hl, const float* hc, int nrows, const float* mod, int shift_chunk, int scale_chunk) {
    bf16_t* XN = (bf16_t*)(c.ws + WS_XN);
    for (int row = blockIdx.x * 8 + c.wave; row < nrows; row += gridDim.x * 8) {
        const float* src = row < TL ? hl + (size_t)row * D : hc + (size_t)(row - TL) * D;
        f32x4 v[16]; float ss = 0.f;
#pragma unroll
        for (int i = 0; i < 16; ++i) { v[i] = *(const f32x4*)(src + i * 256 + c.lane * 4); ss += v[i][0] * v[i][0] + v[i][1] * v[i][1] + v[i][2] * v[i][2] + v[i][3] * v[i][3]; }
        ss = wave_sum(ss);
        const float rs = rsqrtf(ss * (1.0f / 4096.0f) + 1e-6f);
        const float* mp = mod + (size_t)row_modidx(row) * 24576;
        bf16_t* dst = XN + (size_t)row * D;
        if constexpr (Q8) {
            float mx = 0.f;
#pragma unroll
            for (int i = 0; i < 16; ++i) { const int col = i * 256 + c.lane * 4;
                const f32x4 sh = *(const f32x4*)(mp + shift_chunk * 4096 + col), sc = *(const f32x4*)(mp + scale_chunk * 4096 + col);
#pragma unroll
                for (int j = 0; j < 4; ++j) v[i][j] = v[i][j] * rs * (1.f + sc[j]) + sh[j];
                { const float a0 = v[i][0] + v[i][1], a1 = v[i][0] - v[i][1], a2 = v[i][2] + v[i][3], a3 = v[i][2] - v[i][3];
                  v[i][0] = a0 + a2; v[i][1] = a1 + a3; v[i][2] = a0 - a2; v[i][3] = a1 - a3; }
#pragma unroll
                for (int j = 0; j < 4; ++j) { float x = v[i][j];
                    { const float t = __int_as_float(__builtin_amdgcn_update_dpp(0, __float_as_int(x), 0xB1, 0xF, 0xF, false)); x = (c.lane & 1) ? t - x : x + t; }
                    { const float t = __int_as_float(__builtin_amdgcn_update_dpp(0, __float_as_int(x), 0x4E, 0xF, 0xF, false)); x = (c.lane & 2) ? t - x : x + t; }
                    { const float t = __int_as_float(__builtin_amdgcn_ds_swizzle(__float_as_int(x), 0x101F)); x = (c.lane & 4) ? t - x : x + t; }
                    v[i][j] = x; mx = fmaxf(mx, fabsf(x)); } }
#pragma unroll
            for (int o = 32; o >= 1; o >>= 1) mx = fmaxf(mx, __shfl_xor(mx, o));
            const float qs = mx > 0.f ? 127.0f / mx : 0.f;
            unsigned char* d8 = (unsigned char*)XN + (size_t)row * D;
#pragma unroll
            for (int i = 0; i < 16; ++i) *(unsigned*)(d8 + i * 256 + c.lane * 4) = pk_i8x4(v[i][0] * qs, v[i][1] * qs, v[i][2] * qs, v[i][3] * qs);
            if (c.lane == 0) ((float*)(c.ws + WS_XN + (size_t)TT * D))[row] = mx * (1.0f / 127.0f);
            continue;
        }
#pragma unroll
        for (int i = 0; i < 16; ++i) { const int col = i * 256 + c.lane * 4;
            f32x4 sh = *(const f32x4*)(mp + shift_chunk * 4096 + col), sc = *(const f32x4*)(mp + scale_chunk * 4096 + col);
            if constexpr (NPARTS == 4) {
                sh = (sh + *(const f32x4*)(mp + MOD_FLOATS + shift_chunk * 4096 + col)) + (*(const f32x4*)(mp + 2 * MOD_FLOATS + shift_chunk * 4096 + col) + *(const f32x4*)(mp + 3 * MOD_FLOATS + shift_chunk * 4096 + col));
                sc = (sc + *(const f32x4*)(mp + MOD_FLOATS + scale_chunk * 4096 + col)) + (*(const f32x4*)(mp + 2 * MOD_FLOATS + scale_chunk * 4096 + col) + *(const f32x4*)(mp + 3 * MOD_FLOATS + scale_chunk * 4096 + col)); }
            u32x2 w; w.x = pk_bf16(v[i][0] * rs * (1.f + sc[0]) + sh[0], v[i][1] * rs * (1.f + sc[1]) + sh[1]);
            w.y = pk_bf16(v[i][2] * rs * (1.f + sc[2]) + sh[2], v[i][3] * rs * (1.f + sc[3]) + sh[3]);
            *(u32x2*)(dst + col) = w; }
    }
}
__device__ __forceinline__ void p_final_norm(const Ctx& c) {
    const float* H = (const float*)(c.ws + WS_H);
    for (int row = blockIdx.x * 8 + c.wave; row < TL; row += gridDim.x * 8) {
        const float* src = H + (size_t)row * D;
        f32x4 v[16]; float ss = 0.f;
#pragma unroll
        for (int i = 0; i < 16; ++i) { v[i] = *(const f32x4*)(src + i * 256 + c.lane * 4); ss += v[i][0] * v[i][0] + v[i][1] * v[i][1] + v[i][2] * v[i][2] + v[i][3] * v[i][3]; }
        ss = wave_sum(ss);
        const float rs = rsqrtf(ss * (1.0f / 4096.0f) + 1e-6f);
        float* dst = c.out + (size_t)row * D;
#pragma unroll
        for (int i = 0; i < 16; ++i) { const int col = i * 256 + c.lane * 4; const f32x4 g = *(const f32x4*)(c.in[I_FNORM] + col);
            *(f32x4*)(dst + col) = v[i] * rs * g; }
    }
}

DI void rope_store(const f32x4 (&acc)[2][2][4][2], int ai, int m, const float* tc, const float* ts, bool rot, float scale, bf16_t* o1p, bf16_t* o2p) {
    float o1[8], o2[8];
#pragma unroll
    for (int n = 0; n < 2; ++n) { f32x4 cs = {1.f, 1.f, 1.f, 1.f}, sn = {0.f, 0.f, 0.f, 0.f};
        if (rot) { cs = *(const f32x4*)(tc + 4 * n); sn = *(const f32x4*)(ts + 4 * n); }
#pragma unroll
        for (int e = 0; e < 4; ++e) { const float x1 = acc[ai][0][m][n][e], x2 = acc[ai][1][m][n][e];
            o1[4 * n + e] = (x1 * cs[e] - x2 * sn[e]) * scale; o2[4 * n + e] = (x2 * cs[e] + x1 * sn[e]) * scale; } }
    u32x4 w1, w2; w1.x = pk_bf16(o1[0], o1[1]); w1.y = pk_bf16(o1[2], o1[3]); w1.z = pk_bf16(o1[4], o1[5]); w1.w = pk_bf16(o1[6], o1[7]);
    w2.x = pk_bf16(o2[0], o2[1]); w2.y = pk_bf16(o2[2], o2[3]); w2.z = pk_bf16(o2[4], o2[5]); w2.w = pk_bf16(o2[6], o2[7]);
    *(u32x4*)o1p = w1; *(u32x4*)o2p = w2;
}
DI void plain_store(const f32x4 (&acc)[2][2][4][2], int ai, int m, bf16_t* rowp) {
#pragma unroll
    for (int bj = 0; bj < 2; ++bj) { const f32x4 v0 = acc[ai][bj][m][0], v1 = acc[ai][bj][m][1];
        u32x4 w; w.x = pk_bf16(v0[0], v0[1]); w.y = pk_bf16(v0[2], v0[3]); w.z = pk_bf16(v1[0], v1[1]); w.w = pk_bf16(v1[2], v1[3]);
        *(u32x4*)(rowp + bj * 128) = w; }
}
DI void i8_prescale(f32x4 (&acc)[2][2][4][2], const float* SA, const float* CS, const pg8::Unit& u, int wr, int wc, int fr, int fq) {
    f32x4 cs[2][2];
#pragma unroll
    for (int bj = 0; bj < 2; ++bj)
#pragma unroll
        for (int n = 0; n < 2; ++n) cs[bj][n] = *(const f32x4*)(CS + u.pn * 256 + bj * 128 + wc * 32 + 8 * fq + 4 * n);
#pragma unroll
    for (int ai = 0; ai < 2; ++ai)
#pragma unroll
        for (int m = 0; m < 4; ++m) { const float s = SA[u.pm * 256 + ai * 128 + wr * 64 + 16 * m + fr];
#pragma unroll
            for (int bj = 0; bj < 2; ++bj)
#pragma unroll
                for (int n = 0; n < 2; ++n)
#pragma unroll
                    for (int e = 0; e < 4; ++e) acc[ai][bj][m][n][e] = (float)__float_as_int(acc[ai][bj][m][n][e]) * (s * cs[bj][n][e]); }
}
DI void i8_prescale_np(f32x4 (&acc)[2][2][4][2], const float* SA, const float* CS, const pg8::Unit& u, int wr, int wc, int fr, int fq) {
    f32x4 cs[2][2];
#pragma unroll
    for (int bj = 0; bj < 2; ++bj)
#pragma unroll
        for (int n = 0; n < 2; ++n) cs[bj][n] = *(const f32x4*)(CS + u.pn * 256 + wc * 32 + 4 * fq + bj * 128 + n * 16);
#pragma unroll
    for (int ai = 0; ai < 2; ++ai)
#pragma unroll
        for (int m = 0; m < 4; ++m) { const float s = SA[u.pm * 256 + ai * 128 + wr * 64 + 16 * m + fr];
#pragma unroll
            for (int bj = 0; bj < 2; ++bj)
#pragma unroll
                for (int n = 0; n < 2; ++n)
#pragma unroll
                    for (int e = 0; e < 4; ++e) acc[ai][bj][m][n][e] = (float)__float_as_int(acc[ai][bj][m][n][e]) * (s * cs[bj][n][e]); }
}
struct EpiInEven {
    static constexpr bool PERM = true, AFTER_DRAIN = false, I8 = false;
    bf16_t* PA; bf16_t* PB; const float* axc; const float* axs;
    DI void operator()(const f32x4 (&acc)[2][2][4][2], const pg8::Unit& u, int wr, int wc, int fr, int fq) const {
        const int row0 = u.pm * 256 + wr * 64 + fr, tq = u.pn - COLS_A_PAD / 256;
#pragma unroll
        for (int ai = 0; ai < 2; ++ai)
#pragma unroll
            for (int m = 0; m < 4; ++m) { const int row = row0 + ai * 128 + m * 16;
                if (tq < 0) plain_store(acc, ai, m, PA + (size_t)row * COLS_A_PAD + u.pn * 256 + wc * 32 + 8 * fq);
                else if (tq >= 16) plain_store(acc, ai, m, PB + (size_t)row * COLS_B + tq * 256 + wc * 32 + 8 * fq);
                else { const int pos = row & 4095; bf16_t* o = PB + (size_t)row * COLS_B + tq * 256 + wc * 64 + 8 * fq;
                    rope_store(acc, ai, m, axc + pos * 32 + 8 * fq, axs + pos * 32 + 8 * fq, row < TL, tq < 8 ? 0.18033688011112042f : 1.0f, o, o + 32); } }
    }
};
struct EpiInOdd {
    static constexpr bool PERM = true, AFTER_DRAIN = false, I8 = (INO_I8 != 0);
    bf16_t* P1; const float* axc; const float* axs; const float* rtc; const float* rts; const float* SA; const float* CS;
    DI void prescale(f32x4 (&acc)[2][2][4][2], const pg8::Unit& u, int wr, int wc, int fr, int fq) const { i8_prescale(acc, SA, CS, u, wr, wc, fr, fq); }
    DI void operator()(const f32x4 (&acc)[2][2][4][2], const pg8::Unit& u, int wr, int wc, int fr, int fq) const {
        const int row0 = u.pm * 256 + wr * 64 + fr, pn = u.pn;
#pragma unroll
        for (int ai = 0; ai < 2; ++ai)
#pragma unroll
            for (int m = 0; m < 4; ++m) { const int row = row0 + ai * 128 + m * 16; const bool lat = row < TL; const int pos = lat ? (row & 4095) : ((row - TL) & 255);
                if (pn < 9) { bf16_t* o = P1 + (size_t)row * NO + pn * 256 + wc * 64 + 8 * fq;
                    rope_store(acc, ai, m, axc + pos * 32 + 8 * fq, axs + pos * 32 + 8 * fq, lat, pn < 8 ? 0.18033688011112042f : 1.0f, o, o + 32); }
                else if (pn >= 10 && pn < 18) { const int rp = lat ? CTXL + pos : pos, i0 = 32 * (wc & 1) + 8 * fq; bf16_t* o = P1 + (size_t)row * NO + pn * 256 + (wc >> 1) * 128 + i0;
                    rope_store(acc, ai, m, rtc + rp * 64 + i0, rts + rp * 64 + i0, true, pn < 14 ? 0.08838834764831845f : 1.0f, o, o + 64); }
                else plain_store(acc, ai, m, P1 + (size_t)row * NO + pn * 256 + wc * 32 + 8 * fq); }
    }
};
struct CtxSplitOrder {
    int G, c, nNn, ntk;
    __device__ void init(int N, int G_, int c_, int K_) { G = G_; c = c_; nNn = N / 256; ntk = K_ / 64; }
    __device__ bool next(int i, pg8::Unit& u) const {
        const long L = (long)i * G + c; if (L >= 4 * nNn * 4) return false;
        const int j = (int)L, part = j & 3, tile = j >> 2; u.pm = 64 + (tile & 3); u.pn = tile >> 2; u.part = part;
        const int s0 = 2 * ((part * ntk) / 8), s1 = 2 * (((part + 1) * ntk) / 8); u.koff = s0 * 128; u.nt = s1 - s0; return true; }
    __device__ __forceinline__ void a_ready(const pg8::Unit&) const {}
    __device__ __forceinline__ void done(const pg8::Unit&) const {}
};
template <bool Q8>
struct EpiSlabT {
    static constexpr bool PERM = false, AFTER_DRAIN = false, I8 = Q8;
    float* slab; const float* SA; const float* CS;
    DI void prescale(f32x4 (&acc)[2][2][4][2], const pg8::Unit& u, int wr, int wc, int fr, int fq) const { i8_prescale_np(acc, SA, CS, u, wr, wc, fr, fq); }
    DI void operator()(const f32x4 (&acc)[2][2][4][2], const pg8::Unit& u, int wr, int wc, int fr, int fq) const {
        const int row0 = u.pm * 256 + wr * 64 + fr, col0 = u.pn * 256 + wc * 32 + 4 * fq;
        float* sb = slab + ((size_t)u.part * TC + (row0 - TL)) * D + col0;
#pragma unroll
        for (int ai = 0; ai < 2; ++ai)
#pragma unroll
            for (int m = 0; m < 4; ++m)
#pragma unroll
                for (int bj = 0; bj < 2; ++bj)
#pragma unroll
                    for (int n = 0; n < 2; ++n) *(f32x4*)(sb + (size_t)(ai * 128 + m * 16) * D + bj * 128 + n * 16) = acc[ai][bj][m][n];
    }
};
struct LatThenCtxOrder : pg8::StaticOrder {
    int nNn;
    __device__ void init2(int N, int G_, int c_, int K_) { init(TL, N, G_, c_, K_); nNn = N / 256; }
    __device__ bool next(int i, pg8::Unit& u) const {
        const long L = (long)i * G + c; if (L < nwg) return pg8::StaticOrder::next(i, u);
        const int j = (int)(L - nwg); if (j >= 4 * nNn) return false;
        u.pm = 64 + (j & 3); u.pn = j >> 2; u.koff = 0; u.nt = ntk; u.part = -1; return true; }
};
struct LoraOrder : LatThenCtxOrder {
    __device__ bool next(int i, pg8::Unit& u) const { if (!LatThenCtxOrder::next(i, u)) return false; u.koff = (u.pn >> 3) * (LORA_KU * 2); u.nt = LORA_KU / 64; return true; }
};
struct OddInOrder : pg8::StaticOrder {
    __device__ void init2(int G_, int c_, int K_) { init(TL, NO, G_, c_, K_); }
    __device__ bool next(int i, pg8::Unit& u) const {
        const long L = (long)i * G + c; if (L < nwg) return pg8::StaticOrder::next(i, u);
        const int j = (int)(L - nwg); if (j >= 4 * 14) return false;
        const int idx = j >> 2; u.pm = 64 + (j & 3); u.pn = idx < 2 ? 8 + idx : 12 + idx; u.koff = 0; u.nt = ntk; u.part = -1; return true; }
};
template <bool Q8>
struct EpiResModT {
    static constexpr bool PERM = false, AFTER_DRAIN = false, I8 = Q8;
    const float* Rlat; const float* Rctx; float* Hout; const float* mod;
    const float* SA; const float* CS;
    DI void prescale(f32x4 (&acc)[2][2][4][2], const pg8::Unit& u, int wr, int wc, int fr, int fq) const { i8_prescale_np(acc, SA, CS, u, wr, wc, fr, fq); }
    DI void operator()(const f32x4 (&acc)[2][2][4][2], const pg8::Unit& u, int wr, int wc, int fr, int fq) const {
        const int row0 = u.pm * 256 + wr * 64 + fr, col0 = u.pn * 256 + wc * 32 + 4 * fq;
        const float* mp = mod + (size_t)(u.pm < 64 ? (u.pm >> 4) : 4) * 24576 + col0;
        f32x4 mv[2][2];
#pragma unroll
        for (int bj = 0; bj < 2; ++bj)
#pragma unroll
            for (int n = 0; n < 2; ++n) mv[bj][n] = *(const f32x4*)(mp + bj * 128 + n * 16);
        const float* sbase = (u.pm < 64) ? Rlat + (size_t)row0 * D : Rctx + (size_t)(row0 - TL) * D;
        float* dbase = Hout + (size_t)row0 * D;
#pragma unroll
        for (int ai = 0; ai < 2; ++ai)
#pragma unroll
            for (int m = 0; m < 4; ++m) { const size_t ro = (size_t)(ai * 128 + m * 16) * D + col0;
#pragma unroll
                for (int bj = 0; bj < 2; ++bj)
#pragma unroll
                    for (int n = 0; n < 2; ++n) { const f32x4 r = *(const f32x4*)(sbase + ro + bj * 128 + n * 16);
                        *(f32x4*)(dbase + ro + bj * 128 + n * 16) = r + mv[bj][n] * acc[ai][bj][m][n]; } }
    }
};

typedef EpiResModT<false> EpiResMod;
typedef EpiSlabT<false> EpiSlab;
struct EpiConvGlu {
    static constexpr bool PERM = true, AFTER_DRAIN = false, I8 = (FFN_I8 != 0);
    bf16_t* HID; bf16_t* SG; bf16_t* SU; const float* cw; const float* cb; const float* SA; const float* CS;
    DI void prescale(f32x4 (&acc)[2][2][4][2], const pg8::Unit& u, int wr, int wc, int fr, int fq) const { i8_prescale(acc, SA, CS, u, wr, wc, fr, fq); }
    DI void operator()(const f32x4 (&acc)[2][2][4][2], const pg8::Unit& u, int wr, int wc, int fr, int fq) const {
        const int col = u.pn * 128 + wc * 32 + 8 * fq;
#pragma unroll
        for (int ai = 0; ai < 2; ++ai) {
            const int rowb = u.pm * 256 + ai * 128 + wr * 64;
#pragma unroll
            for (int n = 0; n < 2; ++n) {
                const f32x4 w0 = *(const f32x4*)(cw + col + 4 * n), w1 = *(const f32x4*)(cw + DFF + col + 4 * n), w2 = *(const f32x4*)(cw + 2 * DFF + col + 4 * n), bb = *(const f32x4*)(cb + col + 4 * n);
                unsigned outp[4][2];
#pragma unroll
                for (int ep = 0; ep < 2; ++ep) { float o[4][2];
#pragma unroll
                    for (int e2 = 0; e2 < 2; ++e2) { const int e = 2 * ep + e2; float P[4], N[4];
#pragma unroll
                        for (int m = 0; m < 4; ++m) { const int vi = __float_as_int(acc[ai][0][m][n][e]);
                            P[m] = __int_as_float(__builtin_amdgcn_update_dpp(0, vi, 0x121, 0xF, 0xF, false)); N[m] = __int_as_float(__builtin_amdgcn_update_dpp(0, vi, 0x12F, 0xF, 0xF, false)); }
#pragma unroll
                        for (int m = 0; m < 4; ++m) { const float prev = fr > 0 ? P[m] : (m > 0 ? P[m - 1] : 0.f), next = fr < 15 ? N[m] : (m < 3 ? N[m + 1] : 0.f);
                            const float x = w0[e] * prev + w1[e] * acc[ai][0][m][n][e] + w2[e] * next + bb[e];
                            o[m][e2] = silu_f(x) * acc[ai][1][m][n][e]; } }
#pragma unroll
                    for (int m = 0; m < 4; ++m) outp[m][ep] = pk_bf16(o[m][0], o[m][1]); }
#pragma unroll
                for (int m = 0; m < 4; ++m) { const int rho = 16 * m + fr, row = rowb + rho;
                    if (rho != 0 && rho != 63) { u32x2 w = {outp[m][0], outp[m][1]}; *(u32x2*)(HID + (size_t)row * DFF + col + 4 * n) = w; }
                    if (m == 0 || m == 3) { if (rho <= 1 || rho >= 62) { const int slot = rho <= 1 ? rho : rho - 60;
                            u32x2 g; g.x = pk_bf16(acc[ai][0][m][n][0], acc[ai][0][m][n][1]); g.y = pk_bf16(acc[ai][0][m][n][2], acc[ai][0][m][n][3]);
                            *(u32x2*)(SG + ((size_t)(row >> 6) * 4 + slot) * DFF + col + 4 * n) = g;
                            if (rho == 0 || rho == 63) { u32x2 q; q.x = pk_bf16(acc[ai][1][m][n][0], acc[ai][1][m][n][1]); q.y = pk_bf16(acc[ai][1][m][n][2], acc[ai][1][m][n][3]);
                                *(u32x2*)(SU + ((size_t)(row >> 6) * 2 + (rho == 63 ? 1 : 0)) * DFF + col + 4 * n) = q; } } }
                }
            }
        }
    }
};
__device__ __forceinline__ void p_conv_fix(const Ctx& c, int l, int nrows) {
    const bf16_t* SG = (const bf16_t*)(c.ar + AR_SG); const bf16_t* SU = (const bf16_t*)(c.ar + AR_SU); bf16_t* HID = (bf16_t*)(c.ar + AR_HID);
    const float* cw = c.in[I_CONVW] + (size_t)l * 3 * DFF; const float* cb = c.in[I_CONVB] + (size_t)l * DFF;
    const int nitems = (nrows / 64) * 2 * 22;
    const u32x4 z4 = {0u, 0u, 0u, 0u};
    for (int item = blockIdx.x * 8 + c.wave; item < nitems; item += gridDim.x * 8) {
        const int ch = item % 22, kw = item / 22, kb = kw >> 1, last = kw & 1, col = ch * 512 + c.lane * 8;
        if (col >= DFF) continue;
        const int row = kb * 64 + (last ? 63 : 0);
        int pos, len; if (row < TL) { pos = row & 4095; len = 4096; } else { pos = (row - TL) & 255; len = 256; }
        u32x4 gp, gc, gn;
        if (!last) { gp = pos > 0 ? *(const u32x4*)(SG + ((size_t)(kb - 1) * 4 + 3) * DFF + col) : z4; gc = *(const u32x4*)(SG + ((size_t)kb * 4 + 0) * DFF + col); gn = *(const u32x4*)(SG + ((size_t)kb * 4 + 1) * DFF + col); }
        else { gp = *(const u32x4*)(SG + ((size_t)kb * 4 + 2) * DFF + col); gc = *(const u32x4*)(SG + ((size_t)kb * 4 + 3) * DFF + col); gn = pos < len - 1 ? *(const u32x4*)(SG + ((size_t)(kb + 1) * 4 + 0) * DFF + col) : z4; }
        const u32x4 up = *(const u32x4*)(SU + ((size_t)kb * 2 + last) * DFF + col);
        float w0[8], w1[8], w2[8], bb[8]; load8f(cw + col, w0); load8f(cw + DFF + col, w1); load8f(cw + 2 * DFF + col, w2); load8f(cb + col, bb);
        float o[8];
#pragma unroll
        for (int j = 0; j < 4; ++j) {
            const float x0 = bflo(gp[j]) * w0[2 * j] + bflo(gc[j]) * w1[2 * j] + bflo(gn[j]) * w2[2 * j] + bb[2 * j];
            const float x1 = bfhi(gp[j]) * w0[2 * j + 1] + bfhi(gc[j]) * w1[2 * j + 1] + bfhi(gn[j]) * w2[2 * j + 1] + bb[2 * j + 1];
            o[2 * j] = silu_f(x0) * bflo(up[j]); o[2 * j + 1] = silu_f(x1) * bfhi(up[j]); }
        u32x4 w; w.x = pk_bf16(o[0], o[1]); w.y = pk_bf16(o[2], o[3]); w.z = pk_bf16(o[4], o[5]); w.w = pk_bf16(o[6], o[7]);
        *(u32x4*)(HID + (size_t)row * DFF + col) = w;
    }
}

DI void unpack8(const u32x4 w, float (&o)[8]) {
#pragma unroll
    for (int j = 0; j < 4; ++j) { o[2 * j] = bflo(w[j]); o[2 * j + 1] = bfhi(w[j]); }
}
DI u32x4 pack8_bf16(const float (&o)[8]) { u32x4 w; w.x = pk_bf16(o[0], o[1]); w.y = pk_bf16(o[2], o[3]); w.z = pk_bf16(o[4], o[5]); w.w = pk_bf16(o[6], o[7]); return w; }
DI u32x4 pack8_f16(const float (&o)[8]) { u32x4 w; w.x = pk_f16(o[0], o[1]); w.y = pk_f16(o[2], o[3]); w.z = pk_f16(o[4], o[5]); w.w = pk_f16(o[6], o[7]); return w; }
DI void unpack8_f16(const u32x4 w, float (&o)[8]) {
#pragma unroll
    for (int j = 0; j < 4; ++j) { o[2 * j] = h16lo(w[j]); o[2 * j + 1] = h16hi(w[j]); }
}
DI void row_pos(int row, int& pos, int& len) { if (row < TL) { pos = row & 4095; len = 4096; } else { pos = (row - TL) & 255; len = 256; } }

__device__ __forceinline__ void p_rwkv_prepA(const Ctx& c) {
    const bf16_t* PA = (const bf16_t*)(c.ar + AR_PA);
    h16* R16 = (h16*)(c.ar + AR_R); h16* KK16 = (h16*)(c.ar + AR_KK); h16* V16 = (h16*)(c.ar + AR_V); bf16_t* K16 = (bf16_t*)(c.ar + AR_K); bf16_t* LA = (bf16_t*)(c.ar + AR_LA);
    const float* mu = c.in[I_MU]; const float* k_k = c.in[I_KK];
    const int lane = c.lane;
    for (int row = blockIdx.x * 8 + c.wave; row < TT; row += gridDim.x * 8) {
        int pos, len; row_pos(row, pos, len);
        const bool hasp = pos > 0, hasn = pos < len - 1;
        const bf16_t* pc = PA + (size_t)row * COLS_A_PAD;
        for (int it = 0; it < 14; ++it) {
            const int col = it * 512 + lane * 8;
            if (col >= COLS_A) break;
            float cur[8], prv[8], nxt[8], m8[8], mx[8];
            unpack8(*(const u32x4*)(pc + col), cur);
            if (hasp) unpack8(*(const u32x4*)(pc - COLS_A_PAD + col), prv); else {
#pragma unroll
                for (int j = 0; j < 8; ++j) prv[j] = 0.f; }
            if (hasn) unpack8(*(const u32x4*)(pc + COLS_A_PAD + col), nxt); else {
#pragma unroll
                for (int j = 0; j < 8; ++j) nxt[j] = 0.f; }
            load8f(mu + col, m8);
#pragma unroll
            for (int j = 0; j < 8; ++j) mx[j] = cur[j] + m8[j] * (0.5f * (prv[j] + nxt[j]) - cur[j]);
            if (it < 4) {
                *(u32x4*)(R16 + (size_t)row * 2048 + col) = pack8_f16(mx);
            } else if (it < 8) {
                const int j0 = col - 2048;
                *(u32x4*)(K16 + (size_t)row * 2048 + j0) = pack8_bf16(mx);
                float kk8[8], x[8]; load8f(k_k + j0, kk8); float ss = 0.f;
#pragma unroll
                for (int j = 0; j < 8; ++j) { x[j] = mx[j] * kk8[j]; ss += x[j] * x[j]; }
                ss += __shfl_xor(ss, 1); ss += __shfl_xor(ss, 2); ss += __shfl_xor(ss, 4);
                const float rn = rsqrtf(ss + 1e-12f);
#pragma unroll
                for (int j = 0; j < 8; ++j) x[j] *= rn;
                *(u32x4*)(KK16 + (size_t)row * 2048 + j0) = pack8_f16(x);
            } else if (it < 12) {
                *(u32x4*)(V16 + (size_t)row * 2048 + (col - 4096)) = pack8_f16(mx);
            } else {
                const int q0 = col - 6144; float o[8];
#pragma unroll
                for (int j = 0; j < 8; ++j) o[j] = q0 < 192 ? (1.0f - 2.0f * __builtin_amdgcn_rcpf(1.0f + __expf(2.0f * mx[j]))) : (q0 < 384 ? mx[j] : sigmoid_f(mx[j]));
                const int seg = q0 < 384 ? q0 / 96 : 4, off = q0 - (seg < 4 ? seg * 96 : 384);
                *(u32x4*)(LA + (size_t)row * LORA_K + seg * LORA_KU + off) = pack8_bf16(o);
            }
        }
        {
            const u32x4 z4 = {0u, 0u, 0u, 0u};
            for (int z = lane; z < 80; z += 64) *(u32x4*)(LA + (size_t)row * LORA_K + (z / 20) * LORA_KU + 96 + (z % 20) * 8) = z4; }
    }
}

DI int kperm16(int o) { return (o & ~12) | ((o >> 1) & 4) | ((o << 1) & 8); }
template <int DVW  , int NHEAD>
__device__ __forceinline__ void p_build_vt(const Ctx& c, const bf16_t* P, int ldp, int vcol0, bf16_t* VT) {
    constexpr int NSLAB = (DVW * NHEAD) / 512 > 0 ? (DVW * NHEAD) / 512 : 1;
    constexpr int SLABW = (DVW * NHEAD) < 512 ? (DVW * NHEAD) : 512;
    LAS unsigned short* T = (LAS unsigned short*)c.lds;
    const int tid = c.tid;
    for (int item = blockIdx.x; item < (TT / 64) * NSLAB; item += gridDim.x) {
        const int kg = item / NSLAB, slab = item % NSLAB;
        const int row0 = kg * 64;
        int b, key0; if (row0 < TL) { b = row0 >> 12; key0 = row0 & 4095; } else { b = (row0 - TL) >> 8; key0 = 4096 + ((row0 - TL) & 255); }
        { const int key = tid >> 3, part = tid & 7; const int kp = (key & ~15) | kperm16(key & 15);
          constexpr int CPT = SLABW / 8;
          const bf16_t* src = P + (size_t)(row0 + key) * ldp + vcol0 + slab * SLABW + part * CPT;
#pragma unroll
          for (int e = 0; e < CPT / 8; ++e) { const u32x4 w = *(const u32x4*)(src + e * 8);
#pragma unroll
              for (int j = 0; j < 4; ++j) { T[(part * CPT + e * 8 + 2 * j) * 72 + kp] = (unsigned short)(w[j] & 0xffffu); T[(part * CPT + e * 8 + 2 * j + 1) * 72 + kp] = (unsigned short)(w[j] >> 16); } }
        }
        __syncthreads();
        for (int q = tid; q < SLABW * 8; q += NTHREADS) { const int col = q >> 3, ch = q & 7;
            const u32x4 w = *(const LAS u32x4*)(T + col * 72 + ch * 8);
            const int gc = slab * SLABW + col, head = gc / DVW, dv = gc % DVW;
            *(u32x4*)(VT + (((size_t)b * NHEAD + head) * DVW + dv) * NKEY + key0 + ch * 8) = w; }
        __syncthreads();
    }
}

struct EpiLora {
    static constexpr bool PERM = true, AFTER_DRAIN = false, I8 = false;
    const float* w0; const float* a0; const float* k_a; const bf16_t* K16; const h16* KK16; h16* OMW; h16* BB; h16* KD; bf16_t* G;
    DI void operator()(const f32x4 (&acc)[2][2][4][2], const pg8::Unit& u, int wr, int wc, int fr, int fq) const {
        const int type = u.pn >> 3, row0 = u.pm * 256 + wr * 64 + fr;
#pragma unroll
        for (int bj = 0; bj < 2; ++bj) {
            const int jc = (u.pn & 7) * 256 + bj * 128 + wc * 32 + 8 * fq;
            if (type < 2) {
                float w8[8]; load8f(w0 + type * 2048 + jc, w8);
#pragma unroll
                for (int ai = 0; ai < 2; ++ai)
#pragma unroll
                    for (int m = 0; m < 4; ++m) { const int row = row0 + ai * 128 + m * 16; float o[8];
#pragma unroll
                        for (int i = 0; i < 8; ++i) { const float w = w8[i] + (i < 4 ? acc[ai][bj][m][0][i & 3] : acc[ai][bj][m][1][i & 3]);
                            o[i] = 1.0f - __expf(-0.60653066f * sigmoid_f(w)); }
                        *(u32x4*)(OMW + ((size_t)type * TT + row) * 2048 + jc) = pack8_f16(o); }
            } else if (type < 4) {
                const int d = type - 2; float a8[8], ka8[8]; load8f(a0 + d * 2048 + jc, a8); load8f(k_a + jc, ka8);
#pragma unroll
                for (int ai = 0; ai < 2; ++ai)
#pragma unroll
                    for (int m = 0; m < 4; ++m) { const int row = row0 + ai * 128 + m * 16; float kd[8], bb[8], k8[8], kk8[8];
                        unpack8(*(const u32x4*)(K16 + (size_t)row * 2048 + jc), k8); unpack8_f16(*(const u32x4*)(KK16 + (size_t)row * 2048 + jc), kk8);
#pragma unroll
                        for (int i = 0; i < 8; ++i) { const float a = sigmoid_f(a8[i] + (i < 4 ? acc[ai][bj][m][0][i & 3] : acc[ai][bj][m][1][i & 3]));
                            kd[i] = k8[i] * (1.0f + (a - 1.0f) * ka8[i]); bb[i] = kk8[i] * a; }
                        *(u32x4*)(KD + ((size_t)d * TT + row) * 2048 + jc) = pack8_f16(kd);
                        *(u32x4*)(BB + ((size_t)d * TT + row) * 2048 + jc) = pack8_f16(bb); }
            } else {
#pragma unroll
                for (int ai = 0; ai < 2; ++ai)
#pragma unroll
                    for (int m = 0; m < 4; ++m) { const int row = row0 + ai * 128 + m * 16; float o[8];
#pragma unroll
                        for (int i = 0; i < 8; ++i) o[i] = (i < 4 ? acc[ai][bj][m][0][i & 3] : acc[ai][bj][m][1][i & 3]);
                        *(u32x4*)(G + (size_t)row * 2048 + jc) = pack8_bf16(o); }
            }
        }
    }
};

#define MFMA32(a, b, cacc) __builtin_amdgcn_mfma_f32_32x32x16_bf16((a), (b), (cacc), 0, 0, 0)
DI bf16x8 ld_frag(const bf16_t* p) { return __builtin_bit_cast(bf16x8, *(const u32x4*)p); }
DI bf16x8 pack_p(const f32x16& x, int s) { u32x4 w; w.x = pk_bf16(x[8 * s], x[8 * s + 1]); w.y = pk_bf16(x[8 * s + 2], x[8 * s + 3]); w.z = pk_bf16(x[8 * s + 4], x[8 * s + 5]); w.w = pk_bf16(x[8 * s + 6], x[8 * s + 7]); return __builtin_bit_cast(bf16x8, w); }
constexpr float LOG2E = 1.44269504088896f;

DI void fwht8x4(float (&x)[8], int lane) {
#pragma unroll
    for (int h = 1; h < 8; h <<= 1)
#pragma unroll
        for (int i = 0; i < 8; i += 2 * h)
#pragma unroll
            for (int j = i; j < i + h; ++j) { const float a = x[j], b = x[j + h]; x[j] = a + b; x[j + h] = a - b; }
#pragma unroll
    for (int j = 0; j < 8; ++j) { float v = x[j];
        { const float t = __int_as_float(__builtin_amdgcn_update_dpp(0, __float_as_int(v), 0xB1, 0xF, 0xF, false)); v = (lane & 1) ? t - v : v + t; }
        { const float t = __int_as_float(__builtin_amdgcn_update_dpp(0, __float_as_int(v), 0x4E, 0xF, 0xF, false)); v = (lane & 2) ? t - v : v + t; }
        x[j] = v; }
}
DI float wave_max(float v) {
#pragma unroll
    for (int o = 32; o >= 1; o >>= 1) v = fmaxf(v, __shfl_xor(v, o));
    return v;
}
__device__ __forceinline__ void p_rwkv_out(const Ctx& c, int nrows) {
    const bf16_t* Yf = (const bf16_t*)(c.ar + AR_Y); const bf16_t* Yb = Yf + (size_t)TT * 2048;
    const h16* R16 = (const h16*)(c.ar + AR_R); const h16* V16 = (const h16*)(c.ar + AR_V);
    const h16* KDf = (const h16*)(c.ar + AR_KD); const h16* KDb = KDf + (size_t)TT * 2048;
    const bf16_t* G = (const bf16_t*)(c.ar + AR_G); bf16_t* MIX = (bf16_t*)(c.ws + WS_XN);
    const float* r_k = c.in[I_RK]; const float* ln_w = c.in[I_LNW]; const float* ln_b = c.in[I_LNB];
    const int lane = c.lane;
    for (int row = blockIdx.x * 8 + c.wave; row < nrows; row += gridDim.x * 8) {
        float ov[4][8];
#pragma unroll
        for (int it = 0; it < 4; ++it) {
            const int col = it * 512 + lane * 8; const size_t o = (size_t)row * 2048 + col;
            float yf[8], yb[8], y[8], r8[8], v8[8], kf[8], kb[8], g8[8], rk8[8], lw[8], lb[8];
            unpack8(*(const u32x4*)(Yf + o), yf); unpack8(*(const u32x4*)(Yb + o), yb);
            unpack8_f16(*(const u32x4*)(R16 + o), r8); unpack8_f16(*(const u32x4*)(V16 + o), v8);
            unpack8_f16(*(const u32x4*)(KDf + o), kf); unpack8_f16(*(const u32x4*)(KDb + o), kb);
            unpack8(*(const u32x4*)(G + o), g8);
            load8f(r_k + col, rk8); load8f(ln_w + col, lw); load8f(ln_b + col, lb);
            float sm = 0.f, bn = 0.f;
#pragma unroll
            for (int j = 0; j < 8; ++j) { y[j] = yf[j] + yb[j]; sm += y[j]; bn += r8[j] * (kf[j] + kb[j]) * rk8[j]; }
            sm += __shfl_xor(sm, 1); sm += __shfl_xor(sm, 2); sm += __shfl_xor(sm, 4);
            bn += __shfl_xor(bn, 1); bn += __shfl_xor(bn, 2); bn += __shfl_xor(bn, 4);
            const float mean = sm * (1.0f / 64.0f); float vs = 0.f;
#pragma unroll
            for (int j = 0; j < 8; ++j) { const float dlt = y[j] - mean; vs += dlt * dlt; }
            vs += __shfl_xor(vs, 1); vs += __shfl_xor(vs, 2); vs += __shfl_xor(vs, 4);
            const float rs = rsqrtf(vs * (1.0f / 64.0f) + 64e-5f);
            float o8[8];
#pragma unroll
            for (int j = 0; j < 8; ++j) o8[j] = ((y[j] - mean) * rs * lw[j] + lb[j] + bn * v8[j]) * g8[j];
            if (MIX_I8) {
#pragma unroll
                for (int j = 0; j < 8; ++j) ov[it][j] = o8[j]; }
            else *(u32x4*)(MIX + (size_t)row * D + col) = pack8_bf16(o8);
        }
        if (MIX_I8) {
            float av[4][8]; float mx = 0.f;
#pragma unroll
            for (int it = 0; it < 4; ++it) { unpack8(*(const u32x4*)(MIX + (size_t)row * D + 2048 + it * 512 + lane * 8), av[it]);
                fwht8x4(ov[it], lane); fwht8x4(av[it], lane);
#pragma unroll
                for (int j = 0; j < 8; ++j) mx = fmaxf(mx, fmaxf(fabsf(ov[it][j]), fabsf(av[it][j]))); }
            mx = wave_max(mx);
            const float qs = mx > 0.f ? 127.0f / mx : 0.f;
            unsigned char* xq = c.ar + AR_XQ + (size_t)row * D;
#pragma unroll
            for (int it = 0; it < 4; ++it) {
                u32x2 w0 = {pk_i8x4(ov[it][0] * qs, ov[it][1] * qs, ov[it][2] * qs, ov[it][3] * qs), pk_i8x4(ov[it][4] * qs, ov[it][5] * qs, ov[it][6] * qs, ov[it][7] * qs)};
                u32x2 w1 = {pk_i8x4(av[it][0] * qs, av[it][1] * qs, av[it][2] * qs, av[it][3] * qs), pk_i8x4(av[it][4] * qs, av[it][5] * qs, av[it][6] * qs, av[it][7] * qs)};
                *(u32x2*)(xq + it * 512 + lane * 8) = w0; *(u32x2*)(xq + 2048 + it * 512 + lane * 8) = w1; }
            if (lane == 0) ((float*)(c.ar + AR_XQS))[row] = mx * (1.0f / 127.0f);
        }
    }
}
__device__ __forceinline__ void p_quant_hid(const Ctx& c, int nrows) {
    const bf16_t* HID = (const bf16_t*)(c.ar + AR_HID); const int lane = c.lane;
    for (int row = blockIdx.x * 8 + c.wave; row < nrows; row += gridDim.x * 8) {
        u32x4 pk[22]; float mx = 0.f;
#pragma unroll
        for (int it = 0; it < 22; ++it) { const int col = it * 512 + lane * 8; pk[it] = col < DFF ? *(const u32x4*)(HID + (size_t)row * DFF + col) : (u32x4){0u, 0u, 0u, 0u}; }
#pragma unroll
        for (int it = 0; it < 22; ++it) { float x[8]; unpack8(pk[it], x); fwht8x4(x, lane);
#pragma unroll
            for (int j = 0; j < 8; ++j) mx = fmaxf(mx, fabsf(x[j])); }
        mx = wave_max(mx);
        const float qs = mx > 0.f ? 127.0f / mx : 0.f;
        unsigned char* hq = c.ar + AR_HQ + (size_t)row * DFF;
#pragma unroll
        for (int it = 0; it < 22; ++it) { float x[8]; unpack8(pk[it], x); fwht8x4(x, lane); const int col = it * 512 + lane * 8;
            u32x2 w = {pk_i8x4(x[0] * qs, x[1] * qs, x[2] * qs, x[3] * qs), pk_i8x4(x[4] * qs, x[5] * qs, x[6] * qs, x[7] * qs)};
            if (col < DFF) *(u32x2*)(hq + col) = w; }
        if (lane == 0) ((float*)(c.ar + AR_HQS))[row] = mx * (1.0f / 127.0f);
    }
}
__device__ __forceinline__ void p_quant_mix(const Ctx& c, int nrows) {
    const bf16_t* MIX = (const bf16_t*)(c.ws + WS_XN); const int lane = c.lane;
    for (int row = blockIdx.x * 8 + c.wave; row < nrows; row += gridDim.x * 8) {
        float x[8][8]; float mx = 0.f;
#pragma unroll
        for (int it = 0; it < 8; ++it) { unpack8(*(const u32x4*)(MIX + (size_t)row * D + it * 512 + lane * 8), x[it]); fwht8x4(x[it], lane);
#pragma unroll
            for (int j = 0; j < 8; ++j) mx = fmaxf(mx, fabsf(x[it][j])); }
        mx = wave_max(mx);
        const float qs = mx > 0.f ? 127.0f / mx : 0.f;
        unsigned char* xq = c.ar + AR_XQ + (size_t)row * D;
#pragma unroll
        for (int it = 0; it < 8; ++it) { u32x2 w = {pk_i8x4(x[it][0] * qs, x[it][1] * qs, x[it][2] * qs, x[it][3] * qs), pk_i8x4(x[it][4] * qs, x[it][5] * qs, x[it][6] * qs, x[it][7] * qs)};
            *(u32x2*)(xq + it * 512 + lane * 8) = w; }
        if (lane == 0) ((float*)(c.ar + AR_XQS))[row] = mx * (1.0f / 127.0f);
    }
}

constexpr int K1_WAVE_LDS = 35328;
constexpr size_t TT_ROWS2048 = (size_t)TT * 2048;
#define WAVE_SYNC() do { asm volatile("s_waitcnt lgkmcnt(0)" ::: "memory"); __builtin_amdgcn_wave_barrier(); } while (0)
DI int rw_row(int b, int dir, int t) { return t < CTXL ? TL + b * CTXL + (dir ? (CTXL - 1 - t) : t) : b * SEQ + (dir ? (SEQ - 1 - (t - CTXL)) : (t - CTXL)); }
DI float bfu(unsigned short x) { return __uint_as_float((unsigned)x << 16); }
DI bf16x8 colfrag_nat(const LAS unsigned short* T, int col, int t0) { u32x4 w;
#pragma unroll
    for (int j = 0; j < 4; ++j) w[j] = (unsigned)T[(t0 + 2 * j) * 64 + col] | ((unsigned)T[(t0 + 2 * j + 1) * 64 + col] << 16);
    return __builtin_bit_cast(bf16x8, w); }
DI bf16x8 colfrag_nat_scaled(const LAS unsigned short* T, int col, int t0, float sc) { u32x4 w;
#pragma unroll
    for (int j = 0; j < 4; ++j) w[j] = pk_bf16(bfu(T[(t0 + 2 * j) * 64 + col]) * sc, bfu(T[(t0 + 2 * j + 1) * 64 + col]) * sc);
    return __builtin_bit_cast(bf16x8, w); }
DI bf16x8 colfrag_pk_scaled(const LAS unsigned short* T, int col, int s, int hh, float sc) { u32x4 w;
#pragma unroll
    for (int j2 = 0; j2 < 4; ++j2) { const int j = 2 * j2, t = 16 * s + 8 * (j >> 2) + 4 * hh + (j & 3);
        w[j2] = pk_bf16(bfu(T[t * 64 + col]) * sc, bfu(T[(t + 1) * 64 + col]) * sc); }
    return __builtin_bit_cast(bf16x8, w); }
DI bf16x8 rowfrag_nat(const LAS unsigned short* A, int row, int s, int hh) { const LAS u32x2* p = (const LAS u32x2*)(A + row * 40 + 16 * s + 8 * hh); const u32x2 a = p[0], b = p[1];
    u32x4 w = {a.x, a.y, b.x, b.y}; return __builtin_bit_cast(bf16x8, w); }
DI bf16x8 rowfrag_pk(const LAS unsigned short* A, int row, int s, int hh) { const u32x2 a = *(const LAS u32x2*)(A + row * 40 + 16 * s + 4 * hh), b = *(const LAS u32x2*)(A + row * 40 + 16 * s + 8 + 4 * hh);
    u32x4 w = {a.x, a.y, b.x, b.y}; return __builtin_bit_cast(bf16x8, w); }
DI u32x4 pack_pu(const f32x16& x, int s) { u32x4 w; w.x = pk_bf16(x[8 * s], x[8 * s + 1]); w.y = pk_bf16(x[8 * s + 2], x[8 * s + 3]); w.z = pk_bf16(x[8 * s + 4], x[8 * s + 5]); w.w = pk_bf16(x[8 * s + 6], x[8 * s + 7]); return w; }

__device__ __forceinline__ void rwkv_k1_chunk(const Ctx& c, LAS unsigned char* wl, int seq, int ch) {
    const int dir = seq & 1, h = (seq >> 1) & 31, b = seq >> 6;
    const int lane = c.lane, r = lane & 31, hh = lane >> 5;
    LAS unsigned short* TA = (LAS unsigned short*)wl; LAS unsigned short* TB = TA + 2048; LAS unsigned short* TK = TB + 2048; LAS unsigned short* TR = TK + 2048; LAS unsigned short* TVv = TR + 2048;
    LAS float* GC = (LAS float*)(wl + 20480); LAS float* LAB = (LAS float*)(wl + 20736);
    LAS unsigned short* TTi = (LAS unsigned short*)(wl + 24832); LAS unsigned short* TAK = TTi + 1280; LAS unsigned short* TRB = TAK + 1280; LAS unsigned short* TRK = TRB + 1280;
    const h16* KK = (const h16*)(c.ar + AR_KK); const h16* RR = (const h16*)(c.ar + AR_R); const h16* VV = (const h16*)(c.ar + AR_V);
    const h16* OM = (const h16*)(c.ar + AR_OMW) + (size_t)dir * TT_ROWS2048; const h16* BBp = (const h16*)(c.ar + AR_BB) + (size_t)dir * TT_ROWS2048; const h16* KDp = (const h16*)(c.ar + AR_KD) + (size_t)dir * TT_ROWS2048;
    {   LAS unsigned short* TO = (LAS unsigned short*)LAB;
        u32x4 ld[6][4];
#pragma unroll
        for (int i = 0; i < 4; ++i) { const int tau = (lane >> 3) + 8 * i; const size_t off = (size_t)rw_row(b, dir, ch * 32 + tau) * 2048 + h * 64 + (lane & 7) * 8;
            ld[0][i] = *(const u32x4*)(KK + off); ld[1][i] = *(const u32x4*)(BBp + off); ld[2][i] = *(const u32x4*)(KDp + off);
            ld[3][i] = *(const u32x4*)(RR + off); ld[4][i] = *(const u32x4*)(VV + off); ld[5][i] = *(const u32x4*)(OM + off); }
#pragma unroll
        for (int i = 0; i < 4; ++i) { const int o = ((lane >> 3) + 8 * i) * 64 + (lane & 7) * 8;
            *(LAS u32x4*)(TA + o) = ld[0][i]; *(LAS u32x4*)(TB + o) = ld[1][i]; *(LAS u32x4*)(TK + o) = ld[2][i];
            *(LAS u32x4*)(TR + o) = ld[3][i]; *(LAS u32x4*)(TVv + o) = ld[4][i]; *(LAS u32x4*)(TO + o) = ld[5][i]; }
    }
    WAVE_SYNC();
    {   const LAS h16* TO = (const LAS h16*)LAB;
        float g = 1.f;
#pragma unroll 8
        for (int tau = 0; tau < 32; ++tau) { const int o = tau * 64 + lane;
            const float omw = (float)TO[o], bb = (float)((const LAS h16*)TB)[o], kd = (float)((const LAS h16*)TK)[o], kk = (float)((const LAS h16*)TA)[o], rr = (float)((const LAS h16*)TR)[o], vv = (float)((const LAS h16*)TVv)[o];
            const float gp = g; g *= (1.0f - omw); const float ig = __builtin_amdgcn_rcpf(g);
            TA[o] = f2bf(kk * gp); TB[o] = f2bf(-bb * ig); TK[o] = f2bf(kd * ig); TR[o] = f2bf(rr * g); TVv[o] = f2bf(vv);
        }
        GC[lane] = g;
    }
    WAVE_SYNC();
    {   f32x16 ab, ak, rb, rk;
#pragma unroll
        for (int i = 0; i < 16; ++i) { ab[i] = 0.f; ak[i] = 0.f; rb[i] = 0.f; rk[i] = 0.f; }
#pragma unroll
        for (int ks = 0; ks < 4; ++ks) { const int o = r * 64 + 16 * ks + 8 * hh;
            const bf16x8 fa = *(const LAS bf16x8*)(TA + o), fb = *(const LAS bf16x8*)(TB + o), fk = *(const LAS bf16x8*)(TK + o), fr = *(const LAS bf16x8*)(TR + o);
            ab = MFMA32(fa, fb, ab); ak = MFMA32(fa, fk, ak); rb = MFMA32(fr, fb, rb); rk = MFMA32(fr, fk, rk); }
#pragma unroll
        for (int i = 0; i < 16; ++i) { const int tau = (i & 3) + 8 * (i >> 2) + 4 * hh;
            LAB[tau * 32 + r] = (r < tau) ? ab[i] : 0.f;
            TAK[tau * 40 + r] = f2bf((r < tau) ? ak[i] : 0.f); TRB[tau * 40 + r] = f2bf((r <= tau) ? rb[i] : 0.f); TRK[tau * 40 + r] = f2bf((r <= tau) ? rk[i] : 0.f); }
    }
    WAVE_SYNC();
    {   float Tc[32];
#pragma unroll
        for (int tau = 0; tau < 32; ++tau) { float acc = (r == tau) ? 1.f : 0.f;
#pragma unroll
            for (int q = 0; q < (tau + 3) / 4; ++q) { const f32x4 a4 = *(const LAS f32x4*)(LAB + tau * 32 + 4 * q);
#pragma unroll
                for (int e = 0; e < 4; ++e) if (4 * q + e < tau) acc = fmaf(a4[e], Tc[4 * q + e], acc); }
            Tc[tau] = acc; }
        if (hh == 0) {
#pragma unroll
            for (int tau = 0; tau < 32; ++tau) TTi[tau * 40 + r] = f2bf(Tc[tau]); }
    }
    WAVE_SYNC();
    f32x16 W1[2], Z[2]; bf16x8 Vn[2][2];
    {   bf16x8 tn[2], tp[2], akn[2];
#pragma unroll
        for (int s = 0; s < 2; ++s) { tn[s] = rowfrag_nat(TTi, r, s, hh); tp[s] = rowfrag_pk(TTi, r, s, hh); akn[s] = rowfrag_nat(TAK, r, s, hh); }
#pragma unroll
        for (int t2 = 0; t2 < 2; ++t2) {
#pragma unroll
            for (int i = 0; i < 16; ++i) W1[t2][i] = 0.f;
            f32x16 X;
#pragma unroll
            for (int i = 0; i < 16; ++i) X[i] = 0.f;
#pragma unroll
            for (int s = 0; s < 2; ++s) { Vn[t2][s] = colfrag_nat(TVv, 32 * t2 + r, 16 * s + 8 * hh);
                W1[t2] = MFMA32(tn[s], colfrag_nat(TA, 32 * t2 + r, 16 * s + 8 * hh), W1[t2]);
                X = MFMA32(akn[s], Vn[t2][s], X); }
#pragma unroll
            for (int i = 0; i < 16; ++i) Z[t2][i] = 0.f;
#pragma unroll
            for (int s = 0; s < 2; ++s) Z[t2] = MFMA32(tp[s], pack_p(X, s), Z[t2]);
        }
    }
    u32x4* CHp = (u32x4*)(c.ar + AR_CH + ((size_t)seq * RW_NCH + ch) * CH_BYTES) + lane;
    {   bf16x8 rbp[2], rkn[2];
#pragma unroll
        for (int s = 0; s < 2; ++s) { rbp[s] = rowfrag_pk(TRB, r, s, hh); rkn[s] = rowfrag_nat(TRK, r, s, hh); }
#pragma unroll
        for (int kt = 0; kt < 2; ++kt) { f32x16 GT;
#pragma unroll
            for (int g4 = 0; g4 < 4; ++g4) { const u32x2 w = *(const LAS u32x2*)(TR + r * 64 + 32 * kt + 8 * g4 + 4 * hh);
                GT[4 * g4] = bflo(w.x); GT[4 * g4 + 1] = bfhi(w.x); GT[4 * g4 + 2] = bflo(w.y); GT[4 * g4 + 3] = bfhi(w.y); }
#pragma unroll
            for (int s = 0; s < 2; ++s) GT = MFMA32(pack_p(W1[kt], s), rbp[s], GT);
#pragma unroll
            for (int s = 0; s < 2; ++s) CHp[(0 + kt * 2 + s) * 64] = pack_pu(GT, s); }
#pragma unroll
        for (int vt = 0; vt < 2; ++vt) { f32x16 Y0;
#pragma unroll
            for (int i = 0; i < 16; ++i) Y0[i] = 0.f;
#pragma unroll
            for (int s = 0; s < 2; ++s) { Y0 = MFMA32(pack_p(Z[vt], s), rbp[s], Y0); Y0 = MFMA32(Vn[vt][s], rkn[s], Y0); }
#pragma unroll
            for (int s = 0; s < 2; ++s) CHp[(4 + vt * 2 + s) * 64] = pack_pu(Y0, s); }
    }
#pragma unroll
    for (int k2 = 0; k2 < 2; ++k2) {
        const float gc = GC[32 * k2 + r];
        bf16x8 bhp[2], khn[2];
#pragma unroll
        for (int s = 0; s < 2; ++s) { bhp[s] = colfrag_pk_scaled(TB, 32 * k2 + r, s, hh, gc); khn[s] = colfrag_nat_scaled(TK, 32 * k2 + r, 16 * s + 8 * hh, gc); }
#pragma unroll
        for (int kt = 0; kt < 2; ++kt) { f32x16 PT;
#pragma unroll
            for (int i = 0; i < 16; ++i) PT[i] = (kt == k2 && ((i & 3) + 8 * (i >> 2) + 4 * hh) == r) ? gc : 0.f;
#pragma unroll
            for (int s = 0; s < 2; ++s) PT = MFMA32(pack_p(W1[kt], s), bhp[s], PT);
#pragma unroll
            for (int s = 0; s < 2; ++s) CHp[(8 + k2 * 4 + kt * 2 + s) * 64] = pack_pu(PT, s); }
#pragma unroll
        for (int vt = 0; vt < 2; ++vt) { f32x16 PS;
#pragma unroll
            for (int i = 0; i < 16; ++i) PS[i] = 0.f;
#pragma unroll
            for (int s = 0; s < 2; ++s) { PS = MFMA32(bhp[s], pack_p(Z[vt], s), PS); PS = MFMA32(khn[s], Vn[vt][s], PS); }
#pragma unroll
            for (int s = 0; s < 2; ++s) CHp[(16 + k2 * 4 + vt * 2 + s) * 64] = pack_pu(PS, s); }
    }
    WAVE_SYNC();
}

DI void unpack_acc(const u32x4 lo, const u32x4 hi, f32x16& x) {
#pragma unroll
    for (int j = 0; j < 4; ++j) { x[2 * j] = bflo(lo[j]); x[2 * j + 1] = bfhi(lo[j]); x[8 + 2 * j] = bflo(hi[j]); x[8 + 2 * j + 1] = bfhi(hi[j]); }
}
__device__ __forceinline__ void rwkv_seq_wave(const Ctx& c, int seq, int vt) {
    const int dir = seq & 1, h = (seq >> 1) & 31, b = seq >> 6;
    const int lane = c.lane, r = lane & 31, hh = lane >> 5;
    bf16_t* Y = (bf16_t*)(c.ar + AR_Y) + (size_t)dir * TT_ROWS2048;
    f32x16 M[2];
#pragma unroll
    for (int kt = 0; kt < 2; ++kt)
#pragma unroll
        for (int i = 0; i < 16; ++i) M[kt][i] = 0.f;
    const u32x4* CH0 = (const u32x4*)(c.ar + AR_CH + (size_t)seq * RW_NCH * CH_BYTES) + lane;
    u32x4 gf[4], pf[8], y0[2], ps[4];
#define RW_LOAD(chp) do { _Pragma("unroll") for (int q = 0; q < 4; ++q) gf[q] = (chp)[q * 64]; _Pragma("unroll") for (int q = 0; q < 2; ++q) y0[q] = (chp)[(4 + vt * 2 + q) * 64]; \
        _Pragma("unroll") for (int q = 0; q < 8; ++q) pf[q] = (chp)[(8 + q) * 64]; _Pragma("unroll") for (int k2 = 0; k2 < 2; ++k2) _Pragma("unroll") for (int s = 0; s < 2; ++s) ps[k2 * 2 + s] = (chp)[(16 + k2 * 4 + vt * 2 + s) * 64]; } while (0)
    RW_LOAD(CH0);
    for (int ch = 0; ch < (int)RW_NCH; ++ch) {
        bf16x8 mp[4];
#pragma unroll
        for (int kt = 0; kt < 2; ++kt)
#pragma unroll
            for (int s = 0; s < 2; ++s) mp[kt * 2 + s] = pack_p(M[kt], s);
        f32x16 Yc, Mn[2];
        unpack_acc(y0[0], y0[1], Yc); unpack_acc(ps[0], ps[1], Mn[0]); unpack_acc(ps[2], ps[3], Mn[1]);
#pragma unroll
        for (int q = 0; q < 4; ++q) Yc = MFMA32(mp[q], __builtin_bit_cast(bf16x8, gf[q]), Yc);
#pragma unroll
        for (int k2 = 0; k2 < 2; ++k2)
#pragma unroll
            for (int q = 0; q < 4; ++q) Mn[k2] = MFMA32(__builtin_bit_cast(bf16x8, pf[k2 * 4 + q]), mp[q], Mn[k2]);
        if (ch + 1 < (int)RW_NCH) { const u32x4* nx = CH0 + (size_t)(ch + 1) * (CH_BYTES / 16); RW_LOAD(nx); }
        M[0] = Mn[0]; M[1] = Mn[1];
        {   bf16_t* yp = Y + (size_t)rw_row(b, dir, ch * 32 + r) * 2048 + h * 64 + 32 * vt + 4 * hh;
#pragma unroll
            for (int g = 0; g < 4; ++g) { u32x2 w2; w2.x = pk_bf16(Yc[4 * g], Yc[4 * g + 1]); w2.y = pk_bf16(Yc[4 * g + 2], Yc[4 * g + 3]); *(u32x2*)(yp + 8 * g) = w2; } }
    }
#undef RW_LOAD
}

__device__ __forceinline__ void p_rwkv_k1_and_conv(const Ctx& c) {
    if (c.wave < 4) { LAS unsigned char* wl = c.lds + c.wave * K1_WAVE_LDS; const int w = blockIdx.x * 4 + c.wave, nw = gridDim.x * 4;
        for (int task = w; task < 256 * (int)RW_NCH; task += nw) rwkv_k1_chunk(c, wl, task / (int)RW_NCH, task % (int)RW_NCH); }
    else p_convert_deferred(c, blockIdx.x * 4 + (c.wave - 4), gridDim.x * 4, 0, CONV_SPLIT);
}
__device__ __forceinline__ void p_rwkv_seq_and_conv(const Ctx& c) {
    constexpr int NTASK = 512;
    const int G = (int)gridDim.x, task = c.wave * G + (int)blockIdx.x;
    if (task < NTASK) { for (int t = task; t < NTASK; t += G * 8) rwkv_seq_wave(c, t & 255, t >> 8); return; }
    int widx = 0, nworkers = 0;
    for (int w = 0; w < 8; ++w) { const int nsc = NTASK - w * G; const int sb = nsc <= 0 ? 0 : (nsc > G ? G : nsc);
        if (w < c.wave) widx += G - sb; else if (w == c.wave) widx += (int)blockIdx.x - sb;
        nworkers += G - sb; }
    p_convert_deferred(c, widx, nworkers, CONV_SPLIT, 1 << 30);
}

constexpr int DA_KBYTES = 64 * 256, DA_VBYTES = 128 * 128, DA_BUF = DA_KBYTES + DA_VBYTES;
constexpr int DA_COMB = 2 * DA_BUF;
__device__ __forceinline__ void dattn_block_item(const Ctx& c, int item) {
    const bf16_t* PB = (const bf16_t*)(c.ar + AR_PB); const bf16_t* VT = (const bf16_t*)(c.ar + AR_VT); bf16_t* MIX = (bf16_t*)(c.ws + WS_XN);
    const int lane = c.lane, r = lane & 31, hh = lane >> 5, w = c.wave, mp = w >> 2, qg = w & 3;
    int b, h, qrow0, t0, nt;
    if (item < NB * 16 * 32) { b = item >> 9; h = (item >> 5) & 15; qrow0 = b * SEQ + (item & 31) * 128; t0 = 0; nt = NKEY / 64; }
    else { const int i2 = item - NB * 16 * 32; b = i2 >> 5; h = (i2 >> 1) & 15; qrow0 = TL + b * CTXL + (i2 & 1) * 128; t0 = SEQ / 64; nt = CTXL / 64; }
    const bf16_t* VTh = VT + ((size_t)b * 16 + h) * 128 * NKEY;
    int krow_l[2], kchunk_l[2], vrow_l[2], vchunk_l[2];
#pragma unroll
    for (int i = 0; i < 2; ++i) { const int pk = 2 * w + i; krow_l[i] = 4 * pk + (lane >> 4); kchunk_l[i] = (lane & 15) ^ (krow_l[i] & 15);
        vrow_l[i] = 8 * pk + (lane >> 3); vchunk_l[i] = (lane & 7) ^ ((vrow_l[i] >> 1) & 7); }
#define DA_LOAD(t, buf) do { const int kx0 = (t0 + (t)) * 64; const int krow0 = kx0 < SEQ ? b * SEQ + kx0 : TL + b * CTXL + (kx0 - SEQ); \
        _Pragma("unroll") for (int i = 0; i < 2; ++i) { \
            __builtin_amdgcn_global_load_lds((const unsigned*)(PB + (size_t)(krow0 + krow_l[i]) * COLS_B + 2048 + h * 128 + kchunk_l[i] * 8), (LAS unsigned*)(c.lds + (buf) * DA_BUF + (2 * w + i) * 1024), 16, 0, 0); \
            __builtin_amdgcn_global_load_lds((const unsigned*)(VTh + (size_t)vrow_l[i] * NKEY + kx0 + vchunk_l[i] * 8), (LAS unsigned*)(c.lds + (buf) * DA_BUF + DA_KBYTES + (2 * w + i) * 1024), 16, 0, 0); } } while (0)
    bf16x8 q[4];
    { const bf16_t* qp = PB + (size_t)(qrow0 + 32 * qg + r) * COLS_B + h * 128 + mp * 64 + hh * 8;
#pragma unroll
      for (int ks = 0; ks < 4; ++ks) q[ks] = ld_frag(qp + ks * 16); }
    f32x16 O[4];
#pragma unroll
    for (int d = 0; d < 4; ++d)
#pragma unroll
        for (int i = 0; i < 16; ++i) O[d][i] = 0.f;
    float m = 0.f, l = 0.f;
    DA_LOAD(0, 0);
    __syncthreads();
    for (int t = 0; t < nt; ++t) {
        const int cur = t & 1;
        if (t + 1 < nt) DA_LOAD(t + 1, cur ^ 1);
        const LAS unsigned short* Kl = (const LAS unsigned short*)(c.lds + cur * DA_BUF); const LAS unsigned short* Vl = (const LAS unsigned short*)(c.lds + cur * DA_BUF + DA_KBYTES);
        f32x16 st[2];
        const float negm = -m;
#pragma unroll
        for (int sub = 0; sub < 2; ++sub) {
#pragma unroll
            for (int i = 0; i < 16; ++i) st[sub][i] = negm;
#pragma unroll
            for (int ks = 0; ks < 4; ++ks) st[sub] = MFMA32(*(const LAS bf16x8*)((const LAS unsigned char*)Kl + (32 * sub + r) * 256 + (((mp * 8 + ks * 2 + hh) ^ (r & 15)) << 4)), q[ks], st[sub]); }
        float mx = fmaxf(st[0][0], st[1][0]);
#pragma unroll
        for (int i = 1; i < 16; ++i) mx = fmaxf(mx, fmaxf(st[0][i], st[1][i]));
        mx = fmaxf(mx, __shfl_xor(mx, 32));
        if (!__all(mx <= 8.0f && mx >= -24.0f)) {
            const float alpha = __builtin_amdgcn_exp2f(-mx);
            m += mx; l *= alpha;
#pragma unroll
            for (int sub = 0; sub < 2; ++sub)
#pragma unroll
                for (int i = 0; i < 16; ++i) st[sub][i] -= mx;
#pragma unroll
            for (int d = 0; d < 4; ++d)
#pragma unroll
                for (int i = 0; i < 16; ++i) O[d][i] *= alpha;
        }
        float ps = 0.f;
#pragma unroll
        for (int sub = 0; sub < 2; ++sub)
#pragma unroll
            for (int i = 0; i < 16; ++i) { st[sub][i] = __builtin_amdgcn_exp2f(st[sub][i]); ps += st[sub][i]; }
        l += ps;
        bf16x8 P[4];
#pragma unroll
        for (int sub = 0; sub < 2; ++sub) { P[2 * sub] = pack_p(st[sub], 0); P[2 * sub + 1] = pack_p(st[sub], 1); }
#pragma unroll
        for (int d = 0; d < 4; ++d)
#pragma unroll
            for (int kk = 0; kk < 4; ++kk) O[d] = MFMA32(*(const LAS bf16x8*)((const LAS unsigned char*)Vl + (32 * d + r) * 128 + (((2 * kk + hh) ^ ((r >> 1) & 7)) << 4)), P[kk], O[d]);
        __syncthreads();
    }
#undef DA_LOAD
    LAS float* CB = (LAS float*)(c.lds + DA_COMB) + qg * 4096;
    l += __shfl_xor(l, 32);
    if (mp == 1) { const float sc = ((const float*)(c.ws + WS_SCAL))[0] / l;
#pragma unroll
        for (int d = 0; d < 4; ++d)
#pragma unroll
            for (int i = 0; i < 16; ++i) CB[(32 * d + (i & 3) + 8 * (i >> 2) + 4 * hh) * 32 + r] = O[d][i] * sc; }
    __syncthreads();
    if (mp == 0) { const float i0 = 1.0f / l; float ss = 0.f;
#pragma unroll
        for (int d = 0; d < 4; ++d)
#pragma unroll
            for (int i = 0; i < 16; ++i) { const float y = O[d][i] * i0 - CB[(32 * d + (i & 3) + 8 * (i >> 2) + 4 * hh) * 32 + r]; O[d][i] = y; ss += y * y; }
        ss += __shfl_xor(ss, 32);
        const float rs = rsqrtf(ss * (1.0f / 128.0f) + 1e-5f) * 0.8f;
        const float* subln = c.in[I_SUBLN];
        bf16_t* orow = MIX + (size_t)(qrow0 + 32 * qg + r) * D + 2048 + h * 128;
#pragma unroll
        for (int d = 0; d < 4; ++d)
#pragma unroll
            for (int g = 0; g < 4; ++g) { const int dv = 32 * d + 8 * g + 4 * hh; const f32x4 sl = *(const f32x4*)(subln + dv);
                u32x2 wv; wv.x = pk_bf16(O[d][4 * g] * rs * sl[0], O[d][4 * g + 1] * rs * sl[1]); wv.y = pk_bf16(O[d][4 * g + 2] * rs * sl[2], O[d][4 * g + 3] * rs * sl[3]);
                *(u32x2*)(orow + dv) = wv; } }
    __syncthreads();
}
__device__ __forceinline__ void p_dattn_block(const Ctx& c, bool need_ctx) {
    const int nitems = NB * 16 * 32 + (need_ctx ? NB * 16 * 2 : 0);
    const bool remap = gridDim.x == 256;
    for (int item = blockIdx.x; item < nitems; item += gridDim.x) {
        int it = item;
        if (remap && item < NB * 16 * 32) { const int k = item >> 8, x = item & 7, sl = (item & 255) >> 3; it = (((k << 3) + x) << 5) | sl; }
        dattn_block_item(c, it);
    }
}

constexpr int P1_CQ = 0, P1_CK = 2048, P1_CV = 2304, P1_DQ = 2560, P1_DK = 3584, P1_DV = 4608, P1_DG = 6656;

constexpr int SW_KLD = 72, SW_VLD = 40;
constexpr int SW_KBYTES = 32 * SW_KLD * 2, SW_VBYTES = 64 * SW_VLD * 2, SW_BUF = SW_KBYTES + SW_VBYTES;
__device__ __forceinline__ void swa_block_item(const Ctx& c, int item) {
    const bf16_t* P1 = (const bf16_t*)(c.ar + AR_P1); const bf16_t* VTC = (const bf16_t*)(c.ar + AR_VTC); bf16_t* MIX = (bf16_t*)(c.ws + WS_XN);
    const int tid = c.tid, lane = c.lane, r = lane & 31, hh = lane >> 5;
    const int b = item >> 9, g = (item >> 7) & 3, q0 = (item & 127) * 32, hq = g * 8 + c.wave;
    const int qpos = q0 + r;
    bf16x8 q[4]; { const bf16_t* qp = P1 + (size_t)(b * SEQ + qpos) * NO + P1_CQ + hq * 64 + hh * 8;
#pragma unroll
        for (int ks = 0; ks < 4; ++ks) q[ks] = ld_frag(qp + ks * 16); }
    const bf16_t* VTh = VTC + ((size_t)b * 4 + g) * 64 * NKEY;
    f32x16 O[2];
#pragma unroll
    for (int d = 0; d < 2; ++d)
#pragma unroll
        for (int i = 0; i < 16; ++i) O[d][i] = 0.f;
    float m = 0.f, l = 0.f;
    const int wt0 = (q0 - 128 < 0 ? 0 : q0 - 128) / 32, wt1 = (q0 + 160 > SEQ ? SEQ : q0 + 160) / 32;
    const int nwt = wt1 - wt0, ntl = nwt + 8;
    u32x4 sreg;
    const bool kside = tid < 256; const int t2 = tid & 255;
#define SWB_LOAD(ti) do { const bool win_ = (ti) < nwt; const int kx_ = (win_ ? wt0 + (ti) : (SEQ / 32) + ((ti) - nwt)) * 32; \
        sreg = kside ? *(const u32x4*)(P1 + (size_t)((win_ ? b * SEQ + kx_ : TL + b * CTXL + (kx_ - SEQ)) + (t2 >> 3)) * NO + P1_CK + g * 64 + (t2 & 7) * 8) \
                     : *(const u32x4*)(VTh + (size_t)(t2 >> 2) * NKEY + kx_ + (t2 & 3) * 8); } while (0)
#define SWB_STORE(buf) do { LAS unsigned short* base_ = (LAS unsigned short*)(c.lds + (buf) * SW_BUF); \
        if (kside) *(LAS u32x4*)(base_ + (t2 >> 3) * SW_KLD + (t2 & 7) * 8) = sreg; else *(LAS u32x4*)(base_ + SW_KBYTES / 2 + (t2 >> 2) * SW_VLD + (t2 & 3) * 8) = sreg; } while (0)
    SWB_LOAD(0); SWB_STORE(0);
    __syncthreads();
    for (int ti = 0; ti < ntl; ++ti) {
        const bool win = ti < nwt; const int kx0 = (win ? wt0 + ti : (SEQ / 32) + (ti - nwt)) * 32;
        if (ti + 1 < ntl) SWB_LOAD(ti + 1);
        const LAS unsigned short* Kl = (const LAS unsigned short*)(c.lds + (ti & 1) * SW_BUF); const LAS unsigned short* Vl = Kl + SW_KBYTES / 2;
        f32x16 st;
        const float negm = -m;
#pragma unroll
        for (int i = 0; i < 16; ++i) st[i] = negm;
#pragma unroll
        for (int ks = 0; ks < 4; ++ks) st = MFMA32(*(const LAS bf16x8*)(Kl + r * SW_KLD + ks * 16 + hh * 8), q[ks], st);
        if (win && (kx0 == q0 - 128 || kx0 == q0 + 128)) {
#pragma unroll
            for (int i = 0; i < 16; ++i) { const int kpos = kx0 + (i & 3) + 8 * (i >> 2) + 4 * hh; const int dl = kpos - qpos; if (dl > 128 || dl < -128) st[i] = -1e30f; }
        }
        float mx = st[0];
#pragma unroll
        for (int i = 1; i < 16; ++i) mx = fmaxf(mx, st[i]);
        mx = fmaxf(mx, __shfl_xor(mx, 32));
        if (!__all(mx <= 8.0f && mx >= -24.0f)) {
            const float alpha = __builtin_amdgcn_exp2f(-mx);
            m += mx; l *= alpha;
#pragma unroll
            for (int i = 0; i < 16; ++i) st[i] -= mx;
#pragma unroll
            for (int d = 0; d < 2; ++d)
#pragma unroll
                for (int i = 0; i < 16; ++i) O[d][i] *= alpha;
        }
        float ps = 0.f;
#pragma unroll
        for (int i = 0; i < 16; ++i) { st[i] = __builtin_amdgcn_exp2f(st[i]); ps += st[i]; }
        l += ps;
        const bf16x8 p0 = pack_p(st, 0), p1 = pack_p(st, 1);
#pragma unroll
        for (int d = 0; d < 2; ++d) { O[d] = MFMA32(*(const LAS bf16x8*)(Vl + (32 * d + r) * SW_VLD + 8 * hh), p0, O[d]); O[d] = MFMA32(*(const LAS bf16x8*)(Vl + (32 * d + r) * SW_VLD + 16 + 8 * hh), p1, O[d]); }
        if (ti + 1 < ntl) SWB_STORE((ti + 1) & 1);
        __syncthreads();
    }
#undef SWB_LOAD
#undef SWB_STORE
    l += __shfl_xor(l, 32);
    l += __builtin_amdgcn_exp2f(c.in[I_SINK][hq] * LOG2E - m);
    const float il = 1.0f / l;
    bf16_t* orow = MIX + (size_t)(b * SEQ + qpos) * D + hq * 64;
#pragma unroll
    for (int d = 0; d < 2; ++d)
#pragma unroll
        for (int gq = 0; gq < 4; ++gq) { const int dv = 32 * d + 8 * gq + 4 * hh;
            u32x2 w; w.x = pk_bf16(O[d][4 * gq] * il, O[d][4 * gq + 1] * il); w.y = pk_bf16(O[d][4 * gq + 2] * il, O[d][4 * gq + 3] * il);
            *(u32x2*)(orow + dv) = w; }
}

DI float ret_lg(const Ctx& c, int dir, int h) { return log1pf(-exp2f(-c.in[I_RDEC][dir * 8 + h])); }
DI int ret_row0(int b, int cidx) { return cidx < 2 ? TL + b * CTXL + cidx * 128 : b * SEQ + (cidx - 2) * 128; }
constexpr int TK_LD = 136, TV_LD = 264;
constexpr int RT_LD = 136;
DI void stage_chunk_T(const Ctx& c, const bf16_t* src, int ld_src, int ncols, LAS unsigned short* T) {
    const int tid = c.tid, row = tid >> 2, part = tid & 3, cpt = ncols / 4;
    const bf16_t* p = src + (size_t)row * ld_src + part * cpt;
    for (int e = 0; e < cpt / 8; ++e) { const u32x4 w = *(const u32x4*)(p + e * 8);
#pragma unroll
        for (int j = 0; j < 4; ++j) { T[(part * cpt + e * 8 + 2 * j) * RT_LD + row] = (unsigned short)(w[j] & 0xffffu); T[(part * cpt + e * 8 + 2 * j + 1) * RT_LD + row] = (unsigned short)(w[j] >> 16); } }
}
__device__ __forceinline__ void p_ret_local(const Ctx& c) {
    const bf16_t* P1 = (const bf16_t*)(c.ar + AR_P1); float* RU = (float*)(c.ar + AR_RU);
    LAS unsigned short* TK = (LAS unsigned short*)c.lds; LAS unsigned short* TV = TK + 128 * RT_LD;
    const int lane = c.lane, r = lane & 31, hh = lane >> 5, w = c.wave;
    for (int item = blockIdx.x; item < NB * 8 * 34; item += gridDim.x) {
        const int cidx = item % 34, h = (item / 34) & 7, b = item / (34 * 8);
        const int row0 = ret_row0(b, cidx);
        stage_chunk_T(c, P1 + (size_t)row0 * NO + P1_DK + h * 128, NO, 128, TK);
        stage_chunk_T(c, P1 + (size_t)row0 * NO + P1_DV + h * 256, NO, 256, TV);
        __syncthreads();
        for (int dir = 0; dir < 2; ++dir) {
            const float lg = ret_lg(c, dir, h);
            f32x16 af[4];
#pragma unroll
            for (int dt = 0; dt < 4; ++dt)
#pragma unroll
                for (int i = 0; i < 16; ++i) af[dt][i] = 0.f;
#pragma unroll 1
            for (int ks = 0; ks < 8; ++ks) {
                const int i0 = ks * 16 + hh * 8;
                float vf[8]; unpack8(*(const LAS u32x4*)(TV + (32 * w + r) * RT_LD + i0), vf);
#pragma unroll
                for (int j = 0; j < 8; ++j) vf[j] *= __expf(lg * (float)(dir ? (i0 + j) : (127 - (i0 + j))));
                const bf16x8 fa = __builtin_bit_cast(bf16x8, pack8_bf16(vf));
#pragma unroll
                for (int dt = 0; dt < 4; ++dt) af[dt] = MFMA32(*(const LAS bf16x8*)(TK + (32 * dt + r) * RT_LD + i0), fa, af[dt]);
            }
            float* U = RU + ((((size_t)b * 8 + h) * 2 + dir) * 34 + cidx) * 32768;
#pragma unroll
            for (int dt = 0; dt < 4; ++dt)
#pragma unroll
                for (int g = 0; g < 4; ++g) { f32x4 v4 = {af[dt][4 * g], af[dt][4 * g + 1], af[dt][4 * g + 2], af[dt][4 * g + 3]}; *(f32x4*)(U + (32 * w + r) * 128 + 32 * dt + 8 * g + 4 * hh) = v4; }
        }
        __syncthreads();
    }
}
__device__ __forceinline__ void p_ret_prefix(const Ctx& c) {
    const float* RU = (const float*)(c.ar + AR_RU); bf16_t* RS = (bf16_t*)(c.ar + AR_RS);
    const size_t gtid = (size_t)blockIdx.x * NTHREADS + c.tid, gn = (size_t)gridDim.x * NTHREADS;
    for (size_t idx = gtid; idx < (size_t)NB * 8 * 2 * 32768; idx += gn) {
        const int el = (int)(idx & 32767), bhd = (int)(idx >> 15), dir = bhd & 1, h = (bhd >> 1) & 7;
        const float cd = __expf(ret_lg(c, dir, h) * 128.0f);
        const float* U = RU + (size_t)bhd * 34 * 32768 + el; bf16_t* S = RS + (size_t)bhd * 32 * 32768 + el;
        float u[34];
#pragma unroll
        for (int ci = 0; ci < 34; ++ci) u[ci] = __builtin_nontemporal_load(U + (size_t)ci * 32768);
        float s = 0.f;
        if (dir == 0) {
#pragma unroll
            for (int ci = 0; ci < 34; ++ci) { if (ci >= 2) S[(size_t)(ci - 2) * 32768] = f2bf(s); s = s * cd + u[ci]; } }
        else { s = s * cd + u[1]; s = s * cd + u[0];
#pragma unroll
            for (int ci = 33; ci >= 2; --ci) { S[(size_t)(ci - 2) * 32768] = f2bf(s); s = s * cd + u[ci]; } }
    }
}
__device__ __forceinline__ void p_ret_out(const Ctx& c) {
    const bf16_t* P1 = (const bf16_t*)(c.ar + AR_P1); const bf16_t* RS = (const bf16_t*)(c.ar + AR_RS); bf16_t* MIX = (bf16_t*)(c.ws + WS_XN);
    LAS unsigned short* TV = (LAS unsigned short*)c.lds;
    LAS float* XS = (LAS float*)(c.lds + 256 * RT_LD * 2);
    const int lane = c.lane, r = lane & 31, hh = lane >> 5, w = c.wave, qt = w & 3, eh = w >> 2;
    for (int item = blockIdx.x; item < NB * 8 * 32; item += gridDim.x) {
        const int lc = item & 31, h = (item >> 5) & 7, b = item >> 8;
        const int row0 = b * SEQ + lc * 128;
        stage_chunk_T(c, P1 + (size_t)row0 * NO + P1_DV + h * 256, NO, 256, TV);
        __syncthreads();
        const float lgf = ret_lg(c, 0, h), lgb = ret_lg(c, 1, h);
        const int qi = qt * 32 + r;
        const bf16_t* qp = P1 + (size_t)(row0 + qi) * NO + P1_DQ + h * 128 + hh * 8;
        f32x16 Y[4];
#pragma unroll
        for (int et = 0; et < 4; ++et)
#pragma unroll
            for (int i = 0; i < 16; ++i) Y[et][i] = 0.f;
        {
            const float qdf = __expf(lgf * (float)(qi + 1)), qdb = __expf(lgb * (float)(128 - qi));
            const bf16_t* Sf = RS + ((((size_t)b * 8 + h) * 2 + 0) * 32 + lc) * 32768; const bf16_t* Sb = RS + ((((size_t)b * 8 + h) * 2 + 1) * 32 + lc) * 32768;
#pragma unroll 1
            for (int ks = 0; ks < 8; ++ks) {
                float x[8], xf[8], xb[8]; unpack8(*(const u32x4*)(qp + ks * 16), x);
#pragma unroll
                for (int j = 0; j < 8; ++j) { xf[j] = x[j] * qdf; xb[j] = x[j] * qdb; }
                const bf16x8 qf = __builtin_bit_cast(bf16x8, pack8_bf16(xf)), qb = __builtin_bit_cast(bf16x8, pack8_bf16(xb));
#pragma unroll
                for (int et = 0; et < 4; ++et) { const int e = eh * 128 + et * 32 + r;
                    Y[et] = MFMA32(ld_frag(Sf + (size_t)e * 128 + ks * 16 + hh * 8), qf, Y[et]);
                    Y[et] = MFMA32(ld_frag(Sb + (size_t)e * 128 + ks * 16 + hh * 8), qb, Y[et]); }
            }
        }
#pragma unroll 1
        for (int kt = 0; kt < 4; ++kt) {
            f32x16 st;
#pragma unroll
            for (int i = 0; i < 16; ++i) st[i] = 0.f;
            const bf16_t* kp = P1 + (size_t)(row0 + kt * 32 + r) * NO + P1_DK + h * 128 + hh * 8;
#pragma unroll
            for (int ks = 0; ks < 8; ++ks) st = MFMA32(ld_frag(kp + ks * 16), ld_frag(qp + ks * 16), st);
#pragma unroll
            for (int i = 0; i < 16; ++i) { const int ki = kt * 32 + (i & 3) + 8 * (i >> 2) + 4 * hh; const int dl = qi - ki;
                const float f = dl > 0 ? __expf(lgf * (float)dl) : (dl < 0 ? __expf(lgb * (float)(-dl)) : 2.0f); st[i] *= f; }
            const bf16x8 p0 = pack_p(st, 0), p1 = pack_p(st, 1);
#pragma unroll
            for (int et = 0; et < 4; ++et) { const int e = eh * 128 + et * 32 + r;
#pragma unroll
                for (int s = 0; s < 2; ++s) { const u32x2 lo = *(const LAS u32x2*)(TV + e * RT_LD + kt * 32 + 16 * s + 4 * hh), hi = *(const LAS u32x2*)(TV + e * RT_LD + kt * 32 + 16 * s + 8 + 4 * hh);
                    u32x4 vw = {lo.x, lo.y, hi.x, hi.y};
                    Y[et] = MFMA32(__builtin_bit_cast(bf16x8, vw), s == 0 ? p0 : p1, Y[et]); } }
        }
        float ss = 0.f;
#pragma unroll
        for (int et = 0; et < 4; ++et)
#pragma unroll
            for (int i = 0; i < 16; ++i) ss += Y[et][i] * Y[et][i];
        ss += __shfl_xor(ss, 32);
        if (hh == 0) XS[(eh * 4 + qt) * 32 + r] = ss;
        __syncthreads();
        const float tot = XS[(0 * 4 + qt) * 32 + r] + XS[(1 * 4 + qt) * 32 + r];
        const float rs = rsqrtf(tot * (1.0f / 256.0f) + 1e-6f);
        const bf16_t* gp = P1 + (size_t)(row0 + qi) * NO + P1_DG + h * 256; bf16_t* op = MIX + (size_t)(row0 + qi) * D + 2048 + h * 256;
#pragma unroll
        for (int et = 0; et < 4; ++et)
#pragma unroll
            for (int gq = 0; gq < 4; ++gq) { const int e = eh * 128 + et * 32 + 8 * gq + 4 * hh;
                const u32x2 gw = *(const u32x2*)(gp + e);
                const float g0 = bflo(gw.x), g1 = bfhi(gw.x), g2 = bflo(gw.y), g3 = bfhi(gw.y);
                u32x2 o; o.x = pk_bf16(Y[et][4 * gq] * rs * silu_f(g0), Y[et][4 * gq + 1] * rs * silu_f(g1)); o.y = pk_bf16(Y[et][4 * gq + 2] * rs * silu_f(g2), Y[et][4 * gq + 3] * rs * silu_f(g3));
                *(u32x2*)(op + e) = o; }
        __syncthreads();
    }
}

#define MK_PER_PHASE 0
#ifndef MK_PER_PHASE
#define MK_PER_PHASE 0
#endif
constexpr int N_PHASES = 25;
constexpr int LDS_STAGE = 4 * K1_WAVE_LDS;
constexpr int LDS_BYTES = LDS_STAGE + 256;

__global__ void __launch_bounds__(NTHREADS, 2) mk_fwd(Args a) {
    extern __shared__ __attribute__((aligned(16))) unsigned char smem[];
    Ctx c;
#pragma unroll
    for (int i = 0; i < 29; ++i) c.in[i] = a.in[i];
    c.out = a.out; c.ws = a.ws; c.ar = a.ws + WS_ARENA; c.lds = (LAS unsigned char*)smem;
    c.tid = threadIdx.x; c.lane = c.tid & 63; c.wave = __builtin_amdgcn_readfirstlane(c.tid >> 6);
    volatile LAS unsigned* xbw = (volatile LAS unsigned*)(c.lds + LDS_STAGE);
    if (c.tid < 4) xbw[c.tid] = 0u;
    __syncthreads();
    XcdBarrier bar; bar.bar = (unsigned*)(a.ws + WS_CTL); bar.x = 0; bar.st = xbw;
    if (!MK_PER_PHASE) bar = xcd_barrier_post((unsigned*)(a.ws + WS_CTL), xbw);
    const int lo = a.ph_lo, hi = a.ph_hi;
#ifndef PH_MASK
#define PH_MASK 0x1ffffffu
#endif
#define IN(k) (((PH_MASK >> (k)) & 1u) && lo <= (k) && (k) < hi)
#define SEAM(k) do { if (IN(k) && IN((k) + 1)) { xcd_barrier(bar); } } while (0)
    float* H = (float*)(c.ws + WS_H); const float* MOD = (const float*)(c.ws + WS_MOD);
    const bf16_t* XN = (const bf16_t*)(c.ws + WS_XN); unsigned char* W = c.ws + WS_W;
    LAS unsigned char* gl = c.lds; float* SLAB = (float*)(c.ar + AR_SLAB); unsigned char* W1 = c.ws + WS_W1;

    if (IN(0)) { p_mod(c); p_weights_layer0(c); p_wcolmax(c); }
    SEAM(0);
    if (IN(1)) { p_mod_finalize(c); p_norm_mod<4>(c, c.in[I_X], c.in[I_CTX], TT, (const float*)(c.ar + AR_MODP), 0, 1); }
    SEAM(1);
    if (IN(2)) { pg8::Gemm g{XN, (const bf16_t*)(W + W_IN), TT, NE, D}; LatThenCtxOrder S; S.init2(NE, gridDim.x, blockIdx.x, D);
        EpiInEven E{(bf16_t*)(c.ar + AR_PA), (bf16_t*)(c.ar + AR_PB), (const float*)(c.ws + WS_AXC), (const float*)(c.ws + WS_AXS)};
        pg8::gemm_phase(gl, g, S, E); }
    SEAM(2);
    if (IN(3)) { p_rwkv_prepA(c); p_build_vt<128, 16>(c, (const bf16_t*)(c.ar + AR_PB), COLS_B, 4096, (bf16_t*)(c.ar + AR_VT)); }
    SEAM(3);
    if (IN(4)) { pg8::Gemm g{(const bf16_t*)(c.ar + AR_LA), (const bf16_t*)(W + W_LORA), TT, LORA_N, LORA_K}; LoraOrder S; S.init2(LORA_N, gridDim.x, blockIdx.x, LORA_KU);
        EpiLora E{c.in[I_W0], c.in[I_A0], c.in[I_KA], (const bf16_t*)(c.ar + AR_K), (const h16*)(c.ar + AR_KK), (h16*)(c.ar + AR_OMW), (h16*)(c.ar + AR_BB), (h16*)(c.ar + AR_KD), (bf16_t*)(c.ar + AR_G)};
        pg8::gemm_phase(gl, g, S, E); }
    SEAM(4);
    if (IN(5)) {
#ifndef NO_DATTN
        p_dattn_block(c, true); __syncthreads();
#endif
#ifndef NO_K1
        p_rwkv_k1_and_conv(c);
#endif
    }
    SEAM(5);
    if (IN(6)) p_rwkv_seq_and_conv(c);
    SEAM(6);
    if (IN(7)) p_rwkv_out(c, TT);
    SEAM(7);
    if (IN(8)) { constexpr int KE = MIX_I8 ? D / 2 : D; const float* SAq = (const float*)(c.ar + AR_XQS);
        pg8::Gemm g{MIX_I8 ? (const bf16_t*)(c.ar + AR_XQ) : XN, (const bf16_t*)(W + W_MIX), TT, D, KE}; pg8::StaticOrder S; S.init(TL, D, gridDim.x, blockIdx.x, KE);
        EpiResModT<MIX_I8 != 0> E{c.in[I_X], c.in[I_CTX], H, MOD + 2 * 4096, SAq, i8_cs(c, CM_MIX)};
        pg8::gemm_phase(gl, g, S, E);
        CtxSplitOrder S2; S2.init(D, gridDim.x, blockIdx.x, KE); EpiSlabT<MIX_I8 != 0> E2{SLAB, SAq, i8_cs(c, CM_MIX)};
        pg8::gemm_phase(gl, g, S2, E2); }
    SEAM(8);
    if (IN(9)) { p_ctx_fix(c, c.in[I_CTX], MOD + 4 * 24576 + 2 * 4096, SLAB, H); p_norm_mod<1, FFN_I8 != 0>(c, H, H + (size_t)TL * D, TT, MOD, 3, 4); }
    SEAM(9);
    if (IN(10)) { constexpr int KE = FFN_I8 ? D / 2 : D;
        pg8::Gemm g{XN, (const bf16_t*)(W + W_FFI), TT, 2 * DFF, KE}; LatThenCtxOrder S; S.init2(2 * DFF, gridDim.x, blockIdx.x, KE);
        EpiConvGlu E{(bf16_t*)(c.ar + AR_HID), (bf16_t*)(c.ar + AR_SG), (bf16_t*)(c.ar + AR_SU), c.in[I_CONVW], c.in[I_CONVB], (const float*)(c.ws + WS_XN + (size_t)TT * D), i8_cs(c, CM_FFI)};
        pg8::gemm_phase(gl, g, S, E); }
    SEAM(10);
    if (IN(11)) { p_conv_fix(c, 0, TT); if (FFO0_I8 && IN(12)) { xcd_barrier(bar); p_quant_hid(c, TT); } }
    SEAM(11);
    if (IN(12)) { constexpr int KE = FFO0_I8 ? DFF / 2 : DFF; const float* SAq = (const float*)(c.ar + AR_HQS);
        pg8::Gemm g{(const bf16_t*)(c.ar + (FFO0_I8 ? AR_HQ : AR_HID)), (const bf16_t*)(W + W_FFO), TT, D, KE}; pg8::StaticOrder S; S.init(TL, D, gridDim.x, blockIdx.x, KE);
        EpiResModT<FFO0_I8 != 0> E{H, H + (size_t)TL * D, H, MOD + 5 * 4096, SAq, i8_cs(c, CM_FFO0)};
        pg8::gemm_phase(gl, g, S, E);
        CtxSplitOrder S2; S2.init(D, gridDim.x, blockIdx.x, KE); EpiSlabT<FFO0_I8 != 0> E2{SLAB, SAq, i8_cs(c, CM_FFO0)};
        pg8::gemm_phase(gl, g, S2, E2); }
    SEAM(12);
    const float* MOD1 = MOD + 5 * 24576;
    if (IN(13)) { p_ctx_fix(c, H + (size_t)TL * D, MOD + 4 * 24576 + 5 * 4096, SLAB, H); p_norm_mod<1, INO_I8 != 0>(c, H, H + (size_t)TL * D, TT, MOD1, 0, 1); }
    SEAM(13);
    if (IN(14)) { constexpr int KE = INO_I8 ? D / 2 : D;
        pg8::Gemm g{XN, (const bf16_t*)(W + W_IN), TT, NO, KE}; OddInOrder S; S.init2(gridDim.x, blockIdx.x, KE);
        EpiInOdd E{(bf16_t*)(c.ar + AR_P1), (const float*)(c.ws + WS_AXC), (const float*)(c.ws + WS_AXS), (const float*)(c.ws + WS_RTC), (const float*)(c.ws + WS_RTS), (const float*)(c.ws + WS_XN + (size_t)TT * D), i8_cs(c, CM_INO)};
        pg8::gemm_phase(gl, g, S, E); }
    SEAM(14);
    if (IN(15)) { p_build_vt<64, 4>(c, (const bf16_t*)(c.ar + AR_P1), NO, P1_CV, (bf16_t*)(c.ar + AR_VTC)); }
    SEAM(15);
    if (IN(16)) { p_ret_local(c); for (int item = blockIdx.x; item < NB * 4 * 128; item += gridDim.x) swa_block_item(c, item); }
    SEAM(16);
    if (IN(17)) p_ret_prefix(c);
    SEAM(17);
    if (IN(18)) p_ret_out(c);
    SEAM(18);
    if (MIX_I8 && IN(18) && IN(19)) { p_quant_mix(c, TL); xcd_barrier(bar); }
    if (IN(19)) { constexpr int KE = MIX_I8 ? D / 2 : D;
        pg8::Gemm g{MIX_I8 ? (const bf16_t*)(c.ar + AR_XQ) : XN, (const bf16_t*)(W1 + W1_MIX), TL, D, KE}; pg8::StaticOrder S; S.init(TL, D, gridDim.x, blockIdx.x, KE);
        EpiResModT<MIX_I8 != 0> E{H, H + (size_t)TL * D, H, MOD1 + 2 * 4096, (const float*)(c.ar + AR_XQS), i8_cs(c, CM_MIX + D)};
        pg8::gemm_phase(gl, g, S, E); }
    SEAM(19);
    if (IN(20)) p_norm_mod<1, FFN_I8 != 0>(c, H, H + (size_t)TL * D, TL, MOD1, 3, 4);
    SEAM(20);
    if (IN(21)) { constexpr int KE = FFN_I8 ? D / 2 : D;
        pg8::Gemm g{XN, (const bf16_t*)(W1 + W1_FFI), TL, 2 * DFF, KE}; pg8::StaticOrder S; S.init(TL, 2 * DFF, gridDim.x, blockIdx.x, KE);
        EpiConvGlu E{(bf16_t*)(c.ar + AR_HID), (bf16_t*)(c.ar + AR_SG), (bf16_t*)(c.ar + AR_SU), c.in[I_CONVW] + (size_t)3 * DFF, c.in[I_CONVB] + DFF, (const float*)(c.ws + WS_XN + (size_t)TT * D), i8_cs(c, CM_FFI + 2 * DFF)};
        pg8::gemm_phase(gl, g, S, E); }
    SEAM(21);
    if (IN(22)) { p_conv_fix(c, 1, TL); if (FFO1_I8 && IN(23)) { xcd_barrier(bar); p_quant_hid(c, TL); } }
    SEAM(22);
    if (IN(23)) { constexpr int KE = FFO1_I8 ? DFF / 2 : DFF;
        pg8::Gemm g{(const bf16_t*)(c.ar + (FFO1_I8 ? AR_HQ : AR_HID)), (const bf16_t*)(W1 + W1_FFO), TL, D, KE}; pg8::StaticOrder S; S.init(TL, D, gridDim.x, blockIdx.x, KE);
        EpiResModT<FFO1_I8 != 0> E{H, H + (size_t)TL * D, H, MOD1 + 5 * 4096, (const float*)(c.ar + AR_HQS), i8_cs(c, CM_FFO1)};
        pg8::gemm_phase(gl, g, S, E); }
    SEAM(23);
    if (IN(24)) p_final_norm(c);
#undef IN
#undef SEAM
}

extern "C" void kernel_launch(void* const* d_in, const int* in_sizes, int n_in, void* d_out, int out_size, void* d_ws, size_t ws_size, hipStream_t stream) {
    static int grid = 0;
    if (grid == 0) {
        if (n_in != 29 || ws_size < WS_END) { fprintf(stderr, "kernel_launch: need 29 inputs and >= %zu bytes of workspace; got n_in %d, ws %zu; nothing launched\n", (size_t)WS_END, n_in, ws_size); grid = -1; return; }
        int dev = 0, cus = 0, per_cu = 0;
        if (hipGetDevice(&dev) != hipSuccess || hipDeviceGetAttribute(&cus, hipDeviceAttributeMultiprocessorCount, dev) != hipSuccess) { grid = -1; return; }
        if (hipFuncSetAttribute((const void*)mk_fwd, hipFuncAttributeMaxDynamicSharedMemorySize, LDS_BYTES) != hipSuccess) { fprintf(stderr, "kernel_launch: hipFuncSetAttribute failed\n"); grid = -1; return; }
        if (hipOccupancyMaxActiveBlocksPerMultiprocessor(&per_cu, (const void*)mk_fwd, NTHREADS, LDS_BYTES) != hipSuccess || per_cu < 1) { fprintf(stderr, "kernel_launch: occupancy query says %d blocks per CU\n", per_cu); per_cu = 1; }
        (void)hipGetLastError();
        grid = cus;
    }
    if (grid < 0) return;
    (void)hipMemsetAsync((char*)d_ws + WS_CTL, 0, CTL_BYTES, stream);
    Args a{};
    for (int i = 0; i < 29; ++i) a.in[i] = (const float*)d_in[i];
    a.out = (float*)d_out; a.ws = (unsigned char*)d_ws;
#if MK_PER_PHASE
    for (int p = 0; p < N_PHASES; ++p) { a.ph_lo = p; a.ph_hi = p + 1; hipLaunchKernelGGL(mk_fwd, dim3(grid), dim3(NTHREADS), LDS_BYTES, stream, a); }
#else
    a.ph_lo = 0; a.ph_hi = N_PHASES;
    hipLaunchKernelGGL(mk_fwd, dim3(grid), dim3(NTHREADS), LDS_BYTES, stream, a);
#endif
    (void)in_sizes; (void)out_size;
}
```

```cpp
#include <hip/hip_runtime.h>
#include <cstdio>
#include <cstdint>

#define LAS __attribute__((address_space(3)))
#define DI __device__ __forceinline__
typedef unsigned short bf16_t;
typedef _Float16 h16;
typedef short bf16x8 __attribute__((ext_vector_type(8)));
typedef float f32x4 __attribute__((ext_vector_type(4)));
typedef int i32x4 __attribute__((ext_vector_type(4)));
typedef float f32x2 __attribute__((ext_vector_type(2)));
typedef float f32x16 __attribute__((ext_vector_type(16)));
typedef unsigned u32x4 __attribute__((ext_vector_type(4)));
typedef unsigned u32x2 __attribute__((ext_vector_type(2)));
typedef __bf16 bf16x2_n __attribute__((ext_vector_type(2)));
typedef _Float16 h16x2_n __attribute__((ext_vector_type(2)));

constexpr int D = 4096, NB = 4, SEQ = 4096, CTXL = 256;
constexpr int TL = NB * SEQ, TC = NB * CTXL, TT = TL + TC;
constexpr int DFF = 11008;
constexpr int HALF_W = 2048;
constexpr int COLS_A = 6784, COLS_A_PAD = 6912, COLS_B = 6144, NE = COLS_A_PAD + COLS_B;
constexpr int COLS_C = 2560, COLS_D = 6144, NO = COLS_C + COLS_D;
constexpr int NKEY = SEQ + CTXL;
constexpr int LORA_K = 1280, LORA_KU = 256, LORA_N = 5 * 2048;
constexpr int NTHREADS = 512;

constexpr size_t al256(size_t x) { return (x + 255) & ~(size_t)255; }
constexpr size_t WS_CTL = 0;
constexpr size_t CTL_CMAX = 65536;
constexpr int CM_FFI = 0, CM_INO = 2 * 2 * 11008, CM_INE = CM_INO + 8704, CM_MIX = CM_INE + 13056, CM_FFO1 = CM_MIX + 2 * 4096, CM_FFO0 = CM_FFO1 + 4096, CM_END = CM_FFO0 + 4096;
constexpr size_t CTL_BYTES = CTL_CMAX + (((size_t)CM_END * 4 + 255) & ~(size_t)255);
constexpr size_t WS_MOD = WS_CTL + CTL_BYTES;
constexpr size_t WS_SCAL = WS_MOD + al256((size_t)2 * 5 * 6 * D * 4);
constexpr size_t WS_CS = WS_SCAL + 256;
constexpr size_t WS_AXC = WS_CS + (((size_t)CM_END * 4 + 255) & ~(size_t)255);
constexpr size_t WS_AXS = WS_AXC + (size_t)SEQ * 32 * 4;
constexpr size_t WS_RTC = WS_AXS + (size_t)SEQ * 32 * 4;
constexpr size_t WS_RTS = WS_RTC + (size_t)NKEY * 64 * 4;
constexpr size_t WS_W = WS_RTS + (size_t)NKEY * 64 * 4;
constexpr size_t W_IN = 0;
constexpr size_t W_MIX = W_IN + (size_t)NE * D * 2;
constexpr size_t W_FFI = W_MIX + (size_t)D * D * 2;
constexpr size_t W_FFO = W_FFI + (size_t)2 * DFF * D * 2;
constexpr size_t W_LORA = W_FFO + (size_t)D * DFF * 2;
constexpr size_t W_BYTES = W_LORA + (size_t)LORA_N * LORA_K * 2;
constexpr size_t WS_H = WS_W + al256(W_BYTES);
constexpr size_t WS_XN = WS_H + (size_t)TT * D * 4;
constexpr size_t WS_W1 = WS_XN + (size_t)TT * D * 2;
constexpr size_t W1_MIX = 0, W1_FFI = W1_MIX + (size_t)D * D * 2, W1_FFO = W1_FFI + (size_t)2 * DFF * D * 2, W1_BYTES = W1_FFO + (size_t)D * DFF * 2;
constexpr size_t WS_ARENA = WS_W1 + al256(W1_BYTES);
constexpr size_t SZ16 = (size_t)TT * 2048 * 2;
constexpr size_t MOD_FLOATS = (size_t)2 * 5 * 6 * D;
constexpr size_t AR_XQ = 0, AR_XQS = (size_t)80 << 20;
constexpr size_t AR_MODP = 0;
constexpr size_t AR_PA = 0;
constexpr size_t AR_K = AR_PA + (size_t)TT * COLS_A_PAD * 2;
constexpr size_t AR_LA = AR_K + SZ16;
constexpr size_t RW_NCH = 136;
constexpr size_t CH_BYTES = 24576;
constexpr size_t AR_CH = 0;
constexpr size_t AR_CH_END = AR_CH + (size_t)256 * RW_NCH * CH_BYTES;
constexpr size_t AR_PB = AR_CH_END;
constexpr size_t AR_VT = AR_PB + (size_t)TT * COLS_B * 2;
constexpr size_t AR_R = AR_VT + (size_t)NB * 16 * 128 * NKEY * 2;
constexpr size_t AR_KK = AR_R + SZ16;
constexpr size_t AR_V = AR_KK + SZ16;
constexpr size_t AR_OMW = AR_V + SZ16;
constexpr size_t AR_BB = AR_OMW + 2 * SZ16;
constexpr size_t AR_KD = AR_BB + 2 * SZ16;
constexpr size_t AR_G = AR_KD + 2 * SZ16;
constexpr size_t AR_Y = AR_G + SZ16;
constexpr size_t AR_EVEN_END = AR_Y + 2 * SZ16;
static_assert(AR_LA + (size_t)TT * LORA_K * 2 <= AR_CH_END, "PA|K|LA must sit under the chunk matrices");
constexpr size_t AR_GU = 0;
constexpr size_t AR_SG = 0, AR_SU = AR_SG + (size_t)(TT / 64) * 4 * DFF * 2;
constexpr size_t AR_HQ = (size_t)64 << 20, AR_HQS = (size_t)320 << 20;
constexpr size_t AR_HID = AR_GU + (size_t)TT * 2 * DFF * 2;
constexpr size_t AR_FFN_END = AR_HID + (size_t)TT * DFF * 2;
constexpr size_t AR_P1 = 0;
constexpr size_t AR_VTC = AR_P1 + (size_t)TT * NO * 2;
constexpr size_t AR_RU = AR_VTC + (size_t)NB * 4 * 64 * NKEY * 2;
constexpr size_t AR_RS = AR_RU + (size_t)NB * 8 * 2 * 34 * 256 * 128 * 4;
constexpr size_t AR_ODD_END = AR_RS + (size_t)NB * 8 * 2 * 32 * 256 * 128 * 2;
constexpr size_t AR_SLAB = (size_t)1300 << 20;
constexpr size_t AR_SLAB_END = AR_SLAB + (size_t)4 * TC * D * 4;
static_assert(AR_SLAB >= AR_FFN_END, "slab overlaps the FFN buffers");
constexpr size_t cmax(size_t a, size_t b) { return a > b ? a : b; }
constexpr size_t AR_BYTES = cmax(cmax(AR_EVEN_END, AR_FFN_END), AR_ODD_END);
constexpr size_t WS_END = WS_ARENA + AR_BYTES;
static_assert(WS_END <= (size_t)3221225472ull, "workspace plan exceeds 4 x the largest input tensor");
static_assert(AR_SLAB_END <= AR_BYTES, "slab outside the arena");

DI float bf2f(bf16_t x) { return __uint_as_float((unsigned)x << 16); }
DI bf16_t f2bf(float x) { return __builtin_bit_cast(unsigned short, (__bf16)x); }
DI unsigned pk_bf16(float lo, float hi) { f32x2 v = {lo, hi}; return __builtin_bit_cast(unsigned, __builtin_convertvector(v, bf16x2_n)); }
DI unsigned pk_f16(float lo, float hi) { f32x2 v = {lo, hi}; return __builtin_bit_cast(unsigned, __builtin_convertvector(v, h16x2_n)); }
DI float bflo(unsigned w) { return __uint_as_float(w << 16); }
DI float bfhi(unsigned w) { return __uint_as_float(w & 0xffff0000u); }
DI float h16lo(unsigned w) { return (float)__builtin_bit_cast(h16x2_n, w)[0]; }
DI float h16hi(unsigned w) { return (float)__builtin_bit_cast(h16x2_n, w)[1]; }
DI float silu_f(float x) { return x * __builtin_amdgcn_rcpf(1.0f + __expf(-x)); }
DI float sigmoid_f(float x) { return __builtin_amdgcn_rcpf(1.0f + __expf(-x)); }
DI float wave_sum(float v) {
#pragma unroll
    for (int o = 32; o >= 1; o >>= 1) v += __shfl_xor(v, o);
    return v;
}
DI void load8f(const float* p, float (&o)[8]) { const f32x4 a = *(const f32x4*)p, b = *(const f32x4*)(p + 4);
#pragma unroll
    for (int j = 0; j < 4; ++j) { o[j] = a[j]; o[4 + j] = b[j]; } }
DI int row_modidx(int row) { return row < TL ? (row >> 12) : 4; }

#define XB_TMO      128
#define XB_XCNT(j)  (256  + 64 * (j))
#define XB_XSUB(j)  (1280 + 64 * (j))
#define XB_XGEN(j)  (2304 + 64 * (j))
#define XB_TOP      3328
#define XB_TOPGEN   3392
#define XCD_BAR_WORDS 3456
#define XB_SPIN_CAP (1u << 22)

__device__ __forceinline__ unsigned xb_ld(unsigned* p)              { return __hip_atomic_load(p, __ATOMIC_RELAXED, __HIP_MEMORY_SCOPE_AGENT); }
__device__ __forceinline__ unsigned xb_add(unsigned* p, unsigned v) { return __hip_atomic_fetch_add(p, v, __ATOMIC_RELAXED, __HIP_MEMORY_SCOPE_AGENT); }
__device__ __forceinline__ unsigned xb_xcc_id() { return (unsigned)__builtin_amdgcn_s_getreg((3 << 11) | 20) & 0xFu; }
#define XB_SPIN(cond, bar) do { unsigned _sp = 0; while (cond) { __builtin_amdgcn_s_sleep(1); \
    if ((++_sp & 255u) == 0u) { if (xb_ld(&(bar)[XB_TMO])) break; if (_sp > XB_SPIN_CAP) { atomicAdd(&(bar)[XB_TMO], 1u); break; } } } } while (0)

struct XcdBarrier {
    unsigned* bar; unsigned x;
    volatile LAS unsigned* st;
};

__device__ __forceinline__ XcdBarrier xcd_barrier_post(unsigned* bar, volatile LAS unsigned* st) {
    XcdBarrier b; b.bar = bar; b.x = xb_xcc_id(); b.st = st;
    if (threadIdx.x == 0) (void)xb_add(&bar[XB_XCNT(b.x)], 1u);
    return b;
}
__device__ __forceinline__ void xcd_barrier_complete(unsigned* bar, unsigned x, unsigned& nloc, unsigned& nx) {
    const unsigned G = gridDim.x * gridDim.y * gridDim.z;
    unsigned sum, cnt, mine, sp = 0u;
    for (;;) {
        sum = 0u; cnt = 0u; mine = 0u;
#pragma unroll
        for (unsigned j = 0; j < 16; ++j) { const unsigned c = xb_ld(&bar[XB_XCNT(j)]); sum += c; cnt += (c > 0u) ? 1u : 0u; mine = (j == x) ? c : mine; }
        if (sum == G) break;
        __builtin_amdgcn_s_sleep(1);
        if ((++sp & 255u) == 0u) { if (xb_ld(&bar[XB_TMO])) break; if (sp > XB_SPIN_CAP) { atomicAdd(&bar[XB_TMO], 1u); break; } }
    }
    nloc = mine > 0u ? mine : 1u; nx = cnt > 0u ? cnt : 1u;
}

__device__ __forceinline__ void xcd_barrier(const XcdBarrier& b) {
    asm volatile("s_waitcnt vmcnt(0)" ::: "memory");
    __syncthreads();
    if (threadIdx.x == 0) {
        unsigned* bar = b.bar;
        __builtin_amdgcn_s_waitcnt(0);
        unsigned nloc = b.st[0], nx = b.st[1];
        if (nloc == 0u) { xcd_barrier_complete(bar, b.x, nloc, nx); b.st[0] = nloc; b.st[1] = nx; }
        const unsigned old = xb_add(&bar[XB_XSUB(b.x)], 1u);
        const unsigned gen = old / nloc;
        if (old + 1u == (gen + 1u) * nloc) {
            __builtin_amdgcn_fence(__ATOMIC_RELEASE, "agent");
            asm volatile("s_waitcnt vmcnt(0)" ::: "memory");
            const unsigned og = xb_add(&bar[XB_TOP], 1u);
            const unsigned tg = og / nx;
            if (og + 1u == (tg + 1u) * nx) xb_add(&bar[XB_TOPGEN], 1u);
            else XB_SPIN(xb_ld(&bar[XB_TOPGEN]) == tg, bar);
            __builtin_amdgcn_fence(__ATOMIC_ACQUIRE, "agent");
            xb_add(&bar[XB_XGEN(b.x)], 1u);
            asm volatile("s_waitcnt vmcnt(0)" ::: "memory");
        } else {
            XB_SPIN(xb_ld(&bar[XB_XGEN(b.x)]) == gen, bar);
            __builtin_amdgcn_fence(__ATOMIC_ACQUIRE, "agent");
            asm volatile("s_waitcnt vmcnt(0)" ::: "memory");
        }
    }
    __syncthreads();
}

namespace pg8 {
#define PG8_LAS __attribute__((address_space(3)))
constexpr int BM = 256, BK = 64, HALF = 128, HTB = HALF * BK * 2  , STAGE_BYTES = 8 * HTB, NXCD = 8, WGM = 4;

__host__ __device__ __forceinline__ int lds_byte(int r, int c) { const int st = (r >> 4) * 2 + (c >> 5), rr = r & 15, cc = c & 31, ob = rr * 64 + cc * 2; return st * 1024 + (ob ^ (((ob >> 9) & 1) << 5)); }
__host__ __device__ __forceinline__ void stage_rc(int b, int& R, int& C) { const int st = b / 1024, sb = b % 1024, swz = sb ^ (((sb >> 9) & 1) << 5); R = (st >> 1) * 16 + swz / 64; C = (st & 1) * 32 + (swz % 64) / 2; }
__host__ __device__ __forceinline__ int perm32(int rho) { const int n = rho >> 4, i = rho & 15; return 8 * (i >> 2) + 4 * n + (i & 3); }

struct Unit { int pm, pn, koff, nt, part; };
struct Gemm { const bf16_t* A; const bf16_t* Bt; int M, N, K; };

struct StaticOrder {
    int nM, nN, nwg, G, c, ntk;
    __host__ __device__ void init(int M, int N, int G_, int c_, int K_ = 0) { nM = M / BM; nN = N / BM; nwg = nM * nN; G = G_; c = c_; ntk = K_ / BK; }
    __host__ __device__ bool next(int i, Unit& u) const {
        const long L = (long)i * G + c; if (L >= nwg) return false;
        int wgid = (int)L; { const int q = nwg / NXCD, r = nwg % NXCD, xcd = wgid % NXCD, off = wgid / NXCD; wgid = (xcd < r ? xcd * (q + 1) : r * (q + 1) + (xcd - r) * q) + off; }
        const int nig = WGM * nN, gid = wgid / nig, fm = gid * WGM, gsz = (nM - fm) < WGM ? (nM - fm) : WGM;
        u.pm = fm + ((wgid % nig) % gsz); u.pn = (wgid % nig) / gsz; u.koff = 0; u.nt = ntk; u.part = -1; return true;
    }
    __device__ __forceinline__ void a_ready(const Unit&) const {}
    __device__ __forceinline__ void done(const Unit&) const {}
};


template <class Epi, class Sched>
__device__ __forceinline__ void gemm_phase(PG8_LAS unsigned char* lds, const Gemm g, const Sched& S, const Epi& E) {
    const int tid = threadIdx.x, wid = __builtin_amdgcn_readfirstlane(tid >> 6), lane = tid & 63, wr = wid >> 2, wc = wid & 3, fr = lane & 15, fq = lane >> 4;
    const int K = g.K;
    unsigned voffA[2], voffB[2];
#pragma unroll
    for (int i = 0; i < 2; ++i) { int R, C; stage_rc(tid * 16 + i * 8192, R, C); const int Rb = Epi::PERM ? ((R & ~31) + perm32(R & 31)) : R;
        voffA[i] = (unsigned)(R * K + C) * 2u; voffB[i] = (unsigned)(Rb * K + C) * 2u; }
    const size_t kstep = (size_t)(BK * 2);
    const size_t hstep = (size_t)HALF * K * 2;
    const size_t tstep = 2 * hstep;
    const unsigned ldsw = (unsigned)wid * 1024u;
    const int aoff = lds_byte(wr * 64 + fr, fq * 8), boff = lds_byte(wc * 32 + fr, fq * 8);
#define PG8_SA(b, h) (((b) * 2 + (h)) * HTB)
#define PG8_SB(b, h) ((4 + (b) * 2 + (h)) * HTB)
#define PG8_STAGE(bufoff, gbase, voff) do { _Pragma("unroll") for (int _i = 0; _i < 2; ++_i) \
        __builtin_amdgcn_global_load_lds((const unsigned*)((const char*)(gbase) + (voff)[_i]), (PG8_LAS unsigned*)(lds + (bufoff) + ldsw + _i * 8192), 16, 0, 0); } while (0)
#define PG8_LDA(dst, b, h) do { _Pragma("unroll") for (int m = 0; m < 4; ++m) _Pragma("unroll") for (int k = 0; k < 2; ++k) dst[m][k] = *(const PG8_LAS bf16x8*)(lds + PG8_SA(b, h) + aoff + m * 2048 + k * 1024); } while (0)
#define PG8_LDB(dst, b, h) do { _Pragma("unroll") for (int n = 0; n < 2; ++n) _Pragma("unroll") for (int k = 0; k < 2; ++k) dst[n][k] = *(const PG8_LAS bf16x8*)(lds + PG8_SB(b, h) + boff + n * 2048 + k * 1024); } while (0)
#define PG8_MMA(ai, bj, At, Bt) do { __builtin_amdgcn_s_setprio(1); _Pragma("unroll") for (int m = 0; m < 4; ++m) _Pragma("unroll") for (int n = 0; n < 2; ++n) _Pragma("unroll") for (int k = 0; k < 2; ++k) \
        { if constexpr (Epi::I8) acc[ai][bj][m][n] = __builtin_bit_cast(f32x4, __builtin_amdgcn_mfma_i32_16x16x64_i8(__builtin_bit_cast(i32x4, Bt[n][k]), __builtin_bit_cast(i32x4, At[m][k]), __builtin_bit_cast(i32x4, acc[ai][bj][m][n]), 0, 0, 0)); \
          else acc[ai][bj][m][n] = __builtin_amdgcn_mfma_f32_16x16x32_bf16(Bt[n][k], At[m][k], acc[ai][bj][m][n], 0, 0, 0); } __builtin_amdgcn_s_setprio(0); } while (0)
#define PG8_WAIT_V(n) asm volatile("s_waitcnt vmcnt(" #n ")" ::: "memory")
#define PG8_WAIT_L(n) asm volatile("s_waitcnt lgkmcnt(" #n ")" ::: "memory")
#define PG8_BAR __builtin_amdgcn_s_barrier()
#define PG8_SCHED __builtin_amdgcn_sched_barrier(0)
    Unit cur, nxt; int ui = 0;
    if (!S.next(0, cur)) return;
    f32x4 acc[2][2][4][2];
#pragma unroll
    for (int a = 0; a < 2; ++a)
#pragma unroll
        for (int b = 0; b < 2; ++b)
#pragma unroll
            for (int m = 0; m < 4; ++m)
#pragma unroll
                for (int n = 0; n < 2; ++n) acc[a][b][m][n] = (f32x4){0.f, 0.f, 0.f, 0.f};
    bf16x8 At[4][2], B0[2][2], B1[2][2];
    const char* cA = (const char*)g.A + (size_t)cur.pm * tstep + cur.koff; const char* cB = (const char*)g.Bt + (size_t)cur.pn * tstep + cur.koff;
    S.a_ready(cur);
    PG8_STAGE(PG8_SB(0, 0), cB, voffB); PG8_STAGE(PG8_SB(0, 1), cB + hstep, voffB); PG8_STAGE(PG8_SA(0, 0), cA, voffA); PG8_STAGE(PG8_SA(0, 1), cA + hstep, voffA);
    if (wr == 1) PG8_BAR;
    PG8_WAIT_V(2); PG8_BAR;
    PG8_STAGE(PG8_SB(1, 0), cB + kstep, voffB); PG8_STAGE(PG8_SA(1, 0), cA + kstep, voffA); PG8_STAGE(PG8_SB(1, 1), cB + hstep + kstep, voffB);
    PG8_WAIT_V(6); PG8_BAR;
    for (;;) {
        const bool has_next = S.next(ui + 1, nxt);
        const char* nA = has_next ? (const char*)g.A + (size_t)nxt.pm * tstep + nxt.koff : cA; const char* nB = has_next ? (const char*)g.Bt + (size_t)nxt.pn * tstep + nxt.koff : cB;
        const int nt = cur.nt;
        for (int t = 0; t < nt; t += 2) {
            const bool last = (t == nt - 2);
            const char* a1 = cA + (size_t)(t + 1) * kstep;
            const char* a2 = last ? nA : cA + (size_t)(t + 2) * kstep; const char* b2 = last ? nB : cB + (size_t)(t + 2) * kstep;
            const char* a3 = a2 + kstep; const char* b3 = b2 + kstep;
            if (last && has_next) S.a_ready(nxt);
            PG8_LDB(B0, 0, 0); PG8_LDB(B1, 0, 1); PG8_SCHED; PG8_LDA(At, 0, 0); PG8_STAGE(PG8_SA(1, 1), a1 + hstep, voffA);
            PG8_WAIT_V(8); PG8_WAIT_L(0); PG8_BAR; PG8_MMA(0, 0, At, B0); PG8_MMA(0, 1, At, B1); PG8_BAR; PG8_SCHED;
            PG8_LDA(At, 0, 1); PG8_STAGE(PG8_SB(0, 0), b2, voffB); PG8_STAGE(PG8_SB(0, 1), b2 + hstep, voffB); PG8_STAGE(PG8_SA(0, 0), a2, voffA);
            PG8_WAIT_V(8); PG8_WAIT_L(0); PG8_BAR; PG8_MMA(1, 0, At, B0); PG8_MMA(1, 1, At, B1); PG8_BAR; PG8_SCHED;
            PG8_LDB(B0, 1, 0); PG8_LDB(B1, 1, 1); PG8_SCHED; PG8_LDA(At, 1, 0); PG8_STAGE(PG8_SA(0, 1), a2 + hstep, voffA);
            PG8_WAIT_V(8); PG8_WAIT_L(0); PG8_BAR; PG8_MMA(0, 0, At, B0); PG8_MMA(0, 1, At, B1); PG8_BAR; PG8_SCHED;
            PG8_LDA(At, 1, 1); PG8_STAGE(PG8_SB(1, 0), b3, voffB); PG8_STAGE(PG8_SB(1, 1), b3 + hstep, voffB); PG8_STAGE(PG8_SA(1, 0), a3, voffA);
            PG8_WAIT_V(8); PG8_WAIT_L(0); PG8_BAR; PG8_MMA(1, 0, At, B0); PG8_MMA(1, 1, At, B1); PG8_BAR; PG8_SCHED;
        }
        if (wr == 0) PG8_BAR;
        if constexpr (Epi::I8) E.prescale(acc, cur, wr, wc, fr, fq);
        if constexpr (!Epi::AFTER_DRAIN) { E(acc, cur, wr, wc, fr, fq); S.done(cur); }
        if (!has_next) break;
#pragma unroll
        for (int a = 0; a < 2; ++a)
#pragma unroll
            for (int b = 0; b < 2; ++b)
#pragma unroll
                for (int m = 0; m < 4; ++m)
#pragma unroll
                    for (int n = 0; n < 2; ++n) acc[a][b][m][n] = (f32x4){0.f, 0.f, 0.f, 0.f};
        cur = nxt; cA = nA; cB = nB; ++ui;
        if (wr == 1) PG8_BAR;
    }
    PG8_WAIT_V(0);
    PG8_BAR;
    if constexpr (Epi::AFTER_DRAIN) { E.fused(acc, cur, wr, wc, fr, fq, lds, wid, lane); S.done(cur); }
#undef PG8_SA
#undef PG8_SB
#undef PG8_STAGE
#undef PG8_LDA
#undef PG8_LDB
#undef PG8_MMA
#undef PG8_WAIT_V
#undef PG8_WAIT_L
#undef PG8_BAR
#undef PG8_SCHED
}

}

#ifndef INO_I8
#define INO_I8 0
#endif
#ifndef FFO1_I8
#define FFO1_I8 1
#endif
#ifndef FFO0_I8
#define FFO0_I8 1
#endif
#ifndef MIX_I8
#define MIX_I8 0
#endif
#ifndef FFN_I8
#define FFN_I8 1
#endif
struct Args { const float* in[29]; float* out; unsigned char* ws; int ph_lo, ph_hi; };
struct Ctx {
    const float* in[29]; float* out; unsigned char* ws; unsigned char* ar;
    LAS unsigned char* lds;
    int tid, lane, wave;
};
enum { I_X = 0, I_C, I_CTX, I_CCTX, I_WMOD, I_BMOD, I_WINE, I_MU, I_W0, I_W2, I_A0, I_A2, I_G2, I_KK, I_KA, I_RK, I_LNW, I_LNB, I_LAM, I_SUBLN,
       I_WINO, I_SINK, I_RDEC, I_WMIX, I_WFFI, I_CONVW, I_CONVB, I_WFFO, I_FNORM };

__device__ __forceinline__ void p_mod(const Ctx& c) {
    LAS float* sc = (LAS float*)c.lds;
    LAS float* red = sc + 5 * 4096;
    const int tid = c.tid, lane = c.lane, w = c.wave;
    for (int i = tid; i < 5 * 4096; i += NTHREADS) { const int r = i >> 12, k = i & 4095; const float v = r < 4 ? c.in[I_C][r * 4096 + k] : c.in[I_CCTX][k]; sc[i] = silu_f(v); }
    __syncthreads();
    float* MODP = (float*)(c.ar + AR_MODP);
    for (int u = blockIdx.x; u < 768; u += gridDim.x) {
        const int kp = u & 3, cg = (u >> 2) % 96, l = u / 384;
        const int k0 = kp * 1024 + w * 128;
        const float* wp = c.in[I_WMOD] + ((size_t)l * 4096 + k0) * 24576 + cg * 256 + lane * 4;
        f32x4 acc[5];
#pragma unroll
        for (int r = 0; r < 5; ++r) acc[r] = (f32x4){0.f, 0.f, 0.f, 0.f};
#pragma unroll 2
        for (int k = 0; k < 128; k += 4) {
            f32x4 wv[4];
#pragma unroll
            for (int j = 0; j < 4; ++j) wv[j] = __builtin_nontemporal_load((const f32x4*)(wp + (size_t)(k + j) * 24576));
#pragma unroll
            for (int r = 0; r < 5; ++r) { const f32x4 s4 = *(const LAS f32x4*)(sc + r * 4096 + k0 + k);
#pragma unroll
                for (int j = 0; j < 4; ++j) acc[r] += wv[j] * s4[j]; }
        }
#pragma unroll
        for (int r = 0; r < 5; ++r) *(LAS f32x4*)(red + (w * 5 + r) * 256 + lane * 4) = acc[r];
        __syncthreads();
        for (int idx = tid; idx < 5 * 256; idx += NTHREADS) { const int r = idx >> 8, col = idx & 255; float s = 0.f;
#pragma unroll
            for (int q = 0; q < 8; ++q) s += red[(q * 5 + r) * 256 + col];
            if (kp == 0) s += c.in[I_BMOD][l * 24576 + cg * 256 + col];
            MODP[(size_t)kp * MOD_FLOATS + ((size_t)l * 5 + r) * 24576 + cg * 256 + col] = s; }
        __syncthreads();
    }
}

__device__ __forceinline__ void p_mod_finalize(const Ctx& c) {
    const float* MODP = (const float*)(c.ar + AR_MODP); float* MOD = (float*)(c.ws + WS_MOD);
    for (size_t i = ((size_t)blockIdx.x * NTHREADS + c.tid) * 4; i < MOD_FLOATS; i += (size_t)gridDim.x * NTHREADS * 4)
        *(f32x4*)(MOD + i) = (*(const f32x4*)(MODP + i) + *(const f32x4*)(MODP + MOD_FLOATS + i)) + (*(const f32x4*)(MODP + 2 * MOD_FLOATS + i) + *(const f32x4*)(MODP + 3 * MOD_FLOATS + i));
}
DI int perm64(int m) { const int within = m & 255, rho = within & 127; return (m & ~255) + (rho >> 5) * 64 + (within >> 7) * 32 + (rho & 31); }
DI int perm128(int m) { const int within = m & 255, rho = within & 127; return (m & ~255) + (rho >> 6) * 128 + (within >> 7) * 64 + (rho & 63); }
DI int in_odd_src(int n) { return n < 2304 ? perm64(n) : (n < 2560 ? n : (n < 4608 ? 2560 + perm128(n - 2560) : n)); }
__device__ __forceinline__ int p_convert_job(const Ctx& c, const float* __restrict__ src, int src_ld, int K, int n0, int ncnt, bf16_t* __restrict__ dst, int dn0, int base, int nperm = 0) {
    LAS unsigned short* T = (LAS unsigned short*)c.lds;
    const int tid = c.tid, tk = K / 64, tn = ncnt / 128, nt = tk * tn, G = (int)gridDim.x;
    int first = (int)blockIdx.x - (base % G); if (first < 0) first += G;
    const int kr = tid >> 3, c16 = (tid & 7) * 16, wn = tid >> 2, k16 = (tid & 3) * 16;
    f32x4 v[4], vn[4];
    if (first < nt) { const int nn = (first / tk) * 128 + c16; const float* p = src + (size_t)((first % tk) * 64 + kr) * src_ld + n0 + (nn < nperm ? perm64(nn) : nn);
#pragma unroll
        for (int i = 0; i < 4; ++i) v[i] = __builtin_nontemporal_load((const f32x4*)(p + 4 * i)); }
    for (int t = first; t < nt; t += G) {
        const int t2 = t + G;
        if (t2 < nt) { const int nn = (t2 / tk) * 128 + c16; const float* p = src + (size_t)((t2 % tk) * 64 + kr) * src_ld + n0 + (nn < nperm ? perm64(nn) : nn);
#pragma unroll
            for (int i = 0; i < 4; ++i) vn[i] = __builtin_nontemporal_load((const f32x4*)(p + 4 * i)); }
#pragma unroll
        for (int i = 0; i < 4; ++i)
#pragma unroll
            for (int j = 0; j < 4; ++j) T[(c16 + 4 * i + j) * 72 + kr] = f2bf(v[i][j]);
        __syncthreads();
        { const u32x4 a = *(const LAS u32x4*)(T + wn * 72 + k16), b = *(const LAS u32x4*)(T + wn * 72 + k16 + 8);
          bf16_t* q = dst + (size_t)(dn0 + (t / tk) * 128 + wn) * K + (t % tk) * 64 + k16;
          *(u32x4*)q = a; *(u32x4*)(q + 8) = b; }
        __syncthreads();
#pragma unroll
        for (int i = 0; i < 4; ++i) v[i] = vn[i];
    }
    return base + nt;
}
DI void conv_wave_tile(const float* __restrict__ src, int src_ld, int k0, int nsrc, int n0, bf16_t* __restrict__ dst, int K, int lane) {
    float v[32];
    const float* p = src + (size_t)k0 * src_ld + nsrc;
#pragma unroll
    for (int kk = 0; kk < 32; ++kk) v[kk] = __builtin_nontemporal_load(p + (size_t)kk * src_ld);
    bf16_t* q = dst + (size_t)(n0 + lane) * K + k0;
#pragma unroll
    for (int g = 0; g < 4; ++g) { u32x4 w; w.x = pk_bf16(v[8 * g], v[8 * g + 1]); w.y = pk_bf16(v[8 * g + 2], v[8 * g + 3]); w.z = pk_bf16(v[8 * g + 4], v[8 * g + 5]); w.w = pk_bf16(v[8 * g + 6], v[8 * g + 7]);
        *(u32x4*)(q + 8 * g) = w; }
}
DI unsigned pk_i8x4(float a, float b, float c2, float d) { const int ia = (int)rintf(a), ib = (int)rintf(b), ic = (int)rintf(c2), id = (int)rintf(d);
    return ((unsigned)ia & 255u) | (((unsigned)ib & 255u) << 8) | (((unsigned)ic & 255u) << 16) | ((unsigned)id << 24); }
template <class T> DI void fwht32(T (&v)[32]) {
#pragma unroll
    for (int h = 1; h < 32; h <<= 1)
#pragma unroll
        for (int i = 0; i < 32; i += 2 * h)
#pragma unroll
            for (int j = i; j < i + h; ++j) { const T a = v[j], b = v[j + h]; v[j] = a + b; v[j + h] = a - b; }
}
DI unsigned* i8_cmax(const Ctx& c, int off) { return (unsigned*)(c.ws + WS_CTL + CTL_CMAX) + off; }
DI float* i8_cs(const Ctx& c, int off) { return (float*)(c.ws + WS_CS) + off; }
DI void conv_wave_tile_q8(const float* __restrict__ src, int src_ld, int k0, int nsrc, int n0, unsigned char* __restrict__ dst, int K, int lane, const unsigned* cmax, float* cs) {
    float v[32];
    const float* p = src + (size_t)k0 * src_ld + nsrc;
#pragma unroll
    for (int kk = 0; kk < 32; ++kk) v[kk] = __builtin_nontemporal_load(p + (size_t)kk * src_ld);
    const float cm = __uint_as_float(cmax[nsrc]); const float qs = cm > 0.f ? 127.0f / cm : 0.f;
    if (k0 == 0) cs[n0 + lane] = cm * (1.0f / 127.0f);
    fwht32(v);
    unsigned char* q = dst + (size_t)(n0 + lane) * K + k0;
#pragma unroll
    for (int g = 0; g < 2; ++g) { u32x4 w;
#pragma unroll
        for (int j = 0; j < 4; ++j) w[j] = pk_i8x4(v[16 * g + 4 * j] * 0.03125f * qs, v[16 * g + 4 * j + 1] * 0.03125f * qs, v[16 * g + 4 * j + 2] * 0.03125f * qs, v[16 * g + 4 * j + 3] * 0.03125f * qs);
        *(u32x4*)(q + 16 * g) = w; }
}
struct CmxDeal { int worker, nworkers, lo, hi; };
__device__ __forceinline__ int p_wcolmax_job(const Ctx& c, const float* __restrict__ src0, int ld, int K, unsigned* cmax, int base, const CmxDeal dl) {
    LAS float* red = (LAS float*)c.lds;
    const int ncg = (ld + 255) / 256, nko = (K + 1023) / 1024, nitem = ncg * nko;
    int g0 = dl.lo + dl.worker; if (g0 < base) g0 += ((base - g0 + dl.nworkers - 1) / dl.nworkers) * dl.nworkers;
    const int gend = dl.hi < base + nitem ? dl.hi : base + nitem;
#pragma unroll 1
    for (int g = g0; g < gend; g += dl.nworkers) { const int it = g - base;
        const int cg = it % ncg, ko = it / ncg, col = cg * 256 + c.lane * 4;
        f32x4 mx = {0.f, 0.f, 0.f, 0.f};
        if (col < ld && ko * 1024 + c.wave * 128 < K) {
#pragma unroll 1
            for (int t = 0; t < 4; ++t) {
                f32x4 v[32]; const float* p = src0 + (size_t)(ko * 1024 + c.wave * 128 + t * 32) * ld + col;
#pragma unroll
                for (int kk = 0; kk < 32; ++kk) v[kk] = __builtin_nontemporal_load((const f32x4*)(p + (size_t)kk * ld));
                fwht32(v);
#pragma unroll
                for (int kk = 0; kk < 32; ++kk)
#pragma unroll
                    for (int j = 0; j < 4; ++j) mx[j] = fmaxf(mx[j], fabsf(v[kk][j]));
            }
        }
        *(LAS f32x4*)(red + c.wave * 256 + c.lane * 4) = mx;
        __syncthreads();
        if (c.tid < 256) { float m = red[c.tid];
#pragma unroll
            for (int w = 1; w < 8; ++w) m = fmaxf(m, red[w * 256 + c.tid]);
            const int cc = cg * 256 + c.tid; if (cc < ld) atomicMax(cmax + cc, __float_as_uint(m * 0.03125f)); }
        __syncthreads();
    }
    return base + nitem;
}
constexpr int CMX_TOTAL = (FFN_I8 ? 2 * (2 * DFF / 256) * (D / 1024) : 0) + (INO_I8 ? (NO / 256) * (D / 1024) : 0) + ((FFO0_I8 ? 1 : 0) + (FFO1_I8 ? 1 : 0)) * (D / 256) * ((DFF + 1023) / 1024) + (MIX_I8 ? 2 * (D / 256) * (D / 1024) : 0);
__device__ __forceinline__ void p_wcolmax(const Ctx& c, const CmxDeal dl) {
    int base = 0;
    __syncthreads();
    if (FFN_I8) { base = p_wcolmax_job(c, c.in[I_WFFI], 2 * DFF, D, i8_cmax(c, CM_FFI), base, dl); base = p_wcolmax_job(c, c.in[I_WFFI] + (size_t)D * 2 * DFF, 2 * DFF, D, i8_cmax(c, CM_FFI + 2 * DFF), base, dl); }
    if (INO_I8) base = p_wcolmax_job(c, c.in[I_WINO], NO, D, i8_cmax(c, CM_INO), base, dl);
    if (FFO0_I8) base = p_wcolmax_job(c, c.in[I_WFFO], D, DFF, i8_cmax(c, CM_FFO0), base, dl);
    if (FFO1_I8) base = p_wcolmax_job(c, c.in[I_WFFO] + (size_t)DFF * D, D, DFF, i8_cmax(c, CM_FFO1), base, dl);
    if (MIX_I8) { base = p_wcolmax_job(c, c.in[I_WMIX], D, D, i8_cmax(c, CM_MIX), base, dl); base = p_wcolmax_job(c, c.in[I_WMIX] + (size_t)D * D, D, D, i8_cmax(c, CM_MIX + D), base, dl); }
}
#ifndef CMX_P0
#define CMX_P0 624
#endif
DI int cmx_ns(int G) { return G == 256 ? 8 : 0; }
DI int cmx_p0(int G) { return cmx_ns(G) ? (CMX_P0 < CMX_TOTAL ? CMX_P0 : CMX_TOTAL) : CMX_TOTAL; }
__device__ __forceinline__ void p_weights_layer0(const Ctx& c) {
    bf16_t* W = (bf16_t*)(c.ws + WS_W);
    {   constexpr int T_IN = (4096 / 32) * ((COLS_A + COLS_B) / 64), T_MIX = (4096 / 32) * (4096 / 64), T_L96 = 3 * (2048 / 64), T_LG = 8 * (2048 / 64);
        constexpr int E0 = T_IN, E1 = E0, E2 = E1 + 4 * T_L96, E3 = E2 + T_LG;
        bf16_t* L = (bf16_t*)((unsigned char*)W + W_LORA);
        for (int t = blockIdx.x * 8 + c.wave; t < E3; t += gridDim.x * 8) {
            if (t < E0) { const int kt = t & 127, g = t >> 7, n = g * 64 + c.lane;
                const int nsrc = n < COLS_A ? n : COLS_A + (n - COLS_A < 4096 ? perm64(n - COLS_A) : n - COLS_A);
                conv_wave_tile(c.in[I_WINE], COLS_A + COLS_B, kt * 32, nsrc, n < COLS_A ? g * 64 : g * 64 + (COLS_A_PAD - COLS_A), (bf16_t*)((unsigned char*)W + W_IN), 4096, c.lane); }
            else if (t < E1) { const int tl = t - E0, kt = tl & 127, g = tl >> 7;
                conv_wave_tile(c.in[I_WMIX], 4096, kt * 32, g * 64 + c.lane, g * 64, (bf16_t*)((unsigned char*)W + W_MIX), 4096, c.lane); }
            else if (t < E2) { const int tl = t - E1, type = tl / T_L96, r2 = tl % T_L96, kt = r2 % 3, g = r2 / 3;
                const float* src = (type < 2 ? c.in[I_W2] + (size_t)type * 96 * 2048 : c.in[I_A2] + (size_t)(type - 2) * 96 * 2048);
                conv_wave_tile(src, 2048, kt * 32, g * 64 + c.lane, g * 64, L + (size_t)type * 2048 * LORA_K + type * LORA_KU, LORA_K, c.lane); }
            else { const int tl = t - E2, kt = tl & 7, g = tl >> 3;
                conv_wave_tile(c.in[I_G2], 2048, kt * 32, g * 64 + c.lane, g * 64, L + (size_t)4 * 2048 * LORA_K + 4 * LORA_KU, LORA_K, c.lane); }
        }
    }
    const size_t gtid = (size_t)blockIdx.x * NTHREADS + c.tid, gn = (size_t)gridDim.x * NTHREADS;
    { u32x4* z = (u32x4*)((unsigned char*)W + W_IN + (size_t)COLS_A * 4096 * 2); const size_t n16 = (size_t)(COLS_A_PAD - COLS_A) * 4096 * 2 / 16;
      for (size_t i = gtid; i < n16; i += gn) z[i] = (u32x4){0u, 0u, 0u, 0u}; }
    { bf16_t* L = (bf16_t*)((unsigned char*)W + W_LORA);
      for (size_t i = gtid; i < (size_t)4 * 2048 * 20; i += gn) { const int n = (int)(i / 20), ch = (int)(i % 20), type = n >> 11;
          *(u32x4*)(L + (size_t)n * LORA_K + type * LORA_KU + 96 + ch * 8) = (u32x4){0u, 0u, 0u, 0u}; } }
    { float* axc = (float*)(c.ws + WS_AXC); float* axs = (float*)(c.ws + WS_AXS);
      for (size_t i = gtid; i < (size_t)SEQ * 32; i += gn) { const int pos = (int)(i >> 5), a = (int)(i & 31), q = a & 15;
          const float inv = powf(10000.0f, -(float)q / 16.0f); const float p = (a < 16) ? (float)(pos >> 6) : (float)(pos & 63);
          float sn, cs; sincosf(p * inv, &sn, &cs); axc[i] = cs; axs[i] = sn; } }
    { float* rtc = (float*)(c.ws + WS_RTC); float* rts = (float*)(c.ws + WS_RTS);
      for (size_t i = gtid; i < (size_t)NKEY * 64; i += gn) { const int pos = (int)(i >> 6), a = (int)(i & 63);
          const float t = (float)a / 63.0f; const float inv = powf(10000.0f, -t);
          float sn, cs; sincosf((float)pos * inv, &sn, &cs); rtc[i] = cs; rts[i] = sn; } }
    if (gtid == 0) { const float* lv = c.in[I_LAM]; float s01 = 0.f, s23 = 0.f;
        for (int i = 0; i < 64; ++i) { s01 += lv[i] * lv[64 + i]; s23 += lv[128 + i] * lv[192 + i]; }
        ((float*)(c.ws + WS_SCAL))[0] = expf(s01) - expf(s23) + 0.2f; }
}
constexpr int CONV_SPLIT = 128192;
__device__ __forceinline__ void p_convert_deferred(const Ctx& c, int worker, int nworkers, int tlo, int thi) {
    unsigned char* W = c.ws + WS_W; unsigned char* W1 = c.ws + WS_W1;
    constexpr int T_FFI = (4096 / 32) * (2 * DFF / 64), T_FFO = (DFF / 32) * (4096 / 64), T_IN1 = (4096 / 32) * (NO / 64), T_MIX = (4096 / 32) * (4096 / 64);
    constexpr int EM = T_MIX, E0 = EM + T_FFI, E1 = E0 + T_FFO, E2 = E1 + T_IN1, E3 = E2 + T_MIX, E4 = E3 + T_FFI, E5 = E4 + T_FFO;
    const int tend = thi < E5 ? thi : E5;
    for (int t = tlo + worker; t < tend; t += nworkers) {
        const float* src; int ld, K, tl; bf16_t* dst; int mixl = -1;
        if (t < EM) { src = c.in[I_WMIX]; ld = 4096; K = 4096; tl = t; dst = (bf16_t*)(W + W_MIX); mixl = 0; }
        else if (t < E0) { src = c.in[I_WFFI]; ld = 2 * DFF; K = 4096; tl = t - EM; dst = (bf16_t*)(W + W_FFI); }
        else if (t < E1) { src = c.in[I_WFFO]; ld = 4096; K = DFF; tl = t - E0; dst = (bf16_t*)(W + W_FFO); mixl = 3; }
        else if (t < E2) { src = c.in[I_WINO]; ld = NO; K = 4096; tl = t - E1; dst = (bf16_t*)(W + W_IN); }
        else if (t < E3) { src = c.in[I_WMIX] + (size_t)4096 * 4096; ld = 4096; K = 4096; tl = t - E2; dst = (bf16_t*)(W1 + W1_MIX); mixl = 1; }
        else if (t < E4) { src = c.in[I_WFFI] + (size_t)4096 * 2 * DFF; ld = 2 * DFF; K = 4096; tl = t - E3; dst = (bf16_t*)(W1 + W1_FFI); }
        else { src = c.in[I_WFFO] + (size_t)DFF * 4096; ld = 4096; K = DFF; tl = t - E4; dst = (bf16_t*)(W1 + W1_FFO); mixl = 2; }
        const int tk = K / 32, kt = tl % tk, ntile = tl / tk;
        int ncol = ntile * 64;
        if (ld == 2 * DFF) { const int tile = ncol >> 8, within = ncol & 255; ncol = within < 128 ? 128 * tile + within : DFF + 128 * tile + (within - 128); }
        const int nsrc = (ld == NO) ? in_odd_src(ntile * 64 + c.lane) : ncol + c.lane;
        if (FFN_I8 && ld == 2 * DFF) { const int off = CM_FFI + (t < E0 ? 0 : 2 * DFF); conv_wave_tile_q8(src, ld, kt * 32, nsrc, ntile * 64, (unsigned char*)dst, K, c.lane, i8_cmax(c, off), i8_cs(c, off)); }
        else if (FFO0_I8 && mixl == 3) conv_wave_tile_q8(src, ld, kt * 32, nsrc, ntile * 64, (unsigned char*)dst, K, c.lane, i8_cmax(c, CM_FFO0), i8_cs(c, CM_FFO0));
        else if (FFO1_I8 && mixl == 2) conv_wave_tile_q8(src, ld, kt * 32, nsrc, ntile * 64, (unsigned char*)dst, K, c.lane, i8_cmax(c, CM_FFO1), i8_cs(c, CM_FFO1));
        else if (MIX_I8 && mixl >= 0 && mixl < 2) conv_wave_tile_q8(src, ld, kt * 32, nsrc, ntile * 64, (unsigned char*)dst, K, c.lane, i8_cmax(c, CM_MIX + mixl * D), i8_cs(c, CM_MIX + mixl * D));
        else if (INO_I8 && ld == NO) conv_wave_tile_q8(src, ld, kt * 32, nsrc, ntile * 64, (unsigned char*)dst, K, c.lane, i8_cmax(c, CM_INO), i8_cs(c, CM_INO));
        else conv_wave_tile(src, ld, kt * 32, nsrc, ntile * 64, dst, K, c.lane);
    }
}

__device__ __forceinline__ void p_ctx_fix(const Ctx& c, const float* srcc, const float* gate, const float* slab, float* H) {
    for (int row = blockIdx.x * 8 + c.wave; row < TT; row += gridDim.x * 8) {
        if (row < TL) continue;
        const size_t ro = (size_t)(row - TL) * D;
#pragma unroll 4
        for (int i = 0; i < 16; ++i) { const int col = i * 256 + c.lane * 4;
            const f32x4 s4 = (*(const f32x4*)(slab + ro + col) + *(const f32x4*)(slab + (size_t)TC * D + ro + col)) + (*(const f32x4*)(slab + (size_t)2 * TC * D + ro + col) + *(const f32x4*)(slab + (size_t)3 * TC * D + ro + col));
            *(f32x4*)(H + (size_t)row * D + col) = *(const f32x4*)(srcc + ro + col) + *(const f32x4*)(gate + col) * s4; }
    }
}
template <int NPARTS = 1, bool Q8 = false>
__device__ __forceinline__ void p_norm_mod(const Ctx& c, const float* hl, const float* hc, int nrows, const float* mod, int shift_chunk, int scale_chunk) {
    bf16_t* XN = (bf16_t*)(c.ws + WS_XN);
    for (int row = blockIdx.x * 8 + c.wave; row < nrows; row += gridDim.x * 8) {
        const float* src = row < TL ? hl + (size_t)row * D : hc + (size_t)(row - TL) * D;
        f32x4 v[16]; float ss = 0.f;
#pragma unroll
        for (int i = 0; i < 16; ++i) { v[i] = *(const f32x4*)(src + i * 256 + c.lane * 4); ss += v[i][0] * v[i][0] + v[i][1] * v[i][1] + v[i][2] * v[i][2] + v[i][3] * v[i][3]; }
        ss = wave_sum(ss);
        const float rs = rsqrtf(ss * (1.0f / 4096.0f) + 1e-6f);
        const float* mp = mod + (size_t)row_modidx(row) * 24576;
        bf16_t* dst = XN + (size_t)row * D;
        if constexpr (Q8) {
            float mx = 0.f;
#pragma unroll
            for (int i = 0; i < 16; ++i) { const int col = i * 256 + c.lane * 4;
                const f32x4 sh = *(const f32x4*)(mp + shift_chunk * 4096 + col), sc = *(const f32x4*)(mp + scale_chunk * 4096 + col);
#pragma unroll
                for (int j = 0; j < 4; ++j) v[i][j] = v[i][j] * rs * (1.f + sc[j]) + sh[j];
                { const float a0 = v[i][0] + v[i][1], a1 = v[i][0] - v[i][1], a2 = v[i][2] + v[i][3], a3 = v[i][2] - v[i][3];
                  v[i][0] = a0 + a2; v[i][1] = a1 + a3; v[i][2] = a0 - a2; v[i][3] = a1 - a3; }
#pragma unroll
                for (int j = 0; j < 4; ++j) { float x = v[i][j];
                    { const float t = __int_as_float(__builtin_amdgcn_update_dpp(0, __float_as_int(x), 0xB1, 0xF, 0xF, false)); x = (c.lane & 1) ? t - x : x + t; }
                    { const float t = __int_as_float(__builtin_amdgcn_update_dpp(0, __float_as_int(x), 0x4E, 0xF, 0xF, false)); x = (c.lane & 2) ? t - x : x + t; }
                    { const float t = __int_as_float(__builtin_amdgcn_ds_swizzle(__float_as_int(x), 0x101F)); x = (c.lane & 4) ? t - x : x + t; }
                    v[i][j] = x; mx = fmaxf(mx, fabsf(x)); } }
#pragma unroll
            for (int o = 32; o >= 1; o >>= 1) mx = fmaxf(mx, __shfl_xor(mx, o));
            const float qs = mx > 0.f ? 127.0f / mx : 0.f;
            unsigned char* d8 = (unsigned char*)XN + (size_t)row * D;
#pragma unroll
            for (int i = 0; i < 16; ++i) *(unsigned*)(d8 + i * 256 + c.lane * 4) = pk_i8x4(v[i][0] * qs, v[i][1] * qs, v[i][2] * qs, v[i][3] * qs);
            if (c.lane == 0) ((float*)(c.ws + WS_XN + (size_t)TT * D))[row] = mx * (1.0f / 127.0f);
            continue;
        }
#pragma unroll
        for (int i = 0; i < 16; ++i) { const int col = i * 256 + c.lane * 4;
            f32x4 sh = *(const f32x4*)(mp + shift_chunk * 4096 + col), sc = *(const f32x4*)(mp + scale_chunk * 4096 + col);
            if constexpr (NPARTS == 4) {
                sh = (sh + *(const f32x4*)(mp + MOD_FLOATS + shift_chunk * 4096 + col)) + (*(const f32x4*)(mp + 2 * MOD_FLOATS + shift_chunk * 4096 + col) + *(const f32x4*)(mp + 3 * MOD_FLOATS + shift_chunk * 4096 + col));
                sc = (sc + *(const f32x4*)(mp + MOD_FLOATS + scale_chunk * 4096 + col)) + (*(const f32x4*)(mp + 2 * MOD_FLOATS + scale_chunk * 4096 + col) + *(const f32x4*)(mp + 3 * MOD_FLOATS + scale_chunk * 4096 + col)); }
            u32x2 w; w.x = pk_bf16(v[i][0] * rs * (1.f + sc[0]) + sh[0], v[i][1] * rs * (1.f + sc[1]) + sh[1]);
            w.y = pk_bf16(v[i][2] * rs * (1.f + sc[2]) + sh[2], v[i][3] * rs * (1.f + sc[3]) + sh[3]);
            *(u32x2*)(dst + col) = w; }
    }
}
__device__ __forceinline__ void p_final_norm(const Ctx& c) {
    const float* H = (const float*)(c.ws + WS_H);
    for (int row = blockIdx.x * 8 + c.wave; row < TL; row += gridDim.x * 8) {
        const float* src = H + (size_t)row * D;
        f32x4 v[16]; float ss = 0.f;
#pragma unroll
        for (int i = 0; i < 16; ++i) { v[i] = *(const f32x4*)(src + i * 256 + c.lane * 4); ss += v[i][0] * v[i][0] + v[i][1] * v[i][1] + v[i][2] * v[i][2] + v[i][3] * v[i][3]; }
        ss = wave_sum(ss);
        const float rs = rsqrtf(ss * (1.0f / 4096.0f) + 1e-6f);
        float* dst = c.out + (size_t)row * D;
#pragma unroll
        for (int i = 0; i < 16; ++i) { const int col = i * 256 + c.lane * 4; const f32x4 g = *(const f32x4*)(c.in[I_FNORM] + col);
            *(f32x4*)(dst + col) = v[i] * rs * g; }
    }
}

DI void rope_store(const f32x4 (&acc)[2][2][4][2], int ai, int m, const float* tc, const float* ts, bool rot, float scale, bf16_t* o1p, bf16_t* o2p) {
    float o1[8], o2[8];
#pragma unroll
    for (int n = 0; n < 2; ++n) { f32x4 cs = {1.f, 1.f, 1.f, 1.f}, sn = {0.f, 0.f, 0.f, 0.f};
        if (rot) { cs = *(const f32x4*)(tc + 4 * n); sn = *(const f32x4*)(ts + 4 * n); }
#pragma unroll
        for (int e = 0; e < 4; ++e) { const float x1 = acc[ai][0][m][n][e], x2 = acc[ai][1][m][n][e];
            o1[4 * n + e] = (x1 * cs[e] - x2 * sn[e]) * scale; o2[4 * n + e] = (x2 * cs[e] + x1 * sn[e]) * scale; } }
    u32x4 w1, w2; w1.x = pk_bf16(o1[0], o1[1]); w1.y = pk_bf16(o1[2], o1[3]); w1.z = pk_bf16(o1[4], o1[5]); w1.w = pk_bf16(o1[6], o1[7]);
    w2.x = pk_bf16(o2[0], o2[1]); w2.y = pk_bf16(o2[2], o2[3]); w2.z = pk_bf16(o2[4], o2[5]); w2.w = pk_bf16(o2[6], o2[7]);
    *(u32x4*)o1p = w1; *(u32x4*)o2p = w2;
}
DI void plain_store(const f32x4 (&acc)[2][2][4][2], int ai, int m, bf16_t* rowp) {
#pragma unroll
    for (int bj = 0; bj < 2; ++bj) { const f32x4 v0 = acc[ai][bj][m][0], v1 = acc[ai][bj][m][1];
        u32x4 w; w.x = pk_bf16(v0[0], v0[1]); w.y = pk_bf16(v0[2], v0[3]); w.z = pk_bf16(v1[0], v1[1]); w.w = pk_bf16(v1[2], v1[3]);
        *(u32x4*)(rowp + bj * 128) = w; }
}
DI void i8_prescale(f32x4 (&acc)[2][2][4][2], const float* SA, const float* CS, const pg8::Unit& u, int wr, int wc, int fr, int fq) {
    f32x4 cs[2][2];
#pragma unroll
    for (int bj = 0; bj < 2; ++bj)
#pragma unroll
        for (int n = 0; n < 2; ++n) cs[bj][n] = *(const f32x4*)(CS + u.pn * 256 + bj * 128 + wc * 32 + 8 * fq + 4 * n);
#pragma unroll
    for (int ai = 0; ai < 2; ++ai)
#pragma unroll
        for (int m = 0; m < 4; ++m) { const float s = SA[u.pm * 256 + ai * 128 + wr * 64 + 16 * m + fr];
#pragma unroll
            for (int bj = 0; bj < 2; ++bj)
#pragma unroll
                for (int n = 0; n < 2; ++n)
#pragma unroll
                    for (int e = 0; e < 4; ++e) acc[ai][bj][m][n][e] = (float)__float_as_int(acc[ai][bj][m][n][e]) * (s * cs[bj][n][e]); }
}
DI void i8_prescale_np(f32x4 (&acc)[2][2][4][2], const float* SA, const float* CS, const pg8::Unit& u, int wr, int wc, int fr, int fq) {
    f32x4 cs[2][2];
#pragma unroll
    for (int bj = 0; bj < 2; ++bj)
#pragma unroll
        for (int n = 0; n < 2; ++n) cs[bj][n] = *(const f32x4*)(CS + u.pn * 256 + wc * 32 + 4 * fq + bj * 128 + n * 16);
#pragma unroll
    for (int ai = 0; ai < 2; ++ai)
#pragma unroll
        for (int m = 0; m < 4; ++m) { const float s = SA[u.pm * 256 + ai * 128 + wr * 64 + 16 * m + fr];
#pragma unroll
            for (int bj = 0; bj < 2; ++bj)
#pragma unroll
                for (int n = 0; n < 2; ++n)
#pragma unroll
                    for (int e = 0; e < 4; ++e) acc[ai][bj][m][n][e] = (float)__float_as_int(acc[ai][bj][m][n][e]) * (s * cs[bj][n][e]); }
}
struct EpiInEven {
    static constexpr bool PERM = true, AFTER_DRAIN = false, I8 = false;
    bf16_t* PA; bf16_t* PB; const float* axc; const float* axs;
    DI void operator()(const f32x4 (&acc)[2][2][4][2], const pg8::Unit& u, int wr, int wc, int fr, int fq) const {
        const int row0 = u.pm * 256 + wr * 64 + fr, tq = u.pn - COLS_A_PAD / 256;
#pragma unroll
        for (int ai = 0; ai < 2; ++ai)
#pragma unroll
            for (int m = 0; m < 4; ++m) { const int row = row0 + ai * 128 + m * 16;
                if (tq < 0) plain_store(acc, ai, m, PA + (size_t)row * COLS_A_PAD + u.pn * 256 + wc * 32 + 8 * fq);
                else if (tq >= 16) plain_store(acc, ai, m, PB + (size_t)row * COLS_B + tq * 256 + wc * 32 + 8 * fq);
                else { const int pos = row & 4095; bf16_t* o = PB + (size_t)row * COLS_B + tq * 256 + wc * 64 + 8 * fq;
                    rope_store(acc, ai, m, axc + pos * 32 + 8 * fq, axs + pos * 32 + 8 * fq, row < TL, tq < 8 ? 0.18033688011112042f : 1.0f, o, o + 32); } }
    }
};
struct EpiInOdd {
    static constexpr bool PERM = true, AFTER_DRAIN = false, I8 = (INO_I8 != 0);
    bf16_t* P1; const float* axc; const float* axs; const float* rtc; const float* rts; const float* SA; const float* CS;
    DI void prescale(f32x4 (&acc)[2][2][4][2], const pg8::Unit& u, int wr, int wc, int fr, int fq) const { i8_prescale(acc, SA, CS, u, wr, wc, fr, fq); }
    DI void operator()(const f32x4 (&acc)[2][2][4][2], const pg8::Unit& u, int wr, int wc, int fr, int fq) const {
        const int row0 = u.pm * 256 + wr * 64 + fr, pn = u.pn;
#pragma unroll
        for (int ai = 0; ai < 2; ++ai)
#pragma unroll
            for (int m = 0; m < 4; ++m) { const int row = row0 + ai * 128 + m * 16; const bool lat = row < TL; const int pos = lat ? (row & 4095) : ((row - TL) & 255);
                if (pn < 9) { bf16_t* o = P1 + (size_t)row * NO + pn * 256 + wc * 64 + 8 * fq;
                    rope_store(acc, ai, m, axc + pos * 32 + 8 * fq, axs + pos * 32 + 8 * fq, lat, pn < 8 ? 0.18033688011112042f : 1.0f, o, o + 32); }
                else if (pn >= 10 && pn < 18) { const int rp = lat ? CTXL + pos : pos, i0 = 32 * (wc & 1) + 8 * fq; bf16_t* o = P1 + (size_t)row * NO + pn * 256 + (wc >> 1) * 128 + i0;
                    rope_store(acc, ai, m, rtc + rp * 64 + i0, rts + rp * 64 + i0, true, pn < 14 ? 0.08838834764831845f : 1.0f, o, o + 64); }
                else plain_store(acc, ai, m, P1 + (size_t)row * NO + pn * 256 + wc * 32 + 8 * fq); }
    }
};
struct CtxSplitOrder {
    int G, c, nNn, ntk;
    __device__ void init(int N, int G_, int c_, int K_) { G = G_; c = c_; nNn = N / 256; ntk = K_ / 64; }
    __device__ bool next(int i, pg8::Unit& u) const {
        const long L = (long)i * G + c; if (L >= 4 * nNn * 4) return false;
        const int j = (int)L, part = j & 3, tile = j >> 2; u.pm = 64 + (tile & 3); u.pn = tile >> 2; u.part = part;
        const int s0 = 2 * ((part * ntk) / 8), s1 = 2 * (((part + 1) * ntk) / 8); u.koff = s0 * 128; u.nt = s1 - s0; return true; }
    __device__ __forceinline__ void a_ready(const pg8::Unit&) const {}
    __device__ __forceinline__ void done(const pg8::Unit&) const {}
};
template <bool Q8>
struct EpiSlabT {
    static constexpr bool PERM = false, AFTER_DRAIN = false, I8 = Q8;
    float* slab; const float* SA; const float* CS;
    DI void prescale(f32x4 (&acc)[2][2][4][2], const pg8::Unit& u, int wr, int wc, int fr, int fq) const { i8_prescale_np(acc, SA, CS, u, wr, wc, fr, fq); }
    DI void operator()(const f32x4 (&acc)[2][2][4][2], const pg8::Unit& u, int wr, int wc, int fr, int fq) const {
        const int row0 = u.pm * 256 + wr * 64 + fr, col0 = u.pn * 256 + wc * 32 + 4 * fq;
        float* sb = slab + ((size_t)u.part * TC + (row0 - TL)) * D + col0;
#pragma unroll
        for (int ai = 0; ai < 2; ++ai)
#pragma unroll
            for (int m = 0; m < 4; ++m)
#pragma unroll
                for (int bj = 0; bj < 2; ++bj)
#pragma unroll
                    for (int n = 0; n < 2; ++n) *(f32x4*)(sb + (size_t)(ai * 128 + m * 16) * D + bj * 128 + n * 16) = acc[ai][bj][m][n];
    }
};
struct LatThenCtxOrder : pg8::StaticOrder {
    int nNn;
    __device__ void init2(int N, int G_, int c_, int K_) { init(TL, N, G_, c_, K_); nNn = N / 256; }
    __device__ bool next(int i, pg8::Unit& u) const {
        const long L = (long)i * G + c; if (L < nwg) return pg8::StaticOrder::next(i, u);
        const int j = (int)(L - nwg); if (j >= 4 * nNn) return false;
        u.pm = 64 + (j & 3); u.pn = j >> 2; u.koff = 0; u.nt = ntk; u.part = -1; return true; }
};
struct LoraOrder : LatThenCtxOrder {
    __device__ bool next(int i, pg8::Unit& u) const { if (!LatThenCtxOrder::next(i, u)) return false; u.koff = (u.pn >> 3) * (LORA_KU * 2); u.nt = LORA_KU / 64; return true; }
};
struct OddInOrder : pg8::StaticOrder {
    __device__ void init2(int G_, int c_, int K_) { init(TL, NO, G_, c_, K_); }
    __device__ bool next(int i, pg8::Unit& u) const {
        const long L = (long)i * G + c; if (L < nwg) return pg8::StaticOrder::next(i, u);
        const int j = (int)(L - nwg); if (j >= 4 * 14) return false;
        const int idx = j >> 2; u.pm = 64 + (j & 3); u.pn = idx < 2 ? 8 + idx : 12 + idx; u.koff = 0; u.nt = ntk; u.part = -1; return true; }
};
template <bool Q8>
struct EpiResModT {
    static constexpr bool PERM = false, AFTER_DRAIN = false, I8 = Q8;
    const float* Rlat; const float* Rctx; float* Hout; const float* mod;
    const float* SA; const float* CS;
    DI void prescale(f32x4 (&acc)[2][2][4][2], const pg8::Unit& u, int wr, int wc, int fr, int fq) const { i8_prescale_np(acc, SA, CS, u, wr, wc, fr, fq); }
    DI void operator()(const f32x4 (&acc)[2][2][4][2], const pg8::Unit& u, int wr, int wc, int fr, int fq) const {
        const int row0 = u.pm * 256 + wr * 64 + fr, col0 = u.pn * 256 + wc * 32 + 4 * fq;
        const float* mp = mod + (size_t)(u.pm < 64 ? (u.pm >> 4) : 4) * 24576 + col0;
        f32x4 mv[2][2];
#pragma unroll
        for (int bj = 0; bj < 2; ++bj)
#pragma unroll
            for (int n = 0; n < 2; ++n) mv[bj][n] = *(const f32x4*)(mp + bj * 128 + n * 16);
        const float* sbase = (u.pm < 64) ? Rlat + (size_t)row0 * D : Rctx + (size_t)(row0 - TL) * D;
        float* dbase = Hout + (size_t)row0 * D;
#pragma unroll
        for (int ai = 0; ai < 2; ++ai)
#pragma unroll
            for (int m = 0; m < 4; ++m) { const size_t ro = (size_t)(ai * 128 + m * 16) * D + col0;
#pragma unroll
                for (int bj = 0; bj < 2; ++bj)
#pragma unroll
                    for (int n = 0; n < 2; ++n) { const f32x4 r = *(const f32x4*)(sbase + ro + bj * 128 + n * 16);
                        *(f32x4*)(dbase + ro + bj * 128 + n * 16) = r + mv[bj][n] * acc[ai][bj][m][n]; } }
    }
};

typedef EpiResModT<false> EpiResMod;
typedef EpiSlabT<false> EpiSlab;
struct EpiConvGlu {
    static constexpr bool PERM = true, AFTER_DRAIN = false, I8 = (FFN_I8 != 0);
    bf16_t* HID; bf16_t* SG; bf16_t* SU; const float* cw; const float* cb; const float* SA; const float* CS;
    DI void prescale(f32x4 (&acc)[2][2][4][2], const pg8::Unit& u, int wr, int wc, int fr, int fq) const { i8_prescale(acc, SA, CS, u, wr, wc, fr, fq); }
    DI void operator()(const f32x4 (&acc)[2][2][4][2], const pg8::Unit& u, int wr, int wc, int fr, int fq) const {
        const int col = u.pn * 128 + wc * 32 + 8 * fq;
#pragma unroll
        for (int ai = 0; ai < 2; ++ai) {
            const int rowb = u.pm * 256 + ai * 128 + wr * 64;
#pragma unroll
            for (int n = 0; n < 2; ++n) {
                const f32x4 w0 = *(const f32x4*)(cw + col + 4 * n), w1 = *(const f32x4*)(cw + DFF + col + 4 * n), w2 = *(const f32x4*)(cw + 2 * DFF + col + 4 * n), bb = *(const f32x4*)(cb + col + 4 * n);
                unsigned outp[4][2];
#pragma unroll
                for (int ep = 0; ep < 2; ++ep) { float o[4][2];
#pragma unroll
                    for (int e2 = 0; e2 < 2; ++e2) { const int e = 2 * ep + e2; float P[4], N[4];
#pragma unroll
                        for (int m = 0; m < 4; ++m) { const int vi = __float_as_int(acc[ai][0][m][n][e]);
                            P[m] = __int_as_float(__builtin_amdgcn_update_dpp(0, vi, 0x121, 0xF, 0xF, false)); N[m] = __int_as_float(__builtin_amdgcn_update_dpp(0, vi, 0x12F, 0xF, 0xF, false)); }
#pragma unroll
                        for (int m = 0; m < 4; ++m) { const float prev = fr > 0 ? P[m] : (m > 0 ? P[m - 1] : 0.f), next = fr < 15 ? N[m] : (m < 3 ? N[m + 1] : 0.f);
                            const float x = w0[e] * prev + w1[e] * acc[ai][0][m][n][e] + w2[e] * next + bb[e];
                            o[m][e2] = silu_f(x) * acc[ai][1][m][n][e]; } }
#pragma unroll
                    for (int m = 0; m < 4; ++m) outp[m][ep] = pk_bf16(o[m][0], o[m][1]); }
#pragma unroll
                for (int m = 0; m < 4; ++m) { const int rho = 16 * m + fr, row = rowb + rho;
                    if (rho != 0 && rho != 63) { u32x2 w = {outp[m][0], outp[m][1]}; *(u32x2*)(HID + (size_t)row * DFF + col + 4 * n) = w; }
                    if (m == 0 || m == 3) { if (rho <= 1 || rho >= 62) { const int slot = rho <= 1 ? rho : rho - 60;
                            u32x2 g; g.x = pk_bf16(acc[ai][0][m][n][0], acc[ai][0][m][n][1]); g.y = pk_bf16(acc[ai][0][m][n][2], acc[ai][0][m][n][3]);
                            *(u32x2*)(SG + ((size_t)(row >> 6) * 4 + slot) * DFF + col + 4 * n) = g;
                            if (rho == 0 || rho == 63) { u32x2 q; q.x = pk_bf16(acc[ai][1][m][n][0], acc[ai][1][m][n][1]); q.y = pk_bf16(acc[ai][1][m][n][2], acc[ai][1][m][n][3]);
                                *(u32x2*)(SU + ((size_t)(row >> 6) * 2 + (rho == 63 ? 1 : 0)) * DFF + col + 4 * n) = q; } } }
                }
            }
        }
    }
};
__device__ __forceinline__ void p_conv_fix(const Ctx& c, int l, int nrows) {
    const bf16_t* SG = (const bf16_t*)(c.ar + AR_SG); const bf16_t* SU = (const bf16_t*)(c.ar + AR_SU); bf16_t* HID = (bf16_t*)(c.ar + AR_HID);
    const float* cw = c.in[I_CONVW] + (size_t)l * 3 * DFF; const float* cb = c.in[I_CONVB] + (size_t)l * DFF;
    const int nitems = (nrows / 64) * 2 * 22;
    const u32x4 z4 = {0u, 0u, 0u, 0u};
    for (int item = blockIdx.x * 8 + c.wave; item < nitems; item += gridDim.x * 8) {
        const int ch = item % 22, kw = item / 22, kb = kw >> 1, last = kw & 1, col = ch * 512 + c.lane * 8;
        if (col >= DFF) continue;
        const int row = kb * 64 + (last ? 63 : 0);
        int pos, len; if (row < TL) { pos = row & 4095; len = 4096; } else { pos = (row - TL) & 255; len = 256; }
        u32x4 gp, gc, gn;
        if (!last) { gp = pos > 0 ? *(const u32x4*)(SG + ((size_t)(kb - 1) * 4 + 3) * DFF + col) : z4; gc = *(const u32x4*)(SG + ((size_t)kb * 4 + 0) * DFF + col); gn = *(const u32x4*)(SG + ((size_t)kb * 4 + 1) * DFF + col); }
        else { gp = *(const u32x4*)(SG + ((size_t)kb * 4 + 2) * DFF + col); gc = *(const u32x4*)(SG + ((size_t)kb * 4 + 3) * DFF + col); gn = pos < len - 1 ? *(const u32x4*)(SG + ((size_t)(kb + 1) * 4 + 0) * DFF + col) : z4; }
        const u32x4 up = *(const u32x4*)(SU + ((size_t)kb * 2 + last) * DFF + col);
        float w0[8], w1[8], w2[8], bb[8]; load8f(cw + col, w0); load8f(cw + DFF + col, w1); load8f(cw + 2 * DFF + col, w2); load8f(cb + col, bb);
        float o[8];
#pragma unroll
        for (int j = 0; j < 4; ++j) {
            const float x0 = bflo(gp[j]) * w0[2 * j] + bflo(gc[j]) * w1[2 * j] + bflo(gn[j]) * w2[2 * j] + bb[2 * j];
            const float x1 = bfhi(gp[j]) * w0[2 * j + 1] + bfhi(gc[j]) * w1[2 * j + 1] + bfhi(gn[j]) * w2[2 * j + 1] + bb[2 * j + 1];
            o[2 * j] = silu_f(x0) * bflo(up[j]); o[2 * j + 1] = silu_f(x1) * bfhi(up[j]); }
        u32x4 w; w.x = pk_bf16(o[0], o[1]); w.y = pk_bf16(o[2], o[3]); w.z = pk_bf16(o[4], o[5]); w.w = pk_bf16(o[6], o[7]);
        *(u32x4*)(HID + (size_t)row * DFF + col) = w;
    }
}

DI void unpack8(const u32x4 w, float (&o)[8]) {
#pragma unroll
    for (int j = 0; j < 4; ++j) { o[2 * j] = bflo(w[j]); o[2 * j + 1] = bfhi(w[j]); }
}
DI u32x4 pack8_bf16(const float (&o)[8]) { u32x4 w; w.x = pk_bf16(o[0], o[1]); w.y = pk_bf16(o[2], o[3]); w.z = pk_bf16(o[4], o[5]); w.w = pk_bf16(o[6], o[7]); return w; }
DI u32x4 pack8_f16(const float (&o)[8]) { u32x4 w; w.x = pk_f16(o[0], o[1]); w.y = pk_f16(o[2], o[3]); w.z = pk_f16(o[4], o[5]); w.w = pk_f16(o[6], o[7]); return w; }
DI void unpack8_f16(const u32x4 w, float (&o)[8]) {
#pragma unroll
    for (int j = 0; j < 4; ++j) { o[2 * j] = h16lo(w[j]); o[2 * j + 1] = h16hi(w[j]); }
}
DI void row_pos(int row, int& pos, int& len) { if (row < TL) { pos = row & 4095; len = 4096; } else { pos = (row - TL) & 255; len = 256; } }

__device__ __forceinline__ void p_rwkv_prepA(const Ctx& c) {
    const bf16_t* PA = (const bf16_t*)(c.ar + AR_PA);
    h16* R16 = (h16*)(c.ar + AR_R); h16* KK16 = (h16*)(c.ar + AR_KK); h16* V16 = (h16*)(c.ar + AR_V); bf16_t* K16 = (bf16_t*)(c.ar + AR_K); bf16_t* LA = (bf16_t*)(c.ar + AR_LA);
    const float* mu = c.in[I_MU]; const float* k_k = c.in[I_KK];
    const int lane = c.lane;
    for (int row = blockIdx.x * 8 + c.wave; row < TT; row += gridDim.x * 8) {
        int pos, len; row_pos(row, pos, len);
        const bool hasp = pos > 0, hasn = pos < len - 1;
        const bf16_t* pc = PA + (size_t)row * COLS_A_PAD;
        for (int it = 0; it < 14; ++it) {
            const int col = it * 512 + lane * 8;
            if (col >= COLS_A) break;
            float cur[8], prv[8], nxt[8], m8[8], mx[8];
            unpack8(*(const u32x4*)(pc + col), cur);
            if (hasp) unpack8(*(const u32x4*)(pc - COLS_A_PAD + col), prv); else {
#pragma unroll
                for (int j = 0; j < 8; ++j) prv[j] = 0.f; }
            if (hasn) unpack8(*(const u32x4*)(pc + COLS_A_PAD + col), nxt); else {
#pragma unroll
                for (int j = 0; j < 8; ++j) nxt[j] = 0.f; }
            load8f(mu + col, m8);
#pragma unroll
            for (int j = 0; j < 8; ++j) mx[j] = cur[j] + m8[j] * (0.5f * (prv[j] + nxt[j]) - cur[j]);
            if (it < 4) {
                *(u32x4*)(R16 + (size_t)row * 2048 + col) = pack8_f16(mx);
            } else if (it < 8) {
                const int j0 = col - 2048;
                *(u32x4*)(K16 + (size_t)row * 2048 + j0) = pack8_bf16(mx);
                float kk8[8], x[8]; load8f(k_k + j0, kk8); float ss = 0.f;
#pragma unroll
                for (int j = 0; j < 8; ++j) { x[j] = mx[j] * kk8[j]; ss += x[j] * x[j]; }
                ss += __shfl_xor(ss, 1); ss += __shfl_xor(ss, 2); ss += __shfl_xor(ss, 4);
                const float rn = rsqrtf(ss + 1e-12f);
#pragma unroll
                for (int j = 0; j < 8; ++j) x[j] *= rn;
                *(u32x4*)(KK16 + (size_t)row * 2048 + j0) = pack8_f16(x);
            } else if (it < 12) {
                *(u32x4*)(V16 + (size_t)row * 2048 + (col - 4096)) = pack8_f16(mx);
            } else {
                const int q0 = col - 6144; float o[8];
#pragma unroll
                for (int j = 0; j < 8; ++j) o[j] = q0 < 192 ? (1.0f - 2.0f * __builtin_amdgcn_rcpf(1.0f + __expf(2.0f * mx[j]))) : (q0 < 384 ? mx[j] : sigmoid_f(mx[j]));
                const int seg = q0 < 384 ? q0 / 96 : 4, off = q0 - (seg < 4 ? seg * 96 : 384);
                *(u32x4*)(LA + (size_t)row * LORA_K + seg * LORA_KU + off) = pack8_bf16(o);
            }
        }
        {
            const u32x4 z4 = {0u, 0u, 0u, 0u};
            for (int z = lane; z < 80; z += 64) *(u32x4*)(LA + (size_t)row * LORA_K + (z / 20) * LORA_KU + 96 + (z % 20) * 8) = z4; }
    }
}

DI int kperm16(int o) { return (o & ~12) | ((o >> 1) & 4) | ((o << 1) & 8); }
template <int DVW  , int NHEAD>
__device__ __forceinline__ void p_build_vt(const Ctx& c, const bf16_t* P, int ldp, int vcol0, bf16_t* VT) {
    constexpr int NSLAB = (DVW * NHEAD) / 512 > 0 ? (DVW * NHEAD) / 512 : 1;
    constexpr int SLABW = (DVW * NHEAD) < 512 ? (DVW * NHEAD) : 512;
    LAS unsigned short* T = (LAS unsigned short*)c.lds;
    const int tid = c.tid;
    for (int item = blockIdx.x; item < (TT / 64) * NSLAB; item += gridDim.x) {
        const int kg = item / NSLAB, slab = item % NSLAB;
        const int row0 = kg * 64;
        int b, key0; if (row0 < TL) { b = row0 >> 12; key0 = row0 & 4095; } else { b = (row0 - TL) >> 8; key0 = 4096 + ((row0 - TL) & 255); }
        { const int key = tid >> 3, part = tid & 7; const int kp = (key & ~15) | kperm16(key & 15);
          constexpr int CPT = SLABW / 8;
          const bf16_t* src = P + (size_t)(row0 + key) * ldp + vcol0 + slab * SLABW + part * CPT;
#pragma unroll
          for (int e = 0; e < CPT / 8; ++e) { const u32x4 w = *(const u32x4*)(src + e * 8);
#pragma unroll
              for (int j = 0; j < 4; ++j) { T[(part * CPT + e * 8 + 2 * j) * 72 + kp] = (unsigned short)(w[j] & 0xffffu); T[(part * CPT + e * 8 + 2 * j + 1) * 72 + kp] = (unsigned short)(w[j] >> 16); } }
        }
        __syncthreads();
        for (int q = tid; q < SLABW * 8; q += NTHREADS) { const int col = q >> 3, ch = q & 7;
            const u32x4 w = *(const LAS u32x4*)(T + col * 72 + ch * 8);
            const int gc = slab * SLABW + col, head = gc / DVW, dv = gc % DVW;
            *(u32x4*)(VT + (((size_t)b * NHEAD + head) * DVW + dv) * NKEY + key0 + ch * 8) = w; }
        __syncthreads();
    }
}

struct EpiLora {
    static constexpr bool PERM = true, AFTER_DRAIN = false, I8 = false;
    const float* w0; const float* a0; const float* k_a; const bf16_t* K16; const h16* KK16; h16* OMW; h16* BB; h16* KD; bf16_t* G;
    DI void operator()(const f32x4 (&acc)[2][2][4][2], const pg8::Unit& u, int wr, int wc, int fr, int fq) const {
        const int type = u.pn >> 3, row0 = u.pm * 256 + wr * 64 + fr;
#pragma unroll
        for (int bj = 0; bj < 2; ++bj) {
            const int jc = (u.pn & 7) * 256 + bj * 128 + wc * 32 + 8 * fq;
            if (type < 2) {
                float w8[8]; load8f(w0 + type * 2048 + jc, w8);
#pragma unroll
                for (int ai = 0; ai < 2; ++ai)
#pragma unroll
                    for (int m = 0; m < 4; ++m) { const int row = row0 + ai * 128 + m * 16; float o[8];
#pragma unroll
                        for (int i = 0; i < 8; ++i) { const float w = w8[i] + (i < 4 ? acc[ai][bj][m][0][i & 3] : acc[ai][bj][m][1][i & 3]);
                            o[i] = 1.0f - __expf(-0.60653066f * sigmoid_f(w)); }
                        *(u32x4*)(OMW + ((size_t)type * TT + row) * 2048 + jc) = pack8_f16(o); }
            } else if (type < 4) {
                const int d = type - 2; float a8[8], ka8[8]; load8f(a0 + d * 2048 + jc, a8); load8f(k_a + jc, ka8);
#pragma unroll
                for (int ai = 0; ai < 2; ++ai)
#pragma unroll
                    for (int m = 0; m < 4; ++m) { const int row = row0 + ai * 128 + m * 16; float kd[8], bb[8], k8[8], kk8[8];
                        unpack8(*(const u32x4*)(K16 + (size_t)row * 2048 + jc), k8); unpack8_f16(*(const u32x4*)(KK16 + (size_t)row * 2048 + jc), kk8);
#pragma unroll
                        for (int i = 0; i < 8; ++i) { const float a = sigmoid_f(a8[i] + (i < 4 ? acc[ai][bj][m][0][i & 3] : acc[ai][bj][m][1][i & 3]));
                            kd[i] = k8[i] * (1.0f + (a - 1.0f) * ka8[i]); bb[i] = kk8[i] * a; }
                        *(u32x4*)(KD + ((size_t)d * TT + row) * 2048 + jc) = pack8_f16(kd);
                        *(u32x4*)(BB + ((size_t)d * TT + row) * 2048 + jc) = pack8_f16(bb); }
            } else {
#pragma unroll
                for (int ai = 0; ai < 2; ++ai)
#pragma unroll
                    for (int m = 0; m < 4; ++m) { const int row = row0 + ai * 128 + m * 16; float o[8];
#pragma unroll
                        for (int i = 0; i < 8; ++i) o[i] = (i < 4 ? acc[ai][bj][m][0][i & 3] : acc[ai][bj][m][1][i & 3]);
                        *(u32x4*)(G + (size_t)row * 2048 + jc) = pack8_bf16(o); }
            }
        }
    }
};

#define MFMA32(a, b, cacc) __builtin_amdgcn_mfma_f32_32x32x16_bf16((a), (b), (cacc), 0, 0, 0)
DI bf16x8 ld_frag(const bf16_t* p) { return __builtin_bit_cast(bf16x8, *(const u32x4*)p); }
DI bf16x8 pack_p(const f32x16& x, int s) { u32x4 w; w.x = pk_bf16(x[8 * s], x[8 * s + 1]); w.y = pk_bf16(x[8 * s + 2], x[8 * s + 3]); w.z = pk_bf16(x[8 * s + 4], x[8 * s + 5]); w.w = pk_bf16(x[8 * s + 6], x[8 * s + 7]); return __builtin_bit_cast(bf16x8, w); }
constexpr float LOG2E = 1.44269504088896f;

DI void fwht8x4(float (&x)[8], int lane) {
#pragma unroll
    for (int h = 1; h < 8; h <<= 1)
#pragma unroll
        for (int i = 0; i < 8; i += 2 * h)
#pragma unroll
            for (int j = i; j < i + h; ++j) { const float a = x[j], b = x[j + h]; x[j] = a + b; x[j + h] = a - b; }
#pragma unroll
    for (int j = 0; j < 8; ++j) { float v = x[j];
        { const float t = __int_as_float(__builtin_amdgcn_update_dpp(0, __float_as_int(v), 0xB1, 0xF, 0xF, false)); v = (lane & 1) ? t - v : v + t; }
        { const float t = __int_as_float(__builtin_amdgcn_update_dpp(0, __float_as_int(v), 0x4E, 0xF, 0xF, false)); v = (lane & 2) ? t - v : v + t; }
        x[j] = v; }
}
DI float wave_max(float v) {
#pragma unroll
    for (int o = 32; o >= 1; o >>= 1) v = fmaxf(v, __shfl_xor(v, o));
    return v;
}
__device__ __forceinline__ void p_rwkv_out(const Ctx& c, int nrows) {
    const bf16_t* Yf = (const bf16_t*)(c.ar + AR_Y); const bf16_t* Yb = Yf + (size_t)TT * 2048;
    const h16* R16 = (const h16*)(c.ar + AR_R); const h16* V16 = (const h16*)(c.ar + AR_V);
    const h16* KDf = (const h16*)(c.ar + AR_KD); const h16* KDb = KDf + (size_t)TT * 2048;
    const bf16_t* G = (const bf16_t*)(c.ar + AR_G); bf16_t* MIX = (bf16_t*)(c.ws + WS_XN);
    const float* r_k = c.in[I_RK]; const float* ln_w = c.in[I_LNW]; const float* ln_b = c.in[I_LNB];
    const int lane = c.lane;
    for (int row = blockIdx.x * 8 + c.wave; row < nrows; row += gridDim.x * 8) {
        float ov[4][8];
#pragma unroll
        for (int it = 0; it < 4; ++it) {
            const int col = it * 512 + lane * 8; const size_t o = (size_t)row * 2048 + col;
            float yf[8], yb[8], y[8], r8[8], v8[8], kf[8], kb[8], g8[8], rk8[8], lw[8], lb[8];
            unpack8(*(const u32x4*)(Yf + o), yf); unpack8(*(const u32x4*)(Yb + o), yb);
            unpack8_f16(*(const u32x4*)(R16 + o), r8); unpack8_f16(*(const u32x4*)(V16 + o), v8);
            unpack8_f16(*(const u32x4*)(KDf + o), kf); unpack8_f16(*(const u32x4*)(KDb + o), kb);
            unpack8(*(const u32x4*)(G + o), g8);
            load8f(r_k + col, rk8); load8f(ln_w + col, lw); load8f(ln_b + col, lb);
            float sm = 0.f, bn = 0.f;
#pragma unroll
            for (int j = 0; j < 8; ++j) { y[j] = yf[j] + yb[j]; sm += y[j]; bn += r8[j] * (kf[j] + kb[j]) * rk8[j]; }
            sm += __shfl_xor(sm, 1); sm += __shfl_xor(sm, 2); sm += __shfl_xor(sm, 4);
            bn += __shfl_xor(bn, 1); bn += __shfl_xor(bn, 2); bn += __shfl_xor(bn, 4);
            const float mean = sm * (1.0f / 64.0f); float vs = 0.f;
#pragma unroll
            for (int j = 0; j < 8; ++j) { const float dlt = y[j] - mean; vs += dlt * dlt; }
            vs += __shfl_xor(vs, 1); vs += __shfl_xor(vs, 2); vs += __shfl_xor(vs, 4);
            const float rs = rsqrtf(vs * (1.0f / 64.0f) + 64e-5f);
            float o8[8];
#pragma unroll
            for (int j = 0; j < 8; ++j) o8[j] = ((y[j] - mean) * rs * lw[j] + lb[j] + bn * v8[j]) * g8[j];
            if (MIX_I8) {
#pragma unroll
                for (int j = 0; j < 8; ++j) ov[it][j] = o8[j]; }
            else *(u32x4*)(MIX + (size_t)row * D + col) = pack8_bf16(o8);
        }
        if (MIX_I8) {
            float av[4][8]; float mx = 0.f;
#pragma unroll
            for (int it = 0; it < 4; ++it) { unpack8(*(const u32x4*)(MIX + (size_t)row * D + 2048 + it * 512 + lane * 8), av[it]);
                fwht8x4(ov[it], lane); fwht8x4(av[it], lane);
#pragma unroll
                for (int j = 0; j < 8; ++j) mx = fmaxf(mx, fmaxf(fabsf(ov[it][j]), fabsf(av[it][j]))); }
            mx = wave_max(mx);
            const float qs = mx > 0.f ? 127.0f / mx : 0.f;
            unsigned char* xq = c.ar + AR_XQ + (size_t)row * D;
#pragma unroll
            for (int it = 0; it < 4; ++it) {
                u32x2 w0 = {pk_i8x4(ov[it][0] * qs, ov[it][1] * qs, ov[it][2] * qs, ov[it][3] * qs), pk_i8x4(ov[it][4] * qs, ov[it][5] * qs, ov[it][6] * qs, ov[it][7] * qs)};
                u32x2 w1 = {pk_i8x4(av[it][0] * qs, av[it][1] * qs, av[it][2] * qs, av[it][3] * qs), pk_i8x4(av[it][4] * qs, av[it][5] * qs, av[it][6] * qs, av[it][7] * qs)};
                *(u32x2*)(xq + it * 512 + lane * 8) = w0; *(u32x2*)(xq + 2048 + it * 512 + lane * 8) = w1; }
            if (lane == 0) ((float*)(c.ar + AR_XQS))[row] = mx * (1.0f / 127.0f);
        }
    }
}
__device__ __forceinline__ void p_quant_hid(const Ctx& c, int nrows) {
    const bf16_t* HID = (const bf16_t*)(c.ar + AR_HID); const int lane = c.lane;
    for (int row = blockIdx.x * 8 + c.wave; row < nrows; row += gridDim.x * 8) {
        u32x4 pk[22]; float mx = 0.f;
#pragma unroll
        for (int it = 0; it < 22; ++it) { const int col = it * 512 + lane * 8; pk[it] = col < DFF ? *(const u32x4*)(HID + (size_t)row * DFF + col) : (u32x4){0u, 0u, 0u, 0u}; }
#pragma unroll
        for (int it = 0; it < 22; ++it) { float x[8]; unpack8(pk[it], x); fwht8x4(x, lane);
#pragma unroll
            for (int j = 0; j < 8; ++j) mx = fmaxf(mx, fabsf(x[j])); }
        mx = wave_max(mx);
        const float qs = mx > 0.f ? 127.0f / mx : 0.f;
        unsigned char* hq = c.ar + AR_HQ + (size_t)row * DFF;
#pragma unroll
        for (int it = 0; it < 22; ++it) { float x[8]; unpack8(pk[it], x); fwht8x4(x, lane); const int col = it * 512 + lane * 8;
            u32x2 w = {pk_i8x4(x[0] * qs, x[1] * qs, x[2] * qs, x[3] * qs), pk_i8x4(x[4] * qs, x[5] * qs, x[6] * qs, x[7] * qs)};
            if (col < DFF) *(u32x2*)(hq + col) = w; }
        if (lane == 0) ((float*)(c.ar + AR_HQS))[row] = mx * (1.0f / 127.0f);
    }
}
__device__ __forceinline__ void p_quant_mix(const Ctx& c, int nrows) {
    const bf16_t* MIX = (const bf16_t*)(c.ws + WS_XN); const int lane = c.lane;
    for (int row = blockIdx.x * 8 + c.wave; row < nrows; row += gridDim.x * 8) {
        float x[8][8]; float mx = 0.f;
#pragma unroll
        for (int it = 0; it < 8; ++it) { unpack8(*(const u32x4*)(MIX + (size_t)row * D + it * 512 + lane * 8), x[it]); fwht8x4(x[it], lane);
#pragma unroll
            for (int j = 0; j < 8; ++j) mx = fmaxf(mx, fabsf(x[it][j])); }
        mx = wave_max(mx);
        const float qs = mx > 0.f ? 127.0f / mx : 0.f;
        unsigned char* xq = c.ar + AR_XQ + (size_t)row * D;
#pragma unroll
        for (int it = 0; it < 8; ++it) { u32x2 w = {pk_i8x4(x[it][0] * qs, x[it][1] * qs, x[it][2] * qs, x[it][3] * qs), pk_i8x4(x[it][4] * qs, x[it][5] * qs, x[it][6] * qs, x[it][7] * qs)};
            *(u32x2*)(xq + it * 512 + lane * 8) = w; }
        if (lane == 0) ((float*)(c.ar + AR_XQS))[row] = mx * (1.0f / 127.0f);
    }
}

constexpr int K1_WAVE_LDS = 35328;
constexpr size_t TT_ROWS2048 = (size_t)TT * 2048;
#define WAVE_SYNC() do { asm volatile("s_waitcnt lgkmcnt(0)" ::: "memory"); __builtin_amdgcn_wave_barrier(); } while (0)
DI int rw_row(int b, int dir, int t) { return t < CTXL ? TL + b * CTXL + (dir ? (CTXL - 1 - t) : t) : b * SEQ + (dir ? (SEQ - 1 - (t - CTXL)) : (t - CTXL)); }
DI float bfu(unsigned short x) { return __uint_as_float((unsigned)x << 16); }
DI bf16x8 colfrag_nat(const LAS unsigned short* T, int col, int t0) { u32x4 w;
#pragma unroll
    for (int j = 0; j < 4; ++j) w[j] = (unsigned)T[(t0 + 2 * j) * 64 + col] | ((unsigned)T[(t0 + 2 * j + 1) * 64 + col] << 16);
    return __builtin_bit_cast(bf16x8, w); }
DI bf16x8 colfrag_nat_scaled(const LAS unsigned short* T, int col, int t0, float sc) { u32x4 w;
#pragma unroll
    for (int j = 0; j < 4; ++j) w[j] = pk_bf16(bfu(T[(t0 + 2 * j) * 64 + col]) * sc, bfu(T[(t0 + 2 * j + 1) * 64 + col]) * sc);
    return __builtin_bit_cast(bf16x8, w); }
DI bf16x8 colfrag_pk_scaled(const LAS unsigned short* T, int col, int s, int hh, float sc) { u32x4 w;
#pragma unroll
    for (int j2 = 0; j2 < 4; ++j2) { const int j = 2 * j2, t = 16 * s + 8 * (j >> 2) + 4 * hh + (j & 3);
        w[j2] = pk_bf16(bfu(T[t * 64 + col]) * sc, bfu(T[(t + 1) * 64 + col]) * sc); }
    return __builtin_bit_cast(bf16x8, w); }
DI bf16x8 rowfrag_nat(const LAS unsigned short* A, int row, int s, int hh) { const LAS u32x2* p = (const LAS u32x2*)(A + row * 40 + 16 * s + 8 * hh); const u32x2 a = p[0], b = p[1];
    u32x4 w = {a.x, a.y, b.x, b.y}; return __builtin_bit_cast(bf16x8, w); }
DI bf16x8 rowfrag_pk(const LAS unsigned short* A, int row, int s, int hh) { const u32x2 a = *(const LAS u32x2*)(A + row * 40 + 16 * s + 4 * hh), b = *(const LAS u32x2*)(A + row * 40 + 16 * s + 8 + 4 * hh);
    u32x4 w = {a.x, a.y, b.x, b.y}; return __builtin_bit_cast(bf16x8, w); }
DI u32x4 pack_pu(const f32x16& x, int s) { u32x4 w; w.x = pk_bf16(x[8 * s], x[8 * s + 1]); w.y = pk_bf16(x[8 * s + 2], x[8 * s + 3]); w.z = pk_bf16(x[8 * s + 4], x[8 * s + 5]); w.w = pk_bf16(x[8 * s + 6], x[8 * s + 7]); return w; }

__device__ __forceinline__ void rwkv_k1_chunk(const Ctx& c, LAS unsigned char* wl, int seq, int ch) {
    const int dir = seq & 1, h = (seq >> 1) & 31, b = seq >> 6;
    const int lane = c.lane, r = lane & 31, hh = lane >> 5;
    LAS unsigned short* TA = (LAS unsigned short*)wl; LAS unsigned short* TB = TA + 2048; LAS unsigned short* TK = TB + 2048; LAS unsigned short* TR = TK + 2048; LAS unsigned short* TVv = TR + 2048;
    LAS float* GC = (LAS float*)(wl + 20480); LAS float* LAB = (LAS float*)(wl + 20736);
    LAS unsigned short* TTi = (LAS unsigned short*)(wl + 24832); LAS unsigned short* TAK = TTi + 1280; LAS unsigned short* TRB = TAK + 1280; LAS unsigned short* TRK = TRB + 1280;
    const h16* KK = (const h16*)(c.ar + AR_KK); const h16* RR = (const h16*)(c.ar + AR_R); const h16* VV = (const h16*)(c.ar + AR_V);
    const h16* OM = (const h16*)(c.ar + AR_OMW) + (size_t)dir * TT_ROWS2048; const h16* BBp = (const h16*)(c.ar + AR_BB) + (size_t)dir * TT_ROWS2048; const h16* KDp = (const h16*)(c.ar + AR_KD) + (size_t)dir * TT_ROWS2048;
    {   LAS unsigned short* TO = (LAS unsigned short*)LAB;
        u32x4 ld[6][4];
#pragma unroll
        for (int i = 0; i < 4; ++i) { const int tau = (lane >> 3) + 8 * i; const size_t off = (size_t)rw_row(b, dir, ch * 32 + tau) * 2048 + h * 64 + (lane & 7) * 8;
            ld[0][i] = *(const u32x4*)(KK + off); ld[1][i] = *(const u32x4*)(BBp + off); ld[2][i] = *(const u32x4*)(KDp + off);
            ld[3][i] = *(const u32x4*)(RR + off); ld[4][i] = *(const u32x4*)(VV + off); ld[5][i] = *(const u32x4*)(OM + off); }
#pragma unroll
        for (int i = 0; i < 4; ++i) { const int o = ((lane >> 3) + 8 * i) * 64 + (lane & 7) * 8;
            *(LAS u32x4*)(TA + o) = ld[0][i]; *(LAS u32x4*)(TB + o) = ld[1][i]; *(LAS u32x4*)(TK + o) = ld[2][i];
            *(LAS u32x4*)(TR + o) = ld[3][i]; *(LAS u32x4*)(TVv + o) = ld[4][i]; *(LAS u32x4*)(TO + o) = ld[5][i]; }
    }
    WAVE_SYNC();
    {   const LAS h16* TO = (const LAS h16*)LAB;
        float g = 1.f;
#pragma unroll 8
        for (int tau = 0; tau < 32; ++tau) { const int o = tau * 64 + lane;
            const float omw = (float)TO[o], bb = (float)((const LAS h16*)TB)[o], kd = (float)((const LAS h16*)TK)[o], kk = (float)((const LAS h16*)TA)[o], rr = (float)((const LAS h16*)TR)[o], vv = (float)((const LAS h16*)TVv)[o];
            const float gp = g; g *= (1.0f - omw); const float ig = __builtin_amdgcn_rcpf(g);
            TA[o] = f2bf(kk * gp); TB[o] = f2bf(-bb * ig); TK[o] = f2bf(kd * ig); TR[o] = f2bf(rr * g); TVv[o] = f2bf(vv);
        }
        GC[lane] = g;
    }
    WAVE_SYNC();
    {   f32x16 ab, ak, rb, rk;
#pragma unroll
        for (int i = 0; i < 16; ++i) { ab[i] = 0.f; ak[i] = 0.f; rb[i] = 0.f; rk[i] = 0.f; }
#pragma unroll
        for (int ks = 0; ks < 4; ++ks) { const int o = r * 64 + 16 * ks + 8 * hh;
            const bf16x8 fa = *(const LAS bf16x8*)(TA + o), fb = *(const LAS bf16x8*)(TB + o), fk = *(const LAS bf16x8*)(TK + o), fr = *(const LAS bf16x8*)(TR + o);
            ab = MFMA32(fa, fb, ab); ak = MFMA32(fa, fk, ak); rb = MFMA32(fr, fb, rb); rk = MFMA32(fr, fk, rk); }
#pragma unroll
        for (int i = 0; i < 16; ++i) { const int tau = (i & 3) + 8 * (i >> 2) + 4 * hh;
            LAB[tau * 32 + r] = (r < tau) ? ab[i] : 0.f;
            TAK[tau * 40 + r] = f2bf((r < tau) ? ak[i] : 0.f); TRB[tau * 40 + r] = f2bf((r <= tau) ? rb[i] : 0.f); TRK[tau * 40 + r] = f2bf((r <= tau) ? rk[i] : 0.f); }
    }
    WAVE_SYNC();
    {   float Tc[32];
#pragma unroll
        for (int tau = 0; tau < 32; ++tau) { float acc = (r == tau) ? 1.f : 0.f;
#pragma unroll
            for (int q = 0; q < (tau + 3) / 4; ++q) { const f32x4 a4 = *(const LAS f32x4*)(LAB + tau * 32 + 4 * q);
#pragma unroll
                for (int e = 0; e < 4; ++e) if (4 * q + e < tau) acc = fmaf(a4[e], Tc[4 * q + e], acc); }
            Tc[tau] = acc; }
        if (hh == 0) {
#pragma unroll
            for (int tau = 0; tau < 32; ++tau) TTi[tau * 40 + r] = f2bf(Tc[tau]); }
    }
    WAVE_SYNC();
    f32x16 W1[2], Z[2]; bf16x8 Vn[2][2];
    {   bf16x8 tn[2], tp[2], akn[2];
#pragma unroll
        for (int s = 0; s < 2; ++s) { tn[s] = rowfrag_nat(TTi, r, s, hh); tp[s] = rowfrag_pk(TTi, r, s, hh); akn[s] = rowfrag_nat(TAK, r, s, hh); }
#pragma unroll
        for (int t2 = 0; t2 < 2; ++t2) {
#pragma unroll
            for (int i = 0; i < 16; ++i) W1[t2][i] = 0.f;
            f32x16 X;
#pragma unroll
            for (int i = 0; i < 16; ++i) X[i] = 0.f;
#pragma unroll
            for (int s = 0; s < 2; ++s) { Vn[t2][s] = colfrag_nat(TVv, 32 * t2 + r, 16 * s + 8 * hh);
                W1[t2] = MFMA32(tn[s], colfrag_nat(TA, 32 * t2 + r, 16 * s + 8 * hh), W1[t2]);
                X = MFMA32(akn[s], Vn[t2][s], X); }
#pragma unroll
            for (int i = 0; i < 16; ++i) Z[t2][i] = 0.f;
#pragma unroll
            for (int s = 0; s < 2; ++s) Z[t2] = MFMA32(tp[s], pack_p(X, s), Z[t2]);
        }
    }
    u32x4* CHp = (u32x4*)(c.ar + AR_CH + ((size_t)seq * RW_NCH + ch) * CH_BYTES) + lane;
    {   bf16x8 rbp[2], rkn[2];
#pragma unroll
        for (int s = 0; s < 2; ++s) { rbp[s] = rowfrag_pk(TRB, r, s, hh); rkn[s] = rowfrag_nat(TRK, r, s, hh); }
#pragma unroll
        for (int kt = 0; kt < 2; ++kt) { f32x16 GT;
#pragma unroll
            for (int g4 = 0; g4 < 4; ++g4) { const u32x2 w = *(const LAS u32x2*)(TR + r * 64 + 32 * kt + 8 * g4 + 4 * hh);
                GT[4 * g4] = bflo(w.x); GT[4 * g4 + 1] = bfhi(w.x); GT[4 * g4 + 2] = bflo(w.y); GT[4 * g4 + 3] = bfhi(w.y); }
#pragma unroll
            for (int s = 0; s < 2; ++s) GT = MFMA32(pack_p(W1[kt], s), rbp[s], GT);
#pragma unroll
            for (int s = 0; s < 2; ++s) CHp[(0 + kt * 2 + s) * 64] = pack_pu(GT, s); }
#pragma unroll
        for (int vt = 0; vt < 2; ++vt) { f32x16 Y0;
#pragma unroll
            for (int i = 0; i < 16; ++i) Y0[i] = 0.f;
#pragma unroll
            for (int s = 0; s < 2; ++s) { Y0 = MFMA32(pack_p(Z[vt], s), rbp[s], Y0); Y0 = MFMA32(Vn[vt][s], rkn[s], Y0); }
#pragma unroll
            for (int s = 0; s < 2; ++s) CHp[(4 + vt * 2 + s) * 64] = pack_pu(Y0, s); }
    }
#pragma unroll
    for (int k2 = 0; k2 < 2; ++k2) {
        const float gc = GC[32 * k2 + r];
        bf16x8 bhp[2], khn[2];
#pragma unroll
        for (int s = 0; s < 2; ++s) { bhp[s] = colfrag_pk_scaled(TB, 32 * k2 + r, s, hh, gc); khn[s] = colfrag_nat_scaled(TK, 32 * k2 + r, 16 * s + 8 * hh, gc); }
#pragma unroll
        for (int kt = 0; kt < 2; ++kt) { f32x16 PT;
#pragma unroll
            for (int i = 0; i < 16; ++i) PT[i] = (kt == k2 && ((i & 3) + 8 * (i >> 2) + 4 * hh) == r) ? gc : 0.f;
#pragma unroll
            for (int s = 0; s < 2; ++s) PT = MFMA32(pack_p(W1[kt], s), bhp[s], PT);
#pragma unroll
            for (int s = 0; s < 2; ++s) CHp[(8 + k2 * 4 + kt * 2 + s) * 64] = pack_pu(PT, s); }
#pragma unroll
        for (int vt = 0; vt < 2; ++vt) { f32x16 PS;
#pragma unroll
            for (int i = 0; i < 16; ++i) PS[i] = 0.f;
#pragma unroll
            for (int s = 0; s < 2; ++s) { PS = MFMA32(bhp[s], pack_p(Z[vt], s), PS); PS = MFMA32(khn[s], Vn[vt][s], PS); }
#pragma unroll
            for (int s = 0; s < 2; ++s) CHp[(16 + k2 * 4 + vt * 2 + s) * 64] = pack_pu(PS, s); }
    }
    WAVE_SYNC();
}

DI void unpack_acc(const u32x4 lo, const u32x4 hi, f32x16& x) {
#pragma unroll
    for (int j = 0; j < 4; ++j) { x[2 * j] = bflo(lo[j]); x[2 * j + 1] = bfhi(lo[j]); x[8 + 2 * j] = bflo(hi[j]); x[8 + 2 * j + 1] = bfhi(hi[j]); }
}
__device__ __forceinline__ void rwkv_seq_wave(const Ctx& c, int seq, int vt) {
    const int dir = seq & 1, h = (seq >> 1) & 31, b = seq >> 6;
    const int lane = c.lane, r = lane & 31, hh = lane >> 5;
    bf16_t* Y = (bf16_t*)(c.ar + AR_Y) + (size_t)dir * TT_ROWS2048;
    f32x16 M[2];
#pragma unroll
    for (int kt = 0; kt < 2; ++kt)
#pragma unroll
        for (int i = 0; i < 16; ++i) M[kt][i] = 0.f;
    const u32x4* CH0 = (const u32x4*)(c.ar + AR_CH + (size_t)seq * RW_NCH * CH_BYTES) + lane;
    u32x4 gf[4], pf[8], y0[2], ps[4];
#define RW_LOAD(chp) do { _Pragma("unroll") for (int q = 0; q < 4; ++q) gf[q] = (chp)[q * 64]; _Pragma("unroll") for (int q = 0; q < 2; ++q) y0[q] = (chp)[(4 + vt * 2 + q) * 64]; \
        _Pragma("unroll") for (int q = 0; q < 8; ++q) pf[q] = (chp)[(8 + q) * 64]; _Pragma("unroll") for (int k2 = 0; k2 < 2; ++k2) _Pragma("unroll") for (int s = 0; s < 2; ++s) ps[k2 * 2 + s] = (chp)[(16 + k2 * 4 + vt * 2 + s) * 64]; } while (0)
    RW_LOAD(CH0);
    for (int ch = 0; ch < (int)RW_NCH; ++ch) {
        bf16x8 mp[4];
#pragma unroll
        for (int kt = 0; kt < 2; ++kt)
#pragma unroll
            for (int s = 0; s < 2; ++s) mp[kt * 2 + s] = pack_p(M[kt], s);
        f32x16 Yc, Mn[2];
        unpack_acc(y0[0], y0[1], Yc); unpack_acc(ps[0], ps[1], Mn[0]); unpack_acc(ps[2], ps[3], Mn[1]);
#pragma unroll
        for (int q = 0; q < 4; ++q) Yc = MFMA32(mp[q], __builtin_bit_cast(bf16x8, gf[q]), Yc);
#pragma unroll
        for (int k2 = 0; k2 < 2; ++k2)
#pragma unroll
            for (int q = 0; q < 4; ++q) Mn[k2] = MFMA32(__builtin_bit_cast(bf16x8, pf[k2 * 4 + q]), mp[q], Mn[k2]);
        if (ch + 1 < (int)RW_NCH) { const u32x4* nx = CH0 + (size_t)(ch + 1) * (CH_BYTES / 16); RW_LOAD(nx); }
        M[0] = Mn[0]; M[1] = Mn[1];
        {   bf16_t* yp = Y + (size_t)rw_row(b, dir, ch * 32 + r) * 2048 + h * 64 + 32 * vt + 4 * hh;
#pragma unroll
            for (int g = 0; g < 4; ++g) { u32x2 w2; w2.x = pk_bf16(Yc[4 * g], Yc[4 * g + 1]); w2.y = pk_bf16(Yc[4 * g + 2], Yc[4 * g + 3]); *(u32x2*)(yp + 8 * g) = w2; } }
    }
#undef RW_LOAD
}

__device__ __forceinline__ void p_rwkv_k1_and_conv(const Ctx& c) {
    if (c.wave < 4) { LAS unsigned char* wl = c.lds + c.wave * K1_WAVE_LDS; const int w = blockIdx.x * 4 + c.wave, nw = gridDim.x * 4;
        for (int task = w; task < 256 * (int)RW_NCH; task += nw) rwkv_k1_chunk(c, wl, task / (int)RW_NCH, task % (int)RW_NCH); }
    else p_convert_deferred(c, blockIdx.x * 4 + (c.wave - 4), gridDim.x * 4, 0, CONV_SPLIT);
}
__device__ __forceinline__ void p_rwkv_seq_and_conv(const Ctx& c) {
    constexpr int NTASK = 512;
    const int G = (int)gridDim.x, task = c.wave * G + (int)blockIdx.x;
    if (task < NTASK) { for (int t = task; t < NTASK; t += G * 8) rwkv_seq_wave(c, t & 255, t >> 8); return; }
    int widx = 0, nworkers = 0;
    for (int w = 0; w < 8; ++w) { const int nsc = NTASK - w * G; const int sb = nsc <= 0 ? 0 : (nsc > G ? G : nsc);
        if (w < c.wave) widx += G - sb; else if (w == c.wave) widx += (int)blockIdx.x - sb;
        nworkers += G - sb; }
    p_convert_deferred(c, widx, nworkers, CONV_SPLIT, 1 << 30);
}

constexpr int DA_KBYTES = 64 * 256, DA_VBYTES = 128 * 128, DA_BUF = DA_KBYTES + DA_VBYTES;
constexpr int DA_COMB = 2 * DA_BUF;
__device__ __forceinline__ void dattn_block_item(const Ctx& c, int item) {
    const bf16_t* PB = (const bf16_t*)(c.ar + AR_PB); const bf16_t* VT = (const bf16_t*)(c.ar + AR_VT); bf16_t* MIX = (bf16_t*)(c.ws + WS_XN);
    const int lane = c.lane, r = lane & 31, hh = lane >> 5, w = c.wave, mp = w >> 2, qg = w & 3;
    int b, h, qrow0, t0, nt;
    if (item < NB * 16 * 32) { b = item >> 9; h = (item >> 5) & 15; qrow0 = b * SEQ + (item & 31) * 128; t0 = 0; nt = NKEY / 64; }
    else { const int i2 = item - NB * 16 * 32; b = i2 >> 5; h = (i2 >> 1) & 15; qrow0 = TL + b * CTXL + (i2 & 1) * 128; t0 = SEQ / 64; nt = CTXL / 64; }
    const bf16_t* VTh = VT + ((size_t)b * 16 + h) * 128 * NKEY;
    int krow_l[2], kchunk_l[2], vrow_l[2], vchunk_l[2];
#pragma unroll
    for (int i = 0; i < 2; ++i) { const int pk = 2 * w + i; krow_l[i] = 4 * pk + (lane >> 4); kchunk_l[i] = (lane & 15) ^ (krow_l[i] & 15);
        vrow_l[i] = 8 * pk + (lane >> 3); vchunk_l[i] = (lane & 7) ^ ((vrow_l[i] >> 1) & 7); }
#define DA_LOAD(t, buf) do { const int kx0 = (t0 + (t)) * 64; const int krow0 = kx0 < SEQ ? b * SEQ + kx0 : TL + b * CTXL + (kx0 - SEQ); \
        _Pragma("unroll") for (int i = 0; i < 2; ++i) { \
            __builtin_amdgcn_global_load_lds((const unsigned*)(PB + (size_t)(krow0 + krow_l[i]) * COLS_B + 2048 + h * 128 + kchunk_l[i] * 8), (LAS unsigned*)(c.lds + (buf) * DA_BUF + (2 * w + i) * 1024), 16, 0, 0); \
            __builtin_amdgcn_global_load_lds((const unsigned*)(VTh + (size_t)vrow_l[i] * NKEY + kx0 + vchunk_l[i] * 8), (LAS unsigned*)(c.lds + (buf) * DA_BUF + DA_KBYTES + (2 * w + i) * 1024), 16, 0, 0); } } while (0)
    bf16x8 q[4];
    { const bf16_t* qp = PB + (size_t)(qrow0 + 32 * qg + r) * COLS_B + h * 128 + mp * 64 + hh * 8;
#pragma unroll
      for (int ks = 0; ks < 4; ++ks) q[ks] = ld_frag(qp + ks * 16); }
    f32x16 O[4];
#pragma unroll
    for (int d = 0; d < 4; ++d)
#pragma unroll
        for (int i = 0; i < 16; ++i) O[d][i] = 0.f;
    float m = 0.f, l = 0.f;
    DA_LOAD(0, 0);
    __syncthreads();
    for (int t = 0; t < nt; ++t) {
        const int cur = t & 1;
        if (t + 1 < nt) DA_LOAD(t + 1, cur ^ 1);
        const LAS unsigned short* Kl = (const LAS unsigned short*)(c.lds + cur * DA_BUF); const LAS unsigned short* Vl = (const LAS unsigned short*)(c.lds + cur * DA_BUF + DA_KBYTES);
        f32x16 st[2];
        const float negm = -m;
#pragma unroll
        for (int sub = 0; sub < 2; ++sub) {
#pragma unroll
            for (int i = 0; i < 16; ++i) st[sub][i] = negm;
#pragma unroll
            for (int ks = 0; ks < 4; ++ks) st[sub] = MFMA32(*(const LAS bf16x8*)((const LAS unsigned char*)Kl + (32 * sub + r) * 256 + (((mp * 8 + ks * 2 + hh) ^ (r & 15)) << 4)), q[ks], st[sub]); }
        float mx = fmaxf(st[0][0], st[1][0]);
#pragma unroll
        for (int i = 1; i < 16; ++i) mx = fmaxf(mx, fmaxf(st[0][i], st[1][i]));
        mx = fmaxf(mx, __shfl_xor(mx, 32));
        if (!__all(mx <= 8.0f && mx >= -24.0f)) {
            const float alpha = __builtin_amdgcn_exp2f(-mx);
            m += mx; l *= alpha;
#pragma unroll
            for (int sub = 0; sub < 2; ++sub)
#pragma unroll
                for (int i = 0; i < 16; ++i) st[sub][i] -= mx;
#pragma unroll
            for (int d = 0; d < 4; ++d)
#pragma unroll
                for (int i = 0; i < 16; ++i) O[d][i] *= alpha;
        }
        float ps = 0.f;
#pragma unroll
        for (int sub = 0; sub < 2; ++sub)
#pragma unroll
            for (int i = 0; i < 16; ++i) { st[sub][i] = __builtin_amdgcn_exp2f(st[sub][i]); ps += st[sub][i]; }
        l += ps;
        bf16x8 P[4];
#pragma unroll
        for (int sub = 0; sub < 2; ++sub) { P[2 * sub] = pack_p(st[sub], 0); P[2 * sub + 1] = pack_p(st[sub], 1); }
#pragma unroll
        for (int d = 0; d < 4; ++d)
#pragma unroll
            for (int kk = 0; kk < 4; ++kk) O[d] = MFMA32(*(const LAS bf16x8*)((const LAS unsigned char*)Vl + (32 * d + r) * 128 + (((2 * kk + hh) ^ ((r >> 1) & 7)) << 4)), P[kk], O[d]);
        __syncthreads();
    }
#undef DA_LOAD
    LAS float* CB = (LAS float*)(c.lds + DA_COMB) + qg * 4096;
    l += __shfl_xor(l, 32);
    if (mp == 1) { const float sc = ((const float*)(c.ws + WS_SCAL))[0] / l;
#pragma unroll
        for (int d = 0; d < 4; ++d)
#pragma unroll
            for (int i = 0; i < 16; ++i) CB[(32 * d + (i & 3) + 8 * (i >> 2) + 4 * hh) * 32 + r] = O[d][i] * sc; }
    __syncthreads();
    if (mp == 0) { const float i0 = 1.0f / l; float ss = 0.f;
#pragma unroll
        for (int d = 0; d < 4; ++d)
#pragma unroll
            for (int i = 0; i < 16; ++i) { const float y = O[d][i] * i0 - CB[(32 * d + (i & 3) + 8 * (i >> 2) + 4 * hh) * 32 + r]; O[d][i] = y; ss += y * y; }
        ss += __shfl_xor(ss, 32);
        const float rs = rsqrtf(ss * (1.0f / 128.0f) + 1e-5f) * 0.8f;
        const float* subln = c.in[I_SUBLN];
        bf16_t* orow = MIX + (size_t)(qrow0 + 32 * qg + r) * D + 2048 + h * 128;
#pragma unroll
        for (int d = 0; d < 4; ++d)
#pragma unroll
            for (int g = 0; g < 4; ++g) { const int dv = 32 * d + 8 * g + 4 * hh; const f32x4 sl = *(const f32x4*)(subln + dv);
                u32x2 wv; wv.x = pk_bf16(O[d][4 * g] * rs * sl[0], O[d][4 * g + 1] * rs * sl[1]); wv.y = pk_bf16(O[d][4 * g + 2] * rs * sl[2], O[d][4 * g + 3] * rs * sl[3]);
                *(u32x2*)(orow + dv) = wv; } }
    __syncthreads();
}
__device__ __forceinline__ void p_dattn_block(const Ctx& c, bool need_ctx) {
    const int nitems = NB * 16 * 32 + (need_ctx ? NB * 16 * 2 : 0);
    const bool remap = gridDim.x == 256;
    for (int item = blockIdx.x; item < nitems; item += gridDim.x) {
        int it = item;
        if (remap && item < NB * 16 * 32) { const int k = item >> 8, x = item & 7, sl = (item & 255) >> 3; it = (((k << 3) + x) << 5) | sl; }
        dattn_block_item(c, it);
    }
}

constexpr int P1_CQ = 0, P1_CK = 2048, P1_CV = 2304, P1_DQ = 2560, P1_DK = 3584, P1_DV = 4608, P1_DG = 6656;

constexpr int SW_KLD = 72, SW_VLD = 40;
constexpr int SW_KBYTES = 32 * SW_KLD * 2, SW_VBYTES = 64 * SW_VLD * 2, SW_BUF = SW_KBYTES + SW_VBYTES;
__device__ __forceinline__ void swa_block_item(const Ctx& c, int item) {
    const bf16_t* P1 = (const bf16_t*)(c.ar + AR_P1); const bf16_t* VTC = (const bf16_t*)(c.ar + AR_VTC); bf16_t* MIX = (bf16_t*)(c.ws + WS_XN);
    const int tid = c.tid, lane = c.lane, r = lane & 31, hh = lane >> 5;
    const int b = item >> 9, g = (item >> 7) & 3, q0 = (item & 127) * 32, hq = g * 8 + c.wave;
    const int qpos = q0 + r;
    bf16x8 q[4]; { const bf16_t* qp = P1 + (size_t)(b * SEQ + qpos) * NO + P1_CQ + hq * 64 + hh * 8;
#pragma unroll
        for (int ks = 0; ks < 4; ++ks) q[ks] = ld_frag(qp + ks * 16); }
    const bf16_t* VTh = VTC + ((size_t)b * 4 + g) * 64 * NKEY;
    f32x16 O[2];
#pragma unroll
    for (int d = 0; d < 2; ++d)
#pragma unroll
        for (int i = 0; i < 16; ++i) O[d][i] = 0.f;
    float m = 0.f, l = 0.f;
    const int wt0 = (q0 - 128 < 0 ? 0 : q0 - 128) / 32, wt1 = (q0 + 160 > SEQ ? SEQ : q0 + 160) / 32;
    const int nwt = wt1 - wt0, ntl = nwt + 8;
    u32x4 sreg;
    const bool kside = tid < 256; const int t2 = tid & 255;
#define SWB_LOAD(ti) do { const bool win_ = (ti) < nwt; const int kx_ = (win_ ? wt0 + (ti) : (SEQ / 32) + ((ti) - nwt)) * 32; \
        sreg = kside ? *(const u32x4*)(P1 + (size_t)((win_ ? b * SEQ + kx_ : TL + b * CTXL + (kx_ - SEQ)) + (t2 >> 3)) * NO + P1_CK + g * 64 + (t2 & 7) * 8) \
                     : *(const u32x4*)(VTh + (size_t)(t2 >> 2) * NKEY + kx_ + (t2 & 3) * 8); } while (0)
#define SWB_STORE(buf) do { LAS unsigned short* base_ = (LAS unsigned short*)(c.lds + (buf) * SW_BUF); \
        if (kside) *(LAS u32x4*)(base_ + (t2 >> 3) * SW_KLD + (t2 & 7) * 8) = sreg; else *(LAS u32x4*)(base_ + SW_KBYTES / 2 + (t2 >> 2) * SW_VLD + (t2 & 3) * 8) = sreg; } while (0)
    SWB_LOAD(0); SWB_STORE(0);
    __syncthreads();
    for (int ti = 0; ti < ntl; ++ti) {
        const bool win = ti < nwt; const int kx0 = (win ? wt0 + ti : (SEQ / 32) + (ti - nwt)) * 32;
        if (ti + 1 < ntl) SWB_LOAD(ti + 1);
        const LAS unsigned short* Kl = (const LAS unsigned short*)(c.lds + (ti & 1) * SW_BUF); const LAS unsigned short* Vl = Kl + SW_KBYTES / 2;
        f32x16 st;
        const float negm = -m;
#pragma unroll
        for (int i = 0; i < 16; ++i) st[i] = negm;
#pragma unroll
        for (int ks = 0; ks < 4; ++ks) st = MFMA32(*(const LAS bf16x8*)(Kl + r * SW_KLD + ks * 16 + hh * 8), q[ks], st);
        if (win && (kx0 == q0 - 128 || kx0 == q0 + 128)) {
#pragma unroll
            for (int i = 0; i < 16; ++i) { const int kpos = kx0 + (i & 3) + 8 * (i >> 2) + 4 * hh; const int dl = kpos - qpos; if (dl > 128 || dl < -128) st[i] = -1e30f; }
        }
        float mx = st[0];
#pragma unroll
        for (int i = 1; i < 16; ++i) mx = fmaxf(mx, st[i]);
        mx = fmaxf(mx, __shfl_xor(mx, 32));
        if (!__all(mx <= 8.0f && mx >= -24.0f)) {
            const float alpha = __builtin_amdgcn_exp2f(-mx);
            m += mx; l *= alpha;
#pragma unroll
            for (int i = 0; i < 16; ++i) st[i] -= mx;
#pragma unroll
            for (int d = 0; d < 2; ++d)
#pragma unroll
                for (int i = 0; i < 16; ++i) O[d][i] *= alpha;
        }
        float ps = 0.f;
#pragma unroll
        for (int i = 0; i < 16; ++i) { st[i] = __builtin_amdgcn_exp2f(st[i]); ps += st[i]; }
        l += ps;
        const bf16x8 p0 = pack_p(st, 0), p1 = pack_p(st, 1);
#pragma unroll
        for (int d = 0; d < 2; ++d) { O[d] = MFMA32(*(const LAS bf16x8*)(Vl + (32 * d + r) * SW_VLD + 8 * hh), p0, O[d]); O[d] = MFMA32(*(const LAS bf16x8*)(Vl + (32 * d + r) * SW_VLD + 16 + 8 * hh), p1, O[d]); }
        if (ti + 1 < ntl) SWB_STORE((ti + 1) & 1);
        __syncthreads();
    }
#undef SWB_LOAD
#undef SWB_STORE
    l += __shfl_xor(l, 32);
    l += __builtin_amdgcn_exp2f(c.in[I_SINK][hq] * LOG2E - m);
    const float il = 1.0f / l;
    bf16_t* orow = MIX + (size_t)(b * SEQ + qpos) * D + hq * 64;
#pragma unroll
    for (int d = 0; d < 2; ++d)
#pragma unroll
        for (int gq = 0; gq < 4; ++gq) { const int dv = 32 * d + 8 * gq + 4 * hh;
            u32x2 w; w.x = pk_bf16(O[d][4 * gq] * il, O[d][4 * gq + 1] * il); w.y = pk_bf16(O[d][4 * gq + 2] * il, O[d][4 * gq + 3] * il);
            *(u32x2*)(orow + dv) = w; }
}

DI float ret_lg(const Ctx& c, int dir, int h) { return log1pf(-exp2f(-c.in[I_RDEC][dir * 8 + h])); }
DI int ret_row0(int b, int cidx) { return cidx < 2 ? TL + b * CTXL + cidx * 128 : b * SEQ + (cidx - 2) * 128; }
constexpr int TK_LD = 136, TV_LD = 264;
constexpr int RT_LD = 136;
DI void stage_chunk_T(const Ctx& c, const bf16_t* src, int ld_src, int ncols, LAS unsigned short* T) {
    const int tid = c.tid, row = tid >> 2, part = tid & 3, cpt = ncols / 4;
    const bf16_t* p = src + (size_t)row * ld_src + part * cpt;
    for (int e = 0; e < cpt / 8; ++e) { const u32x4 w = *(const u32x4*)(p + e * 8);
#pragma unroll
        for (int j = 0; j < 4; ++j) { T[(part * cpt + e * 8 + 2 * j) * RT_LD + row] = (unsigned short)(w[j] & 0xffffu); T[(part * cpt + e * 8 + 2 * j + 1) * RT_LD + row] = (unsigned short)(w[j] >> 16); } }
}
__device__ __forceinline__ void p_ret_local(const Ctx& c) {
    const bf16_t* P1 = (const bf16_t*)(c.ar + AR_P1); float* RU = (float*)(c.ar + AR_RU);
    LAS unsigned short* TK = (LAS unsigned short*)c.lds; LAS unsigned short* TV = TK + 128 * RT_LD;
    const int lane = c.lane, r = lane & 31, hh = lane >> 5, w = c.wave;
    for (int item = blockIdx.x; item < NB * 8 * 34; item += gridDim.x) {
        const int cidx = item % 34, h = (item / 34) & 7, b = item / (34 * 8);
        const int row0 = ret_row0(b, cidx);
        stage_chunk_T(c, P1 + (size_t)row0 * NO + P1_DK + h * 128, NO, 128, TK);
        stage_chunk_T(c, P1 + (size_t)row0 * NO + P1_DV + h * 256, NO, 256, TV);
        __syncthreads();
        for (int dir = 0; dir < 2; ++dir) {
            const float lg = ret_lg(c, dir, h);
            f32x16 af[4];
#pragma unroll
            for (int dt = 0; dt < 4; ++dt)
#pragma unroll
                for (int i = 0; i < 16; ++i) af[dt][i] = 0.f;
#pragma unroll 1
            for (int ks = 0; ks < 8; ++ks) {
                const int i0 = ks * 16 + hh * 8;
                float vf[8]; unpack8(*(const LAS u32x4*)(TV + (32 * w + r) * RT_LD + i0), vf);
#pragma unroll
                for (int j = 0; j < 8; ++j) vf[j] *= __expf(lg * (float)(dir ? (i0 + j) : (127 - (i0 + j))));
                const bf16x8 fa = __builtin_bit_cast(bf16x8, pack8_bf16(vf));
#pragma unroll
                for (int dt = 0; dt < 4; ++dt) af[dt] = MFMA32(*(const LAS bf16x8*)(TK + (32 * dt + r) * RT_LD + i0), fa, af[dt]);
            }
            float* U = RU + ((((size_t)b * 8 + h) * 2 + dir) * 34 + cidx) * 32768;
#pragma unroll
            for (int dt = 0; dt < 4; ++dt)
#pragma unroll
                for (int g = 0; g < 4; ++g) { f32x4 v4 = {af[dt][4 * g], af[dt][4 * g + 1], af[dt][4 * g + 2], af[dt][4 * g + 3]}; *(f32x4*)(U + (32 * w + r) * 128 + 32 * dt + 8 * g + 4 * hh) = v4; }
        }
        __syncthreads();
    }
}
__device__ __forceinline__ void p_ret_prefix(const Ctx& c) {
    const float* RU = (const float*)(c.ar + AR_RU); bf16_t* RS = (bf16_t*)(c.ar + AR_RS);
    const size_t gtid = (size_t)blockIdx.x * NTHREADS + c.tid, gn = (size_t)gridDim.x * NTHREADS;
    for (size_t idx = gtid; idx < (size_t)NB * 8 * 2 * 32768; idx += gn) {
        const int el = (int)(idx & 32767), bhd = (int)(idx >> 15), dir = bhd & 1, h = (bhd >> 1) & 7;
        const float cd = __expf(ret_lg(c, dir, h) * 128.0f);
        const float* U = RU + (size_t)bhd * 34 * 32768 + el; bf16_t* S = RS + (size_t)bhd * 32 * 32768 + el;
        float u[34];
#pragma unroll
        for (int ci = 0; ci < 34; ++ci) u[ci] = __builtin_nontemporal_load(U + (size_t)ci * 32768);
        float s = 0.f;
        if (dir == 0) {
#pragma unroll
            for (int ci = 0; ci < 34; ++ci) { if (ci >= 2) S[(size_t)(ci - 2) * 32768] = f2bf(s); s = s * cd + u[ci]; } }
        else { s = s * cd + u[1]; s = s * cd + u[0];
#pragma unroll
            for (int ci = 33; ci >= 2; --ci) { S[(size_t)(ci - 2) * 32768] = f2bf(s); s = s * cd + u[ci]; } }
    }
}
__device__ __forceinline__ void p_ret_out(const Ctx& c) {
    const bf16_t* P1 = (const bf16_t*)(c.ar + AR_P1); const bf16_t* RS = (const bf16_t*)(c.ar + AR_RS); bf16_t* MIX = (bf16_t*)(c.ws + WS_XN);
    LAS unsigned short* TV = (LAS unsigned short*)c.lds;
    LAS float* XS = (LAS float*)(c.lds + 256 * RT_LD * 2);
    const int lane = c.lane, r = lane & 31, hh = lane >> 5, w = c.wave, qt = w & 3, eh = w >> 2;
    for (int item = blockIdx.x; item < NB * 8 * 32; item += gridDim.x) {
        const int lc = item & 31, h = (item >> 5) & 7, b = item >> 8;
        const int row0 = b * SEQ + lc * 128;
        stage_chunk_T(c, P1 + (size_t)row0 * NO + P1_DV + h * 256, NO, 256, TV);
        __syncthreads();
        const float lgf = ret_lg(c, 0, h), lgb = ret_lg(c, 1, h);
        const int qi = qt * 32 + r;
        const bf16_t* qp = P1 + (size_t)(row0 + qi) * NO + P1_DQ + h * 128 + hh * 8;
        f32x16 Y[4];
#pragma unroll
        for (int et = 0; et < 4; ++et)
#pragma unroll
            for (int i = 0; i < 16; ++i) Y[et][i] = 0.f;
        {
            const float qdf = __expf(lgf * (float)(qi + 1)), qdb = __expf(lgb * (float)(128 - qi));
            const bf16_t* Sf = RS + ((((size_t)b * 8 + h) * 2 + 0) * 32 + lc) * 32768; const bf16_t* Sb = RS + ((((size_t)b * 8 + h) * 2 + 1) * 32 + lc) * 32768;
#pragma unroll 1
            for (int ks = 0; ks < 8; ++ks) {
                float x[8], xf[8], xb[8]; unpack8(*(const u32x4*)(qp + ks * 16), x);
#pragma unroll
                for (int j = 0; j < 8; ++j) { xf[j] = x[j] * qdf; xb[j] = x[j] * qdb; }
                const bf16x8 qf = __builtin_bit_cast(bf16x8, pack8_bf16(xf)), qb = __builtin_bit_cast(bf16x8, pack8_bf16(xb));
#pragma unroll
                for (int et = 0; et < 4; ++et) { const int e = eh * 128 + et * 32 + r;
                    Y[et] = MFMA32(ld_frag(Sf + (size_t)e * 128 + ks * 16 + hh * 8), qf, Y[et]);
                    Y[et] = MFMA32(ld_frag(Sb + (size_t)e * 128 + ks * 16 + hh * 8), qb, Y[et]); }
            }
        }
#pragma unroll 1
        for (int kt = 0; kt < 4; ++kt) {
            f32x16 st;
#pragma unroll
            for (int i = 0; i < 16; ++i) st[i] = 0.f;
            const bf16_t* kp = P1 + (size_t)(row0 + kt * 32 + r) * NO + P1_DK + h * 128 + hh * 8;
#pragma unroll
            for (int ks = 0; ks < 8; ++ks) st = MFMA32(ld_frag(kp + ks * 16), ld_frag(qp + ks * 16), st);
#pragma unroll
            for (int i = 0; i < 16; ++i) { const int ki = kt * 32 + (i & 3) + 8 * (i >> 2) + 4 * hh; const int dl = qi - ki;
                const float f = dl > 0 ? __expf(lgf * (float)dl) : (dl < 0 ? __expf(lgb * (float)(-dl)) : 2.0f); st[i] *= f; }
            const bf16x8 p0 = pack_p(st, 0), p1 = pack_p(st, 1);
#pragma unroll
            for (int et = 0; et < 4; ++et) { const int e = eh * 128 + et * 32 + r;
#pragma unroll
                for (int s = 0; s < 2; ++s) { const u32x2 lo = *(const LAS u32x2*)(TV + e * RT_LD + kt * 32 + 16 * s + 4 * hh), hi = *(const LAS u32x2*)(TV + e * RT_LD + kt * 32 + 16 * s + 8 + 4 * hh);
                    u32x4 vw = {lo.x, lo.y, hi.x, hi.y};
                    Y[et] = MFMA32(__builtin_bit_cast(bf16x8, vw), s == 0 ? p0 : p1, Y[et]); } }
        }
        float ss = 0.f;
#pragma unroll
        for (int et = 0; et < 4; ++et)
#pragma unroll
            for (int i = 0; i < 16; ++i) ss += Y[et][i] * Y[et][i];
        ss += __shfl_xor(ss, 32);
        if (hh == 0) XS[(eh * 4 + qt) * 32 + r] = ss;
        __syncthreads();
        const float tot = XS[(0 * 4 + qt) * 32 + r] + XS[(1 * 4 + qt) * 32 + r];
        const float rs = rsqrtf(tot * (1.0f / 256.0f) + 1e-6f);
        const bf16_t* gp = P1 + (size_t)(row0 + qi) * NO + P1_DG + h * 256; bf16_t* op = MIX + (size_t)(row0 + qi) * D + 2048 + h * 256;
#pragma unroll
        for (int et = 0; et < 4; ++et)
#pragma unroll
            for (int gq = 0; gq < 4; ++gq) { const int e = eh * 128 + et * 32 + 8 * gq + 4 * hh;
                const u32x2 gw = *(const u32x2*)(gp + e);
                const float g0 = bflo(gw.x), g1 = bfhi(gw.x), g2 = bflo(gw.y), g3 = bfhi(gw.y);
                u32x2 o; o.x = pk_bf16(Y[et][4 * gq] * rs * silu_f(g0), Y[et][4 * gq + 1] * rs * silu_f(g1)); o.y = pk_bf16(Y[et][4 * gq + 2] * rs * silu_f(g2), Y[et][4 * gq + 3] * rs * silu_f(g3));
                *(u32x2*)(op + e) = o; }
        __syncthreads();
    }
}

#define MK_PER_PHASE 0
#ifndef MK_PER_PHASE
#define MK_PER_PHASE 0
#endif
constexpr int N_PHASES = 25;
constexpr int LDS_STAGE = 4 * K1_WAVE_LDS;
constexpr int LDS_BYTES = LDS_STAGE + 256;

__global__ void __launch_bounds__(NTHREADS, 2) mk_fwd(Args a) {
    extern __shared__ __attribute__((aligned(16))) unsigned char smem[];
    Ctx c;
#pragma unroll
    for (int i = 0; i < 29; ++i) c.in[i] = a.in[i];
    c.out = a.out; c.ws = a.ws; c.ar = a.ws + WS_ARENA; c.lds = (LAS unsigned char*)smem;
    c.tid = threadIdx.x; c.lane = c.tid & 63; c.wave = __builtin_amdgcn_readfirstlane(c.tid >> 6);
    volatile LAS unsigned* xbw = (volatile LAS unsigned*)(c.lds + LDS_STAGE);
    if (c.tid < 4) xbw[c.tid] = 0u;
    __syncthreads();
    XcdBarrier bar; bar.bar = (unsigned*)(a.ws + WS_CTL); bar.x = 0; bar.st = xbw;
    if (!MK_PER_PHASE) bar = xcd_barrier_post((unsigned*)(a.ws + WS_CTL), xbw);
    const int lo = a.ph_lo, hi = a.ph_hi;
#ifndef PH_MASK
#define PH_MASK 0x1ffffffu
#endif
#define IN(k) (((PH_MASK >> (k)) & 1u) && lo <= (k) && (k) < hi)
#define SEAM(k) do { if (IN(k) && IN((k) + 1)) { xcd_barrier(bar); } } while (0)
    float* H = (float*)(c.ws + WS_H); const float* MOD = (const float*)(c.ws + WS_MOD);
    const bf16_t* XN = (const bf16_t*)(c.ws + WS_XN); unsigned char* W = c.ws + WS_W;
    LAS unsigned char* gl = c.lds; float* SLAB = (float*)(c.ar + AR_SLAB); unsigned char* W1 = c.ws + WS_W1;

    if (IN(0)) { p_mod(c); p_weights_layer0(c); p_wcolmax(c, CmxDeal{(int)blockIdx.x, (int)gridDim.x, 0, cmx_p0(gridDim.x)}); }
    SEAM(0);
    if (IN(1)) { p_mod_finalize(c); p_norm_mod<4>(c, c.in[I_X], c.in[I_CTX], TT, (const float*)(c.ar + AR_MODP), 0, 1); }
    SEAM(1);
    if (IN(2)) { const int ns = cmx_ns(gridDim.x), gg = (int)gridDim.x - ns;
        if ((int)blockIdx.x < gg) { pg8::Gemm g{XN, (const bf16_t*)(W + W_IN), TT, NE, D}; LatThenCtxOrder S; S.init2(NE, gg, blockIdx.x, D);
            EpiInEven E{(bf16_t*)(c.ar + AR_PA), (bf16_t*)(c.ar + AR_PB), (const float*)(c.ws + WS_AXC), (const float*)(c.ws + WS_AXS)};
            pg8::gemm_phase(gl, g, S, E); }
        else p_wcolmax(c, CmxDeal{(int)blockIdx.x - gg, ns, cmx_p0(gridDim.x), CMX_TOTAL}); }
    SEAM(2);
    if (IN(3)) { p_rwkv_prepA(c); p_build_vt<128, 16>(c, (const bf16_t*)(c.ar + AR_PB), COLS_B, 4096, (bf16_t*)(c.ar + AR_VT)); }
    SEAM(3);
    if (IN(4)) { pg8::Gemm g{(const bf16_t*)(c.ar + AR_LA), (const bf16_t*)(W + W_LORA), TT, LORA_N, LORA_K}; LoraOrder S; S.init2(LORA_N, gridDim.x, blockIdx.x, LORA_KU);
        EpiLora E{c.in[I_W0], c.in[I_A0], c.in[I_KA], (const bf16_t*)(c.ar + AR_K), (const h16*)(c.ar + AR_KK), (h16*)(c.ar + AR_OMW), (h16*)(c.ar + AR_BB), (h16*)(c.ar + AR_KD), (bf16_t*)(c.ar + AR_G)};
        pg8::gemm_phase(gl, g, S, E); }
    SEAM(4);
    if (IN(5)) {
#ifndef NO_DATTN
        p_dattn_block(c, true); __syncthreads();
#endif
#ifndef NO_K1
        p_rwkv_k1_and_conv(c);
#endif
    }
    SEAM(5);
    if (IN(6)) p_rwkv_seq_and_conv(c);
    SEAM(6);
    if (IN(7)) p_rwkv_out(c, TT);
    SEAM(7);
    if (IN(8)) { constexpr int KE = MIX_I8 ? D / 2 : D; const float* SAq = (const float*)(c.ar + AR_XQS);
        pg8::Gemm g{MIX_I8 ? (const bf16_t*)(c.ar + AR_XQ) : XN, (const bf16_t*)(W + W_MIX), TT, D, KE}; pg8::StaticOrder S; S.init(TL, D, gridDim.x, blockIdx.x, KE);
        EpiResModT<MIX_I8 != 0> E{c.in[I_X], c.in[I_CTX], H, MOD + 2 * 4096, SAq, i8_cs(c, CM_MIX)};
        pg8::gemm_phase(gl, g, S, E);
        CtxSplitOrder S2; S2.init(D, gridDim.x, blockIdx.x, KE); EpiSlabT<MIX_I8 != 0> E2{SLAB, SAq, i8_cs(c, CM_MIX)};
        pg8::gemm_phase(gl, g, S2, E2); }
    SEAM(8);
    if (IN(9)) { p_ctx_fix(c, c.in[I_CTX], MOD + 4 * 24576 + 2 * 4096, SLAB, H); p_norm_mod<1, FFN_I8 != 0>(c, H, H + (size_t)TL * D, TT, MOD, 3, 4); }
    SEAM(9);
    if (IN(10)) { constexpr int KE = FFN_I8 ? D / 2 : D;
        pg8::Gemm g{XN, (const bf16_t*)(W + W_FFI), TT, 2 * DFF, KE}; LatThenCtxOrder S; S.init2(2 * DFF, gridDim.x, blockIdx.x, KE);
        EpiConvGlu E{(bf16_t*)(c.ar + AR_HID), (bf16_t*)(c.ar + AR_SG), (bf16_t*)(c.ar + AR_SU), c.in[I_CONVW], c.in[I_CONVB], (const float*)(c.ws + WS_XN + (size_t)TT * D), i8_cs(c, CM_FFI)};
        pg8::gemm_phase(gl, g, S, E); }
    SEAM(10);
    if (IN(11)) { p_conv_fix(c, 0, TT); if (FFO0_I8 && IN(12)) { xcd_barrier(bar); p_quant_hid(c, TT); } }
    SEAM(11);
    if (IN(12)) { constexpr int KE = FFO0_I8 ? DFF / 2 : DFF; const float* SAq = (const float*)(c.ar + AR_HQS);
        pg8::Gemm g{(const bf16_t*)(c.ar + (FFO0_I8 ? AR_HQ : AR_HID)), (const bf16_t*)(W + W_FFO), TT, D, KE}; pg8::StaticOrder S; S.init(TL, D, gridDim.x, blockIdx.x, KE);
        EpiResModT<FFO0_I8 != 0> E{H, H + (size_t)TL * D, H, MOD + 5 * 4096, SAq, i8_cs(c, CM_FFO0)};
        pg8::gemm_phase(gl, g, S, E);
        CtxSplitOrder S2; S2.init(D, gridDim.x, blockIdx.x, KE); EpiSlabT<FFO0_I8 != 0> E2{SLAB, SAq, i8_cs(c, CM_FFO0)};
        pg8::gemm_phase(gl, g, S2, E2); }
    SEAM(12);
    const float* MOD1 = MOD + 5 * 24576;
    if (IN(13)) { p_ctx_fix(c, H + (size_t)TL * D, MOD + 4 * 24576 + 5 * 4096, SLAB, H); p_norm_mod<1, INO_I8 != 0>(c, H, H + (size_t)TL * D, TT, MOD1, 0, 1); }
    SEAM(13);
    if (IN(14)) { constexpr int KE = INO_I8 ? D / 2 : D;
        pg8::Gemm g{XN, (const bf16_t*)(W + W_IN), TT, NO, KE}; OddInOrder S; S.init2(gridDim.x, blockIdx.x, KE);
        EpiInOdd E{(bf16_t*)(c.ar + AR_P1), (const float*)(c.ws + WS_AXC), (const float*)(c.ws + WS_AXS), (const float*)(c.ws + WS_RTC), (const float*)(c.ws + WS_RTS), (const float*)(c.ws + WS_XN + (size_t)TT * D), i8_cs(c, CM_INO)};
        pg8::gemm_phase(gl, g, S, E); }
    SEAM(14);
    if (IN(15)) { p_build_vt<64, 4>(c, (const bf16_t*)(c.ar + AR_P1), NO, P1_CV, (bf16_t*)(c.ar + AR_VTC)); }
    SEAM(15);
    if (IN(16)) { p_ret_local(c); for (int item = blockIdx.x; item < NB * 4 * 128; item += gridDim.x) swa_block_item(c, item); }
    SEAM(16);
    if (IN(17)) p_ret_prefix(c);
    SEAM(17);
    if (IN(18)) p_ret_out(c);
    SEAM(18);
    if (MIX_I8 && IN(18) && IN(19)) { p_quant_mix(c, TL); xcd_barrier(bar); }
    if (IN(19)) { constexpr int KE = MIX_I8 ? D / 2 : D;
        pg8::Gemm g{MIX_I8 ? (const bf16_t*)(c.ar + AR_XQ) : XN, (const bf16_t*)(W1 + W1_MIX), TL, D, KE}; pg8::StaticOrder S; S.init(TL, D, gridDim.x, blockIdx.x, KE);
        EpiResModT<MIX_I8 != 0> E{H, H + (size_t)TL * D, H, MOD1 + 2 * 4096, (const float*)(c.ar + AR_XQS), i8_cs(c, CM_MIX + D)};
        pg8::gemm_phase(gl, g, S, E); }
    SEAM(19);
    if (IN(20)) p_norm_mod<1, FFN_I8 != 0>(c, H, H + (size_t)TL * D, TL, MOD1, 3, 4);
    SEAM(20);
    if (IN(21)) { constexpr int KE = FFN_I8 ? D / 2 : D;
        pg8::Gemm g{XN, (const bf16_t*)(W1 + W1_FFI), TL, 2 * DFF, KE}; pg8::StaticOrder S; S.init(TL, 2 * DFF, gridDim.x, blockIdx.x, KE);
        EpiConvGlu E{(bf16_t*)(c.ar + AR_HID), (bf16_t*)(c.ar + AR_SG), (bf16_t*)(c.ar + AR_SU), c.in[I_CONVW] + (size_t)3 * DFF, c.in[I_CONVB] + DFF, (const float*)(c.ws + WS_XN + (size_t)TT * D), i8_cs(c, CM_FFI + 2 * DFF)};
        pg8::gemm_phase(gl, g, S, E); }
    SEAM(21);
    if (IN(22)) { p_conv_fix(c, 1, TL); if (FFO1_I8 && IN(23)) { xcd_barrier(bar); p_quant_hid(c, TL); } }
    SEAM(22);
    if (IN(23)) { constexpr int KE = FFO1_I8 ? DFF / 2 : DFF;
        pg8::Gemm g{(const bf16_t*)(c.ar + (FFO1_I8 ? AR_HQ : AR_HID)), (const bf16_t*)(W1 + W1_FFO), TL, D, KE}; pg8::StaticOrder S; S.init(TL, D, gridDim.x, blockIdx.x, KE);
        EpiResModT<FFO1_I8 != 0> E{H, H + (size_t)TL * D, H, MOD1 + 5 * 4096, (const float*)(c.ar + AR_HQS), i8_cs(c, CM_FFO1)};
        pg8::gemm_phase(gl, g, S, E); }
    SEAM(23);
    if (IN(24)) p_final_norm(c);
#undef IN
#undef SEAM
}

extern "C" void kernel_launch(void* const* d_in, const int* in_sizes, int n_in, void* d_out, int out_size, void* d_ws, size_t ws_size, hipStream_t stream) {
    static int grid = 0;
    if (grid == 0) {
        if (n_in != 29 || ws_size < WS_END) { fprintf(stderr, "kernel_launch: need 29 inputs and >= %zu bytes of workspace; got n_in %d, ws %zu; nothing launched\n", (size_t)WS_END, n_in, ws_size); grid = -1; return; }
        int dev = 0, cus = 0, per_cu = 0;
        if (hipGetDevice(&dev) != hipSuccess || hipDeviceGetAttribute(&cus, hipDeviceAttributeMultiprocessorCount, dev) != hipSuccess) { grid = -1; return; }
        if (hipFuncSetAttribute((const void*)mk_fwd, hipFuncAttributeMaxDynamicSharedMemorySize, LDS_BYTES) != hipSuccess) { fprintf(stderr, "kernel_launch: hipFuncSetAttribute failed\n"); grid = -1; return; }
        if (hipOccupancyMaxActiveBlocksPerMultiprocessor(&per_cu, (const void*)mk_fwd, NTHREADS, LDS_BYTES) != hipSuccess || per_cu < 1) { fprintf(stderr, "kernel_launch: occupancy query says %d blocks per CU\n", per_cu); per_cu = 1; }
        (void)hipGetLastError();
        grid = cus;
    }
    if (grid < 0) return;
    (void)hipMemsetAsync((char*)d_ws + WS_CTL, 0, CTL_BYTES, stream);
    Args a{};
    for (int i = 0; i < 29; ++i) a.in[i] = (const float*)d_in[i];
    a.out = (float*)d_out; a.ws = (unsigned char*)d_ws;
#if MK_PER_PHASE
    for (int p = 0; p < N_PHASES; ++p) { a.ph_lo = p; a.ph_hi = p + 1; hipLaunchKernelGGL(mk_fwd, dim3(grid), dim3(NTHREADS), LDS_BYTES, stream, a); }
#else
    a.ph_lo = 0; a.ph_hi = N_PHASES;
    hipLaunchKernelGGL(mk_fwd, dim3(grid), dim3(NTHREADS), LDS_BYTES, stream, a);
#endif
    (void)in_sizes; (void)out_size;
}
```

```cpp
#include <hip/hip_runtime.h>
#include <cstdio>
#include <cstdint>

#define LAS __attribute__((address_space(3)))
#define DI __device__ __forceinline__
typedef unsigned short bf16_t;
typedef _Float16 h16;
typedef short bf16x8 __attribute__((ext_vector_type(8)));
typedef float f32x4 __attribute__((ext_vector_type(4)));
typedef int i32x4 __attribute__((ext_vector_type(4)));
typedef float f32x2 __attribute__((ext_vector_type(2)));
typedef float f32x16 __attribute__((ext_vector_type(16)));
typedef unsigned u32x4 __attribute__((ext_vector_type(4)));
typedef unsigned u32x2 __attribute__((ext_vector_type(2)));
typedef __bf16 bf16x2_n __attribute__((ext_vector_type(2)));
typedef _Float16 h16x2_n __attribute__((ext_vector_type(2)));

constexpr int D = 4096, NB = 4, SEQ = 4096, CTXL = 256;
constexpr int TL = NB * SEQ, TC = NB * CTXL, TT = TL + TC;
constexpr int DFF = 11008;
constexpr int HALF_W = 2048;
constexpr int COLS_A = 6784, COLS_A_PAD = 6912, COLS_B = 6144, NE = COLS_A_PAD + COLS_B;
constexpr int COLS_C = 2560, COLS_D = 6144, NO = COLS_C + COLS_D;
constexpr int NKEY = SEQ + CTXL;
constexpr int LORA_K = 1280, LORA_KU = 256, LORA_N = 5 * 2048;
constexpr int NTHREADS = 512;

constexpr size_t al256(size_t x) { return (x + 255) & ~(size_t)255; }
constexpr size_t WS_CTL = 0;
constexpr size_t CTL_CMAX = 65536;
constexpr int CM_FFI = 0, CM_INO = 2 * 2 * 11008, CM_INE = CM_INO + 8704, CM_MIX = CM_INE + 13056, CM_FFO1 = CM_MIX + 2 * 4096, CM_FFO0 = CM_FFO1 + 4096, CM_END = CM_FFO0 + 4096;
constexpr size_t CTL_BYTES = CTL_CMAX + (((size_t)CM_END * 4 + 255) & ~(size_t)255);
constexpr size_t WS_MOD = WS_CTL + CTL_BYTES;
constexpr size_t WS_SCAL = WS_MOD + al256((size_t)2 * 5 * 6 * D * 4);
constexpr size_t WS_CS = WS_SCAL + 256;
constexpr size_t WS_AXC = WS_CS + (((size_t)CM_END * 4 + 255) & ~(size_t)255);
constexpr size_t WS_AXS = WS_AXC + (size_t)SEQ * 32 * 4;
constexpr size_t WS_RTC = WS_AXS + (size_t)SEQ * 32 * 4;
constexpr size_t WS_RTS = WS_RTC + (size_t)NKEY * 64 * 4;
constexpr size_t WS_W = WS_RTS + (size_t)NKEY * 64 * 4;
constexpr size_t W_IN = 0;
constexpr size_t W_MIX = W_IN + (size_t)NE * D * 2;
constexpr size_t W_FFI = W_MIX + (size_t)D * D * 2;
constexpr size_t W_FFO = W_FFI + (size_t)2 * DFF * D * 2;
constexpr size_t W_LORA = W_FFO + (size_t)D * DFF * 2;
constexpr size_t W_BYTES = W_LORA + (size_t)LORA_N * LORA_K * 2;
constexpr size_t WS_H = WS_W + al256(W_BYTES);
constexpr size_t WS_XN = WS_H + (size_t)TT * D * 4;
constexpr size_t WS_W1 = WS_XN + (size_t)TT * D * 2;
constexpr size_t W1_MIX = 0, W1_FFI = W1_MIX + (size_t)D * D * 2, W1_FFO = W1_FFI + (size_t)2 * DFF * D * 2, W1_BYTES = W1_FFO + (size_t)D * DFF * 2;
constexpr size_t WS_ARENA = WS_W1 + al256(W1_BYTES);
constexpr size_t SZ16 = (size_t)TT * 2048 * 2;
constexpr size_t MOD_FLOATS = (size_t)2 * 5 * 6 * D;
constexpr size_t AR_XQ = 0, AR_XQS = (size_t)80 << 20;
constexpr size_t AR_MODP = 0;
constexpr size_t AR_PA = 0;
constexpr size_t AR_K = AR_PA + (size_t)TT * COLS_A_PAD * 2;
constexpr size_t AR_LA = AR_K + SZ16;
constexpr size_t RW_NCH = 136;
constexpr size_t CH_BYTES = 24576;
constexpr size_t AR_CH = 0;
constexpr size_t AR_CH_END = AR_CH + (size_t)256 * RW_NCH * CH_BYTES;
constexpr size_t AR_PB = AR_CH_END;
constexpr size_t AR_VT = AR_PB + (size_t)TT * COLS_B * 2;
constexpr size_t AR_R = AR_VT + (size_t)NB * 16 * 128 * NKEY * 2;
constexpr size_t AR_KK = AR_R + SZ16;
constexpr size_t AR_V = AR_KK + SZ16;
constexpr size_t AR_OMW = AR_V + SZ16;
constexpr size_t AR_BB = AR_OMW + 2 * SZ16;
constexpr size_t AR_KD = AR_BB + 2 * SZ16;
constexpr size_t AR_G = AR_KD + 2 * SZ16;
constexpr size_t AR_Y = AR_G + SZ16;
constexpr size_t AR_EVEN_END = AR_Y + 2 * SZ16;
static_assert(AR_LA + (size_t)TT * LORA_K * 2 <= AR_CH_END, "PA|K|LA must sit under the chunk matrices");
constexpr size_t AR_GU = 0;
constexpr size_t AR_SG = 0, AR_SU = AR_SG + (size_t)(TT / 64) * 4 * DFF * 2;
constexpr size_t AR_HQ = (size_t)64 << 20, AR_HQS = (size_t)320 << 20;
constexpr size_t AR_HID = AR_GU + (size_t)TT * 2 * DFF * 2;
constexpr size_t AR_FFN_END = AR_HID + (size_t)TT * DFF * 2;
constexpr size_t AR_P1 = 0;
constexpr size_t AR_VTC = AR_P1 + (size_t)TT * NO * 2;
constexpr size_t AR_RU = AR_VTC + (size_t)NB * 4 * 64 * NKEY * 2;
constexpr size_t AR_RS = AR_RU + (size_t)NB * 8 * 2 * 34 * 256 * 128 * 4;
constexpr size_t AR_ODD_END = AR_RS + (size_t)NB * 8 * 2 * 32 * 256 * 128 * 2;
constexpr size_t AR_SLAB = (size_t)1300 << 20;
constexpr size_t AR_SLAB_END = AR_SLAB + (size_t)4 * TC * D * 4;
static_assert(AR_SLAB >= AR_FFN_END, "slab overlaps the FFN buffers");
constexpr size_t cmax(size_t a, size_t b) { return a > b ? a : b; }
constexpr size_t AR_BYTES = cmax(cmax(AR_EVEN_END, AR_FFN_END), AR_ODD_END);
constexpr size_t WS_END = WS_ARENA + AR_BYTES;
static_assert(WS_END <= (size_t)3221225472ull, "workspace plan exceeds 4 x the largest input tensor");
static_assert(AR_SLAB_END <= AR_BYTES, "slab outside the arena");

DI float bf2f(bf16_t x) { return __uint_as_float((unsigned)x << 16); }
DI bf16_t f2bf(float x) { return __builtin_bit_cast(unsigned short, (__bf16)x); }
DI unsigned pk_bf16(float lo, float hi) { f32x2 v = {lo, hi}; return __builtin_bit_cast(unsigned, __builtin_convertvector(v, bf16x2_n)); }
DI unsigned pk_f16(float lo, float hi) { f32x2 v = {lo, hi}; return __builtin_bit_cast(unsigned, __builtin_convertvector(v, h16x2_n)); }
DI float bflo(unsigned w) { return __uint_as_float(w << 16); }
DI float bfhi(unsigned w) { return __uint_as_float(w & 0xffff0000u); }
DI float h16lo(unsigned w) { return (float)__builtin_bit_cast(h16x2_n, w)[0]; }
DI float h16hi(unsigned w) { return (float)__builtin_bit_cast(h16x2_n, w)[1]; }
DI float silu_f(float x) { return x * __builtin_amdgcn_rcpf(1.0f + __expf(-x)); }
DI float sigmoid_f(float x) { return __builtin_amdgcn_rcpf(1.0f + __expf(-x)); }
DI float wave_sum(float v) {
#pragma unroll
    for (int o = 32; o >= 1; o >>= 1) v += __shfl_xor(v, o);
    return v;
}
DI void load8f(const float* p, float (&o)[8]) { const f32x4 a = *(const f32x4*)p, b = *(const f32x4*)(p + 4);
#pragma unroll
    for (int j = 0; j < 4; ++j) { o[j] = a[j]; o[4 + j] = b[j]; } }
#ifndef RES_F16
#define RES_F16 1
#endif
#if RES_F16
typedef h16 res_t;
#else
typedef float res_t;
#endif
DI f32x4 ld4(const float* p) { return *(const f32x4*)p; }
DI void st4(float* p, const f32x4 v) { *(f32x4*)p = v; }
#if RES_F16
DI f32x4 ld4(const h16* p) { const u32x2 w = *(const u32x2*)p; f32x4 v = {h16lo(w.x), h16hi(w.x), h16lo(w.y), h16hi(w.y)}; return v; }
DI void st4(h16* p, const f32x4 v) { u32x2 w = {pk_f16(v[0], v[1]), pk_f16(v[2], v[3])}; *(u32x2*)p = w; }
#endif
DI int row_modidx(int row) { return row < TL ? (row >> 12) : 4; }

#define XB_TMO      128
#define XB_XCNT(j)  (256  + 64 * (j))
#define XB_XSUB(j)  (1280 + 64 * (j))
#define XB_XGEN(j)  (2304 + 64 * (j))
#define XB_TOP      3328
#define XB_TOPGEN   3392
#define XCD_BAR_WORDS 3456
#define XB_SPIN_CAP (1u << 22)

__device__ __forceinline__ unsigned xb_ld(unsigned* p)              { return __hip_atomic_load(p, __ATOMIC_RELAXED, __HIP_MEMORY_SCOPE_AGENT); }
__device__ __forceinline__ unsigned xb_add(unsigned* p, unsigned v) { return __hip_atomic_fetch_add(p, v, __ATOMIC_RELAXED, __HIP_MEMORY_SCOPE_AGENT); }
__device__ __forceinline__ unsigned xb_xcc_id() { return (unsigned)__builtin_amdgcn_s_getreg((3 << 11) | 20) & 0xFu; }
#define XB_SPIN(cond, bar) do { unsigned _sp = 0; while (cond) { __builtin_amdgcn_s_sleep(1); \
    if ((++_sp & 255u) == 0u) { if (xb_ld(&(bar)[XB_TMO])) break; if (_sp > XB_SPIN_CAP) { atomicAdd(&(bar)[XB_TMO], 1u); break; } } } } while (0)

struct XcdBarrier {
    unsigned* bar; unsigned x;
    volatile LAS unsigned* st;
};

__device__ __forceinline__ XcdBarrier xcd_barrier_post(unsigned* bar, volatile LAS unsigned* st) {
    XcdBarrier b; b.bar = bar; b.x = xb_xcc_id(); b.st = st;
    if (threadIdx.x == 0) (void)xb_add(&bar[XB_XCNT(b.x)], 1u);
    return b;
}
__device__ __forceinline__ void xcd_barrier_complete(unsigned* bar, unsigned x, unsigned& nloc, unsigned& nx) {
    const unsigned G = gridDim.x * gridDim.y * gridDim.z;
    unsigned sum, cnt, mine, sp = 0u;
    for (;;) {
        sum = 0u; cnt = 0u; mine = 0u;
#pragma unroll
        for (unsigned j = 0; j < 16; ++j) { const unsigned c = xb_ld(&bar[XB_XCNT(j)]); sum += c; cnt += (c > 0u) ? 1u : 0u; mine = (j == x) ? c : mine; }
        if (sum == G) break;
        __builtin_amdgcn_s_sleep(1);
        if ((++sp & 255u) == 0u) { if (xb_ld(&bar[XB_TMO])) break; if (sp > XB_SPIN_CAP) { atomicAdd(&bar[XB_TMO], 1u); break; } }
    }
    nloc = mine > 0u ? mine : 1u; nx = cnt > 0u ? cnt : 1u;
}

__device__ __forceinline__ void xcd_barrier(const XcdBarrier& b) {
    asm volatile("s_waitcnt vmcnt(0)" ::: "memory");
    __syncthreads();
    if (threadIdx.x == 0) {
        unsigned* bar = b.bar;
        __builtin_amdgcn_s_waitcnt(0);
        unsigned nloc = b.st[0], nx = b.st[1];
        if (nloc == 0u) { xcd_barrier_complete(bar, b.x, nloc, nx); b.st[0] = nloc; b.st[1] = nx; }
        const unsigned old = xb_add(&bar[XB_XSUB(b.x)], 1u);
        const unsigned gen = old / nloc;
        if (old + 1u == (gen + 1u) * nloc) {
            __builtin_amdgcn_fence(__ATOMIC_RELEASE, "agent");
            asm volatile("s_waitcnt vmcnt(0)" ::: "memory");
            const unsigned og = xb_add(&bar[XB_TOP], 1u);
            const unsigned tg = og / nx;
            if (og + 1u == (tg + 1u) * nx) xb_add(&bar[XB_TOPGEN], 1u);
            else XB_SPIN(xb_ld(&bar[XB_TOPGEN]) == tg, bar);
            __builtin_amdgcn_fence(__ATOMIC_ACQUIRE, "agent");
            xb_add(&bar[XB_XGEN(b.x)], 1u);
            asm volatile("s_waitcnt vmcnt(0)" ::: "memory");
        } else {
            XB_SPIN(xb_ld(&bar[XB_XGEN(b.x)]) == gen, bar);
            __builtin_amdgcn_fence(__ATOMIC_ACQUIRE, "agent");
            asm volatile("s_waitcnt vmcnt(0)" ::: "memory");
        }
    }
    __syncthreads();
}

namespace pg8 {
#define PG8_LAS __attribute__((address_space(3)))
constexpr int BM = 256, BK = 64, HALF = 128, HTB = HALF * BK * 2  , STAGE_BYTES = 8 * HTB, NXCD = 8, WGM = 4;

__host__ __device__ __forceinline__ int lds_byte(int r, int c) { const int st = (r >> 4) * 2 + (c >> 5), rr = r & 15, cc = c & 31, ob = rr * 64 + cc * 2; return st * 1024 + (ob ^ (((ob >> 9) & 1) << 5)); }
__host__ __device__ __forceinline__ void stage_rc(int b, int& R, int& C) { const int st = b / 1024, sb = b % 1024, swz = sb ^ (((sb >> 9) & 1) << 5); R = (st >> 1) * 16 + swz / 64; C = (st & 1) * 32 + (swz % 64) / 2; }
__host__ __device__ __forceinline__ int perm32(int rho) { const int n = rho >> 4, i = rho & 15; return 8 * (i >> 2) + 4 * n + (i & 3); }

struct Unit { int pm, pn, koff, nt, part; };
struct Gemm { const bf16_t* A; const bf16_t* Bt; int M, N, K; };

struct StaticOrder {
    int nM, nN, nwg, G, c, ntk;
    __host__ __device__ void init(int M, int N, int G_, int c_, int K_ = 0) { nM = M / BM; nN = N / BM; nwg = nM * nN; G = G_; c = c_; ntk = K_ / BK; }
    __host__ __device__ bool next(int i, Unit& u) const {
        const long L = (long)i * G + c; if (L >= nwg) return false;
        int wgid = (int)L; { const int q = nwg / NXCD, r = nwg % NXCD, xcd = wgid % NXCD, off = wgid / NXCD; wgid = (xcd < r ? xcd * (q + 1) : r * (q + 1) + (xcd - r) * q) + off; }
        const int nig = WGM * nN, gid = wgid / nig, fm = gid * WGM, gsz = (nM - fm) < WGM ? (nM - fm) : WGM;
        u.pm = fm + ((wgid % nig) % gsz); u.pn = (wgid % nig) / gsz; u.koff = 0; u.nt = ntk; u.part = -1; return true;
    }
    __device__ __forceinline__ void a_ready(const Unit&) const {}
    __device__ __forceinline__ void done(const Unit&) const {}
};


template <class Epi, class Sched>
__device__ __forceinline__ void gemm_phase(PG8_LAS unsigned char* lds, const Gemm g, const Sched& S, const Epi& E) {
    const int tid = threadIdx.x, wid = __builtin_amdgcn_readfirstlane(tid >> 6), lane = tid & 63, wr = wid >> 2, wc = wid & 3, fr = lane & 15, fq = lane >> 4;
    const int K = g.K;
    unsigned voffA[2], voffB[2];
#pragma unroll
    for (int i = 0; i < 2; ++i) { int R, C; stage_rc(tid * 16 + i * 8192, R, C); const int Rb = Epi::PERM ? ((R & ~31) + perm32(R & 31)) : R;
        voffA[i] = (unsigned)(R * K + C) * 2u; voffB[i] = (unsigned)(Rb * K + C) * 2u; }
    const size_t kstep = (size_t)(BK * 2);
    const size_t hstep = (size_t)HALF * K * 2;
    const size_t tstep = 2 * hstep;
    const unsigned ldsw = (unsigned)wid * 1024u;
    const int aoff = lds_byte(wr * 64 + fr, fq * 8), boff = lds_byte(wc * 32 + fr, fq * 8);
#define PG8_SA(b, h) (((b) * 2 + (h)) * HTB)
#define PG8_SB(b, h) ((4 + (b) * 2 + (h)) * HTB)
#define PG8_STAGE(bufoff, gbase, voff) do { _Pragma("unroll") for (int _i = 0; _i < 2; ++_i) \
        __builtin_amdgcn_global_load_lds((const unsigned*)((const char*)(gbase) + (voff)[_i]), (PG8_LAS unsigned*)(lds + (bufoff) + ldsw + _i * 8192), 16, 0, 0); } while (0)
#define PG8_LDA(dst, b, h) do { _Pragma("unroll") for (int m = 0; m < 4; ++m) _Pragma("unroll") for (int k = 0; k < 2; ++k) dst[m][k] = *(const PG8_LAS bf16x8*)(lds + PG8_SA(b, h) + aoff + m * 2048 + k * 1024); } while (0)
#define PG8_LDB(dst, b, h) do { _Pragma("unroll") for (int n = 0; n < 2; ++n) _Pragma("unroll") for (int k = 0; k < 2; ++k) dst[n][k] = *(const PG8_LAS bf16x8*)(lds + PG8_SB(b, h) + boff + n * 2048 + k * 1024); } while (0)
#define PG8_MMA(ai, bj, At, Bt) do { __builtin_amdgcn_s_setprio(1); _Pragma("unroll") for (int m = 0; m < 4; ++m) _Pragma("unroll") for (int n = 0; n < 2; ++n) _Pragma("unroll") for (int k = 0; k < 2; ++k) \
        { if constexpr (Epi::I8) acc[ai][bj][m][n] = __builtin_bit_cast(f32x4, __builtin_amdgcn_mfma_i32_16x16x64_i8(__builtin_bit_cast(i32x4, Bt[n][k]), __builtin_bit_cast(i32x4, At[m][k]), __builtin_bit_cast(i32x4, acc[ai][bj][m][n]), 0, 0, 0)); \
          else acc[ai][bj][m][n] = __builtin_amdgcn_mfma_f32_16x16x32_bf16(Bt[n][k], At[m][k], acc[ai][bj][m][n], 0, 0, 0); } __builtin_amdgcn_s_setprio(0); } while (0)
#define PG8_WAIT_V(n) asm volatile("s_waitcnt vmcnt(" #n ")" ::: "memory")
#define PG8_WAIT_L(n) asm volatile("s_waitcnt lgkmcnt(" #n ")" ::: "memory")
#define PG8_BAR __builtin_amdgcn_s_barrier()
#define PG8_SCHED __builtin_amdgcn_sched_barrier(0)
    Unit cur, nxt; int ui = 0;
    if (!S.next(0, cur)) return;
    f32x4 acc[2][2][4][2];
#pragma unroll
    for (int a = 0; a < 2; ++a)
#pragma unroll
        for (int b = 0; b < 2; ++b)
#pragma unroll
            for (int m = 0; m < 4; ++m)
#pragma unroll
                for (int n = 0; n < 2; ++n) acc[a][b][m][n] = (f32x4){0.f, 0.f, 0.f, 0.f};
    bf16x8 At[4][2], B0[2][2], B1[2][2];
    const char* cA = (const char*)g.A + (size_t)cur.pm * tstep + cur.koff; const char* cB = (const char*)g.Bt + (size_t)cur.pn * tstep + cur.koff;
    S.a_ready(cur);
    PG8_STAGE(PG8_SB(0, 0), cB, voffB); PG8_STAGE(PG8_SB(0, 1), cB + hstep, voffB); PG8_STAGE(PG8_SA(0, 0), cA, voffA); PG8_STAGE(PG8_SA(0, 1), cA + hstep, voffA);
    if (wr == 1) PG8_BAR;
    PG8_WAIT_V(2); PG8_BAR;
    PG8_STAGE(PG8_SB(1, 0), cB + kstep, voffB); PG8_STAGE(PG8_SA(1, 0), cA + kstep, voffA); PG8_STAGE(PG8_SB(1, 1), cB + hstep + kstep, voffB);
    PG8_WAIT_V(6); PG8_BAR;
    for (;;) {
        const bool has_next = S.next(ui + 1, nxt);
        const char* nA = has_next ? (const char*)g.A + (size_t)nxt.pm * tstep + nxt.koff : cA; const char* nB = has_next ? (const char*)g.Bt + (size_t)nxt.pn * tstep + nxt.koff : cB;
        const int nt = cur.nt;
        for (int t = 0; t < nt; t += 2) {
            const bool last = (t == nt - 2);
            const char* a1 = cA + (size_t)(t + 1) * kstep;
            const char* a2 = last ? nA : cA + (size_t)(t + 2) * kstep; const char* b2 = last ? nB : cB + (size_t)(t + 2) * kstep;
            const char* a3 = a2 + kstep; const char* b3 = b2 + kstep;
            if (last && has_next) S.a_ready(nxt);
            PG8_LDB(B0, 0, 0); PG8_LDB(B1, 0, 1); PG8_SCHED; PG8_LDA(At, 0, 0); PG8_STAGE(PG8_SA(1, 1), a1 + hstep, voffA);
            PG8_WAIT_V(8); PG8_WAIT_L(0); PG8_BAR; PG8_MMA(0, 0, At, B0); PG8_MMA(0, 1, At, B1); PG8_BAR; PG8_SCHED;
            PG8_LDA(At, 0, 1); PG8_STAGE(PG8_SB(0, 0), b2, voffB); PG8_STAGE(PG8_SB(0, 1), b2 + hstep, voffB); PG8_STAGE(PG8_SA(0, 0), a2, voffA);
            PG8_WAIT_V(8); PG8_WAIT_L(0); PG8_BAR; PG8_MMA(1, 0, At, B0); PG8_MMA(1, 1, At, B1); PG8_BAR; PG8_SCHED;
            PG8_LDB(B0, 1, 0); PG8_LDB(B1, 1, 1); PG8_SCHED; PG8_LDA(At, 1, 0); PG8_STAGE(PG8_SA(0, 1), a2 + hstep, voffA);
            PG8_WAIT_V(8); PG8_WAIT_L(0); PG8_BAR; PG8_MMA(0, 0, At, B0); PG8_MMA(0, 1, At, B1); PG8_BAR; PG8_SCHED;
            PG8_LDA(At, 1, 1); PG8_STAGE(PG8_SB(1, 0), b3, voffB); PG8_STAGE(PG8_SB(1, 1), b3 + hstep, voffB); PG8_STAGE(PG8_SA(1, 0), a3, voffA);
            PG8_WAIT_V(8); PG8_WAIT_L(0); PG8_BAR; PG8_MMA(1, 0, At, B0); PG8_MMA(1, 1, At, B1); PG8_BAR; PG8_SCHED;
        }
        if (wr == 0) PG8_BAR;
        if constexpr (Epi::I8) E.prescale(acc, cur, wr, wc, fr, fq);
        if constexpr (!Epi::AFTER_DRAIN) { E(acc, cur, wr, wc, fr, fq); S.done(cur); }
        if (!has_next) break;
#pragma unroll
        for (int a = 0; a < 2; ++a)
#pragma unroll
            for (int b = 0; b < 2; ++b)
#pragma unroll
                for (int m = 0; m < 4; ++m)
#pragma unroll
                    for (int n = 0; n < 2; ++n) acc[a][b][m][n] = (f32x4){0.f, 0.f, 0.f, 0.f};
        cur = nxt; cA = nA; cB = nB; ++ui;
        if (wr == 1) PG8_BAR;
    }
    PG8_WAIT_V(0);
    PG8_BAR;
    if constexpr (Epi::AFTER_DRAIN) { E.fused(acc, cur, wr, wc, fr, fq, lds, wid, lane); S.done(cur); }
#undef PG8_SA
#undef PG8_SB
#undef PG8_STAGE
#undef PG8_LDA
#undef PG8_LDB
#undef PG8_MMA
#undef PG8_WAIT_V
#undef PG8_WAIT_L
#undef PG8_BAR
#undef PG8_SCHED
}

}

#ifndef INO_I8
#define INO_I8 0
#endif
#ifndef FFO1_I8
#define FFO1_I8 1
#endif
#ifndef FFO0_I8
#define FFO0_I8 1
#endif
#ifndef MIX_I8
#define MIX_I8 0
#endif
#ifndef FFN_I8
#define FFN_I8 1
#endif
struct Args { const float* in[29]; float* out; unsigned char* ws; int ph_lo, ph_hi; };
struct Ctx {
    const float* in[29]; float* out; unsigned char* ws; unsigned char* ar;
    LAS unsigned char* lds;
    int tid, lane, wave;
};
enum { I_X = 0, I_C, I_CTX, I_CCTX, I_WMOD, I_BMOD, I_WINE, I_MU, I_W0, I_W2, I_A0, I_A2, I_G2, I_KK, I_KA, I_RK, I_LNW, I_LNB, I_LAM, I_SUBLN,
       I_WINO, I_SINK, I_RDEC, I_WMIX, I_WFFI, I_CONVW, I_CONVB, I_WFFO, I_FNORM };

__device__ __forceinline__ void p_mod(const Ctx& c) {
    LAS float* sc = (LAS float*)c.lds;
    LAS float* red = sc + 5 * 4096;
    const int tid = c.tid, lane = c.lane, w = c.wave;
    for (int i = tid; i < 5 * 4096; i += NTHREADS) { const int r = i >> 12, k = i & 4095; const float v = r < 4 ? c.in[I_C][r * 4096 + k] : c.in[I_CCTX][k]; sc[i] = silu_f(v); }
    __syncthreads();
    float* MODP = (float*)(c.ar + AR_MODP);
    for (int u = blockIdx.x; u < 768; u += gridDim.x) {
        const int kp = u & 3, cg = (u >> 2) % 96, l = u / 384;
        const int k0 = kp * 1024 + w * 128;
        const float* wp = c.in[I_WMOD] + ((size_t)l * 4096 + k0) * 24576 + cg * 256 + lane * 4;
        f32x4 acc[5];
#pragma unroll
        for (int r = 0; r < 5; ++r) acc[r] = (f32x4){0.f, 0.f, 0.f, 0.f};
#pragma unroll 2
        for (int k = 0; k < 128; k += 4) {
            f32x4 wv[4];
#pragma unroll
            for (int j = 0; j < 4; ++j) wv[j] = __builtin_nontemporal_load((const f32x4*)(wp + (size_t)(k + j) * 24576));
#pragma unroll
            for (int r = 0; r < 5; ++r) { const f32x4 s4 = *(const LAS f32x4*)(sc + r * 4096 + k0 + k);
#pragma unroll
                for (int j = 0; j < 4; ++j) acc[r] += wv[j] * s4[j]; }
        }
#pragma unroll
        for (int r = 0; r < 5; ++r) *(LAS f32x4*)(red + (w * 5 + r) * 256 + lane * 4) = acc[r];
        __syncthreads();
        for (int idx = tid; idx < 5 * 256; idx += NTHREADS) { const int r = idx >> 8, col = idx & 255; float s = 0.f;
#pragma unroll
            for (int q = 0; q < 8; ++q) s += red[(q * 5 + r) * 256 + col];
            if (kp == 0) s += c.in[I_BMOD][l * 24576 + cg * 256 + col];
            MODP[(size_t)kp * MOD_FLOATS + ((size_t)l * 5 + r) * 24576 + cg * 256 + col] = s; }
        __syncthreads();
    }
}

__device__ __forceinline__ void p_mod_finalize(const Ctx& c) {
    const float* MODP = (const float*)(c.ar + AR_MODP); float* MOD = (float*)(c.ws + WS_MOD);
    for (size_t i = ((size_t)blockIdx.x * NTHREADS + c.tid) * 4; i < MOD_FLOATS; i += (size_t)gridDim.x * NTHREADS * 4)
        *(f32x4*)(MOD + i) = (*(const f32x4*)(MODP + i) + *(const f32x4*)(MODP + MOD_FLOATS + i)) + (*(const f32x4*)(MODP + 2 * MOD_FLOATS + i) + *(const f32x4*)(MODP + 3 * MOD_FLOATS + i));
}
DI int perm64(int m) { const int within = m & 255, rho = within & 127; return (m & ~255) + (rho >> 5) * 64 + (within >> 7) * 32 + (rho & 31); }
DI int perm128(int m) { const int within = m & 255, rho = within & 127; return (m & ~255) + (rho >> 6) * 128 + (within >> 7) * 64 + (rho & 63); }
DI int in_odd_src(int n) { return n < 2304 ? perm64(n) : (n < 2560 ? n : (n < 4608 ? 2560 + perm128(n - 2560) : n)); }
__device__ __forceinline__ int p_convert_job(const Ctx& c, const float* __restrict__ src, int src_ld, int K, int n0, int ncnt, bf16_t* __restrict__ dst, int dn0, int base, int nperm = 0) {
    LAS unsigned short* T = (LAS unsigned short*)c.lds;
    const int tid = c.tid, tk = K / 64, tn = ncnt / 128, nt = tk * tn, G = (int)gridDim.x;
    int first = (int)blockIdx.x - (base % G); if (first < 0) first += G;
    const int kr = tid >> 3, c16 = (tid & 7) * 16, wn = tid >> 2, k16 = (tid & 3) * 16;
    f32x4 v[4], vn[4];
    if (first < nt) { const int nn = (first / tk) * 128 + c16; const float* p = src + (size_t)((first % tk) * 64 + kr) * src_ld + n0 + (nn < nperm ? perm64(nn) : nn);
#pragma unroll
        for (int i = 0; i < 4; ++i) v[i] = __builtin_nontemporal_load((const f32x4*)(p + 4 * i)); }
    for (int t = first; t < nt; t += G) {
        const int t2 = t + G;
        if (t2 < nt) { const int nn = (t2 / tk) * 128 + c16; const float* p = src + (size_t)((t2 % tk) * 64 + kr) * src_ld + n0 + (nn < nperm ? perm64(nn) : nn);
#pragma unroll
            for (int i = 0; i < 4; ++i) vn[i] = __builtin_nontemporal_load((const f32x4*)(p + 4 * i)); }
#pragma unroll
        for (int i = 0; i < 4; ++i)
#pragma unroll
            for (int j = 0; j < 4; ++j) T[(c16 + 4 * i + j) * 72 + kr] = f2bf(v[i][j]);
        __syncthreads();
        { const u32x4 a = *(const LAS u32x4*)(T + wn * 72 + k16), b = *(const LAS u32x4*)(T + wn * 72 + k16 + 8);
          bf16_t* q = dst + (size_t)(dn0 + (t / tk) * 128 + wn) * K + (t % tk) * 64 + k16;
          *(u32x4*)q = a; *(u32x4*)(q + 8) = b; }
        __syncthreads();
#pragma unroll
        for (int i = 0; i < 4; ++i) v[i] = vn[i];
    }
    return base + nt;
}
DI void conv_wave_tile(const float* __restrict__ src, int src_ld, int k0, int nsrc, int n0, bf16_t* __restrict__ dst, int K, int lane) {
    float v[32];
    const float* p = src + (size_t)k0 * src_ld + nsrc;
#pragma unroll
    for (int kk = 0; kk < 32; ++kk) v[kk] = __builtin_nontemporal_load(p + (size_t)kk * src_ld);
    bf16_t* q = dst + (size_t)(n0 + lane) * K + k0;
#pragma unroll
    for (int g = 0; g < 4; ++g) { u32x4 w; w.x = pk_bf16(v[8 * g], v[8 * g + 1]); w.y = pk_bf16(v[8 * g + 2], v[8 * g + 3]); w.z = pk_bf16(v[8 * g + 4], v[8 * g + 5]); w.w = pk_bf16(v[8 * g + 6], v[8 * g + 7]);
        *(u32x4*)(q + 8 * g) = w; }
}
DI unsigned pk_i8x4(float a, float b, float c2, float d) { const int ia = (int)rintf(a), ib = (int)rintf(b), ic = (int)rintf(c2), id = (int)rintf(d);
    return ((unsigned)ia & 255u) | (((unsigned)ib & 255u) << 8) | (((unsigned)ic & 255u) << 16) | ((unsigned)id << 24); }
template <class T> DI void fwht32(T (&v)[32]) {
#pragma unroll
    for (int h = 1; h < 32; h <<= 1)
#pragma unroll
        for (int i = 0; i < 32; i += 2 * h)
#pragma unroll
            for (int j = i; j < i + h; ++j) { const T a = v[j], b = v[j + h]; v[j] = a + b; v[j + h] = a - b; }
}
DI unsigned* i8_cmax(const Ctx& c, int off) { return (unsigned*)(c.ws + WS_CTL + CTL_CMAX) + off; }
DI float* i8_cs(const Ctx& c, int off) { return (float*)(c.ws + WS_CS) + off; }
DI void conv_wave_tile_q8(const float* __restrict__ src, int src_ld, int k0, int nsrc, int n0, unsigned char* __restrict__ dst, int K, int lane, const unsigned* cmax, float* cs) {
    float v[32];
    const float* p = src + (size_t)k0 * src_ld + nsrc;
#pragma unroll
    for (int kk = 0; kk < 32; ++kk) v[kk] = __builtin_nontemporal_load(p + (size_t)kk * src_ld);
    const float cm = __uint_as_float(cmax[nsrc]); const float qs = cm > 0.f ? 127.0f / cm : 0.f;
    if (k0 == 0) cs[n0 + lane] = cm * (1.0f / 127.0f);
    fwht32(v);
    unsigned char* q = dst + (size_t)(n0 + lane) * K + k0;
#pragma unroll
    for (int g = 0; g < 2; ++g) { u32x4 w;
#pragma unroll
        for (int j = 0; j < 4; ++j) w[j] = pk_i8x4(v[16 * g + 4 * j] * 0.03125f * qs, v[16 * g + 4 * j + 1] * 0.03125f * qs, v[16 * g + 4 * j + 2] * 0.03125f * qs, v[16 * g + 4 * j + 3] * 0.03125f * qs);
        *(u32x4*)(q + 16 * g) = w; }
}
struct CmxDeal { int worker, nworkers, lo, hi; };
__device__ __forceinline__ int p_wcolmax_job(const Ctx& c, const float* __restrict__ src0, int ld, int K, unsigned* cmax, int base, const CmxDeal dl) {
    LAS float* red = (LAS float*)c.lds;
    const int ncg = (ld + 255) / 256, nko = (K + 1023) / 1024, nitem = ncg * nko;
    int g0 = dl.lo + dl.worker; if (g0 < base) g0 += ((base - g0 + dl.nworkers - 1) / dl.nworkers) * dl.nworkers;
    const int gend = dl.hi < base + nitem ? dl.hi : base + nitem;
#pragma unroll 1
    for (int g = g0; g < gend; g += dl.nworkers) { const int it = g - base;
        const int cg = it % ncg, ko = it / ncg, col = cg * 256 + c.lane * 4;
        f32x4 mx = {0.f, 0.f, 0.f, 0.f};
        if (col < ld && ko * 1024 + c.wave * 128 < K) {
#pragma unroll 1
            for (int t = 0; t < 4; ++t) {
                f32x4 v[32]; const float* p = src0 + (size_t)(ko * 1024 + c.wave * 128 + t * 32) * ld + col;
#pragma unroll
                for (int kk = 0; kk < 32; ++kk) v[kk] = __builtin_nontemporal_load((const f32x4*)(p + (size_t)kk * ld));
                fwht32(v);
#pragma unroll
                for (int kk = 0; kk < 32; ++kk)
#pragma unroll
                    for (int j = 0; j < 4; ++j) mx[j] = fmaxf(mx[j], fabsf(v[kk][j]));
            }
        }
        *(LAS f32x4*)(red + c.wave * 256 + c.lane * 4) = mx;
        __syncthreads();
        if (c.tid < 256) { float m = red[c.tid];
#pragma unroll
            for (int w = 1; w < 8; ++w) m = fmaxf(m, red[w * 256 + c.tid]);
            const int cc = cg * 256 + c.tid; if (cc < ld) atomicMax(cmax + cc, __float_as_uint(m * 0.03125f)); }
        __syncthreads();
    }
    return base + nitem;
}
constexpr int CMX_TOTAL = (FFN_I8 ? 2 * (2 * DFF / 256) * (D / 1024) : 0) + (INO_I8 ? (NO / 256) * (D / 1024) : 0) + ((FFO0_I8 ? 1 : 0) + (FFO1_I8 ? 1 : 0)) * (D / 256) * ((DFF + 1023) / 1024) + (MIX_I8 ? 2 * (D / 256) * (D / 1024) : 0);
__device__ __forceinline__ void p_wcolmax(const Ctx& c, const CmxDeal dl) {
    int base = 0;
    __syncthreads();
    if (FFN_I8) { base = p_wcolmax_job(c, c.in[I_WFFI], 2 * DFF, D, i8_cmax(c, CM_FFI), base, dl); base = p_wcolmax_job(c, c.in[I_WFFI] + (size_t)D * 2 * DFF, 2 * DFF, D, i8_cmax(c, CM_FFI + 2 * DFF), base, dl); }
    if (INO_I8) base = p_wcolmax_job(c, c.in[I_WINO], NO, D, i8_cmax(c, CM_INO), base, dl);
    if (FFO0_I8) base = p_wcolmax_job(c, c.in[I_WFFO], D, DFF, i8_cmax(c, CM_FFO0), base, dl);
    if (FFO1_I8) base = p_wcolmax_job(c, c.in[I_WFFO] + (size_t)DFF * D, D, DFF, i8_cmax(c, CM_FFO1), base, dl);
    if (MIX_I8) { base = p_wcolmax_job(c, c.in[I_WMIX], D, D, i8_cmax(c, CM_MIX), base, dl); base = p_wcolmax_job(c, c.in[I_WMIX] + (size_t)D * D, D, D, i8_cmax(c, CM_MIX + D), base, dl); }
}
#ifndef CMX_P0
#define CMX_P0 624
#endif
DI int cmx_ns(int G) { return G == 256 ? 8 : 0; }
DI int cmx_p0(int G) { return cmx_ns(G) ? (CMX_P0 < CMX_TOTAL ? CMX_P0 : CMX_TOTAL) : CMX_TOTAL; }
__device__ __forceinline__ void p_weights_layer0(const Ctx& c) {
    bf16_t* W = (bf16_t*)(c.ws + WS_W);
    {   constexpr int T_IN = (4096 / 32) * ((COLS_A + COLS_B) / 64), T_MIX = (4096 / 32) * (4096 / 64), T_L96 = 3 * (2048 / 64), T_LG = 8 * (2048 / 64);
        constexpr int E0 = T_IN, E1 = E0, E2 = E1 + 4 * T_L96, E3 = E2 + T_LG;
        bf16_t* L = (bf16_t*)((unsigned char*)W + W_LORA);
        for (int t = blockIdx.x * 8 + c.wave; t < E3; t += gridDim.x * 8) {
            if (t < E0) { const int kt = t & 127, g = t >> 7, n = g * 64 + c.lane;
                const int nsrc = n < COLS_A ? n : COLS_A + (n - COLS_A < 4096 ? perm64(n - COLS_A) : n - COLS_A);
                conv_wave_tile(c.in[I_WINE], COLS_A + COLS_B, kt * 32, nsrc, n < COLS_A ? g * 64 : g * 64 + (COLS_A_PAD - COLS_A), (bf16_t*)((unsigned char*)W + W_IN), 4096, c.lane); }
            else if (t < E1) { const int tl = t - E0, kt = tl & 127, g = tl >> 7;
                conv_wave_tile(c.in[I_WMIX], 4096, kt * 32, g * 64 + c.lane, g * 64, (bf16_t*)((unsigned char*)W + W_MIX), 4096, c.lane); }
            else if (t < E2) { const int tl = t - E1, type = tl / T_L96, r2 = tl % T_L96, kt = r2 % 3, g = r2 / 3;
                const float* src = (type < 2 ? c.in[I_W2] + (size_t)type * 96 * 2048 : c.in[I_A2] + (size_t)(type - 2) * 96 * 2048);
                conv_wave_tile(src, 2048, kt * 32, g * 64 + c.lane, g * 64, L + (size_t)type * 2048 * LORA_K + type * LORA_KU, LORA_K, c.lane); }
            else { const int tl = t - E2, kt = tl & 7, g = tl >> 3;
                conv_wave_tile(c.in[I_G2], 2048, kt * 32, g * 64 + c.lane, g * 64, L + (size_t)4 * 2048 * LORA_K + 4 * LORA_KU, LORA_K, c.lane); }
        }
    }
    const size_t gtid = (size_t)blockIdx.x * NTHREADS + c.tid, gn = (size_t)gridDim.x * NTHREADS;
    { u32x4* z = (u32x4*)((unsigned char*)W + W_IN + (size_t)COLS_A * 4096 * 2); const size_t n16 = (size_t)(COLS_A_PAD - COLS_A) * 4096 * 2 / 16;
      for (size_t i = gtid; i < n16; i += gn) z[i] = (u32x4){0u, 0u, 0u, 0u}; }
    { bf16_t* L = (bf16_t*)((unsigned char*)W + W_LORA);
      for (size_t i = gtid; i < (size_t)4 * 2048 * 20; i += gn) { const int n = (int)(i / 20), ch = (int)(i % 20), type = n >> 11;
          *(u32x4*)(L + (size_t)n * LORA_K + type * LORA_KU + 96 + ch * 8) = (u32x4){0u, 0u, 0u, 0u}; } }
    { float* axc = (float*)(c.ws + WS_AXC); float* axs = (float*)(c.ws + WS_AXS);
      for (size_t i = gtid; i < (size_t)SEQ * 32; i += gn) { const int pos = (int)(i >> 5), a = (int)(i & 31), q = a & 15;
          const float inv = powf(10000.0f, -(float)q / 16.0f); const float p = (a < 16) ? (float)(pos >> 6) : (float)(pos & 63);
          float sn, cs; sincosf(p * inv, &sn, &cs); axc[i] = cs; axs[i] = sn; } }
    { float* rtc = (float*)(c.ws + WS_RTC); float* rts = (float*)(c.ws + WS_RTS);
      for (size_t i = gtid; i < (size_t)NKEY * 64; i += gn) { const int pos = (int)(i >> 6), a = (int)(i & 63);
          const float t = (float)a / 63.0f; const float inv = powf(10000.0f, -t);
          float sn, cs; sincosf((float)pos * inv, &sn, &cs); rtc[i] = cs; rts[i] = sn; } }
    if (gtid == 0) { const float* lv = c.in[I_LAM]; float s01 = 0.f, s23 = 0.f;
        for (int i = 0; i < 64; ++i) { s01 += lv[i] * lv[64 + i]; s23 += lv[128 + i] * lv[192 + i]; }
        ((float*)(c.ws + WS_SCAL))[0] = expf(s01) - expf(s23) + 0.2f; }
}
constexpr int CONV_SPLIT = 128192;
__device__ __forceinline__ void p_convert_deferred(const Ctx& c, int worker, int nworkers, int tlo, int thi) {
    unsigned char* W = c.ws + WS_W; unsigned char* W1 = c.ws + WS_W1;
    constexpr int T_FFI = (4096 / 32) * (2 * DFF / 64), T_FFO = (DFF / 32) * (4096 / 64), T_IN1 = (4096 / 32) * (NO / 64), T_MIX = (4096 / 32) * (4096 / 64);
    constexpr int EM = T_MIX, E0 = EM + T_FFI, E1 = E0 + T_FFO, E2 = E1 + T_IN1, E3 = E2 + T_MIX, E4 = E3 + T_FFI, E5 = E4 + T_FFO;
    const int tend = thi < E5 ? thi : E5;
    for (int t = tlo + worker; t < tend; t += nworkers) {
        const float* src; int ld, K, tl; bf16_t* dst; int mixl = -1;
        if (t < EM) { src = c.in[I_WMIX]; ld = 4096; K = 4096; tl = t; dst = (bf16_t*)(W + W_MIX); mixl = 0; }
        else if (t < E0) { src = c.in[I_WFFI]; ld = 2 * DFF; K = 4096; tl = t - EM; dst = (bf16_t*)(W + W_FFI); }
        else if (t < E1) { src = c.in[I_WFFO]; ld = 4096; K = DFF; tl = t - E0; dst = (bf16_t*)(W + W_FFO); mixl = 3; }
        else if (t < E2) { src = c.in[I_WINO]; ld = NO; K = 4096; tl = t - E1; dst = (bf16_t*)(W + W_IN); }
        else if (t < E3) { src = c.in[I_WMIX] + (size_t)4096 * 4096; ld = 4096; K = 4096; tl = t - E2; dst = (bf16_t*)(W1 + W1_MIX); mixl = 1; }
        else if (t < E4) { src = c.in[I_WFFI] + (size_t)4096 * 2 * DFF; ld = 2 * DFF; K = 4096; tl = t - E3; dst = (bf16_t*)(W1 + W1_FFI); }
        else { src = c.in[I_WFFO] + (size_t)DFF * 4096; ld = 4096; K = DFF; tl = t - E4; dst = (bf16_t*)(W1 + W1_FFO); mixl = 2; }
        const int tk = K / 32, kt = tl % tk, ntile = tl / tk;
        int ncol = ntile * 64;
        if (ld == 2 * DFF) { const int tile = ncol >> 8, within = ncol & 255; ncol = within < 128 ? 128 * tile + within : DFF + 128 * tile + (within - 128); }
        const int nsrc = (ld == NO) ? in_odd_src(ntile * 64 + c.lane) : ncol + c.lane;
        if (FFN_I8 && ld == 2 * DFF) { const int off = CM_FFI + (t < E0 ? 0 : 2 * DFF); conv_wave_tile_q8(src, ld, kt * 32, nsrc, ntile * 64, (unsigned char*)dst, K, c.lane, i8_cmax(c, off), i8_cs(c, off)); }
        else if (FFO0_I8 && mixl == 3) conv_wave_tile_q8(src, ld, kt * 32, nsrc, ntile * 64, (unsigned char*)dst, K, c.lane, i8_cmax(c, CM_FFO0), i8_cs(c, CM_FFO0));
        else if (FFO1_I8 && mixl == 2) conv_wave_tile_q8(src, ld, kt * 32, nsrc, ntile * 64, (unsigned char*)dst, K, c.lane, i8_cmax(c, CM_FFO1), i8_cs(c, CM_FFO1));
        else if (MIX_I8 && mixl >= 0 && mixl < 2) conv_wave_tile_q8(src, ld, kt * 32, nsrc, ntile * 64, (unsigned char*)dst, K, c.lane, i8_cmax(c, CM_MIX + mixl * D), i8_cs(c, CM_MIX + mixl * D));
        else if (INO_I8 && ld == NO) conv_wave_tile_q8(src, ld, kt * 32, nsrc, ntile * 64, (unsigned char*)dst, K, c.lane, i8_cmax(c, CM_INO), i8_cs(c, CM_INO));
        else conv_wave_tile(src, ld, kt * 32, nsrc, ntile * 64, dst, K, c.lane);
    }
}

template <class TS>
__device__ __forceinline__ void p_ctx_fix(const Ctx& c, const TS* srcc, const float* gate, const float* slab, res_t* H) {
    for (int row = blockIdx.x * 8 + c.wave; row < TT; row += gridDim.x * 8) {
        if (row < TL) continue;
        const size_t ro = (size_t)(row - TL) * D;
#pragma unroll 4
        for (int i = 0; i < 16; ++i) { const int col = i * 256 + c.lane * 4;
            const f32x4 s4 = (*(const f32x4*)(slab + ro + col) + *(const f32x4*)(slab + (size_t)TC * D + ro + col)) + (*(const f32x4*)(slab + (size_t)2 * TC * D + ro + col) + *(const f32x4*)(slab + (size_t)3 * TC * D + ro + col));
            st4(H + (size_t)row * D + col, ld4(srcc + ro + col) + *(const f32x4*)(gate + col) * s4); }
    }
}
template <int NPARTS = 1, bool Q8 = false, class TS = float>
__device__ __forceinline__ void p_norm_mod(const Ctx& c, const TS* hl, const TS* hc, int nrows, const float* mod, int shift_chunk, int scale_chunk) {
    bf16_t* XN = (bf16_t*)(c.ws + WS_XN);
    for (int row = blockIdx.x * 8 + c.wave; row < nrows; row += gridDim.x * 8) {
        const TS* src = row < TL ? hl + (size_t)row * D : hc + (size_t)(row - TL) * D;
        f32x4 v[16]; float ss = 0.f;
#pragma unroll
        for (int i = 0; i < 16; ++i) { v[i] = ld4(src + i * 256 + c.lane * 4); ss += v[i][0] * v[i][0] + v[i][1] * v[i][1] + v[i][2] * v[i][2] + v[i][3] * v[i][3]; }
        ss = wave_sum(ss);
        const float rs = rsqrtf(ss * (1.0f / 4096.0f) + 1e-6f);
        const float* mp = mod + (size_t)row_modidx(row) * 24576;
        bf16_t* dst = XN + (size_t)row * D;
        if constexpr (Q8) {
            float mx = 0.f;
#pragma unroll
            for (int i = 0; i < 16; ++i) { const int col = i * 256 + c.lane * 4;
                const f32x4 sh = *(const f32x4*)(mp + shift_chunk * 4096 + col), sc = *(const f32x4*)(mp + scale_chunk * 4096 + col);
#pragma unroll
                for (int j = 0; j < 4; ++j) v[i][j] = v[i][j] * rs * (1.f + sc[j]) + sh[j];
                { const float a0 = v[i][0] + v[i][1], a1 = v[i][0] - v[i][1], a2 = v[i][2] + v[i][3], a3 = v[i][2] - v[i][3];
                  v[i][0] = a0 + a2; v[i][1] = a1 + a3; v[i][2] = a0 - a2; v[i][3] = a1 - a3; }
#pragma unroll
                for (int j = 0; j < 4; ++j) { float x = v[i][j];
                    { const float t = __int_as_float(__builtin_amdgcn_update_dpp(0, __float_as_int(x), 0xB1, 0xF, 0xF, false)); x = (c.lane & 1) ? t - x : x + t; }
                    { const float t = __int_as_float(__builtin_amdgcn_update_dpp(0, __float_as_int(x), 0x4E, 0xF, 0xF, false)); x = (c.lane & 2) ? t - x : x + t; }
                    { const float t = __int_as_float(__builtin_amdgcn_ds_swizzle(__float_as_int(x), 0x101F)); x = (c.lane & 4) ? t - x : x + t; }
                    v[i][j] = x; mx = fmaxf(mx, fabsf(x)); } }
#pragma unroll
            for (int o = 32; o >= 1; o >>= 1) mx = fmaxf(mx, __shfl_xor(mx, o));
            const float qs = mx > 0.f ? 127.0f / mx : 0.f;
            unsigned char* d8 = (unsigned char*)XN + (size_t)row * D;
#pragma unroll
            for (int i = 0; i < 16; ++i) *(unsigned*)(d8 + i * 256 + c.lane * 4) = pk_i8x4(v[i][0] * qs, v[i][1] * qs, v[i][2] * qs, v[i][3] * qs);
            if (c.lane == 0) ((float*)(c.ws + WS_XN + (size_t)TT * D))[row] = mx * (1.0f / 127.0f);
            continue;
        }
#pragma unroll
        for (int i = 0; i < 16; ++i) { const int col = i * 256 + c.lane * 4;
            f32x4 sh = *(const f32x4*)(mp + shift_chunk * 4096 + col), sc = *(const f32x4*)(mp + scale_chunk * 4096 + col);
            if constexpr (NPARTS == 4) {
                sh = (sh + *(const f32x4*)(mp + MOD_FLOATS + shift_chunk * 4096 + col)) + (*(const f32x4*)(mp + 2 * MOD_FLOATS + shift_chunk * 4096 + col) + *(const f32x4*)(mp + 3 * MOD_FLOATS + shift_chunk * 4096 + col));
                sc = (sc + *(const f32x4*)(mp + MOD_FLOATS + scale_chunk * 4096 + col)) + (*(const f32x4*)(mp + 2 * MOD_FLOATS + scale_chunk * 4096 + col) + *(const f32x4*)(mp + 3 * MOD_FLOATS + scale_chunk * 4096 + col)); }
            u32x2 w; w.x = pk_bf16(v[i][0] * rs * (1.f + sc[0]) + sh[0], v[i][1] * rs * (1.f + sc[1]) + sh[1]);
            w.y = pk_bf16(v[i][2] * rs * (1.f + sc[2]) + sh[2], v[i][3] * rs * (1.f + sc[3]) + sh[3]);
            *(u32x2*)(dst + col) = w; }
    }
}
__device__ __forceinline__ void p_final_norm(const Ctx& c) {
    const res_t* H = (const res_t*)(c.ws + WS_H);
    for (int row = blockIdx.x * 8 + c.wave; row < TL; row += gridDim.x * 8) {
        const res_t* src = H + (size_t)row * D;
        f32x4 v[16]; float ss = 0.f;
#pragma unroll
        for (int i = 0; i < 16; ++i) { v[i] = ld4(src + i * 256 + c.lane * 4); ss += v[i][0] * v[i][0] + v[i][1] * v[i][1] + v[i][2] * v[i][2] + v[i][3] * v[i][3]; }
        ss = wave_sum(ss);
        const float rs = rsqrtf(ss * (1.0f / 4096.0f) + 1e-6f);
        float* dst = c.out + (size_t)row * D;
#pragma unroll
        for (int i = 0; i < 16; ++i) { const int col = i * 256 + c.lane * 4; const f32x4 g = *(const f32x4*)(c.in[I_FNORM] + col);
            *(f32x4*)(dst + col) = v[i] * rs * g; }
    }
}

DI void rope_store(const f32x4 (&acc)[2][2][4][2], int ai, int m, const float* tc, const float* ts, bool rot, float scale, bf16_t* o1p, bf16_t* o2p) {
    float o1[8], o2[8];
#pragma unroll
    for (int n = 0; n < 2; ++n) { f32x4 cs = {1.f, 1.f, 1.f, 1.f}, sn = {0.f, 0.f, 0.f, 0.f};
        if (rot) { cs = *(const f32x4*)(tc + 4 * n); sn = *(const f32x4*)(ts + 4 * n); }
#pragma unroll
        for (int e = 0; e < 4; ++e) { const float x1 = acc[ai][0][m][n][e], x2 = acc[ai][1][m][n][e];
            o1[4 * n + e] = (x1 * cs[e] - x2 * sn[e]) * scale; o2[4 * n + e] = (x2 * cs[e] + x1 * sn[e]) * scale; } }
    u32x4 w1, w2; w1.x = pk_bf16(o1[0], o1[1]); w1.y = pk_bf16(o1[2], o1[3]); w1.z = pk_bf16(o1[4], o1[5]); w1.w = pk_bf16(o1[6], o1[7]);
    w2.x = pk_bf16(o2[0], o2[1]); w2.y = pk_bf16(o2[2], o2[3]); w2.z = pk_bf16(o2[4], o2[5]); w2.w = pk_bf16(o2[6], o2[7]);
    *(u32x4*)o1p = w1; *(u32x4*)o2p = w2;
}
DI void plain_store(const f32x4 (&acc)[2][2][4][2], int ai, int m, bf16_t* rowp) {
#pragma unroll
    for (int bj = 0; bj < 2; ++bj) { const f32x4 v0 = acc[ai][bj][m][0], v1 = acc[ai][bj][m][1];
        u32x4 w; w.x = pk_bf16(v0[0], v0[1]); w.y = pk_bf16(v0[2], v0[3]); w.z = pk_bf16(v1[0], v1[1]); w.w = pk_bf16(v1[2], v1[3]);
        *(u32x4*)(rowp + bj * 128) = w; }
}
DI void i8_prescale(f32x4 (&acc)[2][2][4][2], const float* SA, const float* CS, const pg8::Unit& u, int wr, int wc, int fr, int fq) {
    f32x4 cs[2][2];
#pragma unroll
    for (int bj = 0; bj < 2; ++bj)
#pragma unroll
        for (int n = 0; n < 2; ++n) cs[bj][n] = *(const f32x4*)(CS + u.pn * 256 + bj * 128 + wc * 32 + 8 * fq + 4 * n);
#pragma unroll
    for (int ai = 0; ai < 2; ++ai)
#pragma unroll
        for (int m = 0; m < 4; ++m) { const float s = SA[u.pm * 256 + ai * 128 + wr * 64 + 16 * m + fr];
#pragma unroll
            for (int bj = 0; bj < 2; ++bj)
#pragma unroll
                for (int n = 0; n < 2; ++n)
#pragma unroll
                    for (int e = 0; e < 4; ++e) acc[ai][bj][m][n][e] = (float)__float_as_int(acc[ai][bj][m][n][e]) * (s * cs[bj][n][e]); }
}
DI void i8_prescale_np(f32x4 (&acc)[2][2][4][2], const float* SA, const float* CS, const pg8::Unit& u, int wr, int wc, int fr, int fq) {
    f32x4 cs[2][2];
#pragma unroll
    for (int bj = 0; bj < 2; ++bj)
#pragma unroll
        for (int n = 0; n < 2; ++n) cs[bj][n] = *(const f32x4*)(CS + u.pn * 256 + wc * 32 + 4 * fq + bj * 128 + n * 16);
#pragma unroll
    for (int ai = 0; ai < 2; ++ai)
#pragma unroll
        for (int m = 0; m < 4; ++m) { const float s = SA[u.pm * 256 + ai * 128 + wr * 64 + 16 * m + fr];
#pragma unroll
            for (int bj = 0; bj < 2; ++bj)
#pragma unroll
                for (int n = 0; n < 2; ++n)
#pragma unroll
                    for (int e = 0; e < 4; ++e) acc[ai][bj][m][n][e] = (float)__float_as_int(acc[ai][bj][m][n][e]) * (s * cs[bj][n][e]); }
}
struct EpiInEven {
    static constexpr bool PERM = true, AFTER_DRAIN = false, I8 = false;
    bf16_t* PA; bf16_t* PB; const float* axc; const float* axs;
    DI void operator()(const f32x4 (&acc)[2][2][4][2], const pg8::Unit& u, int wr, int wc, int fr, int fq) const {
        const int row0 = u.pm * 256 + wr * 64 + fr, tq = u.pn - COLS_A_PAD / 256;
#pragma unroll
        for (int ai = 0; ai < 2; ++ai)
#pragma unroll
            for (int m = 0; m < 4; ++m) { const int row = row0 + ai * 128 + m * 16;
                if (tq < 0) plain_store(acc, ai, m, PA + (size_t)row * COLS_A_PAD + u.pn * 256 + wc * 32 + 8 * fq);
                else if (tq >= 16) plain_store(acc, ai, m, PB + (size_t)row * COLS_B + tq * 256 + wc * 32 + 8 * fq);
                else { const int pos = row & 4095; bf16_t* o = PB + (size_t)row * COLS_B + tq * 256 + wc * 64 + 8 * fq;
                    rope_store(acc, ai, m, axc + pos * 32 + 8 * fq, axs + pos * 32 + 8 * fq, row < TL, tq < 8 ? 0.18033688011112042f : 1.0f, o, o + 32); } }
    }
};
struct EpiInOdd {
    static constexpr bool PERM = true, AFTER_DRAIN = false, I8 = (INO_I8 != 0);
    bf16_t* P1; const float* axc; const float* axs; const float* rtc; const float* rts; const float* SA; const float* CS;
    DI void prescale(f32x4 (&acc)[2][2][4][2], const pg8::Unit& u, int wr, int wc, int fr, int fq) const { i8_prescale(acc, SA, CS, u, wr, wc, fr, fq); }
    DI void operator()(const f32x4 (&acc)[2][2][4][2], const pg8::Unit& u, int wr, int wc, int fr, int fq) const {
        const int row0 = u.pm * 256 + wr * 64 + fr, pn = u.pn;
#pragma unroll
        for (int ai = 0; ai < 2; ++ai)
#pragma unroll
            for (int m = 0; m < 4; ++m) { const int row = row0 + ai * 128 + m * 16; const bool lat = row < TL; const int pos = lat ? (row & 4095) : ((row - TL) & 255);
                if (pn < 9) { bf16_t* o = P1 + (size_t)row * NO + pn * 256 + wc * 64 + 8 * fq;
                    rope_store(acc, ai, m, axc + pos * 32 + 8 * fq, axs + pos * 32 + 8 * fq, lat, pn < 8 ? 0.18033688011112042f : 1.0f, o, o + 32); }
                else if (pn >= 10 && pn < 18) { const int rp = lat ? CTXL + pos : pos, i0 = 32 * (wc & 1) + 8 * fq; bf16_t* o = P1 + (size_t)row * NO + pn * 256 + (wc >> 1) * 128 + i0;
                    rope_store(acc, ai, m, rtc + rp * 64 + i0, rts + rp * 64 + i0, true, pn < 14 ? 0.08838834764831845f : 1.0f, o, o + 64); }
                else plain_store(acc, ai, m, P1 + (size_t)row * NO + pn * 256 + wc * 32 + 8 * fq); }
    }
};
struct CtxSplitOrder {
    int G, c, nNn, ntk;
    __device__ void init(int N, int G_, int c_, int K_) { G = G_; c = c_; nNn = N / 256; ntk = K_ / 64; }
    __device__ bool next(int i, pg8::Unit& u) const {
        const long L = (long)i * G + c; if (L >= 4 * nNn * 4) return false;
        const int j = (int)L, part = j & 3, tile = j >> 2; u.pm = 64 + (tile & 3); u.pn = tile >> 2; u.part = part;
        const int s0 = 2 * ((part * ntk) / 8), s1 = 2 * (((part + 1) * ntk) / 8); u.koff = s0 * 128; u.nt = s1 - s0; return true; }
    __device__ __forceinline__ void a_ready(const pg8::Unit&) const {}
    __device__ __forceinline__ void done(const pg8::Unit&) const {}
};
template <bool Q8>
struct EpiSlabT {
    static constexpr bool PERM = false, AFTER_DRAIN = false, I8 = Q8;
    float* slab; const float* SA; const float* CS;
    DI void prescale(f32x4 (&acc)[2][2][4][2], const pg8::Unit& u, int wr, int wc, int fr, int fq) const { i8_prescale_np(acc, SA, CS, u, wr, wc, fr, fq); }
    DI void operator()(const f32x4 (&acc)[2][2][4][2], const pg8::Unit& u, int wr, int wc, int fr, int fq) const {
        const int row0 = u.pm * 256 + wr * 64 + fr, col0 = u.pn * 256 + wc * 32 + 4 * fq;
        float* sb = slab + ((size_t)u.part * TC + (row0 - TL)) * D + col0;
#pragma unroll
        for (int ai = 0; ai < 2; ++ai)
#pragma unroll
            for (int m = 0; m < 4; ++m)
#pragma unroll
                for (int bj = 0; bj < 2; ++bj)
#pragma unroll
                    for (int n = 0; n < 2; ++n) *(f32x4*)(sb + (size_t)(ai * 128 + m * 16) * D + bj * 128 + n * 16) = acc[ai][bj][m][n];
    }
};
struct LatThenCtxOrder : pg8::StaticOrder {
    int nNn;
    __device__ void init2(int N, int G_, int c_, int K_) { init(TL, N, G_, c_, K_); nNn = N / 256; }
    __device__ bool next(int i, pg8::Unit& u) const {
        const long L = (long)i * G + c; if (L < nwg) return pg8::StaticOrder::next(i, u);
        const int j = (int)(L - nwg); if (j >= 4 * nNn) return false;
        u.pm = 64 + (j & 3); u.pn = j >> 2; u.koff = 0; u.nt = ntk; u.part = -1; return true; }
};
struct LoraOrder : LatThenCtxOrder {
    __device__ bool next(int i, pg8::Unit& u) const { if (!LatThenCtxOrder::next(i, u)) return false; u.koff = (u.pn >> 3) * (LORA_KU * 2); u.nt = LORA_KU / 64; return true; }
};
struct OddInOrder : pg8::StaticOrder {
    __device__ void init2(int G_, int c_, int K_) { init(TL, NO, G_, c_, K_); }
    __device__ bool next(int i, pg8::Unit& u) const {
        const long L = (long)i * G + c; if (L < nwg) return pg8::StaticOrder::next(i, u);
        const int j = (int)(L - nwg); if (j >= 4 * 14) return false;
        const int idx = j >> 2; u.pm = 64 + (j & 3); u.pn = idx < 2 ? 8 + idx : 12 + idx; u.koff = 0; u.nt = ntk; u.part = -1; return true; }
};
template <bool Q8, class TS = res_t>
struct EpiResModT {
    static constexpr bool PERM = false, AFTER_DRAIN = false, I8 = Q8;
    const TS* Rlat; const TS* Rctx; res_t* Hout; const float* mod;
    const float* SA; const float* CS;
    DI void prescale(f32x4 (&acc)[2][2][4][2], const pg8::Unit& u, int wr, int wc, int fr, int fq) const { i8_prescale_np(acc, SA, CS, u, wr, wc, fr, fq); }
    DI void operator()(const f32x4 (&acc)[2][2][4][2], const pg8::Unit& u, int wr, int wc, int fr, int fq) const {
        const int row0 = u.pm * 256 + wr * 64 + fr, col0 = u.pn * 256 + wc * 32 + 4 * fq;
        const float* mp = mod + (size_t)(u.pm < 64 ? (u.pm >> 4) : 4) * 24576 + col0;
        f32x4 mv[2][2];
#pragma unroll
        for (int bj = 0; bj < 2; ++bj)
#pragma unroll
            for (int n = 0; n < 2; ++n) mv[bj][n] = *(const f32x4*)(mp + bj * 128 + n * 16);
        const TS* sbase = (u.pm < 64) ? Rlat + (size_t)row0 * D : Rctx + (size_t)(row0 - TL) * D;
        res_t* dbase = Hout + (size_t)row0 * D;
#pragma unroll
        for (int ai = 0; ai < 2; ++ai)
#pragma unroll
            for (int m = 0; m < 4; ++m) { const size_t ro = (size_t)(ai * 128 + m * 16) * D + col0;
#pragma unroll
                for (int bj = 0; bj < 2; ++bj)
#pragma unroll
                    for (int n = 0; n < 2; ++n) { const f32x4 r = ld4(sbase + ro + bj * 128 + n * 16);
                        st4(dbase + ro + bj * 128 + n * 16, r + mv[bj][n] * acc[ai][bj][m][n]); } }
    }
};

typedef EpiResModT<false, res_t> EpiResMod;
typedef EpiSlabT<false> EpiSlab;
struct EpiConvGlu {
    static constexpr bool PERM = true, AFTER_DRAIN = false, I8 = (FFN_I8 != 0);
    bf16_t* HID; bf16_t* SG; bf16_t* SU; const float* cw; const float* cb; const float* SA; const float* CS;
    DI void prescale(f32x4 (&acc)[2][2][4][2], const pg8::Unit& u, int wr, int wc, int fr, int fq) const { i8_prescale(acc, SA, CS, u, wr, wc, fr, fq); }
    DI void operator()(const f32x4 (&acc)[2][2][4][2], const pg8::Unit& u, int wr, int wc, int fr, int fq) const {
        const int col = u.pn * 128 + wc * 32 + 8 * fq;
#pragma unroll
        for (int ai = 0; ai < 2; ++ai) {
            const int rowb = u.pm * 256 + ai * 128 + wr * 64;
#pragma unroll
            for (int n = 0; n < 2; ++n) {
                const f32x4 w0 = *(const f32x4*)(cw + col + 4 * n), w1 = *(const f32x4*)(cw + DFF + col + 4 * n), w2 = *(const f32x4*)(cw + 2 * DFF + col + 4 * n), bb = *(const f32x4*)(cb + col + 4 * n);
                unsigned outp[4][2];
#pragma unroll
                for (int ep = 0; ep < 2; ++ep) { float o[4][2];
#pragma unroll
                    for (int e2 = 0; e2 < 2; ++e2) { const int e = 2 * ep + e2; float P[4], N[4];
#pragma unroll
                        for (int m = 0; m < 4; ++m) { const int vi = __float_as_int(acc[ai][0][m][n][e]);
                            P[m] = __int_as_float(__builtin_amdgcn_update_dpp(0, vi, 0x121, 0xF, 0xF, false)); N[m] = __int_as_float(__builtin_amdgcn_update_dpp(0, vi, 0x12F, 0xF, 0xF, false)); }
#pragma unroll
                        for (int m = 0; m < 4; ++m) { const float prev = fr > 0 ? P[m] : (m > 0 ? P[m - 1] : 0.f), next = fr < 15 ? N[m] : (m < 3 ? N[m + 1] : 0.f);
                            const float x = w0[e] * prev + w1[e] * acc[ai][0][m][n][e] + w2[e] * next + bb[e];
                            o[m][e2] = silu_f(x) * acc[ai][1][m][n][e]; } }
#pragma unroll
                    for (int m = 0; m < 4; ++m) outp[m][ep] = pk_bf16(o[m][0], o[m][1]); }
#pragma unroll
                for (int m = 0; m < 4; ++m) { const int rho = 16 * m + fr, row = rowb + rho;
                    if (rho != 0 && rho != 63) { u32x2 w = {outp[m][0], outp[m][1]}; *(u32x2*)(HID + (size_t)row * DFF + col + 4 * n) = w; }
                    if (m == 0 || m == 3) { if (rho <= 1 || rho >= 62) { const int slot = rho <= 1 ? rho : rho - 60;
                            u32x2 g; g.x = pk_bf16(acc[ai][0][m][n][0], acc[ai][0][m][n][1]); g.y = pk_bf16(acc[ai][0][m][n][2], acc[ai][0][m][n][3]);
                            *(u32x2*)(SG + ((size_t)(row >> 6) * 4 + slot) * DFF + col + 4 * n) = g;
                            if (rho == 0 || rho == 63) { u32x2 q; q.x = pk_bf16(acc[ai][1][m][n][0], acc[ai][1][m][n][1]); q.y = pk_bf16(acc[ai][1][m][n][2], acc[ai][1][m][n][3]);
                                *(u32x2*)(SU + ((size_t)(row >> 6) * 2 + (rho == 63 ? 1 : 0)) * DFF + col + 4 * n) = q; } } }
                }
            }
        }
    }
};
__device__ __forceinline__ void p_conv_fix(const Ctx& c, int l, int nrows) {
    const bf16_t* SG = (const bf16_t*)(c.ar + AR_SG); const bf16_t* SU = (const bf16_t*)(c.ar + AR_SU); bf16_t* HID = (bf16_t*)(c.ar + AR_HID);
    const float* cw = c.in[I_CONVW] + (size_t)l * 3 * DFF; const float* cb = c.in[I_CONVB] + (size_t)l * DFF;
    const int nitems = (nrows / 64) * 2 * 22;
    const u32x4 z4 = {0u, 0u, 0u, 0u};
    for (int item = blockIdx.x * 8 + c.wave; item < nitems; item += gridDim.x * 8) {
        const int ch = item % 22, kw = item / 22, kb = kw >> 1, last = kw & 1, col = ch * 512 + c.lane * 8;
        if (col >= DFF) continue;
        const int row = kb * 64 + (last ? 63 : 0);
        int pos, len; if (row < TL) { pos = row & 4095; len = 4096; } else { pos = (row - TL) & 255; len = 256; }
        u32x4 gp, gc, gn;
        if (!last) { gp = pos > 0 ? *(const u32x4*)(SG + ((size_t)(kb - 1) * 4 + 3) * DFF + col) : z4; gc = *(const u32x4*)(SG + ((size_t)kb * 4 + 0) * DFF + col); gn = *(const u32x4*)(SG + ((size_t)kb * 4 + 1) * DFF + col); }
        else { gp = *(const u32x4*)(SG + ((size_t)kb * 4 + 2) * DFF + col); gc = *(const u32x4*)(SG + ((size_t)kb * 4 + 3) * DFF + col); gn = pos < len - 1 ? *(const u32x4*)(SG + ((size_t)(kb + 1) * 4 + 0) * DFF + col) : z4; }
        const u32x4 up = *(const u32x4*)(SU + ((size_t)kb * 2 + last) * DFF + col);
        float w0[8], w1[8], w2[8], bb[8]; load8f(cw + col, w0); load8f(cw + DFF + col, w1); load8f(cw + 2 * DFF + col, w2); load8f(cb + col, bb);
        float o[8];
#pragma unroll
        for (int j = 0; j < 4; ++j) {
            const float x0 = bflo(gp[j]) * w0[2 * j] + bflo(gc[j]) * w1[2 * j] + bflo(gn[j]) * w2[2 * j] + bb[2 * j];
            const float x1 = bfhi(gp[j]) * w0[2 * j + 1] + bfhi(gc[j]) * w1[2 * j + 1] + bfhi(gn[j]) * w2[2 * j + 1] + bb[2 * j + 1];
            o[2 * j] = silu_f(x0) * bflo(up[j]); o[2 * j + 1] = silu_f(x1) * bfhi(up[j]); }
        u32x4 w; w.x = pk_bf16(o[0], o[1]); w.y = pk_bf16(o[2], o[3]); w.z = pk_bf16(o[4], o[5]); w.w = pk_bf16(o[6], o[7]);
        *(u32x4*)(HID + (size_t)row * DFF + col) = w;
    }
}

DI void unpack8(const u32x4 w, float (&o)[8]) {
#pragma unroll
    for (int j = 0; j < 4; ++j) { o[2 * j] = bflo(w[j]); o[2 * j + 1] = bfhi(w[j]); }
}
DI u32x4 pack8_bf16(const float (&o)[8]) { u32x4 w; w.x = pk_bf16(o[0], o[1]); w.y = pk_bf16(o[2], o[3]); w.z = pk_bf16(o[4], o[5]); w.w = pk_bf16(o[6], o[7]); return w; }
DI u32x4 pack8_f16(const float (&o)[8]) { u32x4 w; w.x = pk_f16(o[0], o[1]); w.y = pk_f16(o[2], o[3]); w.z = pk_f16(o[4], o[5]); w.w = pk_f16(o[6], o[7]); return w; }
DI void unpack8_f16(const u32x4 w, float (&o)[8]) {
#pragma unroll
    for (int j = 0; j < 4; ++j) { o[2 * j] = h16lo(w[j]); o[2 * j + 1] = h16hi(w[j]); }
}
DI void row_pos(int row, int& pos, int& len) { if (row < TL) { pos = row & 4095; len = 4096; } else { pos = (row - TL) & 255; len = 256; } }

__device__ __forceinline__ void p_rwkv_prepA(const Ctx& c) {
    const bf16_t* PA = (const bf16_t*)(c.ar + AR_PA);
    h16* R16 = (h16*)(c.ar + AR_R); h16* KK16 = (h16*)(c.ar + AR_KK); h16* V16 = (h16*)(c.ar + AR_V); bf16_t* K16 = (bf16_t*)(c.ar + AR_K); bf16_t* LA = (bf16_t*)(c.ar + AR_LA);
    const float* mu = c.in[I_MU]; const float* k_k = c.in[I_KK];
    const int lane = c.lane;
    for (int row = blockIdx.x * 8 + c.wave; row < TT; row += gridDim.x * 8) {
        int pos, len; row_pos(row, pos, len);
        const bool hasp = pos > 0, hasn = pos < len - 1;
        const bf16_t* pc = PA + (size_t)row * COLS_A_PAD;
        for (int it = 0; it < 14; ++it) {
            const int col = it * 512 + lane * 8;
            if (col >= COLS_A) break;
            float cur[8], prv[8], nxt[8], m8[8], mx[8];
            unpack8(*(const u32x4*)(pc + col), cur);
            if (hasp) unpack8(*(const u32x4*)(pc - COLS_A_PAD + col), prv); else {
#pragma unroll
                for (int j = 0; j < 8; ++j) prv[j] = 0.f; }
            if (hasn) unpack8(*(const u32x4*)(pc + COLS_A_PAD + col), nxt); else {
#pragma unroll
                for (int j = 0; j < 8; ++j) nxt[j] = 0.f; }
            load8f(mu + col, m8);
#pragma unroll
            for (int j = 0; j < 8; ++j) mx[j] = cur[j] + m8[j] * (0.5f * (prv[j] + nxt[j]) - cur[j]);
            if (it < 4) {
                *(u32x4*)(R16 + (size_t)row * 2048 + col) = pack8_f16(mx);
            } else if (it < 8) {
                const int j0 = col - 2048;
                *(u32x4*)(K16 + (size_t)row * 2048 + j0) = pack8_bf16(mx);
                float kk8[8], x[8]; load8f(k_k + j0, kk8); float ss = 0.f;
#pragma unroll
                for (int j = 0; j < 8; ++j) { x[j] = mx[j] * kk8[j]; ss += x[j] * x[j]; }
                ss += __shfl_xor(ss, 1); ss += __shfl_xor(ss, 2); ss += __shfl_xor(ss, 4);
                const float rn = rsqrtf(ss + 1e-12f);
#pragma unroll
                for (int j = 0; j < 8; ++j) x[j] *= rn;
                *(u32x4*)(KK16 + (size_t)row * 2048 + j0) = pack8_f16(x);
            } else if (it < 12) {
                *(u32x4*)(V16 + (size_t)row * 2048 + (col - 4096)) = pack8_f16(mx);
            } else {
                const int q0 = col - 6144; float o[8];
#pragma unroll
                for (int j = 0; j < 8; ++j) o[j] = q0 < 192 ? (1.0f - 2.0f * __builtin_amdgcn_rcpf(1.0f + __expf(2.0f * mx[j]))) : (q0 < 384 ? mx[j] : sigmoid_f(mx[j]));
                const int seg = q0 < 384 ? q0 / 96 : 4, off = q0 - (seg < 4 ? seg * 96 : 384);
                *(u32x4*)(LA + (size_t)row * LORA_K + seg * LORA_KU + off) = pack8_bf16(o);
            }
        }
        {
            const u32x4 z4 = {0u, 0u, 0u, 0u};
            for (int z = lane; z < 80; z += 64) *(u32x4*)(LA + (size_t)row * LORA_K + (z / 20) * LORA_KU + 96 + (z % 20) * 8) = z4; }
    }
}

DI int kperm16(int o) { return (o & ~12) | ((o >> 1) & 4) | ((o << 1) & 8); }
template <int DVW  , int NHEAD>
__device__ __forceinline__ void p_build_vt(const Ctx& c, const bf16_t* P, int ldp, int vcol0, bf16_t* VT) {
    constexpr int NSLAB = (DVW * NHEAD) / 512 > 0 ? (DVW * NHEAD) / 512 : 1;
    constexpr int SLABW = (DVW * NHEAD) < 512 ? (DVW * NHEAD) : 512;
    LAS unsigned short* T = (LAS unsigned short*)c.lds;
    const int tid = c.tid;
    for (int item = blockIdx.x; item < (TT / 64) * NSLAB; item += gridDim.x) {
        const int kg = item / NSLAB, slab = item % NSLAB;
        const int row0 = kg * 64;
        int b, key0; if (row0 < TL) { b = row0 >> 12; key0 = row0 & 4095; } else { b = (row0 - TL) >> 8; key0 = 4096 + ((row0 - TL) & 255); }
        { const int key = tid >> 3, part = tid & 7; const int kp = (key & ~15) | kperm16(key & 15);
          constexpr int CPT = SLABW / 8;
          const bf16_t* src = P + (size_t)(row0 + key) * ldp + vcol0 + slab * SLABW + part * CPT;
#pragma unroll
          for (int e = 0; e < CPT / 8; ++e) { const u32x4 w = *(const u32x4*)(src + e * 8);
#pragma unroll
              for (int j = 0; j < 4; ++j) { T[(part * CPT + e * 8 + 2 * j) * 72 + kp] = (unsigned short)(w[j] & 0xffffu); T[(part * CPT + e * 8 + 2 * j + 1) * 72 + kp] = (unsigned short)(w[j] >> 16); } }
        }
        __syncthreads();
        for (int q = tid; q < SLABW * 8; q += NTHREADS) { const int col = q >> 3, ch = q & 7;
            const u32x4 w = *(const LAS u32x4*)(T + col * 72 + ch * 8);
            const int gc = slab * SLABW + col, head = gc / DVW, dv = gc % DVW;
            *(u32x4*)(VT + (((size_t)b * NHEAD + head) * DVW + dv) * NKEY + key0 + ch * 8) = w; }
        __syncthreads();
    }
}

struct EpiLora {
    static constexpr bool PERM = true, AFTER_DRAIN = false, I8 = false;
    const float* w0; const float* a0; const float* k_a; const bf16_t* K16; const h16* KK16; h16* OMW; h16* BB; h16* KD; bf16_t* G;
    DI void operator()(const f32x4 (&acc)[2][2][4][2], const pg8::Unit& u, int wr, int wc, int fr, int fq) const {
        const int type = u.pn >> 3, row0 = u.pm * 256 + wr * 64 + fr;
#pragma unroll
        for (int bj = 0; bj < 2; ++bj) {
            const int jc = (u.pn & 7) * 256 + bj * 128 + wc * 32 + 8 * fq;
            if (type < 2) {
                float w8[8]; load8f(w0 + type * 2048 + jc, w8);
#pragma unroll
                for (int ai = 0; ai < 2; ++ai)
#pragma unroll
                    for (int m = 0; m < 4; ++m) { const int row = row0 + ai * 128 + m * 16; float o[8];
#pragma unroll
                        for (int i = 0; i < 8; ++i) { const float w = w8[i] + (i < 4 ? acc[ai][bj][m][0][i & 3] : acc[ai][bj][m][1][i & 3]);
                            o[i] = 1.0f - __expf(-0.60653066f * sigmoid_f(w)); }
                        *(u32x4*)(OMW + ((size_t)type * TT + row) * 2048 + jc) = pack8_f16(o); }
            } else if (type < 4) {
                const int d = type - 2; float a8[8], ka8[8]; load8f(a0 + d * 2048 + jc, a8); load8f(k_a + jc, ka8);
#pragma unroll
                for (int ai = 0; ai < 2; ++ai)
#pragma unroll
                    for (int m = 0; m < 4; ++m) { const int row = row0 + ai * 128 + m * 16; float kd[8], bb[8], k8[8], kk8[8];
                        unpack8(*(const u32x4*)(K16 + (size_t)row * 2048 + jc), k8); unpack8_f16(*(const u32x4*)(KK16 + (size_t)row * 2048 + jc), kk8);
#pragma unroll
                        for (int i = 0; i < 8; ++i) { const float a = sigmoid_f(a8[i] + (i < 4 ? acc[ai][bj][m][0][i & 3] : acc[ai][bj][m][1][i & 3]));
                            kd[i] = k8[i] * (1.0f + (a - 1.0f) * ka8[i]); bb[i] = kk8[i] * a; }
                        *(u32x4*)(KD + ((size_t)d * TT + row) * 2048 + jc) = pack8_f16(kd);
                        *(u32x4*)(BB + ((size_t)d * TT + row) * 2048 + jc) = pack8_f16(bb); }
            } else {
#pragma unroll
                for (int ai = 0; ai < 2; ++ai)
#pragma unroll
                    for (int m = 0; m < 4; ++m) { const int row = row0 + ai * 128 + m * 16; float o[8];
#pragma unroll
                        for (int i = 0; i < 8; ++i) o[i] = (i < 4 ? acc[ai][bj][m][0][i & 3] : acc[ai][bj][m][1][i & 3]);
                        *(u32x4*)(G + (size_t)row * 2048 + jc) = pack8_bf16(o); }
            }
        }
    }
};

#define MFMA32(a, b, cacc) __builtin_amdgcn_mfma_f32_32x32x16_bf16((a), (b), (cacc), 0, 0, 0)
DI bf16x8 ld_frag(const bf16_t* p) { return __builtin_bit_cast(bf16x8, *(const u32x4*)p); }
DI bf16x8 pack_p(const f32x16& x, int s) { u32x4 w; w.x = pk_bf16(x[8 * s], x[8 * s + 1]); w.y = pk_bf16(x[8 * s + 2], x[8 * s + 3]); w.z = pk_bf16(x[8 * s + 4], x[8 * s + 5]); w.w = pk_bf16(x[8 * s + 6], x[8 * s + 7]); return __builtin_bit_cast(bf16x8, w); }
constexpr float LOG2E = 1.44269504088896f;

DI void fwht8x4(float (&x)[8], int lane) {
#pragma unroll
    for (int h = 1; h < 8; h <<= 1)
#pragma unroll
        for (int i = 0; i < 8; i += 2 * h)
#pragma unroll
            for (int j = i; j < i + h; ++j) { const float a = x[j], b = x[j + h]; x[j] = a + b; x[j + h] = a - b; }
#pragma unroll
    for (int j = 0; j < 8; ++j) { float v = x[j];
        { const float t = __int_as_float(__builtin_amdgcn_update_dpp(0, __float_as_int(v), 0xB1, 0xF, 0xF, false)); v = (lane & 1) ? t - v : v + t; }
        { const float t = __int_as_float(__builtin_amdgcn_update_dpp(0, __float_as_int(v), 0x4E, 0xF, 0xF, false)); v = (lane & 2) ? t - v : v + t; }
        x[j] = v; }
}
DI float wave_max(float v) {
#pragma unroll
    for (int o = 32; o >= 1; o >>= 1) v = fmaxf(v, __shfl_xor(v, o));
    return v;
}
__device__ __forceinline__ void p_rwkv_out(const Ctx& c, int nrows) {
    const bf16_t* Yf = (const bf16_t*)(c.ar + AR_Y); const bf16_t* Yb = Yf + (size_t)TT * 2048;
    const h16* R16 = (const h16*)(c.ar + AR_R); const h16* V16 = (const h16*)(c.ar + AR_V);
    const h16* KDf = (const h16*)(c.ar + AR_KD); const h16* KDb = KDf + (size_t)TT * 2048;
    const bf16_t* G = (const bf16_t*)(c.ar + AR_G); bf16_t* MIX = (bf16_t*)(c.ws + WS_XN);
    const float* r_k = c.in[I_RK]; const float* ln_w = c.in[I_LNW]; const float* ln_b = c.in[I_LNB];
    const int lane = c.lane;
    for (int row = blockIdx.x * 8 + c.wave; row < nrows; row += gridDim.x * 8) {
        float ov[4][8];
#pragma unroll
        for (int it = 0; it < 4; ++it) {
            const int col = it * 512 + lane * 8; const size_t o = (size_t)row * 2048 + col;
            float yf[8], yb[8], y[8], r8[8], v8[8], kf[8], kb[8], g8[8], rk8[8], lw[8], lb[8];
            unpack8(*(const u32x4*)(Yf + o), yf); unpack8(*(const u32x4*)(Yb + o), yb);
            unpack8_f16(*(const u32x4*)(R16 + o), r8); unpack8_f16(*(const u32x4*)(V16 + o), v8);
            unpack8_f16(*(const u32x4*)(KDf + o), kf); unpack8_f16(*(const u32x4*)(KDb + o), kb);
            unpack8(*(const u32x4*)(G + o), g8);
            load8f(r_k + col, rk8); load8f(ln_w + col, lw); load8f(ln_b + col, lb);
            float sm = 0.f, bn = 0.f;
#pragma unroll
            for (int j = 0; j < 8; ++j) { y[j] = yf[j] + yb[j]; sm += y[j]; bn += r8[j] * (kf[j] + kb[j]) * rk8[j]; }
            sm += __shfl_xor(sm, 1); sm += __shfl_xor(sm, 2); sm += __shfl_xor(sm, 4);
            bn += __shfl_xor(bn, 1); bn += __shfl_xor(bn, 2); bn += __shfl_xor(bn, 4);
            const float mean = sm * (1.0f / 64.0f); float vs = 0.f;
#pragma unroll
            for (int j = 0; j < 8; ++j) { const float dlt = y[j] - mean; vs += dlt * dlt; }
            vs += __shfl_xor(vs, 1); vs += __shfl_xor(vs, 2); vs += __shfl_xor(vs, 4);
            const float rs = rsqrtf(vs * (1.0f / 64.0f) + 64e-5f);
            float o8[8];
#pragma unroll
            for (int j = 0; j < 8; ++j) o8[j] = ((y[j] - mean) * rs * lw[j] + lb[j] + bn * v8[j]) * g8[j];
            if (MIX_I8) {
#pragma unroll
                for (int j = 0; j < 8; ++j) ov[it][j] = o8[j]; }
            else *(u32x4*)(MIX + (size_t)row * D + col) = pack8_bf16(o8);
        }
        if (MIX_I8) {
            float av[4][8]; float mx = 0.f;
#pragma unroll
            for (int it = 0; it < 4; ++it) { unpack8(*(const u32x4*)(MIX + (size_t)row * D + 2048 + it * 512 + lane * 8), av[it]);
                fwht8x4(ov[it], lane); fwht8x4(av[it], lane);
#pragma unroll
                for (int j = 0; j < 8; ++j) mx = fmaxf(mx, fmaxf(fabsf(ov[it][j]), fabsf(av[it][j]))); }
            mx = wave_max(mx);
            const float qs = mx > 0.f ? 127.0f / mx : 0.f;
            unsigned char* xq = c.ar + AR_XQ + (size_t)row * D;
#pragma unroll
            for (int it = 0; it < 4; ++it) {
                u32x2 w0 = {pk_i8x4(ov[it][0] * qs, ov[it][1] * qs, ov[it][2] * qs, ov[it][3] * qs), pk_i8x4(ov[it][4] * qs, ov[it][5] * qs, ov[it][6] * qs, ov[it][7] * qs)};
                u32x2 w1 = {pk_i8x4(av[it][0] * qs, av[it][1] * qs, av[it][2] * qs, av[it][3] * qs), pk_i8x4(av[it][4] * qs, av[it][5] * qs, av[it][6] * qs, av[it][7] * qs)};
                *(u32x2*)(xq + it * 512 + lane * 8) = w0; *(u32x2*)(xq + 2048 + it * 512 + lane * 8) = w1; }
            if (lane == 0) ((float*)(c.ar + AR_XQS))[row] = mx * (1.0f / 127.0f);
        }
    }
}
__device__ __forceinline__ void p_quant_hid(const Ctx& c, int nrows) {
    const bf16_t* HID = (const bf16_t*)(c.ar + AR_HID); const int lane = c.lane;
    for (int row = blockIdx.x * 8 + c.wave; row < nrows; row += gridDim.x * 8) {
        u32x4 pk[22]; float mx = 0.f;
#pragma unroll
        for (int it = 0; it < 22; ++it) { const int col = it * 512 + lane * 8; pk[it] = col < DFF ? *(const u32x4*)(HID + (size_t)row * DFF + col) : (u32x4){0u, 0u, 0u, 0u}; }
#pragma unroll
        for (int it = 0; it < 22; ++it) { float x[8]; unpack8(pk[it], x); fwht8x4(x, lane);
#pragma unroll
            for (int j = 0; j < 8; ++j) mx = fmaxf(mx, fabsf(x[j])); }
        mx = wave_max(mx);
        const float qs = mx > 0.f ? 127.0f / mx : 0.f;
        unsigned char* hq = c.ar + AR_HQ + (size_t)row * DFF;
#pragma unroll
        for (int it = 0; it < 22; ++it) { float x[8]; unpack8(pk[it], x); fwht8x4(x, lane); const int col = it * 512 + lane * 8;
            u32x2 w = {pk_i8x4(x[0] * qs, x[1] * qs, x[2] * qs, x[3] * qs), pk_i8x4(x[4] * qs, x[5] * qs, x[6] * qs, x[7] * qs)};
            if (col < DFF) *(u32x2*)(hq + col) = w; }
        if (lane == 0) ((float*)(c.ar + AR_HQS))[row] = mx * (1.0f / 127.0f);
    }
}
__device__ __forceinline__ void p_quant_mix(const Ctx& c, int nrows) {
    const bf16_t* MIX = (const bf16_t*)(c.ws + WS_XN); const int lane = c.lane;
    for (int row = blockIdx.x * 8 + c.wave; row < nrows; row += gridDim.x * 8) {
        float x[8][8]; float mx = 0.f;
#pragma unroll
        for (int it = 0; it < 8; ++it) { unpack8(*(const u32x4*)(MIX + (size_t)row * D + it * 512 + lane * 8), x[it]); fwht8x4(x[it], lane);
#pragma unroll
            for (int j = 0; j < 8; ++j) mx = fmaxf(mx, fabsf(x[it][j])); }
        mx = wave_max(mx);
        const float qs = mx > 0.f ? 127.0f / mx : 0.f;
        unsigned char* xq = c.ar + AR_XQ + (size_t)row * D;
#pragma unroll
        for (int it = 0; it < 8; ++it) { u32x2 w = {pk_i8x4(x[it][0] * qs, x[it][1] * qs, x[it][2] * qs, x[it][3] * qs), pk_i8x4(x[it][4] * qs, x[it][5] * qs, x[it][6] * qs, x[it][7] * qs)};
            *(u32x2*)(xq + it * 512 + lane * 8) = w; }
        if (lane == 0) ((float*)(c.ar + AR_XQS))[row] = mx * (1.0f / 127.0f);
    }
}

constexpr int K1_WAVE_LDS = 35328;
constexpr size_t TT_ROWS2048 = (size_t)TT * 2048;
#define WAVE_SYNC() do { asm volatile("s_waitcnt lgkmcnt(0)" ::: "memory"); __builtin_amdgcn_wave_barrier(); } while (0)
DI int rw_row(int b, int dir, int t) { return t < CTXL ? TL + b * CTXL + (dir ? (CTXL - 1 - t) : t) : b * SEQ + (dir ? (SEQ - 1 - (t - CTXL)) : (t - CTXL)); }
DI float bfu(unsigned short x) { return __uint_as_float((unsigned)x << 16); }
DI bf16x8 colfrag_nat(const LAS unsigned short* T, int col, int t0) { u32x4 w;
#pragma unroll
    for (int j = 0; j < 4; ++j) w[j] = (unsigned)T[(t0 + 2 * j) * 64 + col] | ((unsigned)T[(t0 + 2 * j + 1) * 64 + col] << 16);
    return __builtin_bit_cast(bf16x8, w); }
DI bf16x8 colfrag_nat_scaled(const LAS unsigned short* T, int col, int t0, float sc) { u32x4 w;
#pragma unroll
    for (int j = 0; j < 4; ++j) w[j] = pk_bf16(bfu(T[(t0 + 2 * j) * 64 + col]) * sc, bfu(T[(t0 + 2 * j + 1) * 64 + col]) * sc);
    return __builtin_bit_cast(bf16x8, w); }
DI bf16x8 colfrag_pk_scaled(const LAS unsigned short* T, int col, int s, int hh, float sc) { u32x4 w;
#pragma unroll
    for (int j2 = 0; j2 < 4; ++j2) { const int j = 2 * j2, t = 16 * s + 8 * (j >> 2) + 4 * hh + (j & 3);
        w[j2] = pk_bf16(bfu(T[t * 64 + col]) * sc, bfu(T[(t + 1) * 64 + col]) * sc); }
    return __builtin_bit_cast(bf16x8, w); }
DI bf16x8 rowfrag_nat(const LAS unsigned short* A, int row, int s, int hh) { const LAS u32x2* p = (const LAS u32x2*)(A + row * 40 + 16 * s + 8 * hh); const u32x2 a = p[0], b = p[1];
    u32x4 w = {a.x, a.y, b.x, b.y}; return __builtin_bit_cast(bf16x8, w); }
DI bf16x8 rowfrag_pk(const LAS unsigned short* A, int row, int s, int hh) { const u32x2 a = *(const LAS u32x2*)(A + row * 40 + 16 * s + 4 * hh), b = *(const LAS u32x2*)(A + row * 40 + 16 * s + 8 + 4 * hh);
    u32x4 w = {a.x, a.y, b.x, b.y}; return __builtin_bit_cast(bf16x8, w); }
DI u32x4 pack_pu(const f32x16& x, int s) { u32x4 w; w.x = pk_bf16(x[8 * s], x[8 * s + 1]); w.y = pk_bf16(x[8 * s + 2], x[8 * s + 3]); w.z = pk_bf16(x[8 * s + 4], x[8 * s + 5]); w.w = pk_bf16(x[8 * s + 6], x[8 * s + 7]); return w; }

__device__ __forceinline__ void rwkv_k1_chunk(const Ctx& c, LAS unsigned char* wl, int seq, int ch) {
    const int dir = seq & 1, h = (seq >> 1) & 31, b = seq >> 6;
    const int lane = c.lane, r = lane & 31, hh = lane >> 5;
    LAS unsigned short* TA = (LAS unsigned short*)wl; LAS unsigned short* TB = TA + 2048; LAS unsigned short* TK = TB + 2048; LAS unsigned short* TR = TK + 2048; LAS unsigned short* TVv = TR + 2048;
    LAS float* GC = (LAS float*)(wl + 20480); LAS float* LAB = (LAS float*)(wl + 20736);
    LAS unsigned short* TTi = (LAS unsigned short*)(wl + 24832); LAS unsigned short* TAK = TTi + 1280; LAS unsigned short* TRB = TAK + 1280; LAS unsigned short* TRK = TRB + 1280;
    const h16* KK = (const h16*)(c.ar + AR_KK); const h16* RR = (const h16*)(c.ar + AR_R); const h16* VV = (const h16*)(c.ar + AR_V);
    const h16* OM = (const h16*)(c.ar + AR_OMW) + (size_t)dir * TT_ROWS2048; const h16* BBp = (const h16*)(c.ar + AR_BB) + (size_t)dir * TT_ROWS2048; const h16* KDp = (const h16*)(c.ar + AR_KD) + (size_t)dir * TT_ROWS2048;
    {   LAS unsigned short* TO = (LAS unsigned short*)LAB;
        u32x4 ld[6][4];
#pragma unroll
        for (int i = 0; i < 4; ++i) { const int tau = (lane >> 3) + 8 * i; const size_t off = (size_t)rw_row(b, dir, ch * 32 + tau) * 2048 + h * 64 + (lane & 7) * 8;
            ld[0][i] = *(const u32x4*)(KK + off); ld[1][i] = *(const u32x4*)(BBp + off); ld[2][i] = *(const u32x4*)(KDp + off);
            ld[3][i] = *(const u32x4*)(RR + off); ld[4][i] = *(const u32x4*)(VV + off); ld[5][i] = *(const u32x4*)(OM + off); }
#pragma unroll
        for (int i = 0; i < 4; ++i) { const int o = ((lane >> 3) + 8 * i) * 64 + (lane & 7) * 8;
            *(LAS u32x4*)(TA + o) = ld[0][i]; *(LAS u32x4*)(TB + o) = ld[1][i]; *(LAS u32x4*)(TK + o) = ld[2][i];
            *(LAS u32x4*)(TR + o) = ld[3][i]; *(LAS u32x4*)(TVv + o) = ld[4][i]; *(LAS u32x4*)(TO + o) = ld[5][i]; }
    }
    WAVE_SYNC();
    {   const LAS h16* TO = (const LAS h16*)LAB;
        float g = 1.f;
#pragma unroll 8
        for (int tau = 0; tau < 32; ++tau) { const int o = tau * 64 + lane;
            const float omw = (float)TO[o], bb = (float)((const LAS h16*)TB)[o], kd = (float)((const LAS h16*)TK)[o], kk = (float)((const LAS h16*)TA)[o], rr = (float)((const LAS h16*)TR)[o], vv = (float)((const LAS h16*)TVv)[o];
            const float gp = g; g *= (1.0f - omw); const float ig = __builtin_amdgcn_rcpf(g);
            TA[o] = f2bf(kk * gp); TB[o] = f2bf(-bb * ig); TK[o] = f2bf(kd * ig); TR[o] = f2bf(rr * g); TVv[o] = f2bf(vv);
        }
        GC[lane] = g;
    }
    WAVE_SYNC();
    {   f32x16 ab, ak, rb, rk;
#pragma unroll
        for (int i = 0; i < 16; ++i) { ab[i] = 0.f; ak[i] = 0.f; rb[i] = 0.f; rk[i] = 0.f; }
#pragma unroll
        for (int ks = 0; ks < 4; ++ks) { const int o = r * 64 + 16 * ks + 8 * hh;
            const bf16x8 fa = *(const LAS bf16x8*)(TA + o), fb = *(const LAS bf16x8*)(TB + o), fk = *(const LAS bf16x8*)(TK + o), fr = *(const LAS bf16x8*)(TR + o);
            ab = MFMA32(fa, fb, ab); ak = MFMA32(fa, fk, ak); rb = MFMA32(fr, fb, rb); rk = MFMA32(fr, fk, rk); }
#pragma unroll
        for (int i = 0; i < 16; ++i) { const int tau = (i & 3) + 8 * (i >> 2) + 4 * hh;
            LAB[tau * 32 + r] = (r < tau) ? ab[i] : 0.f;
            TAK[tau * 40 + r] = f2bf((r < tau) ? ak[i] : 0.f); TRB[tau * 40 + r] = f2bf((r <= tau) ? rb[i] : 0.f); TRK[tau * 40 + r] = f2bf((r <= tau) ? rk[i] : 0.f); }
    }
    WAVE_SYNC();
    {   float Tc[32];
#pragma unroll
        for (int tau = 0; tau < 32; ++tau) { float acc = (r == tau) ? 1.f : 0.f;
#pragma unroll
            for (int q = 0; q < (tau + 3) / 4; ++q) { const f32x4 a4 = *(const LAS f32x4*)(LAB + tau * 32 + 4 * q);
#pragma unroll
                for (int e = 0; e < 4; ++e) if (4 * q + e < tau) acc = fmaf(a4[e], Tc[4 * q + e], acc); }
            Tc[tau] = acc; }
        if (hh == 0) {
#pragma unroll
            for (int tau = 0; tau < 32; ++tau) TTi[tau * 40 + r] = f2bf(Tc[tau]); }
    }
    WAVE_SYNC();
    f32x16 W1[2], Z[2]; bf16x8 Vn[2][2];
    {   bf16x8 tn[2], tp[2], akn[2];
#pragma unroll
        for (int s = 0; s < 2; ++s) { tn[s] = rowfrag_nat(TTi, r, s, hh); tp[s] = rowfrag_pk(TTi, r, s, hh); akn[s] = rowfrag_nat(TAK, r, s, hh); }
#pragma unroll
        for (int t2 = 0; t2 < 2; ++t2) {
#pragma unroll
            for (int i = 0; i < 16; ++i) W1[t2][i] = 0.f;
            f32x16 X;
#pragma unroll
            for (int i = 0; i < 16; ++i) X[i] = 0.f;
#pragma unroll
            for (int s = 0; s < 2; ++s) { Vn[t2][s] = colfrag_nat(TVv, 32 * t2 + r, 16 * s + 8 * hh);
                W1[t2] = MFMA32(tn[s], colfrag_nat(TA, 32 * t2 + r, 16 * s + 8 * hh), W1[t2]);
                X = MFMA32(akn[s], Vn[t2][s], X); }
#pragma unroll
            for (int i = 0; i < 16; ++i) Z[t2][i] = 0.f;
#pragma unroll
            for (int s = 0; s < 2; ++s) Z[t2] = MFMA32(tp[s], pack_p(X, s), Z[t2]);
        }
    }
    u32x4* CHp = (u32x4*)(c.ar + AR_CH + ((size_t)seq * RW_NCH + ch) * CH_BYTES) + lane;
    {   bf16x8 rbp[2], rkn[2];
#pragma unroll
        for (int s = 0; s < 2; ++s) { rbp[s] = rowfrag_pk(TRB, r, s, hh); rkn[s] = rowfrag_nat(TRK, r, s, hh); }
#pragma unroll
        for (int kt = 0; kt < 2; ++kt) { f32x16 GT;
#pragma unroll
            for (int g4 = 0; g4 < 4; ++g4) { const u32x2 w = *(const LAS u32x2*)(TR + r * 64 + 32 * kt + 8 * g4 + 4 * hh);
                GT[4 * g4] = bflo(w.x); GT[4 * g4 + 1] = bfhi(w.x); GT[4 * g4 + 2] = bflo(w.y); GT[4 * g4 + 3] = bfhi(w.y); }
#pragma unroll
            for (int s = 0; s < 2; ++s) GT = MFMA32(pack_p(W1[kt], s), rbp[s], GT);
#pragma unroll
            for (int s = 0; s < 2; ++s) CHp[(0 + kt * 2 + s) * 64] = pack_pu(GT, s); }
#pragma unroll
        for (int vt = 0; vt < 2; ++vt) { f32x16 Y0;
#pragma unroll
            for (int i = 0; i < 16; ++i) Y0[i] = 0.f;
#pragma unroll
            for (int s = 0; s < 2; ++s) { Y0 = MFMA32(pack_p(Z[vt], s), rbp[s], Y0); Y0 = MFMA32(Vn[vt][s], rkn[s], Y0); }
#pragma unroll
            for (int s = 0; s < 2; ++s) CHp[(4 + vt * 2 + s) * 64] = pack_pu(Y0, s); }
    }
#pragma unroll
    for (int k2 = 0; k2 < 2; ++k2) {
        const float gc = GC[32 * k2 + r];
        bf16x8 bhp[2], khn[2];
#pragma unroll
        for (int s = 0; s < 2; ++s) { bhp[s] = colfrag_pk_scaled(TB, 32 * k2 + r, s, hh, gc); khn[s] = colfrag_nat_scaled(TK, 32 * k2 + r, 16 * s + 8 * hh, gc); }
#pragma unroll
        for (int kt = 0; kt < 2; ++kt) { f32x16 PT;
#pragma unroll
            for (int i = 0; i < 16; ++i) PT[i] = (kt == k2 && ((i & 3) + 8 * (i >> 2) + 4 * hh) == r) ? gc : 0.f;
#pragma unroll
            for (int s = 0; s < 2; ++s) PT = MFMA32(pack_p(W1[kt], s), bhp[s], PT);
#pragma unroll
            for (int s = 0; s < 2; ++s) CHp[(8 + k2 * 4 + kt * 2 + s) * 64] = pack_pu(PT, s); }
#pragma unroll
        for (int vt = 0; vt < 2; ++vt) { f32x16 PS;
#pragma unroll
            for (int i = 0; i < 16; ++i) PS[i] = 0.f;
#pragma unroll
            for (int s = 0; s < 2; ++s) { PS = MFMA32(bhp[s], pack_p(Z[vt], s), PS); PS = MFMA32(khn[s], Vn[vt][s], PS); }
#pragma unroll
            for (int s = 0; s < 2; ++s) CHp[(16 + k2 * 4 + vt * 2 + s) * 64] = pack_pu(PS, s); }
    }
    WAVE_SYNC();
}

DI void unpack_acc(const u32x4 lo, const u32x4 hi, f32x16& x) {
#pragma unroll
    for (int j = 0; j < 4; ++j) { x[2 * j] = bflo(lo[j]); x[2 * j + 1] = bfhi(lo[j]); x[8 + 2 * j] = bflo(hi[j]); x[8 + 2 * j + 1] = bfhi(hi[j]); }
}
__device__ __forceinline__ void rwkv_seq_wave(const Ctx& c, int seq, int vt) {
    const int dir = seq & 1, h = (seq >> 1) & 31, b = seq >> 6;
    const int lane = c.lane, r = lane & 31, hh = lane >> 5;
    bf16_t* Y = (bf16_t*)(c.ar + AR_Y) + (size_t)dir * TT_ROWS2048;
    f32x16 M[2];
#pragma unroll
    for (int kt = 0; kt < 2; ++kt)
#pragma unroll
        for (int i = 0; i < 16; ++i) M[kt][i] = 0.f;
    const u32x4* CH0 = (const u32x4*)(c.ar + AR_CH + (size_t)seq * RW_NCH * CH_BYTES) + lane;
    u32x4 gf[4], pf[8], y0[2], ps[4];
#define RW_LOAD(chp) do { _Pragma("unroll") for (int q = 0; q < 4; ++q) gf[q] = (chp)[q * 64]; _Pragma("unroll") for (int q = 0; q < 2; ++q) y0[q] = (chp)[(4 + vt * 2 + q) * 64]; \
        _Pragma("unroll") for (int q = 0; q < 8; ++q) pf[q] = (chp)[(8 + q) * 64]; _Pragma("unroll") for (int k2 = 0; k2 < 2; ++k2) _Pragma("unroll") for (int s = 0; s < 2; ++s) ps[k2 * 2 + s] = (chp)[(16 + k2 * 4 + vt * 2 + s) * 64]; } while (0)
    RW_LOAD(CH0);
    for (int ch = 0; ch < (int)RW_NCH; ++ch) {
        bf16x8 mp[4];
#pragma unroll
        for (int kt = 0; kt < 2; ++kt)
#pragma unroll
            for (int s = 0; s < 2; ++s) mp[kt * 2 + s] = pack_p(M[kt], s);
        f32x16 Yc, Mn[2];
        unpack_acc(y0[0], y0[1], Yc); unpack_acc(ps[0], ps[1], Mn[0]); unpack_acc(ps[2], ps[3], Mn[1]);
#pragma unroll
        for (int q = 0; q < 4; ++q) Yc = MFMA32(mp[q], __builtin_bit_cast(bf16x8, gf[q]), Yc);
#pragma unroll
        for (int k2 = 0; k2 < 2; ++k2)
#pragma unroll
            for (int q = 0; q < 4; ++q) Mn[k2] = MFMA32(__builtin_bit_cast(bf16x8, pf[k2 * 4 + q]), mp[q], Mn[k2]);
        if (ch + 1 < (int)RW_NCH) { const u32x4* nx = CH0 + (size_t)(ch + 1) * (CH_BYTES / 16); RW_LOAD(nx); }
        M[0] = Mn[0]; M[1] = Mn[1];
        {   bf16_t* yp = Y + (size_t)rw_row(b, dir, ch * 32 + r) * 2048 + h * 64 + 32 * vt + 4 * hh;
#pragma unroll
            for (int g = 0; g < 4; ++g) { u32x2 w2; w2.x = pk_bf16(Yc[4 * g], Yc[4 * g + 1]); w2.y = pk_bf16(Yc[4 * g + 2], Yc[4 * g + 3]); *(u32x2*)(yp + 8 * g) = w2; } }
    }
#undef RW_LOAD
}

__device__ __forceinline__ void p_rwkv_k1_and_conv(const Ctx& c) {
    if (c.wave < 4) { LAS unsigned char* wl = c.lds + c.wave * K1_WAVE_LDS; const int w = blockIdx.x * 4 + c.wave, nw = gridDim.x * 4;
        for (int task = w; task < 256 * (int)RW_NCH; task += nw) rwkv_k1_chunk(c, wl, task / (int)RW_NCH, task % (int)RW_NCH); }
    else p_convert_deferred(c, blockIdx.x * 4 + (c.wave - 4), gridDim.x * 4, 0, CONV_SPLIT);
}
__device__ __forceinline__ void p_rwkv_seq_and_conv(const Ctx& c) {
    constexpr int NTASK = 512;
    const int G = (int)gridDim.x, task = c.wave * G + (int)blockIdx.x;
    if (task < NTASK) { for (int t = task; t < NTASK; t += G * 8) rwkv_seq_wave(c, t & 255, t >> 8); return; }
    int widx = 0, nworkers = 0;
    for (int w = 0; w < 8; ++w) { const int nsc = NTASK - w * G; const int sb = nsc <= 0 ? 0 : (nsc > G ? G : nsc);
        if (w < c.wave) widx += G - sb; else if (w == c.wave) widx += (int)blockIdx.x - sb;
        nworkers += G - sb; }
    p_convert_deferred(c, widx, nworkers, CONV_SPLIT, 1 << 30);
}

constexpr int DA_KBYTES = 64 * 256, DA_VBYTES = 128 * 128, DA_BUF = DA_KBYTES + DA_VBYTES;
constexpr int DA_COMB = 2 * DA_BUF;
__device__ __forceinline__ void dattn_block_item(const Ctx& c, int item) {
    const bf16_t* PB = (const bf16_t*)(c.ar + AR_PB); const bf16_t* VT = (const bf16_t*)(c.ar + AR_VT); bf16_t* MIX = (bf16_t*)(c.ws + WS_XN);
    const int lane = c.lane, r = lane & 31, hh = lane >> 5, w = c.wave, mp = w >> 2, qg = w & 3;
    int b, h, qrow0, t0, nt;
    if (item < NB * 16 * 32) { b = item >> 9; h = (item >> 5) & 15; qrow0 = b * SEQ + (item & 31) * 128; t0 = 0; nt = NKEY / 64; }
    else { const int i2 = item - NB * 16 * 32; b = i2 >> 5; h = (i2 >> 1) & 15; qrow0 = TL + b * CTXL + (i2 & 1) * 128; t0 = SEQ / 64; nt = CTXL / 64; }
    const bf16_t* VTh = VT + ((size_t)b * 16 + h) * 128 * NKEY;
    int krow_l[2], kchunk_l[2], vrow_l[2], vchunk_l[2];
#pragma unroll
    for (int i = 0; i < 2; ++i) { const int pk = 2 * w + i; krow_l[i] = 4 * pk + (lane >> 4); kchunk_l[i] = (lane & 15) ^ (krow_l[i] & 15);
        vrow_l[i] = 8 * pk + (lane >> 3); vchunk_l[i] = (lane & 7) ^ ((vrow_l[i] >> 1) & 7); }
#define DA_LOAD(t, buf) do { const int kx0 = (t0 + (t)) * 64; const int krow0 = kx0 < SEQ ? b * SEQ + kx0 : TL + b * CTXL + (kx0 - SEQ); \
        _Pragma("unroll") for (int i = 0; i < 2; ++i) { \
            __builtin_amdgcn_global_load_lds((const unsigned*)(PB + (size_t)(krow0 + krow_l[i]) * COLS_B + 2048 + h * 128 + kchunk_l[i] * 8), (LAS unsigned*)(c.lds + (buf) * DA_BUF + (2 * w + i) * 1024), 16, 0, 0); \
            __builtin_amdgcn_global_load_lds((const unsigned*)(VTh + (size_t)vrow_l[i] * NKEY + kx0 + vchunk_l[i] * 8), (LAS unsigned*)(c.lds + (buf) * DA_BUF + DA_KBYTES + (2 * w + i) * 1024), 16, 0, 0); } } while (0)
    bf16x8 q[4];
    { const bf16_t* qp = PB + (size_t)(qrow0 + 32 * qg + r) * COLS_B + h * 128 + mp * 64 + hh * 8;
#pragma unroll
      for (int ks = 0; ks < 4; ++ks) q[ks] = ld_frag(qp + ks * 16); }
    f32x16 O[4];
#pragma unroll
    for (int d = 0; d < 4; ++d)
#pragma unroll
        for (int i = 0; i < 16; ++i) O[d][i] = 0.f;
    float m = 0.f, l = 0.f;
    DA_LOAD(0, 0);
    __syncthreads();
    for (int t = 0; t < nt; ++t) {
        const int cur = t & 1;
        if (t + 1 < nt) DA_LOAD(t + 1, cur ^ 1);
        const LAS unsigned short* Kl = (const LAS unsigned short*)(c.lds + cur * DA_BUF); const LAS unsigned short* Vl = (const LAS unsigned short*)(c.lds + cur * DA_BUF + DA_KBYTES);
        f32x16 st[2];
        const float negm = -m;
#pragma unroll
        for (int sub = 0; sub < 2; ++sub) {
#pragma unroll
            for (int i = 0; i < 16; ++i) st[sub][i] = negm;
#pragma unroll
            for (int ks = 0; ks < 4; ++ks) st[sub] = MFMA32(*(const LAS bf16x8*)((const LAS unsigned char*)Kl + (32 * sub + r) * 256 + (((mp * 8 + ks * 2 + hh) ^ (r & 15)) << 4)), q[ks], st[sub]); }
        float mx = fmaxf(st[0][0], st[1][0]);
#pragma unroll
        for (int i = 1; i < 16; ++i) mx = fmaxf(mx, fmaxf(st[0][i], st[1][i]));
        mx = fmaxf(mx, __shfl_xor(mx, 32));
        if (!__all(mx <= 8.0f && mx >= -24.0f)) {
            const float alpha = __builtin_amdgcn_exp2f(-mx);
            m += mx; l *= alpha;
#pragma unroll
            for (int sub = 0; sub < 2; ++sub)
#pragma unroll
                for (int i = 0; i < 16; ++i) st[sub][i] -= mx;
#pragma unroll
            for (int d = 0; d < 4; ++d)
#pragma unroll
                for (int i = 0; i < 16; ++i) O[d][i] *= alpha;
        }
        float ps = 0.f;
#pragma unroll
        for (int sub = 0; sub < 2; ++sub)
#pragma unroll
            for (int i = 0; i < 16; ++i) { st[sub][i] = __builtin_amdgcn_exp2f(st[sub][i]); ps += st[sub][i]; }
        l += ps;
        bf16x8 P[4];
#pragma unroll
        for (int sub = 0; sub < 2; ++sub) { P[2 * sub] = pack_p(st[sub], 0); P[2 * sub + 1] = pack_p(st[sub], 1); }
#pragma unroll
        for (int d = 0; d < 4; ++d)
#pragma unroll
            for (int kk = 0; kk < 4; ++kk) O[d] = MFMA32(*(const LAS bf16x8*)((const LAS unsigned char*)Vl + (32 * d + r) * 128 + (((2 * kk + hh) ^ ((r >> 1) & 7)) << 4)), P[kk], O[d]);
        __syncthreads();
    }
#undef DA_LOAD
    LAS float* CB = (LAS float*)(c.lds + DA_COMB) + qg * 4096;
    l += __shfl_xor(l, 32);
    if (mp == 1) { const float sc = ((const float*)(c.ws + WS_SCAL))[0] / l;
#pragma unroll
        for (int d = 0; d < 4; ++d)
#pragma unroll
            for (int i = 0; i < 16; ++i) CB[(32 * d + (i & 3) + 8 * (i >> 2) + 4 * hh) * 32 + r] = O[d][i] * sc; }
    __syncthreads();
    if (mp == 0) { const float i0 = 1.0f / l; float ss = 0.f;
#pragma unroll
        for (int d = 0; d < 4; ++d)
#pragma unroll
            for (int i = 0; i < 16; ++i) { const float y = O[d][i] * i0 - CB[(32 * d + (i & 3) + 8 * (i >> 2) + 4 * hh) * 32 + r]; O[d][i] = y; ss += y * y; }
        ss += __shfl_xor(ss, 32);
        const float rs = rsqrtf(ss * (1.0f / 128.0f) + 1e-5f) * 0.8f;
        const float* subln = c.in[I_SUBLN];
        bf16_t* orow = MIX + (size_t)(qrow0 + 32 * qg + r) * D + 2048 + h * 128;
#pragma unroll
        for (int d = 0; d < 4; ++d)
#pragma unroll
            for (int g = 0; g < 4; ++g) { const int dv = 32 * d + 8 * g + 4 * hh; const f32x4 sl = *(const f32x4*)(subln + dv);
                u32x2 wv; wv.x = pk_bf16(O[d][4 * g] * rs * sl[0], O[d][4 * g + 1] * rs * sl[1]); wv.y = pk_bf16(O[d][4 * g + 2] * rs * sl[2], O[d][4 * g + 3] * rs * sl[3]);
                *(u32x2*)(orow + dv) = wv; } }
    __syncthreads();
}
__device__ __forceinline__ void p_dattn_block(const Ctx& c, bool need_ctx) {
    const int nitems = NB * 16 * 32 + (need_ctx ? NB * 16 * 2 : 0);
    const bool remap = gridDim.x == 256;
    for (int item = blockIdx.x; item < nitems; item += gridDim.x) {
        int it = item;
        if (remap && item < NB * 16 * 32) { const int k = item >> 8, x = item & 7, sl = (item & 255) >> 3; it = (((k << 3) + x) << 5) | sl; }
        dattn_block_item(c, it);
    }
}

constexpr int P1_CQ = 0, P1_CK = 2048, P1_CV = 2304, P1_DQ = 2560, P1_DK = 3584, P1_DV = 4608, P1_DG = 6656;

constexpr int SW_KLD = 72, SW_VLD = 40;
constexpr int SW_KBYTES = 32 * SW_KLD * 2, SW_VBYTES = 64 * SW_VLD * 2, SW_BUF = SW_KBYTES + SW_VBYTES;
__device__ __forceinline__ void swa_block_item(const Ctx& c, int item) {
    const bf16_t* P1 = (const bf16_t*)(c.ar + AR_P1); const bf16_t* VTC = (const bf16_t*)(c.ar + AR_VTC); bf16_t* MIX = (bf16_t*)(c.ws + WS_XN);
    const int tid = c.tid, lane = c.lane, r = lane & 31, hh = lane >> 5;
    const int b = item >> 9, g = (item >> 7) & 3, q0 = (item & 127) * 32, hq = g * 8 + c.wave;
    const int qpos = q0 + r;
    bf16x8 q[4]; { const bf16_t* qp = P1 + (size_t)(b * SEQ + qpos) * NO + P1_CQ + hq * 64 + hh * 8;
#pragma unroll
        for (int ks = 0; ks < 4; ++ks) q[ks] = ld_frag(qp + ks * 16); }
    const bf16_t* VTh = VTC + ((size_t)b * 4 + g) * 64 * NKEY;
    f32x16 O[2];
#pragma unroll
    for (int d = 0; d < 2; ++d)
#pragma unroll
        for (int i = 0; i < 16; ++i) O[d][i] = 0.f;
    float m = 0.f, l = 0.f;
    const int wt0 = (q0 - 128 < 0 ? 0 : q0 - 128) / 32, wt1 = (q0 + 160 > SEQ ? SEQ : q0 + 160) / 32;
    const int nwt = wt1 - wt0, ntl = nwt + 8;
    u32x4 sreg;
    const bool kside = tid < 256; const int t2 = tid & 255;
#define SWB_LOAD(ti) do { const bool win_ = (ti) < nwt; const int kx_ = (win_ ? wt0 + (ti) : (SEQ / 32) + ((ti) - nwt)) * 32; \
        sreg = kside ? *(const u32x4*)(P1 + (size_t)((win_ ? b * SEQ + kx_ : TL + b * CTXL + (kx_ - SEQ)) + (t2 >> 3)) * NO + P1_CK + g * 64 + (t2 & 7) * 8) \
                     : *(const u32x4*)(VTh + (size_t)(t2 >> 2) * NKEY + kx_ + (t2 & 3) * 8); } while (0)
#define SWB_STORE(buf) do { LAS unsigned short* base_ = (LAS unsigned short*)(c.lds + (buf) * SW_BUF); \
        if (kside) *(LAS u32x4*)(base_ + (t2 >> 3) * SW_KLD + (t2 & 7) * 8) = sreg; else *(LAS u32x4*)(base_ + SW_KBYTES / 2 + (t2 >> 2) * SW_VLD + (t2 & 3) * 8) = sreg; } while (0)
    SWB_LOAD(0); SWB_STORE(0);
    __syncthreads();
    for (int ti = 0; ti < ntl; ++ti) {
        const bool win = ti < nwt; const int kx0 = (win ? wt0 + ti : (SEQ / 32) + (ti - nwt)) * 32;
        if (ti + 1 < ntl) SWB_LOAD(ti + 1);
        const LAS unsigned short* Kl = (const LAS unsigned short*)(c.lds + (ti & 1) * SW_BUF); const LAS unsigned short* Vl = Kl + SW_KBYTES / 2;
        f32x16 st;
        const float negm = -m;
#pragma unroll
        for (int i = 0; i < 16; ++i) st[i] = negm;
#pragma unroll
        for (int ks = 0; ks < 4; ++ks) st = MFMA32(*(const LAS bf16x8*)(Kl + r * SW_KLD + ks * 16 + hh * 8), q[ks], st);
        if (win && (kx0 == q0 - 128 || kx0 == q0 + 128)) {
#pragma unroll
            for (int i = 0; i < 16; ++i) { const int kpos = kx0 + (i & 3) + 8 * (i >> 2) + 4 * hh; const int dl = kpos - qpos; if (dl > 128 || dl < -128) st[i] = -1e30f; }
        }
        float mx = st[0];
#pragma unroll
        for (int i = 1; i < 16; ++i) mx = fmaxf(mx, st[i]);
        mx = fmaxf(mx, __shfl_xor(mx, 32));
        if (!__all(mx <= 8.0f && mx >= -24.0f)) {
            const float alpha = __builtin_amdgcn_exp2f(-mx);
            m += mx; l *= alpha;
#pragma unroll
            for (int i = 0; i < 16; ++i) st[i] -= mx;
#pragma unroll
            for (int d = 0; d < 2; ++d)
#pragma unroll
                for (int i = 0; i < 16; ++i) O[d][i] *= alpha;
        }
        float ps = 0.f;
#pragma unroll
        for (int i = 0; i < 16; ++i) { st[i] = __builtin_amdgcn_exp2f(st[i]); ps += st[i]; }
        l += ps;
        const bf16x8 p0 = pack_p(st, 0), p1 = pack_p(st, 1);
#pragma unroll
        for (int d = 0; d < 2; ++d) { O[d] = MFMA32(*(const LAS bf16x8*)(Vl + (32 * d + r) * SW_VLD + 8 * hh), p0, O[d]); O[d] = MFMA32(*(const LAS bf16x8*)(Vl + (32 * d + r) * SW_VLD + 16 + 8 * hh), p1, O[d]); }
        if (ti + 1 < ntl) SWB_STORE((ti + 1) & 1);
        __syncthreads();
    }
#undef SWB_LOAD
#undef SWB_STORE
    l += __shfl_xor(l, 32);
    l += __builtin_amdgcn_exp2f(c.in[I_SINK][hq] * LOG2E - m);
    const float il = 1.0f / l;
    bf16_t* orow = MIX + (size_t)(b * SEQ + qpos) * D + hq * 64;
#pragma unroll
    for (int d = 0; d < 2; ++d)
#pragma unroll
        for (int gq = 0; gq < 4; ++gq) { const int dv = 32 * d + 8 * gq + 4 * hh;
            u32x2 w; w.x = pk_bf16(O[d][4 * gq] * il, O[d][4 * gq + 1] * il); w.y = pk_bf16(O[d][4 * gq + 2] * il, O[d][4 * gq + 3] * il);
            *(u32x2*)(orow + dv) = w; }
}

DI float ret_lg(const Ctx& c, int dir, int h) { return log1pf(-exp2f(-c.in[I_RDEC][dir * 8 + h])); }
DI int ret_row0(int b, int cidx) { return cidx < 2 ? TL + b * CTXL + cidx * 128 : b * SEQ + (cidx - 2) * 128; }
constexpr int TK_LD = 136, TV_LD = 264;
constexpr int RT_LD = 136;
DI void stage_chunk_T(const Ctx& c, const bf16_t* src, int ld_src, int ncols, LAS unsigned short* T) {
    const int tid = c.tid, row = tid >> 2, part = tid & 3, cpt = ncols / 4;
    const bf16_t* p = src + (size_t)row * ld_src + part * cpt;
    for (int e = 0; e < cpt / 8; ++e) { const u32x4 w = *(const u32x4*)(p + e * 8);
#pragma unroll
        for (int j = 0; j < 4; ++j) { T[(part * cpt + e * 8 + 2 * j) * RT_LD + row] = (unsigned short)(w[j] & 0xffffu); T[(part * cpt + e * 8 + 2 * j + 1) * RT_LD + row] = (unsigned short)(w[j] >> 16); } }
}
__device__ __forceinline__ void p_ret_local(const Ctx& c) {
    const bf16_t* P1 = (const bf16_t*)(c.ar + AR_P1); float* RU = (float*)(c.ar + AR_RU);
    LAS unsigned short* TK = (LAS unsigned short*)c.lds; LAS unsigned short* TV = TK + 128 * RT_LD;
    const int lane = c.lane, r = lane & 31, hh = lane >> 5, w = c.wave;
    for (int item = blockIdx.x; item < NB * 8 * 34; item += gridDim.x) {
        const int cidx = item % 34, h = (item / 34) & 7, b = item / (34 * 8);
        const int row0 = ret_row0(b, cidx);
        stage_chunk_T(c, P1 + (size_t)row0 * NO + P1_DK + h * 128, NO, 128, TK);
        stage_chunk_T(c, P1 + (size_t)row0 * NO + P1_DV + h * 256, NO, 256, TV);
        __syncthreads();
        for (int dir = 0; dir < 2; ++dir) {
            const float lg = ret_lg(c, dir, h);
            f32x16 af[4];
#pragma unroll
            for (int dt = 0; dt < 4; ++dt)
#pragma unroll
                for (int i = 0; i < 16; ++i) af[dt][i] = 0.f;
#pragma unroll 1
            for (int ks = 0; ks < 8; ++ks) {
                const int i0 = ks * 16 + hh * 8;
                float vf[8]; unpack8(*(const LAS u32x4*)(TV + (32 * w + r) * RT_LD + i0), vf);
#pragma unroll
                for (int j = 0; j < 8; ++j) vf[j] *= __expf(lg * (float)(dir ? (i0 + j) : (127 - (i0 + j))));
                const bf16x8 fa = __builtin_bit_cast(bf16x8, pack8_bf16(vf));
#pragma unroll
                for (int dt = 0; dt < 4; ++dt) af[dt] = MFMA32(*(const LAS bf16x8*)(TK + (32 * dt + r) * RT_LD + i0), fa, af[dt]);
            }
            float* U = RU + ((((size_t)b * 8 + h) * 2 + dir) * 34 + cidx) * 32768;
#pragma unroll
            for (int dt = 0; dt < 4; ++dt)
#pragma unroll
                for (int g = 0; g < 4; ++g) { f32x4 v4 = {af[dt][4 * g], af[dt][4 * g + 1], af[dt][4 * g + 2], af[dt][4 * g + 3]}; *(f32x4*)(U + (32 * w + r) * 128 + 32 * dt + 8 * g + 4 * hh) = v4; }
        }
        __syncthreads();
    }
}
__device__ __forceinline__ void p_ret_prefix(const Ctx& c) {
    const float* RU = (const float*)(c.ar + AR_RU); bf16_t* RS = (bf16_t*)(c.ar + AR_RS);
    const size_t gtid = (size_t)blockIdx.x * NTHREADS + c.tid, gn = (size_t)gridDim.x * NTHREADS;
    for (size_t idx = gtid; idx < (size_t)NB * 8 * 2 * 32768; idx += gn) {
        const int el = (int)(idx & 32767), bhd = (int)(idx >> 15), dir = bhd & 1, h = (bhd >> 1) & 7;
        const float cd = __expf(ret_lg(c, dir, h) * 128.0f);
        const float* U = RU + (size_t)bhd * 34 * 32768 + el; bf16_t* S = RS + (size_t)bhd * 32 * 32768 + el;
        float u[34];
#pragma unroll
        for (int ci = 0; ci < 34; ++ci) u[ci] = __builtin_nontemporal_load(U + (size_t)ci * 32768);
        float s = 0.f;
        if (dir == 0) {
#pragma unroll
            for (int ci = 0; ci < 34; ++ci) { if (ci >= 2) S[(size_t)(ci - 2) * 32768] = f2bf(s); s = s * cd + u[ci]; } }
        else { s = s * cd + u[1]; s = s * cd + u[0];
#pragma unroll
            for (int ci = 33; ci >= 2; --ci) { S[(size_t)(ci - 2) * 32768] = f2bf(s); s = s * cd + u[ci]; } }
    }
}
__device__ __forceinline__ void p_ret_out(const Ctx& c) {
    const bf16_t* P1 = (const bf16_t*)(c.ar + AR_P1); const bf16_t* RS = (const bf16_t*)(c.ar + AR_RS); bf16_t* MIX = (bf16_t*)(c.ws + WS_XN);
    LAS unsigned short* TV = (LAS unsigned short*)c.lds;
    LAS float* XS = (LAS float*)(c.lds + 256 * RT_LD * 2);
    const int lane = c.lane, r = lane & 31, hh = lane >> 5, w = c.wave, qt = w & 3, eh = w >> 2;
    for (int item = blockIdx.x; item < NB * 8 * 32; item += gridDim.x) {
        const int lc = item & 31, h = (item >> 5) & 7, b = item >> 8;
        const int row0 = b * SEQ + lc * 128;
        stage_chunk_T(c, P1 + (size_t)row0 * NO + P1_DV + h * 256, NO, 256, TV);
        __syncthreads();
        const float lgf = ret_lg(c, 0, h), lgb = ret_lg(c, 1, h);
        const int qi = qt * 32 + r;
        const bf16_t* qp = P1 + (size_t)(row0 + qi) * NO + P1_DQ + h * 128 + hh * 8;
        f32x16 Y[4];
#pragma unroll
        for (int et = 0; et < 4; ++et)
#pragma unroll
            for (int i = 0; i < 16; ++i) Y[et][i] = 0.f;
        {
            const float qdf = __expf(lgf * (float)(qi + 1)), qdb = __expf(lgb * (float)(128 - qi));
            const bf16_t* Sf = RS + ((((size_t)b * 8 + h) * 2 + 0) * 32 + lc) * 32768; const bf16_t* Sb = RS + ((((size_t)b * 8 + h) * 2 + 1) * 32 + lc) * 32768;
#pragma unroll 1
            for (int ks = 0; ks < 8; ++ks) {
                float x[8], xf[8], xb[8]; unpack8(*(const u32x4*)(qp + ks * 16), x);
#pragma unroll
                for (int j = 0; j < 8; ++j) { xf[j] = x[j] * qdf; xb[j] = x[j] * qdb; }
                const bf16x8 qf = __builtin_bit_cast(bf16x8, pack8_bf16(xf)), qb = __builtin_bit_cast(bf16x8, pack8_bf16(xb));
#pragma unroll
                for (int et = 0; et < 4; ++et) { const int e = eh * 128 + et * 32 + r;
                    Y[et] = MFMA32(ld_frag(Sf + (size_t)e * 128 + ks * 16 + hh * 8), qf, Y[et]);
                    Y[et] = MFMA32(ld_frag(Sb + (size_t)e * 128 + ks * 16 + hh * 8), qb, Y[et]); }
            }
        }
#pragma unroll 1
        for (int kt = 0; kt < 4; ++kt) {
            f32x16 st;
#pragma unroll
            for (int i = 0; i < 16; ++i) st[i] = 0.f;
            const bf16_t* kp = P1 + (size_t)(row0 + kt * 32 + r) * NO + P1_DK + h * 128 + hh * 8;
#pragma unroll
            for (int ks = 0; ks < 8; ++ks) st = MFMA32(ld_frag(kp + ks * 16), ld_frag(qp + ks * 16), st);
#pragma unroll
            for (int i = 0; i < 16; ++i) { const int ki = kt * 32 + (i & 3) + 8 * (i >> 2) + 4 * hh; const int dl = qi - ki;
                const float f = dl > 0 ? __expf(lgf * (float)dl) : (dl < 0 ? __expf(lgb * (float)(-dl)) : 2.0f); st[i] *= f; }
            const bf16x8 p0 = pack_p(st, 0), p1 = pack_p(st, 1);
#pragma unroll
            for (int et = 0; et < 4; ++et) { const int e = eh * 128 + et * 32 + r;
#pragma unroll
                for (int s = 0; s < 2; ++s) { const u32x2 lo = *(const LAS u32x2*)(TV + e * RT_LD + kt * 32 + 16 * s + 4 * hh), hi = *(const LAS u32x2*)(TV + e * RT_LD + kt * 32 + 16 * s + 8 + 4 * hh);
                    u32x4 vw = {lo.x, lo.y, hi.x, hi.y};
                    Y[et] = MFMA32(__builtin_bit_cast(bf16x8, vw), s == 0 ? p0 : p1, Y[et]); } }
        }
        float ss = 0.f;
#pragma unroll
        for (int et = 0; et < 4; ++et)
#pragma unroll
            for (int i = 0; i < 16; ++i) ss += Y[et][i] * Y[et][i];
        ss += __shfl_xor(ss, 32);
        if (hh == 0) XS[(eh * 4 + qt) * 32 + r] = ss;
        __syncthreads();
        const float tot = XS[(0 * 4 + qt) * 32 + r] + XS[(1 * 4 + qt) * 32 + r];
        const float rs = rsqrtf(tot * (1.0f / 256.0f) + 1e-6f);
        const bf16_t* gp = P1 + (size_t)(row0 + qi) * NO + P1_DG + h * 256; bf16_t* op = MIX + (size_t)(row0 + qi) * D + 2048 + h * 256;
#pragma unroll
        for (int et = 0; et < 4; ++et)
#pragma unroll
            for (int gq = 0; gq < 4; ++gq) { const int e = eh * 128 + et * 32 + 8 * gq + 4 * hh;
                const u32x2 gw = *(const u32x2*)(gp + e);
                const float g0 = bflo(gw.x), g1 = bfhi(gw.x), g2 = bflo(gw.y), g3 = bfhi(gw.y);
                u32x2 o; o.x = pk_bf16(Y[et][4 * gq] * rs * silu_f(g0), Y[et][4 * gq + 1] * rs * silu_f(g1)); o.y = pk_bf16(Y[et][4 * gq + 2] * rs * silu_f(g2), Y[et][4 * gq + 3] * rs * silu_f(g3));
                *(u32x2*)(op + e) = o; }
        __syncthreads();
    }
}

#define MK_PER_PHASE 0
#ifndef MK_PER_PHASE
#define MK_PER_PHASE 0
#endif
constexpr int N_PHASES = 25;
constexpr int LDS_STAGE = 4 * K1_WAVE_LDS;
constexpr int LDS_BYTES = LDS_STAGE + 256;

__global__ void __launch_bounds__(NTHREADS, 2) mk_fwd(Args a) {
    extern __shared__ __attribute__((aligned(16))) unsigned char smem[];
    Ctx c;
#pragma unroll
    for (int i = 0; i < 29; ++i) c.in[i] = a.in[i];
    c.out = a.out; c.ws = a.ws; c.ar = a.ws + WS_ARENA; c.lds = (LAS unsigned char*)smem;
    c.tid = threadIdx.x; c.lane = c.tid & 63; c.wave = __builtin_amdgcn_readfirstlane(c.tid >> 6);
    volatile LAS unsigned* xbw = (volatile LAS unsigned*)(c.lds + LDS_STAGE);
    if (c.tid < 4) xbw[c.tid] = 0u;
    __syncthreads();
    XcdBarrier bar; bar.bar = (unsigned*)(a.ws + WS_CTL); bar.x = 0; bar.st = xbw;
    if (!MK_PER_PHASE) bar = xcd_barrier_post((unsigned*)(a.ws + WS_CTL), xbw);
    const int lo = a.ph_lo, hi = a.ph_hi;
#ifndef PH_MASK
#define PH_MASK 0x1ffffffu
#endif
#define IN(k) (((PH_MASK >> (k)) & 1u) && lo <= (k) && (k) < hi)
#define SEAM(k) do { if (IN(k) && IN((k) + 1)) { xcd_barrier(bar); } } while (0)
    res_t* H = (res_t*)(c.ws + WS_H); const float* MOD = (const float*)(c.ws + WS_MOD);
    const bf16_t* XN = (const bf16_t*)(c.ws + WS_XN); unsigned char* W = c.ws + WS_W;
    LAS unsigned char* gl = c.lds; float* SLAB = (float*)(c.ar + AR_SLAB); unsigned char* W1 = c.ws + WS_W1;

    if (IN(0)) { p_mod(c); p_weights_layer0(c); p_wcolmax(c, CmxDeal{(int)blockIdx.x, (int)gridDim.x, 0, cmx_p0(gridDim.x)}); }
    SEAM(0);
    if (IN(1)) { p_mod_finalize(c); p_norm_mod<4>(c, c.in[I_X], c.in[I_CTX], TT, (const float*)(c.ar + AR_MODP), 0, 1); }
    SEAM(1);
    if (IN(2)) { const int ns = cmx_ns(gridDim.x), gg = (int)gridDim.x - ns;
        if ((int)blockIdx.x < gg) { pg8::Gemm g{XN, (const bf16_t*)(W + W_IN), TT, NE, D}; LatThenCtxOrder S; S.init2(NE, gg, blockIdx.x, D);
            EpiInEven E{(bf16_t*)(c.ar + AR_PA), (bf16_t*)(c.ar + AR_PB), (const float*)(c.ws + WS_AXC), (const float*)(c.ws + WS_AXS)};
            pg8::gemm_phase(gl, g, S, E); }
        else p_wcolmax(c, CmxDeal{(int)blockIdx.x - gg, ns, cmx_p0(gridDim.x), CMX_TOTAL}); }
    SEAM(2);
    if (IN(3)) { p_rwkv_prepA(c); p_build_vt<128, 16>(c, (const bf16_t*)(c.ar + AR_PB), COLS_B, 4096, (bf16_t*)(c.ar + AR_VT)); }
    SEAM(3);
    if (IN(4)) { pg8::Gemm g{(const bf16_t*)(c.ar + AR_LA), (const bf16_t*)(W + W_LORA), TT, LORA_N, LORA_K}; LoraOrder S; S.init2(LORA_N, gridDim.x, blockIdx.x, LORA_KU);
        EpiLora E{c.in[I_W0], c.in[I_A0], c.in[I_KA], (const bf16_t*)(c.ar + AR_K), (const h16*)(c.ar + AR_KK), (h16*)(c.ar + AR_OMW), (h16*)(c.ar + AR_BB), (h16*)(c.ar + AR_KD), (bf16_t*)(c.ar + AR_G)};
        pg8::gemm_phase(gl, g, S, E); }
    SEAM(4);
    if (IN(5)) {
#ifndef NO_DATTN
        p_dattn_block(c, true); __syncthreads();
#endif
#ifndef NO_K1
        p_rwkv_k1_and_conv(c);
#endif
    }
    SEAM(5);
    if (IN(6)) p_rwkv_seq_and_conv(c);
    SEAM(6);
    if (IN(7)) p_rwkv_out(c, TT);
    SEAM(7);
    if (IN(8)) { constexpr int KE = MIX_I8 ? D / 2 : D; const float* SAq = (const float*)(c.ar + AR_XQS);
        pg8::Gemm g{MIX_I8 ? (const bf16_t*)(c.ar + AR_XQ) : XN, (const bf16_t*)(W + W_MIX), TT, D, KE}; pg8::StaticOrder S; S.init(TL, D, gridDim.x, blockIdx.x, KE);
        EpiResModT<MIX_I8 != 0, float> E{c.in[I_X], c.in[I_CTX], H, MOD + 2 * 4096, SAq, i8_cs(c, CM_MIX)};
        pg8::gemm_phase(gl, g, S, E);
        CtxSplitOrder S2; S2.init(D, gridDim.x, blockIdx.x, KE); EpiSlabT<MIX_I8 != 0> E2{SLAB, SAq, i8_cs(c, CM_MIX)};
        pg8::gemm_phase(gl, g, S2, E2); }
    SEAM(8);
    if (IN(9)) { p_ctx_fix(c, c.in[I_CTX], MOD + 4 * 24576 + 2 * 4096, SLAB, H); p_norm_mod<1, FFN_I8 != 0, res_t>(c, H, H + (size_t)TL * D, TT, MOD, 3, 4); }
    SEAM(9);
    if (IN(10)) { constexpr int KE = FFN_I8 ? D / 2 : D;
        pg8::Gemm g{XN, (const bf16_t*)(W + W_FFI), TT, 2 * DFF, KE}; LatThenCtxOrder S; S.init2(2 * DFF, gridDim.x, blockIdx.x, KE);
        EpiConvGlu E{(bf16_t*)(c.ar + AR_HID), (bf16_t*)(c.ar + AR_SG), (bf16_t*)(c.ar + AR_SU), c.in[I_CONVW], c.in[I_CONVB], (const float*)(c.ws + WS_XN + (size_t)TT * D), i8_cs(c, CM_FFI)};
        pg8::gemm_phase(gl, g, S, E); }
    SEAM(10);
    if (IN(11)) { p_conv_fix(c, 0, TT); if (FFO0_I8 && IN(12)) { xcd_barrier(bar); p_quant_hid(c, TT); } }
    SEAM(11);
    if (IN(12)) { constexpr int KE = FFO0_I8 ? DFF / 2 : DFF; const float* SAq = (const float*)(c.ar + AR_HQS);
        pg8::Gemm g{(const bf16_t*)(c.ar + (FFO0_I8 ? AR_HQ : AR_HID)), (const bf16_t*)(W + W_FFO), TT, D, KE}; pg8::StaticOrder S; S.init(TL, D, gridDim.x, blockIdx.x, KE);
        EpiResModT<FFO0_I8 != 0> E{H, H + (size_t)TL * D, H, MOD + 5 * 4096, SAq, i8_cs(c, CM_FFO0)};
        pg8::gemm_phase(gl, g, S, E);
        CtxSplitOrder S2; S2.init(D, gridDim.x, blockIdx.x, KE); EpiSlabT<FFO0_I8 != 0> E2{SLAB, SAq, i8_cs(c, CM_FFO0)};
        pg8::gemm_phase(gl, g, S2, E2); }
    SEAM(12);
    const float* MOD1 = MOD + 5 * 24576;
    if (IN(13)) { p_ctx_fix(c, H + (size_t)TL * D, MOD + 4 * 24576 + 5 * 4096, SLAB, H); p_norm_mod<1, INO_I8 != 0, res_t>(c, H, H + (size_t)TL * D, TT, MOD1, 0, 1); }
    SEAM(13);
    if (IN(14)) { constexpr int KE = INO_I8 ? D / 2 : D;
        pg8::Gemm g{XN, (const bf16_t*)(W + W_IN), TT, NO, KE}; OddInOrder S; S.init2(gridDim.x, blockIdx.x, KE);
        EpiInOdd E{(bf16_t*)(c.ar + AR_P1), (const float*)(c.ws + WS_AXC), (const float*)(c.ws + WS_AXS), (const float*)(c.ws + WS_RTC), (const float*)(c.ws + WS_RTS), (const float*)(c.ws + WS_XN + (size_t)TT * D), i8_cs(c, CM_INO)};
        pg8::gemm_phase(gl, g, S, E); }
    SEAM(14);
    if (IN(15)) { p_build_vt<64, 4>(c, (const bf16_t*)(c.ar + AR_P1), NO, P1_CV, (bf16_t*)(c.ar + AR_VTC)); }
    SEAM(15);
    if (IN(16)) { p_ret_local(c); for (int item = blockIdx.x; item < NB * 4 * 128; item += gridDim.x) swa_block_item(c, item); }
    SEAM(16);
    if (IN(17)) p_ret_prefix(c);
    SEAM(17);
    if (IN(18)) p_ret_out(c);
    SEAM(18);
    if (MIX_I8 && IN(18) && IN(19)) { p_quant_mix(c, TL); xcd_barrier(bar); }
    if (IN(19)) { constexpr int KE = MIX_I8 ? D / 2 : D;
        pg8::Gemm g{MIX_I8 ? (const bf16_t*)(c.ar + AR_XQ) : XN, (const bf16_t*)(W1 + W1_MIX), TL, D, KE}; pg8::StaticOrder S; S.init(TL, D, gridDim.x, blockIdx.x, KE);
        EpiResModT<MIX_I8 != 0> E{H, H + (size_t)TL * D, H, MOD1 + 2 * 4096, (const float*)(c.ar + AR_XQS), i8_cs(c, CM_MIX + D)};
        pg8::gemm_phase(gl, g, S, E); }
    SEAM(19);
    if (IN(20)) p_norm_mod<1, FFN_I8 != 0, res_t>(c, H, H + (size_t)TL * D, TL, MOD1, 3, 4);
    SEAM(20);
    if (IN(21)) { constexpr int KE = FFN_I8 ? D / 2 : D;
        pg8::Gemm g{XN, (const bf16_t*)(W1 + W1_FFI), TL, 2 * DFF, KE}; pg8::StaticOrder S; S.init(TL, 2 * DFF, gridDim.x, blockIdx.x, KE);
        EpiConvGlu E{(bf16_t*)(c.ar + AR_HID), (bf16_t*)(c.ar + AR_SG), (bf16_t*)(c.ar + AR_SU), c.in[I_CONVW] + (size_t)3 * DFF, c.in[I_CONVB] + DFF, (const float*)(c.ws + WS_XN + (size_t)TT * D), i8_cs(c, CM_FFI + 2 * DFF)};
        pg8::gemm_phase(gl, g, S, E); }
    SEAM(21);
    if (IN(22)) { p_conv_fix(c, 1, TL); if (FFO1_I8 && IN(23)) { xcd_barrier(bar); p_quant_hid(c, TL); } }
    SEAM(22);
    if (IN(23)) { constexpr int KE = FFO1_I8 ? DFF / 2 : DFF;
        pg8::Gemm g{(const bf16_t*)(c.ar + (FFO1_I8 ? AR_HQ : AR_HID)), (const bf16_t*)(W1 + W1_FFO), TL, D, KE}; pg8::StaticOrder S; S.init(TL, D, gridDim.x, blockIdx.x, KE);
        EpiResModT<FFO1_I8 != 0> E{H, H + (size_t)TL * D, H, MOD1 + 5 * 4096, (const float*)(c.ar + AR_HQS), i8_cs(c, CM_FFO1)};
        pg8::gemm_phase(gl, g, S, E); }
    SEAM(23);
    if (IN(24)) p_final_norm(c);
#undef IN
#undef SEAM
}

extern "C" void kernel_launch(void* const* d_in, const int* in_sizes, int n_in, void* d_out, int out_size, void* d_ws, size_t ws_size, hipStream_t stream) {
    static int grid = 0;
    if (grid == 0) {
        if (n_in != 29 || ws_size < WS_END) { fprintf(stderr, "kernel_launch: need 29 inputs and >= %zu bytes of workspace; got n_in %d, ws %zu; nothing launched\n", (size_t)WS_END, n_in, ws_size); grid = -1; return; }
        int dev = 0, cus = 0, per_cu = 0;
        if (hipGetDevice(&dev) != hipSuccess || hipDeviceGetAttribute(&cus, hipDeviceAttributeMultiprocessorCount, dev) != hipSuccess) { grid = -1; return; }
        if (hipFuncSetAttribute((const void*)mk_fwd, hipFuncAttributeMaxDynamicSharedMemorySize, LDS_BYTES) != hipSuccess) { fprintf(stderr, "kernel_launch: hipFuncSetAttribute failed\n"); grid = -1; return; }
        if (hipOccupancyMaxActiveBlocksPerMultiprocessor(&per_cu, (const void*)mk_fwd, NTHREADS, LDS_BYTES) != hipSuccess || per_cu < 1) { fprintf(stderr, "kernel_launch: occupancy query says %d blocks per CU\n", per_cu); per_cu = 1; }
        (void)hipGetLastError();
        grid = cus;
    }
    if (grid < 0) return;
    (void)hipMemsetAsync((char*)d_ws + WS_CTL, 0, CTL_BYTES, stream);
    Args a{};
    for (int i = 0; i < 29; ++i) a.in[i] = (const float*)d_in[i];
    a.out = (float*)d_out; a.ws = (unsigned char*)d_ws;
#if MK_PER_PHASE
    for (int p = 0; p < N_PHASES; ++p) { a.ph_lo = p; a.ph_hi = p + 1; hipLaunchKernelGGL(mk_fwd, dim3(grid), dim3(NTHREADS), LDS_BYTES, stream, a); }
#else
    a.ph_lo = 0; a.ph_hi = N_PHASES;
    hipLaunchKernelGGL(mk_fwd, dim3(grid), dim3(NTHREADS), LDS_BYTES, stream, a);
#endif
    (void)in_sizes; (void)out_size;
}
```

```cpp
#include <hip/hip_runtime.h>
#include <cstdio>
#include <cstdint>

#define LAS __attribute__((address_space(3)))
#define DI __device__ __forceinline__
typedef unsigned short bf16_t;
typedef _Float16 h16;
typedef short bf16x8 __attribute__((ext_vector_type(8)));
typedef float f32x4 __attribute__((ext_vector_type(4)));
typedef int i32x4 __attribute__((ext_vector_type(4)));
typedef float f32x2 __attribute__((ext_vector_type(2)));
typedef float f32x16 __attribute__((ext_vector_type(16)));
typedef unsigned u32x4 __attribute__((ext_vector_type(4)));
typedef unsigned u32x2 __attribute__((ext_vector_type(2)));
typedef __bf16 bf16x2_n __attribute__((ext_vector_type(2)));
typedef _Float16 h16x2_n __attribute__((ext_vector_type(2)));

constexpr int D = 4096, NB = 4, SEQ = 4096, CTXL = 256;
constexpr int TL = NB * SEQ, TC = NB * CTXL, TT = TL + TC;
constexpr int DFF = 11008;
constexpr int HALF_W = 2048;
constexpr int COLS_A = 6784, COLS_A_PAD = 6912, COLS_B = 6144, NE = COLS_A_PAD + COLS_B;
constexpr int COLS_C = 2560, COLS_D = 6144, NO = COLS_C + COLS_D;
constexpr int NKEY = SEQ + CTXL;
constexpr int LORA_K = 1280, LORA_KU = 256, LORA_N = 5 * 2048;
constexpr int NTHREADS = 512;

constexpr size_t al256(size_t x) { return (x + 255) & ~(size_t)255; }
constexpr size_t WS_CTL = 0;
constexpr size_t CTL_CMAX = 65536;
constexpr int CM_FFI = 0, CM_INO = 2 * 2 * 11008, CM_INE = CM_INO + 8704, CM_MIX = CM_INE + 13056, CM_FFO1 = CM_MIX + 2 * 4096, CM_FFO0 = CM_FFO1 + 4096, CM_END = CM_FFO0 + 4096;
constexpr size_t CTL_BYTES = CTL_CMAX + (((size_t)CM_END * 4 + 255) & ~(size_t)255);
constexpr size_t WS_MOD = WS_CTL + CTL_BYTES;
constexpr size_t WS_SCAL = WS_MOD + al256((size_t)2 * 5 * 6 * D * 4);
constexpr size_t WS_CS = WS_SCAL + 256;
constexpr size_t WS_AXC = WS_CS + (((size_t)CM_END * 4 + 255) & ~(size_t)255);
constexpr size_t WS_AXS = WS_AXC + (size_t)SEQ * 32 * 4;
constexpr size_t WS_RTC = WS_AXS + (size_t)SEQ * 32 * 4;
constexpr size_t WS_RTS = WS_RTC + (size_t)NKEY * 64 * 4;
constexpr size_t WS_W = WS_RTS + (size_t)NKEY * 64 * 4;
constexpr size_t W_IN = 0;
constexpr size_t W_MIX = W_IN + (size_t)NE * D * 2;
constexpr size_t W_FFI = W_MIX + (size_t)D * D * 2;
constexpr size_t W_FFO = W_FFI + (size_t)2 * DFF * D * 2;
constexpr size_t W_LORA = W_FFO + (size_t)D * DFF * 2;
constexpr size_t W_BYTES = W_LORA + (size_t)LORA_N * LORA_K * 2;
constexpr size_t WS_H = WS_W + al256(W_BYTES);
constexpr size_t WS_XN = WS_H + (size_t)TT * D * 4;
constexpr size_t WS_W1 = WS_XN + (size_t)TT * D * 2;
constexpr size_t W1_MIX = 0, W1_FFI = W1_MIX + (size_t)D * D * 2, W1_FFO = W1_FFI + (size_t)2 * DFF * D * 2, W1_BYTES = W1_FFO + (size_t)D * DFF * 2;
constexpr size_t WS_ARENA = WS_W1 + al256(W1_BYTES);
constexpr size_t SZ16 = (size_t)TT * 2048 * 2;
constexpr size_t MOD_FLOATS = (size_t)2 * 5 * 6 * D;
constexpr size_t AR_XQ = 0, AR_XQS = (size_t)80 << 20;
constexpr size_t AR_MODP = 0;
constexpr size_t AR_PA = 0;
constexpr size_t AR_K = AR_PA + (size_t)TT * COLS_A_PAD * 2;
constexpr size_t AR_LA = AR_K + SZ16;
constexpr size_t RW_NCH = 136;
constexpr size_t CH_BYTES = 24576;
constexpr size_t AR_CH = 0;
constexpr size_t AR_CH_END = AR_CH + (size_t)256 * RW_NCH * CH_BYTES;
constexpr size_t AR_PB = AR_CH_END;
constexpr size_t AR_VT = AR_PB + (size_t)TT * COLS_B * 2;
constexpr size_t AR_R = AR_VT + (size_t)NB * 16 * 128 * NKEY * 2;
constexpr size_t AR_KK = AR_R + SZ16;
constexpr size_t AR_V = AR_KK + SZ16;
constexpr size_t AR_OMW = AR_V + SZ16;
constexpr size_t AR_BB = AR_OMW + 2 * SZ16;
constexpr size_t AR_KD = AR_BB + 2 * SZ16;
constexpr size_t AR_G = AR_KD + 2 * SZ16;
constexpr size_t AR_Y = AR_G + SZ16;
constexpr size_t AR_EVEN_END = AR_Y + 2 * SZ16;
static_assert(AR_LA + (size_t)TT * LORA_K * 2 <= AR_CH_END, "PA|K|LA must sit under the chunk matrices");
constexpr size_t AR_GU = 0;
constexpr size_t AR_SG = 0, AR_SU = AR_SG + (size_t)(TT / 64) * 4 * DFF * 2;
constexpr size_t AR_HQ = (size_t)64 << 20, AR_HQS = (size_t)320 << 20;
constexpr size_t AR_HID = AR_GU + (size_t)TT * 2 * DFF * 2;
constexpr size_t AR_FFN_END = AR_HID + (size_t)TT * DFF * 2;
constexpr size_t AR_P1 = 0;
constexpr size_t AR_VTC = AR_P1 + (size_t)TT * NO * 2;
constexpr size_t AR_RU = AR_VTC + (size_t)NB * 4 * 64 * NKEY * 2;
constexpr size_t AR_RS = AR_RU + (size_t)NB * 8 * 2 * 34 * 256 * 128 * 4;
constexpr size_t AR_ODD_END = AR_RS + (size_t)NB * 8 * 2 * 32 * 256 * 128 * 2;
constexpr size_t AR_SLAB = (size_t)1300 << 20;
constexpr size_t AR_SLAB_END = AR_SLAB + (size_t)4 * TC * D * 4;
static_assert(AR_SLAB >= AR_FFN_END, "slab overlaps the FFN buffers");
constexpr size_t cmax(size_t a, size_t b) { return a > b ? a : b; }
constexpr size_t AR_BYTES = cmax(cmax(AR_EVEN_END, AR_FFN_END), AR_ODD_END);
constexpr size_t WS_END = WS_ARENA + AR_BYTES;
static_assert(WS_END <= (size_t)3221225472ull, "workspace plan exceeds 4 x the largest input tensor");
static_assert(AR_SLAB_END <= AR_BYTES, "slab outside the arena");

DI float bf2f(bf16_t x) { return __uint_as_float((unsigned)x << 16); }
DI bf16_t f2bf(float x) { return __builtin_bit_cast(unsigned short, (__bf16)x); }
DI unsigned pk_bf16(float lo, float hi) { f32x2 v = {lo, hi}; return __builtin_bit_cast(unsigned, __builtin_convertvector(v, bf16x2_n)); }
DI unsigned pk_f16(float lo, float hi) { f32x2 v = {lo, hi}; return __builtin_bit_cast(unsigned, __builtin_convertvector(v, h16x2_n)); }
DI float bflo(unsigned w) { return __uint_as_float(w << 16); }
DI float bfhi(unsigned w) { return __uint_as_float(w & 0xffff0000u); }
DI float h16lo(unsigned w) { return (float)__builtin_bit_cast(h16x2_n, w)[0]; }
DI float h16hi(unsigned w) { return (float)__builtin_bit_cast(h16x2_n, w)[1]; }
DI float silu_f(float x) { return x * __builtin_amdgcn_rcpf(1.0f + __expf(-x)); }
DI float sigmoid_f(float x) { return __builtin_amdgcn_rcpf(1.0f + __expf(-x)); }
DI float wave_sum(float v) {
#pragma unroll
    for (int o = 32; o >= 1; o >>= 1) v += __shfl_xor(v, o);
    return v;
}
DI void load8f(const float* p, float (&o)[8]) { const f32x4 a = *(const f32x4*)p, b = *(const f32x4*)(p + 4);
#pragma unroll
    for (int j = 0; j < 4; ++j) { o[j] = a[j]; o[4 + j] = b[j]; } }
#ifndef RES_F16
#define RES_F16 1
#endif
#if RES_F16
typedef h16 res_t;
#else
typedef float res_t;
#endif
DI f32x4 ld4(const float* p) { return *(const f32x4*)p; }
DI void st4(float* p, const f32x4 v) { *(f32x4*)p = v; }
#if RES_F16
DI f32x4 ld4(const h16* p) { const u32x2 w = *(const u32x2*)p; f32x4 v = {h16lo(w.x), h16hi(w.x), h16lo(w.y), h16hi(w.y)}; return v; }
DI void st4(h16* p, const f32x4 v) { u32x2 w = {pk_f16(v[0], v[1]), pk_f16(v[2], v[3])}; *(u32x2*)p = w; }
#endif
DI int row_modidx(int row) { return row < TL ? (row >> 12) : 4; }

#define XB_TMO      128
#define XB_XCNT(j)  (256  + 64 * (j))
#define XB_XSUB(j)  (1280 + 64 * (j))
#define XB_XGEN(j)  (2304 + 64 * (j))
#define XB_TOP      3328
#define XB_TOPGEN   3392
#define XCD_BAR_WORDS 3456
#define XB_SPIN_CAP (1u << 22)

__device__ __forceinline__ unsigned xb_ld(unsigned* p)              { return __hip_atomic_load(p, __ATOMIC_RELAXED, __HIP_MEMORY_SCOPE_AGENT); }
__device__ __forceinline__ unsigned xb_add(unsigned* p, unsigned v) { return __hip_atomic_fetch_add(p, v, __ATOMIC_RELAXED, __HIP_MEMORY_SCOPE_AGENT); }
__device__ __forceinline__ unsigned xb_xcc_id() { return (unsigned)__builtin_amdgcn_s_getreg((3 << 11) | 20) & 0xFu; }
#define XB_SPIN(cond, bar) do { unsigned _sp = 0; while (cond) { __builtin_amdgcn_s_sleep(1); \
    if ((++_sp & 255u) == 0u) { if (xb_ld(&(bar)[XB_TMO])) break; if (_sp > XB_SPIN_CAP) { atomicAdd(&(bar)[XB_TMO], 1u); break; } } } } while (0)

struct XcdBarrier {
    unsigned* bar; unsigned x;
    volatile LAS unsigned* st;
};

__device__ __forceinline__ XcdBarrier xcd_barrier_post(unsigned* bar, volatile LAS unsigned* st) {
    XcdBarrier b; b.bar = bar; b.x = xb_xcc_id(); b.st = st;
    if (threadIdx.x == 0) (void)xb_add(&bar[XB_XCNT(b.x)], 1u);
    return b;
}
__device__ __forceinline__ void xcd_barrier_complete(unsigned* bar, unsigned x, unsigned& nloc, unsigned& nx) {
    const unsigned G = gridDim.x * gridDim.y * gridDim.z;
    unsigned sum, cnt, mine, sp = 0u;
    for (;;) {
        sum = 0u; cnt = 0u; mine = 0u;
#pragma unroll
        for (unsigned j = 0; j < 16; ++j) { const unsigned c = xb_ld(&bar[XB_XCNT(j)]); sum += c; cnt += (c > 0u) ? 1u : 0u; mine = (j == x) ? c : mine; }
        if (sum == G) break;
        __builtin_amdgcn_s_sleep(1);
        if ((++sp & 255u) == 0u) { if (xb_ld(&bar[XB_TMO])) break; if (sp > XB_SPIN_CAP) { atomicAdd(&bar[XB_TMO], 1u); break; } }
    }
    nloc = mine > 0u ? mine : 1u; nx = cnt > 0u ? cnt : 1u;
}

__device__ __forceinline__ void xcd_barrier(const XcdBarrier& b) {
    asm volatile("s_waitcnt vmcnt(0)" ::: "memory");
    __syncthreads();
    if (threadIdx.x == 0) {
        unsigned* bar = b.bar;
        __builtin_amdgcn_s_waitcnt(0);
        unsigned nloc = b.st[0], nx = b.st[1];
        if (nloc == 0u) { xcd_barrier_complete(bar, b.x, nloc, nx); b.st[0] = nloc; b.st[1] = nx; }
        const unsigned old = xb_add(&bar[XB_XSUB(b.x)], 1u);
        const unsigned gen = old / nloc;
        if (old + 1u == (gen + 1u) * nloc) {
            __builtin_amdgcn_fence(__ATOMIC_RELEASE, "agent");
            asm volatile("s_waitcnt vmcnt(0)" ::: "memory");
            const unsigned og = xb_add(&bar[XB_TOP], 1u);
            const unsigned tg = og / nx;
            if (og + 1u == (tg + 1u) * nx) xb_add(&bar[XB_TOPGEN], 1u);
            else XB_SPIN(xb_ld(&bar[XB_TOPGEN]) == tg, bar);
            __builtin_amdgcn_fence(__ATOMIC_ACQUIRE, "agent");
            xb_add(&bar[XB_XGEN(b.x)], 1u);
            asm volatile("s_waitcnt vmcnt(0)" ::: "memory");
        } else {
            XB_SPIN(xb_ld(&bar[XB_XGEN(b.x)]) == gen, bar);
            __builtin_amdgcn_fence(__ATOMIC_ACQUIRE, "agent");
            asm volatile("s_waitcnt vmcnt(0)" ::: "memory");
        }
    }
    __syncthreads();
}

namespace pg8 {
#define PG8_LAS __attribute__((address_space(3)))
constexpr int BM = 256, BK = 64, HALF = 128, HTB = HALF * BK * 2  , STAGE_BYTES = 8 * HTB, NXCD = 8, WGM = 4;

__host__ __device__ __forceinline__ int lds_byte(int r, int c) { const int st = (r >> 4) * 2 + (c >> 5), rr = r & 15, cc = c & 31, ob = rr * 64 + cc * 2; return st * 1024 + (ob ^ (((ob >> 9) & 1) << 5)); }
__host__ __device__ __forceinline__ void stage_rc(int b, int& R, int& C) { const int st = b / 1024, sb = b % 1024, swz = sb ^ (((sb >> 9) & 1) << 5); R = (st >> 1) * 16 + swz / 64; C = (st & 1) * 32 + (swz % 64) / 2; }
__host__ __device__ __forceinline__ int perm32(int rho) { const int n = rho >> 4, i = rho & 15; return 8 * (i >> 2) + 4 * n + (i & 3); }

struct Unit { int pm, pn, koff, nt, part; };
struct Gemm { const bf16_t* A; const bf16_t* Bt; int M, N, K; };

struct StaticOrder {
    int nM, nN, nwg, G, c, ntk;
    __host__ __device__ void init(int M, int N, int G_, int c_, int K_ = 0) { nM = M / BM; nN = N / BM; nwg = nM * nN; G = G_; c = c_; ntk = K_ / BK; }
    __host__ __device__ bool next(int i, Unit& u) const {
        const long L = (long)i * G + c; if (L >= nwg) return false;
        int wgid = (int)L; { const int q = nwg / NXCD, r = nwg % NXCD, xcd = wgid % NXCD, off = wgid / NXCD; wgid = (xcd < r ? xcd * (q + 1) : r * (q + 1) + (xcd - r) * q) + off; }
        const int nig = WGM * nN, gid = wgid / nig, fm = gid * WGM, gsz = (nM - fm) < WGM ? (nM - fm) : WGM;
        u.pm = fm + ((wgid % nig) % gsz); u.pn = (wgid % nig) / gsz; u.koff = 0; u.nt = ntk; u.part = -1; return true;
    }
    __device__ __forceinline__ void a_ready(const Unit&) const {}
    __device__ __forceinline__ void done(const Unit&) const {}
};


template <class Epi, class Sched>
__device__ __forceinline__ void gemm_phase(PG8_LAS unsigned char* lds, const Gemm g, const Sched& S, const Epi& E) {
    const int tid = threadIdx.x, wid = __builtin_amdgcn_readfirstlane(tid >> 6), lane = tid & 63, wr = wid >> 2, wc = wid & 3, fr = lane & 15, fq = lane >> 4;
    const int K = g.K;
    unsigned voffA[2], voffB[2];
#pragma unroll
    for (int i = 0; i < 2; ++i) { int R, C; stage_rc(tid * 16 + i * 8192, R, C); const int Rb = Epi::PERM ? ((R & ~31) + perm32(R & 31)) : R;
        voffA[i] = (unsigned)(R * K + C) * 2u; voffB[i] = (unsigned)(Rb * K + C) * 2u; }
    const size_t kstep = (size_t)(BK * 2);
    const size_t hstep = (size_t)HALF * K * 2;
    const size_t tstep = 2 * hstep;
    const unsigned ldsw = (unsigned)wid * 1024u;
    const int aoff = lds_byte(wr * 64 + fr, fq * 8), boff = lds_byte(wc * 32 + fr, fq * 8);
#define PG8_SA(b, h) (((b) * 2 + (h)) * HTB)
#define PG8_SB(b, h) ((4 + (b) * 2 + (h)) * HTB)
#define PG8_STAGE(bufoff, gbase, voff) do { _Pragma("unroll") for (int _i = 0; _i < 2; ++_i) \
        __builtin_amdgcn_global_load_lds((const unsigned*)((const char*)(gbase) + (voff)[_i]), (PG8_LAS unsigned*)(lds + (bufoff) + ldsw + _i * 8192), 16, 0, 0); } while (0)
#define PG8_LDA(dst, b, h) do { _Pragma("unroll") for (int m = 0; m < 4; ++m) _Pragma("unroll") for (int k = 0; k < 2; ++k) dst[m][k] = *(const PG8_LAS bf16x8*)(lds + PG8_SA(b, h) + aoff + m * 2048 + k * 1024); } while (0)
#define PG8_LDB(dst, b, h) do { _Pragma("unroll") for (int n = 0; n < 2; ++n) _Pragma("unroll") for (int k = 0; k < 2; ++k) dst[n][k] = *(const PG8_LAS bf16x8*)(lds + PG8_SB(b, h) + boff + n * 2048 + k * 1024); } while (0)
#define PG8_MMA(ai, bj, At, Bt) do { __builtin_amdgcn_s_setprio(1); _Pragma("unroll") for (int m = 0; m < 4; ++m) _Pragma("unroll") for (int n = 0; n < 2; ++n) _Pragma("unroll") for (int k = 0; k < 2; ++k) \
        { if constexpr (Epi::I8) acc[ai][bj][m][n] = __builtin_bit_cast(f32x4, __builtin_amdgcn_mfma_i32_16x16x64_i8(__builtin_bit_cast(i32x4, Bt[n][k]), __builtin_bit_cast(i32x4, At[m][k]), __builtin_bit_cast(i32x4, acc[ai][bj][m][n]), 0, 0, 0)); \
          else acc[ai][bj][m][n] = __builtin_amdgcn_mfma_f32_16x16x32_bf16(Bt[n][k], At[m][k], acc[ai][bj][m][n], 0, 0, 0); } __builtin_amdgcn_s_setprio(0); } while (0)
#define PG8_WAIT_V(n) asm volatile("s_waitcnt vmcnt(" #n ")" ::: "memory")
#define PG8_WAIT_L(n) asm volatile("s_waitcnt lgkmcnt(" #n ")" ::: "memory")
#define PG8_BAR __builtin_amdgcn_s_barrier()
#define PG8_SCHED __builtin_amdgcn_sched_barrier(0)
    Unit cur, nxt; int ui = 0;
    if (!S.next(0, cur)) return;
    f32x4 acc[2][2][4][2];
#pragma unroll
    for (int a = 0; a < 2; ++a)
#pragma unroll
        for (int b = 0; b < 2; ++b)
#pragma unroll
            for (int m = 0; m < 4; ++m)
#pragma unroll
                for (int n = 0; n < 2; ++n) acc[a][b][m][n] = (f32x4){0.f, 0.f, 0.f, 0.f};
    bf16x8 At[4][2], B0[2][2], B1[2][2];
    const char* cA = (const char*)g.A + (size_t)cur.pm * tstep + cur.koff; const char* cB = (const char*)g.Bt + (size_t)cur.pn * tstep + cur.koff;
    S.a_ready(cur);
    PG8_STAGE(PG8_SB(0, 0), cB, voffB); PG8_STAGE(PG8_SB(0, 1), cB + hstep, voffB); PG8_STAGE(PG8_SA(0, 0), cA, voffA); PG8_STAGE(PG8_SA(0, 1), cA + hstep, voffA);
    if (wr == 1) PG8_BAR;
    PG8_WAIT_V(2); PG8_BAR;
    PG8_STAGE(PG8_SB(1, 0), cB + kstep, voffB); PG8_STAGE(PG8_SA(1, 0), cA + kstep, voffA); PG8_STAGE(PG8_SB(1, 1), cB + hstep + kstep, voffB);
    PG8_WAIT_V(6); PG8_BAR;
    for (;;) {
        const bool has_next = S.next(ui + 1, nxt);
        const char* nA = has_next ? (const char*)g.A + (size_t)nxt.pm * tstep + nxt.koff : cA; const char* nB = has_next ? (const char*)g.Bt + (size_t)nxt.pn * tstep + nxt.koff : cB;
        const int nt = cur.nt;
        for (int t = 0; t < nt; t += 2) {
            const bool last = (t == nt - 2);
            const char* a1 = cA + (size_t)(t + 1) * kstep;
            const char* a2 = last ? nA : cA + (size_t)(t + 2) * kstep; const char* b2 = last ? nB : cB + (size_t)(t + 2) * kstep;
            const char* a3 = a2 + kstep; const char* b3 = b2 + kstep;
            if (last && has_next) S.a_ready(nxt);
            PG8_LDB(B0, 0, 0); PG8_LDB(B1, 0, 1); PG8_SCHED; PG8_LDA(At, 0, 0); PG8_STAGE(PG8_SA(1, 1), a1 + hstep, voffA);
            PG8_WAIT_V(8); PG8_WAIT_L(0); PG8_BAR; PG8_MMA(0, 0, At, B0); PG8_MMA(0, 1, At, B1); PG8_BAR; PG8_SCHED;
            PG8_LDA(At, 0, 1); PG8_STAGE(PG8_SB(0, 0), b2, voffB); PG8_STAGE(PG8_SB(0, 1), b2 + hstep, voffB); PG8_STAGE(PG8_SA(0, 0), a2, voffA);
            PG8_WAIT_V(8); PG8_WAIT_L(0); PG8_BAR; PG8_MMA(1, 0, At, B0); PG8_MMA(1, 1, At, B1); PG8_BAR; PG8_SCHED;
            PG8_LDB(B0, 1, 0); PG8_LDB(B1, 1, 1); PG8_SCHED; PG8_LDA(At, 1, 0); PG8_STAGE(PG8_SA(0, 1), a2 + hstep, voffA);
            PG8_WAIT_V(8); PG8_WAIT_L(0); PG8_BAR; PG8_MMA(0, 0, At, B0); PG8_MMA(0, 1, At, B1); PG8_BAR; PG8_SCHED;
            PG8_LDA(At, 1, 1); PG8_STAGE(PG8_SB(1, 0), b3, voffB); PG8_STAGE(PG8_SB(1, 1), b3 + hstep, voffB); PG8_STAGE(PG8_SA(1, 0), a3, voffA);
            PG8_WAIT_V(8); PG8_WAIT_L(0); PG8_BAR; PG8_MMA(1, 0, At, B0); PG8_MMA(1, 1, At, B1); PG8_BAR; PG8_SCHED;
        }
        if (wr == 0) PG8_BAR;
        if constexpr (Epi::I8) E.prescale(acc, cur, wr, wc, fr, fq);
        if constexpr (!Epi::AFTER_DRAIN) { E(acc, cur, wr, wc, fr, fq); S.done(cur); }
        if (!has_next) break;
#pragma unroll
        for (int a = 0; a < 2; ++a)
#pragma unroll
            for (int b = 0; b < 2; ++b)
#pragma unroll
                for (int m = 0; m < 4; ++m)
#pragma unroll
                    for (int n = 0; n < 2; ++n) acc[a][b][m][n] = (f32x4){0.f, 0.f, 0.f, 0.f};
        cur = nxt; cA = nA; cB = nB; ++ui;
        if (wr == 1) PG8_BAR;
    }
    PG8_WAIT_V(0);
    PG8_BAR;
    if constexpr (Epi::AFTER_DRAIN) { E.fused(acc, cur, wr, wc, fr, fq, lds, wid, lane); S.done(cur); }
#undef PG8_SA
#undef PG8_SB
#undef PG8_STAGE
#undef PG8_LDA
#undef PG8_LDB
#undef PG8_MMA
#undef PG8_WAIT_V
#undef PG8_WAIT_L
#undef PG8_BAR
#undef PG8_SCHED
}

}

#ifndef INO_I8
#define INO_I8 0
#endif
#ifndef FFO1_I8
#define FFO1_I8 1
#endif
#ifndef FFO0_I8
#define FFO0_I8 1
#endif
#ifndef MIX_I8
#define MIX_I8 0
#endif
#ifndef FFN_I8
#define FFN_I8 1
#endif
struct Args { const float* in[29]; float* out; unsigned char* ws; int ph_lo, ph_hi; };
struct Ctx {
    const float* in[29]; float* out; unsigned char* ws; unsigned char* ar;
    LAS unsigned char* lds;
    int tid, lane, wave;
};
enum { I_X = 0, I_C, I_CTX, I_CCTX, I_WMOD, I_BMOD, I_WINE, I_MU, I_W0, I_W2, I_A0, I_A2, I_G2, I_KK, I_KA, I_RK, I_LNW, I_LNB, I_LAM, I_SUBLN,
       I_WINO, I_SINK, I_RDEC, I_WMIX, I_WFFI, I_CONVW, I_CONVB, I_WFFO, I_FNORM };

__device__ __forceinline__ void p_mod(const Ctx& c) {
    LAS float* sc = (LAS float*)c.lds;
    LAS float* red = sc + 5 * 4096;
    const int tid = c.tid, lane = c.lane, w = c.wave;
    for (int i = tid; i < 5 * 4096; i += NTHREADS) { const int r = i >> 12, k = i & 4095; const float v = r < 4 ? c.in[I_C][r * 4096 + k] : c.in[I_CCTX][k]; sc[i] = silu_f(v); }
    __syncthreads();
    float* MODP = (float*)(c.ar + AR_MODP);
    for (int u = blockIdx.x; u < 768; u += gridDim.x) {
        const int kp = u & 3, cg = (u >> 2) % 96, l = u / 384;
        const int k0 = kp * 1024 + w * 128;
        const float* wp = c.in[I_WMOD] + ((size_t)l * 4096 + k0) * 24576 + cg * 256 + lane * 4;
        f32x4 acc[5];
#pragma unroll
        for (int r = 0; r < 5; ++r) acc[r] = (f32x4){0.f, 0.f, 0.f, 0.f};
#pragma unroll 2
        for (int k = 0; k < 128; k += 4) {
            f32x4 wv[4];
#pragma unroll
            for (int j = 0; j < 4; ++j) wv[j] = __builtin_nontemporal_load((const f32x4*)(wp + (size_t)(k + j) * 24576));
#pragma unroll
            for (int r = 0; r < 5; ++r) { const f32x4 s4 = *(const LAS f32x4*)(sc + r * 4096 + k0 + k);
#pragma unroll
                for (int j = 0; j < 4; ++j) acc[r] += wv[j] * s4[j]; }
        }
#pragma unroll
        for (int r = 0; r < 5; ++r) *(LAS f32x4*)(red + (w * 5 + r) * 256 + lane * 4) = acc[r];
        __syncthreads();
        for (int idx = tid; idx < 5 * 256; idx += NTHREADS) { const int r = idx >> 8, col = idx & 255; float s = 0.f;
#pragma unroll
            for (int q = 0; q < 8; ++q) s += red[(q * 5 + r) * 256 + col];
            if (kp == 0) s += c.in[I_BMOD][l * 24576 + cg * 256 + col];
            MODP[(size_t)kp * MOD_FLOATS + ((size_t)l * 5 + r) * 24576 + cg * 256 + col] = s; }
        __syncthreads();
    }
}

__device__ __forceinline__ void p_mod_finalize(const Ctx& c) {
    const float* MODP = (const float*)(c.ar + AR_MODP); float* MOD = (float*)(c.ws + WS_MOD);
    for (size_t i = ((size_t)blockIdx.x * NTHREADS + c.tid) * 4; i < MOD_FLOATS; i += (size_t)gridDim.x * NTHREADS * 4)
        *(f32x4*)(MOD + i) = (*(const f32x4*)(MODP + i) + *(const f32x4*)(MODP + MOD_FLOATS + i)) + (*(const f32x4*)(MODP + 2 * MOD_FLOATS + i) + *(const f32x4*)(MODP + 3 * MOD_FLOATS + i));
}
DI int perm64(int m) { const int within = m & 255, rho = within & 127; return (m & ~255) + (rho >> 5) * 64 + (within >> 7) * 32 + (rho & 31); }
DI int perm128(int m) { const int within = m & 255, rho = within & 127; return (m & ~255) + (rho >> 6) * 128 + (within >> 7) * 64 + (rho & 63); }
DI int in_odd_src(int n) { return n < 2304 ? perm64(n) : (n < 2560 ? n : (n < 4608 ? 2560 + perm128(n - 2560) : n)); }
__device__ __forceinline__ int p_convert_job(const Ctx& c, const float* __restrict__ src, int src_ld, int K, int n0, int ncnt, bf16_t* __restrict__ dst, int dn0, int base, int nperm = 0) {
    LAS unsigned short* T = (LAS unsigned short*)c.lds;
    const int tid = c.tid, tk = K / 64, tn = ncnt / 128, nt = tk * tn, G = (int)gridDim.x;
    int first = (int)blockIdx.x - (base % G); if (first < 0) first += G;
    const int kr = tid >> 3, c16 = (tid & 7) * 16, wn = tid >> 2, k16 = (tid & 3) * 16;
    f32x4 v[4], vn[4];
    if (first < nt) { const int nn = (first / tk) * 128 + c16; const float* p = src + (size_t)((first % tk) * 64 + kr) * src_ld + n0 + (nn < nperm ? perm64(nn) : nn);
#pragma unroll
        for (int i = 0; i < 4; ++i) v[i] = __builtin_nontemporal_load((const f32x4*)(p + 4 * i)); }
    for (int t = first; t < nt; t += G) {
        const int t2 = t + G;
        if (t2 < nt) { const int nn = (t2 / tk) * 128 + c16; const float* p = src + (size_t)((t2 % tk) * 64 + kr) * src_ld + n0 + (nn < nperm ? perm64(nn) : nn);
#pragma unroll
            for (int i = 0; i < 4; ++i) vn[i] = __builtin_nontemporal_load((const f32x4*)(p + 4 * i)); }
#pragma unroll
        for (int i = 0; i < 4; ++i)
#pragma unroll
            for (int j = 0; j < 4; ++j) T[(c16 + 4 * i + j) * 72 + kr] = f2bf(v[i][j]);
        __syncthreads();
        { const u32x4 a = *(const LAS u32x4*)(T + wn * 72 + k16), b = *(const LAS u32x4*)(T + wn * 72 + k16 + 8);
          bf16_t* q = dst + (size_t)(dn0 + (t / tk) * 128 + wn) * K + (t % tk) * 64 + k16;
          *(u32x4*)q = a; *(u32x4*)(q + 8) = b; }
        __syncthreads();
#pragma unroll
        for (int i = 0; i < 4; ++i) v[i] = vn[i];
    }
    return base + nt;
}
DI void conv_wave_tile(const float* __restrict__ src, int src_ld, int k0, int nsrc, int n0, bf16_t* __restrict__ dst, int K, int lane) {
    float v[32];
    const float* p = src + (size_t)k0 * src_ld + nsrc;
#pragma unroll
    for (int kk = 0; kk < 32; ++kk) v[kk] = __builtin_nontemporal_load(p + (size_t)kk * src_ld);
    bf16_t* q = dst + (size_t)(n0 + lane) * K + k0;
#pragma unroll
    for (int g = 0; g < 4; ++g) { u32x4 w; w.x = pk_bf16(v[8 * g], v[8 * g + 1]); w.y = pk_bf16(v[8 * g + 2], v[8 * g + 3]); w.z = pk_bf16(v[8 * g + 4], v[8 * g + 5]); w.w = pk_bf16(v[8 * g + 6], v[8 * g + 7]);
        *(u32x4*)(q + 8 * g) = w; }
}
DI unsigned pk_i8x4(float a, float b, float c2, float d) { const int ia = (int)rintf(a), ib = (int)rintf(b), ic = (int)rintf(c2), id = (int)rintf(d);
    return ((unsigned)ia & 255u) | (((unsigned)ib & 255u) << 8) | (((unsigned)ic & 255u) << 16) | ((unsigned)id << 24); }
template <class T> DI void fwht32(T (&v)[32]) {
#pragma unroll
    for (int h = 1; h < 32; h <<= 1)
#pragma unroll
        for (int i = 0; i < 32; i += 2 * h)
#pragma unroll
            for (int j = i; j < i + h; ++j) { const T a = v[j], b = v[j + h]; v[j] = a + b; v[j + h] = a - b; }
}
DI unsigned* i8_cmax(const Ctx& c, int off) { return (unsigned*)(c.ws + WS_CTL + CTL_CMAX) + off; }
DI float* i8_cs(const Ctx& c, int off) { return (float*)(c.ws + WS_CS) + off; }
DI void conv_wave_tile_q8(const float* __restrict__ src, int src_ld, int k0, int nsrc, int n0, unsigned char* __restrict__ dst, int K, int lane, const unsigned* cmax, float* cs) {
    float v[32];
    const float* p = src + (size_t)k0 * src_ld + nsrc;
#pragma unroll
    for (int kk = 0; kk < 32; ++kk) v[kk] = __builtin_nontemporal_load(p + (size_t)kk * src_ld);
    const float cm = __uint_as_float(cmax[nsrc]); const float qs = cm > 0.f ? 127.0f / cm : 0.f;
    if (k0 == 0) cs[n0 + lane] = cm * (1.0f / 127.0f);
    fwht32(v);
    unsigned char* q = dst + (size_t)(n0 + lane) * K + k0;
#pragma unroll
    for (int g = 0; g < 2; ++g) { u32x4 w;
#pragma unroll
        for (int j = 0; j < 4; ++j) w[j] = pk_i8x4(v[16 * g + 4 * j] * 0.03125f * qs, v[16 * g + 4 * j + 1] * 0.03125f * qs, v[16 * g + 4 * j + 2] * 0.03125f * qs, v[16 * g + 4 * j + 3] * 0.03125f * qs);
        *(u32x4*)(q + 16 * g) = w; }
}
struct CmxDeal { int worker, nworkers, lo, hi; };
__device__ __forceinline__ int p_wcolmax_job(const Ctx& c, const float* __restrict__ src0, int ld, int K, unsigned* cmax, int base, const CmxDeal dl) {
    LAS float* red = (LAS float*)c.lds;
    const int ncg = (ld + 255) / 256, nko = (K + 1023) / 1024, nitem = ncg * nko;
    int g0 = dl.lo + dl.worker; if (g0 < base) g0 += ((base - g0 + dl.nworkers - 1) / dl.nworkers) * dl.nworkers;
    const int gend = dl.hi < base + nitem ? dl.hi : base + nitem;
#pragma unroll 1
    for (int g = g0; g < gend; g += dl.nworkers) { const int it = g - base;
        const int cg = it % ncg, ko = it / ncg, col = cg * 256 + c.lane * 4;
        f32x4 mx = {0.f, 0.f, 0.f, 0.f};
        if (col < ld && ko * 1024 + c.wave * 128 < K) {
#pragma unroll 1
            for (int t = 0; t < 4; ++t) {
                f32x4 v[32]; const float* p = src0 + (size_t)(ko * 1024 + c.wave * 128 + t * 32) * ld + col;
#pragma unroll
                for (int kk = 0; kk < 32; ++kk) v[kk] = __builtin_nontemporal_load((const f32x4*)(p + (size_t)kk * ld));
                fwht32(v);
#pragma unroll
                for (int kk = 0; kk < 32; ++kk)
#pragma unroll
                    for (int j = 0; j < 4; ++j) mx[j] = fmaxf(mx[j], fabsf(v[kk][j]));
            }
        }
        *(LAS f32x4*)(red + c.wave * 256 + c.lane * 4) = mx;
        __syncthreads();
        if (c.tid < 256) { float m = red[c.tid];
#pragma unroll
            for (int w = 1; w < 8; ++w) m = fmaxf(m, red[w * 256 + c.tid]);
            const int cc = cg * 256 + c.tid; if (cc < ld) atomicMax(cmax + cc, __float_as_uint(m * 0.03125f)); }
        __syncthreads();
    }
    return base + nitem;
}
constexpr int CMX_TOTAL = (FFN_I8 ? 2 * (2 * DFF / 256) * (D / 1024) : 0) + (INO_I8 ? (NO / 256) * (D / 1024) : 0) + ((FFO0_I8 ? 1 : 0) + (FFO1_I8 ? 1 : 0)) * (D / 256) * ((DFF + 1023) / 1024) + (MIX_I8 ? 2 * (D / 256) * (D / 1024) : 0);
__device__ __forceinline__ void p_wcolmax(const Ctx& c, const CmxDeal dl) {
    int base = 0;
    __syncthreads();
    if (FFN_I8) { base = p_wcolmax_job(c, c.in[I_WFFI], 2 * DFF, D, i8_cmax(c, CM_FFI), base, dl); base = p_wcolmax_job(c, c.in[I_WFFI] + (size_t)D * 2 * DFF, 2 * DFF, D, i8_cmax(c, CM_FFI + 2 * DFF), base, dl); }
    if (INO_I8) base = p_wcolmax_job(c, c.in[I_WINO], NO, D, i8_cmax(c, CM_INO), base, dl);
    if (FFO0_I8) base = p_wcolmax_job(c, c.in[I_WFFO], D, DFF, i8_cmax(c, CM_FFO0), base, dl);
    if (FFO1_I8) base = p_wcolmax_job(c, c.in[I_WFFO] + (size_t)DFF * D, D, DFF, i8_cmax(c, CM_FFO1), base, dl);
    if (MIX_I8) { base = p_wcolmax_job(c, c.in[I_WMIX], D, D, i8_cmax(c, CM_MIX), base, dl); base = p_wcolmax_job(c, c.in[I_WMIX] + (size_t)D * D, D, D, i8_cmax(c, CM_MIX + D), base, dl); }
}
#ifndef CMX_P0
#define CMX_P0 624
#endif
DI int cmx_ns(int G) { return G == 256 ? 8 : 0; }
DI int cmx_p0(int G) { return cmx_ns(G) ? (CMX_P0 < CMX_TOTAL ? CMX_P0 : CMX_TOTAL) : CMX_TOTAL; }
__device__ __forceinline__ void p_weights_layer0(const Ctx& c) {
    bf16_t* W = (bf16_t*)(c.ws + WS_W);
    {   constexpr int T_IN = (4096 / 32) * ((COLS_A + COLS_B) / 64), T_MIX = (4096 / 32) * (4096 / 64), T_L96 = 3 * (2048 / 64), T_LG = 8 * (2048 / 64);
        constexpr int E0 = T_IN, E1 = E0, E2 = E1 + 4 * T_L96, E3 = E2 + T_LG;
        bf16_t* L = (bf16_t*)((unsigned char*)W + W_LORA);
        for (int t = blockIdx.x * 8 + c.wave; t < E3; t += gridDim.x * 8) {
            if (t < E0) { const int kt = t & 127, g = t >> 7, n = g * 64 + c.lane;
                const int nsrc = n < COLS_A ? n : COLS_A + (n - COLS_A < 4096 ? perm64(n - COLS_A) : n - COLS_A);
                conv_wave_tile(c.in[I_WINE], COLS_A + COLS_B, kt * 32, nsrc, n < COLS_A ? g * 64 : g * 64 + (COLS_A_PAD - COLS_A), (bf16_t*)((unsigned char*)W + W_IN), 4096, c.lane); }
            else if (t < E1) { const int tl = t - E0, kt = tl & 127, g = tl >> 7;
                conv_wave_tile(c.in[I_WMIX], 4096, kt * 32, g * 64 + c.lane, g * 64, (bf16_t*)((unsigned char*)W + W_MIX), 4096, c.lane); }
            else if (t < E2) { const int tl = t - E1, type = tl / T_L96, r2 = tl % T_L96, kt = r2 % 3, g = r2 / 3;
                const float* src = (type < 2 ? c.in[I_W2] + (size_t)type * 96 * 2048 : c.in[I_A2] + (size_t)(type - 2) * 96 * 2048);
                conv_wave_tile(src, 2048, kt * 32, g * 64 + c.lane, g * 64, L + (size_t)type * 2048 * LORA_K + type * LORA_KU, LORA_K, c.lane); }
            else { const int tl = t - E2, kt = tl & 7, g = tl >> 3;
                conv_wave_tile(c.in[I_G2], 2048, kt * 32, g * 64 + c.lane, g * 64, L + (size_t)4 * 2048 * LORA_K + 4 * LORA_KU, LORA_K, c.lane); }
        }
    }
    const size_t gtid = (size_t)blockIdx.x * NTHREADS + c.tid, gn = (size_t)gridDim.x * NTHREADS;
    { u32x4* z = (u32x4*)((unsigned char*)W + W_IN + (size_t)COLS_A * 4096 * 2); const size_t n16 = (size_t)(COLS_A_PAD - COLS_A) * 4096 * 2 / 16;
      for (size_t i = gtid; i < n16; i += gn) z[i] = (u32x4){0u, 0u, 0u, 0u}; }
    { bf16_t* L = (bf16_t*)((unsigned char*)W + W_LORA);
      for (size_t i = gtid; i < (size_t)4 * 2048 * 20; i += gn) { const int n = (int)(i / 20), ch = (int)(i % 20), type = n >> 11;
          *(u32x4*)(L + (size_t)n * LORA_K + type * LORA_KU + 96 + ch * 8) = (u32x4){0u, 0u, 0u, 0u}; } }
    { float* axc = (float*)(c.ws + WS_AXC); float* axs = (float*)(c.ws + WS_AXS);
      for (size_t i = gtid; i < (size_t)SEQ * 32; i += gn) { const int pos = (int)(i >> 5), a = (int)(i & 31), q = a & 15;
          const float inv = powf(10000.0f, -(float)q / 16.0f); const float p = (a < 16) ? (float)(pos >> 6) : (float)(pos & 63);
          float sn, cs; sincosf(p * inv, &sn, &cs); axc[i] = cs; axs[i] = sn; } }
    { float* rtc = (float*)(c.ws + WS_RTC); float* rts = (float*)(c.ws + WS_RTS);
      for (size_t i = gtid; i < (size_t)NKEY * 64; i += gn) { const int pos = (int)(i >> 6), a = (int)(i & 63);
          const float t = (float)a / 63.0f; const float inv = powf(10000.0f, -t);
          float sn, cs; sincosf((float)pos * inv, &sn, &cs); rtc[i] = cs; rts[i] = sn; } }
    if (gtid == 0) { const float* lv = c.in[I_LAM]; float s01 = 0.f, s23 = 0.f;
        for (int i = 0; i < 64; ++i) { s01 += lv[i] * lv[64 + i]; s23 += lv[128 + i] * lv[192 + i]; }
        ((float*)(c.ws + WS_SCAL))[0] = expf(s01) - expf(s23) + 0.2f; }
}
constexpr int CONV_SPLIT = 128192;
__device__ __forceinline__ void p_convert_deferred(const Ctx& c, int worker, int nworkers, int tlo, int thi) {
    unsigned char* W = c.ws + WS_W; unsigned char* W1 = c.ws + WS_W1;
    constexpr int T_FFI = (4096 / 32) * (2 * DFF / 64), T_FFO = (DFF / 32) * (4096 / 64), T_IN1 = (4096 / 32) * (NO / 64), T_MIX = (4096 / 32) * (4096 / 64);
    constexpr int EM = T_MIX, E0 = EM + T_FFI, E1 = E0 + T_FFO, E2 = E1 + T_IN1, E3 = E2 + T_MIX, E4 = E3 + T_FFI, E5 = E4 + T_FFO;
    const int tend = thi < E5 ? thi : E5;
    for (int t = tlo + worker; t < tend; t += nworkers) {
        const float* src; int ld, K, tl; bf16_t* dst; int mixl = -1;
        if (t < EM) { src = c.in[I_WMIX]; ld = 4096; K = 4096; tl = t; dst = (bf16_t*)(W + W_MIX); mixl = 0; }
        else if (t < E0) { src = c.in[I_WFFI]; ld = 2 * DFF; K = 4096; tl = t - EM; dst = (bf16_t*)(W + W_FFI); }
        else if (t < E1) { src = c.in[I_WFFO]; ld = 4096; K = DFF; tl = t - E0; dst = (bf16_t*)(W + W_FFO); mixl = 3; }
        else if (t < E2) { src = c.in[I_WINO]; ld = NO; K = 4096; tl = t - E1; dst = (bf16_t*)(W + W_IN); }
        else if (t < E3) { src = c.in[I_WMIX] + (size_t)4096 * 4096; ld = 4096; K = 4096; tl = t - E2; dst = (bf16_t*)(W1 + W1_MIX); mixl = 1; }
        else if (t < E4) { src = c.in[I_WFFI] + (size_t)4096 * 2 * DFF; ld = 2 * DFF; K = 4096; tl = t - E3; dst = (bf16_t*)(W1 + W1_FFI); }
        else { src = c.in[I_WFFO] + (size_t)DFF * 4096; ld = 4096; K = DFF; tl = t - E4; dst = (bf16_t*)(W1 + W1_FFO); mixl = 2; }
        const int tk = K / 32, kt = tl % tk, ntile = tl / tk;
        int ncol = ntile * 64;
        if (ld == 2 * DFF) { const int tile = ncol >> 8, within = ncol & 255; ncol = within < 128 ? 128 * tile + within : DFF + 128 * tile + (within - 128); }
        const int nsrc = (ld == NO) ? in_odd_src(ntile * 64 + c.lane) : ncol + c.lane;
        if (FFN_I8 && ld == 2 * DFF) { const int off = CM_FFI + (t < E0 ? 0 : 2 * DFF); conv_wave_tile_q8(src, ld, kt * 32, nsrc, ntile * 64, (unsigned char*)dst, K, c.lane, i8_cmax(c, off), i8_cs(c, off)); }
        else if (FFO0_I8 && mixl == 3) conv_wave_tile_q8(src, ld, kt * 32, nsrc, ntile * 64, (unsigned char*)dst, K, c.lane, i8_cmax(c, CM_FFO0), i8_cs(c, CM_FFO0));
        else if (FFO1_I8 && mixl == 2) conv_wave_tile_q8(src, ld, kt * 32, nsrc, ntile * 64, (unsigned char*)dst, K, c.lane, i8_cmax(c, CM_FFO1), i8_cs(c, CM_FFO1));
        else if (MIX_I8 && mixl >= 0 && mixl < 2) conv_wave_tile_q8(src, ld, kt * 32, nsrc, ntile * 64, (unsigned char*)dst, K, c.lane, i8_cmax(c, CM_MIX + mixl * D), i8_cs(c, CM_MIX + mixl * D));
        else if (INO_I8 && ld == NO) conv_wave_tile_q8(src, ld, kt * 32, nsrc, ntile * 64, (unsigned char*)dst, K, c.lane, i8_cmax(c, CM_INO), i8_cs(c, CM_INO));
        else conv_wave_tile(src, ld, kt * 32, nsrc, ntile * 64, dst, K, c.lane);
    }
}

template <class TS>
__device__ __forceinline__ void p_ctx_fix(const Ctx& c, const TS* srcc, const float* gate, const float* slab, res_t* H) {
    for (int row = blockIdx.x * 8 + c.wave; row < TT; row += gridDim.x * 8) {
        if (row < TL) continue;
        const size_t ro = (size_t)(row - TL) * D;
#pragma unroll 4
        for (int i = 0; i < 16; ++i) { const int col = i * 256 + c.lane * 4;
            const f32x4 s4 = (*(const f32x4*)(slab + ro + col) + *(const f32x4*)(slab + (size_t)TC * D + ro + col)) + (*(const f32x4*)(slab + (size_t)2 * TC * D + ro + col) + *(const f32x4*)(slab + (size_t)3 * TC * D + ro + col));
            st4(H + (size_t)row * D + col, ld4(srcc + ro + col) + *(const f32x4*)(gate + col) * s4); }
    }
}
template <int NPARTS = 1, bool Q8 = false, class TS = float>
__device__ __forceinline__ void p_norm_mod(const Ctx& c, const TS* hl, const TS* hc, int nrows, const float* mod, int shift_chunk, int scale_chunk) {
    bf16_t* XN = (bf16_t*)(c.ws + WS_XN);
    for (int row = blockIdx.x * 8 + c.wave; row < nrows; row += gridDim.x * 8) {
        const TS* src = row < TL ? hl + (size_t)row * D : hc + (size_t)(row - TL) * D;
        f32x4 v[16]; float ss = 0.f;
#pragma unroll
        for (int i = 0; i < 16; ++i) { v[i] = ld4(src + i * 256 + c.lane * 4); ss += v[i][0] * v[i][0] + v[i][1] * v[i][1] + v[i][2] * v[i][2] + v[i][3] * v[i][3]; }
        ss = wave_sum(ss);
        const float rs = rsqrtf(ss * (1.0f / 4096.0f) + 1e-6f);
        const float* mp = mod + (size_t)row_modidx(row) * 24576;
        bf16_t* dst = XN + (size_t)row * D;
        if constexpr (Q8) {
            float mx = 0.f;
#pragma unroll
            for (int i = 0; i < 16; ++i) { const int col = i * 256 + c.lane * 4;
                const f32x4 sh = *(const f32x4*)(mp + shift_chunk * 4096 + col), sc = *(const f32x4*)(mp + scale_chunk * 4096 + col);
#pragma unroll
                for (int j = 0; j < 4; ++j) v[i][j] = v[i][j] * rs * (1.f + sc[j]) + sh[j];
                { const float a0 = v[i][0] + v[i][1], a1 = v[i][0] - v[i][1], a2 = v[i][2] + v[i][3], a3 = v[i][2] - v[i][3];
                  v[i][0] = a0 + a2; v[i][1] = a1 + a3; v[i][2] = a0 - a2; v[i][3] = a1 - a3; }
#pragma unroll
                for (int j = 0; j < 4; ++j) { float x = v[i][j];
                    { const float t = __int_as_float(__builtin_amdgcn_update_dpp(0, __float_as_int(x), 0xB1, 0xF, 0xF, false)); x = (c.lane & 1) ? t - x : x + t; }
                    { const float t = __int_as_float(__builtin_amdgcn_update_dpp(0, __float_as_int(x), 0x4E, 0xF, 0xF, false)); x = (c.lane & 2) ? t - x : x + t; }
                    { const float t = __int_as_float(__builtin_amdgcn_ds_swizzle(__float_as_int(x), 0x101F)); x = (c.lane & 4) ? t - x : x + t; }
                    v[i][j] = x; mx = fmaxf(mx, fabsf(x)); } }
#pragma unroll
            for (int o = 32; o >= 1; o >>= 1) mx = fmaxf(mx, __shfl_xor(mx, o));
            const float qs = mx > 0.f ? 127.0f / mx : 0.f;
            unsigned char* d8 = (unsigned char*)XN + (size_t)row * D;
#pragma unroll
            for (int i = 0; i < 16; ++i) *(unsigned*)(d8 + i * 256 + c.lane * 4) = pk_i8x4(v[i][0] * qs, v[i][1] * qs, v[i][2] * qs, v[i][3] * qs);
            if (c.lane == 0) ((float*)(c.ws + WS_XN + (size_t)TT * D))[row] = mx * (1.0f / 127.0f);
            continue;
        }
#pragma unroll
        for (int i = 0; i < 16; ++i) { const int col = i * 256 + c.lane * 4;
            f32x4 sh = *(const f32x4*)(mp + shift_chunk * 4096 + col), sc = *(const f32x4*)(mp + scale_chunk * 4096 + col);
            if constexpr (NPARTS == 4) {
                sh = (sh + *(const f32x4*)(mp + MOD_FLOATS + shift_chunk * 4096 + col)) + (*(const f32x4*)(mp + 2 * MOD_FLOATS + shift_chunk * 4096 + col) + *(const f32x4*)(mp + 3 * MOD_FLOATS + shift_chunk * 4096 + col));
                sc = (sc + *(const f32x4*)(mp + MOD_FLOATS + scale_chunk * 4096 + col)) + (*(const f32x4*)(mp + 2 * MOD_FLOATS + scale_chunk * 4096 + col) + *(const f32x4*)(mp + 3 * MOD_FLOATS + scale_chunk * 4096 + col)); }
            u32x2 w; w.x = pk_bf16(v[i][0] * rs * (1.f + sc[0]) + sh[0], v[i][1] * rs * (1.f + sc[1]) + sh[1]);
            w.y = pk_bf16(v[i][2] * rs * (1.f + sc[2]) + sh[2], v[i][3] * rs * (1.f + sc[3]) + sh[3]);
            *(u32x2*)(dst + col) = w; }
    }
}
__device__ __forceinline__ void p_final_norm(const Ctx& c) {
    const res_t* H = (const res_t*)(c.ws + WS_H);
    for (int row = blockIdx.x * 8 + c.wave; row < TL; row += gridDim.x * 8) {
        const res_t* src = H + (size_t)row * D;
        f32x4 v[16]; float ss = 0.f;
#pragma unroll
        for (int i = 0; i < 16; ++i) { v[i] = ld4(src + i * 256 + c.lane * 4); ss += v[i][0] * v[i][0] + v[i][1] * v[i][1] + v[i][2] * v[i][2] + v[i][3] * v[i][3]; }
        ss = wave_sum(ss);
        const float rs = rsqrtf(ss * (1.0f / 4096.0f) + 1e-6f);
        float* dst = c.out + (size_t)row * D;
#pragma unroll
        for (int i = 0; i < 16; ++i) { const int col = i * 256 + c.lane * 4; const f32x4 g = *(const f32x4*)(c.in[I_FNORM] + col);
            *(f32x4*)(dst + col) = v[i] * rs * g; }
    }
}

DI void rope_store(const f32x4 (&acc)[2][2][4][2], int ai, int m, const float* tc, const float* ts, bool rot, float scale, bf16_t* o1p, bf16_t* o2p) {
    float o1[8], o2[8];
#pragma unroll
    for (int n = 0; n < 2; ++n) { f32x4 cs = {1.f, 1.f, 1.f, 1.f}, sn = {0.f, 0.f, 0.f, 0.f};
        if (rot) { cs = *(const f32x4*)(tc + 4 * n); sn = *(const f32x4*)(ts + 4 * n); }
#pragma unroll
        for (int e = 0; e < 4; ++e) { const float x1 = acc[ai][0][m][n][e], x2 = acc[ai][1][m][n][e];
            o1[4 * n + e] = (x1 * cs[e] - x2 * sn[e]) * scale; o2[4 * n + e] = (x2 * cs[e] + x1 * sn[e]) * scale; } }
    u32x4 w1, w2; w1.x = pk_bf16(o1[0], o1[1]); w1.y = pk_bf16(o1[2], o1[3]); w1.z = pk_bf16(o1[4], o1[5]); w1.w = pk_bf16(o1[6], o1[7]);
    w2.x = pk_bf16(o2[0], o2[1]); w2.y = pk_bf16(o2[2], o2[3]); w2.z = pk_bf16(o2[4], o2[5]); w2.w = pk_bf16(o2[6], o2[7]);
    *(u32x4*)o1p = w1; *(u32x4*)o2p = w2;
}
DI void plain_store(const f32x4 (&acc)[2][2][4][2], int ai, int m, bf16_t* rowp) {
#pragma unroll
    for (int bj = 0; bj < 2; ++bj) { const f32x4 v0 = acc[ai][bj][m][0], v1 = acc[ai][bj][m][1];
        u32x4 w; w.x = pk_bf16(v0[0], v0[1]); w.y = pk_bf16(v0[2], v0[3]); w.z = pk_bf16(v1[0], v1[1]); w.w = pk_bf16(v1[2], v1[3]);
        *(u32x4*)(rowp + bj * 128) = w; }
}
DI void i8_prescale(f32x4 (&acc)[2][2][4][2], const float* SA, const float* CS, const pg8::Unit& u, int wr, int wc, int fr, int fq) {
    f32x4 cs[2][2];
#pragma unroll
    for (int bj = 0; bj < 2; ++bj)
#pragma unroll
        for (int n = 0; n < 2; ++n) cs[bj][n] = *(const f32x4*)(CS + u.pn * 256 + bj * 128 + wc * 32 + 8 * fq + 4 * n);
#pragma unroll
    for (int ai = 0; ai < 2; ++ai)
#pragma unroll
        for (int m = 0; m < 4; ++m) { const float s = SA[u.pm * 256 + ai * 128 + wr * 64 + 16 * m + fr];
#pragma unroll
            for (int bj = 0; bj < 2; ++bj)
#pragma unroll
                for (int n = 0; n < 2; ++n)
#pragma unroll
                    for (int e = 0; e < 4; ++e) acc[ai][bj][m][n][e] = (float)__float_as_int(acc[ai][bj][m][n][e]) * (s * cs[bj][n][e]); }
}
DI void i8_prescale_np(f32x4 (&acc)[2][2][4][2], const float* SA, const float* CS, const pg8::Unit& u, int wr, int wc, int fr, int fq) {
    f32x4 cs[2][2];
#pragma unroll
    for (int bj = 0; bj < 2; ++bj)
#pragma unroll
        for (int n = 0; n < 2; ++n) cs[bj][n] = *(const f32x4*)(CS + u.pn * 256 + wc * 32 + 4 * fq + bj * 128 + n * 16);
#pragma unroll
    for (int ai = 0; ai < 2; ++ai)
#pragma unroll
        for (int m = 0; m < 4; ++m) { const float s = SA[u.pm * 256 + ai * 128 + wr * 64 + 16 * m + fr];
#pragma unroll
            for (int bj = 0; bj < 2; ++bj)
#pragma unroll
                for (int n = 0; n < 2; ++n)
#pragma unroll
                    for (int e = 0; e < 4; ++e) acc[ai][bj][m][n][e] = (float)__float_as_int(acc[ai][bj][m][n][e]) * (s * cs[bj][n][e]); }
}
struct EpiInEven {
    static constexpr bool PERM = true, AFTER_DRAIN = false, I8 = false;
    bf16_t* PA; bf16_t* PB; const float* axc; const float* axs;
    DI void operator()(const f32x4 (&acc)[2][2][4][2], const pg8::Unit& u, int wr, int wc, int fr, int fq) const {
        const int row0 = u.pm * 256 + wr * 64 + fr, tq = u.pn - COLS_A_PAD / 256;
#pragma unroll
        for (int ai = 0; ai < 2; ++ai)
#pragma unroll
            for (int m = 0; m < 4; ++m) { const int row = row0 + ai * 128 + m * 16;
                if (tq < 0) plain_store(acc, ai, m, PA + (size_t)row * COLS_A_PAD + u.pn * 256 + wc * 32 + 8 * fq);
                else if (tq >= 16) plain_store(acc, ai, m, PB + (size_t)row * COLS_B + tq * 256 + wc * 32 + 8 * fq);
                else { const int pos = row & 4095; bf16_t* o = PB + (size_t)row * COLS_B + tq * 256 + wc * 64 + 8 * fq;
                    rope_store(acc, ai, m, axc + pos * 32 + 8 * fq, axs + pos * 32 + 8 * fq, row < TL, tq < 8 ? 0.18033688011112042f : 1.0f, o, o + 32); } }
    }
};
struct EpiInOdd {
    static constexpr bool PERM = true, AFTER_DRAIN = false, I8 = (INO_I8 != 0);
    bf16_t* P1; const float* axc; const float* axs; const float* rtc; const float* rts; const float* SA; const float* CS;
    DI void prescale(f32x4 (&acc)[2][2][4][2], const pg8::Unit& u, int wr, int wc, int fr, int fq) const { i8_prescale(acc, SA, CS, u, wr, wc, fr, fq); }
    DI void operator()(const f32x4 (&acc)[2][2][4][2], const pg8::Unit& u, int wr, int wc, int fr, int fq) const {
        const int row0 = u.pm * 256 + wr * 64 + fr, pn = u.pn;
#pragma unroll
        for (int ai = 0; ai < 2; ++ai)
#pragma unroll
            for (int m = 0; m < 4; ++m) { const int row = row0 + ai * 128 + m * 16; const bool lat = row < TL; const int pos = lat ? (row & 4095) : ((row - TL) & 255);
                if (pn < 9) { bf16_t* o = P1 + (size_t)row * NO + pn * 256 + wc * 64 + 8 * fq;
                    rope_store(acc, ai, m, axc + pos * 32 + 8 * fq, axs + pos * 32 + 8 * fq, lat, pn < 8 ? 0.18033688011112042f : 1.0f, o, o + 32); }
                else if (pn >= 10 && pn < 18) { const int rp = lat ? CTXL + pos : pos, i0 = 32 * (wc & 1) + 8 * fq; bf16_t* o = P1 + (size_t)row * NO + pn * 256 + (wc >> 1) * 128 + i0;
                    rope_store(acc, ai, m, rtc + rp * 64 + i0, rts + rp * 64 + i0, true, pn < 14 ? 0.08838834764831845f : 1.0f, o, o + 64); }
                else plain_store(acc, ai, m, P1 + (size_t)row * NO + pn * 256 + wc * 32 + 8 * fq); }
    }
};
struct CtxSplitOrder {
    int G, c, nNn, ntk;
    __device__ void init(int N, int G_, int c_, int K_) { G = G_; c = c_; nNn = N / 256; ntk = K_ / 64; }
    __device__ bool next(int i, pg8::Unit& u) const {
        const long L = (long)i * G + c; if (L >= 4 * nNn * 4) return false;
        const int j = (int)L, part = j & 3, tile = j >> 2; u.pm = 64 + (tile & 3); u.pn = tile >> 2; u.part = part;
        const int s0 = 2 * ((part * ntk) / 8), s1 = 2 * (((part + 1) * ntk) / 8); u.koff = s0 * 128; u.nt = s1 - s0; return true; }
    __device__ __forceinline__ void a_ready(const pg8::Unit&) const {}
    __device__ __forceinline__ void done(const pg8::Unit&) const {}
};
template <bool Q8>
struct EpiSlabT {
    static constexpr bool PERM = false, AFTER_DRAIN = false, I8 = Q8;
    float* slab; const float* SA; const float* CS;
    DI void prescale(f32x4 (&acc)[2][2][4][2], const pg8::Unit& u, int wr, int wc, int fr, int fq) const { i8_prescale_np(acc, SA, CS, u, wr, wc, fr, fq); }
    DI void operator()(const f32x4 (&acc)[2][2][4][2], const pg8::Unit& u, int wr, int wc, int fr, int fq) const {
        const int row0 = u.pm * 256 + wr * 64 + fr, col0 = u.pn * 256 + wc * 32 + 4 * fq;
        float* sb = slab + ((size_t)u.part * TC + (row0 - TL)) * D + col0;
#pragma unroll
        for (int ai = 0; ai < 2; ++ai)
#pragma unroll
            for (int m = 0; m < 4; ++m)
#pragma unroll
                for (int bj = 0; bj < 2; ++bj)
#pragma unroll
                    for (int n = 0; n < 2; ++n) *(f32x4*)(sb + (size_t)(ai * 128 + m * 16) * D + bj * 128 + n * 16) = acc[ai][bj][m][n];
    }
};
struct LatThenCtxOrder : pg8::StaticOrder {
    int nNn;
    __device__ void init2(int N, int G_, int c_, int K_) { init(TL, N, G_, c_, K_); nNn = N / 256; }
    __device__ bool next(int i, pg8::Unit& u) const {
        const long L = (long)i * G + c; if (L < nwg) return pg8::StaticOrder::next(i, u);
        const int j = (int)(L - nwg); if (j >= 4 * nNn) return false;
        u.pm = 64 + (j & 3); u.pn = j >> 2; u.koff = 0; u.nt = ntk; u.part = -1; return true; }
};
struct LoraOrder : LatThenCtxOrder {
    __device__ bool next(int i, pg8::Unit& u) const { if (!LatThenCtxOrder::next(i, u)) return false; u.koff = (u.pn >> 3) * (LORA_KU * 2); u.nt = LORA_KU / 64; return true; }
};
struct OddInOrder : pg8::StaticOrder {
    __device__ void init2(int G_, int c_, int K_) { init(TL, NO, G_, c_, K_); }
    __device__ bool next(int i, pg8::Unit& u) const {
        const long L = (long)i * G + c; if (L < nwg) return pg8::StaticOrder::next(i, u);
        const int j = (int)(L - nwg); if (j >= 4 * 14) return false;
        const int idx = j >> 2; u.pm = 64 + (j & 3); u.pn = idx < 2 ? 8 + idx : 12 + idx; u.koff = 0; u.nt = ntk; u.part = -1; return true; }
};
template <bool Q8, class TS = res_t>
struct EpiResModT {
    static constexpr bool PERM = false, AFTER_DRAIN = false, I8 = Q8;
    const TS* Rlat; const TS* Rctx; res_t* Hout; const float* mod;
    const float* SA; const float* CS;
    DI void prescale(f32x4 (&acc)[2][2][4][2], const pg8::Unit& u, int wr, int wc, int fr, int fq) const { i8_prescale_np(acc, SA, CS, u, wr, wc, fr, fq); }
    DI void operator()(const f32x4 (&acc)[2][2][4][2], const pg8::Unit& u, int wr, int wc, int fr, int fq) const {
        const int row0 = u.pm * 256 + wr * 64 + fr, col0 = u.pn * 256 + wc * 32 + 4 * fq;
        const float* mp = mod + (size_t)(u.pm < 64 ? (u.pm >> 4) : 4) * 24576 + col0;
        f32x4 mv[2][2];
#pragma unroll
        for (int bj = 0; bj < 2; ++bj)
#pragma unroll
            for (int n = 0; n < 2; ++n) mv[bj][n] = *(const f32x4*)(mp + bj * 128 + n * 16);
        const TS* sbase = (u.pm < 64) ? Rlat + (size_t)row0 * D : Rctx + (size_t)(row0 - TL) * D;
        res_t* dbase = Hout + (size_t)row0 * D;
#pragma unroll
        for (int ai = 0; ai < 2; ++ai)
#pragma unroll
            for (int m = 0; m < 4; ++m) { const size_t ro = (size_t)(ai * 128 + m * 16) * D + col0;
#pragma unroll
                for (int bj = 0; bj < 2; ++bj)
#pragma unroll
                    for (int n = 0; n < 2; ++n) { const f32x4 r = ld4(sbase + ro + bj * 128 + n * 16);
                        st4(dbase + ro + bj * 128 + n * 16, r + mv[bj][n] * acc[ai][bj][m][n]); } }
    }
};

typedef EpiResModT<false, res_t> EpiResMod;
typedef EpiSlabT<false> EpiSlab;
struct EpiConvGlu {
    static constexpr bool PERM = true, AFTER_DRAIN = false, I8 = (FFN_I8 != 0);
    bf16_t* HID; bf16_t* SG; bf16_t* SU; const float* cw; const float* cb; const float* SA; const float* CS;
    DI void prescale(f32x4 (&acc)[2][2][4][2], const pg8::Unit& u, int wr, int wc, int fr, int fq) const { i8_prescale(acc, SA, CS, u, wr, wc, fr, fq); }
    DI void operator()(const f32x4 (&acc)[2][2][4][2], const pg8::Unit& u, int wr, int wc, int fr, int fq) const {
        const int col = u.pn * 128 + wc * 32 + 8 * fq;
#pragma unroll
        for (int ai = 0; ai < 2; ++ai) {
            const int rowb = u.pm * 256 + ai * 128 + wr * 64;
#pragma unroll
            for (int n = 0; n < 2; ++n) {
                const f32x4 w0 = *(const f32x4*)(cw + col + 4 * n), w1 = *(const f32x4*)(cw + DFF + col + 4 * n), w2 = *(const f32x4*)(cw + 2 * DFF + col + 4 * n), bb = *(const f32x4*)(cb + col + 4 * n);
                unsigned outp[4][2];
#pragma unroll
                for (int ep = 0; ep < 2; ++ep) { float o[4][2];
#pragma unroll
                    for (int e2 = 0; e2 < 2; ++e2) { const int e = 2 * ep + e2; float P[4], N[4];
#pragma unroll
                        for (int m = 0; m < 4; ++m) { const int vi = __float_as_int(acc[ai][0][m][n][e]);
                            P[m] = __int_as_float(__builtin_amdgcn_update_dpp(0, vi, 0x121, 0xF, 0xF, false)); N[m] = __int_as_float(__builtin_amdgcn_update_dpp(0, vi, 0x12F, 0xF, 0xF, false)); }
#pragma unroll
                        for (int m = 0; m < 4; ++m) { const float prev = fr > 0 ? P[m] : (m > 0 ? P[m - 1] : 0.f), next = fr < 15 ? N[m] : (m < 3 ? N[m + 1] : 0.f);
                            const float x = w0[e] * prev + w1[e] * acc[ai][0][m][n][e] + w2[e] * next + bb[e];
                            o[m][e2] = silu_f(x) * acc[ai][1][m][n][e]; } }
#pragma unroll
                    for (int m = 0; m < 4; ++m) outp[m][ep] = pk_bf16(o[m][0], o[m][1]); }
#pragma unroll
                for (int m = 0; m < 4; ++m) { const int rho = 16 * m + fr, row = rowb + rho;
                    if (rho != 0 && rho != 63) { u32x2 w = {outp[m][0], outp[m][1]}; *(u32x2*)(HID + (size_t)row * DFF + col + 4 * n) = w; }
                    if (m == 0 || m == 3) { if (rho <= 1 || rho >= 62) { const int slot = rho <= 1 ? rho : rho - 60;
                            u32x2 g; g.x = pk_bf16(acc[ai][0][m][n][0], acc[ai][0][m][n][1]); g.y = pk_bf16(acc[ai][0][m][n][2], acc[ai][0][m][n][3]);
                            *(u32x2*)(SG + ((size_t)(row >> 6) * 4 + slot) * DFF + col + 4 * n) = g;
                            if (rho == 0 || rho == 63) { u32x2 q; q.x = pk_bf16(acc[ai][1][m][n][0], acc[ai][1][m][n][1]); q.y = pk_bf16(acc[ai][1][m][n][2], acc[ai][1][m][n][3]);
                                *(u32x2*)(SU + ((size_t)(row >> 6) * 2 + (rho == 63 ? 1 : 0)) * DFF + col + 4 * n) = q; } } }
                }
            }
        }
    }
};
__device__ __forceinline__ void p_conv_fix(const Ctx& c, int l, int nrows) {
    const bf16_t* SG = (const bf16_t*)(c.ar + AR_SG); const bf16_t* SU = (const bf16_t*)(c.ar + AR_SU); bf16_t* HID = (bf16_t*)(c.ar + AR_HID);
    const float* cw = c.in[I_CONVW] + (size_t)l * 3 * DFF; const float* cb = c.in[I_CONVB] + (size_t)l * DFF;
    const int nitems = (nrows / 64) * 2 * 22;
    const u32x4 z4 = {0u, 0u, 0u, 0u};
    for (int item = blockIdx.x * 8 + c.wave; item < nitems; item += gridDim.x * 8) {
        const int ch = item % 22, kw = item / 22, kb = kw >> 1, last = kw & 1, col = ch * 512 + c.lane * 8;
        if (col >= DFF) continue;
        const int row = kb * 64 + (last ? 63 : 0);
        int pos, len; if (row < TL) { pos = row & 4095; len = 4096; } else { pos = (row - TL) & 255; len = 256; }
        u32x4 gp, gc, gn;
        if (!last) { gp = pos > 0 ? *(const u32x4*)(SG + ((size_t)(kb - 1) * 4 + 3) * DFF + col) : z4; gc = *(const u32x4*)(SG + ((size_t)kb * 4 + 0) * DFF + col); gn = *(const u32x4*)(SG + ((size_t)kb * 4 + 1) * DFF + col); }
        else { gp = *(const u32x4*)(SG + ((size_t)kb * 4 + 2) * DFF + col); gc = *(const u32x4*)(SG + ((size_t)kb * 4 + 3) * DFF + col); gn = pos < len - 1 ? *(const u32x4*)(SG + ((size_t)(kb + 1) * 4 + 0) * DFF + col) : z4; }
        const u32x4 up = *(const u32x4*)(SU + ((size_t)kb * 2 + last) * DFF + col);
        float w0[8], w1[8], w2[8], bb[8]; load8f(cw + col, w0); load8f(cw + DFF + col, w1); load8f(cw + 2 * DFF + col, w2); load8f(cb + col, bb);
        float o[8];
#pragma unroll
        for (int j = 0; j < 4; ++j) {
            const float x0 = bflo(gp[j]) * w0[2 * j] + bflo(gc[j]) * w1[2 * j] + bflo(gn[j]) * w2[2 * j] + bb[2 * j];
            const float x1 = bfhi(gp[j]) * w0[2 * j + 1] + bfhi(gc[j]) * w1[2 * j + 1] + bfhi(gn[j]) * w2[2 * j + 1] + bb[2 * j + 1];
            o[2 * j] = silu_f(x0) * bflo(up[j]); o[2 * j + 1] = silu_f(x1) * bfhi(up[j]); }
        u32x4 w; w.x = pk_bf16(o[0], o[1]); w.y = pk_bf16(o[2], o[3]); w.z = pk_bf16(o[4], o[5]); w.w = pk_bf16(o[6], o[7]);
        *(u32x4*)(HID + (size_t)row * DFF + col) = w;
    }
}

DI void unpack8(const u32x4 w, float (&o)[8]) {
#pragma unroll
    for (int j = 0; j < 4; ++j) { o[2 * j] = bflo(w[j]); o[2 * j + 1] = bfhi(w[j]); }
}
DI u32x4 pack8_bf16(const float (&o)[8]) { u32x4 w; w.x = pk_bf16(o[0], o[1]); w.y = pk_bf16(o[2], o[3]); w.z = pk_bf16(o[4], o[5]); w.w = pk_bf16(o[6], o[7]); return w; }
DI u32x4 pack8_f16(const float (&o)[8]) { u32x4 w; w.x = pk_f16(o[0], o[1]); w.y = pk_f16(o[2], o[3]); w.z = pk_f16(o[4], o[5]); w.w = pk_f16(o[6], o[7]); return w; }
DI void unpack8_f16(const u32x4 w, float (&o)[8]) {
#pragma unroll
    for (int j = 0; j < 4; ++j) { o[2 * j] = h16lo(w[j]); o[2 * j + 1] = h16hi(w[j]); }
}
DI void row_pos(int row, int& pos, int& len) { if (row < TL) { pos = row & 4095; len = 4096; } else { pos = (row - TL) & 255; len = 256; } }

__device__ __forceinline__ void p_rwkv_prepA(const Ctx& c) {
    const bf16_t* PA = (const bf16_t*)(c.ar + AR_PA);
    h16* R16 = (h16*)(c.ar + AR_R); h16* KK16 = (h16*)(c.ar + AR_KK); h16* V16 = (h16*)(c.ar + AR_V); bf16_t* K16 = (bf16_t*)(c.ar + AR_K); bf16_t* LA = (bf16_t*)(c.ar + AR_LA);
    const float* mu = c.in[I_MU]; const float* k_k = c.in[I_KK];
    const int lane = c.lane;
    for (int row = blockIdx.x * 8 + c.wave; row < TT; row += gridDim.x * 8) {
        int pos, len; row_pos(row, pos, len);
        const bool hasp = pos > 0, hasn = pos < len - 1;
        const bf16_t* pc = PA + (size_t)row * COLS_A_PAD;
        for (int it = 0; it < 14; ++it) {
            const int col = it * 512 + lane * 8;
            if (col >= COLS_A) break;
            float cur[8], prv[8], nxt[8], m8[8], mx[8];
            unpack8(*(const u32x4*)(pc + col), cur);
            if (hasp) unpack8(*(const u32x4*)(pc - COLS_A_PAD + col), prv); else {
#pragma unroll
                for (int j = 0; j < 8; ++j) prv[j] = 0.f; }
            if (hasn) unpack8(*(const u32x4*)(pc + COLS_A_PAD + col), nxt); else {
#pragma unroll
                for (int j = 0; j < 8; ++j) nxt[j] = 0.f; }
            load8f(mu + col, m8);
#pragma unroll
            for (int j = 0; j < 8; ++j) mx[j] = cur[j] + m8[j] * (0.5f * (prv[j] + nxt[j]) - cur[j]);
            if (it < 4) {
                *(u32x4*)(R16 + (size_t)row * 2048 + col) = pack8_f16(mx);
            } else if (it < 8) {
                const int j0 = col - 2048;
                *(u32x4*)(K16 + (size_t)row * 2048 + j0) = pack8_bf16(mx);
                float kk8[8], x[8]; load8f(k_k + j0, kk8); float ss = 0.f;
#pragma unroll
                for (int j = 0; j < 8; ++j) { x[j] = mx[j] * kk8[j]; ss += x[j] * x[j]; }
                ss += __shfl_xor(ss, 1); ss += __shfl_xor(ss, 2); ss += __shfl_xor(ss, 4);
                const float rn = rsqrtf(ss + 1e-12f);
#pragma unroll
                for (int j = 0; j < 8; ++j) x[j] *= rn;
                *(u32x4*)(KK16 + (size_t)row * 2048 + j0) = pack8_f16(x);
            } else if (it < 12) {
                *(u32x4*)(V16 + (size_t)row * 2048 + (col - 4096)) = pack8_f16(mx);
            } else {
                const int q0 = col - 6144; float o[8];
#pragma unroll
                for (int j = 0; j < 8; ++j) o[j] = q0 < 192 ? (1.0f - 2.0f * __builtin_amdgcn_rcpf(1.0f + __expf(2.0f * mx[j]))) : (q0 < 384 ? mx[j] : sigmoid_f(mx[j]));
                const int seg = q0 < 384 ? q0 / 96 : 4, off = q0 - (seg < 4 ? seg * 96 : 384);
                *(u32x4*)(LA + (size_t)row * LORA_K + seg * LORA_KU + off) = pack8_bf16(o);
            }
        }
        {
            const u32x4 z4 = {0u, 0u, 0u, 0u};
            for (int z = lane; z < 80; z += 64) *(u32x4*)(LA + (size_t)row * LORA_K + (z / 20) * LORA_KU + 96 + (z % 20) * 8) = z4; }
    }
}

DI int kperm16(int o) { return (o & ~12) | ((o >> 1) & 4) | ((o << 1) & 8); }
template <int DVW  , int NHEAD>
__device__ __forceinline__ void p_build_vt(const Ctx& c, const bf16_t* P, int ldp, int vcol0, bf16_t* VT) {
    constexpr int NSLAB = (DVW * NHEAD) / 512 > 0 ? (DVW * NHEAD) / 512 : 1;
    constexpr int SLABW = (DVW * NHEAD) < 512 ? (DVW * NHEAD) : 512;
    LAS unsigned short* T = (LAS unsigned short*)c.lds;
    const int tid = c.tid;
    for (int item = blockIdx.x; item < (TT / 64) * NSLAB; item += gridDim.x) {
        const int kg = item / NSLAB, slab = item % NSLAB;
        const int row0 = kg * 64;
        int b, key0; if (row0 < TL) { b = row0 >> 12; key0 = row0 & 4095; } else { b = (row0 - TL) >> 8; key0 = 4096 + ((row0 - TL) & 255); }
        { const int key = tid >> 3, part = tid & 7; const int kp = (key & ~15) | kperm16(key & 15);
          constexpr int CPT = SLABW / 8;
          const bf16_t* src = P + (size_t)(row0 + key) * ldp + vcol0 + slab * SLABW + part * CPT;
#pragma unroll
          for (int e = 0; e < CPT / 8; ++e) { const u32x4 w = *(const u32x4*)(src + e * 8);
#pragma unroll
              for (int j = 0; j < 4; ++j) { T[(part * CPT + e * 8 + 2 * j) * 72 + kp] = (unsigned short)(w[j] & 0xffffu); T[(part * CPT + e * 8 + 2 * j + 1) * 72 + kp] = (unsigned short)(w[j] >> 16); } }
        }
        __syncthreads();
        for (int q = tid; q < SLABW * 8; q += NTHREADS) { const int col = q >> 3, ch = q & 7;
            const u32x4 w = *(const LAS u32x4*)(T + col * 72 + ch * 8);
            const int gc = slab * SLABW + col, head = gc / DVW, dv = gc % DVW;
            *(u32x4*)(VT + (((size_t)b * NHEAD + head) * DVW + dv) * NKEY + key0 + ch * 8) = w; }
        __syncthreads();
    }
}

struct EpiLora {
    static constexpr bool PERM = true, AFTER_DRAIN = false, I8 = false;
    const float* w0; const float* a0; const float* k_a; const bf16_t* K16; const h16* KK16; h16* OMW; h16* BB; h16* KD; bf16_t* G;
    DI void operator()(const f32x4 (&acc)[2][2][4][2], const pg8::Unit& u, int wr, int wc, int fr, int fq) const {
        const int type = u.pn >> 3, row0 = u.pm * 256 + wr * 64 + fr;
#pragma unroll
        for (int bj = 0; bj < 2; ++bj) {
            const int jc = (u.pn & 7) * 256 + bj * 128 + wc * 32 + 8 * fq;
            if (type < 2) {
                float w8[8]; load8f(w0 + type * 2048 + jc, w8);
#pragma unroll
                for (int ai = 0; ai < 2; ++ai)
#pragma unroll
                    for (int m = 0; m < 4; ++m) { const int row = row0 + ai * 128 + m * 16; float o[8];
#pragma unroll
                        for (int i = 0; i < 8; ++i) { const float w = w8[i] + (i < 4 ? acc[ai][bj][m][0][i & 3] : acc[ai][bj][m][1][i & 3]);
                            o[i] = 1.0f - __expf(-0.60653066f * sigmoid_f(w)); }
                        *(u32x4*)(OMW + ((size_t)type * TT + row) * 2048 + jc) = pack8_f16(o); }
            } else if (type < 4) {
                const int d = type - 2; float a8[8], ka8[8]; load8f(a0 + d * 2048 + jc, a8); load8f(k_a + jc, ka8);
#pragma unroll
                for (int ai = 0; ai < 2; ++ai)
#pragma unroll
                    for (int m = 0; m < 4; ++m) { const int row = row0 + ai * 128 + m * 16; float kd[8], bb[8], k8[8], kk8[8];
                        unpack8(*(const u32x4*)(K16 + (size_t)row * 2048 + jc), k8); unpack8_f16(*(const u32x4*)(KK16 + (size_t)row * 2048 + jc), kk8);
#pragma unroll
                        for (int i = 0; i < 8; ++i) { const float a = sigmoid_f(a8[i] + (i < 4 ? acc[ai][bj][m][0][i & 3] : acc[ai][bj][m][1][i & 3]));
                            kd[i] = k8[i] * (1.0f + (a - 1.0f) * ka8[i]); bb[i] = kk8[i] * a; }
                        *(u32x4*)(KD + ((size_t)d * TT + row) * 2048 + jc) = pack8_f16(kd);
                        *(u32x4*)(BB + ((size_t)d * TT + row) * 2048 + jc) = pack8_f16(bb); }
            } else {
#pragma unroll
                for (int ai = 0; ai < 2; ++ai)
#pragma unroll
                    for (int m = 0; m < 4; ++m) { const int row = row0 + ai * 128 + m * 16; float o[8];
#pragma unroll
                        for (int i = 0; i < 8; ++i) o[i] = (i < 4 ? acc[ai][bj][m][0][i & 3] : acc[ai][bj][m][1][i & 3]);
                        *(u32x4*)(G + (size_t)row * 2048 + jc) = pack8_bf16(o); }
            }
        }
    }
};

#define MFMA32(a, b, cacc) __builtin_amdgcn_mfma_f32_32x32x16_bf16((a), (b), (cacc), 0, 0, 0)
DI bf16x8 ld_frag(const bf16_t* p) { return __builtin_bit_cast(bf16x8, *(const u32x4*)p); }
DI bf16x8 pack_p(const f32x16& x, int s) { u32x4 w; w.x = pk_bf16(x[8 * s], x[8 * s + 1]); w.y = pk_bf16(x[8 * s + 2], x[8 * s + 3]); w.z = pk_bf16(x[8 * s + 4], x[8 * s + 5]); w.w = pk_bf16(x[8 * s + 6], x[8 * s + 7]); return __builtin_bit_cast(bf16x8, w); }
constexpr float LOG2E = 1.44269504088896f;

DI void fwht8x4(float (&x)[8], int lane) {
#pragma unroll
    for (int h = 1; h < 8; h <<= 1)
#pragma unroll
        for (int i = 0; i < 8; i += 2 * h)
#pragma unroll
            for (int j = i; j < i + h; ++j) { const float a = x[j], b = x[j + h]; x[j] = a + b; x[j + h] = a - b; }
#pragma unroll
    for (int j = 0; j < 8; ++j) { float v = x[j];
        { const float t = __int_as_float(__builtin_amdgcn_update_dpp(0, __float_as_int(v), 0xB1, 0xF, 0xF, false)); v = (lane & 1) ? t - v : v + t; }
        { const float t = __int_as_float(__builtin_amdgcn_update_dpp(0, __float_as_int(v), 0x4E, 0xF, 0xF, false)); v = (lane & 2) ? t - v : v + t; }
        x[j] = v; }
}
DI float wave_max(float v) {
#pragma unroll
    for (int o = 32; o >= 1; o >>= 1) v = fmaxf(v, __shfl_xor(v, o));
    return v;
}
__device__ __forceinline__ void p_rwkv_out(const Ctx& c, int nrows) {
    const bf16_t* Yf = (const bf16_t*)(c.ar + AR_Y); const bf16_t* Yb = Yf + (size_t)TT * 2048;
    const h16* R16 = (const h16*)(c.ar + AR_R); const h16* V16 = (const h16*)(c.ar + AR_V);
    const h16* KDf = (const h16*)(c.ar + AR_KD); const h16* KDb = KDf + (size_t)TT * 2048;
    const bf16_t* G = (const bf16_t*)(c.ar + AR_G); bf16_t* MIX = (bf16_t*)(c.ws + WS_XN);
    const float* r_k = c.in[I_RK]; const float* ln_w = c.in[I_LNW]; const float* ln_b = c.in[I_LNB];
    const int lane = c.lane;
    for (int row = blockIdx.x * 8 + c.wave; row < nrows; row += gridDim.x * 8) {
        float ov[4][8];
#pragma unroll
        for (int it = 0; it < 4; ++it) {
            const int col = it * 512 + lane * 8; const size_t o = (size_t)row * 2048 + col;
            float yf[8], yb[8], y[8], r8[8], v8[8], kf[8], kb[8], g8[8], rk8[8], lw[8], lb[8];
            unpack8(*(const u32x4*)(Yf + o), yf); unpack8(*(const u32x4*)(Yb + o), yb);
            unpack8_f16(*(const u32x4*)(R16 + o), r8); unpack8_f16(*(const u32x4*)(V16 + o), v8);
            unpack8_f16(*(const u32x4*)(KDf + o), kf); unpack8_f16(*(const u32x4*)(KDb + o), kb);
            unpack8(*(const u32x4*)(G + o), g8);
            load8f(r_k + col, rk8); load8f(ln_w + col, lw); load8f(ln_b + col, lb);
            float sm = 0.f, bn = 0.f;
#pragma unroll
            for (int j = 0; j < 8; ++j) { y[j] = yf[j] + yb[j]; sm += y[j]; bn += r8[j] * (kf[j] + kb[j]) * rk8[j]; }
            sm += __shfl_xor(sm, 1); sm += __shfl_xor(sm, 2); sm += __shfl_xor(sm, 4);
            bn += __shfl_xor(bn, 1); bn += __shfl_xor(bn, 2); bn += __shfl_xor(bn, 4);
            const float mean = sm * (1.0f / 64.0f); float vs = 0.f;
#pragma unroll
            for (int j = 0; j < 8; ++j) { const float dlt = y[j] - mean; vs += dlt * dlt; }
            vs += __shfl_xor(vs, 1); vs += __shfl_xor(vs, 2); vs += __shfl_xor(vs, 4);
            const float rs = rsqrtf(vs * (1.0f / 64.0f) + 64e-5f);
            float o8[8];
#pragma unroll
            for (int j = 0; j < 8; ++j) o8[j] = ((y[j] - mean) * rs * lw[j] + lb[j] + bn * v8[j]) * g8[j];
            if (MIX_I8) {
#pragma unroll
                for (int j = 0; j < 8; ++j) ov[it][j] = o8[j]; }
            else *(u32x4*)(MIX + (size_t)row * D + col) = pack8_bf16(o8);
        }
        if (MIX_I8) {
            float av[4][8]; float mx = 0.f;
#pragma unroll
            for (int it = 0; it < 4; ++it) { unpack8(*(const u32x4*)(MIX + (size_t)row * D + 2048 + it * 512 + lane * 8), av[it]);
                fwht8x4(ov[it], lane); fwht8x4(av[it], lane);
#pragma unroll
                for (int j = 0; j < 8; ++j) mx = fmaxf(mx, fmaxf(fabsf(ov[it][j]), fabsf(av[it][j]))); }
            mx = wave_max(mx);
            const float qs = mx > 0.f ? 127.0f / mx : 0.f;
            unsigned char* xq = c.ar + AR_XQ + (size_t)row * D;
#pragma unroll
            for (int it = 0; it < 4; ++it) {
                u32x2 w0 = {pk_i8x4(ov[it][0] * qs, ov[it][1] * qs, ov[it][2] * qs, ov[it][3] * qs), pk_i8x4(ov[it][4] * qs, ov[it][5] * qs, ov[it][6] * qs, ov[it][7] * qs)};
                u32x2 w1 = {pk_i8x4(av[it][0] * qs, av[it][1] * qs, av[it][2] * qs, av[it][3] * qs), pk_i8x4(av[it][4] * qs, av[it][5] * qs, av[it][6] * qs, av[it][7] * qs)};
                *(u32x2*)(xq + it * 512 + lane * 8) = w0; *(u32x2*)(xq + 2048 + it * 512 + lane * 8) = w1; }
            if (lane == 0) ((float*)(c.ar + AR_XQS))[row] = mx * (1.0f / 127.0f);
        }
    }
}
__device__ __forceinline__ void p_quant_hid(const Ctx& c, int nrows) {
    const bf16_t* HID = (const bf16_t*)(c.ar + AR_HID); const int lane = c.lane;
    for (int row = blockIdx.x * 8 + c.wave; row < nrows; row += gridDim.x * 8) {
        u32x4 pk[22]; float mx = 0.f;
#pragma unroll
        for (int it = 0; it < 22; ++it) { const int col = it * 512 + lane * 8; pk[it] = col < DFF ? *(const u32x4*)(HID + (size_t)row * DFF + col) : (u32x4){0u, 0u, 0u, 0u}; }
#pragma unroll
        for (int it = 0; it < 22; ++it) { float x[8]; unpack8(pk[it], x); fwht8x4(x, lane);
#pragma unroll
            for (int j = 0; j < 8; ++j) mx = fmaxf(mx, fabsf(x[j])); }
        mx = wave_max(mx);
        const float qs = mx > 0.f ? 127.0f / mx : 0.f;
        unsigned char* hq = c.ar + AR_HQ + (size_t)row * DFF;
#pragma unroll
        for (int it = 0; it < 22; ++it) { float x[8]; unpack8(pk[it], x); fwht8x4(x, lane); const int col = it * 512 + lane * 8;
            u32x2 w = {pk_i8x4(x[0] * qs, x[1] * qs, x[2] * qs, x[3] * qs), pk_i8x4(x[4] * qs, x[5] * qs, x[6] * qs, x[7] * qs)};
            if (col < DFF) *(u32x2*)(hq + col) = w; }
        if (lane == 0) ((float*)(c.ar + AR_HQS))[row] = mx * (1.0f / 127.0f);
    }
}
__device__ __forceinline__ void p_quant_mix(const Ctx& c, int nrows) {
    const bf16_t* MIX = (const bf16_t*)(c.ws + WS_XN); const int lane = c.lane;
    for (int row = blockIdx.x * 8 + c.wave; row < nrows; row += gridDim.x * 8) {
        float x[8][8]; float mx = 0.f;
#pragma unroll
        for (int it = 0; it < 8; ++it) { unpack8(*(const u32x4*)(MIX + (size_t)row * D + it * 512 + lane * 8), x[it]); fwht8x4(x[it], lane);
#pragma unroll
            for (int j = 0; j < 8; ++j) mx = fmaxf(mx, fabsf(x[it][j])); }
        mx = wave_max(mx);
        const float qs = mx > 0.f ? 127.0f / mx : 0.f;
        unsigned char* xq = c.ar + AR_XQ + (size_t)row * D;
#pragma unroll
        for (int it = 0; it < 8; ++it) { u32x2 w = {pk_i8x4(x[it][0] * qs, x[it][1] * qs, x[it][2] * qs, x[it][3] * qs), pk_i8x4(x[it][4] * qs, x[it][5] * qs, x[it][6] * qs, x[it][7] * qs)};
            *(u32x2*)(xq + it * 512 + lane * 8) = w; }
        if (lane == 0) ((float*)(c.ar + AR_XQS))[row] = mx * (1.0f / 127.0f);
    }
}

constexpr int K1_WAVE_LDS = 35328;
constexpr size_t TT_ROWS2048 = (size_t)TT * 2048;
#define WAVE_SYNC() do { asm volatile("s_waitcnt lgkmcnt(0)" ::: "memory"); __builtin_amdgcn_wave_barrier(); } while (0)
DI int rw_row(int b, int dir, int t) { return t < CTXL ? TL + b * CTXL + (dir ? (CTXL - 1 - t) : t) : b * SEQ + (dir ? (SEQ - 1 - (t - CTXL)) : (t - CTXL)); }
DI float bfu(unsigned short x) { return __uint_as_float((unsigned)x << 16); }
DI bf16x8 colfrag_nat(const LAS unsigned short* T, int col, int t0) { u32x4 w;
#pragma unroll
    for (int j = 0; j < 4; ++j) w[j] = (unsigned)T[(t0 + 2 * j) * 64 + col] | ((unsigned)T[(t0 + 2 * j + 1) * 64 + col] << 16);
    return __builtin_bit_cast(bf16x8, w); }
DI bf16x8 colfrag_nat_scaled(const LAS unsigned short* T, int col, int t0, float sc) { u32x4 w;
#pragma unroll
    for (int j = 0; j < 4; ++j) w[j] = pk_bf16(bfu(T[(t0 + 2 * j) * 64 + col]) * sc, bfu(T[(t0 + 2 * j + 1) * 64 + col]) * sc);
    return __builtin_bit_cast(bf16x8, w); }
DI bf16x8 colfrag_pk_scaled(const LAS unsigned short* T, int col, int s, int hh, float sc) { u32x4 w;
#pragma unroll
    for (int j2 = 0; j2 < 4; ++j2) { const int j = 2 * j2, t = 16 * s + 8 * (j >> 2) + 4 * hh + (j & 3);
        w[j2] = pk_bf16(bfu(T[t * 64 + col]) * sc, bfu(T[(t + 1) * 64 + col]) * sc); }
    return __builtin_bit_cast(bf16x8, w); }
DI bf16x8 rowfrag_nat(const LAS unsigned short* A, int row, int s, int hh) { const LAS u32x2* p = (const LAS u32x2*)(A + row * 40 + 16 * s + 8 * hh); const u32x2 a = p[0], b = p[1];
    u32x4 w = {a.x, a.y, b.x, b.y}; return __builtin_bit_cast(bf16x8, w); }
DI bf16x8 rowfrag_pk(const LAS unsigned short* A, int row, int s, int hh) { const u32x2 a = *(const LAS u32x2*)(A + row * 40 + 16 * s + 4 * hh), b = *(const LAS u32x2*)(A + row * 40 + 16 * s + 8 + 4 * hh);
    u32x4 w = {a.x, a.y, b.x, b.y}; return __builtin_bit_cast(bf16x8, w); }
DI u32x4 pack_pu(const f32x16& x, int s) { u32x4 w; w.x = pk_bf16(x[8 * s], x[8 * s + 1]); w.y = pk_bf16(x[8 * s + 2], x[8 * s + 3]); w.z = pk_bf16(x[8 * s + 4], x[8 * s + 5]); w.w = pk_bf16(x[8 * s + 6], x[8 * s + 7]); return w; }

__device__ __forceinline__ void rwkv_k1_chunk(const Ctx& c, LAS unsigned char* wl, int seq, int ch) {
    const int dir = seq & 1, h = (seq >> 1) & 31, b = seq >> 6;
    const int lane = c.lane, r = lane & 31, hh = lane >> 5;
    LAS unsigned short* TA = (LAS unsigned short*)wl; LAS unsigned short* TB = TA + 2048; LAS unsigned short* TK = TB + 2048; LAS unsigned short* TR = TK + 2048; LAS unsigned short* TVv = TR + 2048;
    LAS float* GC = (LAS float*)(wl + 20480); LAS float* LAB = (LAS float*)(wl + 20736);
    LAS unsigned short* TTi = (LAS unsigned short*)(wl + 24832); LAS unsigned short* TAK = TTi + 1280; LAS unsigned short* TRB = TAK + 1280; LAS unsigned short* TRK = TRB + 1280;
    const h16* KK = (const h16*)(c.ar + AR_KK); const h16* RR = (const h16*)(c.ar + AR_R); const h16* VV = (const h16*)(c.ar + AR_V);
    const h16* OM = (const h16*)(c.ar + AR_OMW) + (size_t)dir * TT_ROWS2048; const h16* BBp = (const h16*)(c.ar + AR_BB) + (size_t)dir * TT_ROWS2048; const h16* KDp = (const h16*)(c.ar + AR_KD) + (size_t)dir * TT_ROWS2048;
    {   LAS unsigned short* TO = (LAS unsigned short*)LAB;
        u32x4 ld[6][4];
#pragma unroll
        for (int i = 0; i < 4; ++i) { const int tau = (lane >> 3) + 8 * i; const size_t off = (size_t)rw_row(b, dir, ch * 32 + tau) * 2048 + h * 64 + (lane & 7) * 8;
            ld[0][i] = *(const u32x4*)(KK + off); ld[1][i] = *(const u32x4*)(BBp + off); ld[2][i] = *(const u32x4*)(KDp + off);
            ld[3][i] = *(const u32x4*)(RR + off); ld[4][i] = *(const u32x4*)(VV + off); ld[5][i] = *(const u32x4*)(OM + off); }
#pragma unroll
        for (int i = 0; i < 4; ++i) { const int o = ((lane >> 3) + 8 * i) * 64 + (lane & 7) * 8;
            *(LAS u32x4*)(TA + o) = ld[0][i]; *(LAS u32x4*)(TB + o) = ld[1][i]; *(LAS u32x4*)(TK + o) = ld[2][i];
            *(LAS u32x4*)(TR + o) = ld[3][i]; *(LAS u32x4*)(TVv + o) = ld[4][i]; *(LAS u32x4*)(TO + o) = ld[5][i]; }
    }
    WAVE_SYNC();
    {   const LAS h16* TO = (const LAS h16*)LAB;
        float g = 1.f;
#pragma unroll 8
        for (int tau = 0; tau < 32; ++tau) { const int o = tau * 64 + lane;
            const float omw = (float)TO[o], bb = (float)((const LAS h16*)TB)[o], kd = (float)((const LAS h16*)TK)[o], kk = (float)((const LAS h16*)TA)[o], rr = (float)((const LAS h16*)TR)[o], vv = (float)((const LAS h16*)TVv)[o];
            const float gp = g; g *= (1.0f - omw); const float ig = __builtin_amdgcn_rcpf(g);
            TA[o] = f2bf(kk * gp); TB[o] = f2bf(-bb * ig); TK[o] = f2bf(kd * ig); TR[o] = f2bf(rr * g); TVv[o] = f2bf(vv);
        }
        GC[lane] = g;
    }
    WAVE_SYNC();
    {   f32x16 ab, ak, rb, rk;
#pragma unroll
        for (int i = 0; i < 16; ++i) { ab[i] = 0.f; ak[i] = 0.f; rb[i] = 0.f; rk[i] = 0.f; }
#pragma unroll
        for (int ks = 0; ks < 4; ++ks) { const int o = r * 64 + 16 * ks + 8 * hh;
            const bf16x8 fa = *(const LAS bf16x8*)(TA + o), fb = *(const LAS bf16x8*)(TB + o), fk = *(const LAS bf16x8*)(TK + o), fr = *(const LAS bf16x8*)(TR + o);
            ab = MFMA32(fa, fb, ab); ak = MFMA32(fa, fk, ak); rb = MFMA32(fr, fb, rb); rk = MFMA32(fr, fk, rk); }
#pragma unroll
        for (int i = 0; i < 16; ++i) { const int tau = (i & 3) + 8 * (i >> 2) + 4 * hh;
            LAB[tau * 32 + r] = (r < tau) ? ab[i] : 0.f;
            TAK[tau * 40 + r] = f2bf((r < tau) ? ak[i] : 0.f); TRB[tau * 40 + r] = f2bf((r <= tau) ? rb[i] : 0.f); TRK[tau * 40 + r] = f2bf((r <= tau) ? rk[i] : 0.f); }
    }
    WAVE_SYNC();
    {   float Tc[32];
#pragma unroll
        for (int tau = 0; tau < 32; ++tau) { float acc = (r == tau) ? 1.f : 0.f;
#pragma unroll
            for (int q = 0; q < (tau + 3) / 4; ++q) { const f32x4 a4 = *(const LAS f32x4*)(LAB + tau * 32 + 4 * q);
#pragma unroll
                for (int e = 0; e < 4; ++e) if (4 * q + e < tau) acc = fmaf(a4[e], Tc[4 * q + e], acc); }
            Tc[tau] = acc; }
        if (hh == 0) {
#pragma unroll
            for (int tau = 0; tau < 32; ++tau) TTi[tau * 40 + r] = f2bf(Tc[tau]); }
    }
    WAVE_SYNC();
    f32x16 W1[2], Z[2]; bf16x8 Vn[2][2];
    {   bf16x8 tn[2], tp[2], akn[2];
#pragma unroll
        for (int s = 0; s < 2; ++s) { tn[s] = rowfrag_nat(TTi, r, s, hh); tp[s] = rowfrag_pk(TTi, r, s, hh); akn[s] = rowfrag_nat(TAK, r, s, hh); }
#pragma unroll
        for (int t2 = 0; t2 < 2; ++t2) {
#pragma unroll
            for (int i = 0; i < 16; ++i) W1[t2][i] = 0.f;
            f32x16 X;
#pragma unroll
            for (int i = 0; i < 16; ++i) X[i] = 0.f;
#pragma unroll
            for (int s = 0; s < 2; ++s) { Vn[t2][s] = colfrag_nat(TVv, 32 * t2 + r, 16 * s + 8 * hh);
                W1[t2] = MFMA32(tn[s], colfrag_nat(TA, 32 * t2 + r, 16 * s + 8 * hh), W1[t2]);
                X = MFMA32(akn[s], Vn[t2][s], X); }
#pragma unroll
            for (int i = 0; i < 16; ++i) Z[t2][i] = 0.f;
#pragma unroll
            for (int s = 0; s < 2; ++s) Z[t2] = MFMA32(tp[s], pack_p(X, s), Z[t2]);
        }
    }
    u32x4* CHp = (u32x4*)(c.ar + AR_CH + ((size_t)seq * RW_NCH + ch) * CH_BYTES) + lane;
    {   bf16x8 rbp[2], rkn[2];
#pragma unroll
        for (int s = 0; s < 2; ++s) { rbp[s] = rowfrag_pk(TRB, r, s, hh); rkn[s] = rowfrag_nat(TRK, r, s, hh); }
#pragma unroll
        for (int kt = 0; kt < 2; ++kt) { f32x16 GT;
#pragma unroll
            for (int g4 = 0; g4 < 4; ++g4) { const u32x2 w = *(const LAS u32x2*)(TR + r * 64 + 32 * kt + 8 * g4 + 4 * hh);
                GT[4 * g4] = bflo(w.x); GT[4 * g4 + 1] = bfhi(w.x); GT[4 * g4 + 2] = bflo(w.y); GT[4 * g4 + 3] = bfhi(w.y); }
#pragma unroll
            for (int s = 0; s < 2; ++s) GT = MFMA32(pack_p(W1[kt], s), rbp[s], GT);
#pragma unroll
            for (int s = 0; s < 2; ++s) CHp[(0 + kt * 2 + s) * 64] = pack_pu(GT, s); }
#pragma unroll
        for (int vt = 0; vt < 2; ++vt) { f32x16 Y0;
#pragma unroll
            for (int i = 0; i < 16; ++i) Y0[i] = 0.f;
#pragma unroll
            for (int s = 0; s < 2; ++s) { Y0 = MFMA32(pack_p(Z[vt], s), rbp[s], Y0); Y0 = MFMA32(Vn[vt][s], rkn[s], Y0); }
#pragma unroll
            for (int s = 0; s < 2; ++s) CHp[(4 + vt * 2 + s) * 64] = pack_pu(Y0, s); }
    }
#pragma unroll
    for (int k2 = 0; k2 < 2; ++k2) {
        const float gc = GC[32 * k2 + r];
        bf16x8 bhp[2], khn[2];
#pragma unroll
        for (int s = 0; s < 2; ++s) { bhp[s] = colfrag_pk_scaled(TB, 32 * k2 + r, s, hh, gc); khn[s] = colfrag_nat_scaled(TK, 32 * k2 + r, 16 * s + 8 * hh, gc); }
#pragma unroll
        for (int kt = 0; kt < 2; ++kt) { f32x16 PT;
#pragma unroll
            for (int i = 0; i < 16; ++i) PT[i] = (kt == k2 && ((i & 3) + 8 * (i >> 2) + 4 * hh) == r) ? gc : 0.f;
#pragma unroll
            for (int s = 0; s < 2; ++s) PT = MFMA32(pack_p(W1[kt], s), bhp[s], PT);
#pragma unroll
            for (int s = 0; s < 2; ++s) CHp[(8 + k2 * 4 + kt * 2 + s) * 64] = pack_pu(PT, s); }
#pragma unroll
        for (int vt = 0; vt < 2; ++vt) { f32x16 PS;
#pragma unroll
            for (int i = 0; i < 16; ++i) PS[i] = 0.f;
#pragma unroll
            for (int s = 0; s < 2; ++s) { PS = MFMA32(bhp[s], pack_p(Z[vt], s), PS); PS = MFMA32(khn[s], Vn[vt][s], PS); }
#pragma unroll
            for (int s = 0; s < 2; ++s) CHp[(16 + k2 * 4 + vt * 2 + s) * 64] = pack_pu(PS, s); }
    }
    WAVE_SYNC();
}

DI void unpack_acc(const u32x4 lo, const u32x4 hi, f32x16& x) {
#pragma unroll
    for (int j = 0; j < 4; ++j) { x[2 * j] = bflo(lo[j]); x[2 * j + 1] = bfhi(lo[j]); x[8 + 2 * j] = bflo(hi[j]); x[8 + 2 * j + 1] = bfhi(hi[j]); }
}
__device__ __forceinline__ void rwkv_seq_wave(const Ctx& c, int seq, int vt) {
    const int dir = seq & 1, h = (seq >> 1) & 31, b = seq >> 6;
    const int lane = c.lane, r = lane & 31, hh = lane >> 5;
    bf16_t* Y = (bf16_t*)(c.ar + AR_Y) + (size_t)dir * TT_ROWS2048;
    f32x16 M[2];
#pragma unroll
    for (int kt = 0; kt < 2; ++kt)
#pragma unroll
        for (int i = 0; i < 16; ++i) M[kt][i] = 0.f;
    const u32x4* CH0 = (const u32x4*)(c.ar + AR_CH + (size_t)seq * RW_NCH * CH_BYTES) + lane;
    u32x4 gf[4], pf[8], y0[2], ps[4];
#define RW_LOAD(chp) do { _Pragma("unroll") for (int q = 0; q < 4; ++q) gf[q] = (chp)[q * 64]; _Pragma("unroll") for (int q = 0; q < 2; ++q) y0[q] = (chp)[(4 + vt * 2 + q) * 64]; \
        _Pragma("unroll") for (int q = 0; q < 8; ++q) pf[q] = (chp)[(8 + q) * 64]; _Pragma("unroll") for (int k2 = 0; k2 < 2; ++k2) _Pragma("unroll") for (int s = 0; s < 2; ++s) ps[k2 * 2 + s] = (chp)[(16 + k2 * 4 + vt * 2 + s) * 64]; } while (0)
    RW_LOAD(CH0);
    for (int ch = 0; ch < (int)RW_NCH; ++ch) {
        bf16x8 mp[4];
#pragma unroll
        for (int kt = 0; kt < 2; ++kt)
#pragma unroll
            for (int s = 0; s < 2; ++s) mp[kt * 2 + s] = pack_p(M[kt], s);
        f32x16 Yc, Mn[2];
        unpack_acc(y0[0], y0[1], Yc); unpack_acc(ps[0], ps[1], Mn[0]); unpack_acc(ps[2], ps[3], Mn[1]);
#pragma unroll
        for (int q = 0; q < 4; ++q) Yc = MFMA32(mp[q], __builtin_bit_cast(bf16x8, gf[q]), Yc);
#pragma unroll
        for (int k2 = 0; k2 < 2; ++k2)
#pragma unroll
            for (int q = 0; q < 4; ++q) Mn[k2] = MFMA32(__builtin_bit_cast(bf16x8, pf[k2 * 4 + q]), mp[q], Mn[k2]);
        if (ch + 1 < (int)RW_NCH) { const u32x4* nx = CH0 + (size_t)(ch + 1) * (CH_BYTES / 16); RW_LOAD(nx); }
        M[0] = Mn[0]; M[1] = Mn[1];
        {   bf16_t* yp = Y + (size_t)rw_row(b, dir, ch * 32 + r) * 2048 + h * 64 + 32 * vt + 4 * hh;
#pragma unroll
            for (int g = 0; g < 4; ++g) { u32x2 w2; w2.x = pk_bf16(Yc[4 * g], Yc[4 * g + 1]); w2.y = pk_bf16(Yc[4 * g + 2], Yc[4 * g + 3]); *(u32x2*)(yp + 8 * g) = w2; } }
    }
#undef RW_LOAD
}

__device__ __forceinline__ void p_rwkv_k1_and_conv(const Ctx& c) {
    if (c.wave < 4) { LAS unsigned char* wl = c.lds + c.wave * K1_WAVE_LDS; const int w = blockIdx.x * 4 + c.wave, nw = gridDim.x * 4;
        for (int task = w; task < 256 * (int)RW_NCH; task += nw) rwkv_k1_chunk(c, wl, task / (int)RW_NCH, task % (int)RW_NCH); }
    else p_convert_deferred(c, blockIdx.x * 4 + (c.wave - 4), gridDim.x * 4, 0, CONV_SPLIT);
}
__device__ __forceinline__ void p_rwkv_seq_and_conv(const Ctx& c) {
    constexpr int NTASK = 512;
    const int G = (int)gridDim.x, task = c.wave * G + (int)blockIdx.x;
    if (task < NTASK) { for (int t = task; t < NTASK; t += G * 8) rwkv_seq_wave(c, t & 255, t >> 8); return; }
    int widx = 0, nworkers = 0;
    for (int w = 0; w < 8; ++w) { const int nsc = NTASK - w * G; const int sb = nsc <= 0 ? 0 : (nsc > G ? G : nsc);
        if (w < c.wave) widx += G - sb; else if (w == c.wave) widx += (int)blockIdx.x - sb;
        nworkers += G - sb; }
    p_convert_deferred(c, widx, nworkers, CONV_SPLIT, 1 << 30);
}

constexpr int DA_KBYTES = 64 * 256, DA_VBYTES = 128 * 128, DA_BUF = DA_KBYTES + DA_VBYTES;
constexpr int DA_COMB = 2 * DA_BUF;
__device__ __forceinline__ void dattn_block_item(const Ctx& c, int item) {
    const bf16_t* PB = (const bf16_t*)(c.ar + AR_PB); const bf16_t* VT = (const bf16_t*)(c.ar + AR_VT); bf16_t* MIX = (bf16_t*)(c.ws + WS_XN);
    const int lane = c.lane, r = lane & 31, hh = lane >> 5, w = c.wave, mp = w >> 2, qg = w & 3;
    int b, h, qrow0, t0, nt;
    if (item < NB * 16 * 32) { b = item >> 9; h = (item >> 5) & 15; qrow0 = b * SEQ + (item & 31) * 128; t0 = 0; nt = NKEY / 64; }
    else { const int i2 = item - NB * 16 * 32; b = i2 >> 5; h = (i2 >> 1) & 15; qrow0 = TL + b * CTXL + (i2 & 1) * 128; t0 = SEQ / 64; nt = CTXL / 64; }
    const bf16_t* VTh = VT + ((size_t)b * 16 + h) * 128 * NKEY;
    int krow_l[2], kchunk_l[2], vrow_l[2], vchunk_l[2];
#pragma unroll
    for (int i = 0; i < 2; ++i) { const int pk = 2 * w + i; krow_l[i] = 4 * pk + (lane >> 4); kchunk_l[i] = (lane & 15) ^ (krow_l[i] & 15);
        vrow_l[i] = 8 * pk + (lane >> 3); vchunk_l[i] = (lane & 7) ^ ((vrow_l[i] >> 1) & 7); }
#define DA_LOAD(t, buf) do { const int kx0 = (t0 + (t)) * 64; const int krow0 = kx0 < SEQ ? b * SEQ + kx0 : TL + b * CTXL + (kx0 - SEQ); \
        _Pragma("unroll") for (int i = 0; i < 2; ++i) { \
            __builtin_amdgcn_global_load_lds((const unsigned*)(PB + (size_t)(krow0 + krow_l[i]) * COLS_B + 2048 + h * 128 + kchunk_l[i] * 8), (LAS unsigned*)(c.lds + (buf) * DA_BUF + (2 * w + i) * 1024), 16, 0, 0); \
            __builtin_amdgcn_global_load_lds((const unsigned*)(VTh + (size_t)vrow_l[i] * NKEY + kx0 + vchunk_l[i] * 8), (LAS unsigned*)(c.lds + (buf) * DA_BUF + DA_KBYTES + (2 * w + i) * 1024), 16, 0, 0); } } while (0)
    bf16x8 q[4];
    { const bf16_t* qp = PB + (size_t)(qrow0 + 32 * qg + r) * COLS_B + h * 128 + mp * 64 + hh * 8;
#pragma unroll
      for (int ks = 0; ks < 4; ++ks) q[ks] = ld_frag(qp + ks * 16); }
    f32x16 O[4];
#pragma unroll
    for (int d = 0; d < 4; ++d)
#pragma unroll
        for (int i = 0; i < 16; ++i) O[d][i] = 0.f;
    float m = 0.f, l = 0.f;
    DA_LOAD(0, 0);
    __syncthreads();
    for (int t = 0; t < nt; ++t) {
        const int cur = t & 1;
        if (t + 1 < nt) DA_LOAD(t + 1, cur ^ 1);
        const LAS unsigned short* Kl = (const LAS unsigned short*)(c.lds + cur * DA_BUF); const LAS unsigned short* Vl = (const LAS unsigned short*)(c.lds + cur * DA_BUF + DA_KBYTES);
        f32x16 st[2];
        const float negm = -m;
#pragma unroll
        for (int sub = 0; sub < 2; ++sub) {
#pragma unroll
            for (int i = 0; i < 16; ++i) st[sub][i] = negm;
#pragma unroll
            for (int ks = 0; ks < 4; ++ks) st[sub] = MFMA32(*(const LAS bf16x8*)((const LAS unsigned char*)Kl + (32 * sub + r) * 256 + (((mp * 8 + ks * 2 + hh) ^ (r & 15)) << 4)), q[ks], st[sub]); }
        float mx = fmaxf(st[0][0], st[1][0]);
#pragma unroll
        for (int i = 1; i < 16; ++i) mx = fmaxf(mx, fmaxf(st[0][i], st[1][i]));
        mx = fmaxf(mx, __shfl_xor(mx, 32));
        if (!__all(mx <= 8.0f && mx >= -24.0f)) {
            const float alpha = __builtin_amdgcn_exp2f(-mx);
            m += mx; l *= alpha;
#pragma unroll
            for (int sub = 0; sub < 2; ++sub)
#pragma unroll
                for (int i = 0; i < 16; ++i) st[sub][i] -= mx;
#pragma unroll
            for (int d = 0; d < 4; ++d)
#pragma unroll
                for (int i = 0; i < 16; ++i) O[d][i] *= alpha;
        }
        float ps = 0.f;
#pragma unroll
        for (int sub = 0; sub < 2; ++sub)
#pragma unroll
            for (int i = 0; i < 16; ++i) { st[sub][i] = __builtin_amdgcn_exp2f(st[sub][i]); ps += st[sub][i]; }
        l += ps;
        bf16x8 P[4];
#pragma unroll
        for (int sub = 0; sub < 2; ++sub) { P[2 * sub] = pack_p(st[sub], 0); P[2 * sub + 1] = pack_p(st[sub], 1); }
#pragma unroll
        for (int d = 0; d < 4; ++d)
#pragma unroll
            for (int kk = 0; kk < 4; ++kk) O[d] = MFMA32(*(const LAS bf16x8*)((const LAS unsigned char*)Vl + (32 * d + r) * 128 + (((2 * kk + hh) ^ ((r >> 1) & 7)) << 4)), P[kk], O[d]);
        __syncthreads();
    }
#undef DA_LOAD
    LAS float* CB = (LAS float*)(c.lds + DA_COMB) + qg * 4096;
    l += __shfl_xor(l, 32);
    if (mp == 1) { const float sc = ((const float*)(c.ws + WS_SCAL))[0] / l;
#pragma unroll
        for (int d = 0; d < 4; ++d)
#pragma unroll
            for (int i = 0; i < 16; ++i) CB[(32 * d + (i & 3) + 8 * (i >> 2) + 4 * hh) * 32 + r] = O[d][i] * sc; }
    __syncthreads();
    if (mp == 0) { const float i0 = 1.0f / l; float ss = 0.f;
#pragma unroll
        for (int d = 0; d < 4; ++d)
#pragma unroll
            for (int i = 0; i < 16; ++i) { const float y = O[d][i] * i0 - CB[(32 * d + (i & 3) + 8 * (i >> 2) + 4 * hh) * 32 + r]; O[d][i] = y; ss += y * y; }
        ss += __shfl_xor(ss, 32);
        const float rs = rsqrtf(ss * (1.0f / 128.0f) + 1e-5f) * 0.8f;
        const float* subln = c.in[I_SUBLN];
        bf16_t* orow = MIX + (size_t)(qrow0 + 32 * qg + r) * D + 2048 + h * 128;
#pragma unroll
        for (int d = 0; d < 4; ++d)
#pragma unroll
            for (int g = 0; g < 4; ++g) { const int dv = 32 * d + 8 * g + 4 * hh; const f32x4 sl = *(const f32x4*)(subln + dv);
                u32x2 wv; wv.x = pk_bf16(O[d][4 * g] * rs * sl[0], O[d][4 * g + 1] * rs * sl[1]); wv.y = pk_bf16(O[d][4 * g + 2] * rs * sl[2], O[d][4 * g + 3] * rs * sl[3]);
                *(u32x2*)(orow + dv) = wv; } }
    __syncthreads();
}
__device__ __forceinline__ void p_dattn_block(const Ctx& c, bool need_ctx) {
    const int nitems = NB * 16 * 32 + (need_ctx ? NB * 16 * 2 : 0);
    const bool remap = gridDim.x == 256;
    for (int item = blockIdx.x; item < nitems; item += gridDim.x) {
        int it = item;
        if (remap && item < NB * 16 * 32) { const int k = item >> 8, x = item & 7, sl = (item & 255) >> 3; it = (((k << 3) + x) << 5) | sl; }
        dattn_block_item(c, it);
    }
}

constexpr int P1_CQ = 0, P1_CK = 2048, P1_CV = 2304, P1_DQ = 2560, P1_DK = 3584, P1_DV = 4608, P1_DG = 6656;

constexpr int SW_KLD = 72, SW_VLD = 40;
constexpr int SW_KBYTES = 32 * SW_KLD * 2, SW_VBYTES = 64 * SW_VLD * 2, SW_BUF = SW_KBYTES + SW_VBYTES;
__device__ __forceinline__ void swa_block_item(const Ctx& c, int item) {
    const bf16_t* P1 = (const bf16_t*)(c.ar + AR_P1); const bf16_t* VTC = (const bf16_t*)(c.ar + AR_VTC); bf16_t* MIX = (bf16_t*)(c.ws + WS_XN);
    const int tid = c.tid, lane = c.lane, r = lane & 31, hh = lane >> 5;
    const int b = item >> 9, g = (item >> 7) & 3, q0 = (item & 127) * 32, hq = g * 8 + c.wave;
    const int qpos = q0 + r;
    bf16x8 q[4]; { const bf16_t* qp = P1 + (size_t)(b * SEQ + qpos) * NO + P1_CQ + hq * 64 + hh * 8;
#pragma unroll
        for (int ks = 0; ks < 4; ++ks) q[ks] = ld_frag(qp + ks * 16); }
    const bf16_t* VTh = VTC + ((size_t)b * 4 + g) * 64 * NKEY;
    f32x16 O[2];
#pragma unroll
    for (int d = 0; d < 2; ++d)
#pragma unroll
        for (int i = 0; i < 16; ++i) O[d][i] = 0.f;
    float m = 0.f, l = 0.f;
    const int wt0 = (q0 - 128 < 0 ? 0 : q0 - 128) / 32, wt1 = (q0 + 160 > SEQ ? SEQ : q0 + 160) / 32;
    const int nwt = wt1 - wt0, ntl = nwt + 8;
    u32x4 sreg;
    const bool kside = tid < 256; const int t2 = tid & 255;
#define SWB_LOAD(ti) do { const bool win_ = (ti) < nwt; const int kx_ = (win_ ? wt0 + (ti) : (SEQ / 32) + ((ti) - nwt)) * 32; \
        sreg = kside ? *(const u32x4*)(P1 + (size_t)((win_ ? b * SEQ + kx_ : TL + b * CTXL + (kx_ - SEQ)) + (t2 >> 3)) * NO + P1_CK + g * 64 + (t2 & 7) * 8) \
                     : *(const u32x4*)(VTh + (size_t)(t2 >> 2) * NKEY + kx_ + (t2 & 3) * 8); } while (0)
#define SWB_STORE(buf) do { LAS unsigned short* base_ = (LAS unsigned short*)(c.lds + (buf) * SW_BUF); \
        if (kside) *(LAS u32x4*)(base_ + (t2 >> 3) * SW_KLD + (t2 & 7) * 8) = sreg; else *(LAS u32x4*)(base_ + SW_KBYTES / 2 + (t2 >> 2) * SW_VLD + (t2 & 3) * 8) = sreg; } while (0)
    SWB_LOAD(0); SWB_STORE(0);
    __syncthreads();
    for (int ti = 0; ti < ntl; ++ti) {
        const bool win = ti < nwt; const int kx0 = (win ? wt0 + ti : (SEQ / 32) + (ti - nwt)) * 32;
        if (ti + 1 < ntl) SWB_LOAD(ti + 1);
        const LAS unsigned short* Kl = (const LAS unsigned short*)(c.lds + (ti & 1) * SW_BUF); const LAS unsigned short* Vl = Kl + SW_KBYTES / 2;
        f32x16 st;
        const float negm = -m;
#pragma unroll
        for (int i = 0; i < 16; ++i) st[i] = negm;
#pragma unroll
        for (int ks = 0; ks < 4; ++ks) st = MFMA32(*(const LAS bf16x8*)(Kl + r * SW_KLD + ks * 16 + hh * 8), q[ks], st);
        if (win && (kx0 == q0 - 128 || kx0 == q0 + 128)) {
#pragma unroll
            for (int i = 0; i < 16; ++i) { const int kpos = kx0 + (i & 3) + 8 * (i >> 2) + 4 * hh; const int dl = kpos - qpos; if (dl > 128 || dl < -128) st[i] = -1e30f; }
        }
        float mx = st[0];
#pragma unroll
        for (int i = 1; i < 16; ++i) mx = fmaxf(mx, st[i]);
        mx = fmaxf(mx, __shfl_xor(mx, 32));
        if (!__all(mx <= 8.0f && mx >= -24.0f)) {
            const float alpha = __builtin_amdgcn_exp2f(-mx);
            m += mx; l *= alpha;
#pragma unroll
            for (int i = 0; i < 16; ++i) st[i] -= mx;
#pragma unroll
            for (int d = 0; d < 2; ++d)
#pragma unroll
                for (int i = 0; i < 16; ++i) O[d][i] *= alpha;
        }
        float ps = 0.f;
#pragma unroll
        for (int i = 0; i < 16; ++i) { st[i] = __builtin_amdgcn_exp2f(st[i]); ps += st[i]; }
        l += ps;
        const bf16x8 p0 = pack_p(st, 0), p1 = pack_p(st, 1);
#pragma unroll
        for (int d = 0; d < 2; ++d) { O[d] = MFMA32(*(const LAS bf16x8*)(Vl + (32 * d + r) * SW_VLD + 8 * hh), p0, O[d]); O[d] = MFMA32(*(const LAS bf16x8*)(Vl + (32 * d + r) * SW_VLD + 16 + 8 * hh), p1, O[d]); }
        if (ti + 1 < ntl) SWB_STORE((ti + 1) & 1);
        __syncthreads();
    }
#undef SWB_LOAD
#undef SWB_STORE
    l += __shfl_xor(l, 32);
    l += __builtin_amdgcn_exp2f(c.in[I_SINK][hq] * LOG2E - m);
    const float il = 1.0f / l;
    bf16_t* orow = MIX + (size_t)(b * SEQ + qpos) * D + hq * 64;
#pragma unroll
    for (int d = 0; d < 2; ++d)
#pragma unroll
        for (int gq = 0; gq < 4; ++gq) { const int dv = 32 * d + 8 * gq + 4 * hh;
            u32x2 w; w.x = pk_bf16(O[d][4 * gq] * il, O[d][4 * gq + 1] * il); w.y = pk_bf16(O[d][4 * gq + 2] * il, O[d][4 * gq + 3] * il);
            *(u32x2*)(orow + dv) = w; }
}

DI float ret_lg(const Ctx& c, int dir, int h) { return log1pf(-exp2f(-c.in[I_RDEC][dir * 8 + h])); }
DI int ret_row0(int b, int cidx) { return cidx < 2 ? TL + b * CTXL + cidx * 128 : b * SEQ + (cidx - 2) * 128; }
constexpr int TK_LD = 136, TV_LD = 264;
constexpr int RT_LD = 136;
DI void stage_chunk_T(const Ctx& c, const bf16_t* src, int ld_src, int ncols, LAS unsigned short* T) {
    const int tid = c.tid, row = tid >> 2, part = tid & 3, cpt = ncols / 4;
    const bf16_t* p = src + (size_t)row * ld_src + part * cpt;
    for (int e = 0; e < cpt / 8; ++e) { const u32x4 w = *(const u32x4*)(p + e * 8);
#pragma unroll
        for (int j = 0; j < 4; ++j) { T[(part * cpt + e * 8 + 2 * j) * RT_LD + row] = (unsigned short)(w[j] & 0xffffu); T[(part * cpt + e * 8 + 2 * j + 1) * RT_LD + row] = (unsigned short)(w[j] >> 16); } }
}
__device__ __forceinline__ void p_ret_local(const Ctx& c) {
    const bf16_t* P1 = (const bf16_t*)(c.ar + AR_P1); h16* RU = (h16*)(c.ar + AR_RU);
    LAS unsigned short* TK = (LAS unsigned short*)c.lds; LAS unsigned short* TV = TK + 128 * RT_LD;
    const int lane = c.lane, r = lane & 31, hh = lane >> 5, w = c.wave;
    for (int item = blockIdx.x; item < NB * 8 * 34; item += gridDim.x) {
        const int cidx = item % 34, h = (item / 34) & 7, b = item / (34 * 8);
        const int row0 = ret_row0(b, cidx);
        stage_chunk_T(c, P1 + (size_t)row0 * NO + P1_DK + h * 128, NO, 128, TK);
        stage_chunk_T(c, P1 + (size_t)row0 * NO + P1_DV + h * 256, NO, 256, TV);
        __syncthreads();
        for (int dir = 0; dir < 2; ++dir) {
            const float lg = ret_lg(c, dir, h);
            f32x16 af[4];
#pragma unroll
            for (int dt = 0; dt < 4; ++dt)
#pragma unroll
                for (int i = 0; i < 16; ++i) af[dt][i] = 0.f;
#pragma unroll 1
            for (int ks = 0; ks < 8; ++ks) {
                const int i0 = ks * 16 + hh * 8;
                float vf[8]; unpack8(*(const LAS u32x4*)(TV + (32 * w + r) * RT_LD + i0), vf);
#pragma unroll
                for (int j = 0; j < 8; ++j) vf[j] *= __expf(lg * (float)(dir ? (i0 + j) : (127 - (i0 + j))));
                const bf16x8 fa = __builtin_bit_cast(bf16x8, pack8_bf16(vf));
#pragma unroll
                for (int dt = 0; dt < 4; ++dt) af[dt] = MFMA32(*(const LAS bf16x8*)(TK + (32 * dt + r) * RT_LD + i0), fa, af[dt]);
            }
            h16* U = RU + ((((size_t)b * 8 + h) * 2 + dir) * 34 + cidx) * 32768;
#pragma unroll
            for (int dt = 0; dt < 4; ++dt)
#pragma unroll
                for (int g = 0; g < 4; ++g) { f32x4 v4 = {af[dt][4 * g], af[dt][4 * g + 1], af[dt][4 * g + 2], af[dt][4 * g + 3]}; st4(U + (32 * w + r) * 128 + 32 * dt + 8 * g + 4 * hh, v4); }
        }
        __syncthreads();
    }
}
__device__ __forceinline__ void p_ret_prefix(const Ctx& c) {
    const h16* RU = (const h16*)(c.ar + AR_RU); bf16_t* RS = (bf16_t*)(c.ar + AR_RS);
    const size_t gtid = (size_t)blockIdx.x * NTHREADS + c.tid, gn = (size_t)gridDim.x * NTHREADS;
    for (size_t idx = gtid; idx < (size_t)NB * 8 * 2 * 8192; idx += gn) {
        const int el = (int)(idx & 8191) * 4, bhd = (int)(idx >> 13), dir = bhd & 1, h = (bhd >> 1) & 7;
        const float cd = __expf(ret_lg(c, dir, h) * 128.0f);
        const h16* U = RU + (size_t)bhd * 34 * 32768 + el; bf16_t* S = RS + (size_t)bhd * 32 * 32768 + el;
        u32x2 u[34];
#pragma unroll
        for (int ci = 0; ci < 34; ++ci) u[ci] = __builtin_nontemporal_load((const u32x2*)(U + (size_t)ci * 32768));
#define RP_U(ci) ((f32x4){h16lo(u[ci].x), h16hi(u[ci].x), h16lo(u[ci].y), h16hi(u[ci].y)})
        f32x4 s = {0.f, 0.f, 0.f, 0.f};
        if (dir == 0) {
#pragma unroll
            for (int ci = 0; ci < 34; ++ci) { if (ci >= 2) { u32x2 w = {pk_bf16(s[0], s[1]), pk_bf16(s[2], s[3])}; *(u32x2*)(S + (size_t)(ci - 2) * 32768) = w; } s = s * cd + RP_U(ci); } }
        else { s = s * cd + RP_U(1); s = s * cd + RP_U(0);
#pragma unroll
            for (int ci = 33; ci >= 2; --ci) { u32x2 w = {pk_bf16(s[0], s[1]), pk_bf16(s[2], s[3])}; *(u32x2*)(S + (size_t)(ci - 2) * 32768) = w; s = s * cd + RP_U(ci); } }
#undef RP_U
    }
}
__device__ __forceinline__ void p_ret_out(const Ctx& c) {
    const bf16_t* P1 = (const bf16_t*)(c.ar + AR_P1); const bf16_t* RS = (const bf16_t*)(c.ar + AR_RS); bf16_t* MIX = (bf16_t*)(c.ws + WS_XN);
    LAS unsigned short* TV = (LAS unsigned short*)c.lds;
    LAS float* XS = (LAS float*)(c.lds + 256 * RT_LD * 2);
    const int lane = c.lane, r = lane & 31, hh = lane >> 5, w = c.wave, qt = w & 3, eh = w >> 2;
    for (int item = blockIdx.x; item < NB * 8 * 32; item += gridDim.x) {
        const int lc = item & 31, h = (item >> 5) & 7, b = item >> 8;
        const int row0 = b * SEQ + lc * 128;
        stage_chunk_T(c, P1 + (size_t)row0 * NO + P1_DV + h * 256, NO, 256, TV);
        __syncthreads();
        const float lgf = ret_lg(c, 0, h), lgb = ret_lg(c, 1, h);
        const int qi = qt * 32 + r;
        const bf16_t* qp = P1 + (size_t)(row0 + qi) * NO + P1_DQ + h * 128 + hh * 8;
        f32x16 Y[4];
#pragma unroll
        for (int et = 0; et < 4; ++et)
#pragma unroll
            for (int i = 0; i < 16; ++i) Y[et][i] = 0.f;
        {
            const float qdf = __expf(lgf * (float)(qi + 1)), qdb = __expf(lgb * (float)(128 - qi));
            const bf16_t* Sf = RS + ((((size_t)b * 8 + h) * 2 + 0) * 32 + lc) * 32768; const bf16_t* Sb = RS + ((((size_t)b * 8 + h) * 2 + 1) * 32 + lc) * 32768;
#pragma unroll 1
            for (int ks = 0; ks < 8; ++ks) {
                float x[8], xf[8], xb[8]; unpack8(*(const u32x4*)(qp + ks * 16), x);
#pragma unroll
                for (int j = 0; j < 8; ++j) { xf[j] = x[j] * qdf; xb[j] = x[j] * qdb; }
                const bf16x8 qf = __builtin_bit_cast(bf16x8, pack8_bf16(xf)), qb = __builtin_bit_cast(bf16x8, pack8_bf16(xb));
#pragma unroll
                for (int et = 0; et < 4; ++et) { const int e = eh * 128 + et * 32 + r;
                    Y[et] = MFMA32(ld_frag(Sf + (size_t)e * 128 + ks * 16 + hh * 8), qf, Y[et]);
                    Y[et] = MFMA32(ld_frag(Sb + (size_t)e * 128 + ks * 16 + hh * 8), qb, Y[et]); }
            }
        }
#pragma unroll 1
        for (int kt = 0; kt < 4; ++kt) {
            f32x16 st;
#pragma unroll
            for (int i = 0; i < 16; ++i) st[i] = 0.f;
            const bf16_t* kp = P1 + (size_t)(row0 + kt * 32 + r) * NO + P1_DK + h * 128 + hh * 8;
#pragma unroll
            for (int ks = 0; ks < 8; ++ks) st = MFMA32(ld_frag(kp + ks * 16), ld_frag(qp + ks * 16), st);
#pragma unroll
            for (int i = 0; i < 16; ++i) { const int ki = kt * 32 + (i & 3) + 8 * (i >> 2) + 4 * hh; const int dl = qi - ki;
                const float f = dl > 0 ? __expf(lgf * (float)dl) : (dl < 0 ? __expf(lgb * (float)(-dl)) : 2.0f); st[i] *= f; }
            const bf16x8 p0 = pack_p(st, 0), p1 = pack_p(st, 1);
#pragma unroll
            for (int et = 0; et < 4; ++et) { const int e = eh * 128 + et * 32 + r;
#pragma unroll
                for (int s = 0; s < 2; ++s) { const u32x2 lo = *(const LAS u32x2*)(TV + e * RT_LD + kt * 32 + 16 * s + 4 * hh), hi = *(const LAS u32x2*)(TV + e * RT_LD + kt * 32 + 16 * s + 8 + 4 * hh);
                    u32x4 vw = {lo.x, lo.y, hi.x, hi.y};
                    Y[et] = MFMA32(__builtin_bit_cast(bf16x8, vw), s == 0 ? p0 : p1, Y[et]); } }
        }
        float ss = 0.f;
#pragma unroll
        for (int et = 0; et < 4; ++et)
#pragma unroll
            for (int i = 0; i < 16; ++i) ss += Y[et][i] * Y[et][i];
        ss += __shfl_xor(ss, 32);
        if (hh == 0) XS[(eh * 4 + qt) * 32 + r] = ss;
        __syncthreads();
        const float tot = XS[(0 * 4 + qt) * 32 + r] + XS[(1 * 4 + qt) * 32 + r];
        const float rs = rsqrtf(tot * (1.0f / 256.0f) + 1e-6f);
        const bf16_t* gp = P1 + (size_t)(row0 + qi) * NO + P1_DG + h * 256; bf16_t* op = MIX + (size_t)(row0 + qi) * D + 2048 + h * 256;
#pragma unroll
        for (int et = 0; et < 4; ++et)
#pragma unroll
            for (int gq = 0; gq < 4; ++gq) { const int e = eh * 128 + et * 32 + 8 * gq + 4 * hh;
                const u32x2 gw = *(const u32x2*)(gp + e);
                const float g0 = bflo(gw.x), g1 = bfhi(gw.x), g2 = bflo(gw.y), g3 = bfhi(gw.y);
                u32x2 o; o.x = pk_bf16(Y[et][4 * gq] * rs * silu_f(g0), Y[et][4 * gq + 1] * rs * silu_f(g1)); o.y = pk_bf16(Y[et][4 * gq + 2] * rs * silu_f(g2), Y[et][4 * gq + 3] * rs * silu_f(g3));
                *(u32x2*)(op + e) = o; }
        __syncthreads();
    }
}

#define MK_PER_PHASE 0
#ifndef MK_PER_PHASE
#define MK_PER_PHASE 0
#endif
constexpr int N_PHASES = 25;
constexpr int LDS_STAGE = 4 * K1_WAVE_LDS;
constexpr int LDS_BYTES = LDS_STAGE + 256;

__global__ void __launch_bounds__(NTHREADS, 2) mk_fwd(Args a) {
    extern __shared__ __attribute__((aligned(16))) unsigned char smem[];
    Ctx c;
#pragma unroll
    for (int i = 0; i < 29; ++i) c.in[i] = a.in[i];
    c.out = a.out; c.ws = a.ws; c.ar = a.ws + WS_ARENA; c.lds = (LAS unsigned char*)smem;
    c.tid = threadIdx.x; c.lane = c.tid & 63; c.wave = __builtin_amdgcn_readfirstlane(c.tid >> 6);
    volatile LAS unsigned* xbw = (volatile LAS unsigned*)(c.lds + LDS_STAGE);
    if (c.tid < 4) xbw[c.tid] = 0u;
    __syncthreads();
    XcdBarrier bar; bar.bar = (unsigned*)(a.ws + WS_CTL); bar.x = 0; bar.st = xbw;
    if (!MK_PER_PHASE) bar = xcd_barrier_post((unsigned*)(a.ws + WS_CTL), xbw);
    const int lo = a.ph_lo, hi = a.ph_hi;
#ifndef PH_MASK
#define PH_MASK 0x1ffffffu
#endif
#define IN(k) (((PH_MASK >> (k)) & 1u) && lo <= (k) && (k) < hi)
#define SEAM(k) do { if (IN(k) && IN((k) + 1)) { xcd_barrier(bar); } } while (0)
    res_t* H = (res_t*)(c.ws + WS_H); const float* MOD = (const float*)(c.ws + WS_MOD);
    const bf16_t* XN = (const bf16_t*)(c.ws + WS_XN); unsigned char* W = c.ws + WS_W;
    LAS unsigned char* gl = c.lds; float* SLAB = (float*)(c.ar + AR_SLAB); unsigned char* W1 = c.ws + WS_W1;

    if (IN(0)) { p_mod(c); p_weights_layer0(c); p_wcolmax(c, CmxDeal{(int)blockIdx.x, (int)gridDim.x, 0, cmx_p0(gridDim.x)}); }
    SEAM(0);
    if (IN(1)) { p_mod_finalize(c); p_norm_mod<4>(c, c.in[I_X], c.in[I_CTX], TT, (const float*)(c.ar + AR_MODP), 0, 1); }
    SEAM(1);
    if (IN(2)) { const int ns = cmx_ns(gridDim.x), gg = (int)gridDim.x - ns;
        if ((int)blockIdx.x < gg) { pg8::Gemm g{XN, (const bf16_t*)(W + W_IN), TT, NE, D}; LatThenCtxOrder S; S.init2(NE, gg, blockIdx.x, D);
            EpiInEven E{(bf16_t*)(c.ar + AR_PA), (bf16_t*)(c.ar + AR_PB), (const float*)(c.ws + WS_AXC), (const float*)(c.ws + WS_AXS)};
            pg8::gemm_phase(gl, g, S, E); }
        else p_wcolmax(c, CmxDeal{(int)blockIdx.x - gg, ns, cmx_p0(gridDim.x), CMX_TOTAL}); }
    SEAM(2);
    if (IN(3)) { p_rwkv_prepA(c); p_build_vt<128, 16>(c, (const bf16_t*)(c.ar + AR_PB), COLS_B, 4096, (bf16_t*)(c.ar + AR_VT)); }
    SEAM(3);
    if (IN(4)) { pg8::Gemm g{(const bf16_t*)(c.ar + AR_LA), (const bf16_t*)(W + W_LORA), TT, LORA_N, LORA_K}; LoraOrder S; S.init2(LORA_N, gridDim.x, blockIdx.x, LORA_KU);
        EpiLora E{c.in[I_W0], c.in[I_A0], c.in[I_KA], (const bf16_t*)(c.ar + AR_K), (const h16*)(c.ar + AR_KK), (h16*)(c.ar + AR_OMW), (h16*)(c.ar + AR_BB), (h16*)(c.ar + AR_KD), (bf16_t*)(c.ar + AR_G)};
        pg8::gemm_phase(gl, g, S, E); }
    SEAM(4);
    if (IN(5)) {
#ifndef NO_DATTN
        p_dattn_block(c, true); __syncthreads();
#endif
#ifndef NO_K1
        p_rwkv_k1_and_conv(c);
#endif
    }
    SEAM(5);
    if (IN(6)) p_rwkv_seq_and_conv(c);
    SEAM(6);
    if (IN(7)) p_rwkv_out(c, TT);
    SEAM(7);
    if (IN(8)) { constexpr int KE = MIX_I8 ? D / 2 : D; const float* SAq = (const float*)(c.ar + AR_XQS);
        pg8::Gemm g{MIX_I8 ? (const bf16_t*)(c.ar + AR_XQ) : XN, (const bf16_t*)(W + W_MIX), TT, D, KE}; pg8::StaticOrder S; S.init(TL, D, gridDim.x, blockIdx.x, KE);
        EpiResModT<MIX_I8 != 0, float> E{c.in[I_X], c.in[I_CTX], H, MOD + 2 * 4096, SAq, i8_cs(c, CM_MIX)};
        pg8::gemm_phase(gl, g, S, E);
        CtxSplitOrder S2; S2.init(D, gridDim.x, blockIdx.x, KE); EpiSlabT<MIX_I8 != 0> E2{SLAB, SAq, i8_cs(c, CM_MIX)};
        pg8::gemm_phase(gl, g, S2, E2); }
    SEAM(8);
    if (IN(9)) { p_ctx_fix(c, c.in[I_CTX], MOD + 4 * 24576 + 2 * 4096, SLAB, H); p_norm_mod<1, FFN_I8 != 0, res_t>(c, H, H + (size_t)TL * D, TT, MOD, 3, 4); }
    SEAM(9);
    if (IN(10)) { constexpr int KE = FFN_I8 ? D / 2 : D;
        pg8::Gemm g{XN, (const bf16_t*)(W + W_FFI), TT, 2 * DFF, KE}; LatThenCtxOrder S; S.init2(2 * DFF, gridDim.x, blockIdx.x, KE);
        EpiConvGlu E{(bf16_t*)(c.ar + AR_HID), (bf16_t*)(c.ar + AR_SG), (bf16_t*)(c.ar + AR_SU), c.in[I_CONVW], c.in[I_CONVB], (const float*)(c.ws + WS_XN + (size_t)TT * D), i8_cs(c, CM_FFI)};
        pg8::gemm_phase(gl, g, S, E); }
    SEAM(10);
    if (IN(11)) { p_conv_fix(c, 0, TT); if (FFO0_I8 && IN(12)) { xcd_barrier(bar); p_quant_hid(c, TT); } }
    SEAM(11);
    if (IN(12)) { constexpr int KE = FFO0_I8 ? DFF / 2 : DFF; const float* SAq = (const float*)(c.ar + AR_HQS);
        pg8::Gemm g{(const bf16_t*)(c.ar + (FFO0_I8 ? AR_HQ : AR_HID)), (const bf16_t*)(W + W_FFO), TT, D, KE}; pg8::StaticOrder S; S.init(TL, D, gridDim.x, blockIdx.x, KE);
        EpiResModT<FFO0_I8 != 0> E{H, H + (size_t)TL * D, H, MOD + 5 * 4096, SAq, i8_cs(c, CM_FFO0)};
        pg8::gemm_phase(gl, g, S, E);
        CtxSplitOrder S2; S2.init(D, gridDim.x, blockIdx.x, KE); EpiSlabT<FFO0_I8 != 0> E2{SLAB, SAq, i8_cs(c, CM_FFO0)};
        pg8::gemm_phase(gl, g, S2, E2); }
    SEAM(12);
    const float* MOD1 = MOD + 5 * 24576;
    if (IN(13)) { p_ctx_fix(c, H + (size_t)TL * D, MOD + 4 * 24576 + 5 * 4096, SLAB, H); p_norm_mod<1, INO_I8 != 0, res_t>(c, H, H + (size_t)TL * D, TT, MOD1, 0, 1); }
    SEAM(13);
    if (IN(14)) { constexpr int KE = INO_I8 ? D / 2 : D;
        pg8::Gemm g{XN, (const bf16_t*)(W + W_IN), TT, NO, KE}; OddInOrder S; S.init2(gridDim.x, blockIdx.x, KE);
        EpiInOdd E{(bf16_t*)(c.ar + AR_P1), (const float*)(c.ws + WS_AXC), (const float*)(c.ws + WS_AXS), (const float*)(c.ws + WS_RTC), (const float*)(c.ws + WS_RTS), (const float*)(c.ws + WS_XN + (size_t)TT * D), i8_cs(c, CM_INO)};
        pg8::gemm_phase(gl, g, S, E); }
    SEAM(14);
    if (IN(15)) { p_build_vt<64, 4>(c, (const bf16_t*)(c.ar + AR_P1), NO, P1_CV, (bf16_t*)(c.ar + AR_VTC)); }
    SEAM(15);
    if (IN(16)) { p_ret_local(c); for (int item = blockIdx.x; item < NB * 4 * 128; item += gridDim.x) swa_block_item(c, item); }
    SEAM(16);
    if (IN(17)) p_ret_prefix(c);
    SEAM(17);
    if (IN(18)) p_ret_out(c);
    SEAM(18);
    if (MIX_I8 && IN(18) && IN(19)) { p_quant_mix(c, TL); xcd_barrier(bar); }
    if (IN(19)) { constexpr int KE = MIX_I8 ? D / 2 : D;
        pg8::Gemm g{MIX_I8 ? (const bf16_t*)(c.ar + AR_XQ) : XN, (const bf16_t*)(W1 + W1_MIX), TL, D, KE}; pg8::StaticOrder S; S.init(TL, D, gridDim.x, blockIdx.x, KE);
        EpiResModT<MIX_I8 != 0> E{H, H + (size_t)TL * D, H, MOD1 + 2 * 4096, (const float*)(c.ar + AR_XQS), i8_cs(c, CM_MIX + D)};
        pg8::gemm_phase(gl, g, S, E); }
    SEAM(19);
    if (IN(20)) p_norm_mod<1, FFN_I8 != 0, res_t>(c, H, H + (size_t)TL * D, TL, MOD1, 3, 4);
    SEAM(20);
    if (IN(21)) { constexpr int KE = FFN_I8 ? D / 2 : D;
        pg8::Gemm g{XN, (const bf16_t*)(W1 + W1_FFI), TL, 2 * DFF, KE}; pg8::StaticOrder S; S.init(TL, 2 * DFF, gridDim.x, blockIdx.x, KE);
        EpiConvGlu E{(bf16_t*)(c.ar + AR_HID), (bf16_t*)(c.ar + AR_SG), (bf16_t*)(c.ar + AR_SU), c.in[I_CONVW] + (size_t)3 * DFF, c.in[I_CONVB] + DFF, (const float*)(c.ws + WS_XN + (size_t)TT * D), i8_cs(c, CM_FFI + 2 * DFF)};
        pg8::gemm_phase(gl, g, S, E); }
    SEAM(21);
    if (IN(22)) { p_conv_fix(c, 1, TL); if (FFO1_I8 && IN(23)) { xcd_barrier(bar); p_quant_hid(c, TL); } }
    SEAM(22);
    if (IN(23)) { constexpr int KE = FFO1_I8 ? DFF / 2 : DFF;
        pg8::Gemm g{(const bf16_t*)(c.ar + (FFO1_I8 ? AR_HQ : AR_HID)), (const bf16_t*)(W1 + W1_FFO), TL, D, KE}; pg8::StaticOrder S; S.init(TL, D, gridDim.x, blockIdx.x, KE);
        EpiResModT<FFO1_I8 != 0> E{H, H + (size_t)TL * D, H, MOD1 + 5 * 4096, (const float*)(c.ar + AR_HQS), i8_cs(c, CM_FFO1)};
        pg8::gemm_phase(gl, g, S, E); }
    SEAM(23);
    if (IN(24)) p_final_norm(c);
#undef IN
#undef SEAM
}

extern "C" void kernel_launch(void* const* d_in, const int* in_sizes, int n_in, void* d_out, int out_size, void* d_ws, size_t ws_size, hipStream_t stream) {
    static int grid = 0;
    if (grid == 0) {
        if (n_in != 29 || ws_size < WS_END) { fprintf(stderr, "kernel_launch: need 29 inputs and >= %zu bytes of workspace; got n_in %d, ws %zu; nothing launched\n", (size_t)WS_END, n_in, ws_size); grid = -1; return; }
        int dev = 0, cus = 0, per_cu = 0;
        if (hipGetDevice(&dev) != hipSuccess || hipDeviceGetAttribute(&cus, hipDeviceAttributeMultiprocessorCount, dev) != hipSuccess) { grid = -1; return; }
        if (hipFuncSetAttribute((const void*)mk_fwd, hipFuncAttributeMaxDynamicSharedMemorySize, LDS_BYTES) != hipSuccess) { fprintf(stderr, "kernel_launch: hipFuncSetAttribute failed\n"); grid = -1; return; }
        if (hipOccupancyMaxActiveBlocksPerMultiprocessor(&per_cu, (const void*)mk_fwd, NTHREADS, LDS_BYTES) != hipSuccess || per_cu < 1) { fprintf(stderr, "kernel_launch: occupancy query says %d blocks per CU\n", per_cu); per_cu = 1; }
        (void)hipGetLastError();
        grid = cus;
    }
    if (grid < 0) return;
    (void)hipMemsetAsync((char*)d_ws + WS_CTL, 0, CTL_BYTES, stream);
    Args a{};
    for (int i = 0; i < 29; ++i) a.in[i] = (const float*)d_in[i];
    a.out = (float*)d_out; a.ws = (unsigned char*)d_ws;
#if MK_PER_PHASE
    for (int p = 0; p < N_PHASES; ++p) { a.ph_lo = p; a.ph_hi = p + 1; hipLaunchKernelGGL(mk_fwd, dim3(grid), dim3(NTHREADS), LDS_BYTES, stream, a); }
#else
    a.ph_lo = 0; a.ph_hi = N_PHASES;
    hipLaunchKernelGGL(mk_fwd, dim3(grid), dim3(NTHREADS), LDS_BYTES, stream, a);
#endif
    (void)in_sizes; (void)out_size;
}
```

```cpp
#include <hip/hip_runtime.h>
#include <cstdio>
#include <cstdint>

#define LAS __attribute__((address_space(3)))
#define DI __device__ __forceinline__
typedef unsigned short bf16_t;
typedef _Float16 h16;
typedef short bf16x8 __attribute__((ext_vector_type(8)));
typedef float f32x4 __attribute__((ext_vector_type(4)));
typedef int i32x4 __attribute__((ext_vector_type(4)));
typedef float f32x2 __attribute__((ext_vector_type(2)));
typedef float f32x16 __attribute__((ext_vector_type(16)));
typedef unsigned u32x4 __attribute__((ext_vector_type(4)));
typedef unsigned u32x2 __attribute__((ext_vector_type(2)));
typedef __bf16 bf16x2_n __attribute__((ext_vector_type(2)));
typedef _Float16 h16x2_n __attribute__((ext_vector_type(2)));

constexpr int D = 4096, NB = 4, SEQ = 4096, CTXL = 256;
constexpr int TL = NB * SEQ, TC = NB * CTXL, TT = TL + TC;
constexpr int DFF = 11008;
constexpr int HALF_W = 2048;
constexpr int COLS_A = 6784, COLS_A_PAD = 6912, COLS_B = 6144, NE = COLS_A_PAD + COLS_B;
constexpr int COLS_C = 2560, COLS_D = 6144, NO = COLS_C + COLS_D;
constexpr int NKEY = SEQ + CTXL;
constexpr int LORA_K = 1280, LORA_KU = 256, LORA_N = 5 * 2048;
constexpr int NTHREADS = 512;

constexpr size_t al256(size_t x) { return (x + 255) & ~(size_t)255; }
constexpr size_t WS_CTL = 0;
constexpr size_t CTL_CMAX = 65536;
constexpr int CM_FFI = 0, CM_INO = 2 * 2 * 11008, CM_INE = CM_INO + 8704, CM_MIX = CM_INE + 13056, CM_FFO1 = CM_MIX + 2 * 4096, CM_FFO0 = CM_FFO1 + 4096, CM_END = CM_FFO0 + 4096;
constexpr size_t CTL_BYTES = CTL_CMAX + (((size_t)CM_END * 4 + 255) & ~(size_t)255);
constexpr size_t WS_MOD = WS_CTL + CTL_BYTES;
constexpr size_t WS_SCAL = WS_MOD + al256((size_t)2 * 5 * 6 * D * 4);
constexpr size_t WS_CS = WS_SCAL + 256;
constexpr size_t WS_AXC = WS_CS + (((size_t)CM_END * 4 + 255) & ~(size_t)255);
constexpr size_t WS_AXS = WS_AXC + (size_t)SEQ * 32 * 4;
constexpr size_t WS_RTC = WS_AXS + (size_t)SEQ * 32 * 4;
constexpr size_t WS_RTS = WS_RTC + (size_t)NKEY * 64 * 4;
constexpr size_t WS_W = WS_RTS + (size_t)NKEY * 64 * 4;
constexpr size_t W_IN = 0;
constexpr size_t W_MIX = W_IN + (size_t)NE * D * 2;
constexpr size_t W_FFI = W_MIX + (size_t)D * D * 2;
constexpr size_t W_FFO = W_FFI + (size_t)2 * DFF * D * 2;
constexpr size_t W_LORA = W_FFO + (size_t)D * DFF * 2;
constexpr size_t W_BYTES = W_LORA + (size_t)LORA_N * LORA_K * 2;
constexpr size_t WS_H = WS_W + al256(W_BYTES);
constexpr size_t WS_XN = WS_H + (size_t)TT * D * 4;
constexpr size_t WS_W1 = WS_XN + (size_t)TT * D * 2;
constexpr size_t W1_MIX = 0, W1_FFI = W1_MIX + (size_t)D * D * 2, W1_FFO = W1_FFI + (size_t)2 * DFF * D * 2, W1_BYTES = W1_FFO + (size_t)D * DFF * 2;
constexpr size_t WS_ARENA = WS_W1 + al256(W1_BYTES);
constexpr size_t SZ16 = (size_t)TT * 2048 * 2;
constexpr size_t MOD_FLOATS = (size_t)2 * 5 * 6 * D;
constexpr size_t AR_XQ = 0, AR_XQS = (size_t)80 << 20;
constexpr size_t AR_MODP = 0;
constexpr size_t AR_PA = 0;
constexpr size_t AR_K = AR_PA + (size_t)TT * COLS_A_PAD * 2;
constexpr size_t AR_LA = AR_K + SZ16;
constexpr size_t RW_NCH = 136;
constexpr size_t CH_BYTES = 24576;
constexpr size_t AR_CH = 0;
constexpr size_t AR_CH_END = AR_CH + (size_t)256 * RW_NCH * CH_BYTES;
constexpr size_t AR_PB = AR_CH_END;
constexpr size_t AR_VT = AR_PB + (size_t)TT * COLS_B * 2;
constexpr size_t AR_R = AR_VT + (size_t)NB * 16 * 128 * NKEY * 2;
constexpr size_t AR_KK = AR_R + SZ16;
constexpr size_t AR_V = AR_KK + SZ16;
constexpr size_t AR_OMW = AR_V + SZ16;
constexpr size_t AR_BB = AR_OMW + 2 * SZ16;
constexpr size_t AR_KD = AR_BB + 2 * SZ16;
constexpr size_t AR_G = AR_KD + 2 * SZ16;
constexpr size_t AR_Y = AR_G + SZ16;
constexpr size_t AR_EVEN_END = AR_Y + 2 * SZ16;
static_assert(AR_LA + (size_t)TT * LORA_K * 2 <= AR_CH_END, "PA|K|LA must sit under the chunk matrices");
constexpr size_t AR_GU = 0;
constexpr size_t AR_SG = 0, AR_SU = AR_SG + (size_t)(TT / 64) * 4 * DFF * 2;
constexpr size_t AR_HQ = (size_t)64 << 20, AR_HQS = (size_t)320 << 20;
constexpr size_t AR_HID = AR_GU + (size_t)TT * 2 * DFF * 2;
constexpr size_t AR_FFN_END = AR_HID + (size_t)TT * DFF * 2;
constexpr size_t AR_P1 = 0;
constexpr size_t AR_VTC = AR_P1 + (size_t)TT * NO * 2;
constexpr size_t AR_RU = AR_VTC + (size_t)NB * 4 * 64 * NKEY * 2;
constexpr size_t AR_RS = AR_RU + (size_t)NB * 8 * 2 * 34 * 256 * 128 * 4;
constexpr size_t AR_ODD_END = AR_RS + (size_t)NB * 8 * 2 * 32 * 256 * 128 * 2;
constexpr size_t AR_SLAB = (size_t)1300 << 20;
constexpr size_t AR_SLAB_END = AR_SLAB + (size_t)4 * TC * D * 4;
static_assert(AR_SLAB >= AR_FFN_END, "slab overlaps the FFN buffers");
constexpr size_t cmax(size_t a, size_t b) { return a > b ? a : b; }
constexpr size_t AR_BYTES = cmax(cmax(AR_EVEN_END, AR_FFN_END), AR_ODD_END);
constexpr size_t WS_END = WS_ARENA + AR_BYTES;
static_assert(WS_END <= (size_t)3221225472ull, "workspace plan exceeds 4 x the largest input tensor");
static_assert(AR_SLAB_END <= AR_BYTES, "slab outside the arena");

DI float bf2f(bf16_t x) { return __uint_as_float((unsigned)x << 16); }
DI bf16_t f2bf(float x) { return __builtin_bit_cast(unsigned short, (__bf16)x); }
DI unsigned pk_bf16(float lo, float hi) { f32x2 v = {lo, hi}; return __builtin_bit_cast(unsigned, __builtin_convertvector(v, bf16x2_n)); }
DI unsigned pk_f16(float lo, float hi) { f32x2 v = {lo, hi}; return __builtin_bit_cast(unsigned, __builtin_convertvector(v, h16x2_n)); }
DI float bflo(unsigned w) { return __uint_as_float(w << 16); }
DI float bfhi(unsigned w) { return __uint_as_float(w & 0xffff0000u); }
DI float h16lo(unsigned w) { return (float)__builtin_bit_cast(h16x2_n, w)[0]; }
DI float h16hi(unsigned w) { return (float)__builtin_bit_cast(h16x2_n, w)[1]; }
DI float silu_f(float x) { return x * __builtin_amdgcn_rcpf(1.0f + __expf(-x)); }
DI float sigmoid_f(float x) { return __builtin_amdgcn_rcpf(1.0f + __expf(-x)); }
DI float wave_sum(float v) {
#pragma unroll
    for (int o = 32; o >= 1; o >>= 1) v += __shfl_xor(v, o);
    return v;
}
DI void load8f(const float* p, float (&o)[8]) { const f32x4 a = *(const f32x4*)p, b = *(const f32x4*)(p + 4);
#pragma unroll
    for (int j = 0; j < 4; ++j) { o[j] = a[j]; o[4 + j] = b[j]; } }
#ifndef RES_F16
#define RES_F16 1
#endif
#if RES_F16
typedef h16 res_t;
#else
typedef float res_t;
#endif
DI f32x4 ld4(const float* p) { return *(const f32x4*)p; }
DI void st4(float* p, const f32x4 v) { *(f32x4*)p = v; }
#if RES_F16
DI f32x4 ld4(const h16* p) { const u32x2 w = *(const u32x2*)p; f32x4 v = {h16lo(w.x), h16hi(w.x), h16lo(w.y), h16hi(w.y)}; return v; }
DI void st4(h16* p, const f32x4 v) { u32x2 w = {pk_f16(v[0], v[1]), pk_f16(v[2], v[3])}; *(u32x2*)p = w; }
#endif
DI int row_modidx(int row) { return row < TL ? (row >> 12) : 4; }

#define XB_TMO      128
#define XB_XCNT(j)  (256  + 64 * (j))
#define XB_XSUB(j)  (1280 + 64 * (j))
#define XB_XGEN(j)  (2304 + 64 * (j))
#define XB_TOP      3328
#define XB_TOPGEN   3392
#define XCD_BAR_WORDS 3456
#define XB_SPIN_CAP (1u << 22)

__device__ __forceinline__ unsigned xb_ld(unsigned* p)              { return __hip_atomic_load(p, __ATOMIC_RELAXED, __HIP_MEMORY_SCOPE_AGENT); }
__device__ __forceinline__ unsigned xb_add(unsigned* p, unsigned v) { return __hip_atomic_fetch_add(p, v, __ATOMIC_RELAXED, __HIP_MEMORY_SCOPE_AGENT); }
__device__ __forceinline__ unsigned xb_xcc_id() { return (unsigned)__builtin_amdgcn_s_getreg((3 << 11) | 20) & 0xFu; }
#define XB_SPIN(cond, bar) do { unsigned _sp = 0; while (cond) { __builtin_amdgcn_s_sleep(1); \
    if ((++_sp & 255u) == 0u) { if (xb_ld(&(bar)[XB_TMO])) break; if (_sp > XB_SPIN_CAP) { atomicAdd(&(bar)[XB_TMO], 1u); break; } } } } while (0)

struct XcdBarrier {
    unsigned* bar; unsigned x;
    volatile LAS unsigned* st;
};

__device__ __forceinline__ XcdBarrier xcd_barrier_post(unsigned* bar, volatile LAS unsigned* st) {
    XcdBarrier b; b.bar = bar; b.x = xb_xcc_id(); b.st = st;
    if (threadIdx.x == 0) (void)xb_add(&bar[XB_XCNT(b.x)], 1u);
    return b;
}
__device__ __forceinline__ void xcd_barrier_complete(unsigned* bar, unsigned x, unsigned& nloc, unsigned& nx) {
    const unsigned G = gridDim.x * gridDim.y * gridDim.z;
    unsigned sum, cnt, mine, sp = 0u;
    for (;;) {
        sum = 0u; cnt = 0u; mine = 0u;
#pragma unroll
        for (unsigned j = 0; j < 16; ++j) { const unsigned c = xb_ld(&bar[XB_XCNT(j)]); sum += c; cnt += (c > 0u) ? 1u : 0u; mine = (j == x) ? c : mine; }
        if (sum == G) break;
        __builtin_amdgcn_s_sleep(1);
        if ((++sp & 255u) == 0u) { if (xb_ld(&bar[XB_TMO])) break; if (sp > XB_SPIN_CAP) { atomicAdd(&bar[XB_TMO], 1u); break; } }
    }
    nloc = mine > 0u ? mine : 1u; nx = cnt > 0u ? cnt : 1u;
}

__device__ __forceinline__ void xcd_barrier(const XcdBarrier& b) {
    asm volatile("s_waitcnt vmcnt(0)" ::: "memory");
    __syncthreads();
    if (threadIdx.x == 0) {
        unsigned* bar = b.bar;
        __builtin_amdgcn_s_waitcnt(0);
        unsigned nloc = b.st[0], nx = b.st[1];
        if (nloc == 0u) { xcd_barrier_complete(bar, b.x, nloc, nx); b.st[0] = nloc; b.st[1] = nx; }
        const unsigned old = xb_add(&bar[XB_XSUB(b.x)], 1u);
        const unsigned gen = old / nloc;
        if (old + 1u == (gen + 1u) * nloc) {
            __builtin_amdgcn_fence(__ATOMIC_RELEASE, "agent");
            asm volatile("s_waitcnt vmcnt(0)" ::: "memory");
            const unsigned og = xb_add(&bar[XB_TOP], 1u);
            const unsigned tg = og / nx;
            if (og + 1u == (tg + 1u) * nx) xb_add(&bar[XB_TOPGEN], 1u);
            else XB_SPIN(xb_ld(&bar[XB_TOPGEN]) == tg, bar);
            __builtin_amdgcn_fence(__ATOMIC_ACQUIRE, "agent");
            xb_add(&bar[XB_XGEN(b.x)], 1u);
            asm volatile("s_waitcnt vmcnt(0)" ::: "memory");
        } else {
            XB_SPIN(xb_ld(&bar[XB_XGEN(b.x)]) == gen, bar);
            __builtin_amdgcn_fence(__ATOMIC_ACQUIRE, "agent");
            asm volatile("s_waitcnt vmcnt(0)" ::: "memory");
        }
    }
    __syncthreads();
}

namespace pg8 {
#define PG8_LAS __attribute__((address_space(3)))
constexpr int BM = 256, BK = 64, HALF = 128, HTB = HALF * BK * 2  , STAGE_BYTES = 8 * HTB, NXCD = 8, WGM = 4;

__host__ __device__ __forceinline__ int lds_byte(int r, int c) { const int st = (r >> 4) * 2 + (c >> 5), rr = r & 15, cc = c & 31, ob = rr * 64 + cc * 2; return st * 1024 + (ob ^ (((ob >> 9) & 1) << 5)); }
__host__ __device__ __forceinline__ void stage_rc(int b, int& R, int& C) { const int st = b / 1024, sb = b % 1024, swz = sb ^ (((sb >> 9) & 1) << 5); R = (st >> 1) * 16 + swz / 64; C = (st & 1) * 32 + (swz % 64) / 2; }
__host__ __device__ __forceinline__ int perm32(int rho) { const int n = rho >> 4, i = rho & 15; return 8 * (i >> 2) + 4 * n + (i & 3); }

struct Unit { int pm, pn, koff, nt, part; };
struct Gemm { const bf16_t* A; const bf16_t* Bt; int M, N, K; };

struct StaticOrder {
    int nM, nN, nwg, G, c, ntk;
    __host__ __device__ void init(int M, int N, int G_, int c_, int K_ = 0) { nM = M / BM; nN = N / BM; nwg = nM * nN; G = G_; c = c_; ntk = K_ / BK; }
    __host__ __device__ bool next(int i, Unit& u) const {
        const long L = (long)i * G + c; if (L >= nwg) return false;
        int wgid = (int)L; { const int q = nwg / NXCD, r = nwg % NXCD, xcd = wgid % NXCD, off = wgid / NXCD; wgid = (xcd < r ? xcd * (q + 1) : r * (q + 1) + (xcd - r) * q) + off; }
        const int nig = WGM * nN, gid = wgid / nig, fm = gid * WGM, gsz = (nM - fm) < WGM ? (nM - fm) : WGM;
        u.pm = fm + ((wgid % nig) % gsz); u.pn = (wgid % nig) / gsz; u.koff = 0; u.nt = ntk; u.part = -1; return true;
    }
    __device__ __forceinline__ void a_ready(const Unit&) const {}
    __device__ __forceinline__ void done(const Unit&) const {}
};


template <class Epi, class Sched>
__device__ __forceinline__ void gemm_phase(PG8_LAS unsigned char* lds, const Gemm g, const Sched& S, const Epi& E) {
    const int tid = threadIdx.x, wid = __builtin_amdgcn_readfirstlane(tid >> 6), lane = tid & 63, wr = wid >> 2, wc = wid & 3, fr = lane & 15, fq = lane >> 4;
    const int K = g.K;
    unsigned voffA[2], voffB[2];
#pragma unroll
    for (int i = 0; i < 2; ++i) { int R, C; stage_rc(tid * 16 + i * 8192, R, C); const int Rb = Epi::PERM ? ((R & ~31) + perm32(R & 31)) : R;
        voffA[i] = (unsigned)(R * K + C) * 2u; voffB[i] = (unsigned)(Rb * K + C) * 2u; }
    const size_t kstep = (size_t)(BK * 2);
    const size_t hstep = (size_t)HALF * K * 2;
    const size_t tstep = 2 * hstep;
    const unsigned ldsw = (unsigned)wid * 1024u;
    const int aoff = lds_byte(wr * 64 + fr, fq * 8), boff = lds_byte(wc * 32 + fr, fq * 8);
#define PG8_SA(b, h) (((b) * 2 + (h)) * HTB)
#define PG8_SB(b, h) ((4 + (b) * 2 + (h)) * HTB)
#define PG8_STAGE(bufoff, gbase, voff) do { _Pragma("unroll") for (int _i = 0; _i < 2; ++_i) \
        __builtin_amdgcn_global_load_lds((const unsigned*)((const char*)(gbase) + (voff)[_i]), (PG8_LAS unsigned*)(lds + (bufoff) + ldsw + _i * 8192), 16, 0, 0); } while (0)
#define PG8_LDA(dst, b, h) do { _Pragma("unroll") for (int m = 0; m < 4; ++m) _Pragma("unroll") for (int k = 0; k < 2; ++k) dst[m][k] = *(const PG8_LAS bf16x8*)(lds + PG8_SA(b, h) + aoff + m * 2048 + k * 1024); } while (0)
#define PG8_LDB(dst, b, h) do { _Pragma("unroll") for (int n = 0; n < 2; ++n) _Pragma("unroll") for (int k = 0; k < 2; ++k) dst[n][k] = *(const PG8_LAS bf16x8*)(lds + PG8_SB(b, h) + boff + n * 2048 + k * 1024); } while (0)
#define PG8_MMA(ai, bj, At, Bt) do { __builtin_amdgcn_s_setprio(1); _Pragma("unroll") for (int m = 0; m < 4; ++m) _Pragma("unroll") for (int n = 0; n < 2; ++n) _Pragma("unroll") for (int k = 0; k < 2; ++k) \
        { if constexpr (Epi::I8) acc[ai][bj][m][n] = __builtin_bit_cast(f32x4, __builtin_amdgcn_mfma_i32_16x16x64_i8(__builtin_bit_cast(i32x4, Bt[n][k]), __builtin_bit_cast(i32x4, At[m][k]), __builtin_bit_cast(i32x4, acc[ai][bj][m][n]), 0, 0, 0)); \
          else acc[ai][bj][m][n] = __builtin_amdgcn_mfma_f32_16x16x32_bf16(Bt[n][k], At[m][k], acc[ai][bj][m][n], 0, 0, 0); } __builtin_amdgcn_s_setprio(0); } while (0)
#define PG8_WAIT_V(n) asm volatile("s_waitcnt vmcnt(" #n ")" ::: "memory")
#define PG8_WAIT_L(n) asm volatile("s_waitcnt lgkmcnt(" #n ")" ::: "memory")
#define PG8_BAR __builtin_amdgcn_s_barrier()
#define PG8_SCHED __builtin_amdgcn_sched_barrier(0)
    Unit cur, nxt; int ui = 0;
    if (!S.next(0, cur)) return;
    f32x4 acc[2][2][4][2];
#pragma unroll
    for (int a = 0; a < 2; ++a)
#pragma unroll
        for (int b = 0; b < 2; ++b)
#pragma unroll
            for (int m = 0; m < 4; ++m)
#pragma unroll
                for (int n = 0; n < 2; ++n) acc[a][b][m][n] = (f32x4){0.f, 0.f, 0.f, 0.f};
    bf16x8 At[4][2], B0[2][2], B1[2][2];
    const char* cA = (const char*)g.A + (size_t)cur.pm * tstep + cur.koff; const char* cB = (const char*)g.Bt + (size_t)cur.pn * tstep + cur.koff;
    S.a_ready(cur);
    PG8_STAGE(PG8_SB(0, 0), cB, voffB); PG8_STAGE(PG8_SB(0, 1), cB + hstep, voffB); PG8_STAGE(PG8_SA(0, 0), cA, voffA); PG8_STAGE(PG8_SA(0, 1), cA + hstep, voffA);
    if (wr == 1) PG8_BAR;
    PG8_WAIT_V(2); PG8_BAR;
    PG8_STAGE(PG8_SB(1, 0), cB + kstep, voffB); PG8_STAGE(PG8_SA(1, 0), cA + kstep, voffA); PG8_STAGE(PG8_SB(1, 1), cB + hstep + kstep, voffB);
    PG8_WAIT_V(6); PG8_BAR;
    for (;;) {
        const bool has_next = S.next(ui + 1, nxt);
        const char* nA = has_next ? (const char*)g.A + (size_t)nxt.pm * tstep + nxt.koff : cA; const char* nB = has_next ? (const char*)g.Bt + (size_t)nxt.pn * tstep + nxt.koff : cB;
        const int nt = cur.nt;
        for (int t = 0; t < nt; t += 2) {
            const bool last = (t == nt - 2);
            const char* a1 = cA + (size_t)(t + 1) * kstep;
            const char* a2 = last ? nA : cA + (size_t)(t + 2) * kstep; const char* b2 = last ? nB : cB + (size_t)(t + 2) * kstep;
            const char* a3 = a2 + kstep; const char* b3 = b2 + kstep;
            if (last && has_next) S.a_ready(nxt);
            PG8_LDB(B0, 0, 0); PG8_LDB(B1, 0, 1); PG8_SCHED; PG8_LDA(At, 0, 0); PG8_STAGE(PG8_SA(1, 1), a1 + hstep, voffA);
            PG8_WAIT_V(8); PG8_WAIT_L(0); PG8_BAR; PG8_MMA(0, 0, At, B0); PG8_MMA(0, 1, At, B1); PG8_BAR; PG8_SCHED;
            PG8_LDA(At, 0, 1); PG8_STAGE(PG8_SB(0, 0), b2, voffB); PG8_STAGE(PG8_SB(0, 1), b2 + hstep, voffB); PG8_STAGE(PG8_SA(0, 0), a2, voffA);
            PG8_WAIT_V(8); PG8_WAIT_L(0); PG8_BAR; PG8_MMA(1, 0, At, B0); PG8_MMA(1, 1, At, B1); PG8_BAR; PG8_SCHED;
            PG8_LDB(B0, 1, 0); PG8_LDB(B1, 1, 1); PG8_SCHED; PG8_LDA(At, 1, 0); PG8_STAGE(PG8_SA(0, 1), a2 + hstep, voffA);
            PG8_WAIT_V(8); PG8_WAIT_L(0); PG8_BAR; PG8_MMA(0, 0, At, B0); PG8_MMA(0, 1, At, B1); PG8_BAR; PG8_SCHED;
            PG8_LDA(At, 1, 1); PG8_STAGE(PG8_SB(1, 0), b3, voffB); PG8_STAGE(PG8_SB(1, 1), b3 + hstep, voffB); PG8_STAGE(PG8_SA(1, 0), a3, voffA);
            PG8_WAIT_V(8); PG8_WAIT_L(0); PG8_BAR; PG8_MMA(1, 0, At, B0); PG8_MMA(1, 1, At, B1); PG8_BAR; PG8_SCHED;
        }
        if (wr == 0) PG8_BAR;
        if constexpr (Epi::I8) E.prescale(acc, cur, wr, wc, fr, fq);
        if constexpr (!Epi::AFTER_DRAIN) { E(acc, cur, wr, wc, fr, fq); S.done(cur); }
        if (!has_next) break;
#pragma unroll
        for (int a = 0; a < 2; ++a)
#pragma unroll
            for (int b = 0; b < 2; ++b)
#pragma unroll
                for (int m = 0; m < 4; ++m)
#pragma unroll
                    for (int n = 0; n < 2; ++n) acc[a][b][m][n] = (f32x4){0.f, 0.f, 0.f, 0.f};
        cur = nxt; cA = nA; cB = nB; ++ui;
        if (wr == 1) PG8_BAR;
    }
    PG8_WAIT_V(0);
    PG8_BAR;
    if constexpr (Epi::AFTER_DRAIN) { E.fused(acc, cur, wr, wc, fr, fq, lds, wid, lane); S.done(cur); }
#undef PG8_SA
#undef PG8_SB
#undef PG8_STAGE
#undef PG8_LDA
#undef PG8_LDB
#undef PG8_MMA
#undef PG8_WAIT_V
#undef PG8_WAIT_L
#undef PG8_BAR
#undef PG8_SCHED
}

}

#ifndef INO_I8
#define INO_I8 0
#endif
#ifndef FFO1_I8
#define FFO1_I8 1
#endif
#ifndef FFO0_I8
#define FFO0_I8 1
#endif
#ifndef MIX_I8
#define MIX_I8 0
#endif
#ifndef FFN_I8
#define FFN_I8 1
#endif
struct Args { const float* in[29]; float* out; unsigned char* ws; int ph_lo, ph_hi; };
struct Ctx {
    const float* in[29]; float* out; unsigned char* ws; unsigned char* ar;
    LAS unsigned char* lds;
    int tid, lane, wave;
};
enum { I_X = 0, I_C, I_CTX, I_CCTX, I_WMOD, I_BMOD, I_WINE, I_MU, I_W0, I_W2, I_A0, I_A2, I_G2, I_KK, I_KA, I_RK, I_LNW, I_LNB, I_LAM, I_SUBLN,
       I_WINO, I_SINK, I_RDEC, I_WMIX, I_WFFI, I_CONVW, I_CONVB, I_WFFO, I_FNORM };

__device__ __forceinline__ void p_mod(const Ctx& c) {
    LAS float* sc = (LAS float*)c.lds;
    LAS float* red = sc + 5 * 4096;
    const int tid = c.tid, lane = c.lane, w = c.wave;
    for (int i = tid; i < 5 * 4096; i += NTHREADS) { const int r = i >> 12, k = i & 4095; const float v = r < 4 ? c.in[I_C][r * 4096 + k] : c.in[I_CCTX][k]; sc[i] = silu_f(v); }
    __syncthreads();
    float* MODP = (float*)(c.ar + AR_MODP);
    for (int u = blockIdx.x; u < 768; u += gridDim.x) {
        const int kp = u & 3, cg = (u >> 2) % 96, l = u / 384;
        const int k0 = kp * 1024 + w * 128;
        const float* wp = c.in[I_WMOD] + ((size_t)l * 4096 + k0) * 24576 + cg * 256 + lane * 4;
        f32x4 acc[5];
#pragma unroll
        for (int r = 0; r < 5; ++r) acc[r] = (f32x4){0.f, 0.f, 0.f, 0.f};
#pragma unroll 2
        for (int k = 0; k < 128; k += 4) {
            f32x4 wv[4];
#pragma unroll
            for (int j = 0; j < 4; ++j) wv[j] = __builtin_nontemporal_load((const f32x4*)(wp + (size_t)(k + j) * 24576));
#pragma unroll
            for (int r = 0; r < 5; ++r) { const f32x4 s4 = *(const LAS f32x4*)(sc + r * 4096 + k0 + k);
#pragma unroll
                for (int j = 0; j < 4; ++j) acc[r] += wv[j] * s4[j]; }
        }
#pragma unroll
        for (int r = 0; r < 5; ++r) *(LAS f32x4*)(red + (w * 5 + r) * 256 + lane * 4) = acc[r];
        __syncthreads();
        for (int idx = tid; idx < 5 * 256; idx += NTHREADS) { const int r = idx >> 8, col = idx & 255; float s = 0.f;
#pragma unroll
            for (int q = 0; q < 8; ++q) s += red[(q * 5 + r) * 256 + col];
            if (kp == 0) s += c.in[I_BMOD][l * 24576 + cg * 256 + col];
            MODP[(size_t)kp * MOD_FLOATS + ((size_t)l * 5 + r) * 24576 + cg * 256 + col] = s; }
        __syncthreads();
    }
}

__device__ __forceinline__ void p_mod_finalize(const Ctx& c) {
    const float* MODP = (const float*)(c.ar + AR_MODP); float* MOD = (float*)(c.ws + WS_MOD);
    for (size_t i = ((size_t)blockIdx.x * NTHREADS + c.tid) * 4; i < MOD_FLOATS; i += (size_t)gridDim.x * NTHREADS * 4)
        *(f32x4*)(MOD + i) = (*(const f32x4*)(MODP + i) + *(const f32x4*)(MODP + MOD_FLOATS + i)) + (*(const f32x4*)(MODP + 2 * MOD_FLOATS + i) + *(const f32x4*)(MODP + 3 * MOD_FLOATS + i));
}
DI int perm64(int m) { const int within = m & 255, rho = within & 127; return (m & ~255) + (rho >> 5) * 64 + (within >> 7) * 32 + (rho & 31); }
DI int perm128(int m) { const int within = m & 255, rho = within & 127; return (m & ~255) + (rho >> 6) * 128 + (within >> 7) * 64 + (rho & 63); }
DI int in_odd_src(int n) { return n < 2304 ? perm64(n) : (n < 2560 ? n : (n < 4608 ? 2560 + perm128(n - 2560) : n)); }
__device__ __forceinline__ int p_convert_job(const Ctx& c, const float* __restrict__ src, int src_ld, int K, int n0, int ncnt, bf16_t* __restrict__ dst, int dn0, int base, int nperm = 0) {
    LAS unsigned short* T = (LAS unsigned short*)c.lds;
    const int tid = c.tid, tk = K / 64, tn = ncnt / 128, nt = tk * tn, G = (int)gridDim.x;
    int first = (int)blockIdx.x - (base % G); if (first < 0) first += G;
    const int kr = tid >> 3, c16 = (tid & 7) * 16, wn = tid >> 2, k16 = (tid & 3) * 16;
    f32x4 v[4], vn[4];
    if (first < nt) { const int nn = (first / tk) * 128 + c16; const float* p = src + (size_t)((first % tk) * 64 + kr) * src_ld + n0 + (nn < nperm ? perm64(nn) : nn);
#pragma unroll
        for (int i = 0; i < 4; ++i) v[i] = __builtin_nontemporal_load((const f32x4*)(p + 4 * i)); }
    for (int t = first; t < nt; t += G) {
        const int t2 = t + G;
        if (t2 < nt) { const int nn = (t2 / tk) * 128 + c16; const float* p = src + (size_t)((t2 % tk) * 64 + kr) * src_ld + n0 + (nn < nperm ? perm64(nn) : nn);
#pragma unroll
            for (int i = 0; i < 4; ++i) vn[i] = __builtin_nontemporal_load((const f32x4*)(p + 4 * i)); }
#pragma unroll
        for (int i = 0; i < 4; ++i)
#pragma unroll
            for (int j = 0; j < 4; ++j) T[(c16 + 4 * i + j) * 72 + kr] = f2bf(v[i][j]);
        __syncthreads();
        { const u32x4 a = *(const LAS u32x4*)(T + wn * 72 + k16), b = *(const LAS u32x4*)(T + wn * 72 + k16 + 8);
          bf16_t* q = dst + (size_t)(dn0 + (t / tk) * 128 + wn) * K + (t % tk) * 64 + k16;
          *(u32x4*)q = a; *(u32x4*)(q + 8) = b; }
        __syncthreads();
#pragma unroll
        for (int i = 0; i < 4; ++i) v[i] = vn[i];
    }
    return base + nt;
}
DI void conv_wave_tile(const float* __restrict__ src, int src_ld, int k0, int nsrc, int n0, bf16_t* __restrict__ dst, int K, int lane) {
    float v[32];
    const float* p = src + (size_t)k0 * src_ld + nsrc;
#pragma unroll
    for (int kk = 0; kk < 32; ++kk) v[kk] = __builtin_nontemporal_load(p + (size_t)kk * src_ld);
    bf16_t* q = dst + (size_t)(n0 + lane) * K + k0;
#pragma unroll
    for (int g = 0; g < 4; ++g) { u32x4 w; w.x = pk_bf16(v[8 * g], v[8 * g + 1]); w.y = pk_bf16(v[8 * g + 2], v[8 * g + 3]); w.z = pk_bf16(v[8 * g + 4], v[8 * g + 5]); w.w = pk_bf16(v[8 * g + 6], v[8 * g + 7]);
        *(u32x4*)(q + 8 * g) = w; }
}
DI unsigned pk_i8x4(float a, float b, float c2, float d) { const int ia = (int)rintf(a), ib = (int)rintf(b), ic = (int)rintf(c2), id = (int)rintf(d);
    return ((unsigned)ia & 255u) | (((unsigned)ib & 255u) << 8) | (((unsigned)ic & 255u) << 16) | ((unsigned)id << 24); }
template <class T> DI void fwht32(T (&v)[32]) {
#pragma unroll
    for (int h = 1; h < 32; h <<= 1)
#pragma unroll
        for (int i = 0; i < 32; i += 2 * h)
#pragma unroll
            for (int j = i; j < i + h; ++j) { const T a = v[j], b = v[j + h]; v[j] = a + b; v[j + h] = a - b; }
}
DI unsigned* i8_cmax(const Ctx& c, int off) { return (unsigned*)(c.ws + WS_CTL + CTL_CMAX) + off; }
DI float* i8_cs(const Ctx& c, int off) { return (float*)(c.ws + WS_CS) + off; }
DI void conv_wave_tile_q8(const float* __restrict__ src, int src_ld, int k0, int nsrc, int n0, unsigned char* __restrict__ dst, int K, int lane, const unsigned* cmax, float* cs) {
    float v[32];
    const float* p = src + (size_t)k0 * src_ld + nsrc;
#pragma unroll
    for (int kk = 0; kk < 32; ++kk) v[kk] = __builtin_nontemporal_load(p + (size_t)kk * src_ld);
    const float cm = __uint_as_float(cmax[nsrc]); const float qs = cm > 0.f ? 127.0f / cm : 0.f;
    if (k0 == 0) cs[n0 + lane] = cm * (1.0f / 127.0f);
    fwht32(v);
    unsigned char* q = dst + (size_t)(n0 + lane) * K + k0;
#pragma unroll
    for (int g = 0; g < 2; ++g) { u32x4 w;
#pragma unroll
        for (int j = 0; j < 4; ++j) w[j] = pk_i8x4(v[16 * g + 4 * j] * 0.03125f * qs, v[16 * g + 4 * j + 1] * 0.03125f * qs, v[16 * g + 4 * j + 2] * 0.03125f * qs, v[16 * g + 4 * j + 3] * 0.03125f * qs);
        *(u32x4*)(q + 16 * g) = w; }
}
struct CmxDeal { int worker, nworkers, lo, hi; };
__device__ __forceinline__ int p_wcolmax_job(const Ctx& c, const float* __restrict__ src0, int ld, int K, unsigned* cmax, int base, const CmxDeal dl) {
    LAS float* red = (LAS float*)c.lds;
    const int ncg = (ld + 255) / 256, nko = (K + 1023) / 1024, nitem = ncg * nko;
    int g0 = dl.lo + dl.worker; if (g0 < base) g0 += ((base - g0 + dl.nworkers - 1) / dl.nworkers) * dl.nworkers;
    const int gend = dl.hi < base + nitem ? dl.hi : base + nitem;
#pragma unroll 1
    for (int g = g0; g < gend; g += dl.nworkers) { const int it = g - base;
        const int cg = it % ncg, ko = it / ncg, col = cg * 256 + c.lane * 4;
        f32x4 mx = {0.f, 0.f, 0.f, 0.f};
        if (col < ld && ko * 1024 + c.wave * 128 < K) {
#pragma unroll 1
            for (int t = 0; t < 4; ++t) {
                f32x4 v[32]; const float* p = src0 + (size_t)(ko * 1024 + c.wave * 128 + t * 32) * ld + col;
#pragma unroll
                for (int kk = 0; kk < 32; ++kk) v[kk] = __builtin_nontemporal_load((const f32x4*)(p + (size_t)kk * ld));
                fwht32(v);
#pragma unroll
                for (int kk = 0; kk < 32; ++kk)
#pragma unroll
                    for (int j = 0; j < 4; ++j) mx[j] = fmaxf(mx[j], fabsf(v[kk][j]));
            }
        }
        *(LAS f32x4*)(red + c.wave * 256 + c.lane * 4) = mx;
        __syncthreads();
        if (c.tid < 256) { float m = red[c.tid];
#pragma unroll
            for (int w = 1; w < 8; ++w) m = fmaxf(m, red[w * 256 + c.tid]);
            const int cc = cg * 256 + c.tid; if (cc < ld) atomicMax(cmax + cc, __float_as_uint(m * 0.03125f)); }
        __syncthreads();
    }
    return base + nitem;
}
constexpr int CMX_TOTAL = (FFN_I8 ? 2 * (2 * DFF / 256) * (D / 1024) : 0) + (INO_I8 ? (NO / 256) * (D / 1024) : 0) + ((FFO0_I8 ? 1 : 0) + (FFO1_I8 ? 1 : 0)) * (D / 256) * ((DFF + 1023) / 1024) + (MIX_I8 ? 2 * (D / 256) * (D / 1024) : 0);
__device__ __forceinline__ void p_wcolmax(const Ctx& c, const CmxDeal dl) {
    int base = 0;
    __syncthreads();
    if (FFN_I8) { base = p_wcolmax_job(c, c.in[I_WFFI], 2 * DFF, D, i8_cmax(c, CM_FFI), base, dl); base = p_wcolmax_job(c, c.in[I_WFFI] + (size_t)D * 2 * DFF, 2 * DFF, D, i8_cmax(c, CM_FFI + 2 * DFF), base, dl); }
    if (INO_I8) base = p_wcolmax_job(c, c.in[I_WINO], NO, D, i8_cmax(c, CM_INO), base, dl);
    if (FFO0_I8) base = p_wcolmax_job(c, c.in[I_WFFO], D, DFF, i8_cmax(c, CM_FFO0), base, dl);
    if (FFO1_I8) base = p_wcolmax_job(c, c.in[I_WFFO] + (size_t)DFF * D, D, DFF, i8_cmax(c, CM_FFO1), base, dl);
    if (MIX_I8) { base = p_wcolmax_job(c, c.in[I_WMIX], D, D, i8_cmax(c, CM_MIX), base, dl); base = p_wcolmax_job(c, c.in[I_WMIX] + (size_t)D * D, D, D, i8_cmax(c, CM_MIX + D), base, dl); }
}
#ifndef CMX_P0
#define CMX_P0 624
#endif
DI int cmx_ns(int G) { return G == 256 ? 8 : 0; }
DI int cmx_p0(int G) { return cmx_ns(G) ? (CMX_P0 < CMX_TOTAL ? CMX_P0 : CMX_TOTAL) : CMX_TOTAL; }
__device__ __forceinline__ void p_weights_layer0(const Ctx& c) {
    bf16_t* W = (bf16_t*)(c.ws + WS_W);
    {   constexpr int T_IN = (4096 / 32) * ((COLS_A + COLS_B) / 64), T_MIX = (4096 / 32) * (4096 / 64), T_L96 = 3 * (2048 / 64), T_LG = 8 * (2048 / 64);
        constexpr int E0 = T_IN, E1 = E0, E2 = E1 + 4 * T_L96, E3 = E2 + T_LG;
        bf16_t* L = (bf16_t*)((unsigned char*)W + W_LORA);
        for (int t = blockIdx.x * 8 + c.wave; t < E3; t += gridDim.x * 8) {
            if (t < E0) { const int kt = t & 127, g = t >> 7, n = g * 64 + c.lane;
                const int nsrc = n < COLS_A ? n : COLS_A + (n - COLS_A < 4096 ? perm64(n - COLS_A) : n - COLS_A);
                conv_wave_tile(c.in[I_WINE], COLS_A + COLS_B, kt * 32, nsrc, n < COLS_A ? g * 64 : g * 64 + (COLS_A_PAD - COLS_A), (bf16_t*)((unsigned char*)W + W_IN), 4096, c.lane); }
            else if (t < E1) { const int tl = t - E0, kt = tl & 127, g = tl >> 7;
                conv_wave_tile(c.in[I_WMIX], 4096, kt * 32, g * 64 + c.lane, g * 64, (bf16_t*)((unsigned char*)W + W_MIX), 4096, c.lane); }
            else if (t < E2) { const int tl = t - E1, type = tl / T_L96, r2 = tl % T_L96, kt = r2 % 3, g = r2 / 3;
                const float* src = (type < 2 ? c.in[I_W2] + (size_t)type * 96 * 2048 : c.in[I_A2] + (size_t)(type - 2) * 96 * 2048);
                conv_wave_tile(src, 2048, kt * 32, g * 64 + c.lane, g * 64, L + (size_t)type * 2048 * LORA_K + type * LORA_KU, LORA_K, c.lane); }
            else { const int tl = t - E2, kt = tl & 7, g = tl >> 3;
                conv_wave_tile(c.in[I_G2], 2048, kt * 32, g * 64 + c.lane, g * 64, L + (size_t)4 * 2048 * LORA_K + 4 * LORA_KU, LORA_K, c.lane); }
        }
    }
    const size_t gtid = (size_t)blockIdx.x * NTHREADS + c.tid, gn = (size_t)gridDim.x * NTHREADS;
    { u32x4* z = (u32x4*)((unsigned char*)W + W_IN + (size_t)COLS_A * 4096 * 2); const size_t n16 = (size_t)(COLS_A_PAD - COLS_A) * 4096 * 2 / 16;
      for (size_t i = gtid; i < n16; i += gn) z[i] = (u32x4){0u, 0u, 0u, 0u}; }
    { bf16_t* L = (bf16_t*)((unsigned char*)W + W_LORA);
      for (size_t i = gtid; i < (size_t)4 * 2048 * 20; i += gn) { const int n = (int)(i / 20), ch = (int)(i % 20), type = n >> 11;
          *(u32x4*)(L + (size_t)n * LORA_K + type * LORA_KU + 96 + ch * 8) = (u32x4){0u, 0u, 0u, 0u}; } }
    { float* axc = (float*)(c.ws + WS_AXC); float* axs = (float*)(c.ws + WS_AXS);
      for (size_t i = gtid; i < (size_t)SEQ * 32; i += gn) { const int pos = (int)(i >> 5), a = (int)(i & 31), q = a & 15;
          const float inv = powf(10000.0f, -(float)q / 16.0f); const float p = (a < 16) ? (float)(pos >> 6) : (float)(pos & 63);
          float sn, cs; sincosf(p * inv, &sn, &cs); axc[i] = cs; axs[i] = sn; } }
    { float* rtc = (float*)(c.ws + WS_RTC); float* rts = (float*)(c.ws + WS_RTS);
      for (size_t i = gtid; i < (size_t)NKEY * 64; i += gn) { const int pos = (int)(i >> 6), a = (int)(i & 63);
          const float t = (float)a / 63.0f; const float inv = powf(10000.0f, -t);
          float sn, cs; sincosf((float)pos * inv, &sn, &cs); rtc[i] = cs; rts[i] = sn; } }
    if (gtid == 0) { const float* lv = c.in[I_LAM]; float s01 = 0.f, s23 = 0.f;
        for (int i = 0; i < 64; ++i) { s01 += lv[i] * lv[64 + i]; s23 += lv[128 + i] * lv[192 + i]; }
        ((float*)(c.ws + WS_SCAL))[0] = expf(s01) - expf(s23) + 0.2f; }
}
constexpr int CONV_SPLIT = 152000;
__device__ __forceinline__ void p_convert_deferred(const Ctx& c, int worker, int nworkers, int tlo, int thi) {
    unsigned char* W = c.ws + WS_W; unsigned char* W1 = c.ws + WS_W1;
    constexpr int T_FFI = (4096 / 32) * (2 * DFF / 64), T_FFO = (DFF / 32) * (4096 / 64), T_IN1 = (4096 / 32) * (NO / 64), T_MIX = (4096 / 32) * (4096 / 64);
    constexpr int EM = T_MIX, E0 = EM + T_FFI, E1 = E0 + T_FFO, E2 = E1 + T_IN1, E3 = E2 + T_MIX, E4 = E3 + T_FFI, E5 = E4 + T_FFO;
    const int tend = thi < E5 ? thi : E5;
    for (int t = tlo + worker; t < tend; t += nworkers) {
        const float* src; int ld, K, tl; bf16_t* dst; int mixl = -1;
        if (t < EM) { src = c.in[I_WMIX]; ld = 4096; K = 4096; tl = t; dst = (bf16_t*)(W + W_MIX); mixl = 0; }
        else if (t < E0) { src = c.in[I_WFFI]; ld = 2 * DFF; K = 4096; tl = t - EM; dst = (bf16_t*)(W + W_FFI); }
        else if (t < E1) { src = c.in[I_WFFO]; ld = 4096; K = DFF; tl = t - E0; dst = (bf16_t*)(W + W_FFO); mixl = 3; }
        else if (t < E2) { src = c.in[I_WINO]; ld = NO; K = 4096; tl = t - E1; dst = (bf16_t*)(W + W_IN); }
        else if (t < E3) { src = c.in[I_WMIX] + (size_t)4096 * 4096; ld = 4096; K = 4096; tl = t - E2; dst = (bf16_t*)(W1 + W1_MIX); mixl = 1; }
        else if (t < E4) { src = c.in[I_WFFI] + (size_t)4096 * 2 * DFF; ld = 2 * DFF; K = 4096; tl = t - E3; dst = (bf16_t*)(W1 + W1_FFI); }
        else { src = c.in[I_WFFO] + (size_t)DFF * 4096; ld = 4096; K = DFF; tl = t - E4; dst = (bf16_t*)(W1 + W1_FFO); mixl = 2; }
        const int tk = K / 32, kt = tl % tk, ntile = tl / tk;
        int ncol = ntile * 64;
        if (ld == 2 * DFF) { const int tile = ncol >> 8, within = ncol & 255; ncol = within < 128 ? 128 * tile + within : DFF + 128 * tile + (within - 128); }
        const int nsrc = (ld == NO) ? in_odd_src(ntile * 64 + c.lane) : ncol + c.lane;
        if (FFN_I8 && ld == 2 * DFF) { const int off = CM_FFI + (t < E0 ? 0 : 2 * DFF); conv_wave_tile_q8(src, ld, kt * 32, nsrc, ntile * 64, (unsigned char*)dst, K, c.lane, i8_cmax(c, off), i8_cs(c, off)); }
        else if (FFO0_I8 && mixl == 3) conv_wave_tile_q8(src, ld, kt * 32, nsrc, ntile * 64, (unsigned char*)dst, K, c.lane, i8_cmax(c, CM_FFO0), i8_cs(c, CM_FFO0));
        else if (FFO1_I8 && mixl == 2) conv_wave_tile_q8(src, ld, kt * 32, nsrc, ntile * 64, (unsigned char*)dst, K, c.lane, i8_cmax(c, CM_FFO1), i8_cs(c, CM_FFO1));
        else if (MIX_I8 && mixl >= 0 && mixl < 2) conv_wave_tile_q8(src, ld, kt * 32, nsrc, ntile * 64, (unsigned char*)dst, K, c.lane, i8_cmax(c, CM_MIX + mixl * D), i8_cs(c, CM_MIX + mixl * D));
        else if (INO_I8 && ld == NO) conv_wave_tile_q8(src, ld, kt * 32, nsrc, ntile * 64, (unsigned char*)dst, K, c.lane, i8_cmax(c, CM_INO), i8_cs(c, CM_INO));
        else conv_wave_tile(src, ld, kt * 32, nsrc, ntile * 64, dst, K, c.lane);
    }
}

template <class TS>
__device__ __forceinline__ void p_ctx_fix(const Ctx& c, const TS* srcc, const float* gate, const float* slab, res_t* H) {
    for (int row = blockIdx.x * 8 + c.wave; row < TT; row += gridDim.x * 8) {
        if (row < TL) continue;
        const size_t ro = (size_t)(row - TL) * D;
#pragma unroll 4
        for (int i = 0; i < 16; ++i) { const int col = i * 256 + c.lane * 4;
            const f32x4 s4 = (*(const f32x4*)(slab + ro + col) + *(const f32x4*)(slab + (size_t)TC * D + ro + col)) + (*(const f32x4*)(slab + (size_t)2 * TC * D + ro + col) + *(const f32x4*)(slab + (size_t)3 * TC * D + ro + col));
            st4(H + (size_t)row * D + col, ld4(srcc + ro + col) + *(const f32x4*)(gate + col) * s4); }
    }
}
template <int NPARTS = 1, bool Q8 = false, class TS = float>
__device__ __forceinline__ void p_norm_mod(const Ctx& c, const TS* hl, const TS* hc, int nrows, const float* mod, int shift_chunk, int scale_chunk) {
    bf16_t* XN = (bf16_t*)(c.ws + WS_XN);
    for (int row = blockIdx.x * 8 + c.wave; row < nrows; row += gridDim.x * 8) {
        const TS* src = row < TL ? hl + (size_t)row * D : hc + (size_t)(row - TL) * D;
        f32x4 v[16]; float ss = 0.f;
#pragma unroll
        for (int i = 0; i < 16; ++i) { v[i] = ld4(src + i * 256 + c.lane * 4); ss += v[i][0] * v[i][0] + v[i][1] * v[i][1] + v[i][2] * v[i][2] + v[i][3] * v[i][3]; }
        ss = wave_sum(ss);
        const float rs = rsqrtf(ss * (1.0f / 4096.0f) + 1e-6f);
        const float* mp = mod + (size_t)row_modidx(row) * 24576;
        bf16_t* dst = XN + (size_t)row * D;
        if constexpr (Q8) {
            float mx = 0.f;
#pragma unroll
            for (int i = 0; i < 16; ++i) { const int col = i * 256 + c.lane * 4;
                const f32x4 sh = *(const f32x4*)(mp + shift_chunk * 4096 + col), sc = *(const f32x4*)(mp + scale_chunk * 4096 + col);
#pragma unroll
                for (int j = 0; j < 4; ++j) v[i][j] = v[i][j] * rs * (1.f + sc[j]) + sh[j];
                { const float a0 = v[i][0] + v[i][1], a1 = v[i][0] - v[i][1], a2 = v[i][2] + v[i][3], a3 = v[i][2] - v[i][3];
                  v[i][0] = a0 + a2; v[i][1] = a1 + a3; v[i][2] = a0 - a2; v[i][3] = a1 - a3; }
#pragma unroll
                for (int j = 0; j < 4; ++j) { float x = v[i][j];
                    { const float t = __int_as_float(__builtin_amdgcn_update_dpp(0, __float_as_int(x), 0xB1, 0xF, 0xF, false)); x = (c.lane & 1) ? t - x : x + t; }
                    { const float t = __int_as_float(__builtin_amdgcn_update_dpp(0, __float_as_int(x), 0x4E, 0xF, 0xF, false)); x = (c.lane & 2) ? t - x : x + t; }
                    { const float t = __int_as_float(__builtin_amdgcn_ds_swizzle(__float_as_int(x), 0x101F)); x = (c.lane & 4) ? t - x : x + t; }
                    v[i][j] = x; mx = fmaxf(mx, fabsf(x)); } }
#pragma unroll
            for (int o = 32; o >= 1; o >>= 1) mx = fmaxf(mx, __shfl_xor(mx, o));
            const float qs = mx > 0.f ? 127.0f / mx : 0.f;
            unsigned char* d8 = (unsigned char*)XN + (size_t)row * D;
#pragma unroll
            for (int i = 0; i < 16; ++i) *(unsigned*)(d8 + i * 256 + c.lane * 4) = pk_i8x4(v[i][0] * qs, v[i][1] * qs, v[i][2] * qs, v[i][3] * qs);
            if (c.lane == 0) ((float*)(c.ws + WS_XN + (size_t)TT * D))[row] = mx * (1.0f / 127.0f);
            continue;
        }
#pragma unroll
        for (int i = 0; i < 16; ++i) { const int col = i * 256 + c.lane * 4;
            f32x4 sh = *(const f32x4*)(mp + shift_chunk * 4096 + col), sc = *(const f32x4*)(mp + scale_chunk * 4096 + col);
            if constexpr (NPARTS == 4) {
                sh = (sh + *(const f32x4*)(mp + MOD_FLOATS + shift_chunk * 4096 + col)) + (*(const f32x4*)(mp + 2 * MOD_FLOATS + shift_chunk * 4096 + col) + *(const f32x4*)(mp + 3 * MOD_FLOATS + shift_chunk * 4096 + col));
                sc = (sc + *(const f32x4*)(mp + MOD_FLOATS + scale_chunk * 4096 + col)) + (*(const f32x4*)(mp + 2 * MOD_FLOATS + scale_chunk * 4096 + col) + *(const f32x4*)(mp + 3 * MOD_FLOATS + scale_chunk * 4096 + col)); }
            u32x2 w; w.x = pk_bf16(v[i][0] * rs * (1.f + sc[0]) + sh[0], v[i][1] * rs * (1.f + sc[1]) + sh[1]);
            w.y = pk_bf16(v[i][2] * rs * (1.f + sc[2]) + sh[2], v[i][3] * rs * (1.f + sc[3]) + sh[3]);
            *(u32x2*)(dst + col) = w; }
    }
}
__device__ __forceinline__ void p_final_norm(const Ctx& c) {
    const res_t* H = (const res_t*)(c.ws + WS_H);
    for (int row = blockIdx.x * 8 + c.wave; row < TL; row += gridDim.x * 8) {
        const res_t* src = H + (size_t)row * D;
        f32x4 v[16]; float ss = 0.f;
#pragma unroll
        for (int i = 0; i < 16; ++i) { v[i] = ld4(src + i * 256 + c.lane * 4); ss += v[i][0] * v[i][0] + v[i][1] * v[i][1] + v[i][2] * v[i][2] + v[i][3] * v[i][3]; }
        ss = wave_sum(ss);
        const float rs = rsqrtf(ss * (1.0f / 4096.0f) + 1e-6f);
        float* dst = c.out + (size_t)row * D;
#pragma unroll
        for (int i = 0; i < 16; ++i) { const int col = i * 256 + c.lane * 4; const f32x4 g = *(const f32x4*)(c.in[I_FNORM] + col);
            *(f32x4*)(dst + col) = v[i] * rs * g; }
    }
}

DI void rope_store(const f32x4 (&acc)[2][2][4][2], int ai, int m, const float* tc, const float* ts, bool rot, float scale, bf16_t* o1p, bf16_t* o2p) {
    float o1[8], o2[8];
#pragma unroll
    for (int n = 0; n < 2; ++n) { f32x4 cs = {1.f, 1.f, 1.f, 1.f}, sn = {0.f, 0.f, 0.f, 0.f};
        if (rot) { cs = *(const f32x4*)(tc + 4 * n); sn = *(const f32x4*)(ts + 4 * n); }
#pragma unroll
        for (int e = 0; e < 4; ++e) { const float x1 = acc[ai][0][m][n][e], x2 = acc[ai][1][m][n][e];
            o1[4 * n + e] = (x1 * cs[e] - x2 * sn[e]) * scale; o2[4 * n + e] = (x2 * cs[e] + x1 * sn[e]) * scale; } }
    u32x4 w1, w2; w1.x = pk_bf16(o1[0], o1[1]); w1.y = pk_bf16(o1[2], o1[3]); w1.z = pk_bf16(o1[4], o1[5]); w1.w = pk_bf16(o1[6], o1[7]);
    w2.x = pk_bf16(o2[0], o2[1]); w2.y = pk_bf16(o2[2], o2[3]); w2.z = pk_bf16(o2[4], o2[5]); w2.w = pk_bf16(o2[6], o2[7]);
    *(u32x4*)o1p = w1; *(u32x4*)o2p = w2;
}
DI void plain_store(const f32x4 (&acc)[2][2][4][2], int ai, int m, bf16_t* rowp) {
#pragma unroll
    for (int bj = 0; bj < 2; ++bj) { const f32x4 v0 = acc[ai][bj][m][0], v1 = acc[ai][bj][m][1];
        u32x4 w; w.x = pk_bf16(v0[0], v0[1]); w.y = pk_bf16(v0[2], v0[3]); w.z = pk_bf16(v1[0], v1[1]); w.w = pk_bf16(v1[2], v1[3]);
        *(u32x4*)(rowp + bj * 128) = w; }
}
DI void i8_prescale(f32x4 (&acc)[2][2][4][2], const float* SA, const float* CS, const pg8::Unit& u, int wr, int wc, int fr, int fq) {
    f32x4 cs[2][2];
#pragma unroll
    for (int bj = 0; bj < 2; ++bj)
#pragma unroll
        for (int n = 0; n < 2; ++n) cs[bj][n] = *(const f32x4*)(CS + u.pn * 256 + bj * 128 + wc * 32 + 8 * fq + 4 * n);
#pragma unroll
    for (int ai = 0; ai < 2; ++ai)
#pragma unroll
        for (int m = 0; m < 4; ++m) { const float s = SA[u.pm * 256 + ai * 128 + wr * 64 + 16 * m + fr];
#pragma unroll
            for (int bj = 0; bj < 2; ++bj)
#pragma unroll
                for (int n = 0; n < 2; ++n)
#pragma unroll
                    for (int e = 0; e < 4; ++e) acc[ai][bj][m][n][e] = (float)__float_as_int(acc[ai][bj][m][n][e]) * (s * cs[bj][n][e]); }
}
DI void i8_prescale_np(f32x4 (&acc)[2][2][4][2], const float* SA, const float* CS, const pg8::Unit& u, int wr, int wc, int fr, int fq) {
    f32x4 cs[2][2];
#pragma unroll
    for (int bj = 0; bj < 2; ++bj)
#pragma unroll
        for (int n = 0; n < 2; ++n) cs[bj][n] = *(const f32x4*)(CS + u.pn * 256 + wc * 32 + 4 * fq + bj * 128 + n * 16);
#pragma unroll
    for (int ai = 0; ai < 2; ++ai)
#pragma unroll
        for (int m = 0; m < 4; ++m) { const float s = SA[u.pm * 256 + ai * 128 + wr * 64 + 16 * m + fr];
#pragma unroll
            for (int bj = 0; bj < 2; ++bj)
#pragma unroll
                for (int n = 0; n < 2; ++n)
#pragma unroll
                    for (int e = 0; e < 4; ++e) acc[ai][bj][m][n][e] = (float)__float_as_int(acc[ai][bj][m][n][e]) * (s * cs[bj][n][e]); }
}
struct EpiInEven {
    static constexpr bool PERM = true, AFTER_DRAIN = false, I8 = false;
    bf16_t* PA; bf16_t* PB; const float* axc; const float* axs;
    DI void operator()(const f32x4 (&acc)[2][2][4][2], const pg8::Unit& u, int wr, int wc, int fr, int fq) const {
        const int row0 = u.pm * 256 + wr * 64 + fr, tq = u.pn - COLS_A_PAD / 256;
#pragma unroll
        for (int ai = 0; ai < 2; ++ai)
#pragma unroll
            for (int m = 0; m < 4; ++m) { const int row = row0 + ai * 128 + m * 16;
                if (tq < 0) plain_store(acc, ai, m, PA + (size_t)row * COLS_A_PAD + u.pn * 256 + wc * 32 + 8 * fq);
                else if (tq >= 16) plain_store(acc, ai, m, PB + (size_t)row * COLS_B + tq * 256 + wc * 32 + 8 * fq);
                else { const int pos = row & 4095; bf16_t* o = PB + (size_t)row * COLS_B + tq * 256 + wc * 64 + 8 * fq;
                    rope_store(acc, ai, m, axc + pos * 32 + 8 * fq, axs + pos * 32 + 8 * fq, row < TL, tq < 8 ? 0.18033688011112042f : 1.0f, o, o + 32); } }
    }
};
struct EpiInOdd {
    static constexpr bool PERM = true, AFTER_DRAIN = false, I8 = (INO_I8 != 0);
    bf16_t* P1; const float* axc; const float* axs; const float* rtc; const float* rts; const float* SA; const float* CS;
    DI void prescale(f32x4 (&acc)[2][2][4][2], const pg8::Unit& u, int wr, int wc, int fr, int fq) const { i8_prescale(acc, SA, CS, u, wr, wc, fr, fq); }
    DI void operator()(const f32x4 (&acc)[2][2][4][2], const pg8::Unit& u, int wr, int wc, int fr, int fq) const {
        const int row0 = u.pm * 256 + wr * 64 + fr, pn = u.pn;
#pragma unroll
        for (int ai = 0; ai < 2; ++ai)
#pragma unroll
            for (int m = 0; m < 4; ++m) { const int row = row0 + ai * 128 + m * 16; const bool lat = row < TL; const int pos = lat ? (row & 4095) : ((row - TL) & 255);
                if (pn < 9) { bf16_t* o = P1 + (size_t)row * NO + pn * 256 + wc * 64 + 8 * fq;
                    rope_store(acc, ai, m, axc + pos * 32 + 8 * fq, axs + pos * 32 + 8 * fq, lat, pn < 8 ? 0.18033688011112042f : 1.0f, o, o + 32); }
                else if (pn >= 10 && pn < 18) { const int rp = lat ? CTXL + pos : pos, i0 = 32 * (wc & 1) + 8 * fq; bf16_t* o = P1 + (size_t)row * NO + pn * 256 + (wc >> 1) * 128 + i0;
                    rope_store(acc, ai, m, rtc + rp * 64 + i0, rts + rp * 64 + i0, true, pn < 14 ? 0.08838834764831845f : 1.0f, o, o + 64); }
                else plain_store(acc, ai, m, P1 + (size_t)row * NO + pn * 256 + wc * 32 + 8 * fq); }
    }
};
struct CtxSplitOrder {
    int G, c, nNn, ntk;
    __device__ void init(int N, int G_, int c_, int K_) { G = G_; c = c_; nNn = N / 256; ntk = K_ / 64; }
    __device__ bool next(int i, pg8::Unit& u) const {
        const long L = (long)i * G + c; if (L >= 4 * nNn * 4) return false;
        const int j = (int)L, part = j & 3, tile = j >> 2; u.pm = 64 + (tile & 3); u.pn = tile >> 2; u.part = part;
        const int s0 = 2 * ((part * ntk) / 8), s1 = 2 * (((part + 1) * ntk) / 8); u.koff = s0 * 128; u.nt = s1 - s0; return true; }
    __device__ __forceinline__ void a_ready(const pg8::Unit&) const {}
    __device__ __forceinline__ void done(const pg8::Unit&) const {}
};
template <bool Q8>
struct EpiSlabT {
    static constexpr bool PERM = false, AFTER_DRAIN = false, I8 = Q8;
    float* slab; const float* SA; const float* CS;
    DI void prescale(f32x4 (&acc)[2][2][4][2], const pg8::Unit& u, int wr, int wc, int fr, int fq) const { i8_prescale_np(acc, SA, CS, u, wr, wc, fr, fq); }
    DI void operator()(const f32x4 (&acc)[2][2][4][2], const pg8::Unit& u, int wr, int wc, int fr, int fq) const {
        const int row0 = u.pm * 256 + wr * 64 + fr, col0 = u.pn * 256 + wc * 32 + 4 * fq;
        float* sb = slab + ((size_t)u.part * TC + (row0 - TL)) * D + col0;
#pragma unroll
        for (int ai = 0; ai < 2; ++ai)
#pragma unroll
            for (int m = 0; m < 4; ++m)
#pragma unroll
                for (int bj = 0; bj < 2; ++bj)
#pragma unroll
                    for (int n = 0; n < 2; ++n) *(f32x4*)(sb + (size_t)(ai * 128 + m * 16) * D + bj * 128 + n * 16) = acc[ai][bj][m][n];
    }
};
struct LatThenCtxOrder : pg8::StaticOrder {
    int nNn;
    __device__ void init2(int N, int G_, int c_, int K_) { init(TL, N, G_, c_, K_); nNn = N / 256; }
    __device__ bool next(int i, pg8::Unit& u) const {
        const long L = (long)i * G + c; if (L < nwg) return pg8::StaticOrder::next(i, u);
        const int j = (int)(L - nwg); if (j >= 4 * nNn) return false;
        u.pm = 64 + (j & 3); u.pn = j >> 2; u.koff = 0; u.nt = ntk; u.part = -1; return true; }
};
struct LoraOrder : LatThenCtxOrder {
    __device__ bool next(int i, pg8::Unit& u) const { if (!LatThenCtxOrder::next(i, u)) return false; u.koff = (u.pn >> 3) * (LORA_KU * 2); u.nt = LORA_KU / 64; return true; }
};
struct OddInOrder : pg8::StaticOrder {
    __device__ void init2(int G_, int c_, int K_) { init(TL, NO, G_, c_, K_); }
    __device__ bool next(int i, pg8::Unit& u) const {
        const long L = (long)i * G + c; if (L < nwg) return pg8::StaticOrder::next(i, u);
        const int j = (int)(L - nwg); if (j >= 4 * 14) return false;
        const int idx = j >> 2; u.pm = 64 + (j & 3); u.pn = idx < 2 ? 8 + idx : 12 + idx; u.koff = 0; u.nt = ntk; u.part = -1; return true; }
};
template <bool Q8, class TS = res_t>
struct EpiResModT {
    static constexpr bool PERM = false, AFTER_DRAIN = false, I8 = Q8;
    const TS* Rlat; const TS* Rctx; res_t* Hout; const float* mod;
    const float* SA; const float* CS;
    DI void prescale(f32x4 (&acc)[2][2][4][2], const pg8::Unit& u, int wr, int wc, int fr, int fq) const { i8_prescale_np(acc, SA, CS, u, wr, wc, fr, fq); }
    DI void operator()(const f32x4 (&acc)[2][2][4][2], const pg8::Unit& u, int wr, int wc, int fr, int fq) const {
        const int row0 = u.pm * 256 + wr * 64 + fr, col0 = u.pn * 256 + wc * 32 + 4 * fq;
        const float* mp = mod + (size_t)(u.pm < 64 ? (u.pm >> 4) : 4) * 24576 + col0;
        f32x4 mv[2][2];
#pragma unroll
        for (int bj = 0; bj < 2; ++bj)
#pragma unroll
            for (int n = 0; n < 2; ++n) mv[bj][n] = *(const f32x4*)(mp + bj * 128 + n * 16);
        const TS* sbase = (u.pm < 64) ? Rlat + (size_t)row0 * D : Rctx + (size_t)(row0 - TL) * D;
        res_t* dbase = Hout + (size_t)row0 * D;
#pragma unroll
        for (int ai = 0; ai < 2; ++ai)
#pragma unroll
            for (int m = 0; m < 4; ++m) { const size_t ro = (size_t)(ai * 128 + m * 16) * D + col0;
#pragma unroll
                for (int bj = 0; bj < 2; ++bj)
#pragma unroll
                    for (int n = 0; n < 2; ++n) { const f32x4 r = ld4(sbase + ro + bj * 128 + n * 16);
                        st4(dbase + ro + bj * 128 + n * 16, r + mv[bj][n] * acc[ai][bj][m][n]); } }
    }
};

typedef EpiResModT<false, res_t> EpiResMod;
typedef EpiSlabT<false> EpiSlab;
struct EpiConvGlu {
    static constexpr bool PERM = true, AFTER_DRAIN = false, I8 = (FFN_I8 != 0);
    bf16_t* HID; bf16_t* SG; bf16_t* SU; const float* cw; const float* cb; const float* SA; const float* CS;
    DI void prescale(f32x4 (&acc)[2][2][4][2], const pg8::Unit& u, int wr, int wc, int fr, int fq) const { i8_prescale(acc, SA, CS, u, wr, wc, fr, fq); }
    DI void operator()(const f32x4 (&acc)[2][2][4][2], const pg8::Unit& u, int wr, int wc, int fr, int fq) const {
        const int col = u.pn * 128 + wc * 32 + 8 * fq;
#pragma unroll
        for (int ai = 0; ai < 2; ++ai) {
            const int rowb = u.pm * 256 + ai * 128 + wr * 64;
#pragma unroll
            for (int n = 0; n < 2; ++n) {
                const f32x4 w0 = *(const f32x4*)(cw + col + 4 * n), w1 = *(const f32x4*)(cw + DFF + col + 4 * n), w2 = *(const f32x4*)(cw + 2 * DFF + col + 4 * n), bb = *(const f32x4*)(cb + col + 4 * n);
                unsigned outp[4][2];
#pragma unroll
                for (int ep = 0; ep < 2; ++ep) { float o[4][2];
#pragma unroll
                    for (int e2 = 0; e2 < 2; ++e2) { const int e = 2 * ep + e2; float P[4], N[4];
#pragma unroll
                        for (int m = 0; m < 4; ++m) { const int vi = __float_as_int(acc[ai][0][m][n][e]);
                            P[m] = __int_as_float(__builtin_amdgcn_update_dpp(0, vi, 0x121, 0xF, 0xF, false)); N[m] = __int_as_float(__builtin_amdgcn_update_dpp(0, vi, 0x12F, 0xF, 0xF, false)); }
#pragma unroll
                        for (int m = 0; m < 4; ++m) { const float prev = fr > 0 ? P[m] : (m > 0 ? P[m - 1] : 0.f), next = fr < 15 ? N[m] : (m < 3 ? N[m + 1] : 0.f);
                            const float x = w0[e] * prev + w1[e] * acc[ai][0][m][n][e] + w2[e] * next + bb[e];
                            o[m][e2] = silu_f(x) * acc[ai][1][m][n][e]; } }
#pragma unroll
                    for (int m = 0; m < 4; ++m) outp[m][ep] = pk_bf16(o[m][0], o[m][1]); }
#pragma unroll
                for (int m = 0; m < 4; ++m) { const int rho = 16 * m + fr, row = rowb + rho;
                    if (rho != 0 && rho != 63) { u32x2 w = {outp[m][0], outp[m][1]}; *(u32x2*)(HID + (size_t)row * DFF + col + 4 * n) = w; }
                    if (m == 0 || m == 3) { if (rho <= 1 || rho >= 62) { const int slot = rho <= 1 ? rho : rho - 60;
                            u32x2 g; g.x = pk_bf16(acc[ai][0][m][n][0], acc[ai][0][m][n][1]); g.y = pk_bf16(acc[ai][0][m][n][2], acc[ai][0][m][n][3]);
                            *(u32x2*)(SG + ((size_t)(row >> 6) * 4 + slot) * DFF + col + 4 * n) = g;
                            if (rho == 0 || rho == 63) { u32x2 q; q.x = pk_bf16(acc[ai][1][m][n][0], acc[ai][1][m][n][1]); q.y = pk_bf16(acc[ai][1][m][n][2], acc[ai][1][m][n][3]);
                                *(u32x2*)(SU + ((size_t)(row >> 6) * 2 + (rho == 63 ? 1 : 0)) * DFF + col + 4 * n) = q; } } }
                }
            }
        }
    }
};
__device__ __forceinline__ void p_conv_fix(const Ctx& c, int l, int nrows) {
    const bf16_t* SG = (const bf16_t*)(c.ar + AR_SG); const bf16_t* SU = (const bf16_t*)(c.ar + AR_SU); bf16_t* HID = (bf16_t*)(c.ar + AR_HID);
    const float* cw = c.in[I_CONVW] + (size_t)l * 3 * DFF; const float* cb = c.in[I_CONVB] + (size_t)l * DFF;
    const int nitems = (nrows / 64) * 2 * 22;
    const u32x4 z4 = {0u, 0u, 0u, 0u};
    for (int item = blockIdx.x * 8 + c.wave; item < nitems; item += gridDim.x * 8) {
        const int ch = item % 22, kw = item / 22, kb = kw >> 1, last = kw & 1, col = ch * 512 + c.lane * 8;
        if (col >= DFF) continue;
        const int row = kb * 64 + (last ? 63 : 0);
        int pos, len; if (row < TL) { pos = row & 4095; len = 4096; } else { pos = (row - TL) & 255; len = 256; }
        u32x4 gp, gc, gn;
        if (!last) { gp = pos > 0 ? *(const u32x4*)(SG + ((size_t)(kb - 1) * 4 + 3) * DFF + col) : z4; gc = *(const u32x4*)(SG + ((size_t)kb * 4 + 0) * DFF + col); gn = *(const u32x4*)(SG + ((size_t)kb * 4 + 1) * DFF + col); }
        else { gp = *(const u32x4*)(SG + ((size_t)kb * 4 + 2) * DFF + col); gc = *(const u32x4*)(SG + ((size_t)kb * 4 + 3) * DFF + col); gn = pos < len - 1 ? *(const u32x4*)(SG + ((size_t)(kb + 1) * 4 + 0) * DFF + col) : z4; }
        const u32x4 up = *(const u32x4*)(SU + ((size_t)kb * 2 + last) * DFF + col);
        float w0[8], w1[8], w2[8], bb[8]; load8f(cw + col, w0); load8f(cw + DFF + col, w1); load8f(cw + 2 * DFF + col, w2); load8f(cb + col, bb);
        float o[8];
#pragma unroll
        for (int j = 0; j < 4; ++j) {
            const float x0 = bflo(gp[j]) * w0[2 * j] + bflo(gc[j]) * w1[2 * j] + bflo(gn[j]) * w2[2 * j] + bb[2 * j];
            const float x1 = bfhi(gp[j]) * w0[2 * j + 1] + bfhi(gc[j]) * w1[2 * j + 1] + bfhi(gn[j]) * w2[2 * j + 1] + bb[2 * j + 1];
            o[2 * j] = silu_f(x0) * bflo(up[j]); o[2 * j + 1] = silu_f(x1) * bfhi(up[j]); }
        u32x4 w; w.x = pk_bf16(o[0], o[1]); w.y = pk_bf16(o[2], o[3]); w.z = pk_bf16(o[4], o[5]); w.w = pk_bf16(o[6], o[7]);
        *(u32x4*)(HID + (size_t)row * DFF + col) = w;
    }
}

DI void unpack8(const u32x4 w, float (&o)[8]) {
#pragma unroll
    for (int j = 0; j < 4; ++j) { o[2 * j] = bflo(w[j]); o[2 * j + 1] = bfhi(w[j]); }
}
DI u32x4 pack8_bf16(const float (&o)[8]) { u32x4 w; w.x = pk_bf16(o[0], o[1]); w.y = pk_bf16(o[2], o[3]); w.z = pk_bf16(o[4], o[5]); w.w = pk_bf16(o[6], o[7]); return w; }
DI u32x4 pack8_f16(const float (&o)[8]) { u32x4 w; w.x = pk_f16(o[0], o[1]); w.y = pk_f16(o[2], o[3]); w.z = pk_f16(o[4], o[5]); w.w = pk_f16(o[6], o[7]); return w; }
DI void unpack8_f16(const u32x4 w, float (&o)[8]) {
#pragma unroll
    for (int j = 0; j < 4; ++j) { o[2 * j] = h16lo(w[j]); o[2 * j + 1] = h16hi(w[j]); }
}
DI void row_pos(int row, int& pos, int& len) { if (row < TL) { pos = row & 4095; len = 4096; } else { pos = (row - TL) & 255; len = 256; } }

__device__ __forceinline__ void p_rwkv_prepA(const Ctx& c) {
    const bf16_t* PA = (const bf16_t*)(c.ar + AR_PA);
    h16* R16 = (h16*)(c.ar + AR_R); h16* KK16 = (h16*)(c.ar + AR_KK); h16* V16 = (h16*)(c.ar + AR_V); bf16_t* K16 = (bf16_t*)(c.ar + AR_K); bf16_t* LA = (bf16_t*)(c.ar + AR_LA);
    const float* mu = c.in[I_MU]; const float* k_k = c.in[I_KK];
    const int lane = c.lane;
    for (int row = blockIdx.x * 8 + c.wave; row < TT; row += gridDim.x * 8) {
        int pos, len; row_pos(row, pos, len);
        const bool hasp = pos > 0, hasn = pos < len - 1;
        const bf16_t* pc = PA + (size_t)row * COLS_A_PAD;
        for (int it = 0; it < 14; ++it) {
            const int col = it * 512 + lane * 8;
            if (col >= COLS_A) break;
            float cur[8], prv[8], nxt[8], m8[8], mx[8];
            unpack8(*(const u32x4*)(pc + col), cur);
            if (hasp) unpack8(*(const u32x4*)(pc - COLS_A_PAD + col), prv); else {
#pragma unroll
                for (int j = 0; j < 8; ++j) prv[j] = 0.f; }
            if (hasn) unpack8(*(const u32x4*)(pc + COLS_A_PAD + col), nxt); else {
#pragma unroll
                for (int j = 0; j < 8; ++j) nxt[j] = 0.f; }
            load8f(mu + col, m8);
#pragma unroll
            for (int j = 0; j < 8; ++j) mx[j] = cur[j] + m8[j] * (0.5f * (prv[j] + nxt[j]) - cur[j]);
            if (it < 4) {
                *(u32x4*)(R16 + (size_t)row * 2048 + col) = pack8_f16(mx);
            } else if (it < 8) {
                const int j0 = col - 2048;
                *(u32x4*)(K16 + (size_t)row * 2048 + j0) = pack8_bf16(mx);
                float kk8[8], x[8]; load8f(k_k + j0, kk8); float ss = 0.f;
#pragma unroll
                for (int j = 0; j < 8; ++j) { x[j] = mx[j] * kk8[j]; ss += x[j] * x[j]; }
                ss += __shfl_xor(ss, 1); ss += __shfl_xor(ss, 2); ss += __shfl_xor(ss, 4);
                const float rn = rsqrtf(ss + 1e-12f);
#pragma unroll
                for (int j = 0; j < 8; ++j) x[j] *= rn;
                *(u32x4*)(KK16 + (size_t)row * 2048 + j0) = pack8_f16(x);
            } else if (it < 12) {
                *(u32x4*)(V16 + (size_t)row * 2048 + (col - 4096)) = pack8_f16(mx);
            } else {
                const int q0 = col - 6144; float o[8];
#pragma unroll
                for (int j = 0; j < 8; ++j) o[j] = q0 < 192 ? (1.0f - 2.0f * __builtin_amdgcn_rcpf(1.0f + __expf(2.0f * mx[j]))) : (q0 < 384 ? mx[j] : sigmoid_f(mx[j]));
                const int seg = q0 < 384 ? q0 / 96 : 4, off = q0 - (seg < 4 ? seg * 96 : 384);
                *(u32x4*)(LA + (size_t)row * LORA_K + seg * LORA_KU + off) = pack8_bf16(o);
            }
        }
        {
            const u32x4 z4 = {0u, 0u, 0u, 0u};
            for (int z = lane; z < 80; z += 64) *(u32x4*)(LA + (size_t)row * LORA_K + (z / 20) * LORA_KU + 96 + (z % 20) * 8) = z4; }
    }
}

DI int kperm16(int o) { return (o & ~12) | ((o >> 1) & 4) | ((o << 1) & 8); }
template <int DVW  , int NHEAD>
__device__ __forceinline__ void p_build_vt(const Ctx& c, const bf16_t* P, int ldp, int vcol0, bf16_t* VT) {
    constexpr int NSLAB = (DVW * NHEAD) / 512 > 0 ? (DVW * NHEAD) / 512 : 1;
    constexpr int SLABW = (DVW * NHEAD) < 512 ? (DVW * NHEAD) : 512;
    LAS unsigned short* T = (LAS unsigned short*)c.lds;
    const int tid = c.tid;
    for (int item = blockIdx.x; item < (TT / 64) * NSLAB; item += gridDim.x) {
        const int kg = item / NSLAB, slab = item % NSLAB;
        const int row0 = kg * 64;
        int b, key0; if (row0 < TL) { b = row0 >> 12; key0 = row0 & 4095; } else { b = (row0 - TL) >> 8; key0 = 4096 + ((row0 - TL) & 255); }
        { const int key = tid >> 3, part = tid & 7; const int kp = (key & ~15) | kperm16(key & 15);
          constexpr int CPT = SLABW / 8;
          const bf16_t* src = P + (size_t)(row0 + key) * ldp + vcol0 + slab * SLABW + part * CPT;
#pragma unroll
          for (int e = 0; e < CPT / 8; ++e) { const u32x4 w = *(const u32x4*)(src + e * 8);
#pragma unroll
              for (int j = 0; j < 4; ++j) { T[(part * CPT + e * 8 + 2 * j) * 72 + kp] = (unsigned short)(w[j] & 0xffffu); T[(part * CPT + e * 8 + 2 * j + 1) * 72 + kp] = (unsigned short)(w[j] >> 16); } }
        }
        __syncthreads();
        for (int q = tid; q < SLABW * 8; q += NTHREADS) { const int col = q >> 3, ch = q & 7;
            const u32x4 w = *(const LAS u32x4*)(T + col * 72 + ch * 8);
            const int gc = slab * SLABW + col, head = gc / DVW, dv = gc % DVW;
            *(u32x4*)(VT + (((size_t)b * NHEAD + head) * DVW + dv) * NKEY + key0 + ch * 8) = w; }
        __syncthreads();
    }
}

struct EpiLora {
    static constexpr bool PERM = true, AFTER_DRAIN = false, I8 = false;
    const float* w0; const float* a0; const float* k_a; const bf16_t* K16; const h16* KK16; h16* OMW; h16* BB; h16* KD; bf16_t* G;
    DI void operator()(const f32x4 (&acc)[2][2][4][2], const pg8::Unit& u, int wr, int wc, int fr, int fq) const {
        const int type = u.pn >> 3, row0 = u.pm * 256 + wr * 64 + fr;
#pragma unroll
        for (int bj = 0; bj < 2; ++bj) {
            const int jc = (u.pn & 7) * 256 + bj * 128 + wc * 32 + 8 * fq;
            if (type < 2) {
                float w8[8]; load8f(w0 + type * 2048 + jc, w8);
#pragma unroll
                for (int ai = 0; ai < 2; ++ai)
#pragma unroll
                    for (int m = 0; m < 4; ++m) { const int row = row0 + ai * 128 + m * 16; float o[8];
#pragma unroll
                        for (int i = 0; i < 8; ++i) { const float w = w8[i] + (i < 4 ? acc[ai][bj][m][0][i & 3] : acc[ai][bj][m][1][i & 3]);
                            o[i] = 1.0f - __expf(-0.60653066f * sigmoid_f(w)); }
                        *(u32x4*)(OMW + ((size_t)type * TT + row) * 2048 + jc) = pack8_f16(o); }
            } else if (type < 4) {
                const int d = type - 2; float a8[8], ka8[8]; load8f(a0 + d * 2048 + jc, a8); load8f(k_a + jc, ka8);
#pragma unroll
                for (int ai = 0; ai < 2; ++ai)
#pragma unroll
                    for (int m = 0; m < 4; ++m) { const int row = row0 + ai * 128 + m * 16; float kd[8], bb[8], k8[8], kk8[8];
                        unpack8(*(const u32x4*)(K16 + (size_t)row * 2048 + jc), k8); unpack8_f16(*(const u32x4*)(KK16 + (size_t)row * 2048 + jc), kk8);
#pragma unroll
                        for (int i = 0; i < 8; ++i) { const float a = sigmoid_f(a8[i] + (i < 4 ? acc[ai][bj][m][0][i & 3] : acc[ai][bj][m][1][i & 3]));
                            kd[i] = k8[i] * (1.0f + (a - 1.0f) * ka8[i]); bb[i] = kk8[i] * a; }
                        *(u32x4*)(KD + ((size_t)d * TT + row) * 2048 + jc) = pack8_f16(kd);
                        *(u32x4*)(BB + ((size_t)d * TT + row) * 2048 + jc) = pack8_f16(bb); }
            } else {
#pragma unroll
                for (int ai = 0; ai < 2; ++ai)
#pragma unroll
                    for (int m = 0; m < 4; ++m) { const int row = row0 + ai * 128 + m * 16; float o[8];
#pragma unroll
                        for (int i = 0; i < 8; ++i) o[i] = (i < 4 ? acc[ai][bj][m][0][i & 3] : acc[ai][bj][m][1][i & 3]);
                        *(u32x4*)(G + (size_t)row * 2048 + jc) = pack8_bf16(o); }
            }
        }
    }
};

#define MFMA32(a, b, cacc) __builtin_amdgcn_mfma_f32_32x32x16_bf16((a), (b), (cacc), 0, 0, 0)
DI bf16x8 ld_frag(const bf16_t* p) { return __builtin_bit_cast(bf16x8, *(const u32x4*)p); }
DI bf16x8 pack_p(const f32x16& x, int s) { u32x4 w; w.x = pk_bf16(x[8 * s], x[8 * s + 1]); w.y = pk_bf16(x[8 * s + 2], x[8 * s + 3]); w.z = pk_bf16(x[8 * s + 4], x[8 * s + 5]); w.w = pk_bf16(x[8 * s + 6], x[8 * s + 7]); return __builtin_bit_cast(bf16x8, w); }
constexpr float LOG2E = 1.44269504088896f;

DI void fwht8x4(float (&x)[8], int lane) {
#pragma unroll
    for (int h = 1; h < 8; h <<= 1)
#pragma unroll
        for (int i = 0; i < 8; i += 2 * h)
#pragma unroll
            for (int j = i; j < i + h; ++j) { const float a = x[j], b = x[j + h]; x[j] = a + b; x[j + h] = a - b; }
#pragma unroll
    for (int j = 0; j < 8; ++j) { float v = x[j];
        { const float t = __int_as_float(__builtin_amdgcn_update_dpp(0, __float_as_int(v), 0xB1, 0xF, 0xF, false)); v = (lane & 1) ? t - v : v + t; }
        { const float t = __int_as_float(__builtin_amdgcn_update_dpp(0, __float_as_int(v), 0x4E, 0xF, 0xF, false)); v = (lane & 2) ? t - v : v + t; }
        x[j] = v; }
}
DI float wave_max(float v) {
#pragma unroll
    for (int o = 32; o >= 1; o >>= 1) v = fmaxf(v, __shfl_xor(v, o));
    return v;
}
__device__ __forceinline__ void p_rwkv_out(const Ctx& c, int nrows) {
    const bf16_t* Yf = (const bf16_t*)(c.ar + AR_Y); const bf16_t* Yb = Yf + (size_t)TT * 2048;
    const h16* R16 = (const h16*)(c.ar + AR_R); const h16* V16 = (const h16*)(c.ar + AR_V);
    const h16* KDf = (const h16*)(c.ar + AR_KD); const h16* KDb = KDf + (size_t)TT * 2048;
    const bf16_t* G = (const bf16_t*)(c.ar + AR_G); bf16_t* MIX = (bf16_t*)(c.ws + WS_XN);
    const float* r_k = c.in[I_RK]; const float* ln_w = c.in[I_LNW]; const float* ln_b = c.in[I_LNB];
    const int lane = c.lane;
    for (int row = blockIdx.x * 8 + c.wave; row < nrows; row += gridDim.x * 8) {
        float ov[4][8];
#pragma unroll
        for (int it = 0; it < 4; ++it) {
            const int col = it * 512 + lane * 8; const size_t o = (size_t)row * 2048 + col;
            float yf[8], yb[8], y[8], r8[8], v8[8], kf[8], kb[8], g8[8], rk8[8], lw[8], lb[8];
            unpack8(*(const u32x4*)(Yf + o), yf); unpack8(*(const u32x4*)(Yb + o), yb);
            unpack8_f16(*(const u32x4*)(R16 + o), r8); unpack8_f16(*(const u32x4*)(V16 + o), v8);
            unpack8_f16(*(const u32x4*)(KDf + o), kf); unpack8_f16(*(const u32x4*)(KDb + o), kb);
            unpack8(*(const u32x4*)(G + o), g8);
            load8f(r_k + col, rk8); load8f(ln_w + col, lw); load8f(ln_b + col, lb);
            float sm = 0.f, bn = 0.f;
#pragma unroll
            for (int j = 0; j < 8; ++j) { y[j] = yf[j] + yb[j]; sm += y[j]; bn += r8[j] * (kf[j] + kb[j]) * rk8[j]; }
            sm += __shfl_xor(sm, 1); sm += __shfl_xor(sm, 2); sm += __shfl_xor(sm, 4);
            bn += __shfl_xor(bn, 1); bn += __shfl_xor(bn, 2); bn += __shfl_xor(bn, 4);
            const float mean = sm * (1.0f / 64.0f); float vs = 0.f;
#pragma unroll
            for (int j = 0; j < 8; ++j) { const float dlt = y[j] - mean; vs += dlt * dlt; }
            vs += __shfl_xor(vs, 1); vs += __shfl_xor(vs, 2); vs += __shfl_xor(vs, 4);
            const float rs = rsqrtf(vs * (1.0f / 64.0f) + 64e-5f);
            float o8[8];
#pragma unroll
            for (int j = 0; j < 8; ++j) o8[j] = ((y[j] - mean) * rs * lw[j] + lb[j] + bn * v8[j]) * g8[j];
            if (MIX_I8) {
#pragma unroll
                for (int j = 0; j < 8; ++j) ov[it][j] = o8[j]; }
            else *(u32x4*)(MIX + (size_t)row * D + col) = pack8_bf16(o8);
        }
        if (MIX_I8) {
            float av[4][8]; float mx = 0.f;
#pragma unroll
            for (int it = 0; it < 4; ++it) { unpack8(*(const u32x4*)(MIX + (size_t)row * D + 2048 + it * 512 + lane * 8), av[it]);
                fwht8x4(ov[it], lane); fwht8x4(av[it], lane);
#pragma unroll
                for (int j = 0; j < 8; ++j) mx = fmaxf(mx, fmaxf(fabsf(ov[it][j]), fabsf(av[it][j]))); }
            mx = wave_max(mx);
            const float qs = mx > 0.f ? 127.0f / mx : 0.f;
            unsigned char* xq = c.ar + AR_XQ + (size_t)row * D;
#pragma unroll
            for (int it = 0; it < 4; ++it) {
                u32x2 w0 = {pk_i8x4(ov[it][0] * qs, ov[it][1] * qs, ov[it][2] * qs, ov[it][3] * qs), pk_i8x4(ov[it][4] * qs, ov[it][5] * qs, ov[it][6] * qs, ov[it][7] * qs)};
                u32x2 w1 = {pk_i8x4(av[it][0] * qs, av[it][1] * qs, av[it][2] * qs, av[it][3] * qs), pk_i8x4(av[it][4] * qs, av[it][5] * qs, av[it][6] * qs, av[it][7] * qs)};
                *(u32x2*)(xq + it * 512 + lane * 8) = w0; *(u32x2*)(xq + 2048 + it * 512 + lane * 8) = w1; }
            if (lane == 0) ((float*)(c.ar + AR_XQS))[row] = mx * (1.0f / 127.0f);
        }
    }
}
__device__ __forceinline__ void p_quant_hid(const Ctx& c, int nrows) {
    const bf16_t* HID = (const bf16_t*)(c.ar + AR_HID); const int lane = c.lane;
    for (int row = blockIdx.x * 8 + c.wave; row < nrows; row += gridDim.x * 8) {
        u32x4 pk[22]; float mx = 0.f;
#pragma unroll
        for (int it = 0; it < 22; ++it) { const int col = it * 512 + lane * 8; pk[it] = col < DFF ? *(const u32x4*)(HID + (size_t)row * DFF + col) : (u32x4){0u, 0u, 0u, 0u}; }
#pragma unroll
        for (int it = 0; it < 22; ++it) { float x[8]; unpack8(pk[it], x); fwht8x4(x, lane);
#pragma unroll
            for (int j = 0; j < 8; ++j) mx = fmaxf(mx, fabsf(x[j])); }
        mx = wave_max(mx);
        const float qs = mx > 0.f ? 127.0f / mx : 0.f;
        unsigned char* hq = c.ar + AR_HQ + (size_t)row * DFF;
#pragma unroll
        for (int it = 0; it < 22; ++it) { float x[8]; unpack8(pk[it], x); fwht8x4(x, lane); const int col = it * 512 + lane * 8;
            u32x2 w = {pk_i8x4(x[0] * qs, x[1] * qs, x[2] * qs, x[3] * qs), pk_i8x4(x[4] * qs, x[5] * qs, x[6] * qs, x[7] * qs)};
            if (col < DFF) *(u32x2*)(hq + col) = w; }
        if (lane == 0) ((float*)(c.ar + AR_HQS))[row] = mx * (1.0f / 127.0f);
    }
}
__device__ __forceinline__ void p_quant_mix(const Ctx& c, int nrows) {
    const bf16_t* MIX = (const bf16_t*)(c.ws + WS_XN); const int lane = c.lane;
    for (int row = blockIdx.x * 8 + c.wave; row < nrows; row += gridDim.x * 8) {
        float x[8][8]; float mx = 0.f;
#pragma unroll
        for (int it = 0; it < 8; ++it) { unpack8(*(const u32x4*)(MIX + (size_t)row * D + it * 512 + lane * 8), x[it]); fwht8x4(x[it], lane);
#pragma unroll
            for (int j = 0; j < 8; ++j) mx = fmaxf(mx, fabsf(x[it][j])); }
        mx = wave_max(mx);
        const float qs = mx > 0.f ? 127.0f / mx : 0.f;
        unsigned char* xq = c.ar + AR_XQ + (size_t)row * D;
#pragma unroll
        for (int it = 0; it < 8; ++it) { u32x2 w = {pk_i8x4(x[it][0] * qs, x[it][1] * qs, x[it][2] * qs, x[it][3] * qs), pk_i8x4(x[it][4] * qs, x[it][5] * qs, x[it][6] * qs, x[it][7] * qs)};
            *(u32x2*)(xq + it * 512 + lane * 8) = w; }
        if (lane == 0) ((float*)(c.ar + AR_XQS))[row] = mx * (1.0f / 127.0f);
    }
}

constexpr int K1_WAVE_LDS = 35328;
constexpr size_t TT_ROWS2048 = (size_t)TT * 2048;
#define WAVE_SYNC() do { asm volatile("s_waitcnt lgkmcnt(0)" ::: "memory"); __builtin_amdgcn_wave_barrier(); } while (0)
DI int rw_row(int b, int dir, int t) { return t < CTXL ? TL + b * CTXL + (dir ? (CTXL - 1 - t) : t) : b * SEQ + (dir ? (SEQ - 1 - (t - CTXL)) : (t - CTXL)); }
DI float bfu(unsigned short x) { return __uint_as_float((unsigned)x << 16); }
DI bf16x8 colfrag_nat(const LAS unsigned short* T, int col, int t0) { u32x4 w;
#pragma unroll
    for (int j = 0; j < 4; ++j) w[j] = (unsigned)T[(t0 + 2 * j) * 64 + col] | ((unsigned)T[(t0 + 2 * j + 1) * 64 + col] << 16);
    return __builtin_bit_cast(bf16x8, w); }
DI bf16x8 colfrag_nat_scaled(const LAS unsigned short* T, int col, int t0, float sc) { u32x4 w;
#pragma unroll
    for (int j = 0; j < 4; ++j) w[j] = pk_bf16(bfu(T[(t0 + 2 * j) * 64 + col]) * sc, bfu(T[(t0 + 2 * j + 1) * 64 + col]) * sc);
    return __builtin_bit_cast(bf16x8, w); }
DI bf16x8 colfrag_pk_scaled(const LAS unsigned short* T, int col, int s, int hh, float sc) { u32x4 w;
#pragma unroll
    for (int j2 = 0; j2 < 4; ++j2) { const int j = 2 * j2, t = 16 * s + 8 * (j >> 2) + 4 * hh + (j & 3);
        w[j2] = pk_bf16(bfu(T[t * 64 + col]) * sc, bfu(T[(t + 1) * 64 + col]) * sc); }
    return __builtin_bit_cast(bf16x8, w); }
DI bf16x8 rowfrag_nat(const LAS unsigned short* A, int row, int s, int hh) { const LAS u32x2* p = (const LAS u32x2*)(A + row * 40 + 16 * s + 8 * hh); const u32x2 a = p[0], b = p[1];
    u32x4 w = {a.x, a.y, b.x, b.y}; return __builtin_bit_cast(bf16x8, w); }
DI bf16x8 rowfrag_pk(const LAS unsigned short* A, int row, int s, int hh) { const u32x2 a = *(const LAS u32x2*)(A + row * 40 + 16 * s + 4 * hh), b = *(const LAS u32x2*)(A + row * 40 + 16 * s + 8 + 4 * hh);
    u32x4 w = {a.x, a.y, b.x, b.y}; return __builtin_bit_cast(bf16x8, w); }
DI u32x4 pack_pu(const f32x16& x, int s) { u32x4 w; w.x = pk_bf16(x[8 * s], x[8 * s + 1]); w.y = pk_bf16(x[8 * s + 2], x[8 * s + 3]); w.z = pk_bf16(x[8 * s + 4], x[8 * s + 5]); w.w = pk_bf16(x[8 * s + 6], x[8 * s + 7]); return w; }

__device__ __forceinline__ void rwkv_k1_chunk(const Ctx& c, LAS unsigned char* wl, int seq, int ch) {
    const int dir = seq & 1, h = (seq >> 1) & 31, b = seq >> 6;
    const int lane = c.lane, r = lane & 31, hh = lane >> 5;
    LAS unsigned short* TA = (LAS unsigned short*)wl; LAS unsigned short* TB = TA + 2048; LAS unsigned short* TK = TB + 2048; LAS unsigned short* TR = TK + 2048; LAS unsigned short* TVv = TR + 2048;
    LAS float* GC = (LAS float*)(wl + 20480); LAS float* LAB = (LAS float*)(wl + 20736);
    LAS unsigned short* TTi = (LAS unsigned short*)(wl + 24832); LAS unsigned short* TAK = TTi + 1280; LAS unsigned short* TRB = TAK + 1280; LAS unsigned short* TRK = TRB + 1280;
    const h16* KK = (const h16*)(c.ar + AR_KK); const h16* RR = (const h16*)(c.ar + AR_R); const h16* VV = (const h16*)(c.ar + AR_V);
    const h16* OM = (const h16*)(c.ar + AR_OMW) + (size_t)dir * TT_ROWS2048; const h16* BBp = (const h16*)(c.ar + AR_BB) + (size_t)dir * TT_ROWS2048; const h16* KDp = (const h16*)(c.ar + AR_KD) + (size_t)dir * TT_ROWS2048;
    {   LAS unsigned short* TO = (LAS unsigned short*)LAB;
        u32x4 ld[6][4];
#pragma unroll
        for (int i = 0; i < 4; ++i) { const int tau = (lane >> 3) + 8 * i; const size_t off = (size_t)rw_row(b, dir, ch * 32 + tau) * 2048 + h * 64 + (lane & 7) * 8;
            ld[0][i] = *(const u32x4*)(KK + off); ld[1][i] = *(const u32x4*)(BBp + off); ld[2][i] = *(const u32x4*)(KDp + off);
            ld[3][i] = *(const u32x4*)(RR + off); ld[4][i] = *(const u32x4*)(VV + off); ld[5][i] = *(const u32x4*)(OM + off); }
#pragma unroll
        for (int i = 0; i < 4; ++i) { const int o = ((lane >> 3) + 8 * i) * 64 + (lane & 7) * 8;
            *(LAS u32x4*)(TA + o) = ld[0][i]; *(LAS u32x4*)(TB + o) = ld[1][i]; *(LAS u32x4*)(TK + o) = ld[2][i];
            *(LAS u32x4*)(TR + o) = ld[3][i]; *(LAS u32x4*)(TVv + o) = ld[4][i]; *(LAS u32x4*)(TO + o) = ld[5][i]; }
    }
    WAVE_SYNC();
    {   const LAS h16* TO = (const LAS h16*)LAB;
        float g = 1.f;
#pragma unroll 8
        for (int tau = 0; tau < 32; ++tau) { const int o = tau * 64 + lane;
            const float omw = (float)TO[o], bb = (float)((const LAS h16*)TB)[o], kd = (float)((const LAS h16*)TK)[o], kk = (float)((const LAS h16*)TA)[o], rr = (float)((const LAS h16*)TR)[o], vv = (float)((const LAS h16*)TVv)[o];
            const float gp = g; g *= (1.0f - omw); const float ig = __builtin_amdgcn_rcpf(g);
            TA[o] = f2bf(kk * gp); TB[o] = f2bf(-bb * ig); TK[o] = f2bf(kd * ig); TR[o] = f2bf(rr * g); TVv[o] = f2bf(vv);
        }
        GC[lane] = g;
    }
    WAVE_SYNC();
    {   f32x16 ab, ak, rb, rk;
#pragma unroll
        for (int i = 0; i < 16; ++i) { ab[i] = 0.f; ak[i] = 0.f; rb[i] = 0.f; rk[i] = 0.f; }
#pragma unroll
        for (int ks = 0; ks < 4; ++ks) { const int o = r * 64 + 16 * ks + 8 * hh;
            const bf16x8 fa = *(const LAS bf16x8*)(TA + o), fb = *(const LAS bf16x8*)(TB + o), fk = *(const LAS bf16x8*)(TK + o), fr = *(const LAS bf16x8*)(TR + o);
            ab = MFMA32(fa, fb, ab); ak = MFMA32(fa, fk, ak); rb = MFMA32(fr, fb, rb); rk = MFMA32(fr, fk, rk); }
#pragma unroll
        for (int i = 0; i < 16; ++i) { const int tau = (i & 3) + 8 * (i >> 2) + 4 * hh;
            LAB[tau * 32 + r] = (r < tau) ? ab[i] : 0.f;
            TAK[tau * 40 + r] = f2bf((r < tau) ? ak[i] : 0.f); TRB[tau * 40 + r] = f2bf((r <= tau) ? rb[i] : 0.f); TRK[tau * 40 + r] = f2bf((r <= tau) ? rk[i] : 0.f); }
    }
    WAVE_SYNC();
    {   float Tc[32];
#pragma unroll
        for (int tau = 0; tau < 32; ++tau) { float acc = (r == tau) ? 1.f : 0.f;
#pragma unroll
            for (int q = 0; q < (tau + 3) / 4; ++q) { const f32x4 a4 = *(const LAS f32x4*)(LAB + tau * 32 + 4 * q);
#pragma unroll
                for (int e = 0; e < 4; ++e) if (4 * q + e < tau) acc = fmaf(a4[e], Tc[4 * q + e], acc); }
            Tc[tau] = acc; }
        if (hh == 0) {
#pragma unroll
            for (int tau = 0; tau < 32; ++tau) TTi[tau * 40 + r] = f2bf(Tc[tau]); }
    }
    WAVE_SYNC();
    f32x16 W1[2], Z[2]; bf16x8 Vn[2][2];
    {   bf16x8 tn[2], tp[2], akn[2];
#pragma unroll
        for (int s = 0; s < 2; ++s) { tn[s] = rowfrag_nat(TTi, r, s, hh); tp[s] = rowfrag_pk(TTi, r, s, hh); akn[s] = rowfrag_nat(TAK, r, s, hh); }
#pragma unroll
        for (int t2 = 0; t2 < 2; ++t2) {
#pragma unroll
            for (int i = 0; i < 16; ++i) W1[t2][i] = 0.f;
            f32x16 X;
#pragma unroll
            for (int i = 0; i < 16; ++i) X[i] = 0.f;
#pragma unroll
            for (int s = 0; s < 2; ++s) { Vn[t2][s] = colfrag_nat(TVv, 32 * t2 + r, 16 * s + 8 * hh);
                W1[t2] = MFMA32(tn[s], colfrag_nat(TA, 32 * t2 + r, 16 * s + 8 * hh), W1[t2]);
                X = MFMA32(akn[s], Vn[t2][s], X); }
#pragma unroll
            for (int i = 0; i < 16; ++i) Z[t2][i] = 0.f;
#pragma unroll
            for (int s = 0; s < 2; ++s) Z[t2] = MFMA32(tp[s], pack_p(X, s), Z[t2]);
        }
    }
    u32x4* CHp = (u32x4*)(c.ar + AR_CH + ((size_t)seq * RW_NCH + ch) * CH_BYTES) + lane;
    {   bf16x8 rbp[2], rkn[2];
#pragma unroll
        for (int s = 0; s < 2; ++s) { rbp[s] = rowfrag_pk(TRB, r, s, hh); rkn[s] = rowfrag_nat(TRK, r, s, hh); }
#pragma unroll
        for (int kt = 0; kt < 2; ++kt) { f32x16 GT;
#pragma unroll
            for (int g4 = 0; g4 < 4; ++g4) { const u32x2 w = *(const LAS u32x2*)(TR + r * 64 + 32 * kt + 8 * g4 + 4 * hh);
                GT[4 * g4] = bflo(w.x); GT[4 * g4 + 1] = bfhi(w.x); GT[4 * g4 + 2] = bflo(w.y); GT[4 * g4 + 3] = bfhi(w.y); }
#pragma unroll
            for (int s = 0; s < 2; ++s) GT = MFMA32(pack_p(W1[kt], s), rbp[s], GT);
#pragma unroll
            for (int s = 0; s < 2; ++s) CHp[(0 + kt * 2 + s) * 64] = pack_pu(GT, s); }
#pragma unroll
        for (int vt = 0; vt < 2; ++vt) { f32x16 Y0;
#pragma unroll
            for (int i = 0; i < 16; ++i) Y0[i] = 0.f;
#pragma unroll
            for (int s = 0; s < 2; ++s) { Y0 = MFMA32(pack_p(Z[vt], s), rbp[s], Y0); Y0 = MFMA32(Vn[vt][s], rkn[s], Y0); }
#pragma unroll
            for (int s = 0; s < 2; ++s) CHp[(4 + vt * 2 + s) * 64] = pack_pu(Y0, s); }
    }
#pragma unroll
    for (int k2 = 0; k2 < 2; ++k2) {
        const float gc = GC[32 * k2 + r];
        bf16x8 bhp[2], khn[2];
#pragma unroll
        for (int s = 0; s < 2; ++s) { bhp[s] = colfrag_pk_scaled(TB, 32 * k2 + r, s, hh, gc); khn[s] = colfrag_nat_scaled(TK, 32 * k2 + r, 16 * s + 8 * hh, gc); }
#pragma unroll
        for (int kt = 0; kt < 2; ++kt) { f32x16 PT;
#pragma unroll
            for (int i = 0; i < 16; ++i) PT[i] = (kt == k2 && ((i & 3) + 8 * (i >> 2) + 4 * hh) == r) ? gc : 0.f;
#pragma unroll
            for (int s = 0; s < 2; ++s) PT = MFMA32(pack_p(W1[kt], s), bhp[s], PT);
#pragma unroll
            for (int s = 0; s < 2; ++s) CHp[(8 + k2 * 4 + kt * 2 + s) * 64] = pack_pu(PT, s); }
#pragma unroll
        for (int vt = 0; vt < 2; ++vt) { f32x16 PS;
#pragma unroll
            for (int i = 0; i < 16; ++i) PS[i] = 0.f;
#pragma unroll
            for (int s = 0; s < 2; ++s) { PS = MFMA32(bhp[s], pack_p(Z[vt], s), PS); PS = MFMA32(khn[s], Vn[vt][s], PS); }
#pragma unroll
            for (int s = 0; s < 2; ++s) CHp[(16 + k2 * 4 + vt * 2 + s) * 64] = pack_pu(PS, s); }
    }
    WAVE_SYNC();
}

DI void unpack_acc(const u32x4 lo, const u32x4 hi, f32x16& x) {
#pragma unroll
    for (int j = 0; j < 4; ++j) { x[2 * j] = bflo(lo[j]); x[2 * j + 1] = bfhi(lo[j]); x[8 + 2 * j] = bflo(hi[j]); x[8 + 2 * j + 1] = bfhi(hi[j]); }
}
__device__ __forceinline__ void rwkv_seq_wave(const Ctx& c, int seq, int vt) {
    const int dir = seq & 1, h = (seq >> 1) & 31, b = seq >> 6;
    const int lane = c.lane, r = lane & 31, hh = lane >> 5;
    bf16_t* Y = (bf16_t*)(c.ar + AR_Y) + (size_t)dir * TT_ROWS2048;
    f32x16 M[2];
#pragma unroll
    for (int kt = 0; kt < 2; ++kt)
#pragma unroll
        for (int i = 0; i < 16; ++i) M[kt][i] = 0.f;
    const u32x4* CH0 = (const u32x4*)(c.ar + AR_CH + (size_t)seq * RW_NCH * CH_BYTES) + lane;
    u32x4 gf[4], pf[8], y0[2], ps[4];
#define RW_LOAD(chp) do { _Pragma("unroll") for (int q = 0; q < 4; ++q) gf[q] = (chp)[q * 64]; _Pragma("unroll") for (int q = 0; q < 2; ++q) y0[q] = (chp)[(4 + vt * 2 + q) * 64]; \
        _Pragma("unroll") for (int q = 0; q < 8; ++q) pf[q] = (chp)[(8 + q) * 64]; _Pragma("unroll") for (int k2 = 0; k2 < 2; ++k2) _Pragma("unroll") for (int s = 0; s < 2; ++s) ps[k2 * 2 + s] = (chp)[(16 + k2 * 4 + vt * 2 + s) * 64]; } while (0)
    RW_LOAD(CH0);
    for (int ch = 0; ch < (int)RW_NCH; ++ch) {
        bf16x8 mp[4];
#pragma unroll
        for (int kt = 0; kt < 2; ++kt)
#pragma unroll
            for (int s = 0; s < 2; ++s) mp[kt * 2 + s] = pack_p(M[kt], s);
        f32x16 Yc, Mn[2];
        unpack_acc(y0[0], y0[1], Yc); unpack_acc(ps[0], ps[1], Mn[0]); unpack_acc(ps[2], ps[3], Mn[1]);
#pragma unroll
        for (int q = 0; q < 4; ++q) Yc = MFMA32(mp[q], __builtin_bit_cast(bf16x8, gf[q]), Yc);
#pragma unroll
        for (int k2 = 0; k2 < 2; ++k2)
#pragma unroll
            for (int q = 0; q < 4; ++q) Mn[k2] = MFMA32(__builtin_bit_cast(bf16x8, pf[k2 * 4 + q]), mp[q], Mn[k2]);
        if (ch + 1 < (int)RW_NCH) { const u32x4* nx = CH0 + (size_t)(ch + 1) * (CH_BYTES / 16); RW_LOAD(nx); }
        M[0] = Mn[0]; M[1] = Mn[1];
        {   bf16_t* yp = Y + (size_t)rw_row(b, dir, ch * 32 + r) * 2048 + h * 64 + 32 * vt + 4 * hh;
#pragma unroll
            for (int g = 0; g < 4; ++g) { u32x2 w2; w2.x = pk_bf16(Yc[4 * g], Yc[4 * g + 1]); w2.y = pk_bf16(Yc[4 * g + 2], Yc[4 * g + 3]); *(u32x2*)(yp + 8 * g) = w2; } }
    }
#undef RW_LOAD
}

__device__ __forceinline__ void p_rwkv_k1_and_conv(const Ctx& c) {
    if (c.wave < 4) { LAS unsigned char* wl = c.lds + c.wave * K1_WAVE_LDS; const int w = blockIdx.x * 4 + c.wave, nw = gridDim.x * 4;
        for (int task = w; task < 256 * (int)RW_NCH; task += nw) rwkv_k1_chunk(c, wl, task / (int)RW_NCH, task % (int)RW_NCH); }
    else p_convert_deferred(c, blockIdx.x * 4 + (c.wave - 4), gridDim.x * 4, 0, CONV_SPLIT);
}
__device__ __forceinline__ void p_rwkv_seq_and_conv(const Ctx& c) {
    constexpr int NTASK = 512;
    const int G = (int)gridDim.x, task = c.wave * G + (int)blockIdx.x;
    if (task < NTASK) { for (int t = task; t < NTASK; t += G * 8) rwkv_seq_wave(c, t & 255, t >> 8); return; }
    int widx = 0, nworkers = 0;
    for (int w = 0; w < 8; ++w) { const int nsc = NTASK - w * G; const int sb = nsc <= 0 ? 0 : (nsc > G ? G : nsc);
        if (w < c.wave) widx += G - sb; else if (w == c.wave) widx += (int)blockIdx.x - sb;
        nworkers += G - sb; }
    p_convert_deferred(c, widx, nworkers, CONV_SPLIT, 1 << 30);
}

constexpr int DA_KBYTES = 64 * 256, DA_VBYTES = 128 * 128, DA_BUF = DA_KBYTES + DA_VBYTES;
constexpr int DA_COMB = 2 * DA_BUF;
__device__ __forceinline__ void dattn_block_item(const Ctx& c, int item) {
    const bf16_t* PB = (const bf16_t*)(c.ar + AR_PB); const bf16_t* VT = (const bf16_t*)(c.ar + AR_VT); bf16_t* MIX = (bf16_t*)(c.ws + WS_XN);
    const int lane = c.lane, r = lane & 31, hh = lane >> 5, w = c.wave, mp = w >> 2, qg = w & 3;
    int b, h, qrow0, t0, nt;
    if (item < NB * 16 * 32) { b = item >> 9; h = (item >> 5) & 15; qrow0 = b * SEQ + (item & 31) * 128; t0 = 0; nt = NKEY / 64; }
    else { const int i2 = item - NB * 16 * 32; b = i2 >> 5; h = (i2 >> 1) & 15; qrow0 = TL + b * CTXL + (i2 & 1) * 128; t0 = SEQ / 64; nt = CTXL / 64; }
    const bf16_t* VTh = VT + ((size_t)b * 16 + h) * 128 * NKEY;
    int krow_l[2], kchunk_l[2], vrow_l[2], vchunk_l[2];
#pragma unroll
    for (int i = 0; i < 2; ++i) { const int pk = 2 * w + i; krow_l[i] = 4 * pk + (lane >> 4); kchunk_l[i] = (lane & 15) ^ (krow_l[i] & 15);
        vrow_l[i] = 8 * pk + (lane >> 3); vchunk_l[i] = (lane & 7) ^ ((vrow_l[i] >> 1) & 7); }
#define DA_LOAD(t, buf) do { const int kx0 = (t0 + (t)) * 64; const int krow0 = kx0 < SEQ ? b * SEQ + kx0 : TL + b * CTXL + (kx0 - SEQ); \
        _Pragma("unroll") for (int i = 0; i < 2; ++i) { \
            __builtin_amdgcn_global_load_lds((const unsigned*)(PB + (size_t)(krow0 + krow_l[i]) * COLS_B + 2048 + h * 128 + kchunk_l[i] * 8), (LAS unsigned*)(c.lds + (buf) * DA_BUF + (2 * w + i) * 1024), 16, 0, 0); \
            __builtin_amdgcn_global_load_lds((const unsigned*)(VTh + (size_t)vrow_l[i] * NKEY + kx0 + vchunk_l[i] * 8), (LAS unsigned*)(c.lds + (buf) * DA_BUF + DA_KBYTES + (2 * w + i) * 1024), 16, 0, 0); } } while (0)
    bf16x8 q[4];
    { const bf16_t* qp = PB + (size_t)(qrow0 + 32 * qg + r) * COLS_B + h * 128 + mp * 64 + hh * 8;
#pragma unroll
      for (int ks = 0; ks < 4; ++ks) q[ks] = ld_frag(qp + ks * 16); }
    f32x16 O[4];
#pragma unroll
    for (int d = 0; d < 4; ++d)
#pragma unroll
        for (int i = 0; i < 16; ++i) O[d][i] = 0.f;
    float m = 0.f, l = 0.f;
    DA_LOAD(0, 0);
    __syncthreads();
    for (int t = 0; t < nt; ++t) {
        const int cur = t & 1;
        if (t + 1 < nt) DA_LOAD(t + 1, cur ^ 1);
        const LAS unsigned short* Kl = (const LAS unsigned short*)(c.lds + cur * DA_BUF); const LAS unsigned short* Vl = (const LAS unsigned short*)(c.lds + cur * DA_BUF + DA_KBYTES);
        f32x16 st[2];
        const float negm = -m;
#pragma unroll
        for (int sub = 0; sub < 2; ++sub) {
#pragma unroll
            for (int i = 0; i < 16; ++i) st[sub][i] = negm;
#pragma unroll
            for (int ks = 0; ks < 4; ++ks) st[sub] = MFMA32(*(const LAS bf16x8*)((const LAS unsigned char*)Kl + (32 * sub + r) * 256 + (((mp * 8 + ks * 2 + hh) ^ (r & 15)) << 4)), q[ks], st[sub]); }
        float mx = fmaxf(st[0][0], st[1][0]);
#pragma unroll
        for (int i = 1; i < 16; ++i) mx = fmaxf(mx, fmaxf(st[0][i], st[1][i]));
        mx = fmaxf(mx, __shfl_xor(mx, 32));
        if (!__all(mx <= 8.0f && mx >= -24.0f)) {
            const float alpha = __builtin_amdgcn_exp2f(-mx);
            m += mx; l *= alpha;
#pragma unroll
            for (int sub = 0; sub < 2; ++sub)
#pragma unroll
                for (int i = 0; i < 16; ++i) st[sub][i] -= mx;
#pragma unroll
            for (int d = 0; d < 4; ++d)
#pragma unroll
                for (int i = 0; i < 16; ++i) O[d][i] *= alpha;
        }
        float ps = 0.f;
#pragma unroll
        for (int sub = 0; sub < 2; ++sub)
#pragma unroll
            for (int i = 0; i < 16; ++i) { st[sub][i] = __builtin_amdgcn_exp2f(st[sub][i]); ps += st[sub][i]; }
        l += ps;
        bf16x8 P[4];
#pragma unroll
        for (int sub = 0; sub < 2; ++sub) { P[2 * sub] = pack_p(st[sub], 0); P[2 * sub + 1] = pack_p(st[sub], 1); }
#pragma unroll
        for (int d = 0; d < 4; ++d)
#pragma unroll
            for (int kk = 0; kk < 4; ++kk) O[d] = MFMA32(*(const LAS bf16x8*)((const LAS unsigned char*)Vl + (32 * d + r) * 128 + (((2 * kk + hh) ^ ((r >> 1) & 7)) << 4)), P[kk], O[d]);
        __syncthreads();
    }
#undef DA_LOAD
    LAS float* CB = (LAS float*)(c.lds + DA_COMB) + qg * 4096;
    l += __shfl_xor(l, 32);
    if (mp == 1) { const float sc = ((const float*)(c.ws + WS_SCAL))[0] / l;
#pragma unroll
        for (int d = 0; d < 4; ++d)
#pragma unroll
            for (int i = 0; i < 16; ++i) CB[(32 * d + (i & 3) + 8 * (i >> 2) + 4 * hh) * 32 + r] = O[d][i] * sc; }
    __syncthreads();
    if (mp == 0) { const float i0 = 1.0f / l; float ss = 0.f;
#pragma unroll
        for (int d = 0; d < 4; ++d)
#pragma unroll
            for (int i = 0; i < 16; ++i) { const float y = O[d][i] * i0 - CB[(32 * d + (i & 3) + 8 * (i >> 2) + 4 * hh) * 32 + r]; O[d][i] = y; ss += y * y; }
        ss += __shfl_xor(ss, 32);
        const float rs = rsqrtf(ss * (1.0f / 128.0f) + 1e-5f) * 0.8f;
        const float* subln = c.in[I_SUBLN];
        bf16_t* orow = MIX + (size_t)(qrow0 + 32 * qg + r) * D + 2048 + h * 128;
#pragma unroll
        for (int d = 0; d < 4; ++d)
#pragma unroll
            for (int g = 0; g < 4; ++g) { const int dv = 32 * d + 8 * g + 4 * hh; const f32x4 sl = *(const f32x4*)(subln + dv);
                u32x2 wv; wv.x = pk_bf16(O[d][4 * g] * rs * sl[0], O[d][4 * g + 1] * rs * sl[1]); wv.y = pk_bf16(O[d][4 * g + 2] * rs * sl[2], O[d][4 * g + 3] * rs * sl[3]);
                *(u32x2*)(orow + dv) = wv; } }
    __syncthreads();
}
__device__ __forceinline__ void p_dattn_block(const Ctx& c, bool need_ctx) {
    const int nitems = NB * 16 * 32 + (need_ctx ? NB * 16 * 2 : 0);
    const bool remap = gridDim.x == 256;
    for (int item = blockIdx.x; item < nitems; item += gridDim.x) {
        int it = item;
        if (remap && item < NB * 16 * 32) { const int k = item >> 8, x = item & 7, sl = (item & 255) >> 3; it = (((k << 3) + x) << 5) | sl; }
        dattn_block_item(c, it);
    }
}

constexpr int P1_CQ = 0, P1_CK = 2048, P1_CV = 2304, P1_DQ = 2560, P1_DK = 3584, P1_DV = 4608, P1_DG = 6656;

constexpr int SW_KLD = 72, SW_VLD = 40;
constexpr int SW_KBYTES = 32 * SW_KLD * 2, SW_VBYTES = 64 * SW_VLD * 2, SW_BUF = SW_KBYTES + SW_VBYTES;
__device__ __forceinline__ void swa_block_item(const Ctx& c, int item) {
    const bf16_t* P1 = (const bf16_t*)(c.ar + AR_P1); const bf16_t* VTC = (const bf16_t*)(c.ar + AR_VTC); bf16_t* MIX = (bf16_t*)(c.ws + WS_XN);
    const int tid = c.tid, lane = c.lane, r = lane & 31, hh = lane >> 5;
    const int b = item >> 9, g = (item >> 7) & 3, q0 = (item & 127) * 32, hq = g * 8 + c.wave;
    const int qpos = q0 + r;
    bf16x8 q[4]; { const bf16_t* qp = P1 + (size_t)(b * SEQ + qpos) * NO + P1_CQ + hq * 64 + hh * 8;
#pragma unroll
        for (int ks = 0; ks < 4; ++ks) q[ks] = ld_frag(qp + ks * 16); }
    const bf16_t* VTh = VTC + ((size_t)b * 4 + g) * 64 * NKEY;
    f32x16 O[2];
#pragma unroll
    for (int d = 0; d < 2; ++d)
#pragma unroll
        for (int i = 0; i < 16; ++i) O[d][i] = 0.f;
    float m = 0.f, l = 0.f;
    const int wt0 = (q0 - 128 < 0 ? 0 : q0 - 128) / 32, wt1 = (q0 + 160 > SEQ ? SEQ : q0 + 160) / 32;
    const int nwt = wt1 - wt0, ntl = nwt + 8;
    u32x4 sreg;
    const bool kside = tid < 256; const int t2 = tid & 255;
#define SWB_LOAD(ti) do { const bool win_ = (ti) < nwt; const int kx_ = (win_ ? wt0 + (ti) : (SEQ / 32) + ((ti) - nwt)) * 32; \
        sreg = kside ? *(const u32x4*)(P1 + (size_t)((win_ ? b * SEQ + kx_ : TL + b * CTXL + (kx_ - SEQ)) + (t2 >> 3)) * NO + P1_CK + g * 64 + (t2 & 7) * 8) \
                     : *(const u32x4*)(VTh + (size_t)(t2 >> 2) * NKEY + kx_ + (t2 & 3) * 8); } while (0)
#define SWB_STORE(buf) do { LAS unsigned short* base_ = (LAS unsigned short*)(c.lds + (buf) * SW_BUF); \
        if (kside) *(LAS u32x4*)(base_ + (t2 >> 3) * SW_KLD + (t2 & 7) * 8) = sreg; else *(LAS u32x4*)(base_ + SW_KBYTES / 2 + (t2 >> 2) * SW_VLD + (t2 & 3) * 8) = sreg; } while (0)
    SWB_LOAD(0); SWB_STORE(0);
    __syncthreads();
    for (int ti = 0; ti < ntl; ++ti) {
        const bool win = ti < nwt; const int kx0 = (win ? wt0 + ti : (SEQ / 32) + (ti - nwt)) * 32;
        if (ti + 1 < ntl) SWB_LOAD(ti + 1);
        const LAS unsigned short* Kl = (const LAS unsigned short*)(c.lds + (ti & 1) * SW_BUF); const LAS unsigned short* Vl = Kl + SW_KBYTES / 2;
        f32x16 st;
        const float negm = -m;
#pragma unroll
        for (int i = 0; i < 16; ++i) st[i] = negm;
#pragma unroll
        for (int ks = 0; ks < 4; ++ks) st = MFMA32(*(const LAS bf16x8*)(Kl + r * SW_KLD + ks * 16 + hh * 8), q[ks], st);
        if (win && (kx0 == q0 - 128 || kx0 == q0 + 128)) {
#pragma unroll
            for (int i = 0; i < 16; ++i) { const int kpos = kx0 + (i & 3) + 8 * (i >> 2) + 4 * hh; const int dl = kpos - qpos; if (dl > 128 || dl < -128) st[i] = -1e30f; }
        }
        float mx = st[0];
#pragma unroll
        for (int i = 1; i < 16; ++i) mx = fmaxf(mx, st[i]);
        mx = fmaxf(mx, __shfl_xor(mx, 32));
        if (!__all(mx <= 8.0f && mx >= -24.0f)) {
            const float alpha = __builtin_amdgcn_exp2f(-mx);
            m += mx; l *= alpha;
#pragma unroll
            for (int i = 0; i < 16; ++i) st[i] -= mx;
#pragma unroll
            for (int d = 0; d < 2; ++d)
#pragma unroll
                for (int i = 0; i < 16; ++i) O[d][i] *= alpha;
        }
        float ps = 0.f;
#pragma unroll
        for (int i = 0; i < 16; ++i) { st[i] = __builtin_amdgcn_exp2f(st[i]); ps += st[i]; }
        l += ps;
        const bf16x8 p0 = pack_p(st, 0), p1 = pack_p(st, 1);
#pragma unroll
        for (int d = 0; d < 2; ++d) { O[d] = MFMA32(*(const LAS bf16x8*)(Vl + (32 * d + r) * SW_VLD + 8 * hh), p0, O[d]); O[d] = MFMA32(*(const LAS bf16x8*)(Vl + (32 * d + r) * SW_VLD + 16 + 8 * hh), p1, O[d]); }
        if (ti + 1 < ntl) SWB_STORE((ti + 1) & 1);
        __syncthreads();
    }
#undef SWB_LOAD
#undef SWB_STORE
    l += __shfl_xor(l, 32);
    l += __builtin_amdgcn_exp2f(c.in[I_SINK][hq] * LOG2E - m);
    const float il = 1.0f / l;
    bf16_t* orow = MIX + (size_t)(b * SEQ + qpos) * D + hq * 64;
#pragma unroll
    for (int d = 0; d < 2; ++d)
#pragma unroll
        for (int gq = 0; gq < 4; ++gq) { const int dv = 32 * d + 8 * gq + 4 * hh;
            u32x2 w; w.x = pk_bf16(O[d][4 * gq] * il, O[d][4 * gq + 1] * il); w.y = pk_bf16(O[d][4 * gq + 2] * il, O[d][4 * gq + 3] * il);
            *(u32x2*)(orow + dv) = w; }
}

DI float ret_lg(const Ctx& c, int dir, int h) { return log1pf(-exp2f(-c.in[I_RDEC][dir * 8 + h])); }
DI int ret_row0(int b, int cidx) { return cidx < 2 ? TL + b * CTXL + cidx * 128 : b * SEQ + (cidx - 2) * 128; }
constexpr int TK_LD = 136, TV_LD = 264;
constexpr int RT_LD = 136;
DI void stage_chunk_T(const Ctx& c, const bf16_t* src, int ld_src, int ncols, LAS unsigned short* T) {
    const int tid = c.tid, row = tid >> 2, part = tid & 3, cpt = ncols / 4;
    const bf16_t* p = src + (size_t)row * ld_src + part * cpt;
    for (int e = 0; e < cpt / 8; ++e) { const u32x4 w = *(const u32x4*)(p + e * 8);
#pragma unroll
        for (int j = 0; j < 4; ++j) { T[(part * cpt + e * 8 + 2 * j) * RT_LD + row] = (unsigned short)(w[j] & 0xffffu); T[(part * cpt + e * 8 + 2 * j + 1) * RT_LD + row] = (unsigned short)(w[j] >> 16); } }
}
__device__ __forceinline__ void p_ret_local(const Ctx& c) {
    const bf16_t* P1 = (const bf16_t*)(c.ar + AR_P1); h16* RU = (h16*)(c.ar + AR_RU);
    LAS unsigned short* TK = (LAS unsigned short*)c.lds; LAS unsigned short* TV = TK + 128 * RT_LD;
    const int lane = c.lane, r = lane & 31, hh = lane >> 5, w = c.wave;
    for (int item = blockIdx.x; item < NB * 8 * 34; item += gridDim.x) {
        const int cidx = item % 34, h = (item / 34) & 7, b = item / (34 * 8);
        const int row0 = ret_row0(b, cidx);
        stage_chunk_T(c, P1 + (size_t)row0 * NO + P1_DK + h * 128, NO, 128, TK);
        stage_chunk_T(c, P1 + (size_t)row0 * NO + P1_DV + h * 256, NO, 256, TV);
        __syncthreads();
        for (int dir = 0; dir < 2; ++dir) {
            const float lg = ret_lg(c, dir, h);
            f32x16 af[4];
#pragma unroll
            for (int dt = 0; dt < 4; ++dt)
#pragma unroll
                for (int i = 0; i < 16; ++i) af[dt][i] = 0.f;
#pragma unroll 1
            for (int ks = 0; ks < 8; ++ks) {
                const int i0 = ks * 16 + hh * 8;
                float vf[8]; unpack8(*(const LAS u32x4*)(TV + (32 * w + r) * RT_LD + i0), vf);
#pragma unroll
                for (int j = 0; j < 8; ++j) vf[j] *= __expf(lg * (float)(dir ? (i0 + j) : (127 - (i0 + j))));
                const bf16x8 fa = __builtin_bit_cast(bf16x8, pack8_bf16(vf));
#pragma unroll
                for (int dt = 0; dt < 4; ++dt) af[dt] = MFMA32(*(const LAS bf16x8*)(TK + (32 * dt + r) * RT_LD + i0), fa, af[dt]);
            }
            h16* U = RU + ((((size_t)b * 8 + h) * 2 + dir) * 34 + cidx) * 32768;
#pragma unroll
            for (int dt = 0; dt < 4; ++dt)
#pragma unroll
                for (int g = 0; g < 4; ++g) { f32x4 v4 = {af[dt][4 * g], af[dt][4 * g + 1], af[dt][4 * g + 2], af[dt][4 * g + 3]}; st4(U + (32 * w + r) * 128 + 32 * dt + 8 * g + 4 * hh, v4); }
        }
        __syncthreads();
    }
}
__device__ __forceinline__ void p_ret_prefix(const Ctx& c) {
    const h16* RU = (const h16*)(c.ar + AR_RU); bf16_t* RS = (bf16_t*)(c.ar + AR_RS);
    const size_t gtid = (size_t)blockIdx.x * NTHREADS + c.tid, gn = (size_t)gridDim.x * NTHREADS;
    for (size_t idx = gtid; idx < (size_t)NB * 8 * 2 * 8192; idx += gn) {
        const int el = (int)(idx & 8191) * 4, bhd = (int)(idx >> 13), dir = bhd & 1, h = (bhd >> 1) & 7;
        const float cd = __expf(ret_lg(c, dir, h) * 128.0f);
        const h16* U = RU + (size_t)bhd * 34 * 32768 + el; bf16_t* S = RS + (size_t)bhd * 32 * 32768 + el;
        u32x2 u[34];
#pragma unroll
        for (int ci = 0; ci < 34; ++ci) u[ci] = __builtin_nontemporal_load((const u32x2*)(U + (size_t)ci * 32768));
#define RP_U(ci) ((f32x4){h16lo(u[ci].x), h16hi(u[ci].x), h16lo(u[ci].y), h16hi(u[ci].y)})
        f32x4 s = {0.f, 0.f, 0.f, 0.f};
        if (dir == 0) {
#pragma unroll
            for (int ci = 0; ci < 34; ++ci) { if (ci >= 2) { u32x2 w = {pk_bf16(s[0], s[1]), pk_bf16(s[2], s[3])}; *(u32x2*)(S + (size_t)(ci - 2) * 32768) = w; } s = s * cd + RP_U(ci); } }
        else { s = s * cd + RP_U(1); s = s * cd + RP_U(0);
#pragma unroll
            for (int ci = 33; ci >= 2; --ci) { u32x2 w = {pk_bf16(s[0], s[1]), pk_bf16(s[2], s[3])}; *(u32x2*)(S + (size_t)(ci - 2) * 32768) = w; s = s * cd + RP_U(ci); } }
#undef RP_U
    }
}
__device__ __forceinline__ void p_ret_out(const Ctx& c) {
    const bf16_t* P1 = (const bf16_t*)(c.ar + AR_P1); const bf16_t* RS = (const bf16_t*)(c.ar + AR_RS); bf16_t* MIX = (bf16_t*)(c.ws + WS_XN);
    LAS unsigned short* TV = (LAS unsigned short*)c.lds;
    LAS float* XS = (LAS float*)(c.lds + 256 * RT_LD * 2);
    const int lane = c.lane, r = lane & 31, hh = lane >> 5, w = c.wave, qt = w & 3, eh = w >> 2;
    for (int item = blockIdx.x; item < NB * 8 * 32; item += gridDim.x) {
        const int lc = item & 31, h = (item >> 5) & 7, b = item >> 8;
        const int row0 = b * SEQ + lc * 128;
        stage_chunk_T(c, P1 + (size_t)row0 * NO + P1_DV + h * 256, NO, 256, TV);
        __syncthreads();
        const float lgf = ret_lg(c, 0, h), lgb = ret_lg(c, 1, h);
        const int qi = qt * 32 + r;
        const bf16_t* qp = P1 + (size_t)(row0 + qi) * NO + P1_DQ + h * 128 + hh * 8;
        f32x16 Y[4];
#pragma unroll
        for (int et = 0; et < 4; ++et)
#pragma unroll
            for (int i = 0; i < 16; ++i) Y[et][i] = 0.f;
        {
            const float qdf = __expf(lgf * (float)(qi + 1)), qdb = __expf(lgb * (float)(128 - qi));
            const bf16_t* Sf = RS + ((((size_t)b * 8 + h) * 2 + 0) * 32 + lc) * 32768; const bf16_t* Sb = RS + ((((size_t)b * 8 + h) * 2 + 1) * 32 + lc) * 32768;
#pragma unroll 1
            for (int ks = 0; ks < 8; ++ks) {
                float x[8], xf[8], xb[8]; unpack8(*(const u32x4*)(qp + ks * 16), x);
#pragma unroll
                for (int j = 0; j < 8; ++j) { xf[j] = x[j] * qdf; xb[j] = x[j] * qdb; }
                const bf16x8 qf = __builtin_bit_cast(bf16x8, pack8_bf16(xf)), qb = __builtin_bit_cast(bf16x8, pack8_bf16(xb));
#pragma unroll
                for (int et = 0; et < 4; ++et) { const int e = eh * 128 + et * 32 + r;
                    Y[et] = MFMA32(ld_frag(Sf + (size_t)e * 128 + ks * 16 + hh * 8), qf, Y[et]);
                    Y[et] = MFMA32(ld_frag(Sb + (size_t)e * 128 + ks * 16 + hh * 8), qb, Y[et]); }
            }
        }
#pragma unroll 1
        for (int kt = 0; kt < 4; ++kt) {
            f32x16 st;
#pragma unroll
            for (int i = 0; i < 16; ++i) st[i] = 0.f;
            const bf16_t* kp = P1 + (size_t)(row0 + kt * 32 + r) * NO + P1_DK + h * 128 + hh * 8;
#pragma unroll
            for (int ks = 0; ks < 8; ++ks) st = MFMA32(ld_frag(kp + ks * 16), ld_frag(qp + ks * 16), st);
#pragma unroll
            for (int i = 0; i < 16; ++i) { const int ki = kt * 32 + (i & 3) + 8 * (i >> 2) + 4 * hh; const int dl = qi - ki;
                const float f = dl > 0 ? __expf(lgf * (float)dl) : (dl < 0 ? __expf(lgb * (float)(-dl)) : 2.0f); st[i] *= f; }
            const bf16x8 p0 = pack_p(st, 0), p1 = pack_p(st, 1);
#pragma unroll
            for (int et = 0; et < 4; ++et) { const int e = eh * 128 + et * 32 + r;
#pragma unroll
                for (int s = 0; s < 2; ++s) { const u32x2 lo = *(const LAS u32x2*)(TV + e * RT_LD + kt * 32 + 16 * s + 4 * hh), hi = *(const LAS u32x2*)(TV + e * RT_LD + kt * 32 + 16 * s + 8 + 4 * hh);
                    u32x4 vw = {lo.x, lo.y, hi.x, hi.y};
                    Y[et] = MFMA32(__builtin_bit_cast(bf16x8, vw), s == 0 ? p0 : p1, Y[et]); } }
        }
        float ss = 0.f;
#pragma unroll
        for (int et = 0; et < 4; ++et)
#pragma unroll
            for (int i = 0; i < 16; ++i) ss += Y[et][i] * Y[et][i];
        ss += __shfl_xor(ss, 32);
        if (hh == 0) XS[(eh * 4 + qt) * 32 + r] = ss;
        __syncthreads();
        const float tot = XS[(0 * 4 + qt) * 32 + r] + XS[(1 * 4 + qt) * 32 + r];
        const float rs = rsqrtf(tot * (1.0f / 256.0f) + 1e-6f);
        const bf16_t* gp = P1 + (size_t)(row0 + qi) * NO + P1_DG + h * 256; bf16_t* op = MIX + (size_t)(row0 + qi) * D + 2048 + h * 256;
#pragma unroll
        for (int et = 0; et < 4; ++et)
#pragma unroll
            for (int gq = 0; gq < 4; ++gq) { const int e = eh * 128 + et * 32 + 8 * gq + 4 * hh;
                const u32x2 gw = *(const u32x2*)(gp + e);
                const float g0 = bflo(gw.x), g1 = bfhi(gw.x), g2 = bflo(gw.y), g3 = bfhi(gw.y);
                u32x2 o; o.x = pk_bf16(Y[et][4 * gq] * rs * silu_f(g0), Y[et][4 * gq + 1] * rs * silu_f(g1)); o.y = pk_bf16(Y[et][4 * gq + 2] * rs * silu_f(g2), Y[et][4 * gq + 3] * rs * silu_f(g3));
                *(u32x2*)(op + e) = o; }
        __syncthreads();
    }
}

#define MK_PER_PHASE 0
#ifndef MK_PER_PHASE
#define MK_PER_PHASE 0
#endif
constexpr int N_PHASES = 25;
constexpr int LDS_STAGE = 4 * K1_WAVE_LDS;
constexpr int LDS_BYTES = LDS_STAGE + 256;

__global__ void __launch_bounds__(NTHREADS, 2) mk_fwd(Args a) {
    extern __shared__ __attribute__((aligned(16))) unsigned char smem[];
    Ctx c;
#pragma unroll
    for (int i = 0; i < 29; ++i) c.in[i] = a.in[i];
    c.out = a.out; c.ws = a.ws; c.ar = a.ws + WS_ARENA; c.lds = (LAS unsigned char*)smem;
    c.tid = threadIdx.x; c.lane = c.tid & 63; c.wave = __builtin_amdgcn_readfirstlane(c.tid >> 6);
    volatile LAS unsigned* xbw = (volatile LAS unsigned*)(c.lds + LDS_STAGE);
    if (c.tid < 4) xbw[c.tid] = 0u;
    __syncthreads();
    XcdBarrier bar; bar.bar = (unsigned*)(a.ws + WS_CTL); bar.x = 0; bar.st = xbw;
    if (!MK_PER_PHASE) bar = xcd_barrier_post((unsigned*)(a.ws + WS_CTL), xbw);
    const int lo = a.ph_lo, hi = a.ph_hi;
#ifndef PH_MASK
#define PH_MASK 0x1ffffffu
#endif
#define IN(k) (((PH_MASK >> (k)) & 1u) && lo <= (k) && (k) < hi)
#define SEAM(k) do { if (IN(k) && IN((k) + 1)) { xcd_barrier(bar); } } while (0)
    res_t* H = (res_t*)(c.ws + WS_H); const float* MOD = (const float*)(c.ws + WS_MOD);
    const bf16_t* XN = (const bf16_t*)(c.ws + WS_XN); unsigned char* W = c.ws + WS_W;
    LAS unsigned char* gl = c.lds; float* SLAB = (float*)(c.ar + AR_SLAB); unsigned char* W1 = c.ws + WS_W1;

    if (IN(0)) { p_mod(c); p_weights_layer0(c); p_wcolmax(c, CmxDeal{(int)blockIdx.x, (int)gridDim.x, 0, cmx_p0(gridDim.x)}); }
    SEAM(0);
    if (IN(1)) { p_mod_finalize(c); p_norm_mod<4>(c, c.in[I_X], c.in[I_CTX], TT, (const float*)(c.ar + AR_MODP), 0, 1); }
    SEAM(1);
    if (IN(2)) { const int ns = cmx_ns(gridDim.x), gg = (int)gridDim.x - ns;
        if ((int)blockIdx.x < gg) { pg8::Gemm g{XN, (const bf16_t*)(W + W_IN), TT, NE, D}; LatThenCtxOrder S; S.init2(NE, gg, blockIdx.x, D);
            EpiInEven E{(bf16_t*)(c.ar + AR_PA), (bf16_t*)(c.ar + AR_PB), (const float*)(c.ws + WS_AXC), (const float*)(c.ws + WS_AXS)};
            pg8::gemm_phase(gl, g, S, E); }
        else p_wcolmax(c, CmxDeal{(int)blockIdx.x - gg, ns, cmx_p0(gridDim.x), CMX_TOTAL}); }
    SEAM(2);
    if (IN(3)) { p_rwkv_prepA(c); p_build_vt<128, 16>(c, (const bf16_t*)(c.ar + AR_PB), COLS_B, 4096, (bf16_t*)(c.ar + AR_VT)); }
    SEAM(3);
    if (IN(4)) { pg8::Gemm g{(const bf16_t*)(c.ar + AR_LA), (const bf16_t*)(W + W_LORA), TT, LORA_N, LORA_K}; LoraOrder S; S.init2(LORA_N, gridDim.x, blockIdx.x, LORA_KU);
        EpiLora E{c.in[I_W0], c.in[I_A0], c.in[I_KA], (const bf16_t*)(c.ar + AR_K), (const h16*)(c.ar + AR_KK), (h16*)(c.ar + AR_OMW), (h16*)(c.ar + AR_BB), (h16*)(c.ar + AR_KD), (bf16_t*)(c.ar + AR_G)};
        pg8::gemm_phase(gl, g, S, E); }
    SEAM(4);
    if (IN(5)) {
#ifndef NO_DATTN
        p_dattn_block(c, true); __syncthreads();
#endif
#ifndef NO_K1
        p_rwkv_k1_and_conv(c);
#endif
    }
    SEAM(5);
    if (IN(6)) p_rwkv_seq_and_conv(c);
    SEAM(6);
    if (IN(7)) p_rwkv_out(c, TT);
    SEAM(7);
    if (IN(8)) { constexpr int KE = MIX_I8 ? D / 2 : D; const float* SAq = (const float*)(c.ar + AR_XQS);
        pg8::Gemm g{MIX_I8 ? (const bf16_t*)(c.ar + AR_XQ) : XN, (const bf16_t*)(W + W_MIX), TT, D, KE}; pg8::StaticOrder S; S.init(TL, D, gridDim.x, blockIdx.x, KE);
        EpiResModT<MIX_I8 != 0, float> E{c.in[I_X], c.in[I_CTX], H, MOD + 2 * 4096, SAq, i8_cs(c, CM_MIX)};
        pg8::gemm_phase(gl, g, S, E);
        CtxSplitOrder S2; S2.init(D, gridDim.x, blockIdx.x, KE); EpiSlabT<MIX_I8 != 0> E2{SLAB, SAq, i8_cs(c, CM_MIX)};
        pg8::gemm_phase(gl, g, S2, E2); }
    SEAM(8);
    if (IN(9)) { p_ctx_fix(c, c.in[I_CTX], MOD + 4 * 24576 + 2 * 4096, SLAB, H); p_norm_mod<1, FFN_I8 != 0, res_t>(c, H, H + (size_t)TL * D, TT, MOD, 3, 4); }
    SEAM(9);
    if (IN(10)) { constexpr int KE = FFN_I8 ? D / 2 : D;
        pg8::Gemm g{XN, (const bf16_t*)(W + W_FFI), TT, 2 * DFF, KE}; LatThenCtxOrder S; S.init2(2 * DFF, gridDim.x, blockIdx.x, KE);
        EpiConvGlu E{(bf16_t*)(c.ar + AR_HID), (bf16_t*)(c.ar + AR_SG), (bf16_t*)(c.ar + AR_SU), c.in[I_CONVW], c.in[I_CONVB], (const float*)(c.ws + WS_XN + (size_t)TT * D), i8_cs(c, CM_FFI)};
        pg8::gemm_phase(gl, g, S, E); }
    SEAM(10);
    if (IN(11)) { p_conv_fix(c, 0, TT); if (FFO0_I8 && IN(12)) { xcd_barrier(bar); p_quant_hid(c, TT); } }
    SEAM(11);
    if (IN(12)) { constexpr int KE = FFO0_I8 ? DFF / 2 : DFF; const float* SAq = (const float*)(c.ar + AR_HQS);
        pg8::Gemm g{(const bf16_t*)(c.ar + (FFO0_I8 ? AR_HQ : AR_HID)), (const bf16_t*)(W + W_FFO), TT, D, KE}; pg8::StaticOrder S; S.init(TL, D, gridDim.x, blockIdx.x, KE);
        EpiResModT<FFO0_I8 != 0> E{H, H + (size_t)TL * D, H, MOD + 5 * 4096, SAq, i8_cs(c, CM_FFO0)};
        pg8::gemm_phase(gl, g, S, E);
        CtxSplitOrder S2; S2.init(D, gridDim.x, blockIdx.x, KE); EpiSlabT<FFO0_I8 != 0> E2{SLAB, SAq, i8_cs(c, CM_FFO0)};
        pg8::gemm_phase(gl, g, S2, E2); }
    SEAM(12);
    const float* MOD1 = MOD + 5 * 24576;
    if (IN(13)) { p_ctx_fix(c, H + (size_t)TL * D, MOD + 4 * 24576 + 5 * 4096, SLAB, H); p_norm_mod<1, INO_I8 != 0, res_t>(c, H, H + (size_t)TL * D, TT, MOD1, 0, 1); }
    SEAM(13);
    if (IN(14)) { constexpr int KE = INO_I8 ? D / 2 : D;
        pg8::Gemm g{XN, (const bf16_t*)(W + W_IN), TT, NO, KE}; OddInOrder S; S.init2(gridDim.x, blockIdx.x, KE);
        EpiInOdd E{(bf16_t*)(c.ar + AR_P1), (const float*)(c.ws + WS_AXC), (const float*)(c.ws + WS_AXS), (const float*)(c.ws + WS_RTC), (const float*)(c.ws + WS_RTS), (const float*)(c.ws + WS_XN + (size_t)TT * D), i8_cs(c, CM_INO)};
        pg8::gemm_phase(gl, g, S, E); }
    SEAM(14);
    if (IN(15)) { p_build_vt<64, 4>(c, (const bf16_t*)(c.ar + AR_P1), NO, P1_CV, (bf16_t*)(c.ar + AR_VTC)); }
    SEAM(15);
    if (IN(16)) { p_ret_local(c); for (int item = blockIdx.x; item < NB * 4 * 128; item += gridDim.x) swa_block_item(c, item); }
    SEAM(16);
    if (IN(17)) p_ret_prefix(c);
    SEAM(17);
    if (IN(18)) p_ret_out(c);
    SEAM(18);
    if (MIX_I8 && IN(18) && IN(19)) { p_quant_mix(c, TL); xcd_barrier(bar); }
    if (IN(19)) { constexpr int KE = MIX_I8 ? D / 2 : D;
        pg8::Gemm g{MIX_I8 ? (const bf16_t*)(c.ar + AR_XQ) : XN, (const bf16_t*)(W1 + W1_MIX), TL, D, KE}; pg8::StaticOrder S; S.init(TL, D, gridDim.x, blockIdx.x, KE);
        EpiResModT<MIX_I8 != 0> E{H, H + (size_t)TL * D, H, MOD1 + 2 * 4096, (const float*)(c.ar + AR_XQS), i8_cs(c, CM_MIX + D)};
        pg8::gemm_phase(gl, g, S, E); }
    SEAM(19);
    if (IN(20)) p_norm_mod<1, FFN_I8 != 0, res_t>(c, H, H + (size_t)TL * D, TL, MOD1, 3, 4);
    SEAM(20);
    if (IN(21)) { constexpr int KE = FFN_I8 ? D / 2 : D;
        pg8::Gemm g{XN, (const bf16_t*)(W1 + W1_FFI), TL, 2 * DFF, KE}; pg8::StaticOrder S; S.init(TL, 2 * DFF, gridDim.x, blockIdx.x, KE);
        EpiConvGlu E{(bf16_t*)(c.ar + AR_HID), (bf16_t*)(c.ar + AR_SG), (bf16_t*)(c.ar + AR_SU), c.in[I_CONVW] + (size_t)3 * DFF, c.in[I_CONVB] + DFF, (const float*)(c.ws + WS_XN + (size_t)TT * D), i8_cs(c, CM_FFI + 2 * DFF)};
        pg8::gemm_phase(gl, g, S, E); }
    SEAM(21);
    if (IN(22)) { p_conv_fix(c, 1, TL); if (FFO1_I8 && IN(23)) { xcd_barrier(bar); p_quant_hid(c, TL); } }
    SEAM(22);
    if (IN(23)) { constexpr int KE = FFO1_I8 ? DFF / 2 : DFF;
        pg8::Gemm g{(const bf16_t*)(c.ar + (FFO1_I8 ? AR_HQ : AR_HID)), (const bf16_t*)(W1 + W1_FFO), TL, D, KE}; pg8::StaticOrder S; S.init(TL, D, gridDim.x, blockIdx.x, KE);
        EpiResModT<FFO1_I8 != 0> E{H, H + (size_t)TL * D, H, MOD1 + 5 * 4096, (const float*)(c.ar + AR_HQS), i8_cs(c, CM_FFO1)};
        pg8::gemm_phase(gl, g, S, E); }
    SEAM(23);
    if (IN(24)) p_final_norm(c);
#undef IN
#undef SEAM
}

extern "C" void kernel_launch(void* const* d_in, const int* in_sizes, int n_in, void* d_out, int out_size, void* d_ws, size_t ws_size, hipStream_t stream) {
    static int grid = 0;
    if (grid == 0) {
        if (n_in != 29 || ws_size < WS_END) { fprintf(stderr, "kernel_launch: need 29 inputs and >= %zu bytes of workspace; got n_in %d, ws %zu; nothing launched\n", (size_t)WS_END, n_in, ws_size); grid = -1; return; }
        int dev = 0, cus = 0, per_cu = 0;
        if (hipGetDevice(&dev) != hipSuccess || hipDeviceGetAttribute(&cus, hipDeviceAttributeMultiprocessorCount, dev) != hipSuccess) { grid = -1; return; }
        if (hipFuncSetAttribute((const void*)mk_fwd, hipFuncAttributeMaxDynamicSharedMemorySize, LDS_BYTES) != hipSuccess) { fprintf(stderr, "kernel_launch: hipFuncSetAttribute failed\n"); grid = -1; return; }
        if (hipOccupancyMaxActiveBlocksPerMultiprocessor(&per_cu, (const void*)mk_fwd, NTHREADS, LDS_BYTES) != hipSuccess || per_cu < 1) { fprintf(stderr, "kernel_launch: occupancy query says %d blocks per CU\n", per_cu); per_cu = 1; }
        (void)hipGetLastError();
        grid = cus;
    }
    if (grid < 0) return;
    (void)hipMemsetAsync((char*)d_ws + WS_CTL, 0, CTL_BYTES, stream);
    Args a{};
    for (int i = 0; i < 29; ++i) a.in[i] = (const float*)d_in[i];
    a.out = (float*)d_out; a.ws = (unsigned char*)d_ws;
#if MK_PER_PHASE
    for (int p = 0; p < N_PHASES; ++p) { a.ph_lo = p; a.ph_hi = p + 1; hipLaunchKernelGGL(mk_fwd, dim3(grid), dim3(NTHREADS), LDS_BYTES, stream, a); }
#else
    a.ph_lo = 0; a.ph_hi = N_PHASES;
    hipLaunchKernelGGL(mk_fwd, dim3(grid), dim3(NTHREADS), LDS_BYTES, stream, a);
#endif
    (void)in_sizes; (void)out_size;
}
```

```cpp
#include <hip/hip_runtime.h>
#include <cstdio>
#include <cstdint>

#define LAS __attribute__((address_space(3)))
#define DI __device__ __forceinline__
typedef unsigned short bf16_t;
typedef _Float16 h16;
typedef short bf16x8 __attribute__((ext_vector_type(8)));
typedef float f32x4 __attribute__((ext_vector_type(4)));
typedef int i32x4 __attribute__((ext_vector_type(4)));
typedef float f32x2 __attribute__((ext_vector_type(2)));
typedef float f32x16 __attribute__((ext_vector_type(16)));
typedef unsigned u32x4 __attribute__((ext_vector_type(4)));
typedef unsigned u32x2 __attribute__((ext_vector_type(2)));
typedef __bf16 bf16x2_n __attribute__((ext_vector_type(2)));
typedef _Float16 h16x2_n __attribute__((ext_vector_type(2)));

constexpr int D = 4096, NB = 4, SEQ = 4096, CTXL = 256;
constexpr int TL = NB * SEQ, TC = NB * CTXL, TT = TL + TC;
constexpr int DFF = 11008;
constexpr int HALF_W = 2048;
constexpr int COLS_A = 6784, COLS_A_PAD = 6912, COLS_B = 6144, NE = COLS_A_PAD + COLS_B;
constexpr int COLS_C = 2560, COLS_D = 6144, NO = COLS_C + COLS_D;
constexpr int NKEY = SEQ + CTXL;
constexpr int LORA_K = 1280, LORA_KU = 256, LORA_N = 5 * 2048;
constexpr int NTHREADS = 512;

constexpr size_t al256(size_t x) { return (x + 255) & ~(size_t)255; }
constexpr size_t WS_CTL = 0;
constexpr size_t CTL_CMAX = 65536;
constexpr int CM_FFI = 0, CM_INO = 2 * 2 * 11008, CM_INE = CM_INO + 8704, CM_MIX = CM_INE + 13056, CM_FFO1 = CM_MIX + 2 * 4096, CM_FFO0 = CM_FFO1 + 4096, CM_END = CM_FFO0 + 4096;
constexpr size_t CTL_BYTES = CTL_CMAX + (((size_t)CM_END * 4 + 255) & ~(size_t)255);
constexpr size_t WS_MOD = WS_CTL + CTL_BYTES;
constexpr size_t WS_SCAL = WS_MOD + al256((size_t)2 * 5 * 6 * D * 4);
constexpr size_t WS_CS = WS_SCAL + 256;
constexpr size_t WS_AXC = WS_CS + (((size_t)CM_END * 4 + 255) & ~(size_t)255);
constexpr size_t WS_AXS = WS_AXC + (size_t)SEQ * 32 * 4;
constexpr size_t WS_RTC = WS_AXS + (size_t)SEQ * 32 * 4;
constexpr size_t WS_RTS = WS_RTC + (size_t)NKEY * 64 * 4;
constexpr size_t WS_W = WS_RTS + (size_t)NKEY * 64 * 4;
constexpr size_t W_IN = 0;
constexpr size_t W_MIX = W_IN + (size_t)NE * D * 2;
constexpr size_t W_FFI = W_MIX + (size_t)D * D * 2;
constexpr size_t W_FFO = W_FFI + (size_t)2 * DFF * D * 2;
constexpr size_t W_LORA = W_FFO + (size_t)D * DFF * 2;
constexpr size_t W_BYTES = W_LORA + (size_t)LORA_N * LORA_K * 2;
constexpr size_t WS_H = WS_W + al256(W_BYTES);
constexpr size_t WS_XN = WS_H + (size_t)TT * D * 4;
constexpr size_t WS_W1 = WS_XN + (size_t)TT * D * 2;
constexpr size_t W1_MIX = 0, W1_FFI = W1_MIX + (size_t)D * D * 2, W1_FFO = W1_FFI + (size_t)2 * DFF * D * 2, W1_BYTES = W1_FFO + (size_t)D * DFF * 2;
constexpr size_t WS_ARENA = WS_W1 + al256(W1_BYTES);
constexpr size_t SZ16 = (size_t)TT * 2048 * 2;
constexpr size_t MOD_FLOATS = (size_t)2 * 5 * 6 * D;
constexpr size_t AR_XQ = 0, AR_XQS = (size_t)80 << 20;
constexpr size_t AR_MODP = 0;
constexpr size_t AR_PA = 0;
constexpr size_t AR_K = AR_PA + (size_t)TT * COLS_A_PAD * 2;
constexpr size_t AR_LA = AR_K + SZ16;
constexpr size_t RW_NCH = 136;
constexpr size_t CH_BYTES = 24576;
constexpr size_t AR_CH = 0;
constexpr size_t AR_CH_END = AR_CH + (size_t)256 * RW_NCH * CH_BYTES;
constexpr size_t AR_PB = AR_CH_END;
constexpr size_t AR_VT = AR_PB + (size_t)TT * COLS_B * 2;
constexpr size_t AR_R = AR_VT + (size_t)NB * 16 * 128 * NKEY * 2;
constexpr size_t AR_KK = AR_R + SZ16;
constexpr size_t AR_V = AR_KK + SZ16;
constexpr size_t AR_OMW = AR_V + SZ16;
constexpr size_t AR_BB = AR_OMW + 2 * SZ16;
constexpr size_t AR_KD = AR_BB + 2 * SZ16;
constexpr size_t AR_G = AR_KD + 2 * SZ16;
constexpr size_t AR_Y = AR_G + SZ16;
constexpr size_t AR_EVEN_END = AR_Y + 2 * SZ16;
static_assert(AR_LA + (size_t)TT * LORA_K * 2 <= AR_CH_END, "PA|K|LA must sit under the chunk matrices");
constexpr size_t AR_GU = 0;
constexpr size_t AR_SG = 0, AR_SU = AR_SG + (size_t)(TT / 64) * 4 * DFF * 2;
constexpr size_t AR_HQ = (size_t)64 << 20, AR_HQS = (size_t)320 << 20;
constexpr size_t AR_HID = AR_GU + (size_t)TT * 2 * DFF * 2;
constexpr size_t AR_FFN_END = AR_HID + (size_t)TT * DFF * 2;
constexpr size_t AR_P1 = 0;
constexpr size_t AR_VTC = AR_P1 + (size_t)TT * NO * 2;
constexpr size_t AR_RU = AR_VTC + (size_t)NB * 4 * 64 * NKEY * 2;
constexpr size_t AR_RS = AR_RU + (size_t)NB * 8 * 2 * 34 * 256 * 128 * 4;
constexpr size_t AR_ODD_END = AR_RS + (size_t)NB * 8 * 2 * 32 * 256 * 128 * 2;
constexpr size_t AR_SLAB = (size_t)1300 << 20;
constexpr size_t AR_SLAB_END = AR_SLAB + (size_t)4 * TC * D * 4;
static_assert(AR_SLAB >= AR_FFN_END, "slab overlaps the FFN buffers");
constexpr size_t cmax(size_t a, size_t b) { return a > b ? a : b; }
constexpr size_t AR_BYTES = cmax(cmax(AR_EVEN_END, AR_FFN_END), AR_ODD_END);
constexpr size_t WS_END = WS_ARENA + AR_BYTES;
static_assert(WS_END <= (size_t)3221225472ull, "workspace plan exceeds 4 x the largest input tensor");
static_assert(AR_SLAB_END <= AR_BYTES, "slab outside the arena");

DI float bf2f(bf16_t x) { return __uint_as_float((unsigned)x << 16); }
DI bf16_t f2bf(float x) { return __builtin_bit_cast(unsigned short, (__bf16)x); }
DI unsigned pk_bf16(float lo, float hi) { f32x2 v = {lo, hi}; return __builtin_bit_cast(unsigned, __builtin_convertvector(v, bf16x2_n)); }
DI unsigned pk_f16(float lo, float hi) { f32x2 v = {lo, hi}; return __builtin_bit_cast(unsigned, __builtin_convertvector(v, h16x2_n)); }
DI float bflo(unsigned w) { return __uint_as_float(w << 16); }
DI float bfhi(unsigned w) { return __uint_as_float(w & 0xffff0000u); }
DI float h16lo(unsigned w) { return (float)__builtin_bit_cast(h16x2_n, w)[0]; }
DI float h16hi(unsigned w) { return (float)__builtin_bit_cast(h16x2_n, w)[1]; }
DI float silu_f(float x) { return x * __builtin_amdgcn_rcpf(1.0f + __expf(-x)); }
DI float sigmoid_f(float x) { return __builtin_amdgcn_rcpf(1.0f + __expf(-x)); }
DI float wave_sum(float v) {
#pragma unroll
    for (int o = 32; o >= 1; o >>= 1) v += __shfl_xor(v, o);
    return v;
}
DI void load8f(const float* p, float (&o)[8]) { const f32x4 a = *(const f32x4*)p, b = *(const f32x4*)(p + 4);
#pragma unroll
    for (int j = 0; j < 4; ++j) { o[j] = a[j]; o[4 + j] = b[j]; } }
#ifndef RES_F16
#define RES_F16 1
#endif
#if RES_F16
typedef h16 res_t;
#else
typedef float res_t;
#endif
DI f32x4 ld4(const float* p) { return *(const f32x4*)p; }
DI void st4(float* p, const f32x4 v) { *(f32x4*)p = v; }
#if RES_F16
DI f32x4 ld4(const h16* p) { const u32x2 w = *(const u32x2*)p; f32x4 v = {h16lo(w.x), h16hi(w.x), h16lo(w.y), h16hi(w.y)}; return v; }
DI void st4(h16* p, const f32x4 v) { u32x2 w = {pk_f16(v[0], v[1]), pk_f16(v[2], v[3])}; *(u32x2*)p = w; }
#endif
DI int row_modidx(int row) { return row < TL ? (row >> 12) : 4; }

#define XB_TMO      128
#define XB_XCNT(j)  (256  + 64 * (j))
#define XB_XSUB(j)  (1280 + 64 * (j))
#define XB_XGEN(j)  (2304 + 64 * (j))
#define XB_TOP      3328
#define XB_TOPGEN   3392
#define XCD_BAR_WORDS 3456
#define XB_SPIN_CAP (1u << 22)

__device__ __forceinline__ unsigned xb_ld(unsigned* p)              { return __hip_atomic_load(p, __ATOMIC_RELAXED, __HIP_MEMORY_SCOPE_AGENT); }
__device__ __forceinline__ unsigned xb_add(unsigned* p, unsigned v) { return __hip_atomic_fetch_add(p, v, __ATOMIC_RELAXED, __HIP_MEMORY_SCOPE_AGENT); }
__device__ __forceinline__ unsigned xb_xcc_id() { return (unsigned)__builtin_amdgcn_s_getreg((3 << 11) | 20) & 0xFu; }
#define XB_SPIN(cond, bar) do { unsigned _sp = 0; while (cond) { __builtin_amdgcn_s_sleep(1); \
    if ((++_sp & 255u) == 0u) { if (xb_ld(&(bar)[XB_TMO])) break; if (_sp > XB_SPIN_CAP) { atomicAdd(&(bar)[XB_TMO], 1u); break; } } } } while (0)

struct XcdBarrier {
    unsigned* bar; unsigned x;
    volatile LAS unsigned* st;
};

__device__ __forceinline__ XcdBarrier xcd_barrier_post(unsigned* bar, volatile LAS unsigned* st) {
    XcdBarrier b; b.bar = bar; b.x = xb_xcc_id(); b.st = st;
    if (threadIdx.x == 0) (void)xb_add(&bar[XB_XCNT(b.x)], 1u);
    return b;
}
__device__ __forceinline__ void xcd_barrier_complete(unsigned* bar, unsigned x, unsigned& nloc, unsigned& nx) {
    const unsigned G = gridDim.x * gridDim.y * gridDim.z;
    unsigned sum, cnt, mine, sp = 0u;
    for (;;) {
        sum = 0u; cnt = 0u; mine = 0u;
#pragma unroll
        for (unsigned j = 0; j < 16; ++j) { const unsigned c = xb_ld(&bar[XB_XCNT(j)]); sum += c; cnt += (c > 0u) ? 1u : 0u; mine = (j == x) ? c : mine; }
        if (sum == G) break;
        __builtin_amdgcn_s_sleep(1);
        if ((++sp & 255u) == 0u) { if (xb_ld(&bar[XB_TMO])) break; if (sp > XB_SPIN_CAP) { atomicAdd(&bar[XB_TMO], 1u); break; } }
    }
    nloc = mine > 0u ? mine : 1u; nx = cnt > 0u ? cnt : 1u;
}

__device__ __forceinline__ void xcd_barrier(const XcdBarrier& b) {
    asm volatile("s_waitcnt vmcnt(0)" ::: "memory");
    __syncthreads();
    if (threadIdx.x == 0) {
        unsigned* bar = b.bar;
        __builtin_amdgcn_s_waitcnt(0);
        unsigned nloc = b.st[0], nx = b.st[1];
        if (nloc == 0u) { xcd_barrier_complete(bar, b.x, nloc, nx); b.st[0] = nloc; b.st[1] = nx; }
        const unsigned old = xb_add(&bar[XB_XSUB(b.x)], 1u);
        const unsigned gen = old / nloc;
        if (old + 1u == (gen + 1u) * nloc) {
            __builtin_amdgcn_fence(__ATOMIC_RELEASE, "agent");
            asm volatile("s_waitcnt vmcnt(0)" ::: "memory");
            const unsigned og = xb_add(&bar[XB_TOP], 1u);
            const unsigned tg = og / nx;
            if (og + 1u == (tg + 1u) * nx) xb_add(&bar[XB_TOPGEN], 1u);
            else XB_SPIN(xb_ld(&bar[XB_TOPGEN]) == tg, bar);
            __builtin_amdgcn_fence(__ATOMIC_ACQUIRE, "agent");
            xb_add(&bar[XB_XGEN(b.x)], 1u);
            asm volatile("s_waitcnt vmcnt(0)" ::: "memory");
        } else {
            XB_SPIN(xb_ld(&bar[XB_XGEN(b.x)]) == gen, bar);
            __builtin_amdgcn_fence(__ATOMIC_ACQUIRE, "agent");
            asm volatile("s_waitcnt vmcnt(0)" ::: "memory");
        }
    }
    __syncthreads();
}

namespace pg8 {
#define PG8_LAS __attribute__((address_space(3)))
constexpr int BM = 256, BK = 64, HALF = 128, HTB = HALF * BK * 2  , STAGE_BYTES = 8 * HTB, NXCD = 8, WGM = 4;

__host__ __device__ __forceinline__ int lds_byte(int r, int c) { const int st = (r >> 4) * 2 + (c >> 5), rr = r & 15, cc = c & 31, ob = rr * 64 + cc * 2; return st * 1024 + (ob ^ (((ob >> 9) & 1) << 5)); }
__host__ __device__ __forceinline__ void stage_rc(int b, int& R, int& C) { const int st = b / 1024, sb = b % 1024, swz = sb ^ (((sb >> 9) & 1) << 5); R = (st >> 1) * 16 + swz / 64; C = (st & 1) * 32 + (swz % 64) / 2; }
__host__ __device__ __forceinline__ int perm32(int rho) { const int n = rho >> 4, i = rho & 15; return 8 * (i >> 2) + 4 * n + (i & 3); }

struct Unit { int pm, pn, koff, nt, part; };
struct Gemm { const bf16_t* A; const bf16_t* Bt; int M, N, K; };

struct StaticOrder {
    int nM, nN, nwg, G, c, ntk;
    __host__ __device__ void init(int M, int N, int G_, int c_, int K_ = 0) { nM = M / BM; nN = N / BM; nwg = nM * nN; G = G_; c = c_; ntk = K_ / BK; }
    __host__ __device__ bool next(int i, Unit& u) const {
        const long L = (long)i * G + c; if (L >= nwg) return false;
        int wgid = (int)L; { const int q = nwg / NXCD, r = nwg % NXCD, xcd = wgid % NXCD, off = wgid / NXCD; wgid = (xcd < r ? xcd * (q + 1) : r * (q + 1) + (xcd - r) * q) + off; }
        const int nig = WGM * nN, gid = wgid / nig, fm = gid * WGM, gsz = (nM - fm) < WGM ? (nM - fm) : WGM;
        u.pm = fm + ((wgid % nig) % gsz); u.pn = (wgid % nig) / gsz; u.koff = 0; u.nt = ntk; u.part = -1; return true;
    }
    __device__ __forceinline__ void a_ready(const Unit&) const {}
    __device__ __forceinline__ void done(const Unit&) const {}
};


template <class Epi, class Sched>
__device__ __forceinline__ void gemm_phase(PG8_LAS unsigned char* lds, const Gemm g, const Sched& S, const Epi& E) {
    const int tid = threadIdx.x, wid = __builtin_amdgcn_readfirstlane(tid >> 6), lane = tid & 63, wr = wid >> 2, wc = wid & 3, fr = lane & 15, fq = lane >> 4;
    const int K = g.K;
    unsigned voffA[2], voffB[2];
#pragma unroll
    for (int i = 0; i < 2; ++i) { int R, C; stage_rc(tid * 16 + i * 8192, R, C); const int Rb = Epi::PERM ? ((R & ~31) + perm32(R & 31)) : R;
        voffA[i] = (unsigned)(R * K + C) * 2u; voffB[i] = (unsigned)(Rb * K + C) * 2u; }
    const size_t kstep = (size_t)(BK * 2);
    const size_t hstep = (size_t)HALF * K * 2;
    const size_t tstep = 2 * hstep;
    const unsigned ldsw = (unsigned)wid * 1024u;
    const int aoff = lds_byte(wr * 64 + fr, fq * 8), boff = lds_byte(wc * 32 + fr, fq * 8);
#define PG8_SA(b, h) (((b) * 2 + (h)) * HTB)
#define PG8_SB(b, h) ((4 + (b) * 2 + (h)) * HTB)
#define PG8_STAGE(bufoff, gbase, voff) do { _Pragma("unroll") for (int _i = 0; _i < 2; ++_i) \
        __builtin_amdgcn_global_load_lds((const unsigned*)((const char*)(gbase) + (voff)[_i]), (PG8_LAS unsigned*)(lds + (bufoff) + ldsw + _i * 8192), 16, 0, 0); } while (0)
#define PG8_LDA(dst, b, h) do { _Pragma("unroll") for (int m = 0; m < 4; ++m) _Pragma("unroll") for (int k = 0; k < 2; ++k) dst[m][k] = *(const PG8_LAS bf16x8*)(lds + PG8_SA(b, h) + aoff + m * 2048 + k * 1024); } while (0)
#define PG8_LDB(dst, b, h) do { _Pragma("unroll") for (int n = 0; n < 2; ++n) _Pragma("unroll") for (int k = 0; k < 2; ++k) dst[n][k] = *(const PG8_LAS bf16x8*)(lds + PG8_SB(b, h) + boff + n * 2048 + k * 1024); } while (0)
#define PG8_MMA(ai, bj, At, Bt) do { __builtin_amdgcn_s_setprio(1); _Pragma("unroll") for (int m = 0; m < 4; ++m) _Pragma("unroll") for (int n = 0; n < 2; ++n) _Pragma("unroll") for (int k = 0; k < 2; ++k) \
        { if constexpr (Epi::I8) acc[ai][bj][m][n] = __builtin_bit_cast(f32x4, __builtin_amdgcn_mfma_i32_16x16x64_i8(__builtin_bit_cast(i32x4, Bt[n][k]), __builtin_bit_cast(i32x4, At[m][k]), __builtin_bit_cast(i32x4, acc[ai][bj][m][n]), 0, 0, 0)); \
          else acc[ai][bj][m][n] = __builtin_amdgcn_mfma_f32_16x16x32_bf16(Bt[n][k], At[m][k], acc[ai][bj][m][n], 0, 0, 0); } __builtin_amdgcn_s_setprio(0); } while (0)
#define PG8_WAIT_V(n) asm volatile("s_waitcnt vmcnt(" #n ")" ::: "memory")
#define PG8_WAIT_L(n) asm volatile("s_waitcnt lgkmcnt(" #n ")" ::: "memory")
#define PG8_BAR __builtin_amdgcn_s_barrier()
#define PG8_SCHED __builtin_amdgcn_sched_barrier(0)
    Unit cur, nxt; int ui = 0;
    if (!S.next(0, cur)) return;
    f32x4 acc[2][2][4][2];
#pragma unroll
    for (int a = 0; a < 2; ++a)
#pragma unroll
        for (int b = 0; b < 2; ++b)
#pragma unroll
            for (int m = 0; m < 4; ++m)
#pragma unroll
                for (int n = 0; n < 2; ++n) acc[a][b][m][n] = (f32x4){0.f, 0.f, 0.f, 0.f};
    bf16x8 At[4][2], B0[2][2], B1[2][2];
    const char* cA = (const char*)g.A + (size_t)cur.pm * tstep + cur.koff; const char* cB = (const char*)g.Bt + (size_t)cur.pn * tstep + cur.koff;
    S.a_ready(cur);
    PG8_STAGE(PG8_SB(0, 0), cB, voffB); PG8_STAGE(PG8_SB(0, 1), cB + hstep, voffB); PG8_STAGE(PG8_SA(0, 0), cA, voffA); PG8_STAGE(PG8_SA(0, 1), cA + hstep, voffA);
    if (wr == 1) PG8_BAR;
    PG8_WAIT_V(2); PG8_BAR;
    PG8_STAGE(PG8_SB(1, 0), cB + kstep, voffB); PG8_STAGE(PG8_SA(1, 0), cA + kstep, voffA); PG8_STAGE(PG8_SB(1, 1), cB + hstep + kstep, voffB);
    PG8_WAIT_V(6); PG8_BAR;
    for (;;) {
        const bool has_next = S.next(ui + 1, nxt);
        const char* nA = has_next ? (const char*)g.A + (size_t)nxt.pm * tstep + nxt.koff : cA; const char* nB = has_next ? (const char*)g.Bt + (size_t)nxt.pn * tstep + nxt.koff : cB;
        const int nt = cur.nt;
        for (int t = 0; t < nt; t += 2) {
            const bool last = (t == nt - 2);
            const char* a1 = cA + (size_t)(t + 1) * kstep;
            const char* a2 = last ? nA : cA + (size_t)(t + 2) * kstep; const char* b2 = last ? nB : cB + (size_t)(t + 2) * kstep;
            const char* a3 = a2 + kstep; const char* b3 = b2 + kstep;
            if (last && has_next) S.a_ready(nxt);
            PG8_LDB(B0, 0, 0); PG8_LDB(B1, 0, 1); PG8_SCHED; PG8_LDA(At, 0, 0); PG8_STAGE(PG8_SA(1, 1), a1 + hstep, voffA);
            PG8_WAIT_V(8); PG8_WAIT_L(0); PG8_BAR; PG8_MMA(0, 0, At, B0); PG8_MMA(0, 1, At, B1); PG8_BAR; PG8_SCHED;
            PG8_LDA(At, 0, 1); PG8_STAGE(PG8_SB(0, 0), b2, voffB); PG8_STAGE(PG8_SB(0, 1), b2 + hstep, voffB); PG8_STAGE(PG8_SA(0, 0), a2, voffA);
            PG8_WAIT_V(8); PG8_WAIT_L(0); PG8_BAR; PG8_MMA(1, 0, At, B0); PG8_MMA(1, 1, At, B1); PG8_BAR; PG8_SCHED;
            PG8_LDB(B0, 1, 0); PG8_LDB(B1, 1, 1); PG8_SCHED; PG8_LDA(At, 1, 0); PG8_STAGE(PG8_SA(0, 1), a2 + hstep, voffA);
            PG8_WAIT_V(8); PG8_WAIT_L(0); PG8_BAR; PG8_MMA(0, 0, At, B0); PG8_MMA(0, 1, At, B1); PG8_BAR; PG8_SCHED;
            PG8_LDA(At, 1, 1); PG8_STAGE(PG8_SB(1, 0), b3, voffB); PG8_STAGE(PG8_SB(1, 1), b3 + hstep, voffB); PG8_STAGE(PG8_SA(1, 0), a3, voffA);
            PG8_WAIT_V(8); PG8_WAIT_L(0); PG8_BAR; PG8_MMA(1, 0, At, B0); PG8_MMA(1, 1, At, B1); PG8_BAR; PG8_SCHED;
        }
        if (wr == 0) PG8_BAR;
        if constexpr (Epi::I8) E.prescale(acc, cur, wr, wc, fr, fq);
        if constexpr (!Epi::AFTER_DRAIN) { E(acc, cur, wr, wc, fr, fq); S.done(cur); }
        if (!has_next) break;
#pragma unroll
        for (int a = 0; a < 2; ++a)
#pragma unroll
            for (int b = 0; b < 2; ++b)
#pragma unroll
                for (int m = 0; m < 4; ++m)
#pragma unroll
                    for (int n = 0; n < 2; ++n) acc[a][b][m][n] = (f32x4){0.f, 0.f, 0.f, 0.f};
        cur = nxt; cA = nA; cB = nB; ++ui;
        if (wr == 1) PG8_BAR;
    }
    PG8_WAIT_V(0);
    PG8_BAR;
    if constexpr (Epi::AFTER_DRAIN) { E.fused(acc, cur, wr, wc, fr, fq, lds, wid, lane); S.done(cur); }
#undef PG8_SA
#undef PG8_SB
#undef PG8_STAGE
#undef PG8_LDA
#undef PG8_LDB
#undef PG8_MMA
#undef PG8_WAIT_V
#undef PG8_WAIT_L
#undef PG8_BAR
#undef PG8_SCHED
}

}

#ifndef INO_I8
#define INO_I8 0
#endif
#ifndef FFO1_I8
#define FFO1_I8 1
#endif
#ifndef FFO0_I8
#define FFO0_I8 1
#endif
#ifndef MIX_I8
#define MIX_I8 0
#endif
#ifndef FFN_I8
#define FFN_I8 1
#endif
struct Args { const float* in[29]; float* out; unsigned char* ws; int ph_lo, ph_hi; };
struct Ctx {
    const float* in[29]; float* out; unsigned char* ws; unsigned char* ar;
    LAS unsigned char* lds;
    int tid, lane, wave;
};
enum { I_X = 0, I_C, I_CTX, I_CCTX, I_WMOD, I_BMOD, I_WINE, I_MU, I_W0, I_W2, I_A0, I_A2, I_G2, I_KK, I_KA, I_RK, I_LNW, I_LNB, I_LAM, I_SUBLN,
       I_WINO, I_SINK, I_RDEC, I_WMIX, I_WFFI, I_CONVW, I_CONVB, I_WFFO, I_FNORM };

__device__ __forceinline__ void p_mod(const Ctx& c) {
    LAS float* sc = (LAS float*)c.lds;
    LAS float* red = sc + 5 * 4096;
    const int tid = c.tid, lane = c.lane, w = c.wave;
    for (int i = tid; i < 5 * 4096; i += NTHREADS) { const int r = i >> 12, k = i & 4095; const float v = r < 4 ? c.in[I_C][r * 4096 + k] : c.in[I_CCTX][k]; sc[i] = silu_f(v); }
    __syncthreads();
    float* MODP = (float*)(c.ar + AR_MODP);
    for (int u = blockIdx.x; u < 768; u += gridDim.x) {
        const int kp = u & 3, cg = (u >> 2) % 96, l = u / 384;
        const int k0 = kp * 1024 + w * 128;
        const float* wp = c.in[I_WMOD] + ((size_t)l * 4096 + k0) * 24576 + cg * 256 + lane * 4;
        f32x4 acc[5];
#pragma unroll
        for (int r = 0; r < 5; ++r) acc[r] = (f32x4){0.f, 0.f, 0.f, 0.f};
#pragma unroll 2
        for (int k = 0; k < 128; k += 4) {
            f32x4 wv[4];
#pragma unroll
            for (int j = 0; j < 4; ++j) wv[j] = __builtin_nontemporal_load((const f32x4*)(wp + (size_t)(k + j) * 24576));
#pragma unroll
            for (int r = 0; r < 5; ++r) { const f32x4 s4 = *(const LAS f32x4*)(sc + r * 4096 + k0 + k);
#pragma unroll
                for (int j = 0; j < 4; ++j) acc[r] += wv[j] * s4[j]; }
        }
#pragma unroll
        for (int r = 0; r < 5; ++r) *(LAS f32x4*)(red + (w * 5 + r) * 256 + lane * 4) = acc[r];
        __syncthreads();
        for (int idx = tid; idx < 5 * 256; idx += NTHREADS) { const int r = idx >> 8, col = idx & 255; float s = 0.f;
#pragma unroll
            for (int q = 0; q < 8; ++q) s += red[(q * 5 + r) * 256 + col];
            if (kp == 0) s += c.in[I_BMOD][l * 24576 + cg * 256 + col];
            MODP[(size_t)kp * MOD_FLOATS + ((size_t)l * 5 + r) * 24576 + cg * 256 + col] = s; }
        __syncthreads();
    }
}

__device__ __forceinline__ void p_mod_finalize(const Ctx& c) {
    const float* MODP = (const float*)(c.ar + AR_MODP); float* MOD = (float*)(c.ws + WS_MOD);
    for (size_t i = ((size_t)blockIdx.x * NTHREADS + c.tid) * 4; i < MOD_FLOATS; i += (size_t)gridDim.x * NTHREADS * 4)
        *(f32x4*)(MOD + i) = (*(const f32x4*)(MODP + i) + *(const f32x4*)(MODP + MOD_FLOATS + i)) + (*(const f32x4*)(MODP + 2 * MOD_FLOATS + i) + *(const f32x4*)(MODP + 3 * MOD_FLOATS + i));
}
DI int perm64(int m) { const int within = m & 255, rho = within & 127; return (m & ~255) + (rho >> 5) * 64 + (within >> 7) * 32 + (rho & 31); }
DI int perm128(int m) { const int within = m & 255, rho = within & 127; return (m & ~255) + (rho >> 6) * 128 + (within >> 7) * 64 + (rho & 63); }
DI int in_odd_src(int n) { return n < 2304 ? perm64(n) : (n < 2560 ? n : (n < 4608 ? 2560 + perm128(n - 2560) : n)); }
__device__ __forceinline__ int p_convert_job(const Ctx& c, const float* __restrict__ src, int src_ld, int K, int n0, int ncnt, bf16_t* __restrict__ dst, int dn0, int base, int nperm = 0) {
    LAS unsigned short* T = (LAS unsigned short*)c.lds;
    const int tid = c.tid, tk = K / 64, tn = ncnt / 128, nt = tk * tn, G = (int)gridDim.x;
    int first = (int)blockIdx.x - (base % G); if (first < 0) first += G;
    const int kr = tid >> 3, c16 = (tid & 7) * 16, wn = tid >> 2, k16 = (tid & 3) * 16;
    f32x4 v[4], vn[4];
    if (first < nt) { const int nn = (first / tk) * 128 + c16; const float* p = src + (size_t)((first % tk) * 64 + kr) * src_ld + n0 + (nn < nperm ? perm64(nn) : nn);
#pragma unroll
        for (int i = 0; i < 4; ++i) v[i] = __builtin_nontemporal_load((const f32x4*)(p + 4 * i)); }
    for (int t = first; t < nt; t += G) {
        const int t2 = t + G;
        if (t2 < nt) { const int nn = (t2 / tk) * 128 + c16; const float* p = src + (size_t)((t2 % tk) * 64 + kr) * src_ld + n0 + (nn < nperm ? perm64(nn) : nn);
#pragma unroll
            for (int i = 0; i < 4; ++i) vn[i] = __builtin_nontemporal_load((const f32x4*)(p + 4 * i)); }
#pragma unroll
        for (int i = 0; i < 4; ++i)
#pragma unroll
            for (int j = 0; j < 4; ++j) T[(c16 + 4 * i + j) * 72 + kr] = f2bf(v[i][j]);
        __syncthreads();
        { const u32x4 a = *(const LAS u32x4*)(T + wn * 72 + k16), b = *(const LAS u32x4*)(T + wn * 72 + k16 + 8);
          bf16_t* q = dst + (size_t)(dn0 + (t / tk) * 128 + wn) * K + (t % tk) * 64 + k16;
          *(u32x4*)q = a; *(u32x4*)(q + 8) = b; }
        __syncthreads();
#pragma unroll
        for (int i = 0; i < 4; ++i) v[i] = vn[i];
    }
    return base + nt;
}
DI void conv_wave_tile(const float* __restrict__ src, int src_ld, int k0, int nsrc, int n0, bf16_t* __restrict__ dst, int K, int lane) {
    float v[32];
    const float* p = src + (size_t)k0 * src_ld + nsrc;
#pragma unroll
    for (int kk = 0; kk < 32; ++kk) v[kk] = __builtin_nontemporal_load(p + (size_t)kk * src_ld);
    bf16_t* q = dst + (size_t)(n0 + lane) * K + k0;
#pragma unroll
    for (int g = 0; g < 4; ++g) { u32x4 w; w.x = pk_bf16(v[8 * g], v[8 * g + 1]); w.y = pk_bf16(v[8 * g + 2], v[8 * g + 3]); w.z = pk_bf16(v[8 * g + 4], v[8 * g + 5]); w.w = pk_bf16(v[8 * g + 6], v[8 * g + 7]);
        *(u32x4*)(q + 8 * g) = w; }
}
DI unsigned pk_i8x4(float a, float b, float c2, float d) { const int ia = (int)rintf(a), ib = (int)rintf(b), ic = (int)rintf(c2), id = (int)rintf(d);
    return ((unsigned)ia & 255u) | (((unsigned)ib & 255u) << 8) | (((unsigned)ic & 255u) << 16) | ((unsigned)id << 24); }
template <class T> DI void fwht32(T (&v)[32]) {
#pragma unroll
    for (int h = 1; h < 32; h <<= 1)
#pragma unroll
        for (int i = 0; i < 32; i += 2 * h)
#pragma unroll
            for (int j = i; j < i + h; ++j) { const T a = v[j], b = v[j + h]; v[j] = a + b; v[j + h] = a - b; }
}
DI unsigned* i8_cmax(const Ctx& c, int off) { return (unsigned*)(c.ws + WS_CTL + CTL_CMAX) + off; }
DI float* i8_cs(const Ctx& c, int off) { return (float*)(c.ws + WS_CS) + off; }
DI void conv_wave_tile_q8(const float* __restrict__ src, int src_ld, int k0, int nsrc, int n0, unsigned char* __restrict__ dst, int K, int lane, const unsigned* cmax, float* cs) {
    float v[32];
    const float* p = src + (size_t)k0 * src_ld + nsrc;
#pragma unroll
    for (int kk = 0; kk < 32; ++kk) v[kk] = __builtin_nontemporal_load(p + (size_t)kk * src_ld);
    const float cm = __uint_as_float(cmax[nsrc]); const float qs = cm > 0.f ? 127.0f / cm : 0.f;
    if (k0 == 0) cs[n0 + lane] = cm * (1.0f / 127.0f);
    fwht32(v);
    unsigned char* q = dst + (size_t)(n0 + lane) * K + k0;
#pragma unroll
    for (int g = 0; g < 2; ++g) { u32x4 w;
#pragma unroll
        for (int j = 0; j < 4; ++j) w[j] = pk_i8x4(v[16 * g + 4 * j] * 0.03125f * qs, v[16 * g + 4 * j + 1] * 0.03125f * qs, v[16 * g + 4 * j + 2] * 0.03125f * qs, v[16 * g + 4 * j + 3] * 0.03125f * qs);
        *(u32x4*)(q + 16 * g) = w; }
}
struct CmxDeal { int worker, nworkers, lo, hi; };
__device__ __forceinline__ int p_wcolmax_job(const Ctx& c, const float* __restrict__ src0, int ld, int K, unsigned* cmax, int base, const CmxDeal dl) {
    LAS float* red = (LAS float*)c.lds;
    const int ncg = (ld + 255) / 256, nko = (K + 1023) / 1024, nitem = ncg * nko;
    int g0 = dl.lo + dl.worker; if (g0 < base) g0 += ((base - g0 + dl.nworkers - 1) / dl.nworkers) * dl.nworkers;
    const int gend = dl.hi < base + nitem ? dl.hi : base + nitem;
#pragma unroll 1
    for (int g = g0; g < gend; g += dl.nworkers) { const int it = g - base;
        const int cg = it % ncg, ko = it / ncg, col = cg * 256 + c.lane * 4;
        f32x4 mx = {0.f, 0.f, 0.f, 0.f};
        if (col < ld && ko * 1024 + c.wave * 128 < K) {
#pragma unroll 1
            for (int t = 0; t < 4; ++t) {
                f32x4 v[32]; const float* p = src0 + (size_t)(ko * 1024 + c.wave * 128 + t * 32) * ld + col;
#pragma unroll
                for (int kk = 0; kk < 32; ++kk) v[kk] = __builtin_nontemporal_load((const f32x4*)(p + (size_t)kk * ld));
                fwht32(v);
#pragma unroll
                for (int kk = 0; kk < 32; ++kk)
#pragma unroll
                    for (int j = 0; j < 4; ++j) mx[j] = fmaxf(mx[j], fabsf(v[kk][j]));
            }
        }
        *(LAS f32x4*)(red + c.wave * 256 + c.lane * 4) = mx;
        __syncthreads();
        if (c.tid < 256) { float m = red[c.tid];
#pragma unroll
            for (int w = 1; w < 8; ++w) m = fmaxf(m, red[w * 256 + c.tid]);
            const int cc = cg * 256 + c.tid; if (cc < ld) atomicMax(cmax + cc, __float_as_uint(m * 0.03125f)); }
        __syncthreads();
    }
    return base + nitem;
}
constexpr int CMX_TOTAL = (FFN_I8 ? 2 * (2 * DFF / 256) * (D / 1024) : 0) + (INO_I8 ? (NO / 256) * (D / 1024) : 0) + ((FFO0_I8 ? 1 : 0) + (FFO1_I8 ? 1 : 0)) * (D / 256) * ((DFF + 1023) / 1024) + (MIX_I8 ? 2 * (D / 256) * (D / 1024) : 0);
__device__ __forceinline__ void p_wcolmax(const Ctx& c, const CmxDeal dl) {
    int base = 0;
    __syncthreads();
    if (FFN_I8) { base = p_wcolmax_job(c, c.in[I_WFFI], 2 * DFF, D, i8_cmax(c, CM_FFI), base, dl); base = p_wcolmax_job(c, c.in[I_WFFI] + (size_t)D * 2 * DFF, 2 * DFF, D, i8_cmax(c, CM_FFI + 2 * DFF), base, dl); }
    if (INO_I8) base = p_wcolmax_job(c, c.in[I_WINO], NO, D, i8_cmax(c, CM_INO), base, dl);
    if (FFO0_I8) base = p_wcolmax_job(c, c.in[I_WFFO], D, DFF, i8_cmax(c, CM_FFO0), base, dl);
    if (FFO1_I8) base = p_wcolmax_job(c, c.in[I_WFFO] + (size_t)DFF * D, D, DFF, i8_cmax(c, CM_FFO1), base, dl);
    if (MIX_I8) { base = p_wcolmax_job(c, c.in[I_WMIX], D, D, i8_cmax(c, CM_MIX), base, dl); base = p_wcolmax_job(c, c.in[I_WMIX] + (size_t)D * D, D, D, i8_cmax(c, CM_MIX + D), base, dl); }
}
#ifndef CMX_P0
#define CMX_P0 624
#endif
DI int cmx_ns(int G) { return G == 256 ? 8 : 0; }
DI int cmx_p0(int G) { return cmx_ns(G) ? (CMX_P0 < CMX_TOTAL ? CMX_P0 : CMX_TOTAL) : CMX_TOTAL; }
__device__ __forceinline__ void p_weights_layer0(const Ctx& c) {
    bf16_t* W = (bf16_t*)(c.ws + WS_W);
    {   constexpr int T_IN = (4096 / 32) * ((COLS_A + COLS_B) / 64), T_MIX = (4096 / 32) * (4096 / 64), T_L96 = 3 * (2048 / 64), T_LG = 8 * (2048 / 64);
        constexpr int E0 = T_IN, E1 = E0, E2 = E1 + 4 * T_L96, E3 = E2 + T_LG;
        bf16_t* L = (bf16_t*)((unsigned char*)W + W_LORA);
        for (int t = blockIdx.x * 8 + c.wave; t < E3; t += gridDim.x * 8) {
            if (t < E0) { const int kt = t & 127, g = t >> 7, n = g * 64 + c.lane;
                const int nsrc = n < COLS_A ? n : COLS_A + (n - COLS_A < 4096 ? perm64(n - COLS_A) : n - COLS_A);
                conv_wave_tile(c.in[I_WINE], COLS_A + COLS_B, kt * 32, nsrc, n < COLS_A ? g * 64 : g * 64 + (COLS_A_PAD - COLS_A), (bf16_t*)((unsigned char*)W + W_IN), 4096, c.lane); }
            else if (t < E1) { const int tl = t - E0, kt = tl & 127, g = tl >> 7;
                conv_wave_tile(c.in[I_WMIX], 4096, kt * 32, g * 64 + c.lane, g * 64, (bf16_t*)((unsigned char*)W + W_MIX), 4096, c.lane); }
            else if (t < E2) { const int tl = t - E1, type = tl / T_L96, r2 = tl % T_L96, kt = r2 % 3, g = r2 / 3;
                const float* src = (type < 2 ? c.in[I_W2] + (size_t)type * 96 * 2048 : c.in[I_A2] + (size_t)(type - 2) * 96 * 2048);
                conv_wave_tile(src, 2048, kt * 32, g * 64 + c.lane, g * 64, L + (size_t)type * 2048 * LORA_K + type * LORA_KU, LORA_K, c.lane); }
            else { const int tl = t - E2, kt = tl & 7, g = tl >> 3;
                conv_wave_tile(c.in[I_G2], 2048, kt * 32, g * 64 + c.lane, g * 64, L + (size_t)4 * 2048 * LORA_K + 4 * LORA_KU, LORA_K, c.lane); }
        }
    }
    const size_t gtid = (size_t)blockIdx.x * NTHREADS + c.tid, gn = (size_t)gridDim.x * NTHREADS;
    { u32x4* z = (u32x4*)((unsigned char*)W + W_IN + (size_t)COLS_A * 4096 * 2); const size_t n16 = (size_t)(COLS_A_PAD - COLS_A) * 4096 * 2 / 16;
      for (size_t i = gtid; i < n16; i += gn) z[i] = (u32x4){0u, 0u, 0u, 0u}; }
    { bf16_t* L = (bf16_t*)((unsigned char*)W + W_LORA);
      for (size_t i = gtid; i < (size_t)4 * 2048 * 20; i += gn) { const int n = (int)(i / 20), ch = (int)(i % 20), type = n >> 11;
          *(u32x4*)(L + (size_t)n * LORA_K + type * LORA_KU + 96 + ch * 8) = (u32x4){0u, 0u, 0u, 0u}; } }
    { float* axc = (float*)(c.ws + WS_AXC); float* axs = (float*)(c.ws + WS_AXS);
      for (size_t i = gtid; i < (size_t)SEQ * 32; i += gn) { const int pos = (int)(i >> 5), a = (int)(i & 31), q = a & 15;
          const float inv = powf(10000.0f, -(float)q / 16.0f); const float p = (a < 16) ? (float)(pos >> 6) : (float)(pos & 63);
          float sn, cs; sincosf(p * inv, &sn, &cs); axc[i] = cs; axs[i] = sn; } }
    { float* rtc = (float*)(c.ws + WS_RTC); float* rts = (float*)(c.ws + WS_RTS);
      for (size_t i = gtid; i < (size_t)NKEY * 64; i += gn) { const int pos = (int)(i >> 6), a = (int)(i & 63);
          const float t = (float)a / 63.0f; const float inv = powf(10000.0f, -t);
          float sn, cs; sincosf((float)pos * inv, &sn, &cs); rtc[i] = cs; rts[i] = sn; } }
    if (gtid == 0) { const float* lv = c.in[I_LAM]; float s01 = 0.f, s23 = 0.f;
        for (int i = 0; i < 64; ++i) { s01 += lv[i] * lv[64 + i]; s23 += lv[128 + i] * lv[192 + i]; }
        ((float*)(c.ws + WS_SCAL))[0] = expf(s01) - expf(s23) + 0.2f; }
}
constexpr int CONV_SPLIT = 152000;
__device__ __forceinline__ void p_convert_deferred(const Ctx& c, int worker, int nworkers, int tlo, int thi) {
    unsigned char* W = c.ws + WS_W; unsigned char* W1 = c.ws + WS_W1;
    constexpr int T_FFI = (4096 / 32) * (2 * DFF / 64), T_FFO = (DFF / 32) * (4096 / 64), T_IN1 = (4096 / 32) * (NO / 64), T_MIX = (4096 / 32) * (4096 / 64);
    constexpr int EM = T_MIX, E0 = EM + T_FFI, E1 = E0 + T_FFO, E2 = E1 + T_IN1, E3 = E2 + T_MIX, E4 = E3 + T_FFI, E5 = E4 + T_FFO;
    const int tend = thi < E5 ? thi : E5;
    for (int t = tlo + worker; t < tend; t += nworkers) {
        const float* src; int ld, K, tl; bf16_t* dst; int mixl = -1;
        if (t < EM) { src = c.in[I_WMIX]; ld = 4096; K = 4096; tl = t; dst = (bf16_t*)(W + W_MIX); mixl = 0; }
        else if (t < E0) { src = c.in[I_WFFI]; ld = 2 * DFF; K = 4096; tl = t - EM; dst = (bf16_t*)(W + W_FFI); }
        else if (t < E1) { src = c.in[I_WFFO]; ld = 4096; K = DFF; tl = t - E0; dst = (bf16_t*)(W + W_FFO); mixl = 3; }
        else if (t < E2) { src = c.in[I_WINO]; ld = NO; K = 4096; tl = t - E1; dst = (bf16_t*)(W + W_IN); }
        else if (t < E3) { src = c.in[I_WMIX] + (size_t)4096 * 4096; ld = 4096; K = 4096; tl = t - E2; dst = (bf16_t*)(W1 + W1_MIX); mixl = 1; }
        else if (t < E4) { src = c.in[I_WFFI] + (size_t)4096 * 2 * DFF; ld = 2 * DFF; K = 4096; tl = t - E3; dst = (bf16_t*)(W1 + W1_FFI); }
        else { src = c.in[I_WFFO] + (size_t)DFF * 4096; ld = 4096; K = DFF; tl = t - E4; dst = (bf16_t*)(W1 + W1_FFO); mixl = 2; }
        const int tk = K / 32, kt = tl % tk, ntile = tl / tk;
        int ncol = ntile * 64;
        if (ld == 2 * DFF) { const int tile = ncol >> 8, within = ncol & 255; ncol = within < 128 ? 128 * tile + within : DFF + 128 * tile + (within - 128); }
        const int nsrc = (ld == NO) ? in_odd_src(ntile * 64 + c.lane) : ncol + c.lane;
        if (FFN_I8 && ld == 2 * DFF) { const int off = CM_FFI + (t < E0 ? 0 : 2 * DFF); conv_wave_tile_q8(src, ld, kt * 32, nsrc, ntile * 64, (unsigned char*)dst, K, c.lane, i8_cmax(c, off), i8_cs(c, off)); }
        else if (FFO0_I8 && mixl == 3) conv_wave_tile_q8(src, ld, kt * 32, nsrc, ntile * 64, (unsigned char*)dst, K, c.lane, i8_cmax(c, CM_FFO0), i8_cs(c, CM_FFO0));
        else if (FFO1_I8 && mixl == 2) conv_wave_tile_q8(src, ld, kt * 32, nsrc, ntile * 64, (unsigned char*)dst, K, c.lane, i8_cmax(c, CM_FFO1), i8_cs(c, CM_FFO1));
        else if (MIX_I8 && mixl >= 0 && mixl < 2) conv_wave_tile_q8(src, ld, kt * 32, nsrc, ntile * 64, (unsigned char*)dst, K, c.lane, i8_cmax(c, CM_MIX + mixl * D), i8_cs(c, CM_MIX + mixl * D));
        else if (INO_I8 && ld == NO) conv_wave_tile_q8(src, ld, kt * 32, nsrc, ntile * 64, (unsigned char*)dst, K, c.lane, i8_cmax(c, CM_INO), i8_cs(c, CM_INO));
        else conv_wave_tile(src, ld, kt * 32, nsrc, ntile * 64, dst, K, c.lane);
    }
}

template <class TS>
__device__ __forceinline__ void p_ctx_fix(const Ctx& c, const TS* srcc, const float* gate, const float* slab, res_t* H) {
    for (int row = blockIdx.x * 8 + c.wave; row < TT; row += gridDim.x * 8) {
        if (row < TL) continue;
        const size_t ro = (size_t)(row - TL) * D;
#pragma unroll 4
        for (int i = 0; i < 16; ++i) { const int col = i * 256 + c.lane * 4;
            const f32x4 s4 = (*(const f32x4*)(slab + ro + col) + *(const f32x4*)(slab + (size_t)TC * D + ro + col)) + (*(const f32x4*)(slab + (size_t)2 * TC * D + ro + col) + *(const f32x4*)(slab + (size_t)3 * TC * D + ro + col));
            st4(H + (size_t)row * D + col, ld4(srcc + ro + col) + *(const f32x4*)(gate + col) * s4); }
    }
}
template <int NPARTS = 1, bool Q8 = false, class TS = float>
__device__ __forceinline__ void p_norm_mod(const Ctx& c, const TS* hl, const TS* hc, int nrows, const float* mod, int shift_chunk, int scale_chunk) {
    bf16_t* XN = (bf16_t*)(c.ws + WS_XN);
    for (int row = blockIdx.x * 8 + c.wave; row < nrows; row += gridDim.x * 8) {
        const TS* src = row < TL ? hl + (size_t)row * D : hc + (size_t)(row - TL) * D;
        f32x4 v[16]; float ss = 0.f;
#pragma unroll
        for (int i = 0; i < 16; ++i) { v[i] = ld4(src + i * 256 + c.lane * 4); ss += v[i][0] * v[i][0] + v[i][1] * v[i][1] + v[i][2] * v[i][2] + v[i][3] * v[i][3]; }
        ss = wave_sum(ss);
        const float rs = rsqrtf(ss * (1.0f / 4096.0f) + 1e-6f);
        const float* mp = mod + (size_t)row_modidx(row) * 24576;
        bf16_t* dst = XN + (size_t)row * D;
        if constexpr (Q8) {
            float mx = 0.f;
#pragma unroll
            for (int i = 0; i < 16; ++i) { const int col = i * 256 + c.lane * 4;
                const f32x4 sh = *(const f32x4*)(mp + shift_chunk * 4096 + col), sc = *(const f32x4*)(mp + scale_chunk * 4096 + col);
#pragma unroll
                for (int j = 0; j < 4; ++j) v[i][j] = v[i][j] * rs * (1.f + sc[j]) + sh[j];
                { const float a0 = v[i][0] + v[i][1], a1 = v[i][0] - v[i][1], a2 = v[i][2] + v[i][3], a3 = v[i][2] - v[i][3];
                  v[i][0] = a0 + a2; v[i][1] = a1 + a3; v[i][2] = a0 - a2; v[i][3] = a1 - a3; }
#pragma unroll
                for (int j = 0; j < 4; ++j) { float x = v[i][j];
                    { const float t = __int_as_float(__builtin_amdgcn_update_dpp(0, __float_as_int(x), 0xB1, 0xF, 0xF, false)); x = (c.lane & 1) ? t - x : x + t; }
                    { const float t = __int_as_float(__builtin_amdgcn_update_dpp(0, __float_as_int(x), 0x4E, 0xF, 0xF, false)); x = (c.lane & 2) ? t - x : x + t; }
                    { const float t = __int_as_float(__builtin_amdgcn_ds_swizzle(__float_as_int(x), 0x101F)); x = (c.lane & 4) ? t - x : x + t; }
                    v[i][j] = x; mx = fmaxf(mx, fabsf(x)); } }
#pragma unroll
            for (int o = 32; o >= 1; o >>= 1) mx = fmaxf(mx, __shfl_xor(mx, o));
            const float qs = mx > 0.f ? 127.0f / mx : 0.f;
            unsigned char* d8 = (unsigned char*)XN + (size_t)row * D;
#pragma unroll
            for (int i = 0; i < 16; ++i) *(unsigned*)(d8 + i * 256 + c.lane * 4) = pk_i8x4(v[i][0] * qs, v[i][1] * qs, v[i][2] * qs, v[i][3] * qs);
            if (c.lane == 0) ((float*)(c.ws + WS_XN + (size_t)TT * D))[row] = mx * (1.0f / 127.0f);
            continue;
        }
#pragma unroll
        for (int i = 0; i < 16; ++i) { const int col = i * 256 + c.lane * 4;
            f32x4 sh = *(const f32x4*)(mp + shift_chunk * 4096 + col), sc = *(const f32x4*)(mp + scale_chunk * 4096 + col);
            if constexpr (NPARTS == 4) {
                sh = (sh + *(const f32x4*)(mp + MOD_FLOATS + shift_chunk * 4096 + col)) + (*(const f32x4*)(mp + 2 * MOD_FLOATS + shift_chunk * 4096 + col) + *(const f32x4*)(mp + 3 * MOD_FLOATS + shift_chunk * 4096 + col));
                sc = (sc + *(const f32x4*)(mp + MOD_FLOATS + scale_chunk * 4096 + col)) + (*(const f32x4*)(mp + 2 * MOD_FLOATS + scale_chunk * 4096 + col) + *(const f32x4*)(mp + 3 * MOD_FLOATS + scale_chunk * 4096 + col)); }
            u32x2 w; w.x = pk_bf16(v[i][0] * rs * (1.f + sc[0]) + sh[0], v[i][1] * rs * (1.f + sc[1]) + sh[1]);
            w.y = pk_bf16(v[i][2] * rs * (1.f + sc[2]) + sh[2], v[i][3] * rs * (1.f + sc[3]) + sh[3]);
            *(u32x2*)(dst + col) = w; }
    }
}
__device__ __forceinline__ void p_final_norm(const Ctx& c) {
    const res_t* H = (const res_t*)(c.ws + WS_H);
    for (int row = blockIdx.x * 8 + c.wave; row < TL; row += gridDim.x * 8) {
        const res_t* src = H + (size_t)row * D;
        f32x4 v[16]; float ss = 0.f;
#pragma unroll
        for (int i = 0; i < 16; ++i) { v[i] = ld4(src + i * 256 + c.lane * 4); ss += v[i][0] * v[i][0] + v[i][1] * v[i][1] + v[i][2] * v[i][2] + v[i][3] * v[i][3]; }
        ss = wave_sum(ss);
        const float rs = rsqrtf(ss * (1.0f / 4096.0f) + 1e-6f);
        float* dst = c.out + (size_t)row * D;
#pragma unroll
        for (int i = 0; i < 16; ++i) { const int col = i * 256 + c.lane * 4; const f32x4 g = *(const f32x4*)(c.in[I_FNORM] + col);
            *(f32x4*)(dst + col) = v[i] * rs * g; }
    }
}

DI void rope_store(const f32x4 (&acc)[2][2][4][2], int ai, int m, const float* tc, const float* ts, bool rot, float scale, bf16_t* o1p, bf16_t* o2p) {
    float o1[8], o2[8];
#pragma unroll
    for (int n = 0; n < 2; ++n) { f32x4 cs = {1.f, 1.f, 1.f, 1.f}, sn = {0.f, 0.f, 0.f, 0.f};
        if (rot) { cs = *(const f32x4*)(tc + 4 * n); sn = *(const f32x4*)(ts + 4 * n); }
#pragma unroll
        for (int e = 0; e < 4; ++e) { const float x1 = acc[ai][0][m][n][e], x2 = acc[ai][1][m][n][e];
            o1[4 * n + e] = (x1 * cs[e] - x2 * sn[e]) * scale; o2[4 * n + e] = (x2 * cs[e] + x1 * sn[e]) * scale; } }
    u32x4 w1, w2; w1.x = pk_bf16(o1[0], o1[1]); w1.y = pk_bf16(o1[2], o1[3]); w1.z = pk_bf16(o1[4], o1[5]); w1.w = pk_bf16(o1[6], o1[7]);
    w2.x = pk_bf16(o2[0], o2[1]); w2.y = pk_bf16(o2[2], o2[3]); w2.z = pk_bf16(o2[4], o2[5]); w2.w = pk_bf16(o2[6], o2[7]);
    *(u32x4*)o1p = w1; *(u32x4*)o2p = w2;
}
DI void plain_store(const f32x4 (&acc)[2][2][4][2], int ai, int m, bf16_t* rowp) {
#pragma unroll
    for (int bj = 0; bj < 2; ++bj) { const f32x4 v0 = acc[ai][bj][m][0], v1 = acc[ai][bj][m][1];
        u32x4 w; w.x = pk_bf16(v0[0], v0[1]); w.y = pk_bf16(v0[2], v0[3]); w.z = pk_bf16(v1[0], v1[1]); w.w = pk_bf16(v1[2], v1[3]);
        *(u32x4*)(rowp + bj * 128) = w; }
}
DI void i8_prescale(f32x4 (&acc)[2][2][4][2], const float* SA, const float* CS, const pg8::Unit& u, int wr, int wc, int fr, int fq) {
    f32x4 cs[2][2];
#pragma unroll
    for (int bj = 0; bj < 2; ++bj)
#pragma unroll
        for (int n = 0; n < 2; ++n) cs[bj][n] = *(const f32x4*)(CS + u.pn * 256 + bj * 128 + wc * 32 + 8 * fq + 4 * n);
#pragma unroll
    for (int ai = 0; ai < 2; ++ai)
#pragma unroll
        for (int m = 0; m < 4; ++m) { const float s = SA[u.pm * 256 + ai * 128 + wr * 64 + 16 * m + fr];
#pragma unroll
            for (int bj = 0; bj < 2; ++bj)
#pragma unroll
                for (int n = 0; n < 2; ++n)
#pragma unroll
                    for (int e = 0; e < 4; ++e) acc[ai][bj][m][n][e] = (float)__float_as_int(acc[ai][bj][m][n][e]) * (s * cs[bj][n][e]); }
}
DI void i8_prescale_np(f32x4 (&acc)[2][2][4][2], const float* SA, const float* CS, const pg8::Unit& u, int wr, int wc, int fr, int fq) {
    f32x4 cs[2][2];
#pragma unroll
    for (int bj = 0; bj < 2; ++bj)
#pragma unroll
        for (int n = 0; n < 2; ++n) cs[bj][n] = *(const f32x4*)(CS + u.pn * 256 + wc * 32 + 4 * fq + bj * 128 + n * 16);
#pragma unroll
    for (int ai = 0; ai < 2; ++ai)
#pragma unroll
        for (int m = 0; m < 4; ++m) { const float s = SA[u.pm * 256 + ai * 128 + wr * 64 + 16 * m + fr];
#pragma unroll
            for (int bj = 0; bj < 2; ++bj)
#pragma unroll
                for (int n = 0; n < 2; ++n)
#pragma unroll
                    for (int e = 0; e < 4; ++e) acc[ai][bj][m][n][e] = (float)__float_as_int(acc[ai][bj][m][n][e]) * (s * cs[bj][n][e]); }
}
struct EpiInEven {
    static constexpr bool PERM = true, AFTER_DRAIN = false, I8 = false;
    bf16_t* PA; bf16_t* PB; const float* axc; const float* axs;
    DI void operator()(const f32x4 (&acc)[2][2][4][2], const pg8::Unit& u, int wr, int wc, int fr, int fq) const {
        const int row0 = u.pm * 256 + wr * 64 + fr, tq = u.pn - COLS_A_PAD / 256;
#pragma unroll
        for (int ai = 0; ai < 2; ++ai)
#pragma unroll
            for (int m = 0; m < 4; ++m) { const int row = row0 + ai * 128 + m * 16;
                if (tq < 0) plain_store(acc, ai, m, PA + (size_t)row * COLS_A_PAD + u.pn * 256 + wc * 32 + 8 * fq);
                else if (tq >= 16) plain_store(acc, ai, m, PB + (size_t)row * COLS_B + tq * 256 + wc * 32 + 8 * fq);
                else { const int pos = row & 4095; bf16_t* o = PB + (size_t)row * COLS_B + tq * 256 + wc * 64 + 8 * fq;
                    rope_store(acc, ai, m, axc + pos * 32 + 8 * fq, axs + pos * 32 + 8 * fq, row < TL, tq < 8 ? 0.18033688011112042f : 1.0f, o, o + 32); } }
    }
};
struct EpiInOdd {
    static constexpr bool PERM = true, AFTER_DRAIN = false, I8 = (INO_I8 != 0);
    bf16_t* P1; const float* axc; const float* axs; const float* rtc; const float* rts; const float* SA; const float* CS;
    DI void prescale(f32x4 (&acc)[2][2][4][2], const pg8::Unit& u, int wr, int wc, int fr, int fq) const { i8_prescale(acc, SA, CS, u, wr, wc, fr, fq); }
    DI void operator()(const f32x4 (&acc)[2][2][4][2], const pg8::Unit& u, int wr, int wc, int fr, int fq) const {
        const int row0 = u.pm * 256 + wr * 64 + fr, pn = u.pn;
#pragma unroll
        for (int ai = 0; ai < 2; ++ai)
#pragma unroll
            for (int m = 0; m < 4; ++m) { const int row = row0 + ai * 128 + m * 16; const bool lat = row < TL; const int pos = lat ? (row & 4095) : ((row - TL) & 255);
                if (pn < 9) { bf16_t* o = P1 + (size_t)row * NO + pn * 256 + wc * 64 + 8 * fq;
                    rope_store(acc, ai, m, axc + pos * 32 + 8 * fq, axs + pos * 32 + 8 * fq, lat, pn < 8 ? 0.18033688011112042f : 1.0f, o, o + 32); }
                else if (pn >= 10 && pn < 18) { const int rp = lat ? CTXL + pos : pos, i0 = 32 * (wc & 1) + 8 * fq; bf16_t* o = P1 + (size_t)row * NO + pn * 256 + (wc >> 1) * 128 + i0;
                    rope_store(acc, ai, m, rtc + rp * 64 + i0, rts + rp * 64 + i0, true, pn < 14 ? 0.08838834764831845f : 1.0f, o, o + 64); }
                else plain_store(acc, ai, m, P1 + (size_t)row * NO + pn * 256 + wc * 32 + 8 * fq); }
    }
};
struct CtxSplitOrder {
    int G, c, nNn, ntk;
    __device__ void init(int N, int G_, int c_, int K_) { G = G_; c = c_; nNn = N / 256; ntk = K_ / 64; }
    __device__ bool next(int i, pg8::Unit& u) const {
        const long L = (long)i * G + c; if (L >= 4 * nNn * 4) return false;
        const int j = (int)L, part = j & 3, tile = j >> 2; u.pm = 64 + (tile & 3); u.pn = tile >> 2; u.part = part;
        const int s0 = 2 * ((part * ntk) / 8), s1 = 2 * (((part + 1) * ntk) / 8); u.koff = s0 * 128; u.nt = s1 - s0; return true; }
    __device__ __forceinline__ void a_ready(const pg8::Unit&) const {}
    __device__ __forceinline__ void done(const pg8::Unit&) const {}
};
template <bool Q8>
struct EpiSlabT {
    static constexpr bool PERM = false, AFTER_DRAIN = false, I8 = Q8;
    float* slab; const float* SA; const float* CS;
    DI void prescale(f32x4 (&acc)[2][2][4][2], const pg8::Unit& u, int wr, int wc, int fr, int fq) const { i8_prescale_np(acc, SA, CS, u, wr, wc, fr, fq); }
    DI void operator()(const f32x4 (&acc)[2][2][4][2], const pg8::Unit& u, int wr, int wc, int fr, int fq) const {
        const int row0 = u.pm * 256 + wr * 64 + fr, col0 = u.pn * 256 + wc * 32 + 4 * fq;
        float* sb = slab + ((size_t)u.part * TC + (row0 - TL)) * D + col0;
#pragma unroll
        for (int ai = 0; ai < 2; ++ai)
#pragma unroll
            for (int m = 0; m < 4; ++m)
#pragma unroll
                for (int bj = 0; bj < 2; ++bj)
#pragma unroll
                    for (int n = 0; n < 2; ++n) *(f32x4*)(sb + (size_t)(ai * 128 + m * 16) * D + bj * 128 + n * 16) = acc[ai][bj][m][n];
    }
};
struct LatThenCtxOrder : pg8::StaticOrder {
    int nNn;
    __device__ void init2(int N, int G_, int c_, int K_) { init(TL, N, G_, c_, K_); nNn = N / 256; }
    __device__ bool next(int i, pg8::Unit& u) const {
        const long L = (long)i * G + c; if (L < nwg) return pg8::StaticOrder::next(i, u);
        const int j = (int)(L - nwg); if (j >= 4 * nNn) return false;
        u.pm = 64 + (j & 3); u.pn = j >> 2; u.koff = 0; u.nt = ntk; u.part = -1; return true; }
};
struct LoraOrder : LatThenCtxOrder {
    __device__ bool next(int i, pg8::Unit& u) const { if (!LatThenCtxOrder::next(i, u)) return false; u.koff = (u.pn >> 3) * (LORA_KU * 2); u.nt = LORA_KU / 64; return true; }
};
struct OddInOrder : pg8::StaticOrder {
    __device__ void init2(int G_, int c_, int K_) { init(TL, NO, G_, c_, K_); }
    __device__ bool next(int i, pg8::Unit& u) const {
        const long L = (long)i * G + c; if (L < nwg) return pg8::StaticOrder::next(i, u);
        const int j = (int)(L - nwg); if (j >= 4 * 14) return false;
        const int idx = j >> 2; u.pm = 64 + (j & 3); u.pn = idx < 2 ? 8 + idx : 12 + idx; u.koff = 0; u.nt = ntk; u.part = -1; return true; }
};
template <bool Q8, class TS = res_t>
struct EpiResModT {
    static constexpr bool PERM = false, AFTER_DRAIN = false, I8 = Q8;
    const TS* Rlat; const TS* Rctx; res_t* Hout; const float* mod;
    const float* SA; const float* CS;
    DI void prescale(f32x4 (&acc)[2][2][4][2], const pg8::Unit& u, int wr, int wc, int fr, int fq) const { i8_prescale_np(acc, SA, CS, u, wr, wc, fr, fq); }
    DI void operator()(const f32x4 (&acc)[2][2][4][2], const pg8::Unit& u, int wr, int wc, int fr, int fq) const {
        const int row0 = u.pm * 256 + wr * 64 + fr, col0 = u.pn * 256 + wc * 32 + 4 * fq;
        const float* mp = mod + (size_t)(u.pm < 64 ? (u.pm >> 4) : 4) * 24576 + col0;
        f32x4 mv[2][2];
#pragma unroll
        for (int bj = 0; bj < 2; ++bj)
#pragma unroll
            for (int n = 0; n < 2; ++n) mv[bj][n] = *(const f32x4*)(mp + bj * 128 + n * 16);
        const TS* sbase = (u.pm < 64) ? Rlat + (size_t)row0 * D : Rctx + (size_t)(row0 - TL) * D;
        res_t* dbase = Hout + (size_t)row0 * D;
#pragma unroll
        for (int ai = 0; ai < 2; ++ai)
#pragma unroll
            for (int m = 0; m < 4; ++m) { const size_t ro = (size_t)(ai * 128 + m * 16) * D + col0;
#pragma unroll
                for (int bj = 0; bj < 2; ++bj)
#pragma unroll
                    for (int n = 0; n < 2; ++n) { const f32x4 r = ld4(sbase + ro + bj * 128 + n * 16);
                        st4(dbase + ro + bj * 128 + n * 16, r + mv[bj][n] * acc[ai][bj][m][n]); } }
    }
};

typedef EpiResModT<false, res_t> EpiResMod;
typedef EpiSlabT<false> EpiSlab;
struct EpiConvGlu {
    static constexpr bool PERM = true, AFTER_DRAIN = false, I8 = (FFN_I8 != 0);
    bf16_t* HID; bf16_t* SG; bf16_t* SU; const float* cw; const float* cb; const float* SA; const float* CS;
    DI void prescale(f32x4 (&acc)[2][2][4][2], const pg8::Unit& u, int wr, int wc, int fr, int fq) const { i8_prescale(acc, SA, CS, u, wr, wc, fr, fq); }
    DI void operator()(const f32x4 (&acc)[2][2][4][2], const pg8::Unit& u, int wr, int wc, int fr, int fq) const {
        const int col = u.pn * 128 + wc * 32 + 8 * fq;
#pragma unroll
        for (int ai = 0; ai < 2; ++ai) {
            const int rowb = u.pm * 256 + ai * 128 + wr * 64;
#pragma unroll
            for (int n = 0; n < 2; ++n) {
                const f32x4 w0 = *(const f32x4*)(cw + col + 4 * n), w1 = *(const f32x4*)(cw + DFF + col + 4 * n), w2 = *(const f32x4*)(cw + 2 * DFF + col + 4 * n), bb = *(const f32x4*)(cb + col + 4 * n);
                unsigned outp[4][2];
#pragma unroll
                for (int ep = 0; ep < 2; ++ep) { float o[4][2];
#pragma unroll
                    for (int e2 = 0; e2 < 2; ++e2) { const int e = 2 * ep + e2; float P[4], N[4];
#pragma unroll
                        for (int m = 0; m < 4; ++m) { const int vi = __float_as_int(acc[ai][0][m][n][e]);
                            P[m] = __int_as_float(__builtin_amdgcn_update_dpp(0, vi, 0x121, 0xF, 0xF, false)); N[m] = __int_as_float(__builtin_amdgcn_update_dpp(0, vi, 0x12F, 0xF, 0xF, false)); }
#pragma unroll
                        for (int m = 0; m < 4; ++m) { const float prev = fr > 0 ? P[m] : (m > 0 ? P[m - 1] : 0.f), next = fr < 15 ? N[m] : (m < 3 ? N[m + 1] : 0.f);
                            const float x = w0[e] * prev + w1[e] * acc[ai][0][m][n][e] + w2[e] * next + bb[e];
                            o[m][e2] = silu_f(x) * acc[ai][1][m][n][e]; } }
#pragma unroll
                    for (int m = 0; m < 4; ++m) outp[m][ep] = pk_bf16(o[m][0], o[m][1]); }
#pragma unroll
                for (int m = 0; m < 4; ++m) { const int rho = 16 * m + fr, row = rowb + rho;
                    if (rho != 0 && rho != 63) { u32x2 w = {outp[m][0], outp[m][1]}; *(u32x2*)(HID + (size_t)row * DFF + col + 4 * n) = w; }
                    if (m == 0 || m == 3) { if (rho <= 1 || rho >= 62) { const int slot = rho <= 1 ? rho : rho - 60;
                            u32x2 g; g.x = pk_bf16(acc[ai][0][m][n][0], acc[ai][0][m][n][1]); g.y = pk_bf16(acc[ai][0][m][n][2], acc[ai][0][m][n][3]);
                            *(u32x2*)(SG + ((size_t)(row >> 6) * 4 + slot) * DFF + col + 4 * n) = g;
                            if (rho == 0 || rho == 63) { u32x2 q; q.x = pk_bf16(acc[ai][1][m][n][0], acc[ai][1][m][n][1]); q.y = pk_bf16(acc[ai][1][m][n][2], acc[ai][1][m][n][3]);
                                *(u32x2*)(SU + ((size_t)(row >> 6) * 2 + (rho == 63 ? 1 : 0)) * DFF + col + 4 * n) = q; } } }
                }
            }
        }
    }
};
__device__ __forceinline__ void p_conv_fix(const Ctx& c, int l, int nrows) {
    const bf16_t* SG = (const bf16_t*)(c.ar + AR_SG); const bf16_t* SU = (const bf16_t*)(c.ar + AR_SU); bf16_t* HID = (bf16_t*)(c.ar + AR_HID);
    const float* cw = c.in[I_CONVW] + (size_t)l * 3 * DFF; const float* cb = c.in[I_CONVB] + (size_t)l * DFF;
    const int nitems = (nrows / 64) * 2 * 22;
    const u32x4 z4 = {0u, 0u, 0u, 0u};
    for (int item = blockIdx.x * 8 + c.wave; item < nitems; item += gridDim.x * 8) {
        const int ch = item % 22, kw = item / 22, kb = kw >> 1, last = kw & 1, col = ch * 512 + c.lane * 8;
        if (col >= DFF) continue;
        const int row = kb * 64 + (last ? 63 : 0);
        int pos, len; if (row < TL) { pos = row & 4095; len = 4096; } else { pos = (row - TL) & 255; len = 256; }
        u32x4 gp, gc, gn;
        if (!last) { gp = pos > 0 ? *(const u32x4*)(SG + ((size_t)(kb - 1) * 4 + 3) * DFF + col) : z4; gc = *(const u32x4*)(SG + ((size_t)kb * 4 + 0) * DFF + col); gn = *(const u32x4*)(SG + ((size_t)kb * 4 + 1) * DFF + col); }
        else { gp = *(const u32x4*)(SG + ((size_t)kb * 4 + 2) * DFF + col); gc = *(const u32x4*)(SG + ((size_t)kb * 4 + 3) * DFF + col); gn = pos < len - 1 ? *(const u32x4*)(SG + ((size_t)(kb + 1) * 4 + 0) * DFF + col) : z4; }
        const u32x4 up = *(const u32x4*)(SU + ((size_t)kb * 2 + last) * DFF + col);
        float w0[8], w1[8], w2[8], bb[8]; load8f(cw + col, w0); load8f(cw + DFF + col, w1); load8f(cw + 2 * DFF + col, w2); load8f(cb + col, bb);
        float o[8];
#pragma unroll
        for (int j = 0; j < 4; ++j) {
            const float x0 = bflo(gp[j]) * w0[2 * j] + bflo(gc[j]) * w1[2 * j] + bflo(gn[j]) * w2[2 * j] + bb[2 * j];
            const float x1 = bfhi(gp[j]) * w0[2 * j + 1] + bfhi(gc[j]) * w1[2 * j + 1] + bfhi(gn[j]) * w2[2 * j + 1] + bb[2 * j + 1];
            o[2 * j] = silu_f(x0) * bflo(up[j]); o[2 * j + 1] = silu_f(x1) * bfhi(up[j]); }
        u32x4 w; w.x = pk_bf16(o[0], o[1]); w.y = pk_bf16(o[2], o[3]); w.z = pk_bf16(o[4], o[5]); w.w = pk_bf16(o[6], o[7]);
        *(u32x4*)(HID + (size_t)row * DFF + col) = w;
    }
}

DI void unpack8(const u32x4 w, float (&o)[8]) {
#pragma unroll
    for (int j = 0; j < 4; ++j) { o[2 * j] = bflo(w[j]); o[2 * j + 1] = bfhi(w[j]); }
}
DI u32x4 pack8_bf16(const float (&o)[8]) { u32x4 w; w.x = pk_bf16(o[0], o[1]); w.y = pk_bf16(o[2], o[3]); w.z = pk_bf16(o[4], o[5]); w.w = pk_bf16(o[6], o[7]); return w; }
DI u32x4 pack8_f16(const float (&o)[8]) { u32x4 w; w.x = pk_f16(o[0], o[1]); w.y = pk_f16(o[2], o[3]); w.z = pk_f16(o[4], o[5]); w.w = pk_f16(o[6], o[7]); return w; }
DI void unpack8_f16(const u32x4 w, float (&o)[8]) {
#pragma unroll
    for (int j = 0; j < 4; ++j) { o[2 * j] = h16lo(w[j]); o[2 * j + 1] = h16hi(w[j]); }
}
DI void row_pos(int row, int& pos, int& len) { if (row < TL) { pos = row & 4095; len = 4096; } else { pos = (row - TL) & 255; len = 256; } }

__device__ __forceinline__ void p_rwkv_prepA(const Ctx& c) {
    const bf16_t* PA = (const bf16_t*)(c.ar + AR_PA);
    h16* R16 = (h16*)(c.ar + AR_R); h16* KK16 = (h16*)(c.ar + AR_KK); h16* V16 = (h16*)(c.ar + AR_V); bf16_t* K16 = (bf16_t*)(c.ar + AR_K); bf16_t* LA = (bf16_t*)(c.ar + AR_LA);
    const float* mu = c.in[I_MU]; const float* k_k = c.in[I_KK];
    const int lane = c.lane;
    for (int row = blockIdx.x * 8 + c.wave; row < TT; row += gridDim.x * 8) {
        int pos, len; row_pos(row, pos, len);
        const bool hasp = pos > 0, hasn = pos < len - 1;
        const bf16_t* pc = PA + (size_t)row * COLS_A_PAD;
        for (int it = 0; it < 14; ++it) {
            const int col = it * 512 + lane * 8;
            if (col >= COLS_A) break;
            float cur[8], prv[8], nxt[8], m8[8], mx[8];
            unpack8(*(const u32x4*)(pc + col), cur);
            if (hasp) unpack8(*(const u32x4*)(pc - COLS_A_PAD + col), prv); else {
#pragma unroll
                for (int j = 0; j < 8; ++j) prv[j] = 0.f; }
            if (hasn) unpack8(*(const u32x4*)(pc + COLS_A_PAD + col), nxt); else {
#pragma unroll
                for (int j = 0; j < 8; ++j) nxt[j] = 0.f; }
            load8f(mu + col, m8);
#pragma unroll
            for (int j = 0; j < 8; ++j) mx[j] = cur[j] + m8[j] * (0.5f * (prv[j] + nxt[j]) - cur[j]);
            if (it < 4) {
                *(u32x4*)(R16 + (size_t)row * 2048 + col) = pack8_f16(mx);
            } else if (it < 8) {
                const int j0 = col - 2048;
                *(u32x4*)(K16 + (size_t)row * 2048 + j0) = pack8_bf16(mx);
                float kk8[8], x[8]; load8f(k_k + j0, kk8); float ss = 0.f;
#pragma unroll
                for (int j = 0; j < 8; ++j) { x[j] = mx[j] * kk8[j]; ss += x[j] * x[j]; }
                ss += __shfl_xor(ss, 1); ss += __shfl_xor(ss, 2); ss += __shfl_xor(ss, 4);
                const float rn = rsqrtf(ss + 1e-12f);
#pragma unroll
                for (int j = 0; j < 8; ++j) x[j] *= rn;
                *(u32x4*)(KK16 + (size_t)row * 2048 + j0) = pack8_f16(x);
            } else if (it < 12) {
                *(u32x4*)(V16 + (size_t)row * 2048 + (col - 4096)) = pack8_f16(mx);
            } else {
                const int q0 = col - 6144; float o[8];
#pragma unroll
                for (int j = 0; j < 8; ++j) o[j] = q0 < 192 ? (1.0f - 2.0f * __builtin_amdgcn_rcpf(1.0f + __expf(2.0f * mx[j]))) : (q0 < 384 ? mx[j] : sigmoid_f(mx[j]));
                const int seg = q0 < 384 ? q0 / 96 : 4, off = q0 - (seg < 4 ? seg * 96 : 384);
                *(u32x4*)(LA + (size_t)row * LORA_K + seg * LORA_KU + off) = pack8_bf16(o);
            }
        }
        {
            const u32x4 z4 = {0u, 0u, 0u, 0u};
            for (int z = lane; z < 80; z += 64) *(u32x4*)(LA + (size_t)row * LORA_K + (z / 20) * LORA_KU + 96 + (z % 20) * 8) = z4; }
    }
}

DI int kperm16(int o) { return (o & ~12) | ((o >> 1) & 4) | ((o << 1) & 8); }
template <int DVW  , int NHEAD>
__device__ __forceinline__ void p_build_vt(const Ctx& c, const bf16_t* P, int ldp, int vcol0, bf16_t* VT) {
    constexpr int NSLAB = (DVW * NHEAD) / 512 > 0 ? (DVW * NHEAD) / 512 : 1;
    constexpr int SLABW = (DVW * NHEAD) < 512 ? (DVW * NHEAD) : 512;
    LAS unsigned short* T = (LAS unsigned short*)c.lds;
    const int tid = c.tid;
    for (int item = blockIdx.x; item < (TT / 64) * NSLAB; item += gridDim.x) {
        const int kg = item / NSLAB, slab = item % NSLAB;
        const int row0 = kg * 64;
        int b, key0; if (row0 < TL) { b = row0 >> 12; key0 = row0 & 4095; } else { b = (row0 - TL) >> 8; key0 = 4096 + ((row0 - TL) & 255); }
        { const int key = tid >> 3, part = tid & 7; const int kp = (key & ~15) | kperm16(key & 15);
          constexpr int CPT = SLABW / 8;
          const bf16_t* src = P + (size_t)(row0 + key) * ldp + vcol0 + slab * SLABW + part * CPT;
#pragma unroll
          for (int e = 0; e < CPT / 8; ++e) { const u32x4 w = *(const u32x4*)(src + e * 8);
#pragma unroll
              for (int j = 0; j < 4; ++j) { T[(part * CPT + e * 8 + 2 * j) * 72 + kp] = (unsigned short)(w[j] & 0xffffu); T[(part * CPT + e * 8 + 2 * j + 1) * 72 + kp] = (unsigned short)(w[j] >> 16); } }
        }
        __syncthreads();
        for (int q = tid; q < SLABW * 8; q += NTHREADS) { const int col = q >> 3, ch = q & 7;
            const u32x4 w = *(const LAS u32x4*)(T + col * 72 + ch * 8);
            const int gc = slab * SLABW + col, head = gc / DVW, dv = gc % DVW;
            *(u32x4*)(VT + (((size_t)b * NHEAD + head) * DVW + dv) * NKEY + key0 + ch * 8) = w; }
        __syncthreads();
    }
}

struct EpiLora {
    static constexpr bool PERM = true, AFTER_DRAIN = false, I8 = false;
    const float* w0; const float* a0; const float* k_a; const bf16_t* K16; const h16* KK16; h16* OMW; h16* BB; h16* KD; bf16_t* G;
    DI void operator()(const f32x4 (&acc)[2][2][4][2], const pg8::Unit& u, int wr, int wc, int fr, int fq) const {
        const int type = u.pn >> 3, row0 = u.pm * 256 + wr * 64 + fr;
#pragma unroll
        for (int bj = 0; bj < 2; ++bj) {
            const int jc = (u.pn & 7) * 256 + bj * 128 + wc * 32 + 8 * fq;
            if (type < 2) {
                float w8[8]; load8f(w0 + type * 2048 + jc, w8);
#pragma unroll
                for (int ai = 0; ai < 2; ++ai)
#pragma unroll
                    for (int m = 0; m < 4; ++m) { const int row = row0 + ai * 128 + m * 16; float o[8];
#pragma unroll
                        for (int i = 0; i < 8; ++i) { const float w = w8[i] + (i < 4 ? acc[ai][bj][m][0][i & 3] : acc[ai][bj][m][1][i & 3]);
                            o[i] = 1.0f - __expf(-0.60653066f * sigmoid_f(w)); }
                        *(u32x4*)(OMW + ((size_t)type * TT + row) * 2048 + jc) = pack8_f16(o); }
            } else if (type < 4) {
                const int d = type - 2; float a8[8], ka8[8]; load8f(a0 + d * 2048 + jc, a8); load8f(k_a + jc, ka8);
#pragma unroll
                for (int ai = 0; ai < 2; ++ai)
#pragma unroll
                    for (int m = 0; m < 4; ++m) { const int row = row0 + ai * 128 + m * 16; float kd[8], bb[8], k8[8], kk8[8];
                        unpack8(*(const u32x4*)(K16 + (size_t)row * 2048 + jc), k8); unpack8_f16(*(const u32x4*)(KK16 + (size_t)row * 2048 + jc), kk8);
#pragma unroll
                        for (int i = 0; i < 8; ++i) { const float a = sigmoid_f(a8[i] + (i < 4 ? acc[ai][bj][m][0][i & 3] : acc[ai][bj][m][1][i & 3]));
                            kd[i] = k8[i] * (1.0f + (a - 1.0f) * ka8[i]); bb[i] = kk8[i] * a; }
                        *(u32x4*)(KD + ((size_t)d * TT + row) * 2048 + jc) = pack8_f16(kd);
                        *(u32x4*)(BB + ((size_t)d * TT + row) * 2048 + jc) = pack8_f16(bb); }
            } else {
#pragma unroll
                for (int ai = 0; ai < 2; ++ai)
#pragma unroll
                    for (int m = 0; m < 4; ++m) { const int row = row0 + ai * 128 + m * 16; float o[8];
#pragma unroll
                        for (int i = 0; i < 8; ++i) o[i] = (i < 4 ? acc[ai][bj][m][0][i & 3] : acc[ai][bj][m][1][i & 3]);
                        *(u32x4*)(G + (size_t)row * 2048 + jc) = pack8_bf16(o); }
            }
        }
    }
};

#define MFMA32(a, b, cacc) __builtin_amdgcn_mfma_f32_32x32x16_bf16((a), (b), (cacc), 0, 0, 0)
DI bf16x8 ld_frag(const bf16_t* p) { return __builtin_bit_cast(bf16x8, *(const u32x4*)p); }
DI bf16x8 pack_p(const f32x16& x, int s) { u32x4 w; w.x = pk_bf16(x[8 * s], x[8 * s + 1]); w.y = pk_bf16(x[8 * s + 2], x[8 * s + 3]); w.z = pk_bf16(x[8 * s + 4], x[8 * s + 5]); w.w = pk_bf16(x[8 * s + 6], x[8 * s + 7]); return __builtin_bit_cast(bf16x8, w); }
constexpr float LOG2E = 1.44269504088896f;

DI void fwht8x4(float (&x)[8], int lane) {
#pragma unroll
    for (int h = 1; h < 8; h <<= 1)
#pragma unroll
        for (int i = 0; i < 8; i += 2 * h)
#pragma unroll
            for (int j = i; j < i + h; ++j) { const float a = x[j], b = x[j + h]; x[j] = a + b; x[j + h] = a - b; }
#pragma unroll
    for (int j = 0; j < 8; ++j) { float v = x[j];
        { const float t = __int_as_float(__builtin_amdgcn_update_dpp(0, __float_as_int(v), 0xB1, 0xF, 0xF, false)); v = (lane & 1) ? t - v : v + t; }
        { const float t = __int_as_float(__builtin_amdgcn_update_dpp(0, __float_as_int(v), 0x4E, 0xF, 0xF, false)); v = (lane & 2) ? t - v : v + t; }
        x[j] = v; }
}
DI float wave_max(float v) {
#pragma unroll
    for (int o = 32; o >= 1; o >>= 1) v = fmaxf(v, __shfl_xor(v, o));
    return v;
}
__device__ __forceinline__ void p_rwkv_out(const Ctx& c, int nrows) {
    const bf16_t* Yf = (const bf16_t*)(c.ar + AR_Y); const bf16_t* Yb = Yf + (size_t)TT * 2048;
    const h16* R16 = (const h16*)(c.ar + AR_R); const h16* V16 = (const h16*)(c.ar + AR_V);
    const h16* KDf = (const h16*)(c.ar + AR_KD); const h16* KDb = KDf + (size_t)TT * 2048;
    const bf16_t* G = (const bf16_t*)(c.ar + AR_G); bf16_t* MIX = (bf16_t*)(c.ws + WS_XN);
    const float* r_k = c.in[I_RK]; const float* ln_w = c.in[I_LNW]; const float* ln_b = c.in[I_LNB];
    const int lane = c.lane;
    for (int row = blockIdx.x * 8 + c.wave; row < nrows; row += gridDim.x * 8) {
        float ov[4][8];
#pragma unroll
        for (int it = 0; it < 4; ++it) {
            const int col = it * 512 + lane * 8; const size_t o = (size_t)row * 2048 + col;
            float yf[8], yb[8], y[8], r8[8], v8[8], kf[8], kb[8], g8[8], rk8[8], lw[8], lb[8];
            unpack8(*(const u32x4*)(Yf + o), yf); unpack8(*(const u32x4*)(Yb + o), yb);
            unpack8_f16(*(const u32x4*)(R16 + o), r8); unpack8_f16(*(const u32x4*)(V16 + o), v8);
            unpack8_f16(*(const u32x4*)(KDf + o), kf); unpack8_f16(*(const u32x4*)(KDb + o), kb);
            unpack8(*(const u32x4*)(G + o), g8);
            load8f(r_k + col, rk8); load8f(ln_w + col, lw); load8f(ln_b + col, lb);
            float sm = 0.f, bn = 0.f;
#pragma unroll
            for (int j = 0; j < 8; ++j) { y[j] = yf[j] + yb[j]; sm += y[j]; bn += r8[j] * (kf[j] + kb[j]) * rk8[j]; }
            sm += __shfl_xor(sm, 1); sm += __shfl_xor(sm, 2); sm += __shfl_xor(sm, 4);
            bn += __shfl_xor(bn, 1); bn += __shfl_xor(bn, 2); bn += __shfl_xor(bn, 4);
            const float mean = sm * (1.0f / 64.0f); float vs = 0.f;
#pragma unroll
            for (int j = 0; j < 8; ++j) { const float dlt = y[j] - mean; vs += dlt * dlt; }
            vs += __shfl_xor(vs, 1); vs += __shfl_xor(vs, 2); vs += __shfl_xor(vs, 4);
            const float rs = rsqrtf(vs * (1.0f / 64.0f) + 64e-5f);
            float o8[8];
#pragma unroll
            for (int j = 0; j < 8; ++j) o8[j] = ((y[j] - mean) * rs * lw[j] + lb[j] + bn * v8[j]) * g8[j];
            if (MIX_I8) {
#pragma unroll
                for (int j = 0; j < 8; ++j) ov[it][j] = o8[j]; }
            else *(u32x4*)(MIX + (size_t)row * D + col) = pack8_bf16(o8);
        }
        if (MIX_I8) {
            float av[4][8]; float mx = 0.f;
#pragma unroll
            for (int it = 0; it < 4; ++it) { unpack8(*(const u32x4*)(MIX + (size_t)row * D + 2048 + it * 512 + lane * 8), av[it]);
                fwht8x4(ov[it], lane); fwht8x4(av[it], lane);
#pragma unroll
                for (int j = 0; j < 8; ++j) mx = fmaxf(mx, fmaxf(fabsf(ov[it][j]), fabsf(av[it][j]))); }
            mx = wave_max(mx);
            const float qs = mx > 0.f ? 127.0f / mx : 0.f;
            unsigned char* xq = c.ar + AR_XQ + (size_t)row * D;
#pragma unroll
            for (int it = 0; it < 4; ++it) {
                u32x2 w0 = {pk_i8x4(ov[it][0] * qs, ov[it][1] * qs, ov[it][2] * qs, ov[it][3] * qs), pk_i8x4(ov[it][4] * qs, ov[it][5] * qs, ov[it][6] * qs, ov[it][7] * qs)};
                u32x2 w1 = {pk_i8x4(av[it][0] * qs, av[it][1] * qs, av[it][2] * qs, av[it][3] * qs), pk_i8x4(av[it][4] * qs, av[it][5] * qs, av[it][6] * qs, av[it][7] * qs)};
                *(u32x2*)(xq + it * 512 + lane * 8) = w0; *(u32x2*)(xq + 2048 + it * 512 + lane * 8) = w1; }
            if (lane == 0) ((float*)(c.ar + AR_XQS))[row] = mx * (1.0f / 127.0f);
        }
    }
}
__device__ __forceinline__ void p_quant_hid(const Ctx& c, int nrows) {
    const bf16_t* HID = (const bf16_t*)(c.ar + AR_HID); const int lane = c.lane;
    for (int row = blockIdx.x * 8 + c.wave; row < nrows; row += gridDim.x * 8) {
        u32x4 pk[22]; float mx = 0.f;
#pragma unroll
        for (int it = 0; it < 22; ++it) { const int col = it * 512 + lane * 8; pk[it] = col < DFF ? *(const u32x4*)(HID + (size_t)row * DFF + col) : (u32x4){0u, 0u, 0u, 0u}; }
#pragma unroll
        for (int it = 0; it < 22; ++it) { float x[8]; unpack8(pk[it], x); fwht8x4(x, lane);
#pragma unroll
            for (int j = 0; j < 8; ++j) mx = fmaxf(mx, fabsf(x[j])); }
        mx = wave_max(mx);
        const float qs = mx > 0.f ? 127.0f / mx : 0.f;
        unsigned char* hq = c.ar + AR_HQ + (size_t)row * DFF;
#pragma unroll
        for (int it = 0; it < 22; ++it) { float x[8]; unpack8(pk[it], x); fwht8x4(x, lane); const int col = it * 512 + lane * 8;
            u32x2 w = {pk_i8x4(x[0] * qs, x[1] * qs, x[2] * qs, x[3] * qs), pk_i8x4(x[4] * qs, x[5] * qs, x[6] * qs, x[7] * qs)};
            if (col < DFF) *(u32x2*)(hq + col) = w; }
        if (lane == 0) ((float*)(c.ar + AR_HQS))[row] = mx * (1.0f / 127.0f);
    }
}
__device__ __forceinline__ void p_quant_mix(const Ctx& c, int nrows) {
    const bf16_t* MIX = (const bf16_t*)(c.ws + WS_XN); const int lane = c.lane;
    for (int row = blockIdx.x * 8 + c.wave; row < nrows; row += gridDim.x * 8) {
        float x[8][8]; float mx = 0.f;
#pragma unroll
        for (int it = 0; it < 8; ++it) { unpack8(*(const u32x4*)(MIX + (size_t)row * D + it * 512 + lane * 8), x[it]); fwht8x4(x[it], lane);
#pragma unroll
            for (int j = 0; j < 8; ++j) mx = fmaxf(mx, fabsf(x[it][j])); }
        mx = wave_max(mx);
        const float qs = mx > 0.f ? 127.0f / mx : 0.f;
        unsigned char* xq = c.ar + AR_XQ + (size_t)row * D;
#pragma unroll
        for (int it = 0; it < 8; ++it) { u32x2 w = {pk_i8x4(x[it][0] * qs, x[it][1] * qs, x[it][2] * qs, x[it][3] * qs), pk_i8x4(x[it][4] * qs, x[it][5] * qs, x[it][6] * qs, x[it][7] * qs)};
            *(u32x2*)(xq + it * 512 + lane * 8) = w; }
        if (lane == 0) ((float*)(c.ar + AR_XQS))[row] = mx * (1.0f / 127.0f);
    }
}

constexpr int K1_WAVE_LDS = 35328;
constexpr size_t TT_ROWS2048 = (size_t)TT * 2048;
#define WAVE_SYNC() do { asm volatile("s_waitcnt lgkmcnt(0)" ::: "memory"); __builtin_amdgcn_wave_barrier(); } while (0)
DI int rw_row(int b, int dir, int t) { return t < CTXL ? TL + b * CTXL + (dir ? (CTXL - 1 - t) : t) : b * SEQ + (dir ? (SEQ - 1 - (t - CTXL)) : (t - CTXL)); }
DI float bfu(unsigned short x) { return __uint_as_float((unsigned)x << 16); }
DI bf16x8 colfrag_nat(const LAS unsigned short* T, int col, int t0) { u32x4 w;
#pragma unroll
    for (int j = 0; j < 4; ++j) w[j] = (unsigned)T[(t0 + 2 * j) * 64 + col] | ((unsigned)T[(t0 + 2 * j + 1) * 64 + col] << 16);
    return __builtin_bit_cast(bf16x8, w); }
DI bf16x8 colfrag_nat_scaled(const LAS unsigned short* T, int col, int t0, float sc) { u32x4 w;
#pragma unroll
    for (int j = 0; j < 4; ++j) w[j] = pk_bf16(bfu(T[(t0 + 2 * j) * 64 + col]) * sc, bfu(T[(t0 + 2 * j + 1) * 64 + col]) * sc);
    return __builtin_bit_cast(bf16x8, w); }
DI bf16x8 colfrag_pk_scaled(const LAS unsigned short* T, int col, int s, int hh, float sc) { u32x4 w;
#pragma unroll
    for (int j2 = 0; j2 < 4; ++j2) { const int j = 2 * j2, t = 16 * s + 8 * (j >> 2) + 4 * hh + (j & 3);
        w[j2] = pk_bf16(bfu(T[t * 64 + col]) * sc, bfu(T[(t + 1) * 64 + col]) * sc); }
    return __builtin_bit_cast(bf16x8, w); }
DI bf16x8 rowfrag_nat(const LAS unsigned short* A, int row, int s, int hh) { const LAS u32x2* p = (const LAS u32x2*)(A + row * 40 + 16 * s + 8 * hh); const u32x2 a = p[0], b = p[1];
    u32x4 w = {a.x, a.y, b.x, b.y}; return __builtin_bit_cast(bf16x8, w); }
DI bf16x8 rowfrag_pk(const LAS unsigned short* A, int row, int s, int hh) { const u32x2 a = *(const LAS u32x2*)(A + row * 40 + 16 * s + 4 * hh), b = *(const LAS u32x2*)(A + row * 40 + 16 * s + 8 + 4 * hh);
    u32x4 w = {a.x, a.y, b.x, b.y}; return __builtin_bit_cast(bf16x8, w); }
DI u32x4 pack_pu(const f32x16& x, int s) { u32x4 w; w.x = pk_bf16(x[8 * s], x[8 * s + 1]); w.y = pk_bf16(x[8 * s + 2], x[8 * s + 3]); w.z = pk_bf16(x[8 * s + 4], x[8 * s + 5]); w.w = pk_bf16(x[8 * s + 6], x[8 * s + 7]); return w; }

__device__ __forceinline__ void rwkv_k1_chunk(const Ctx& c, LAS unsigned char* wl, int seq, int ch) {
    const int dir = seq & 1, h = (seq >> 1) & 31, b = seq >> 6;
    const int lane = c.lane, r = lane & 31, hh = lane >> 5;
    LAS unsigned short* TA = (LAS unsigned short*)wl; LAS unsigned short* TB = TA + 2048; LAS unsigned short* TK = TB + 2048; LAS unsigned short* TR = TK + 2048; LAS unsigned short* TVv = TR + 2048;
    LAS float* GC = (LAS float*)(wl + 20480); LAS float* LAB = (LAS float*)(wl + 20736);
    LAS unsigned short* TTi = (LAS unsigned short*)(wl + 24832); LAS unsigned short* TAK = TTi + 1280; LAS unsigned short* TRB = TAK + 1280; LAS unsigned short* TRK = TRB + 1280;
    const h16* KK = (const h16*)(c.ar + AR_KK); const h16* RR = (const h16*)(c.ar + AR_R); const h16* VV = (const h16*)(c.ar + AR_V);
    const h16* OM = (const h16*)(c.ar + AR_OMW) + (size_t)dir * TT_ROWS2048; const h16* BBp = (const h16*)(c.ar + AR_BB) + (size_t)dir * TT_ROWS2048; const h16* KDp = (const h16*)(c.ar + AR_KD) + (size_t)dir * TT_ROWS2048;
    {   LAS unsigned short* TO = (LAS unsigned short*)LAB;
        u32x4 ld[6][4];
#pragma unroll
        for (int i = 0; i < 4; ++i) { const int tau = (lane >> 3) + 8 * i; const size_t off = (size_t)rw_row(b, dir, ch * 32 + tau) * 2048 + h * 64 + (lane & 7) * 8;
            ld[0][i] = *(const u32x4*)(KK + off); ld[1][i] = *(const u32x4*)(BBp + off); ld[2][i] = *(const u32x4*)(KDp + off);
            ld[3][i] = *(const u32x4*)(RR + off); ld[4][i] = *(const u32x4*)(VV + off); ld[5][i] = *(const u32x4*)(OM + off); }
#pragma unroll
        for (int i = 0; i < 4; ++i) { const int o = ((lane >> 3) + 8 * i) * 64 + (lane & 7) * 8;
            *(LAS u32x4*)(TA + o) = ld[0][i]; *(LAS u32x4*)(TB + o) = ld[1][i]; *(LAS u32x4*)(TK + o) = ld[2][i];
            *(LAS u32x4*)(TR + o) = ld[3][i]; *(LAS u32x4*)(TVv + o) = ld[4][i]; *(LAS u32x4*)(TO + o) = ld[5][i]; }
    }
    WAVE_SYNC();
    {   const LAS h16* TO = (const LAS h16*)LAB;
        float g = 1.f;
#pragma unroll 8
        for (int tau = 0; tau < 32; ++tau) { const int o = tau * 64 + lane;
            const float omw = (float)TO[o], bb = (float)((const LAS h16*)TB)[o], kd = (float)((const LAS h16*)TK)[o], kk = (float)((const LAS h16*)TA)[o], rr = (float)((const LAS h16*)TR)[o], vv = (float)((const LAS h16*)TVv)[o];
            const float gp = g; g *= (1.0f - omw); const float ig = __builtin_amdgcn_rcpf(g);
            TA[o] = f2bf(kk * gp); TB[o] = f2bf(-bb * ig); TK[o] = f2bf(kd * ig); TR[o] = f2bf(rr * g); TVv[o] = f2bf(vv);
        }
        GC[lane] = g;
    }
    WAVE_SYNC();
    {   f32x16 ab, ak, rb, rk;
#pragma unroll
        for (int i = 0; i < 16; ++i) { ab[i] = 0.f; ak[i] = 0.f; rb[i] = 0.f; rk[i] = 0.f; }
#pragma unroll
        for (int ks = 0; ks < 4; ++ks) { const int o = r * 64 + 16 * ks + 8 * hh;
            const bf16x8 fa = *(const LAS bf16x8*)(TA + o), fb = *(const LAS bf16x8*)(TB + o), fk = *(const LAS bf16x8*)(TK + o), fr = *(const LAS bf16x8*)(TR + o);
            ab = MFMA32(fa, fb, ab); ak = MFMA32(fa, fk, ak); rb = MFMA32(fr, fb, rb); rk = MFMA32(fr, fk, rk); }
#pragma unroll
        for (int i = 0; i < 16; ++i) { const int tau = (i & 3) + 8 * (i >> 2) + 4 * hh;
            LAB[tau * 32 + r] = (r < tau) ? ab[i] : 0.f;
            TAK[tau * 40 + r] = f2bf((r < tau) ? ak[i] : 0.f); TRB[tau * 40 + r] = f2bf((r <= tau) ? rb[i] : 0.f); TRK[tau * 40 + r] = f2bf((r <= tau) ? rk[i] : 0.f); }
    }
    WAVE_SYNC();
    {   float Tc[32];
#pragma unroll
        for (int tau = 0; tau < 32; ++tau) { float acc = (r == tau) ? 1.f : 0.f;
#pragma unroll
            for (int q = 0; q < (tau + 3) / 4; ++q) { const f32x4 a4 = *(const LAS f32x4*)(LAB + tau * 32 + 4 * q);
#pragma unroll
                for (int e = 0; e < 4; ++e) if (4 * q + e < tau) acc = fmaf(a4[e], Tc[4 * q + e], acc); }
            Tc[tau] = acc; }
        if (hh == 0) {
#pragma unroll
            for (int tau = 0; tau < 32; ++tau) TTi[tau * 40 + r] = f2bf(Tc[tau]); }
    }
    WAVE_SYNC();
    f32x16 W1[2], Z[2]; bf16x8 Vn[2][2];
    {   bf16x8 tn[2], tp[2], akn[2];
#pragma unroll
        for (int s = 0; s < 2; ++s) { tn[s] = rowfrag_nat(TTi, r, s, hh); tp[s] = rowfrag_pk(TTi, r, s, hh); akn[s] = rowfrag_nat(TAK, r, s, hh); }
#pragma unroll
        for (int t2 = 0; t2 < 2; ++t2) {
#pragma unroll
            for (int i = 0; i < 16; ++i) W1[t2][i] = 0.f;
            f32x16 X;
#pragma unroll
            for (int i = 0; i < 16; ++i) X[i] = 0.f;
#pragma unroll
            for (int s = 0; s < 2; ++s) { Vn[t2][s] = colfrag_nat(TVv, 32 * t2 + r, 16 * s + 8 * hh);
                W1[t2] = MFMA32(tn[s], colfrag_nat(TA, 32 * t2 + r, 16 * s + 8 * hh), W1[t2]);
                X = MFMA32(akn[s], Vn[t2][s], X); }
#pragma unroll
            for (int i = 0; i < 16; ++i) Z[t2][i] = 0.f;
#pragma unroll
            for (int s = 0; s < 2; ++s) Z[t2] = MFMA32(tp[s], pack_p(X, s), Z[t2]);
        }
    }
    u32x4* CHp = (u32x4*)(c.ar + AR_CH + ((size_t)seq * RW_NCH + ch) * CH_BYTES) + lane;
    {   bf16x8 rbp[2], rkn[2];
#pragma unroll
        for (int s = 0; s < 2; ++s) { rbp[s] = rowfrag_pk(TRB, r, s, hh); rkn[s] = rowfrag_nat(TRK, r, s, hh); }
#pragma unroll
        for (int kt = 0; kt < 2; ++kt) { f32x16 GT;
#pragma unroll
            for (int g4 = 0; g4 < 4; ++g4) { const u32x2 w = *(const LAS u32x2*)(TR + r * 64 + 32 * kt + 8 * g4 + 4 * hh);
                GT[4 * g4] = bflo(w.x); GT[4 * g4 + 1] = bfhi(w.x); GT[4 * g4 + 2] = bflo(w.y); GT[4 * g4 + 3] = bfhi(w.y); }
#pragma unroll
            for (int s = 0; s < 2; ++s) GT = MFMA32(pack_p(W1[kt], s), rbp[s], GT);
#pragma unroll
            for (int s = 0; s < 2; ++s) CHp[(0 + kt * 2 + s) * 64] = pack_pu(GT, s); }
#pragma unroll
        for (int vt = 0; vt < 2; ++vt) { f32x16 Y0;
#pragma unroll
            for (int i = 0; i < 16; ++i) Y0[i] = 0.f;
#pragma unroll
            for (int s = 0; s < 2; ++s) { Y0 = MFMA32(pack_p(Z[vt], s), rbp[s], Y0); Y0 = MFMA32(Vn[vt][s], rkn[s], Y0); }
#pragma unroll
            for (int s = 0; s < 2; ++s) CHp[(4 + vt * 2 + s) * 64] = pack_pu(Y0, s); }
    }
#pragma unroll
    for (int k2 = 0; k2 < 2; ++k2) {
        const float gc = GC[32 * k2 + r];
        bf16x8 bhp[2], khn[2];
#pragma unroll
        for (int s = 0; s < 2; ++s) { bhp[s] = colfrag_pk_scaled(TB, 32 * k2 + r, s, hh, gc); khn[s] = colfrag_nat_scaled(TK, 32 * k2 + r, 16 * s + 8 * hh, gc); }
#pragma unroll
        for (int kt = 0; kt < 2; ++kt) { f32x16 PT;
#pragma unroll
            for (int i = 0; i < 16; ++i) PT[i] = (kt == k2 && ((i & 3) + 8 * (i >> 2) + 4 * hh) == r) ? gc : 0.f;
#pragma unroll
            for (int s = 0; s < 2; ++s) PT = MFMA32(pack_p(W1[kt], s), bhp[s], PT);
#pragma unroll
            for (int s = 0; s < 2; ++s) CHp[(8 + k2 * 4 + kt * 2 + s) * 64] = pack_pu(PT, s); }
#pragma unroll
        for (int vt = 0; vt < 2; ++vt) { f32x16 PS;
#pragma unroll
            for (int i = 0; i < 16; ++i) PS[i] = 0.f;
#pragma unroll
            for (int s = 0; s < 2; ++s) { PS = MFMA32(bhp[s], pack_p(Z[vt], s), PS); PS = MFMA32(khn[s], Vn[vt][s], PS); }
#pragma unroll
            for (int s = 0; s < 2; ++s) CHp[(16 + k2 * 4 + vt * 2 + s) * 64] = pack_pu(PS, s); }
    }
    WAVE_SYNC();
}

DI void unpack_acc(const u32x4 lo, const u32x4 hi, f32x16& x) {
#pragma unroll
    for (int j = 0; j < 4; ++j) { x[2 * j] = bflo(lo[j]); x[2 * j + 1] = bfhi(lo[j]); x[8 + 2 * j] = bflo(hi[j]); x[8 + 2 * j + 1] = bfhi(hi[j]); }
}
__device__ __forceinline__ void rwkv_seq_wave(const Ctx& c, int seq, int vt) {
    const int dir = seq & 1, h = (seq >> 1) & 31, b = seq >> 6;
    const int lane = c.lane, r = lane & 31, hh = lane >> 5;
    bf16_t* Y = (bf16_t*)(c.ar + AR_Y) + (size_t)dir * TT_ROWS2048;
    f32x16 M[2];
#pragma unroll
    for (int kt = 0; kt < 2; ++kt)
#pragma unroll
        for (int i = 0; i < 16; ++i) M[kt][i] = 0.f;
    const u32x4* CH0 = (const u32x4*)(c.ar + AR_CH + (size_t)seq * RW_NCH * CH_BYTES) + lane;
    u32x4 gf[4], pf[8], y0[2], ps[4];
#define RW_LOAD(chp) do { _Pragma("unroll") for (int q = 0; q < 4; ++q) gf[q] = (chp)[q * 64]; _Pragma("unroll") for (int q = 0; q < 2; ++q) y0[q] = (chp)[(4 + vt * 2 + q) * 64]; \
        _Pragma("unroll") for (int q = 0; q < 8; ++q) pf[q] = (chp)[(8 + q) * 64]; _Pragma("unroll") for (int k2 = 0; k2 < 2; ++k2) _Pragma("unroll") for (int s = 0; s < 2; ++s) ps[k2 * 2 + s] = (chp)[(16 + k2 * 4 + vt * 2 + s) * 64]; } while (0)
    RW_LOAD(CH0);
    for (int ch = 0; ch < (int)RW_NCH; ++ch) {
        bf16x8 mp[4];
#pragma unroll
        for (int kt = 0; kt < 2; ++kt)
#pragma unroll
            for (int s = 0; s < 2; ++s) mp[kt * 2 + s] = pack_p(M[kt], s);
        f32x16 Yc, Mn[2];
        unpack_acc(y0[0], y0[1], Yc); unpack_acc(ps[0], ps[1], Mn[0]); unpack_acc(ps[2], ps[3], Mn[1]);
#pragma unroll
        for (int q = 0; q < 4; ++q) Yc = MFMA32(mp[q], __builtin_bit_cast(bf16x8, gf[q]), Yc);
#pragma unroll
        for (int k2 = 0; k2 < 2; ++k2)
#pragma unroll
            for (int q = 0; q < 4; ++q) Mn[k2] = MFMA32(__builtin_bit_cast(bf16x8, pf[k2 * 4 + q]), mp[q], Mn[k2]);
        if (ch + 1 < (int)RW_NCH) { const u32x4* nx = CH0 + (size_t)(ch + 1) * (CH_BYTES / 16); RW_LOAD(nx); }
        M[0] = Mn[0]; M[1] = Mn[1];
        {   bf16_t* yp = Y + (size_t)rw_row(b, dir, ch * 32 + r) * 2048 + h * 64 + 32 * vt + 4 * hh;
#pragma unroll
            for (int g = 0; g < 4; ++g) { u32x2 w2; w2.x = pk_bf16(Yc[4 * g], Yc[4 * g + 1]); w2.y = pk_bf16(Yc[4 * g + 2], Yc[4 * g + 3]); *(u32x2*)(yp + 8 * g) = w2; } }
    }
#undef RW_LOAD
}

__device__ __forceinline__ void p_rwkv_k1_and_conv(const Ctx& c) {
    if (c.wave < 4) { LAS unsigned char* wl = c.lds + c.wave * K1_WAVE_LDS; const int w = blockIdx.x * 4 + c.wave, nw = gridDim.x * 4;
        for (int task = w; task < 256 * (int)RW_NCH; task += nw) rwkv_k1_chunk(c, wl, task / (int)RW_NCH, task % (int)RW_NCH); }
    else p_convert_deferred(c, blockIdx.x * 4 + (c.wave - 4), gridDim.x * 4, 0, CONV_SPLIT);
}
__device__ __forceinline__ void p_rwkv_seq_and_conv(const Ctx& c) {
    constexpr int NTASK = 512;
    const int G = (int)gridDim.x, task = c.wave * G + (int)blockIdx.x;
    if (task < NTASK) { for (int t = task; t < NTASK; t += G * 8) rwkv_seq_wave(c, t & 255, t >> 8); return; }
    int widx = 0, nworkers = 0;
    for (int w = 0; w < 8; ++w) { const int nsc = NTASK - w * G; const int sb = nsc <= 0 ? 0 : (nsc > G ? G : nsc);
        if (w < c.wave) widx += G - sb; else if (w == c.wave) widx += (int)blockIdx.x - sb;
        nworkers += G - sb; }
    p_convert_deferred(c, widx, nworkers, CONV_SPLIT, 1 << 30);
}

constexpr int DA_KBYTES = 64 * 256, DA_VBYTES = 128 * 128, DA_BUF = DA_KBYTES + DA_VBYTES;
constexpr int DA_COMB = 2 * DA_BUF;
__device__ __forceinline__ void dattn_block_item(const Ctx& c, int item) {
    const bf16_t* PB = (const bf16_t*)(c.ar + AR_PB); const bf16_t* VT = (const bf16_t*)(c.ar + AR_VT); bf16_t* MIX = (bf16_t*)(c.ws + WS_XN);
    const int lane = c.lane, r = lane & 31, hh = lane >> 5, w = c.wave, mp = w >> 2, qg = w & 3;
    int b, h, qrow0, t0, nt;
    if (item < NB * 16 * 32) { b = item >> 9; h = (item >> 5) & 15; qrow0 = b * SEQ + (item & 31) * 128; t0 = 0; nt = NKEY / 64; }
    else { const int i2 = item - NB * 16 * 32; b = i2 >> 5; h = (i2 >> 1) & 15; qrow0 = TL + b * CTXL + (i2 & 1) * 128; t0 = SEQ / 64; nt = CTXL / 64; }
    const bf16_t* VTh = VT + ((size_t)b * 16 + h) * 128 * NKEY;
    int krow_l[2], kchunk_l[2], vrow_l[2], vchunk_l[2];
#pragma unroll
    for (int i = 0; i < 2; ++i) { const int pk = 2 * w + i; krow_l[i] = 4 * pk + (lane >> 4); kchunk_l[i] = (lane & 15) ^ (krow_l[i] & 15);
        vrow_l[i] = 8 * pk + (lane >> 3); vchunk_l[i] = (lane & 7) ^ ((vrow_l[i] >> 1) & 7); }
#define DA_LOAD(t, buf) do { const int kx0 = (t0 + (t)) * 64; const int krow0 = kx0 < SEQ ? b * SEQ + kx0 : TL + b * CTXL + (kx0 - SEQ); \
        _Pragma("unroll") for (int i = 0; i < 2; ++i) { \
            __builtin_amdgcn_global_load_lds((const unsigned*)(PB + (size_t)(krow0 + krow_l[i]) * COLS_B + 2048 + h * 128 + kchunk_l[i] * 8), (LAS unsigned*)(c.lds + (buf) * DA_BUF + (2 * w + i) * 1024), 16, 0, 0); \
            __builtin_amdgcn_global_load_lds((const unsigned*)(VTh + (size_t)vrow_l[i] * NKEY + kx0 + vchunk_l[i] * 8), (LAS unsigned*)(c.lds + (buf) * DA_BUF + DA_KBYTES + (2 * w + i) * 1024), 16, 0, 0); } } while (0)
    bf16x8 q[4];
    { const bf16_t* qp = PB + (size_t)(qrow0 + 32 * qg + r) * COLS_B + h * 128 + mp * 64 + hh * 8;
#pragma unroll
      for (int ks = 0; ks < 4; ++ks) q[ks] = ld_frag(qp + ks * 16); }
    f32x16 O[4];
#pragma unroll
    for (int d = 0; d < 4; ++d)
#pragma unroll
        for (int i = 0; i < 16; ++i) O[d][i] = 0.f;
    float m = 0.f, l = 0.f;
    DA_LOAD(0, 0);
    __syncthreads();
    for (int t = 0; t < nt; ++t) {
        const int cur = t & 1;
        if (t + 1 < nt) DA_LOAD(t + 1, cur ^ 1);
        const LAS unsigned short* Kl = (const LAS unsigned short*)(c.lds + cur * DA_BUF); const LAS unsigned short* Vl = (const LAS unsigned short*)(c.lds + cur * DA_BUF + DA_KBYTES);
        f32x16 st[2];
        const float negm = -m;
#pragma unroll
        for (int sub = 0; sub < 2; ++sub) {
#pragma unroll
            for (int i = 0; i < 16; ++i) st[sub][i] = negm;
#pragma unroll
            for (int ks = 0; ks < 4; ++ks) st[sub] = MFMA32(*(const LAS bf16x8*)((const LAS unsigned char*)Kl + (32 * sub + r) * 256 + (((mp * 8 + ks * 2 + hh) ^ (r & 15)) << 4)), q[ks], st[sub]); }
        float mx = fmaxf(st[0][0], st[1][0]);
#pragma unroll
        for (int i = 1; i < 16; ++i) mx = fmaxf(mx, fmaxf(st[0][i], st[1][i]));
        mx = fmaxf(mx, __shfl_xor(mx, 32));
        if (!__all(mx <= 8.0f && mx >= -24.0f)) {
            const float alpha = __builtin_amdgcn_exp2f(-mx);
            m += mx; l *= alpha;
#pragma unroll
            for (int sub = 0; sub < 2; ++sub)
#pragma unroll
                for (int i = 0; i < 16; ++i) st[sub][i] -= mx;
#pragma unroll
            for (int d = 0; d < 4; ++d)
#pragma unroll
                for (int i = 0; i < 16; ++i) O[d][i] *= alpha;
        }
        float ps = 0.f;
#pragma unroll
        for (int sub = 0; sub < 2; ++sub)
#pragma unroll
            for (int i = 0; i < 16; ++i) { st[sub][i] = __builtin_amdgcn_exp2f(st[sub][i]); ps += st[sub][i]; }
        l += ps;
        bf16x8 P[4];
#pragma unroll
        for (int sub = 0; sub < 2; ++sub) { P[2 * sub] = pack_p(st[sub], 0); P[2 * sub + 1] = pack_p(st[sub], 1); }
#pragma unroll
        for (int d = 0; d < 4; ++d)
#pragma unroll
            for (int kk = 0; kk < 4; ++kk) O[d] = MFMA32(*(const LAS bf16x8*)((const LAS unsigned char*)Vl + (32 * d + r) * 128 + (((2 * kk + hh) ^ ((r >> 1) & 7)) << 4)), P[kk], O[d]);
        __syncthreads();
    }
#undef DA_LOAD
    LAS float* CB = (LAS float*)(c.lds + DA_COMB) + qg * 4096;
    l += __shfl_xor(l, 32);
    if (mp == 1) { const float sc = ((const float*)(c.ws + WS_SCAL))[0] / l;
#pragma unroll
        for (int d = 0; d < 4; ++d)
#pragma unroll
            for (int i = 0; i < 16; ++i) CB[(32 * d + (i & 3) + 8 * (i >> 2) + 4 * hh) * 32 + r] = O[d][i] * sc; }
    __syncthreads();
    if (mp == 0) { const float i0 = 1.0f / l; float ss = 0.f;
#pragma unroll
        for (int d = 0; d < 4; ++d)
#pragma unroll
            for (int i = 0; i < 16; ++i) { const float y = O[d][i] * i0 - CB[(32 * d + (i & 3) + 8 * (i >> 2) + 4 * hh) * 32 + r]; O[d][i] = y; ss += y * y; }
        ss += __shfl_xor(ss, 32);
        const float rs = rsqrtf(ss * (1.0f / 128.0f) + 1e-5f) * 0.8f;
        const float* subln = c.in[I_SUBLN];
        bf16_t* orow = MIX + (size_t)(qrow0 + 32 * qg + r) * D + 2048 + h * 128;
#pragma unroll
        for (int d = 0; d < 4; ++d)
#pragma unroll
            for (int g = 0; g < 4; ++g) { const int dv = 32 * d + 8 * g + 4 * hh; const f32x4 sl = *(const f32x4*)(subln + dv);
                u32x2 wv; wv.x = pk_bf16(O[d][4 * g] * rs * sl[0], O[d][4 * g + 1] * rs * sl[1]); wv.y = pk_bf16(O[d][4 * g + 2] * rs * sl[2], O[d][4 * g + 3] * rs * sl[3]);
                *(u32x2*)(orow + dv) = wv; } }
    __syncthreads();
}
__device__ __forceinline__ void p_dattn_block(const Ctx& c, bool need_ctx) {
    const int nitems = NB * 16 * 32 + (need_ctx ? NB * 16 * 2 : 0);
    const bool remap = gridDim.x == 256;
    for (int item = blockIdx.x; item < nitems; item += gridDim.x) {
        int it = item;
        if (remap && item < NB * 16 * 32) { const int k = item >> 8, x = item & 7, sl = (item & 255) >> 3; it = (((k << 3) + x) << 5) | sl; }
        dattn_block_item(c, it);
    }
}

constexpr int P1_CQ = 0, P1_CK = 2048, P1_CV = 2304, P1_DQ = 2560, P1_DK = 3584, P1_DV = 4608, P1_DG = 6656;

constexpr int SW_KLD = 72, SW_VLD = 40;
constexpr int SW_KBYTES = 32 * SW_KLD * 2, SW_VBYTES = 64 * SW_VLD * 2, SW_BUF = SW_KBYTES + SW_VBYTES;
__device__ __forceinline__ void swa_block_item(const Ctx& c, int item) {
    const bf16_t* P1 = (const bf16_t*)(c.ar + AR_P1); const bf16_t* VTC = (const bf16_t*)(c.ar + AR_VTC); bf16_t* MIX = (bf16_t*)(c.ws + WS_XN);
    const int tid = c.tid, lane = c.lane, r = lane & 31, hh = lane >> 5;
    const int b = item >> 9, g = (item >> 7) & 3, q0 = (item & 127) * 32, hq = g * 8 + c.wave;
    const int qpos = q0 + r;
    bf16x8 q[4]; { const bf16_t* qp = P1 + (size_t)(b * SEQ + qpos) * NO + P1_CQ + hq * 64 + hh * 8;
#pragma unroll
        for (int ks = 0; ks < 4; ++ks) q[ks] = ld_frag(qp + ks * 16); }
    const bf16_t* VTh = VTC + ((size_t)b * 4 + g) * 64 * NKEY;
    f32x16 O[2];
#pragma unroll
    for (int d = 0; d < 2; ++d)
#pragma unroll
        for (int i = 0; i < 16; ++i) O[d][i] = 0.f;
    float m = 0.f, l = 0.f;
    const int wt0 = (q0 - 128 < 0 ? 0 : q0 - 128) / 32, wt1 = (q0 + 160 > SEQ ? SEQ : q0 + 160) / 32;
    const int nwt = wt1 - wt0, ntl = nwt + 8;
    u32x4 sreg;
    const bool kside = tid < 256; const int t2 = tid & 255;
#define SWB_LOAD(ti) do { const bool win_ = (ti) < nwt; const int kx_ = (win_ ? wt0 + (ti) : (SEQ / 32) + ((ti) - nwt)) * 32; \
        sreg = kside ? *(const u32x4*)(P1 + (size_t)((win_ ? b * SEQ + kx_ : TL + b * CTXL + (kx_ - SEQ)) + (t2 >> 3)) * NO + P1_CK + g * 64 + (t2 & 7) * 8) \
                     : *(const u32x4*)(VTh + (size_t)(t2 >> 2) * NKEY + kx_ + (t2 & 3) * 8); } while (0)
#define SWB_STORE(buf) do { LAS unsigned short* base_ = (LAS unsigned short*)(c.lds + (buf) * SW_BUF); \
        if (kside) *(LAS u32x4*)(base_ + (t2 >> 3) * SW_KLD + (t2 & 7) * 8) = sreg; else *(LAS u32x4*)(base_ + SW_KBYTES / 2 + (t2 >> 2) * SW_VLD + (t2 & 3) * 8) = sreg; } while (0)
    SWB_LOAD(0); SWB_STORE(0);
    __syncthreads();
    for (int ti = 0; ti < ntl; ++ti) {
        const bool win = ti < nwt; const int kx0 = (win ? wt0 + ti : (SEQ / 32) + (ti - nwt)) * 32;
        if (ti + 1 < ntl) SWB_LOAD(ti + 1);
        const LAS unsigned short* Kl = (const LAS unsigned short*)(c.lds + (ti & 1) * SW_BUF); const LAS unsigned short* Vl = Kl + SW_KBYTES / 2;
        f32x16 st;
        const float negm = -m;
#pragma unroll
        for (int i = 0; i < 16; ++i) st[i] = negm;
#pragma unroll
        for (int ks = 0; ks < 4; ++ks) st = MFMA32(*(const LAS bf16x8*)(Kl + r * SW_KLD + ks * 16 + hh * 8), q[ks], st);
        if (win && (kx0 == q0 - 128 || kx0 == q0 + 128)) {
#pragma unroll
            for (int i = 0; i < 16; ++i) { const int kpos = kx0 + (i & 3) + 8 * (i >> 2) + 4 * hh; const int dl = kpos - qpos; if (dl > 128 || dl < -128) st[i] = -1e30f; }
        }
        float mx = st[0];
#pragma unroll
        for (int i = 1; i < 16; ++i) mx = fmaxf(mx, st[i]);
        mx = fmaxf(mx, __shfl_xor(mx, 32));
        if (!__all(mx <= 8.0f && mx >= -24.0f)) {
            const float alpha = __builtin_amdgcn_exp2f(-mx);
            m += mx; l *= alpha;
#pragma unroll
            for (int i = 0; i < 16; ++i) st[i] -= mx;
#pragma unroll
            for (int d = 0; d < 2; ++d)
#pragma unroll
                for (int i = 0; i < 16; ++i) O[d][i] *= alpha;
        }
        float ps = 0.f;
#pragma unroll
        for (int i = 0; i < 16; ++i) { st[i] = __builtin_amdgcn_exp2f(st[i]); ps += st[i]; }
        l += ps;
        const bf16x8 p0 = pack_p(st, 0), p1 = pack_p(st, 1);
#pragma unroll
        for (int d = 0; d < 2; ++d) { O[d] = MFMA32(*(const LAS bf16x8*)(Vl + (32 * d + r) * SW_VLD + 8 * hh), p0, O[d]); O[d] = MFMA32(*(const LAS bf16x8*)(Vl + (32 * d + r) * SW_VLD + 16 + 8 * hh), p1, O[d]); }
        if (ti + 1 < ntl) SWB_STORE((ti + 1) & 1);
        __syncthreads();
    }
#undef SWB_LOAD
#undef SWB_STORE
    l += __shfl_xor(l, 32);
    l += __builtin_amdgcn_exp2f(c.in[I_SINK][hq] * LOG2E - m);
    const float il = 1.0f / l;
    bf16_t* orow = MIX + (size_t)(b * SEQ + qpos) * D + hq * 64;
#pragma unroll
    for (int d = 0; d < 2; ++d)
#pragma unroll
        for (int gq = 0; gq < 4; ++gq) { const int dv = 32 * d + 8 * gq + 4 * hh;
            u32x2 w; w.x = pk_bf16(O[d][4 * gq] * il, O[d][4 * gq + 1] * il); w.y = pk_bf16(O[d][4 * gq + 2] * il, O[d][4 * gq + 3] * il);
            *(u32x2*)(orow + dv) = w; }
}

DI float ret_lg(const Ctx& c, int dir, int h) { return log1pf(-exp2f(-c.in[I_RDEC][dir * 8 + h])); }
DI int ret_row0(int b, int cidx) { return cidx < 2 ? TL + b * CTXL + cidx * 128 : b * SEQ + (cidx - 2) * 128; }
constexpr int TK_LD = 136, TV_LD = 264;
constexpr int RT_LD = 136;
DI void stage_chunk_T(const Ctx& c, const bf16_t* src, int ld_src, int ncols, LAS unsigned short* T) {
    const int tid = c.tid, row = tid >> 2, part = tid & 3, cpt = ncols / 4;
    const bf16_t* p = src + (size_t)row * ld_src + part * cpt;
    for (int e = 0; e < cpt / 8; ++e) { const u32x4 w = *(const u32x4*)(p + e * 8);
#pragma unroll
        for (int j = 0; j < 4; ++j) { T[(part * cpt + e * 8 + 2 * j) * RT_LD + row] = (unsigned short)(w[j] & 0xffffu); T[(part * cpt + e * 8 + 2 * j + 1) * RT_LD + row] = (unsigned short)(w[j] >> 16); } }
}
__device__ __forceinline__ void p_ret_local(const Ctx& c) {
    const bf16_t* P1 = (const bf16_t*)(c.ar + AR_P1); h16* RU = (h16*)(c.ar + AR_RU);
    LAS unsigned short* TK = (LAS unsigned short*)c.lds; LAS unsigned short* TV = TK + 128 * RT_LD;
    const int lane = c.lane, r = lane & 31, hh = lane >> 5, w = c.wave;
    for (int item = blockIdx.x; item < NB * 8 * 34; item += gridDim.x) {
        const int cidx = item % 34, h = (item / 34) & 7, b = item / (34 * 8);
        const int row0 = ret_row0(b, cidx);
        stage_chunk_T(c, P1 + (size_t)row0 * NO + P1_DK + h * 128, NO, 128, TK);
        stage_chunk_T(c, P1 + (size_t)row0 * NO + P1_DV + h * 256, NO, 256, TV);
        __syncthreads();
        for (int dir = 0; dir < 2; ++dir) {
            const float lg = ret_lg(c, dir, h);
            f32x16 af[4];
#pragma unroll
            for (int dt = 0; dt < 4; ++dt)
#pragma unroll
                for (int i = 0; i < 16; ++i) af[dt][i] = 0.f;
#pragma unroll 1
            for (int ks = 0; ks < 8; ++ks) {
                const int i0 = ks * 16 + hh * 8;
                float vf[8]; unpack8(*(const LAS u32x4*)(TV + (32 * w + r) * RT_LD + i0), vf);
#pragma unroll
                for (int j = 0; j < 8; ++j) vf[j] *= __expf(lg * (float)(dir ? (i0 + j) : (127 - (i0 + j))));
                const bf16x8 fa = __builtin_bit_cast(bf16x8, pack8_bf16(vf));
#pragma unroll
                for (int dt = 0; dt < 4; ++dt) af[dt] = MFMA32(*(const LAS bf16x8*)(TK + (32 * dt + r) * RT_LD + i0), fa, af[dt]);
            }
            h16* U = RU + ((((size_t)b * 8 + h) * 2 + dir) * 34 + cidx) * 32768;
#pragma unroll
            for (int dt = 0; dt < 4; ++dt)
#pragma unroll
                for (int g = 0; g < 4; ++g) { f32x4 v4 = {af[dt][4 * g], af[dt][4 * g + 1], af[dt][4 * g + 2], af[dt][4 * g + 3]}; st4(U + (32 * w + r) * 128 + 32 * dt + 8 * g + 4 * hh, v4); }
        }
        __syncthreads();
    }
}
__device__ __forceinline__ void p_ret_prefix(const Ctx& c) {
    const h16* RU = (const h16*)(c.ar + AR_RU); bf16_t* RS = (bf16_t*)(c.ar + AR_RS);
    const size_t gtid = (size_t)blockIdx.x * NTHREADS + c.tid, gn = (size_t)gridDim.x * NTHREADS;
    for (size_t idx = gtid; idx < (size_t)NB * 8 * 2 * 8192; idx += gn) {
        const int el = (int)(idx & 8191) * 4, bhd = (int)(idx >> 13), dir = bhd & 1, h = (bhd >> 1) & 7;
        const float cd = __expf(ret_lg(c, dir, h) * 128.0f);
        const h16* U = RU + (size_t)bhd * 34 * 32768 + el; bf16_t* S = RS + (size_t)bhd * 32 * 32768 + el;
        u32x2 u[34];
#pragma unroll
        for (int ci = 0; ci < 34; ++ci) u[ci] = __builtin_nontemporal_load((const u32x2*)(U + (size_t)ci * 32768));
#define RP_U(ci) ((f32x4){h16lo(u[ci].x), h16hi(u[ci].x), h16lo(u[ci].y), h16hi(u[ci].y)})
        f32x4 s = {0.f, 0.f, 0.f, 0.f};
        if (dir == 0) {
#pragma unroll
            for (int ci = 0; ci < 34; ++ci) { if (ci >= 2) { u32x2 w = {pk_bf16(s[0], s[1]), pk_bf16(s[2], s[3])}; *(u32x2*)(S + (size_t)(ci - 2) * 32768) = w; } s = s * cd + RP_U(ci); } }
        else { s = s * cd + RP_U(1); s = s * cd + RP_U(0);
#pragma unroll
            for (int ci = 33; ci >= 2; --ci) { u32x2 w = {pk_bf16(s[0], s[1]), pk_bf16(s[2], s[3])}; *(u32x2*)(S + (size_t)(ci - 2) * 32768) = w; s = s * cd + RP_U(ci); } }
#undef RP_U
    }
}
__device__ __forceinline__ void p_ret_out(const Ctx& c) {
    const bf16_t* P1 = (const bf16_t*)(c.ar + AR_P1); const bf16_t* RS = (const bf16_t*)(c.ar + AR_RS); bf16_t* MIX = (bf16_t*)(c.ws + WS_XN);
    LAS unsigned short* TV = (LAS unsigned short*)c.lds;
    LAS float* XS = (LAS float*)(c.lds + 256 * RT_LD * 2);
    const int lane = c.lane, r = lane & 31, hh = lane >> 5, w = c.wave, qt = w & 3, eh = w >> 2;
    LAS unsigned char* SB = c.lds + 71680;
#define RO_SLOAD(Sg) do { _Pragma("unroll") for (int i = 0; i < 8; ++i) { const int srow = (8 * w + i) * 4 + (lane >> 4), schunk = (lane & 15) ^ (srow & 15); \
        __builtin_amdgcn_global_load_lds((const unsigned*)((Sg) + (size_t)srow * 128 + schunk * 8), (LAS unsigned*)(SB + (8 * w + i) * 1024), 16, 0, 0); } } while (0)
#define RO_SFRAG(e, ks) (*(const LAS bf16x8*)(SB + (e) * 256 + (((((ks) * 2 + hh)) ^ ((e) & 15)) << 4)))
    for (int item = blockIdx.x; item < NB * 8 * 32; item += gridDim.x) {
        const int lc = item & 31, h = (item >> 5) & 7, b = item >> 8;
        const int row0 = b * SEQ + lc * 128;
        const bf16_t* Sf = RS + ((((size_t)b * 8 + h) * 2 + 0) * 32 + lc) * 32768; const bf16_t* Sb = RS + ((((size_t)b * 8 + h) * 2 + 1) * 32 + lc) * 32768;
        RO_SLOAD(Sf);
        stage_chunk_T(c, P1 + (size_t)row0 * NO + P1_DV + h * 256, NO, 256, TV);
        asm volatile("s_waitcnt vmcnt(0)" ::: "memory");
        __syncthreads();
        const float lgf = ret_lg(c, 0, h), lgb = ret_lg(c, 1, h);
        const int qi = qt * 32 + r;
        const bf16_t* qp = P1 + (size_t)(row0 + qi) * NO + P1_DQ + h * 128 + hh * 8;
        f32x16 Y[4];
#pragma unroll
        for (int et = 0; et < 4; ++et)
#pragma unroll
            for (int i = 0; i < 16; ++i) Y[et][i] = 0.f;
        const float qdf = __expf(lgf * (float)(qi + 1)), qdb = __expf(lgb * (float)(128 - qi));
        {
#pragma unroll 1
            for (int ks = 0; ks < 8; ++ks) {
                float x[8]; unpack8(*(const u32x4*)(qp + ks * 16), x);
#pragma unroll
                for (int j = 0; j < 8; ++j) x[j] *= qdf;
                const bf16x8 qf = __builtin_bit_cast(bf16x8, pack8_bf16(x));
#pragma unroll
                for (int et = 0; et < 4; ++et) { const int e = eh * 128 + et * 32 + r; Y[et] = MFMA32(RO_SFRAG(e, ks), qf, Y[et]); }
            }
        }
        __syncthreads();
        RO_SLOAD(Sb);
#pragma unroll 1
        for (int kt = 0; kt < 4; ++kt) {
            f32x16 st;
#pragma unroll
            for (int i = 0; i < 16; ++i) st[i] = 0.f;
            const bf16_t* kp = P1 + (size_t)(row0 + kt * 32 + r) * NO + P1_DK + h * 128 + hh * 8;
#pragma unroll
            for (int ks = 0; ks < 8; ++ks) st = MFMA32(ld_frag(kp + ks * 16), ld_frag(qp + ks * 16), st);
#pragma unroll
            for (int i = 0; i < 16; ++i) { const int ki = kt * 32 + (i & 3) + 8 * (i >> 2) + 4 * hh; const int dl = qi - ki;
                const float f = dl > 0 ? __expf(lgf * (float)dl) : (dl < 0 ? __expf(lgb * (float)(-dl)) : 2.0f); st[i] *= f; }
            const bf16x8 p0 = pack_p(st, 0), p1 = pack_p(st, 1);
#pragma unroll
            for (int et = 0; et < 4; ++et) { const int e = eh * 128 + et * 32 + r;
#pragma unroll
                for (int s = 0; s < 2; ++s) { const u32x2 lo = *(const LAS u32x2*)(TV + e * RT_LD + kt * 32 + 16 * s + 4 * hh), hi = *(const LAS u32x2*)(TV + e * RT_LD + kt * 32 + 16 * s + 8 + 4 * hh);
                    u32x4 vw = {lo.x, lo.y, hi.x, hi.y};
                    Y[et] = MFMA32(__builtin_bit_cast(bf16x8, vw), s == 0 ? p0 : p1, Y[et]); } }
        }
        asm volatile("s_waitcnt vmcnt(0)" ::: "memory");
        __syncthreads();
        {
#pragma unroll 1
            for (int ks = 0; ks < 8; ++ks) {
                float x[8]; unpack8(*(const u32x4*)(qp + ks * 16), x);
#pragma unroll
                for (int j = 0; j < 8; ++j) x[j] *= qdb;
                const bf16x8 qb = __builtin_bit_cast(bf16x8, pack8_bf16(x));
#pragma unroll
                for (int et = 0; et < 4; ++et) { const int e = eh * 128 + et * 32 + r; Y[et] = MFMA32(RO_SFRAG(e, ks), qb, Y[et]); }
            }
        }
        float ss = 0.f;
#pragma unroll
        for (int et = 0; et < 4; ++et)
#pragma unroll
            for (int i = 0; i < 16; ++i) ss += Y[et][i] * Y[et][i];
        ss += __shfl_xor(ss, 32);
        if (hh == 0) XS[(eh * 4 + qt) * 32 + r] = ss;
        __syncthreads();
        const float tot = XS[(0 * 4 + qt) * 32 + r] + XS[(1 * 4 + qt) * 32 + r];
        const float rs = rsqrtf(tot * (1.0f / 256.0f) + 1e-6f);
        const bf16_t* gp = P1 + (size_t)(row0 + qi) * NO + P1_DG + h * 256; bf16_t* op = MIX + (size_t)(row0 + qi) * D + 2048 + h * 256;
#pragma unroll
        for (int et = 0; et < 4; ++et)
#pragma unroll
            for (int gq = 0; gq < 4; ++gq) { const int e = eh * 128 + et * 32 + 8 * gq + 4 * hh;
                const u32x2 gw = *(const u32x2*)(gp + e);
                const float g0 = bflo(gw.x), g1 = bfhi(gw.x), g2 = bflo(gw.y), g3 = bfhi(gw.y);
                u32x2 o; o.x = pk_bf16(Y[et][4 * gq] * rs * silu_f(g0), Y[et][4 * gq + 1] * rs * silu_f(g1)); o.y = pk_bf16(Y[et][4 * gq + 2] * rs * silu_f(g2), Y[et][4 * gq + 3] * rs * silu_f(g3));
                *(u32x2*)(op + e) = o; }
        __syncthreads();
    }
#undef RO_SLOAD
#undef RO_SFRAG
}

#define MK_PER_PHASE 0
#ifndef MK_PER_PHASE
#define MK_PER_PHASE 0
#endif
constexpr int N_PHASES = 25;
constexpr int LDS_STAGE = 4 * K1_WAVE_LDS;
constexpr int LDS_BYTES = LDS_STAGE + 256;

__global__ void __launch_bounds__(NTHREADS, 2) mk_fwd(Args a) {
    extern __shared__ __attribute__((aligned(16))) unsigned char smem[];
    Ctx c;
#pragma unroll
    for (int i = 0; i < 29; ++i) c.in[i] = a.in[i];
    c.out = a.out; c.ws = a.ws; c.ar = a.ws + WS_ARENA; c.lds = (LAS unsigned char*)smem;
    c.tid = threadIdx.x; c.lane = c.tid & 63; c.wave = __builtin_amdgcn_readfirstlane(c.tid >> 6);
    volatile LAS unsigned* xbw = (volatile LAS unsigned*)(c.lds + LDS_STAGE);
    if (c.tid < 4) xbw[c.tid] = 0u;
    __syncthreads();
    XcdBarrier bar; bar.bar = (unsigned*)(a.ws + WS_CTL); bar.x = 0; bar.st = xbw;
    if (!MK_PER_PHASE) bar = xcd_barrier_post((unsigned*)(a.ws + WS_CTL), xbw);
    const int lo = a.ph_lo, hi = a.ph_hi;
#ifndef PH_MASK
#define PH_MASK 0x1ffffffu
#endif
#define IN(k) (((PH_MASK >> (k)) & 1u) && lo <= (k) && (k) < hi)
#define SEAM(k) do { if (IN(k) && IN((k) + 1)) { xcd_barrier(bar); } } while (0)
    res_t* H = (res_t*)(c.ws + WS_H); const float* MOD = (const float*)(c.ws + WS_MOD);
    const bf16_t* XN = (const bf16_t*)(c.ws + WS_XN); unsigned char* W = c.ws + WS_W;
    LAS unsigned char* gl = c.lds; float* SLAB = (float*)(c.ar + AR_SLAB); unsigned char* W1 = c.ws + WS_W1;

    if (IN(0)) { p_mod(c); p_weights_layer0(c); p_wcolmax(c, CmxDeal{(int)blockIdx.x, (int)gridDim.x, 0, cmx_p0(gridDim.x)}); }
    SEAM(0);
    if (IN(1)) { p_mod_finalize(c); p_norm_mod<4>(c, c.in[I_X], c.in[I_CTX], TT, (const float*)(c.ar + AR_MODP), 0, 1); }
    SEAM(1);
    if (IN(2)) { const int ns = cmx_ns(gridDim.x), gg = (int)gridDim.x - ns;
        if ((int)blockIdx.x < gg) { pg8::Gemm g{XN, (const bf16_t*)(W + W_IN), TT, NE, D}; LatThenCtxOrder S; S.init2(NE, gg, blockIdx.x, D);
            EpiInEven E{(bf16_t*)(c.ar + AR_PA), (bf16_t*)(c.ar + AR_PB), (const float*)(c.ws + WS_AXC), (const float*)(c.ws + WS_AXS)};
            pg8::gemm_phase(gl, g, S, E); }
        else p_wcolmax(c, CmxDeal{(int)blockIdx.x - gg, ns, cmx_p0(gridDim.x), CMX_TOTAL}); }
    SEAM(2);
    if (IN(3)) { p_rwkv_prepA(c); p_build_vt<128, 16>(c, (const bf16_t*)(c.ar + AR_PB), COLS_B, 4096, (bf16_t*)(c.ar + AR_VT)); }
    SEAM(3);
    if (IN(4)) { pg8::Gemm g{(const bf16_t*)(c.ar + AR_LA), (const bf16_t*)(W + W_LORA), TT, LORA_N, LORA_K}; LoraOrder S; S.init2(LORA_N, gridDim.x, blockIdx.x, LORA_KU);
        EpiLora E{c.in[I_W0], c.in[I_A0], c.in[I_KA], (const bf16_t*)(c.ar + AR_K), (const h16*)(c.ar + AR_KK), (h16*)(c.ar + AR_OMW), (h16*)(c.ar + AR_BB), (h16*)(c.ar + AR_KD), (bf16_t*)(c.ar + AR_G)};
        pg8::gemm_phase(gl, g, S, E); }
    SEAM(4);
    if (IN(5)) {
#ifndef NO_DATTN
        p_dattn_block(c, true); __syncthreads();
#endif
#ifndef NO_K1
        p_rwkv_k1_and_conv(c);
#endif
    }
    SEAM(5);
    if (IN(6)) p_rwkv_seq_and_conv(c);
    SEAM(6);
    if (IN(7)) p_rwkv_out(c, TT);
    SEAM(7);
    if (IN(8)) { constexpr int KE = MIX_I8 ? D / 2 : D; const float* SAq = (const float*)(c.ar + AR_XQS);
        pg8::Gemm g{MIX_I8 ? (const bf16_t*)(c.ar + AR_XQ) : XN, (const bf16_t*)(W + W_MIX), TT, D, KE}; pg8::StaticOrder S; S.init(TL, D, gridDim.x, blockIdx.x, KE);
        EpiResModT<MIX_I8 != 0, float> E{c.in[I_X], c.in[I_CTX], H, MOD + 2 * 4096, SAq, i8_cs(c, CM_MIX)};
        pg8::gemm_phase(gl, g, S, E);
        CtxSplitOrder S2; S2.init(D, gridDim.x, blockIdx.x, KE); EpiSlabT<MIX_I8 != 0> E2{SLAB, SAq, i8_cs(c, CM_MIX)};
        pg8::gemm_phase(gl, g, S2, E2); }
    SEAM(8);
    if (IN(9)) { p_ctx_fix(c, c.in[I_CTX], MOD + 4 * 24576 + 2 * 4096, SLAB, H); p_norm_mod<1, FFN_I8 != 0, res_t>(c, H, H + (size_t)TL * D, TT, MOD, 3, 4); }
    SEAM(9);
    if (IN(10)) { constexpr int KE = FFN_I8 ? D / 2 : D;
        pg8::Gemm g{XN, (const bf16_t*)(W + W_FFI), TT, 2 * DFF, KE}; LatThenCtxOrder S; S.init2(2 * DFF, gridDim.x, blockIdx.x, KE);
        EpiConvGlu E{(bf16_t*)(c.ar + AR_HID), (bf16_t*)(c.ar + AR_SG), (bf16_t*)(c.ar + AR_SU), c.in[I_CONVW], c.in[I_CONVB], (const float*)(c.ws + WS_XN + (size_t)TT * D), i8_cs(c, CM_FFI)};
        pg8::gemm_phase(gl, g, S, E); }
    SEAM(10);
    if (IN(11)) { p_conv_fix(c, 0, TT); if (FFO0_I8 && IN(12)) { xcd_barrier(bar); p_quant_hid(c, TT); } }
    SEAM(11);
    if (IN(12)) { constexpr int KE = FFO0_I8 ? DFF / 2 : DFF; const float* SAq = (const float*)(c.ar + AR_HQS);
        pg8::Gemm g{(const bf16_t*)(c.ar + (FFO0_I8 ? AR_HQ : AR_HID)), (const bf16_t*)(W + W_FFO), TT, D, KE}; pg8::StaticOrder S; S.init(TL, D, gridDim.x, blockIdx.x, KE);
        EpiResModT<FFO0_I8 != 0> E{H, H + (size_t)TL * D, H, MOD + 5 * 4096, SAq, i8_cs(c, CM_FFO0)};
        pg8::gemm_phase(gl, g, S, E);
        CtxSplitOrder S2; S2.init(D, gridDim.x, blockIdx.x, KE); EpiSlabT<FFO0_I8 != 0> E2{SLAB, SAq, i8_cs(c, CM_FFO0)};
        pg8::gemm_phase(gl, g, S2, E2); }
    SEAM(12);
    const float* MOD1 = MOD + 5 * 24576;
    if (IN(13)) { p_ctx_fix(c, H + (size_t)TL * D, MOD + 4 * 24576 + 5 * 4096, SLAB, H); p_norm_mod<1, INO_I8 != 0, res_t>(c, H, H + (size_t)TL * D, TT, MOD1, 0, 1); }
    SEAM(13);
    if (IN(14)) { constexpr int KE = INO_I8 ? D / 2 : D;
        pg8::Gemm g{XN, (const bf16_t*)(W + W_IN), TT, NO, KE}; OddInOrder S; S.init2(gridDim.x, blockIdx.x, KE);
        EpiInOdd E{(bf16_t*)(c.ar + AR_P1), (const float*)(c.ws + WS_AXC), (const float*)(c.ws + WS_AXS), (const float*)(c.ws + WS_RTC), (const float*)(c.ws + WS_RTS), (const float*)(c.ws + WS_XN + (size_t)TT * D), i8_cs(c, CM_INO)};
        pg8::gemm_phase(gl, g, S, E); }
    SEAM(14);
    if (IN(15)) { p_build_vt<64, 4>(c, (const bf16_t*)(c.ar + AR_P1), NO, P1_CV, (bf16_t*)(c.ar + AR_VTC)); }
    SEAM(15);
    if (IN(16)) { p_ret_local(c); for (int item = blockIdx.x; item < NB * 4 * 128; item += gridDim.x) swa_block_item(c, item); }
    SEAM(16);
    if (IN(17)) p_ret_prefix(c);
    SEAM(17);
    if (IN(18)) p_ret_out(c);
    SEAM(18);
    if (MIX_I8 && IN(18) && IN(19)) { p_quant_mix(c, TL); xcd_barrier(bar); }
    if (IN(19)) { constexpr int KE = MIX_I8 ? D / 2 : D;
        pg8::Gemm g{MIX_I8 ? (const bf16_t*)(c.ar + AR_XQ) : XN, (const bf16_t*)(W1 + W1_MIX), TL, D, KE}; pg8::StaticOrder S; S.init(TL, D, gridDim.x, blockIdx.x, KE);
        EpiResModT<MIX_I8 != 0> E{H, H + (size_t)TL * D, H, MOD1 + 2 * 4096, (const float*)(c.ar + AR_XQS), i8_cs(c, CM_MIX + D)};
        pg8::gemm_phase(gl, g, S, E); }
    SEAM(19);
    if (IN(20)) p_norm_mod<1, FFN_I8 != 0, res_t>(c, H, H + (size_t)TL * D, TL, MOD1, 3, 4);
    SEAM(20);
    if (IN(21)) { constexpr int KE = FFN_I8 ? D / 2 : D;
        pg8::Gemm g{XN, (const bf16_t*)(W1 + W1_FFI), TL, 2 * DFF, KE}; pg8::StaticOrder S; S.init(TL, 2 * DFF, gridDim.x, blockIdx.x, KE);
        EpiConvGlu E{(bf16_t*)(c.ar + AR_HID), (bf16_t*)(c.ar + AR_SG), (bf16_t*)(c.ar + AR_SU), c.in[I_CONVW] + (size_t)3 * DFF, c.in[I_CONVB] + DFF, (const float*)(c.ws + WS_XN + (size_t)TT * D), i8_cs(c, CM_FFI + 2 * DFF)};
        pg8::gemm_phase(gl, g, S, E); }
    SEAM(21);
    if (IN(22)) { p_conv_fix(c, 1, TL); if (FFO1_I8 && IN(23)) { xcd_barrier(bar); p_quant_hid(c, TL); } }
    SEAM(22);
    if (IN(23)) { constexpr int KE = FFO1_I8 ? DFF / 2 : DFF;
        pg8::Gemm g{(const bf16_t*)(c.ar + (FFO1_I8 ? AR_HQ : AR_HID)), (const bf16_t*)(W1 + W1_FFO), TL, D, KE}; pg8::StaticOrder S; S.init(TL, D, gridDim.x, blockIdx.x, KE);
        EpiResModT<FFO1_I8 != 0> E{H, H + (size_t)TL * D, H, MOD1 + 5 * 4096, (const float*)(c.ar + AR_HQS), i8_cs(c, CM_FFO1)};
        pg8::gemm_phase(gl, g, S, E); }
    SEAM(23);
    if (IN(24)) p_final_norm(c);
#undef IN
#undef SEAM
}

extern "C" void kernel_launch(void* const* d_in, const int* in_sizes, int n_in, void* d_out, int out_size, void* d_ws, size_t ws_size, hipStream_t stream) {
    static int grid = 0;
    if (grid == 0) {
        if (n_in != 29 || ws_size < WS_END) { fprintf(stderr, "kernel_launch: need 29 inputs and >= %zu bytes of workspace; got n_in %d, ws %zu; nothing launched\n", (size_t)WS_END, n_in, ws_size); grid = -1; return; }
        int dev = 0, cus = 0, per_cu = 0;
        if (hipGetDevice(&dev) != hipSuccess || hipDeviceGetAttribute(&cus, hipDeviceAttributeMultiprocessorCount, dev) != hipSuccess) { grid = -1; return; }
        if (hipFuncSetAttribute((const void*)mk_fwd, hipFuncAttributeMaxDynamicSharedMemorySize, LDS_BYTES) != hipSuccess) { fprintf(stderr, "kernel_launch: hipFuncSetAttribute failed\n"); grid = -1; return; }
        if (hipOccupancyMaxActiveBlocksPerMultiprocessor(&per_cu, (const void*)mk_fwd, NTHREADS, LDS_BYTES) != hipSuccess || per_cu < 1) { fprintf(stderr, "kernel_launch: occupancy query says %d blocks per CU\n", per_cu); per_cu = 1; }
        (void)hipGetLastError();
        grid = cus;
    }
    if (grid < 0) return;
    (void)hipMemsetAsync((char*)d_ws + WS_CTL, 0, CTL_BYTES, stream);
    Args a{};
    for (int i = 0; i < 29; ++i) a.in[i] = (const float*)d_in[i];
    a.out = (float*)d_out; a.ws = (unsigned char*)d_ws;
#if MK_PER_PHASE
    for (int p = 0; p < N_PHASES; ++p) { a.ph_lo = p; a.ph_hi = p + 1; hipLaunchKernelGGL(mk_fwd, dim3(grid), dim3(NTHREADS), LDS_BYTES, stream, a); }
#else
    a.ph_lo = 0; a.ph_hi = N_PHASES;
    hipLaunchKernelGGL(mk_fwd, dim3(grid), dim3(NTHREADS), LDS_BYTES, stream, a);
#endif
    (void)in_sizes; (void)out_size;
}
```

```cpp
#include <hip/hip_runtime.h>
#include <cstdio>
#include <cstdint>

#define LAS __attribute__((address_space(3)))
#define DI __device__ __forceinline__
typedef unsigned short bf16_t;
typedef _Float16 h16;
typedef short bf16x8 __attribute__((ext_vector_type(8)));
typedef float f32x4 __attribute__((ext_vector_type(4)));
typedef int i32x4 __attribute__((ext_vector_type(4)));
typedef float f32x2 __attribute__((ext_vector_type(2)));
typedef float f32x16 __attribute__((ext_vector_type(16)));
typedef unsigned u32x4 __attribute__((ext_vector_type(4)));
typedef unsigned u32x2 __attribute__((ext_vector_type(2)));
typedef __bf16 bf16x2_n __attribute__((ext_vector_type(2)));
typedef _Float16 h16x2_n __attribute__((ext_vector_type(2)));

constexpr int D = 4096, NB = 4, SEQ = 4096, CTXL = 256;
constexpr int TL = NB * SEQ, TC = NB * CTXL, TT = TL + TC;
constexpr int DFF = 11008;
constexpr int HALF_W = 2048;
constexpr int COLS_A = 6784, COLS_A_PAD = 6912, COLS_B = 6144, NE = COLS_A_PAD + COLS_B;
constexpr int COLS_C = 2560, COLS_D = 6144, NO = COLS_C + COLS_D;
constexpr int NKEY = SEQ + CTXL;
constexpr int LORA_K = 1280, LORA_KU = 256, LORA_N = 5 * 2048;
constexpr int NTHREADS = 512;

constexpr size_t al256(size_t x) { return (x + 255) & ~(size_t)255; }
constexpr size_t WS_CTL = 0;
constexpr size_t CTL_CMAX = 65536;
constexpr int CM_FFI = 0, CM_INO = 2 * 2 * 11008, CM_INE = CM_INO + 8704, CM_MIX = CM_INE + 13056, CM_FFO1 = CM_MIX + 2 * 4096, CM_FFO0 = CM_FFO1 + 4096, CM_END = CM_FFO0 + 4096;
constexpr size_t CTL_BYTES = CTL_CMAX + (((size_t)CM_END * 4 + 255) & ~(size_t)255);
constexpr size_t WS_MOD = WS_CTL + CTL_BYTES;
constexpr size_t WS_SCAL = WS_MOD + al256((size_t)2 * 5 * 6 * D * 4);
constexpr size_t WS_CS = WS_SCAL + 256;
constexpr size_t WS_AXC = WS_CS + (((size_t)CM_END * 4 + 255) & ~(size_t)255);
constexpr size_t WS_AXS = WS_AXC + (size_t)SEQ * 32 * 4;
constexpr size_t WS_RTC = WS_AXS + (size_t)SEQ * 32 * 4;
constexpr size_t WS_RTS = WS_RTC + (size_t)NKEY * 64 * 4;
constexpr size_t WS_W = WS_RTS + (size_t)NKEY * 64 * 4;
constexpr size_t W_IN = 0;
constexpr size_t W_MIX = W_IN + (size_t)NE * D * 2;
constexpr size_t W_FFI = W_MIX + (size_t)D * D * 2;
constexpr size_t W_FFO = W_FFI + (size_t)2 * DFF * D * 2;
constexpr size_t W_LORA = W_FFO + (size_t)D * DFF * 2;
constexpr size_t W_BYTES = W_LORA + (size_t)LORA_N * LORA_K * 2;
constexpr size_t WS_H = WS_W + al256(W_BYTES);
constexpr size_t WS_XN = WS_H + (size_t)TT * D * 4;
constexpr size_t WS_W1 = WS_XN + (size_t)TT * D * 2;
constexpr size_t W1_MIX = 0, W1_FFI = W1_MIX + (size_t)D * D * 2, W1_FFO = W1_FFI + (size_t)2 * DFF * D * 2, W1_BYTES = W1_FFO + (size_t)D * DFF * 2;
constexpr size_t WS_ARENA = WS_W1 + al256(W1_BYTES);
constexpr size_t SZ16 = (size_t)TT * 2048 * 2;
constexpr size_t MOD_FLOATS = (size_t)2 * 5 * 6 * D;
constexpr size_t AR_XQ = 0, AR_XQS = (size_t)80 << 20;
constexpr size_t AR_MODP = 0;
constexpr size_t AR_PA = 0;
constexpr size_t AR_K = AR_PA + (size_t)TT * COLS_A_PAD * 2;
constexpr size_t AR_LA = AR_K + SZ16;
constexpr size_t RW_NCH = 136;
constexpr size_t CH_BYTES = 24576;
constexpr size_t AR_CH = 0;
constexpr size_t AR_CH_END = AR_CH + (size_t)256 * RW_NCH * CH_BYTES;
constexpr size_t AR_PB = AR_CH_END;
constexpr size_t AR_VT = AR_PB + (size_t)TT * COLS_B * 2;
constexpr size_t AR_R = AR_VT + (size_t)NB * 16 * 128 * NKEY * 2;
constexpr size_t AR_KK = AR_R + SZ16;
constexpr size_t AR_V = AR_KK + SZ16;
constexpr size_t AR_OMW = AR_V + SZ16;
constexpr size_t AR_BB = AR_OMW + 2 * SZ16;
constexpr size_t AR_KD = AR_BB + 2 * SZ16;
constexpr size_t AR_G = AR_KD + 2 * SZ16;
constexpr size_t AR_Y = AR_G + SZ16;
constexpr size_t AR_EVEN_END = AR_Y + 2 * SZ16;
static_assert(AR_LA + (size_t)TT * LORA_K * 2 <= AR_CH_END, "PA|K|LA must sit under the chunk matrices");
constexpr size_t AR_GU = 0;
constexpr size_t AR_SG = 0, AR_SU = AR_SG + (size_t)(TT / 64) * 4 * DFF * 2;
constexpr size_t AR_HQ = (size_t)64 << 20, AR_HQS = (size_t)320 << 20;
constexpr size_t AR_HID = AR_GU + (size_t)TT * 2 * DFF * 2;
constexpr size_t AR_FFN_END = AR_HID + (size_t)TT * DFF * 2;
constexpr size_t AR_P1 = 0;
constexpr size_t AR_VTC = AR_P1 + (size_t)TT * NO * 2;
constexpr size_t AR_RU = AR_VTC + (size_t)NB * 4 * 64 * NKEY * 2;
constexpr size_t AR_RS = AR_RU + (size_t)NB * 8 * 2 * 34 * 256 * 128 * 4;
constexpr size_t AR_ODD_END = AR_RS + (size_t)NB * 8 * 2 * 32 * 256 * 128 * 2;
constexpr size_t AR_SLAB = (size_t)1300 << 20;
constexpr size_t AR_SLAB_END = AR_SLAB + (size_t)4 * TC * D * 4;
static_assert(AR_SLAB >= AR_FFN_END, "slab overlaps the FFN buffers");
constexpr size_t cmax(size_t a, size_t b) { return a > b ? a : b; }
constexpr size_t AR_BYTES = cmax(cmax(AR_EVEN_END, AR_FFN_END), AR_ODD_END);
constexpr size_t WS_END = WS_ARENA + AR_BYTES;
static_assert(WS_END <= (size_t)3221225472ull, "workspace plan exceeds 4 x the largest input tensor");
static_assert(AR_SLAB_END <= AR_BYTES, "slab outside the arena");

DI float bf2f(bf16_t x) { return __uint_as_float((unsigned)x << 16); }
DI bf16_t f2bf(float x) { return __builtin_bit_cast(unsigned short, (__bf16)x); }
DI unsigned pk_bf16(float lo, float hi) { f32x2 v = {lo, hi}; return __builtin_bit_cast(unsigned, __builtin_convertvector(v, bf16x2_n)); }
DI unsigned pk_f16(float lo, float hi) { f32x2 v = {lo, hi}; return __builtin_bit_cast(unsigned, __builtin_convertvector(v, h16x2_n)); }
DI float bflo(unsigned w) { return __uint_as_float(w << 16); }
DI float bfhi(unsigned w) { return __uint_as_float(w & 0xffff0000u); }
DI float h16lo(unsigned w) { return (float)__builtin_bit_cast(h16x2_n, w)[0]; }
DI float h16hi(unsigned w) { return (float)__builtin_bit_cast(h16x2_n, w)[1]; }
DI float silu_f(float x) { return x * __builtin_amdgcn_rcpf(1.0f + __expf(-x)); }
DI float sigmoid_f(float x) { return __builtin_amdgcn_rcpf(1.0f + __expf(-x)); }
DI float wave_sum(float v) {
#pragma unroll
    for (int o = 32; o >= 1; o >>= 1) v += __shfl_xor(v, o);
    return v;
}
DI void load8f(const float* p, float (&o)[8]) { const f32x4 a = *(const f32x4*)p, b = *(const f32x4*)(p + 4);
#pragma unroll
    for (int j = 0; j < 4; ++j) { o[j] = a[j]; o[4 + j] = b[j]; } }
#ifndef RES_F16
#define RES_F16 1
#endif
#if RES_F16
typedef h16 res_t;
#else
typedef float res_t;
#endif
DI f32x4 ld4(const float* p) { return *(const f32x4*)p; }
DI void st4(float* p, const f32x4 v) { *(f32x4*)p = v; }
#if RES_F16
DI f32x4 ld4(const h16* p) { const u32x2 w = *(const u32x2*)p; f32x4 v = {h16lo(w.x), h16hi(w.x), h16lo(w.y), h16hi(w.y)}; return v; }
DI void st4(h16* p, const f32x4 v) { u32x2 w = {pk_f16(v[0], v[1]), pk_f16(v[2], v[3])}; *(u32x2*)p = w; }
#endif
DI void ld8(const float* p, f32x4& a, f32x4& b) { a = *(const f32x4*)p; b = *(const f32x4*)(p + 4); }
DI void st8(float* p, const f32x4 a, const f32x4 b) { *(f32x4*)p = a; *(f32x4*)(p + 4) = b; }
#if RES_F16
DI void ld8(const h16* p, f32x4& a, f32x4& b) { const u32x4 w = *(const u32x4*)p; a = (f32x4){h16lo(w.x), h16hi(w.x), h16lo(w.y), h16hi(w.y)}; b = (f32x4){h16lo(w.z), h16hi(w.z), h16lo(w.w), h16hi(w.w)}; }
DI void st8(h16* p, const f32x4 a, const f32x4 b) { u32x4 w = {pk_f16(a[0], a[1]), pk_f16(a[2], a[3]), pk_f16(b[0], b[1]), pk_f16(b[2], b[3])}; *(u32x4*)p = w; }
#endif
DI int row_modidx(int row) { return row < TL ? (row >> 12) : 4; }

#define XB_TMO      128
#define XB_XCNT(j)  (256  + 64 * (j))
#define XB_XSUB(j)  (1280 + 64 * (j))
#define XB_XGEN(j)  (2304 + 64 * (j))
#define XB_TOP      3328
#define XB_TOPGEN   3392
#define XCD_BAR_WORDS 3456
#define XB_SPIN_CAP (1u << 22)

__device__ __forceinline__ unsigned xb_ld(unsigned* p)              { return __hip_atomic_load(p, __ATOMIC_RELAXED, __HIP_MEMORY_SCOPE_AGENT); }
__device__ __forceinline__ unsigned xb_add(unsigned* p, unsigned v) { return __hip_atomic_fetch_add(p, v, __ATOMIC_RELAXED, __HIP_MEMORY_SCOPE_AGENT); }
__device__ __forceinline__ unsigned xb_xcc_id() { return (unsigned)__builtin_amdgcn_s_getreg((3 << 11) | 20) & 0xFu; }
#define XB_SPIN(cond, bar) do { unsigned _sp = 0; while (cond) { __builtin_amdgcn_s_sleep(1); \
    if ((++_sp & 255u) == 0u) { if (xb_ld(&(bar)[XB_TMO])) break; if (_sp > XB_SPIN_CAP) { atomicAdd(&(bar)[XB_TMO], 1u); break; } } } } while (0)

struct XcdBarrier {
    unsigned* bar; unsigned x;
    volatile LAS unsigned* st;
};

__device__ __forceinline__ XcdBarrier xcd_barrier_post(unsigned* bar, volatile LAS unsigned* st) {
    XcdBarrier b; b.bar = bar; b.x = xb_xcc_id(); b.st = st;
    if (threadIdx.x == 0) (void)xb_add(&bar[XB_XCNT(b.x)], 1u);
    return b;
}
__device__ __forceinline__ void xcd_barrier_complete(unsigned* bar, unsigned x, unsigned& nloc, unsigned& nx) {
    const unsigned G = gridDim.x * gridDim.y * gridDim.z;
    unsigned sum, cnt, mine, sp = 0u;
    for (;;) {
        sum = 0u; cnt = 0u; mine = 0u;
#pragma unroll
        for (unsigned j = 0; j < 16; ++j) { const unsigned c = xb_ld(&bar[XB_XCNT(j)]); sum += c; cnt += (c > 0u) ? 1u : 0u; mine = (j == x) ? c : mine; }
        if (sum == G) break;
        __builtin_amdgcn_s_sleep(1);
        if ((++sp & 255u) == 0u) { if (xb_ld(&bar[XB_TMO])) break; if (sp > XB_SPIN_CAP) { atomicAdd(&bar[XB_TMO], 1u); break; } }
    }
    nloc = mine > 0u ? mine : 1u; nx = cnt > 0u ? cnt : 1u;
}

__device__ __forceinline__ void xcd_barrier(const XcdBarrier& b) {
    asm volatile("s_waitcnt vmcnt(0)" ::: "memory");
    __syncthreads();
    if (threadIdx.x == 0) {
        unsigned* bar = b.bar;
        __builtin_amdgcn_s_waitcnt(0);
        unsigned nloc = b.st[0], nx = b.st[1];
        if (nloc == 0u) { xcd_barrier_complete(bar, b.x, nloc, nx); b.st[0] = nloc; b.st[1] = nx; }
        const unsigned old = xb_add(&bar[XB_XSUB(b.x)], 1u);
        const unsigned gen = old / nloc;
        if (old + 1u == (gen + 1u) * nloc) {
            __builtin_amdgcn_fence(__ATOMIC_RELEASE, "agent");
            asm volatile("s_waitcnt vmcnt(0)" ::: "memory");
            const unsigned og = xb_add(&bar[XB_TOP], 1u);
            const unsigned tg = og / nx;
            if (og + 1u == (tg + 1u) * nx) xb_add(&bar[XB_TOPGEN], 1u);
            else XB_SPIN(xb_ld(&bar[XB_TOPGEN]) == tg, bar);
            __builtin_amdgcn_fence(__ATOMIC_ACQUIRE, "agent");
            xb_add(&bar[XB_XGEN(b.x)], 1u);
            asm volatile("s_waitcnt vmcnt(0)" ::: "memory");
        } else {
            XB_SPIN(xb_ld(&bar[XB_XGEN(b.x)]) == gen, bar);
            __builtin_amdgcn_fence(__ATOMIC_ACQUIRE, "agent");
            asm volatile("s_waitcnt vmcnt(0)" ::: "memory");
        }
    }
    __syncthreads();
}

namespace pg8 {
#define PG8_LAS __attribute__((address_space(3)))
constexpr int BM = 256, BK = 64, HALF = 128, HTB = HALF * BK * 2  , STAGE_BYTES = 8 * HTB, NXCD = 8, WGM = 4;

__host__ __device__ __forceinline__ int lds_byte(int r, int c) { const int st = (r >> 4) * 2 + (c >> 5), rr = r & 15, cc = c & 31, ob = rr * 64 + cc * 2; return st * 1024 + (ob ^ (((ob >> 9) & 1) << 5)); }
__host__ __device__ __forceinline__ void stage_rc(int b, int& R, int& C) { const int st = b / 1024, sb = b % 1024, swz = sb ^ (((sb >> 9) & 1) << 5); R = (st >> 1) * 16 + swz / 64; C = (st & 1) * 32 + (swz % 64) / 2; }
__host__ __device__ __forceinline__ int perm32(int rho) { const int n = rho >> 4, i = rho & 15; return 8 * (i >> 2) + 4 * n + (i & 3); }

struct Unit { int pm, pn, koff, nt, part; };
struct Gemm { const bf16_t* A; const bf16_t* Bt; int M, N, K; };

struct StaticOrder {
    int nM, nN, nwg, G, c, ntk;
    __host__ __device__ void init(int M, int N, int G_, int c_, int K_ = 0) { nM = M / BM; nN = N / BM; nwg = nM * nN; G = G_; c = c_; ntk = K_ / BK; }
    __host__ __device__ bool next(int i, Unit& u) const {
        const long L = (long)i * G + c; if (L >= nwg) return false;
        int wgid = (int)L; { const int q = nwg / NXCD, r = nwg % NXCD, xcd = wgid % NXCD, off = wgid / NXCD; wgid = (xcd < r ? xcd * (q + 1) : r * (q + 1) + (xcd - r) * q) + off; }
        const int nig = WGM * nN, gid = wgid / nig, fm = gid * WGM, gsz = (nM - fm) < WGM ? (nM - fm) : WGM;
        u.pm = fm + ((wgid % nig) % gsz); u.pn = (wgid % nig) / gsz; u.koff = 0; u.nt = ntk; u.part = -1; return true;
    }
    __device__ __forceinline__ void a_ready(const Unit&) const {}
    __device__ __forceinline__ void done(const Unit&) const {}
};


template <class Epi, class Sched>
__device__ __forceinline__ void gemm_phase(PG8_LAS unsigned char* lds, const Gemm g, const Sched& S, const Epi& E) {
    const int tid = threadIdx.x, wid = __builtin_amdgcn_readfirstlane(tid >> 6), lane = tid & 63, wr = wid >> 2, wc = wid & 3, fr = lane & 15, fq = lane >> 4;
    const int K = g.K;
    unsigned voffA[2], voffB[2];
#pragma unroll
    for (int i = 0; i < 2; ++i) { int R, C; stage_rc(tid * 16 + i * 8192, R, C); const int Rb = Epi::PERM ? ((R & ~31) + perm32(R & 31)) : R;
        voffA[i] = (unsigned)(R * K + C) * 2u; voffB[i] = (unsigned)(Rb * K + C) * 2u; }
    const size_t kstep = (size_t)(BK * 2);
    const size_t hstep = (size_t)HALF * K * 2;
    const size_t tstep = 2 * hstep;
    const unsigned ldsw = (unsigned)wid * 1024u;
    const int aoff = lds_byte(wr * 64 + fr, fq * 8), boff = lds_byte(wc * 32 + fr, fq * 8);
#define PG8_SA(b, h) (((b) * 2 + (h)) * HTB)
#define PG8_SB(b, h) ((4 + (b) * 2 + (h)) * HTB)
#define PG8_STAGE(bufoff, gbase, voff) do { _Pragma("unroll") for (int _i = 0; _i < 2; ++_i) \
        __builtin_amdgcn_global_load_lds((const unsigned*)((const char*)(gbase) + (voff)[_i]), (PG8_LAS unsigned*)(lds + (bufoff) + ldsw + _i * 8192), 16, 0, 0); } while (0)
#define PG8_LDA(dst, b, h) do { _Pragma("unroll") for (int m = 0; m < 4; ++m) _Pragma("unroll") for (int k = 0; k < 2; ++k) dst[m][k] = *(const PG8_LAS bf16x8*)(lds + PG8_SA(b, h) + aoff + m * 2048 + k * 1024); } while (0)
#define PG8_LDB(dst, b, h) do { _Pragma("unroll") for (int n = 0; n < 2; ++n) _Pragma("unroll") for (int k = 0; k < 2; ++k) dst[n][k] = *(const PG8_LAS bf16x8*)(lds + PG8_SB(b, h) + boff + n * 2048 + k * 1024); } while (0)
#define PG8_MMA(ai, bj, At, Bt) do { __builtin_amdgcn_s_setprio(1); _Pragma("unroll") for (int m = 0; m < 4; ++m) _Pragma("unroll") for (int n = 0; n < 2; ++n) _Pragma("unroll") for (int k = 0; k < 2; ++k) \
        { if constexpr (Epi::I8) acc[ai][bj][m][n] = __builtin_bit_cast(f32x4, __builtin_amdgcn_mfma_i32_16x16x64_i8(__builtin_bit_cast(i32x4, Bt[n][k]), __builtin_bit_cast(i32x4, At[m][k]), __builtin_bit_cast(i32x4, acc[ai][bj][m][n]), 0, 0, 0)); \
          else acc[ai][bj][m][n] = __builtin_amdgcn_mfma_f32_16x16x32_bf16(Bt[n][k], At[m][k], acc[ai][bj][m][n], 0, 0, 0); } __builtin_amdgcn_s_setprio(0); } while (0)
#define PG8_WAIT_V(n) asm volatile("s_waitcnt vmcnt(" #n ")" ::: "memory")
#define PG8_WAIT_L(n) asm volatile("s_waitcnt lgkmcnt(" #n ")" ::: "memory")
#define PG8_BAR __builtin_amdgcn_s_barrier()
#define PG8_SCHED __builtin_amdgcn_sched_barrier(0)
    Unit cur, nxt; int ui = 0;
    if (!S.next(0, cur)) return;
    f32x4 acc[2][2][4][2];
#pragma unroll
    for (int a = 0; a < 2; ++a)
#pragma unroll
        for (int b = 0; b < 2; ++b)
#pragma unroll
            for (int m = 0; m < 4; ++m)
#pragma unroll
                for (int n = 0; n < 2; ++n) acc[a][b][m][n] = (f32x4){0.f, 0.f, 0.f, 0.f};
    bf16x8 At[4][2], B0[2][2], B1[2][2];
    const char* cA = (const char*)g.A + (size_t)cur.pm * tstep + cur.koff; const char* cB = (const char*)g.Bt + (size_t)cur.pn * tstep + cur.koff;
    S.a_ready(cur);
    PG8_STAGE(PG8_SB(0, 0), cB, voffB); PG8_STAGE(PG8_SB(0, 1), cB + hstep, voffB); PG8_STAGE(PG8_SA(0, 0), cA, voffA); PG8_STAGE(PG8_SA(0, 1), cA + hstep, voffA);
    if (wr == 1) PG8_BAR;
    PG8_WAIT_V(2); PG8_BAR;
    PG8_STAGE(PG8_SB(1, 0), cB + kstep, voffB); PG8_STAGE(PG8_SA(1, 0), cA + kstep, voffA); PG8_STAGE(PG8_SB(1, 1), cB + hstep + kstep, voffB);
    PG8_WAIT_V(6); PG8_BAR;
    for (;;) {
        const bool has_next = S.next(ui + 1, nxt);
        const char* nA = has_next ? (const char*)g.A + (size_t)nxt.pm * tstep + nxt.koff : cA; const char* nB = has_next ? (const char*)g.Bt + (size_t)nxt.pn * tstep + nxt.koff : cB;
        const int nt = cur.nt;
        for (int t = 0; t < nt; t += 2) {
            const bool last = (t == nt - 2);
            const char* a1 = cA + (size_t)(t + 1) * kstep;
            const char* a2 = last ? nA : cA + (size_t)(t + 2) * kstep; const char* b2 = last ? nB : cB + (size_t)(t + 2) * kstep;
            const char* a3 = a2 + kstep; const char* b3 = b2 + kstep;
            if (last && has_next) S.a_ready(nxt);
            PG8_LDB(B0, 0, 0); PG8_LDB(B1, 0, 1); PG8_SCHED; PG8_LDA(At, 0, 0); PG8_STAGE(PG8_SA(1, 1), a1 + hstep, voffA);
            PG8_WAIT_V(8); PG8_WAIT_L(0); PG8_BAR; PG8_MMA(0, 0, At, B0); PG8_MMA(0, 1, At, B1); PG8_BAR; PG8_SCHED;
            PG8_LDA(At, 0, 1); PG8_STAGE(PG8_SB(0, 0), b2, voffB); PG8_STAGE(PG8_SB(0, 1), b2 + hstep, voffB); PG8_STAGE(PG8_SA(0, 0), a2, voffA);
            PG8_WAIT_V(8); PG8_WAIT_L(0); PG8_BAR; PG8_MMA(1, 0, At, B0); PG8_MMA(1, 1, At, B1); PG8_BAR; PG8_SCHED;
            PG8_LDB(B0, 1, 0); PG8_LDB(B1, 1, 1); PG8_SCHED; PG8_LDA(At, 1, 0); PG8_STAGE(PG8_SA(0, 1), a2 + hstep, voffA);
            PG8_WAIT_V(8); PG8_WAIT_L(0); PG8_BAR; PG8_MMA(0, 0, At, B0); PG8_MMA(0, 1, At, B1); PG8_BAR; PG8_SCHED;
            PG8_LDA(At, 1, 1); PG8_STAGE(PG8_SB(1, 0), b3, voffB); PG8_STAGE(PG8_SB(1, 1), b3 + hstep, voffB); PG8_STAGE(PG8_SA(1, 0), a3, voffA);
            PG8_WAIT_V(8); PG8_WAIT_L(0); PG8_BAR; PG8_MMA(1, 0, At, B0); PG8_MMA(1, 1, At, B1); PG8_BAR; PG8_SCHED;
        }
        if (wr == 0) PG8_BAR;
        if constexpr (Epi::I8) E.prescale(acc, cur, wr, wc, fr, fq);
        if constexpr (!Epi::AFTER_DRAIN) { E(acc, cur, wr, wc, fr, fq); S.done(cur); }
        if (!has_next) break;
#pragma unroll
        for (int a = 0; a < 2; ++a)
#pragma unroll
            for (int b = 0; b < 2; ++b)
#pragma unroll
                for (int m = 0; m < 4; ++m)
#pragma unroll
                    for (int n = 0; n < 2; ++n) acc[a][b][m][n] = (f32x4){0.f, 0.f, 0.f, 0.f};
        cur = nxt; cA = nA; cB = nB; ++ui;
        if (wr == 1) PG8_BAR;
    }
    PG8_WAIT_V(0);
    PG8_BAR;
    if constexpr (Epi::AFTER_DRAIN) { E.fused(acc, cur, wr, wc, fr, fq, lds, wid, lane); S.done(cur); }
#undef PG8_SA
#undef PG8_SB
#undef PG8_STAGE
#undef PG8_LDA
#undef PG8_LDB
#undef PG8_MMA
#undef PG8_WAIT_V
#undef PG8_WAIT_L
#undef PG8_BAR
#undef PG8_SCHED
}

}

#ifndef INO_I8
#define INO_I8 0
#endif
#ifndef FFO1_I8
#define FFO1_I8 1
#endif
#ifndef FFO0_I8
#define FFO0_I8 1
#endif
#ifndef MIX_I8
#define MIX_I8 0
#endif
#ifndef FFN_I8
#define FFN_I8 1
#endif
struct Args { const float* in[29]; float* out; unsigned char* ws; int ph_lo, ph_hi; };
struct Ctx {
    const float* in[29]; float* out; unsigned char* ws; unsigned char* ar;
    LAS unsigned char* lds;
    int tid, lane, wave;
};
enum { I_X = 0, I_C, I_CTX, I_CCTX, I_WMOD, I_BMOD, I_WINE, I_MU, I_W0, I_W2, I_A0, I_A2, I_G2, I_KK, I_KA, I_RK, I_LNW, I_LNB, I_LAM, I_SUBLN,
       I_WINO, I_SINK, I_RDEC, I_WMIX, I_WFFI, I_CONVW, I_CONVB, I_WFFO, I_FNORM };

__device__ __forceinline__ void p_mod(const Ctx& c) {
    LAS float* sc = (LAS float*)c.lds;
    LAS float* red = sc + 5 * 4096;
    const int tid = c.tid, lane = c.lane, w = c.wave;
    for (int i = tid; i < 5 * 4096; i += NTHREADS) { const int r = i >> 12, k = i & 4095; const float v = r < 4 ? c.in[I_C][r * 4096 + k] : c.in[I_CCTX][k]; sc[i] = silu_f(v); }
    __syncthreads();
    float* MODP = (float*)(c.ar + AR_MODP);
    for (int u = blockIdx.x; u < 768; u += gridDim.x) {
        const int kp = u & 3, cg = (u >> 2) % 96, l = u / 384;
        const int k0 = kp * 1024 + w * 128;
        const float* wp = c.in[I_WMOD] + ((size_t)l * 4096 + k0) * 24576 + cg * 256 + lane * 4;
        f32x4 acc[5];
#pragma unroll
        for (int r = 0; r < 5; ++r) acc[r] = (f32x4){0.f, 0.f, 0.f, 0.f};
#pragma unroll 2
        for (int k = 0; k < 128; k += 4) {
            f32x4 wv[4];
#pragma unroll
            for (int j = 0; j < 4; ++j) wv[j] = __builtin_nontemporal_load((const f32x4*)(wp + (size_t)(k + j) * 24576));
#pragma unroll
            for (int r = 0; r < 5; ++r) { const f32x4 s4 = *(const LAS f32x4*)(sc + r * 4096 + k0 + k);
#pragma unroll
                for (int j = 0; j < 4; ++j) acc[r] += wv[j] * s4[j]; }
        }
#pragma unroll
        for (int r = 0; r < 5; ++r) *(LAS f32x4*)(red + (w * 5 + r) * 256 + lane * 4) = acc[r];
        __syncthreads();
        for (int idx = tid; idx < 5 * 256; idx += NTHREADS) { const int r = idx >> 8, col = idx & 255; float s = 0.f;
#pragma unroll
            for (int q = 0; q < 8; ++q) s += red[(q * 5 + r) * 256 + col];
            if (kp == 0) s += c.in[I_BMOD][l * 24576 + cg * 256 + col];
            MODP[(size_t)kp * MOD_FLOATS + ((size_t)l * 5 + r) * 24576 + cg * 256 + col] = s; }
        __syncthreads();
    }
}

__device__ __forceinline__ void p_mod_finalize(const Ctx& c) {
    const float* MODP = (const float*)(c.ar + AR_MODP); float* MOD = (float*)(c.ws + WS_MOD);
    for (size_t i = ((size_t)blockIdx.x * NTHREADS + c.tid) * 4; i < MOD_FLOATS; i += (size_t)gridDim.x * NTHREADS * 4)
        *(f32x4*)(MOD + i) = (*(const f32x4*)(MODP + i) + *(const f32x4*)(MODP + MOD_FLOATS + i)) + (*(const f32x4*)(MODP + 2 * MOD_FLOATS + i) + *(const f32x4*)(MODP + 3 * MOD_FLOATS + i));
}
DI int perm64(int m) { const int within = m & 255, rho = within & 127; return (m & ~255) + (rho >> 5) * 64 + (within >> 7) * 32 + (rho & 31); }
DI int perm128(int m) { const int within = m & 255, rho = within & 127; return (m & ~255) + (rho >> 6) * 128 + (within >> 7) * 64 + (rho & 63); }
DI int in_odd_src(int n) { return n < 2304 ? perm64(n) : (n < 2560 ? n : (n < 4608 ? 2560 + perm128(n - 2560) : n)); }
__device__ __forceinline__ int p_convert_job(const Ctx& c, const float* __restrict__ src, int src_ld, int K, int n0, int ncnt, bf16_t* __restrict__ dst, int dn0, int base, int nperm = 0) {
    LAS unsigned short* T = (LAS unsigned short*)c.lds;
    const int tid = c.tid, tk = K / 64, tn = ncnt / 128, nt = tk * tn, G = (int)gridDim.x;
    int first = (int)blockIdx.x - (base % G); if (first < 0) first += G;
    const int kr = tid >> 3, c16 = (tid & 7) * 16, wn = tid >> 2, k16 = (tid & 3) * 16;
    f32x4 v[4], vn[4];
    if (first < nt) { const int nn = (first / tk) * 128 + c16; const float* p = src + (size_t)((first % tk) * 64 + kr) * src_ld + n0 + (nn < nperm ? perm64(nn) : nn);
#pragma unroll
        for (int i = 0; i < 4; ++i) v[i] = __builtin_nontemporal_load((const f32x4*)(p + 4 * i)); }
    for (int t = first; t < nt; t += G) {
        const int t2 = t + G;
        if (t2 < nt) { const int nn = (t2 / tk) * 128 + c16; const float* p = src + (size_t)((t2 % tk) * 64 + kr) * src_ld + n0 + (nn < nperm ? perm64(nn) : nn);
#pragma unroll
            for (int i = 0; i < 4; ++i) vn[i] = __builtin_nontemporal_load((const f32x4*)(p + 4 * i)); }
#pragma unroll
        for (int i = 0; i < 4; ++i)
#pragma unroll
            for (int j = 0; j < 4; ++j) T[(c16 + 4 * i + j) * 72 + kr] = f2bf(v[i][j]);
        __syncthreads();
        { const u32x4 a = *(const LAS u32x4*)(T + wn * 72 + k16), b = *(const LAS u32x4*)(T + wn * 72 + k16 + 8);
          bf16_t* q = dst + (size_t)(dn0 + (t / tk) * 128 + wn) * K + (t % tk) * 64 + k16;
          *(u32x4*)q = a; *(u32x4*)(q + 8) = b; }
        __syncthreads();
#pragma unroll
        for (int i = 0; i < 4; ++i) v[i] = vn[i];
    }
    return base + nt;
}
DI void conv_wave_tile(const float* __restrict__ src, int src_ld, int k0, int nsrc, int n0, bf16_t* __restrict__ dst, int K, int lane) {
    float v[32];
    const float* p = src + (size_t)k0 * src_ld + nsrc;
#pragma unroll
    for (int kk = 0; kk < 32; ++kk) v[kk] = __builtin_nontemporal_load(p + (size_t)kk * src_ld);
    bf16_t* q = dst + (size_t)(n0 + lane) * K + k0;
#pragma unroll
    for (int g = 0; g < 4; ++g) { u32x4 w; w.x = pk_bf16(v[8 * g], v[8 * g + 1]); w.y = pk_bf16(v[8 * g + 2], v[8 * g + 3]); w.z = pk_bf16(v[8 * g + 4], v[8 * g + 5]); w.w = pk_bf16(v[8 * g + 6], v[8 * g + 7]);
        *(u32x4*)(q + 8 * g) = w; }
}
DI unsigned pk_i8x4(float a, float b, float c2, float d) { const int ia = (int)rintf(a), ib = (int)rintf(b), ic = (int)rintf(c2), id = (int)rintf(d);
    return ((unsigned)ia & 255u) | (((unsigned)ib & 255u) << 8) | (((unsigned)ic & 255u) << 16) | ((unsigned)id << 24); }
template <class T> DI void fwht32(T (&v)[32]) {
#pragma unroll
    for (int h = 1; h < 32; h <<= 1)
#pragma unroll
        for (int i = 0; i < 32; i += 2 * h)
#pragma unroll
            for (int j = i; j < i + h; ++j) { const T a = v[j], b = v[j + h]; v[j] = a + b; v[j + h] = a - b; }
}
DI unsigned* i8_cmax(const Ctx& c, int off) { return (unsigned*)(c.ws + WS_CTL + CTL_CMAX) + off; }
DI float* i8_cs(const Ctx& c, int off) { return (float*)(c.ws + WS_CS) + off; }
DI void conv_wave_tile_q8(const float* __restrict__ src, int src_ld, int k0, int nsrc, int n0, unsigned char* __restrict__ dst, int K, int lane, const unsigned* cmax, float* cs) {
    float v[32];
    const float* p = src + (size_t)k0 * src_ld + nsrc;
#pragma unroll
    for (int kk = 0; kk < 32; ++kk) v[kk] = __builtin_nontemporal_load(p + (size_t)kk * src_ld);
    const float cm = __uint_as_float(cmax[nsrc]); const float qs = cm > 0.f ? 127.0f / cm : 0.f;
    if (k0 == 0) cs[n0 + lane] = cm * (1.0f / 127.0f);
    fwht32(v);
    unsigned char* q = dst + (size_t)(n0 + lane) * K + k0;
#pragma unroll
    for (int g = 0; g < 2; ++g) { u32x4 w;
#pragma unroll
        for (int j = 0; j < 4; ++j) w[j] = pk_i8x4(v[16 * g + 4 * j] * 0.03125f * qs, v[16 * g + 4 * j + 1] * 0.03125f * qs, v[16 * g + 4 * j + 2] * 0.03125f * qs, v[16 * g + 4 * j + 3] * 0.03125f * qs);
        *(u32x4*)(q + 16 * g) = w; }
}
struct CmxDeal { int worker, nworkers, lo, hi; };
__device__ __forceinline__ int p_wcolmax_job(const Ctx& c, const float* __restrict__ src0, int ld, int K, unsigned* cmax, int base, const CmxDeal dl) {
    LAS float* red = (LAS float*)c.lds;
    const int ncg = (ld + 255) / 256, nko = (K + 1023) / 1024, nitem = ncg * nko;
    int g0 = dl.lo + dl.worker; if (g0 < base) g0 += ((base - g0 + dl.nworkers - 1) / dl.nworkers) * dl.nworkers;
    const int gend = dl.hi < base + nitem ? dl.hi : base + nitem;
#pragma unroll 1
    for (int g = g0; g < gend; g += dl.nworkers) { const int it = g - base;
        const int cg = it % ncg, ko = it / ncg, col = cg * 256 + c.lane * 4;
        f32x4 mx = {0.f, 0.f, 0.f, 0.f};
        if (col < ld && ko * 1024 + c.wave * 128 < K) {
#pragma unroll 1
            for (int t = 0; t < 4; ++t) {
                f32x4 v[32]; const float* p = src0 + (size_t)(ko * 1024 + c.wave * 128 + t * 32) * ld + col;
#pragma unroll
                for (int kk = 0; kk < 32; ++kk) v[kk] = __builtin_nontemporal_load((const f32x4*)(p + (size_t)kk * ld));
                fwht32(v);
#pragma unroll
                for (int kk = 0; kk < 32; ++kk)
#pragma unroll
                    for (int j = 0; j < 4; ++j) mx[j] = fmaxf(mx[j], fabsf(v[kk][j]));
            }
        }
        *(LAS f32x4*)(red + c.wave * 256 + c.lane * 4) = mx;
        __syncthreads();
        if (c.tid < 256) { float m = red[c.tid];
#pragma unroll
            for (int w = 1; w < 8; ++w) m = fmaxf(m, red[w * 256 + c.tid]);
            const int cc = cg * 256 + c.tid; if (cc < ld) atomicMax(cmax + cc, __float_as_uint(m * 0.03125f)); }
        __syncthreads();
    }
    return base + nitem;
}
constexpr int CMX_TOTAL = (FFN_I8 ? 2 * (2 * DFF / 256) * (D / 1024) : 0) + (INO_I8 ? (NO / 256) * (D / 1024) : 0) + ((FFO0_I8 ? 1 : 0) + (FFO1_I8 ? 1 : 0)) * (D / 256) * ((DFF + 1023) / 1024) + (MIX_I8 ? 2 * (D / 256) * (D / 1024) : 0);
__device__ __forceinline__ void p_wcolmax(const Ctx& c, const CmxDeal dl) {
    int base = 0;
    __syncthreads();
    if (FFN_I8) { base = p_wcolmax_job(c, c.in[I_WFFI], 2 * DFF, D, i8_cmax(c, CM_FFI), base, dl); base = p_wcolmax_job(c, c.in[I_WFFI] + (size_t)D * 2 * DFF, 2 * DFF, D, i8_cmax(c, CM_FFI + 2 * DFF), base, dl); }
    if (INO_I8) base = p_wcolmax_job(c, c.in[I_WINO], NO, D, i8_cmax(c, CM_INO), base, dl);
    if (FFO0_I8) base = p_wcolmax_job(c, c.in[I_WFFO], D, DFF, i8_cmax(c, CM_FFO0), base, dl);
    if (FFO1_I8) base = p_wcolmax_job(c, c.in[I_WFFO] + (size_t)DFF * D, D, DFF, i8_cmax(c, CM_FFO1), base, dl);
    if (MIX_I8) { base = p_wcolmax_job(c, c.in[I_WMIX], D, D, i8_cmax(c, CM_MIX), base, dl); base = p_wcolmax_job(c, c.in[I_WMIX] + (size_t)D * D, D, D, i8_cmax(c, CM_MIX + D), base, dl); }
}
#ifndef CMX_P0
#define CMX_P0 624
#endif
DI int cmx_ns(int G) { return G == 256 ? 8 : 0; }
DI int cmx_p0(int G) { return cmx_ns(G) ? (CMX_P0 < CMX_TOTAL ? CMX_P0 : CMX_TOTAL) : CMX_TOTAL; }
__device__ __forceinline__ void p_weights_layer0(const Ctx& c) {
    bf16_t* W = (bf16_t*)(c.ws + WS_W);
    {   constexpr int T_IN = (4096 / 32) * ((COLS_A + COLS_B) / 64), T_MIX = (4096 / 32) * (4096 / 64), T_L96 = 3 * (2048 / 64), T_LG = 8 * (2048 / 64);
        constexpr int E0 = T_IN, E1 = E0, E2 = E1 + 4 * T_L96, E3 = E2 + T_LG;
        bf16_t* L = (bf16_t*)((unsigned char*)W + W_LORA);
        for (int t = blockIdx.x * 8 + c.wave; t < E3; t += gridDim.x * 8) {
            if (t < E0) { const int kt = t & 127, g = t >> 7, n = g * 64 + c.lane;
                const int nsrc = n < COLS_A ? n : COLS_A + (n - COLS_A < 4096 ? perm64(n - COLS_A) : n - COLS_A);
                conv_wave_tile(c.in[I_WINE], COLS_A + COLS_B, kt * 32, nsrc, n < COLS_A ? g * 64 : g * 64 + (COLS_A_PAD - COLS_A), (bf16_t*)((unsigned char*)W + W_IN), 4096, c.lane); }
            else if (t < E1) { const int tl = t - E0, kt = tl & 127, g = tl >> 7;
                conv_wave_tile(c.in[I_WMIX], 4096, kt * 32, g * 64 + c.lane, g * 64, (bf16_t*)((unsigned char*)W + W_MIX), 4096, c.lane); }
            else if (t < E2) { const int tl = t - E1, type = tl / T_L96, r2 = tl % T_L96, kt = r2 % 3, g = r2 / 3;
                const float* src = (type < 2 ? c.in[I_W2] + (size_t)type * 96 * 2048 : c.in[I_A2] + (size_t)(type - 2) * 96 * 2048);
                conv_wave_tile(src, 2048, kt * 32, g * 64 + c.lane, g * 64, L + (size_t)type * 2048 * LORA_K + type * LORA_KU, LORA_K, c.lane); }
            else { const int tl = t - E2, kt = tl & 7, g = tl >> 3;
                conv_wave_tile(c.in[I_G2], 2048, kt * 32, g * 64 + c.lane, g * 64, L + (size_t)4 * 2048 * LORA_K + 4 * LORA_KU, LORA_K, c.lane); }
        }
    }
    const size_t gtid = (size_t)blockIdx.x * NTHREADS + c.tid, gn = (size_t)gridDim.x * NTHREADS;
    { u32x4* z = (u32x4*)((unsigned char*)W + W_IN + (size_t)COLS_A * 4096 * 2); const size_t n16 = (size_t)(COLS_A_PAD - COLS_A) * 4096 * 2 / 16;
      for (size_t i = gtid; i < n16; i += gn) z[i] = (u32x4){0u, 0u, 0u, 0u}; }
    { bf16_t* L = (bf16_t*)((unsigned char*)W + W_LORA);
      for (size_t i = gtid; i < (size_t)4 * 2048 * 20; i += gn) { const int n = (int)(i / 20), ch = (int)(i % 20), type = n >> 11;
          *(u32x4*)(L + (size_t)n * LORA_K + type * LORA_KU + 96 + ch * 8) = (u32x4){0u, 0u, 0u, 0u}; } }
    { float* axc = (float*)(c.ws + WS_AXC); float* axs = (float*)(c.ws + WS_AXS);
      for (size_t i = gtid; i < (size_t)SEQ * 32; i += gn) { const int pos = (int)(i >> 5), a = (int)(i & 31), q = a & 15;
          const float inv = powf(10000.0f, -(float)q / 16.0f); const float p = (a < 16) ? (float)(pos >> 6) : (float)(pos & 63);
          float sn, cs; sincosf(p * inv, &sn, &cs); axc[i] = cs; axs[i] = sn; } }
    { float* rtc = (float*)(c.ws + WS_RTC); float* rts = (float*)(c.ws + WS_RTS);
      for (size_t i = gtid; i < (size_t)NKEY * 64; i += gn) { const int pos = (int)(i >> 6), a = (int)(i & 63);
          const float t = (float)a / 63.0f; const float inv = powf(10000.0f, -t);
          float sn, cs; sincosf((float)pos * inv, &sn, &cs); rtc[i] = cs; rts[i] = sn; } }
    if (gtid == 0) { const float* lv = c.in[I_LAM]; float s01 = 0.f, s23 = 0.f;
        for (int i = 0; i < 64; ++i) { s01 += lv[i] * lv[64 + i]; s23 += lv[128 + i] * lv[192 + i]; }
        ((float*)(c.ws + WS_SCAL))[0] = expf(s01) - expf(s23) + 0.2f; }
}
constexpr int CONV_SPLIT = 152000;
__device__ __forceinline__ void p_convert_deferred(const Ctx& c, int worker, int nworkers, int tlo, int thi) {
    unsigned char* W = c.ws + WS_W; unsigned char* W1 = c.ws + WS_W1;
    constexpr int T_FFI = (4096 / 32) * (2 * DFF / 64), T_FFO = (DFF / 32) * (4096 / 64), T_IN1 = (4096 / 32) * (NO / 64), T_MIX = (4096 / 32) * (4096 / 64);
    constexpr int EM = T_MIX, E0 = EM + T_FFI, E1 = E0 + T_FFO, E2 = E1 + T_IN1, E3 = E2 + T_MIX, E4 = E3 + T_FFI, E5 = E4 + T_FFO;
    const int tend = thi < E5 ? thi : E5;
    for (int t = tlo + worker; t < tend; t += nworkers) {
        const float* src; int ld, K, tl; bf16_t* dst; int mixl = -1;
        if (t < EM) { src = c.in[I_WMIX]; ld = 4096; K = 4096; tl = t; dst = (bf16_t*)(W + W_MIX); mixl = 0; }
        else if (t < E0) { src = c.in[I_WFFI]; ld = 2 * DFF; K = 4096; tl = t - EM; dst = (bf16_t*)(W + W_FFI); }
        else if (t < E1) { src = c.in[I_WFFO]; ld = 4096; K = DFF; tl = t - E0; dst = (bf16_t*)(W + W_FFO); mixl = 3; }
        else if (t < E2) { src = c.in[I_WINO]; ld = NO; K = 4096; tl = t - E1; dst = (bf16_t*)(W + W_IN); }
        else if (t < E3) { src = c.in[I_WMIX] + (size_t)4096 * 4096; ld = 4096; K = 4096; tl = t - E2; dst = (bf16_t*)(W1 + W1_MIX); mixl = 1; }
        else if (t < E4) { src = c.in[I_WFFI] + (size_t)4096 * 2 * DFF; ld = 2 * DFF; K = 4096; tl = t - E3; dst = (bf16_t*)(W1 + W1_FFI); }
        else { src = c.in[I_WFFO] + (size_t)DFF * 4096; ld = 4096; K = DFF; tl = t - E4; dst = (bf16_t*)(W1 + W1_FFO); mixl = 2; }
        const int tk = K / 32, kt = tl % tk, ntile = tl / tk;
        int ncol = ntile * 64;
        if (ld == 2 * DFF) { const int tile = ncol >> 8, within = ncol & 255; ncol = within < 128 ? 128 * tile + within : DFF + 128 * tile + (within - 128); }
        const int nsrc = (ld == NO) ? in_odd_src(ntile * 64 + c.lane) : ncol + c.lane;
        if (FFN_I8 && ld == 2 * DFF) { const int off = CM_FFI + (t < E0 ? 0 : 2 * DFF); conv_wave_tile_q8(src, ld, kt * 32, nsrc, ntile * 64, (unsigned char*)dst, K, c.lane, i8_cmax(c, off), i8_cs(c, off)); }
        else if (FFO0_I8 && mixl == 3) conv_wave_tile_q8(src, ld, kt * 32, nsrc, ntile * 64, (unsigned char*)dst, K, c.lane, i8_cmax(c, CM_FFO0), i8_cs(c, CM_FFO0));
        else if (FFO1_I8 && mixl == 2) conv_wave_tile_q8(src, ld, kt * 32, nsrc, ntile * 64, (unsigned char*)dst, K, c.lane, i8_cmax(c, CM_FFO1), i8_cs(c, CM_FFO1));
        else if (MIX_I8 && mixl >= 0 && mixl < 2) conv_wave_tile_q8(src, ld, kt * 32, nsrc, ntile * 64, (unsigned char*)dst, K, c.lane, i8_cmax(c, CM_MIX + mixl * D), i8_cs(c, CM_MIX + mixl * D));
        else if (INO_I8 && ld == NO) conv_wave_tile_q8(src, ld, kt * 32, nsrc, ntile * 64, (unsigned char*)dst, K, c.lane, i8_cmax(c, CM_INO), i8_cs(c, CM_INO));
        else conv_wave_tile(src, ld, kt * 32, nsrc, ntile * 64, dst, K, c.lane);
    }
}

template <class TS>
__device__ __forceinline__ void p_ctx_fix(const Ctx& c, const TS* srcc, const float* gate, const float* slab, res_t* H) {
    for (int row = blockIdx.x * 8 + c.wave; row < TT; row += gridDim.x * 8) {
        if (row < TL) continue;
        const size_t ro = (size_t)(row - TL) * D;
#pragma unroll 4
        for (int i = 0; i < 16; ++i) { const int col = i * 256 + c.lane * 4;
            const f32x4 s4 = (*(const f32x4*)(slab + ro + col) + *(const f32x4*)(slab + (size_t)TC * D + ro + col)) + (*(const f32x4*)(slab + (size_t)2 * TC * D + ro + col) + *(const f32x4*)(slab + (size_t)3 * TC * D + ro + col));
            st4(H + (size_t)row * D + col, ld4(srcc + ro + col) + *(const f32x4*)(gate + col) * s4); }
    }
}
template <int NPARTS = 1, bool Q8 = false, class TS = float>
__device__ __forceinline__ void p_norm_mod(const Ctx& c, const TS* hl, const TS* hc, int nrows, const float* mod, int shift_chunk, int scale_chunk) {
    bf16_t* XN = (bf16_t*)(c.ws + WS_XN);
    for (int row = blockIdx.x * 8 + c.wave; row < nrows; row += gridDim.x * 8) {
        const TS* src = row < TL ? hl + (size_t)row * D : hc + (size_t)(row - TL) * D;
        f32x4 v[16]; float ss = 0.f;
#pragma unroll
        for (int i = 0; i < 16; ++i) { v[i] = ld4(src + i * 256 + c.lane * 4); ss += v[i][0] * v[i][0] + v[i][1] * v[i][1] + v[i][2] * v[i][2] + v[i][3] * v[i][3]; }
        ss = wave_sum(ss);
        const float rs = rsqrtf(ss * (1.0f / 4096.0f) + 1e-6f);
        const float* mp = mod + (size_t)row_modidx(row) * 24576;
        bf16_t* dst = XN + (size_t)row * D;
        if constexpr (Q8) {
            float mx = 0.f;
#pragma unroll
            for (int i = 0; i < 16; ++i) { const int col = i * 256 + c.lane * 4;
                const f32x4 sh = *(const f32x4*)(mp + shift_chunk * 4096 + col), sc = *(const f32x4*)(mp + scale_chunk * 4096 + col);
#pragma unroll
                for (int j = 0; j < 4; ++j) v[i][j] = v[i][j] * rs * (1.f + sc[j]) + sh[j];
                { const float a0 = v[i][0] + v[i][1], a1 = v[i][0] - v[i][1], a2 = v[i][2] + v[i][3], a3 = v[i][2] - v[i][3];
                  v[i][0] = a0 + a2; v[i][1] = a1 + a3; v[i][2] = a0 - a2; v[i][3] = a1 - a3; }
#pragma unroll
                for (int j = 0; j < 4; ++j) { float x = v[i][j];
                    { const float t = __int_as_float(__builtin_amdgcn_update_dpp(0, __float_as_int(x), 0xB1, 0xF, 0xF, false)); x = (c.lane & 1) ? t - x : x + t; }
                    { const float t = __int_as_float(__builtin_amdgcn_update_dpp(0, __float_as_int(x), 0x4E, 0xF, 0xF, false)); x = (c.lane & 2) ? t - x : x + t; }
                    { const float t = __int_as_float(__builtin_amdgcn_ds_swizzle(__float_as_int(x), 0x101F)); x = (c.lane & 4) ? t - x : x + t; }
                    v[i][j] = x; mx = fmaxf(mx, fabsf(x)); } }
#pragma unroll
            for (int o = 32; o >= 1; o >>= 1) mx = fmaxf(mx, __shfl_xor(mx, o));
            const float qs = mx > 0.f ? 127.0f / mx : 0.f;
            unsigned char* d8 = (unsigned char*)XN + (size_t)row * D;
#pragma unroll
            for (int i = 0; i < 16; ++i) *(unsigned*)(d8 + i * 256 + c.lane * 4) = pk_i8x4(v[i][0] * qs, v[i][1] * qs, v[i][2] * qs, v[i][3] * qs);
            if (c.lane == 0) ((float*)(c.ws + WS_XN + (size_t)TT * D))[row] = mx * (1.0f / 127.0f);
            continue;
        }
#pragma unroll
        for (int i = 0; i < 16; ++i) { const int col = i * 256 + c.lane * 4;
            f32x4 sh = *(const f32x4*)(mp + shift_chunk * 4096 + col), sc = *(const f32x4*)(mp + scale_chunk * 4096 + col);
            if constexpr (NPARTS == 4) {
                sh = (sh + *(const f32x4*)(mp + MOD_FLOATS + shift_chunk * 4096 + col)) + (*(const f32x4*)(mp + 2 * MOD_FLOATS + shift_chunk * 4096 + col) + *(const f32x4*)(mp + 3 * MOD_FLOATS + shift_chunk * 4096 + col));
                sc = (sc + *(const f32x4*)(mp + MOD_FLOATS + scale_chunk * 4096 + col)) + (*(const f32x4*)(mp + 2 * MOD_FLOATS + scale_chunk * 4096 + col) + *(const f32x4*)(mp + 3 * MOD_FLOATS + scale_chunk * 4096 + col)); }
            u32x2 w; w.x = pk_bf16(v[i][0] * rs * (1.f + sc[0]) + sh[0], v[i][1] * rs * (1.f + sc[1]) + sh[1]);
            w.y = pk_bf16(v[i][2] * rs * (1.f + sc[2]) + sh[2], v[i][3] * rs * (1.f + sc[3]) + sh[3]);
            *(u32x2*)(dst + col) = w; }
    }
}
__device__ __forceinline__ void p_final_norm(const Ctx& c) {
    const res_t* H = (const res_t*)(c.ws + WS_H);
    for (int row = blockIdx.x * 8 + c.wave; row < TL; row += gridDim.x * 8) {
        const res_t* src = H + (size_t)row * D;
        f32x4 v[16]; float ss = 0.f;
#pragma unroll
        for (int i = 0; i < 16; ++i) { v[i] = ld4(src + i * 256 + c.lane * 4); ss += v[i][0] * v[i][0] + v[i][1] * v[i][1] + v[i][2] * v[i][2] + v[i][3] * v[i][3]; }
        ss = wave_sum(ss);
        const float rs = rsqrtf(ss * (1.0f / 4096.0f) + 1e-6f);
        float* dst = c.out + (size_t)row * D;
#pragma unroll
        for (int i = 0; i < 16; ++i) { const int col = i * 256 + c.lane * 4; const f32x4 g = *(const f32x4*)(c.in[I_FNORM] + col);
            *(f32x4*)(dst + col) = v[i] * rs * g; }
    }
}

DI void rope_store(const f32x4 (&acc)[2][2][4][2], int ai, int m, const float* tc, const float* ts, bool rot, float scale, bf16_t* o1p, bf16_t* o2p) {
    float o1[8], o2[8];
#pragma unroll
    for (int n = 0; n < 2; ++n) { f32x4 cs = {1.f, 1.f, 1.f, 1.f}, sn = {0.f, 0.f, 0.f, 0.f};
        if (rot) { cs = *(const f32x4*)(tc + 4 * n); sn = *(const f32x4*)(ts + 4 * n); }
#pragma unroll
        for (int e = 0; e < 4; ++e) { const float x1 = acc[ai][0][m][n][e], x2 = acc[ai][1][m][n][e];
            o1[4 * n + e] = (x1 * cs[e] - x2 * sn[e]) * scale; o2[4 * n + e] = (x2 * cs[e] + x1 * sn[e]) * scale; } }
    u32x4 w1, w2; w1.x = pk_bf16(o1[0], o1[1]); w1.y = pk_bf16(o1[2], o1[3]); w1.z = pk_bf16(o1[4], o1[5]); w1.w = pk_bf16(o1[6], o1[7]);
    w2.x = pk_bf16(o2[0], o2[1]); w2.y = pk_bf16(o2[2], o2[3]); w2.z = pk_bf16(o2[4], o2[5]); w2.w = pk_bf16(o2[6], o2[7]);
    *(u32x4*)o1p = w1; *(u32x4*)o2p = w2;
}
DI void plain_store(const f32x4 (&acc)[2][2][4][2], int ai, int m, bf16_t* rowp) {
#pragma unroll
    for (int bj = 0; bj < 2; ++bj) { const f32x4 v0 = acc[ai][bj][m][0], v1 = acc[ai][bj][m][1];
        u32x4 w; w.x = pk_bf16(v0[0], v0[1]); w.y = pk_bf16(v0[2], v0[3]); w.z = pk_bf16(v1[0], v1[1]); w.w = pk_bf16(v1[2], v1[3]);
        *(u32x4*)(rowp + bj * 128) = w; }
}
DI void i8_prescale(f32x4 (&acc)[2][2][4][2], const float* SA, const float* CS, const pg8::Unit& u, int wr, int wc, int fr, int fq) {
    f32x4 cs[2][2];
#pragma unroll
    for (int bj = 0; bj < 2; ++bj)
#pragma unroll
        for (int n = 0; n < 2; ++n) cs[bj][n] = *(const f32x4*)(CS + u.pn * 256 + bj * 128 + wc * 32 + 8 * fq + 4 * n);
#pragma unroll
    for (int ai = 0; ai < 2; ++ai)
#pragma unroll
        for (int m = 0; m < 4; ++m) { const float s = SA[u.pm * 256 + ai * 128 + wr * 64 + 16 * m + fr];
#pragma unroll
            for (int bj = 0; bj < 2; ++bj)
#pragma unroll
                for (int n = 0; n < 2; ++n)
#pragma unroll
                    for (int e = 0; e < 4; ++e) acc[ai][bj][m][n][e] = (float)__float_as_int(acc[ai][bj][m][n][e]) * (s * cs[bj][n][e]); }
}
DI void i8_prescale_np(f32x4 (&acc)[2][2][4][2], const float* SA, const float* CS, const pg8::Unit& u, int wr, int wc, int fr, int fq) {
    f32x4 cs[2][2];
#pragma unroll
    for (int bj = 0; bj < 2; ++bj)
#pragma unroll
        for (int n = 0; n < 2; ++n) cs[bj][n] = *(const f32x4*)(CS + u.pn * 256 + wc * 32 + 4 * fq + bj * 128 + n * 16);
#pragma unroll
    for (int ai = 0; ai < 2; ++ai)
#pragma unroll
        for (int m = 0; m < 4; ++m) { const float s = SA[u.pm * 256 + ai * 128 + wr * 64 + 16 * m + fr];
#pragma unroll
            for (int bj = 0; bj < 2; ++bj)
#pragma unroll
                for (int n = 0; n < 2; ++n)
#pragma unroll
                    for (int e = 0; e < 4; ++e) acc[ai][bj][m][n][e] = (float)__float_as_int(acc[ai][bj][m][n][e]) * (s * cs[bj][n][e]); }
}
struct EpiInEven {
    static constexpr bool PERM = true, AFTER_DRAIN = false, I8 = false;
    bf16_t* PA; bf16_t* PB; const float* axc; const float* axs;
    DI void operator()(const f32x4 (&acc)[2][2][4][2], const pg8::Unit& u, int wr, int wc, int fr, int fq) const {
        const int row0 = u.pm * 256 + wr * 64 + fr, tq = u.pn - COLS_A_PAD / 256;
#pragma unroll
        for (int ai = 0; ai < 2; ++ai)
#pragma unroll
            for (int m = 0; m < 4; ++m) { const int row = row0 + ai * 128 + m * 16;
                if (tq < 0) plain_store(acc, ai, m, PA + (size_t)row * COLS_A_PAD + u.pn * 256 + wc * 32 + 8 * fq);
                else if (tq >= 16) plain_store(acc, ai, m, PB + (size_t)row * COLS_B + tq * 256 + wc * 32 + 8 * fq);
                else { const int pos = row & 4095; bf16_t* o = PB + (size_t)row * COLS_B + tq * 256 + wc * 64 + 8 * fq;
                    rope_store(acc, ai, m, axc + pos * 32 + 8 * fq, axs + pos * 32 + 8 * fq, row < TL, tq < 8 ? 0.18033688011112042f : 1.0f, o, o + 32); } }
    }
};
struct EpiInOdd {
    static constexpr bool PERM = true, AFTER_DRAIN = false, I8 = (INO_I8 != 0);
    bf16_t* P1; const float* axc; const float* axs; const float* rtc; const float* rts; const float* SA; const float* CS;
    DI void prescale(f32x4 (&acc)[2][2][4][2], const pg8::Unit& u, int wr, int wc, int fr, int fq) const { i8_prescale(acc, SA, CS, u, wr, wc, fr, fq); }
    DI void operator()(const f32x4 (&acc)[2][2][4][2], const pg8::Unit& u, int wr, int wc, int fr, int fq) const {
        const int row0 = u.pm * 256 + wr * 64 + fr, pn = u.pn;
#pragma unroll
        for (int ai = 0; ai < 2; ++ai)
#pragma unroll
            for (int m = 0; m < 4; ++m) { const int row = row0 + ai * 128 + m * 16; const bool lat = row < TL; const int pos = lat ? (row & 4095) : ((row - TL) & 255);
                if (pn < 9) { bf16_t* o = P1 + (size_t)row * NO + pn * 256 + wc * 64 + 8 * fq;
                    rope_store(acc, ai, m, axc + pos * 32 + 8 * fq, axs + pos * 32 + 8 * fq, lat, pn < 8 ? 0.18033688011112042f : 1.0f, o, o + 32); }
                else if (pn >= 10 && pn < 18) { const int rp = lat ? CTXL + pos : pos, i0 = 32 * (wc & 1) + 8 * fq; bf16_t* o = P1 + (size_t)row * NO + pn * 256 + (wc >> 1) * 128 + i0;
                    rope_store(acc, ai, m, rtc + rp * 64 + i0, rts + rp * 64 + i0, true, pn < 14 ? 0.08838834764831845f : 1.0f, o, o + 64); }
                else plain_store(acc, ai, m, P1 + (size_t)row * NO + pn * 256 + wc * 32 + 8 * fq); }
    }
};
struct CtxSplitOrder {
    int G, c, nNn, ntk;
    __device__ void init(int N, int G_, int c_, int K_) { G = G_; c = c_; nNn = N / 256; ntk = K_ / 64; }
    __device__ bool next(int i, pg8::Unit& u) const {
        const long L = (long)i * G + c; if (L >= 4 * nNn * 4) return false;
        const int j = (int)L, part = j & 3, tile = j >> 2; u.pm = 64 + (tile & 3); u.pn = tile >> 2; u.part = part;
        const int s0 = 2 * ((part * ntk) / 8), s1 = 2 * (((part + 1) * ntk) / 8); u.koff = s0 * 128; u.nt = s1 - s0; return true; }
    __device__ __forceinline__ void a_ready(const pg8::Unit&) const {}
    __device__ __forceinline__ void done(const pg8::Unit&) const {}
};
template <bool Q8>
struct EpiSlabT {
    static constexpr bool PERM = false, AFTER_DRAIN = false, I8 = Q8;
    float* slab; const float* SA; const float* CS;
    DI void prescale(f32x4 (&acc)[2][2][4][2], const pg8::Unit& u, int wr, int wc, int fr, int fq) const { i8_prescale_np(acc, SA, CS, u, wr, wc, fr, fq); }
    DI void operator()(const f32x4 (&acc)[2][2][4][2], const pg8::Unit& u, int wr, int wc, int fr, int fq) const {
        const int row0 = u.pm * 256 + wr * 64 + fr, col0 = u.pn * 256 + wc * 32 + 4 * fq;
        float* sb = slab + ((size_t)u.part * TC + (row0 - TL)) * D + col0;
#pragma unroll
        for (int ai = 0; ai < 2; ++ai)
#pragma unroll
            for (int m = 0; m < 4; ++m)
#pragma unroll
                for (int bj = 0; bj < 2; ++bj)
#pragma unroll
                    for (int n = 0; n < 2; ++n) *(f32x4*)(sb + (size_t)(ai * 128 + m * 16) * D + bj * 128 + n * 16) = acc[ai][bj][m][n];
    }
};
struct LatThenCtxOrder : pg8::StaticOrder {
    int nNn;
    __device__ void init2(int N, int G_, int c_, int K_) { init(TL, N, G_, c_, K_); nNn = N / 256; }
    __device__ bool next(int i, pg8::Unit& u) const {
        const long L = (long)i * G + c; if (L < nwg) return pg8::StaticOrder::next(i, u);
        const int j = (int)(L - nwg); if (j >= 4 * nNn) return false;
        u.pm = 64 + (j & 3); u.pn = j >> 2; u.koff = 0; u.nt = ntk; u.part = -1; return true; }
};
struct LoraOrder : LatThenCtxOrder {
    __device__ bool next(int i, pg8::Unit& u) const { if (!LatThenCtxOrder::next(i, u)) return false; u.koff = (u.pn >> 3) * (LORA_KU * 2); u.nt = LORA_KU / 64; return true; }
};
struct OddInOrder : pg8::StaticOrder {
    __device__ void init2(int G_, int c_, int K_) { init(TL, NO, G_, c_, K_); }
    __device__ bool next(int i, pg8::Unit& u) const {
        const long L = (long)i * G + c; if (L < nwg) return pg8::StaticOrder::next(i, u);
        const int j = (int)(L - nwg); if (j >= 4 * 14) return false;
        const int idx = j >> 2; u.pm = 64 + (j & 3); u.pn = idx < 2 ? 8 + idx : 12 + idx; u.koff = 0; u.nt = ntk; u.part = -1; return true; }
};
template <bool Q8, class TS = res_t>
struct EpiResModT {
    static constexpr bool PERM = true, AFTER_DRAIN = false, I8 = Q8;
    const TS* Rlat; const TS* Rctx; res_t* Hout; const float* mod;
    const float* SA; const float* CS;
    DI void prescale(f32x4 (&acc)[2][2][4][2], const pg8::Unit& u, int wr, int wc, int fr, int fq) const { i8_prescale(acc, SA, CS, u, wr, wc, fr, fq); }
    DI void operator()(const f32x4 (&acc)[2][2][4][2], const pg8::Unit& u, int wr, int wc, int fr, int fq) const {
        const int row0 = u.pm * 256 + wr * 64 + fr, col0 = u.pn * 256 + wc * 32 + 8 * fq;
        const float* mp = mod + (size_t)(u.pm < 64 ? (u.pm >> 4) : 4) * 24576 + col0;
        f32x4 mv[2][2];
#pragma unroll
        for (int bj = 0; bj < 2; ++bj)
#pragma unroll
            for (int n = 0; n < 2; ++n) mv[bj][n] = *(const f32x4*)(mp + bj * 128 + n * 4);
        const TS* sbase = (u.pm < 64) ? Rlat + (size_t)row0 * D : Rctx + (size_t)(row0 - TL) * D;
        res_t* dbase = Hout + (size_t)row0 * D;
#pragma unroll
        for (int ai = 0; ai < 2; ++ai)
#pragma unroll
            for (int m = 0; m < 4; ++m) { const size_t ro = (size_t)(ai * 128 + m * 16) * D + col0;
#pragma unroll
                for (int bj = 0; bj < 2; ++bj) { f32x4 r0, r1; ld8(sbase + ro + bj * 128, r0, r1);
                    st8(dbase + ro + bj * 128, r0 + mv[bj][0] * acc[ai][bj][m][0], r1 + mv[bj][1] * acc[ai][bj][m][1]); } }
    }
};

typedef EpiResModT<false, res_t> EpiResMod;
typedef EpiSlabT<false> EpiSlab;
struct EpiConvGlu {
    static constexpr bool PERM = true, AFTER_DRAIN = false, I8 = (FFN_I8 != 0);
    bf16_t* HID; bf16_t* SG; bf16_t* SU; const float* cw; const float* cb; const float* SA; const float* CS;
    DI void prescale(f32x4 (&acc)[2][2][4][2], const pg8::Unit& u, int wr, int wc, int fr, int fq) const { i8_prescale(acc, SA, CS, u, wr, wc, fr, fq); }
    DI void operator()(const f32x4 (&acc)[2][2][4][2], const pg8::Unit& u, int wr, int wc, int fr, int fq) const {
        const int col = u.pn * 128 + wc * 32 + 8 * fq;
#pragma unroll
        for (int ai = 0; ai < 2; ++ai) {
            const int rowb = u.pm * 256 + ai * 128 + wr * 64;
#pragma unroll
            for (int n = 0; n < 2; ++n) {
                const f32x4 w0 = *(const f32x4*)(cw + col + 4 * n), w1 = *(const f32x4*)(cw + DFF + col + 4 * n), w2 = *(const f32x4*)(cw + 2 * DFF + col + 4 * n), bb = *(const f32x4*)(cb + col + 4 * n);
                unsigned outp[4][2];
#pragma unroll
                for (int ep = 0; ep < 2; ++ep) { float o[4][2];
#pragma unroll
                    for (int e2 = 0; e2 < 2; ++e2) { const int e = 2 * ep + e2; float P[4], N[4];
#pragma unroll
                        for (int m = 0; m < 4; ++m) { const int vi = __float_as_int(acc[ai][0][m][n][e]);
                            P[m] = __int_as_float(__builtin_amdgcn_update_dpp(0, vi, 0x121, 0xF, 0xF, false)); N[m] = __int_as_float(__builtin_amdgcn_update_dpp(0, vi, 0x12F, 0xF, 0xF, false)); }
#pragma unroll
                        for (int m = 0; m < 4; ++m) { const float prev = fr > 0 ? P[m] : (m > 0 ? P[m - 1] : 0.f), next = fr < 15 ? N[m] : (m < 3 ? N[m + 1] : 0.f);
                            const float x = w0[e] * prev + w1[e] * acc[ai][0][m][n][e] + w2[e] * next + bb[e];
                            o[m][e2] = silu_f(x) * acc[ai][1][m][n][e]; } }
#pragma unroll
                    for (int m = 0; m < 4; ++m) outp[m][ep] = pk_bf16(o[m][0], o[m][1]); }
#pragma unroll
                for (int m = 0; m < 4; ++m) { const int rho = 16 * m + fr, row = rowb + rho;
                    if (rho != 0 && rho != 63) { u32x2 w = {outp[m][0], outp[m][1]}; *(u32x2*)(HID + (size_t)row * DFF + col + 4 * n) = w; }
                    if (m == 0 || m == 3) { if (rho <= 1 || rho >= 62) { const int slot = rho <= 1 ? rho : rho - 60;
                            u32x2 g; g.x = pk_bf16(acc[ai][0][m][n][0], acc[ai][0][m][n][1]); g.y = pk_bf16(acc[ai][0][m][n][2], acc[ai][0][m][n][3]);
                            *(u32x2*)(SG + ((size_t)(row >> 6) * 4 + slot) * DFF + col + 4 * n) = g;
                            if (rho == 0 || rho == 63) { u32x2 q; q.x = pk_bf16(acc[ai][1][m][n][0], acc[ai][1][m][n][1]); q.y = pk_bf16(acc[ai][1][m][n][2], acc[ai][1][m][n][3]);
                                *(u32x2*)(SU + ((size_t)(row >> 6) * 2 + (rho == 63 ? 1 : 0)) * DFF + col + 4 * n) = q; } } }
                }
            }
        }
    }
};
__device__ __forceinline__ void p_conv_fix(const Ctx& c, int l, int nrows) {
    const bf16_t* SG = (const bf16_t*)(c.ar + AR_SG); const bf16_t* SU = (const bf16_t*)(c.ar + AR_SU); bf16_t* HID = (bf16_t*)(c.ar + AR_HID);
    const float* cw = c.in[I_CONVW] + (size_t)l * 3 * DFF; const float* cb = c.in[I_CONVB] + (size_t)l * DFF;
    const int nitems = (nrows / 64) * 2 * 22;
    const u32x4 z4 = {0u, 0u, 0u, 0u};
    for (int item = blockIdx.x * 8 + c.wave; item < nitems; item += gridDim.x * 8) {
        const int ch = item % 22, kw = item / 22, kb = kw >> 1, last = kw & 1, col = ch * 512 + c.lane * 8;
        if (col >= DFF) continue;
        const int row = kb * 64 + (last ? 63 : 0);
        int pos, len; if (row < TL) { pos = row & 4095; len = 4096; } else { pos = (row - TL) & 255; len = 256; }
        u32x4 gp, gc, gn;
        if (!last) { gp = pos > 0 ? *(const u32x4*)(SG + ((size_t)(kb - 1) * 4 + 3) * DFF + col) : z4; gc = *(const u32x4*)(SG + ((size_t)kb * 4 + 0) * DFF + col); gn = *(const u32x4*)(SG + ((size_t)kb * 4 + 1) * DFF + col); }
        else { gp = *(const u32x4*)(SG + ((size_t)kb * 4 + 2) * DFF + col); gc = *(const u32x4*)(SG + ((size_t)kb * 4 + 3) * DFF + col); gn = pos < len - 1 ? *(const u32x4*)(SG + ((size_t)(kb + 1) * 4 + 0) * DFF + col) : z4; }
        const u32x4 up = *(const u32x4*)(SU + ((size_t)kb * 2 + last) * DFF + col);
        float w0[8], w1[8], w2[8], bb[8]; load8f(cw + col, w0); load8f(cw + DFF + col, w1); load8f(cw + 2 * DFF + col, w2); load8f(cb + col, bb);
        float o[8];
#pragma unroll
        for (int j = 0; j < 4; ++j) {
            const float x0 = bflo(gp[j]) * w0[2 * j] + bflo(gc[j]) * w1[2 * j] + bflo(gn[j]) * w2[2 * j] + bb[2 * j];
            const float x1 = bfhi(gp[j]) * w0[2 * j + 1] + bfhi(gc[j]) * w1[2 * j + 1] + bfhi(gn[j]) * w2[2 * j + 1] + bb[2 * j + 1];
            o[2 * j] = silu_f(x0) * bflo(up[j]); o[2 * j + 1] = silu_f(x1) * bfhi(up[j]); }
        u32x4 w; w.x = pk_bf16(o[0], o[1]); w.y = pk_bf16(o[2], o[3]); w.z = pk_bf16(o[4], o[5]); w.w = pk_bf16(o[6], o[7]);
        *(u32x4*)(HID + (size_t)row * DFF + col) = w;
    }
}

DI void unpack8(const u32x4 w, float (&o)[8]) {
#pragma unroll
    for (int j = 0; j < 4; ++j) { o[2 * j] = bflo(w[j]); o[2 * j + 1] = bfhi(w[j]); }
}
DI u32x4 pack8_bf16(const float (&o)[8]) { u32x4 w; w.x = pk_bf16(o[0], o[1]); w.y = pk_bf16(o[2], o[3]); w.z = pk_bf16(o[4], o[5]); w.w = pk_bf16(o[6], o[7]); return w; }
DI u32x4 pack8_f16(const float (&o)[8]) { u32x4 w; w.x = pk_f16(o[0], o[1]); w.y = pk_f16(o[2], o[3]); w.z = pk_f16(o[4], o[5]); w.w = pk_f16(o[6], o[7]); return w; }
DI void unpack8_f16(const u32x4 w, float (&o)[8]) {
#pragma unroll
    for (int j = 0; j < 4; ++j) { o[2 * j] = h16lo(w[j]); o[2 * j + 1] = h16hi(w[j]); }
}
DI void row_pos(int row, int& pos, int& len) { if (row < TL) { pos = row & 4095; len = 4096; } else { pos = (row - TL) & 255; len = 256; } }

__device__ __forceinline__ void p_rwkv_prepA(const Ctx& c) {
    const bf16_t* PA = (const bf16_t*)(c.ar + AR_PA);
    h16* R16 = (h16*)(c.ar + AR_R); h16* KK16 = (h16*)(c.ar + AR_KK); h16* V16 = (h16*)(c.ar + AR_V); bf16_t* K16 = (bf16_t*)(c.ar + AR_K); bf16_t* LA = (bf16_t*)(c.ar + AR_LA);
    const float* mu = c.in[I_MU]; const float* k_k = c.in[I_KK];
    const int lane = c.lane;
    for (int row = blockIdx.x * 8 + c.wave; row < TT; row += gridDim.x * 8) {
        int pos, len; row_pos(row, pos, len);
        const bool hasp = pos > 0, hasn = pos < len - 1;
        const bf16_t* pc = PA + (size_t)row * COLS_A_PAD;
        for (int it = 0; it < 14; ++it) {
            const int col = it * 512 + lane * 8;
            if (col >= COLS_A) break;
            float cur[8], prv[8], nxt[8], m8[8], mx[8];
            unpack8(*(const u32x4*)(pc + col), cur);
            if (hasp) unpack8(*(const u32x4*)(pc - COLS_A_PAD + col), prv); else {
#pragma unroll
                for (int j = 0; j < 8; ++j) prv[j] = 0.f; }
            if (hasn) unpack8(*(const u32x4*)(pc + COLS_A_PAD + col), nxt); else {
#pragma unroll
                for (int j = 0; j < 8; ++j) nxt[j] = 0.f; }
            load8f(mu + col, m8);
#pragma unroll
            for (int j = 0; j < 8; ++j) mx[j] = cur[j] + m8[j] * (0.5f * (prv[j] + nxt[j]) - cur[j]);
            if (it < 4) {
                *(u32x4*)(R16 + (size_t)row * 2048 + col) = pack8_f16(mx);
            } else if (it < 8) {
                const int j0 = col - 2048;
                *(u32x4*)(K16 + (size_t)row * 2048 + j0) = pack8_bf16(mx);
                float kk8[8], x[8]; load8f(k_k + j0, kk8); float ss = 0.f;
#pragma unroll
                for (int j = 0; j < 8; ++j) { x[j] = mx[j] * kk8[j]; ss += x[j] * x[j]; }
                ss += __shfl_xor(ss, 1); ss += __shfl_xor(ss, 2); ss += __shfl_xor(ss, 4);
                const float rn = rsqrtf(ss + 1e-12f);
#pragma unroll
                for (int j = 0; j < 8; ++j) x[j] *= rn;
                *(u32x4*)(KK16 + (size_t)row * 2048 + j0) = pack8_f16(x);
            } else if (it < 12) {
                *(u32x4*)(V16 + (size_t)row * 2048 + (col - 4096)) = pack8_f16(mx);
            } else {
                const int q0 = col - 6144; float o[8];
#pragma unroll
                for (int j = 0; j < 8; ++j) o[j] = q0 < 192 ? (1.0f - 2.0f * __builtin_amdgcn_rcpf(1.0f + __expf(2.0f * mx[j]))) : (q0 < 384 ? mx[j] : sigmoid_f(mx[j]));
                const int seg = q0 < 384 ? q0 / 96 : 4, off = q0 - (seg < 4 ? seg * 96 : 384);
                *(u32x4*)(LA + (size_t)row * LORA_K + seg * LORA_KU + off) = pack8_bf16(o);
            }
        }
        {
            const u32x4 z4 = {0u, 0u, 0u, 0u};
            for (int z = lane; z < 80; z += 64) *(u32x4*)(LA + (size_t)row * LORA_K + (z / 20) * LORA_KU + 96 + (z % 20) * 8) = z4; }
    }
}

DI int kperm16(int o) { return (o & ~12) | ((o >> 1) & 4) | ((o << 1) & 8); }
template <int DVW  , int NHEAD>
__device__ __forceinline__ void p_build_vt(const Ctx& c, const bf16_t* P, int ldp, int vcol0, bf16_t* VT) {
    constexpr int NSLAB = (DVW * NHEAD) / 512 > 0 ? (DVW * NHEAD) / 512 : 1;
    constexpr int SLABW = (DVW * NHEAD) < 512 ? (DVW * NHEAD) : 512;
    LAS unsigned short* T = (LAS unsigned short*)c.lds;
    const int tid = c.tid;
    for (int item = blockIdx.x; item < (TT / 64) * NSLAB; item += gridDim.x) {
        const int kg = item / NSLAB, slab = item % NSLAB;
        const int row0 = kg * 64;
        int b, key0; if (row0 < TL) { b = row0 >> 12; key0 = row0 & 4095; } else { b = (row0 - TL) >> 8; key0 = 4096 + ((row0 - TL) & 255); }
        { const int key = tid >> 3, part = tid & 7; const int kp = (key & ~15) | kperm16(key & 15);
          constexpr int CPT = SLABW / 8;
          const bf16_t* src = P + (size_t)(row0 + key) * ldp + vcol0 + slab * SLABW + part * CPT;
#pragma unroll
          for (int e = 0; e < CPT / 8; ++e) { const u32x4 w = *(const u32x4*)(src + e * 8);
#pragma unroll
              for (int j = 0; j < 4; ++j) { T[(part * CPT + e * 8 + 2 * j) * 72 + kp] = (unsigned short)(w[j] & 0xffffu); T[(part * CPT + e * 8 + 2 * j + 1) * 72 + kp] = (unsigned short)(w[j] >> 16); } }
        }
        __syncthreads();
        for (int q = tid; q < SLABW * 8; q += NTHREADS) { const int col = q >> 3, ch = q & 7;
            const u32x4 w = *(const LAS u32x4*)(T + col * 72 + ch * 8);
            const int gc = slab * SLABW + col, head = gc / DVW, dv = gc % DVW;
            *(u32x4*)(VT + (((size_t)b * NHEAD + head) * DVW + dv) * NKEY + key0 + ch * 8) = w; }
        __syncthreads();
    }
}

struct EpiLora {
    static constexpr bool PERM = true, AFTER_DRAIN = false, I8 = false;
    const float* w0; const float* a0; const float* k_a; const bf16_t* K16; const h16* KK16; h16* OMW; h16* BB; h16* KD; bf16_t* G;
    DI void operator()(const f32x4 (&acc)[2][2][4][2], const pg8::Unit& u, int wr, int wc, int fr, int fq) const {
        const int type = u.pn >> 3, row0 = u.pm * 256 + wr * 64 + fr;
#pragma unroll
        for (int bj = 0; bj < 2; ++bj) {
            const int jc = (u.pn & 7) * 256 + bj * 128 + wc * 32 + 8 * fq;
            if (type < 2) {
                float w8[8]; load8f(w0 + type * 2048 + jc, w8);
#pragma unroll
                for (int ai = 0; ai < 2; ++ai)
#pragma unroll
                    for (int m = 0; m < 4; ++m) { const int row = row0 + ai * 128 + m * 16; float o[8];
#pragma unroll
                        for (int i = 0; i < 8; ++i) { const float w = w8[i] + (i < 4 ? acc[ai][bj][m][0][i & 3] : acc[ai][bj][m][1][i & 3]);
                            o[i] = 1.0f - __expf(-0.60653066f * sigmoid_f(w)); }
                        *(u32x4*)(OMW + ((size_t)type * TT + row) * 2048 + jc) = pack8_f16(o); }
            } else if (type < 4) {
                const int d = type - 2; float a8[8], ka8[8]; load8f(a0 + d * 2048 + jc, a8); load8f(k_a + jc, ka8);
#pragma unroll
                for (int ai = 0; ai < 2; ++ai)
#pragma unroll
                    for (int m = 0; m < 4; ++m) { const int row = row0 + ai * 128 + m * 16; float kd[8], bb[8], k8[8], kk8[8];
                        unpack8(*(const u32x4*)(K16 + (size_t)row * 2048 + jc), k8); unpack8_f16(*(const u32x4*)(KK16 + (size_t)row * 2048 + jc), kk8);
#pragma unroll
                        for (int i = 0; i < 8; ++i) { const float a = sigmoid_f(a8[i] + (i < 4 ? acc[ai][bj][m][0][i & 3] : acc[ai][bj][m][1][i & 3]));
                            kd[i] = k8[i] * (1.0f + (a - 1.0f) * ka8[i]); bb[i] = kk8[i] * a; }
                        *(u32x4*)(KD + ((size_t)d * TT + row) * 2048 + jc) = pack8_f16(kd);
                        *(u32x4*)(BB + ((size_t)d * TT + row) * 2048 + jc) = pack8_f16(bb); }
            } else {
#pragma unroll
                for (int ai = 0; ai < 2; ++ai)
#pragma unroll
                    for (int m = 0; m < 4; ++m) { const int row = row0 + ai * 128 + m * 16; float o[8];
#pragma unroll
                        for (int i = 0; i < 8; ++i) o[i] = (i < 4 ? acc[ai][bj][m][0][i & 3] : acc[ai][bj][m][1][i & 3]);
                        *(u32x4*)(G + (size_t)row * 2048 + jc) = pack8_bf16(o); }
            }
        }
    }
};

#define MFMA32(a, b, cacc) __builtin_amdgcn_mfma_f32_32x32x16_bf16((a), (b), (cacc), 0, 0, 0)
DI bf16x8 ld_frag(const bf16_t* p) { return __builtin_bit_cast(bf16x8, *(const u32x4*)p); }
DI bf16x8 pack_p(const f32x16& x, int s) { u32x4 w; w.x = pk_bf16(x[8 * s], x[8 * s + 1]); w.y = pk_bf16(x[8 * s + 2], x[8 * s + 3]); w.z = pk_bf16(x[8 * s + 4], x[8 * s + 5]); w.w = pk_bf16(x[8 * s + 6], x[8 * s + 7]); return __builtin_bit_cast(bf16x8, w); }
constexpr float LOG2E = 1.44269504088896f;

DI void fwht8x4(float (&x)[8], int lane) {
#pragma unroll
    for (int h = 1; h < 8; h <<= 1)
#pragma unroll
        for (int i = 0; i < 8; i += 2 * h)
#pragma unroll
            for (int j = i; j < i + h; ++j) { const float a = x[j], b = x[j + h]; x[j] = a + b; x[j + h] = a - b; }
#pragma unroll
    for (int j = 0; j < 8; ++j) { float v = x[j];
        { const float t = __int_as_float(__builtin_amdgcn_update_dpp(0, __float_as_int(v), 0xB1, 0xF, 0xF, false)); v = (lane & 1) ? t - v : v + t; }
        { const float t = __int_as_float(__builtin_amdgcn_update_dpp(0, __float_as_int(v), 0x4E, 0xF, 0xF, false)); v = (lane & 2) ? t - v : v + t; }
        x[j] = v; }
}
DI float wave_max(float v) {
#pragma unroll
    for (int o = 32; o >= 1; o >>= 1) v = fmaxf(v, __shfl_xor(v, o));
    return v;
}
__device__ __forceinline__ void p_rwkv_out(const Ctx& c, int nrows) {
    const bf16_t* Yf = (const bf16_t*)(c.ar + AR_Y); const bf16_t* Yb = Yf + (size_t)TT * 2048;
    const h16* R16 = (const h16*)(c.ar + AR_R); const h16* V16 = (const h16*)(c.ar + AR_V);
    const h16* KDf = (const h16*)(c.ar + AR_KD); const h16* KDb = KDf + (size_t)TT * 2048;
    const bf16_t* G = (const bf16_t*)(c.ar + AR_G); bf16_t* MIX = (bf16_t*)(c.ws + WS_XN);
    const float* r_k = c.in[I_RK]; const float* ln_w = c.in[I_LNW]; const float* ln_b = c.in[I_LNB];
    const int lane = c.lane;
    for (int row = blockIdx.x * 8 + c.wave; row < nrows; row += gridDim.x * 8) {
        float ov[4][8];
#pragma unroll
        for (int it = 0; it < 4; ++it) {
            const int col = it * 512 + lane * 8; const size_t o = (size_t)row * 2048 + col;
            float yf[8], yb[8], y[8], r8[8], v8[8], kf[8], kb[8], g8[8], rk8[8], lw[8], lb[8];
            unpack8(*(const u32x4*)(Yf + o), yf); unpack8(*(const u32x4*)(Yb + o), yb);
            unpack8_f16(*(const u32x4*)(R16 + o), r8); unpack8_f16(*(const u32x4*)(V16 + o), v8);
            unpack8_f16(*(const u32x4*)(KDf + o), kf); unpack8_f16(*(const u32x4*)(KDb + o), kb);
            unpack8(*(const u32x4*)(G + o), g8);
            load8f(r_k + col, rk8); load8f(ln_w + col, lw); load8f(ln_b + col, lb);
            float sm = 0.f, bn = 0.f;
#pragma unroll
            for (int j = 0; j < 8; ++j) { y[j] = yf[j] + yb[j]; sm += y[j]; bn += r8[j] * (kf[j] + kb[j]) * rk8[j]; }
            sm += __shfl_xor(sm, 1); sm += __shfl_xor(sm, 2); sm += __shfl_xor(sm, 4);
            bn += __shfl_xor(bn, 1); bn += __shfl_xor(bn, 2); bn += __shfl_xor(bn, 4);
            const float mean = sm * (1.0f / 64.0f); float vs = 0.f;
#pragma unroll
            for (int j = 0; j < 8; ++j) { const float dlt = y[j] - mean; vs += dlt * dlt; }
            vs += __shfl_xor(vs, 1); vs += __shfl_xor(vs, 2); vs += __shfl_xor(vs, 4);
            const float rs = rsqrtf(vs * (1.0f / 64.0f) + 64e-5f);
            float o8[8];
#pragma unroll
            for (int j = 0; j < 8; ++j) o8[j] = ((y[j] - mean) * rs * lw[j] + lb[j] + bn * v8[j]) * g8[j];
            if (MIX_I8) {
#pragma unroll
                for (int j = 0; j < 8; ++j) ov[it][j] = o8[j]; }
            else *(u32x4*)(MIX + (size_t)row * D + col) = pack8_bf16(o8);
        }
        if (MIX_I8) {
            float av[4][8]; float mx = 0.f;
#pragma unroll
            for (int it = 0; it < 4; ++it) { unpack8(*(const u32x4*)(MIX + (size_t)row * D + 2048 + it * 512 + lane * 8), av[it]);
                fwht8x4(ov[it], lane); fwht8x4(av[it], lane);
#pragma unroll
                for (int j = 0; j < 8; ++j) mx = fmaxf(mx, fmaxf(fabsf(ov[it][j]), fabsf(av[it][j]))); }
            mx = wave_max(mx);
            const float qs = mx > 0.f ? 127.0f / mx : 0.f;
            unsigned char* xq = c.ar + AR_XQ + (size_t)row * D;
#pragma unroll
            for (int it = 0; it < 4; ++it) {
                u32x2 w0 = {pk_i8x4(ov[it][0] * qs, ov[it][1] * qs, ov[it][2] * qs, ov[it][3] * qs), pk_i8x4(ov[it][4] * qs, ov[it][5] * qs, ov[it][6] * qs, ov[it][7] * qs)};
                u32x2 w1 = {pk_i8x4(av[it][0] * qs, av[it][1] * qs, av[it][2] * qs, av[it][3] * qs), pk_i8x4(av[it][4] * qs, av[it][5] * qs, av[it][6] * qs, av[it][7] * qs)};
                *(u32x2*)(xq + it * 512 + lane * 8) = w0; *(u32x2*)(xq + 2048 + it * 512 + lane * 8) = w1; }
            if (lane == 0) ((float*)(c.ar + AR_XQS))[row] = mx * (1.0f / 127.0f);
        }
    }
}
__device__ __forceinline__ void p_quant_hid(const Ctx& c, int nrows) {
    const bf16_t* HID = (const bf16_t*)(c.ar + AR_HID); const int lane = c.lane;
    for (int row = blockIdx.x * 8 + c.wave; row < nrows; row += gridDim.x * 8) {
        u32x4 pk[22]; float mx = 0.f;
#pragma unroll
        for (int it = 0; it < 22; ++it) { const int col = it * 512 + lane * 8; pk[it] = col < DFF ? *(const u32x4*)(HID + (size_t)row * DFF + col) : (u32x4){0u, 0u, 0u, 0u}; }
#pragma unroll
        for (int it = 0; it < 22; ++it) { float x[8]; unpack8(pk[it], x); fwht8x4(x, lane);
#pragma unroll
            for (int j = 0; j < 8; ++j) mx = fmaxf(mx, fabsf(x[j])); }
        mx = wave_max(mx);
        const float qs = mx > 0.f ? 127.0f / mx : 0.f;
        unsigned char* hq = c.ar + AR_HQ + (size_t)row * DFF;
#pragma unroll
        for (int it = 0; it < 22; ++it) { float x[8]; unpack8(pk[it], x); fwht8x4(x, lane); const int col = it * 512 + lane * 8;
            u32x2 w = {pk_i8x4(x[0] * qs, x[1] * qs, x[2] * qs, x[3] * qs), pk_i8x4(x[4] * qs, x[5] * qs, x[6] * qs, x[7] * qs)};
            if (col < DFF) *(u32x2*)(hq + col) = w; }
        if (lane == 0) ((float*)(c.ar + AR_HQS))[row] = mx * (1.0f / 127.0f);
    }
}
__device__ __forceinline__ void p_quant_mix(const Ctx& c, int nrows) {
    const bf16_t* MIX = (const bf16_t*)(c.ws + WS_XN); const int lane = c.lane;
    for (int row = blockIdx.x * 8 + c.wave; row < nrows; row += gridDim.x * 8) {
        float x[8][8]; float mx = 0.f;
#pragma unroll
        for (int it = 0; it < 8; ++it) { unpack8(*(const u32x4*)(MIX + (size_t)row * D + it * 512 + lane * 8), x[it]); fwht8x4(x[it], lane);
#pragma unroll
            for (int j = 0; j < 8; ++j) mx = fmaxf(mx, fabsf(x[it][j])); }
        mx = wave_max(mx);
        const float qs = mx > 0.f ? 127.0f / mx : 0.f;
        unsigned char* xq = c.ar + AR_XQ + (size_t)row * D;
#pragma unroll
        for (int it = 0; it < 8; ++it) { u32x2 w = {pk_i8x4(x[it][0] * qs, x[it][1] * qs, x[it][2] * qs, x[it][3] * qs), pk_i8x4(x[it][4] * qs, x[it][5] * qs, x[it][6] * qs, x[it][7] * qs)};
            *(u32x2*)(xq + it * 512 + lane * 8) = w; }
        if (lane == 0) ((float*)(c.ar + AR_XQS))[row] = mx * (1.0f / 127.0f);
    }
}

constexpr int K1_WAVE_LDS = 35328;
constexpr size_t TT_ROWS2048 = (size_t)TT * 2048;
#define WAVE_SYNC() do { asm volatile("s_waitcnt lgkmcnt(0)" ::: "memory"); __builtin_amdgcn_wave_barrier(); } while (0)
DI int rw_row(int b, int dir, int t) { return t < CTXL ? TL + b * CTXL + (dir ? (CTXL - 1 - t) : t) : b * SEQ + (dir ? (SEQ - 1 - (t - CTXL)) : (t - CTXL)); }
DI float bfu(unsigned short x) { return __uint_as_float((unsigned)x << 16); }
DI bf16x8 colfrag_nat(const LAS unsigned short* T, int col, int t0) { u32x4 w;
#pragma unroll
    for (int j = 0; j < 4; ++j) w[j] = (unsigned)T[(t0 + 2 * j) * 64 + col] | ((unsigned)T[(t0 + 2 * j + 1) * 64 + col] << 16);
    return __builtin_bit_cast(bf16x8, w); }
DI bf16x8 colfrag_nat_scaled(const LAS unsigned short* T, int col, int t0, float sc) { u32x4 w;
#pragma unroll
    for (int j = 0; j < 4; ++j) w[j] = pk_bf16(bfu(T[(t0 + 2 * j) * 64 + col]) * sc, bfu(T[(t0 + 2 * j + 1) * 64 + col]) * sc);
    return __builtin_bit_cast(bf16x8, w); }
DI bf16x8 colfrag_pk_scaled(const LAS unsigned short* T, int col, int s, int hh, float sc) { u32x4 w;
#pragma unroll
    for (int j2 = 0; j2 < 4; ++j2) { const int j = 2 * j2, t = 16 * s + 8 * (j >> 2) + 4 * hh + (j & 3);
        w[j2] = pk_bf16(bfu(T[t * 64 + col]) * sc, bfu(T[(t + 1) * 64 + col]) * sc); }
    return __builtin_bit_cast(bf16x8, w); }
DI bf16x8 rowfrag_nat(const LAS unsigned short* A, int row, int s, int hh) { const LAS u32x2* p = (const LAS u32x2*)(A + row * 40 + 16 * s + 8 * hh); const u32x2 a = p[0], b = p[1];
    u32x4 w = {a.x, a.y, b.x, b.y}; return __builtin_bit_cast(bf16x8, w); }
DI bf16x8 rowfrag_pk(const LAS unsigned short* A, int row, int s, int hh) { const u32x2 a = *(const LAS u32x2*)(A + row * 40 + 16 * s + 4 * hh), b = *(const LAS u32x2*)(A + row * 40 + 16 * s + 8 + 4 * hh);
    u32x4 w = {a.x, a.y, b.x, b.y}; return __builtin_bit_cast(bf16x8, w); }
DI u32x4 pack_pu(const f32x16& x, int s) { u32x4 w; w.x = pk_bf16(x[8 * s], x[8 * s + 1]); w.y = pk_bf16(x[8 * s + 2], x[8 * s + 3]); w.z = pk_bf16(x[8 * s + 4], x[8 * s + 5]); w.w = pk_bf16(x[8 * s + 6], x[8 * s + 7]); return w; }

__device__ __forceinline__ void rwkv_k1_chunk(const Ctx& c, LAS unsigned char* wl, int seq, int ch) {
    const int dir = seq & 1, h = (seq >> 1) & 31, b = seq >> 6;
    const int lane = c.lane, r = lane & 31, hh = lane >> 5;
    LAS unsigned short* TA = (LAS unsigned short*)wl; LAS unsigned short* TB = TA + 2048; LAS unsigned short* TK = TB + 2048; LAS unsigned short* TR = TK + 2048; LAS unsigned short* TVv = TR + 2048;
    LAS float* GC = (LAS float*)(wl + 20480); LAS float* LAB = (LAS float*)(wl + 20736);
    LAS unsigned short* TTi = (LAS unsigned short*)(wl + 24832); LAS unsigned short* TAK = TTi + 1280; LAS unsigned short* TRB = TAK + 1280; LAS unsigned short* TRK = TRB + 1280;
    const h16* KK = (const h16*)(c.ar + AR_KK); const h16* RR = (const h16*)(c.ar + AR_R); const h16* VV = (const h16*)(c.ar + AR_V);
    const h16* OM = (const h16*)(c.ar + AR_OMW) + (size_t)dir * TT_ROWS2048; const h16* BBp = (const h16*)(c.ar + AR_BB) + (size_t)dir * TT_ROWS2048; const h16* KDp = (const h16*)(c.ar + AR_KD) + (size_t)dir * TT_ROWS2048;
    {   LAS unsigned short* TO = (LAS unsigned short*)LAB;
        u32x4 ld[6][4];
#pragma unroll
        for (int i = 0; i < 4; ++i) { const int tau = (lane >> 3) + 8 * i; const size_t off = (size_t)rw_row(b, dir, ch * 32 + tau) * 2048 + h * 64 + (lane & 7) * 8;
            ld[0][i] = *(const u32x4*)(KK + off); ld[1][i] = *(const u32x4*)(BBp + off); ld[2][i] = *(const u32x4*)(KDp + off);
            ld[3][i] = *(const u32x4*)(RR + off); ld[4][i] = *(const u32x4*)(VV + off); ld[5][i] = *(const u32x4*)(OM + off); }
#pragma unroll
        for (int i = 0; i < 4; ++i) { const int o = ((lane >> 3) + 8 * i) * 64 + (lane & 7) * 8;
            *(LAS u32x4*)(TA + o) = ld[0][i]; *(LAS u32x4*)(TB + o) = ld[1][i]; *(LAS u32x4*)(TK + o) = ld[2][i];
            *(LAS u32x4*)(TR + o) = ld[3][i]; *(LAS u32x4*)(TVv + o) = ld[4][i]; *(LAS u32x4*)(TO + o) = ld[5][i]; }
    }
    WAVE_SYNC();
    {   const LAS h16* TO = (const LAS h16*)LAB;
        float g = 1.f;
#pragma unroll 8
        for (int tau = 0; tau < 32; ++tau) { const int o = tau * 64 + lane;
            const float omw = (float)TO[o], bb = (float)((const LAS h16*)TB)[o], kd = (float)((const LAS h16*)TK)[o], kk = (float)((const LAS h16*)TA)[o], rr = (float)((const LAS h16*)TR)[o], vv = (float)((const LAS h16*)TVv)[o];
            const float gp = g; g *= (1.0f - omw); const float ig = __builtin_amdgcn_rcpf(g);
            TA[o] = f2bf(kk * gp); TB[o] = f2bf(-bb * ig); TK[o] = f2bf(kd * ig); TR[o] = f2bf(rr * g); TVv[o] = f2bf(vv);
        }
        GC[lane] = g;
    }
    WAVE_SYNC();
    {   f32x16 ab, ak, rb, rk;
#pragma unroll
        for (int i = 0; i < 16; ++i) { ab[i] = 0.f; ak[i] = 0.f; rb[i] = 0.f; rk[i] = 0.f; }
#pragma unroll
        for (int ks = 0; ks < 4; ++ks) { const int o = r * 64 + 16 * ks + 8 * hh;
            const bf16x8 fa = *(const LAS bf16x8*)(TA + o), fb = *(const LAS bf16x8*)(TB + o), fk = *(const LAS bf16x8*)(TK + o), fr = *(const LAS bf16x8*)(TR + o);
            ab = MFMA32(fa, fb, ab); ak = MFMA32(fa, fk, ak); rb = MFMA32(fr, fb, rb); rk = MFMA32(fr, fk, rk); }
#pragma unroll
        for (int i = 0; i < 16; ++i) { const int tau = (i & 3) + 8 * (i >> 2) + 4 * hh;
            LAB[tau * 32 + r] = (r < tau) ? ab[i] : 0.f;
            TAK[tau * 40 + r] = f2bf((r < tau) ? ak[i] : 0.f); TRB[tau * 40 + r] = f2bf((r <= tau) ? rb[i] : 0.f); TRK[tau * 40 + r] = f2bf((r <= tau) ? rk[i] : 0.f); }
    }
    WAVE_SYNC();
    {   float Tc[32];
#pragma unroll
        for (int tau = 0; tau < 32; ++tau) { float acc = (r == tau) ? 1.f : 0.f;
#pragma unroll
            for (int q = 0; q < (tau + 3) / 4; ++q) { const f32x4 a4 = *(const LAS f32x4*)(LAB + tau * 32 + 4 * q);
#pragma unroll
                for (int e = 0; e < 4; ++e) if (4 * q + e < tau) acc = fmaf(a4[e], Tc[4 * q + e], acc); }
            Tc[tau] = acc; }
        if (hh == 0) {
#pragma unroll
            for (int tau = 0; tau < 32; ++tau) TTi[tau * 40 + r] = f2bf(Tc[tau]); }
    }
    WAVE_SYNC();
    f32x16 W1[2], Z[2]; bf16x8 Vn[2][2];
    {   bf16x8 tn[2], tp[2], akn[2];
#pragma unroll
        for (int s = 0; s < 2; ++s) { tn[s] = rowfrag_nat(TTi, r, s, hh); tp[s] = rowfrag_pk(TTi, r, s, hh); akn[s] = rowfrag_nat(TAK, r, s, hh); }
#pragma unroll
        for (int t2 = 0; t2 < 2; ++t2) {
#pragma unroll
            for (int i = 0; i < 16; ++i) W1[t2][i] = 0.f;
            f32x16 X;
#pragma unroll
            for (int i = 0; i < 16; ++i) X[i] = 0.f;
#pragma unroll
            for (int s = 0; s < 2; ++s) { Vn[t2][s] = colfrag_nat(TVv, 32 * t2 + r, 16 * s + 8 * hh);
                W1[t2] = MFMA32(tn[s], colfrag_nat(TA, 32 * t2 + r, 16 * s + 8 * hh), W1[t2]);
                X = MFMA32(akn[s], Vn[t2][s], X); }
#pragma unroll
            for (int i = 0; i < 16; ++i) Z[t2][i] = 0.f;
#pragma unroll
            for (int s = 0; s < 2; ++s) Z[t2] = MFMA32(tp[s], pack_p(X, s), Z[t2]);
        }
    }
    u32x4* CHp = (u32x4*)(c.ar + AR_CH + ((size_t)seq * RW_NCH + ch) * CH_BYTES) + lane;
    {   bf16x8 rbp[2], rkn[2];
#pragma unroll
        for (int s = 0; s < 2; ++s) { rbp[s] = rowfrag_pk(TRB, r, s, hh); rkn[s] = rowfrag_nat(TRK, r, s, hh); }
#pragma unroll
        for (int kt = 0; kt < 2; ++kt) { f32x16 GT;
#pragma unroll
            for (int g4 = 0; g4 < 4; ++g4) { const u32x2 w = *(const LAS u32x2*)(TR + r * 64 + 32 * kt + 8 * g4 + 4 * hh);
                GT[4 * g4] = bflo(w.x); GT[4 * g4 + 1] = bfhi(w.x); GT[4 * g4 + 2] = bflo(w.y); GT[4 * g4 + 3] = bfhi(w.y); }
#pragma unroll
            for (int s = 0; s < 2; ++s) GT = MFMA32(pack_p(W1[kt], s), rbp[s], GT);
#pragma unroll
            for (int s = 0; s < 2; ++s) CHp[(0 + kt * 2 + s) * 64] = pack_pu(GT, s); }
#pragma unroll
        for (int vt = 0; vt < 2; ++vt) { f32x16 Y0;
#pragma unroll
            for (int i = 0; i < 16; ++i) Y0[i] = 0.f;
#pragma unroll
            for (int s = 0; s < 2; ++s) { Y0 = MFMA32(pack_p(Z[vt], s), rbp[s], Y0); Y0 = MFMA32(Vn[vt][s], rkn[s], Y0); }
#pragma unroll
            for (int s = 0; s < 2; ++s) CHp[(4 + vt * 2 + s) * 64] = pack_pu(Y0, s); }
    }
#pragma unroll
    for (int k2 = 0; k2 < 2; ++k2) {
        const float gc = GC[32 * k2 + r];
        bf16x8 bhp[2], khn[2];
#pragma unroll
        for (int s = 0; s < 2; ++s) { bhp[s] = colfrag_pk_scaled(TB, 32 * k2 + r, s, hh, gc); khn[s] = colfrag_nat_scaled(TK, 32 * k2 + r, 16 * s + 8 * hh, gc); }
#pragma unroll
        for (int kt = 0; kt < 2; ++kt) { f32x16 PT;
#pragma unroll
            for (int i = 0; i < 16; ++i) PT[i] = (kt == k2 && ((i & 3) + 8 * (i >> 2) + 4 * hh) == r) ? gc : 0.f;
#pragma unroll
            for (int s = 0; s < 2; ++s) PT = MFMA32(pack_p(W1[kt], s), bhp[s], PT);
#pragma unroll
            for (int s = 0; s < 2; ++s) CHp[(8 + k2 * 4 + kt * 2 + s) * 64] = pack_pu(PT, s); }
#pragma unroll
        for (int vt = 0; vt < 2; ++vt) { f32x16 PS;
#pragma unroll
            for (int i = 0; i < 16; ++i) PS[i] = 0.f;
#pragma unroll
            for (int s = 0; s < 2; ++s) { PS = MFMA32(bhp[s], pack_p(Z[vt], s), PS); PS = MFMA32(khn[s], Vn[vt][s], PS); }
#pragma unroll
            for (int s = 0; s < 2; ++s) CHp[(16 + k2 * 4 + vt * 2 + s) * 64] = pack_pu(PS, s); }
    }
    WAVE_SYNC();
}

DI void unpack_acc(const u32x4 lo, const u32x4 hi, f32x16& x) {
#pragma unroll
    for (int j = 0; j < 4; ++j) { x[2 * j] = bflo(lo[j]); x[2 * j + 1] = bfhi(lo[j]); x[8 + 2 * j] = bflo(hi[j]); x[8 + 2 * j + 1] = bfhi(hi[j]); }
}
__device__ __forceinline__ void rwkv_seq_wave(const Ctx& c, int seq, int vt) {
    const int dir = seq & 1, h = (seq >> 1) & 31, b = seq >> 6;
    const int lane = c.lane, r = lane & 31, hh = lane >> 5;
    bf16_t* Y = (bf16_t*)(c.ar + AR_Y) + (size_t)dir * TT_ROWS2048;
    f32x16 M[2];
#pragma unroll
    for (int kt = 0; kt < 2; ++kt)
#pragma unroll
        for (int i = 0; i < 16; ++i) M[kt][i] = 0.f;
    const u32x4* CH0 = (const u32x4*)(c.ar + AR_CH + (size_t)seq * RW_NCH * CH_BYTES) + lane;
    u32x4 gf[4], pf[8], y0[2], ps[4];
#define RW_LOAD(chp) do { _Pragma("unroll") for (int q = 0; q < 4; ++q) gf[q] = (chp)[q * 64]; _Pragma("unroll") for (int q = 0; q < 2; ++q) y0[q] = (chp)[(4 + vt * 2 + q) * 64]; \
        _Pragma("unroll") for (int q = 0; q < 8; ++q) pf[q] = (chp)[(8 + q) * 64]; _Pragma("unroll") for (int k2 = 0; k2 < 2; ++k2) _Pragma("unroll") for (int s = 0; s < 2; ++s) ps[k2 * 2 + s] = (chp)[(16 + k2 * 4 + vt * 2 + s) * 64]; } while (0)
    RW_LOAD(CH0);
    for (int ch = 0; ch < (int)RW_NCH; ++ch) {
        bf16x8 mp[4];
#pragma unroll
        for (int kt = 0; kt < 2; ++kt)
#pragma unroll
            for (int s = 0; s < 2; ++s) mp[kt * 2 + s] = pack_p(M[kt], s);
        f32x16 Yc, Mn[2];
        unpack_acc(y0[0], y0[1], Yc); unpack_acc(ps[0], ps[1], Mn[0]); unpack_acc(ps[2], ps[3], Mn[1]);
#pragma unroll
        for (int q = 0; q < 4; ++q) Yc = MFMA32(mp[q], __builtin_bit_cast(bf16x8, gf[q]), Yc);
#pragma unroll
        for (int k2 = 0; k2 < 2; ++k2)
#pragma unroll
            for (int q = 0; q < 4; ++q) Mn[k2] = MFMA32(__builtin_bit_cast(bf16x8, pf[k2 * 4 + q]), mp[q], Mn[k2]);
        if (ch + 1 < (int)RW_NCH) { const u32x4* nx = CH0 + (size_t)(ch + 1) * (CH_BYTES / 16); RW_LOAD(nx); }
        M[0] = Mn[0]; M[1] = Mn[1];
        {   bf16_t* yp = Y + (size_t)rw_row(b, dir, ch * 32 + r) * 2048 + h * 64 + 32 * vt + 4 * hh;
#pragma unroll
            for (int g = 0; g < 4; ++g) { u32x2 w2; w2.x = pk_bf16(Yc[4 * g], Yc[4 * g + 1]); w2.y = pk_bf16(Yc[4 * g + 2], Yc[4 * g + 3]); *(u32x2*)(yp + 8 * g) = w2; } }
    }
#undef RW_LOAD
}

__device__ __forceinline__ void p_rwkv_k1_and_conv(const Ctx& c) {
    if (c.wave < 4) { LAS unsigned char* wl = c.lds + c.wave * K1_WAVE_LDS; const int w = blockIdx.x * 4 + c.wave, nw = gridDim.x * 4;
        for (int task = w; task < 256 * (int)RW_NCH; task += nw) rwkv_k1_chunk(c, wl, task / (int)RW_NCH, task % (int)RW_NCH); }
    else p_convert_deferred(c, blockIdx.x * 4 + (c.wave - 4), gridDim.x * 4, 0, CONV_SPLIT);
}
__device__ __forceinline__ void p_rwkv_seq_and_conv(const Ctx& c) {
    constexpr int NTASK = 512;
    const int G = (int)gridDim.x, task = c.wave * G + (int)blockIdx.x;
    if (task < NTASK) { for (int t = task; t < NTASK; t += G * 8) rwkv_seq_wave(c, t & 255, t >> 8); return; }
    int widx = 0, nworkers = 0;
    for (int w = 0; w < 8; ++w) { const int nsc = NTASK - w * G; const int sb = nsc <= 0 ? 0 : (nsc > G ? G : nsc);
        if (w < c.wave) widx += G - sb; else if (w == c.wave) widx += (int)blockIdx.x - sb;
        nworkers += G - sb; }
    p_convert_deferred(c, widx, nworkers, CONV_SPLIT, 1 << 30);
}

constexpr int DA_KBYTES = 64 * 256, DA_VBYTES = 128 * 128, DA_BUF = DA_KBYTES + DA_VBYTES;
constexpr int DA_COMB = 2 * DA_BUF;
__device__ __forceinline__ void dattn_block_item(const Ctx& c, int item) {
    const bf16_t* PB = (const bf16_t*)(c.ar + AR_PB); const bf16_t* VT = (const bf16_t*)(c.ar + AR_VT); bf16_t* MIX = (bf16_t*)(c.ws + WS_XN);
    const int lane = c.lane, r = lane & 31, hh = lane >> 5, w = c.wave, mp = w >> 2, qg = w & 3;
    int b, h, qrow0, t0, nt;
    if (item < NB * 16 * 32) { b = item >> 9; h = (item >> 5) & 15; qrow0 = b * SEQ + (item & 31) * 128; t0 = 0; nt = NKEY / 64; }
    else { const int i2 = item - NB * 16 * 32; b = i2 >> 5; h = (i2 >> 1) & 15; qrow0 = TL + b * CTXL + (i2 & 1) * 128; t0 = SEQ / 64; nt = CTXL / 64; }
    const bf16_t* VTh = VT + ((size_t)b * 16 + h) * 128 * NKEY;
    int krow_l[2], kchunk_l[2], vrow_l[2], vchunk_l[2];
#pragma unroll
    for (int i = 0; i < 2; ++i) { const int pk = 2 * w + i; krow_l[i] = 4 * pk + (lane >> 4); kchunk_l[i] = (lane & 15) ^ (krow_l[i] & 15);
        vrow_l[i] = 8 * pk + (lane >> 3); vchunk_l[i] = (lane & 7) ^ ((vrow_l[i] >> 1) & 7); }
#define DA_LOAD(t, buf) do { const int kx0 = (t0 + (t)) * 64; const int krow0 = kx0 < SEQ ? b * SEQ + kx0 : TL + b * CTXL + (kx0 - SEQ); \
        _Pragma("unroll") for (int i = 0; i < 2; ++i) { \
            __builtin_amdgcn_global_load_lds((const unsigned*)(PB + (size_t)(krow0 + krow_l[i]) * COLS_B + 2048 + h * 128 + kchunk_l[i] * 8), (LAS unsigned*)(c.lds + (buf) * DA_BUF + (2 * w + i) * 1024), 16, 0, 0); \
            __builtin_amdgcn_global_load_lds((const unsigned*)(VTh + (size_t)vrow_l[i] * NKEY + kx0 + vchunk_l[i] * 8), (LAS unsigned*)(c.lds + (buf) * DA_BUF + DA_KBYTES + (2 * w + i) * 1024), 16, 0, 0); } } while (0)
    bf16x8 q[4];
    { const bf16_t* qp = PB + (size_t)(qrow0 + 32 * qg + r) * COLS_B + h * 128 + mp * 64 + hh * 8;
#pragma unroll
      for (int ks = 0; ks < 4; ++ks) q[ks] = ld_frag(qp + ks * 16); }
    f32x16 O[4];
#pragma unroll
    for (int d = 0; d < 4; ++d)
#pragma unroll
        for (int i = 0; i < 16; ++i) O[d][i] = 0.f;
    float m = 0.f, l = 0.f;
    DA_LOAD(0, 0);
    __syncthreads();
    for (int t = 0; t < nt; ++t) {
        const int cur = t & 1;
        if (t + 1 < nt) DA_LOAD(t + 1, cur ^ 1);
        const LAS unsigned short* Kl = (const LAS unsigned short*)(c.lds + cur * DA_BUF); const LAS unsigned short* Vl = (const LAS unsigned short*)(c.lds + cur * DA_BUF + DA_KBYTES);
        f32x16 st[2];
        const float negm = -m;
#pragma unroll
        for (int sub = 0; sub < 2; ++sub) {
#pragma unroll
            for (int i = 0; i < 16; ++i) st[sub][i] = negm;
#pragma unroll
            for (int ks = 0; ks < 4; ++ks) st[sub] = MFMA32(*(const LAS bf16x8*)((const LAS unsigned char*)Kl + (32 * sub + r) * 256 + (((mp * 8 + ks * 2 + hh) ^ (r & 15)) << 4)), q[ks], st[sub]); }
        float mx = fmaxf(st[0][0], st[1][0]);
#pragma unroll
        for (int i = 1; i < 16; ++i) mx = fmaxf(mx, fmaxf(st[0][i], st[1][i]));
        mx = fmaxf(mx, __shfl_xor(mx, 32));
        if (!__all(mx <= 8.0f && mx >= -24.0f)) {
            const float alpha = __builtin_amdgcn_exp2f(-mx);
            m += mx; l *= alpha;
#pragma unroll
            for (int sub = 0; sub < 2; ++sub)
#pragma unroll
                for (int i = 0; i < 16; ++i) st[sub][i] -= mx;
#pragma unroll
            for (int d = 0; d < 4; ++d)
#pragma unroll
                for (int i = 0; i < 16; ++i) O[d][i] *= alpha;
        }
        float ps = 0.f;
#pragma unroll
        for (int sub = 0; sub < 2; ++sub)
#pragma unroll
            for (int i = 0; i < 16; ++i) { st[sub][i] = __builtin_amdgcn_exp2f(st[sub][i]); ps += st[sub][i]; }
        l += ps;
        bf16x8 P[4];
#pragma unroll
        for (int sub = 0; sub < 2; ++sub) { P[2 * sub] = pack_p(st[sub], 0); P[2 * sub + 1] = pack_p(st[sub], 1); }
#pragma unroll
        for (int d = 0; d < 4; ++d)
#pragma unroll
            for (int kk = 0; kk < 4; ++kk) O[d] = MFMA32(*(const LAS bf16x8*)((const LAS unsigned char*)Vl + (32 * d + r) * 128 + (((2 * kk + hh) ^ ((r >> 1) & 7)) << 4)), P[kk], O[d]);
        __syncthreads();
    }
#undef DA_LOAD
    LAS float* CB = (LAS float*)(c.lds + DA_COMB) + qg * 4096;
    l += __shfl_xor(l, 32);
    if (mp == 1) { const float sc = ((const float*)(c.ws + WS_SCAL))[0] / l;
#pragma unroll
        for (int d = 0; d < 4; ++d)
#pragma unroll
            for (int i = 0; i < 16; ++i) CB[(32 * d + (i & 3) + 8 * (i >> 2) + 4 * hh) * 32 + r] = O[d][i] * sc; }
    __syncthreads();
    if (mp == 0) { const float i0 = 1.0f / l; float ss = 0.f;
#pragma unroll
        for (int d = 0; d < 4; ++d)
#pragma unroll
            for (int i = 0; i < 16; ++i) { const float y = O[d][i] * i0 - CB[(32 * d + (i & 3) + 8 * (i >> 2) + 4 * hh) * 32 + r]; O[d][i] = y; ss += y * y; }
        ss += __shfl_xor(ss, 32);
        const float rs = rsqrtf(ss * (1.0f / 128.0f) + 1e-5f) * 0.8f;
        const float* subln = c.in[I_SUBLN];
        bf16_t* orow = MIX + (size_t)(qrow0 + 32 * qg + r) * D + 2048 + h * 128;
#pragma unroll
        for (int d = 0; d < 4; ++d)
#pragma unroll
            for (int g = 0; g < 4; ++g) { const int dv = 32 * d + 8 * g + 4 * hh; const f32x4 sl = *(const f32x4*)(subln + dv);
                u32x2 wv; wv.x = pk_bf16(O[d][4 * g] * rs * sl[0], O[d][4 * g + 1] * rs * sl[1]); wv.y = pk_bf16(O[d][4 * g + 2] * rs * sl[2], O[d][4 * g + 3] * rs * sl[3]);
                *(u32x2*)(orow + dv) = wv; } }
    __syncthreads();
}
__device__ __forceinline__ void p_dattn_block(const Ctx& c, bool need_ctx) {
    const int nitems = NB * 16 * 32 + (need_ctx ? NB * 16 * 2 : 0);
    const bool remap = gridDim.x == 256;
    for (int item = blockIdx.x; item < nitems; item += gridDim.x) {
        int it = item;
        if (remap && item < NB * 16 * 32) { const int k = item >> 8, x = item & 7, sl = (item & 255) >> 3; it = (((k << 3) + x) << 5) | sl; }
        dattn_block_item(c, it);
    }
}

constexpr int P1_CQ = 0, P1_CK = 2048, P1_CV = 2304, P1_DQ = 2560, P1_DK = 3584, P1_DV = 4608, P1_DG = 6656;

constexpr int SW_KLD = 72, SW_VLD = 40;
constexpr int SW_KBYTES = 32 * SW_KLD * 2, SW_VBYTES = 64 * SW_VLD * 2, SW_BUF = SW_KBYTES + SW_VBYTES;
__device__ __forceinline__ void swa_block_item(const Ctx& c, int item) {
    const bf16_t* P1 = (const bf16_t*)(c.ar + AR_P1); const bf16_t* VTC = (const bf16_t*)(c.ar + AR_VTC); bf16_t* MIX = (bf16_t*)(c.ws + WS_XN);
    const int tid = c.tid, lane = c.lane, r = lane & 31, hh = lane >> 5;
    const int b = item >> 9, g = (item >> 7) & 3, q0 = (item & 127) * 32, hq = g * 8 + c.wave;
    const int qpos = q0 + r;
    bf16x8 q[4]; { const bf16_t* qp = P1 + (size_t)(b * SEQ + qpos) * NO + P1_CQ + hq * 64 + hh * 8;
#pragma unroll
        for (int ks = 0; ks < 4; ++ks) q[ks] = ld_frag(qp + ks * 16); }
    const bf16_t* VTh = VTC + ((size_t)b * 4 + g) * 64 * NKEY;
    f32x16 O[2];
#pragma unroll
    for (int d = 0; d < 2; ++d)
#pragma unroll
        for (int i = 0; i < 16; ++i) O[d][i] = 0.f;
    float m = 0.f, l = 0.f;
    const int wt0 = (q0 - 128 < 0 ? 0 : q0 - 128) / 32, wt1 = (q0 + 160 > SEQ ? SEQ : q0 + 160) / 32;
    const int nwt = wt1 - wt0, ntl = nwt + 8;
    u32x4 sreg;
    const bool kside = tid < 256; const int t2 = tid & 255;
#define SWB_LOAD(ti) do { const bool win_ = (ti) < nwt; const int kx_ = (win_ ? wt0 + (ti) : (SEQ / 32) + ((ti) - nwt)) * 32; \
        sreg = kside ? *(const u32x4*)(P1 + (size_t)((win_ ? b * SEQ + kx_ : TL + b * CTXL + (kx_ - SEQ)) + (t2 >> 3)) * NO + P1_CK + g * 64 + (t2 & 7) * 8) \
                     : *(const u32x4*)(VTh + (size_t)(t2 >> 2) * NKEY + kx_ + (t2 & 3) * 8); } while (0)
#define SWB_STORE(buf) do { LAS unsigned short* base_ = (LAS unsigned short*)(c.lds + (buf) * SW_BUF); \
        if (kside) *(LAS u32x4*)(base_ + (t2 >> 3) * SW_KLD + (t2 & 7) * 8) = sreg; else *(LAS u32x4*)(base_ + SW_KBYTES / 2 + (t2 >> 2) * SW_VLD + (t2 & 3) * 8) = sreg; } while (0)
    SWB_LOAD(0); SWB_STORE(0);
    __syncthreads();
    for (int ti = 0; ti < ntl; ++ti) {
        const bool win = ti < nwt; const int kx0 = (win ? wt0 + ti : (SEQ / 32) + (ti - nwt)) * 32;
        if (ti + 1 < ntl) SWB_LOAD(ti + 1);
        const LAS unsigned short* Kl = (const LAS unsigned short*)(c.lds + (ti & 1) * SW_BUF); const LAS unsigned short* Vl = Kl + SW_KBYTES / 2;
        f32x16 st;
        const float negm = -m;
#pragma unroll
        for (int i = 0; i < 16; ++i) st[i] = negm;
#pragma unroll
        for (int ks = 0; ks < 4; ++ks) st = MFMA32(*(const LAS bf16x8*)(Kl + r * SW_KLD + ks * 16 + hh * 8), q[ks], st);
        if (win && (kx0 == q0 - 128 || kx0 == q0 + 128)) {
#pragma unroll
            for (int i = 0; i < 16; ++i) { const int kpos = kx0 + (i & 3) + 8 * (i >> 2) + 4 * hh; const int dl = kpos - qpos; if (dl > 128 || dl < -128) st[i] = -1e30f; }
        }
        float mx = st[0];
#pragma unroll
        for (int i = 1; i < 16; ++i) mx = fmaxf(mx, st[i]);
        mx = fmaxf(mx, __shfl_xor(mx, 32));
        if (!__all(mx <= 8.0f && mx >= -24.0f)) {
            const float alpha = __builtin_amdgcn_exp2f(-mx);
            m += mx; l *= alpha;
#pragma unroll
            for (int i = 0; i < 16; ++i) st[i] -= mx;
#pragma unroll
            for (int d = 0; d < 2; ++d)
#pragma unroll
                for (int i = 0; i < 16; ++i) O[d][i] *= alpha;
        }
        float ps = 0.f;
#pragma unroll
        for (int i = 0; i < 16; ++i) { st[i] = __builtin_amdgcn_exp2f(st[i]); ps += st[i]; }
        l += ps;
        const bf16x8 p0 = pack_p(st, 0), p1 = pack_p(st, 1);
#pragma unroll
        for (int d = 0; d < 2; ++d) { O[d] = MFMA32(*(const LAS bf16x8*)(Vl + (32 * d + r) * SW_VLD + 8 * hh), p0, O[d]); O[d] = MFMA32(*(const LAS bf16x8*)(Vl + (32 * d + r) * SW_VLD + 16 + 8 * hh), p1, O[d]); }
        if (ti + 1 < ntl) SWB_STORE((ti + 1) & 1);
        __syncthreads();
    }
#undef SWB_LOAD
#undef SWB_STORE
    l += __shfl_xor(l, 32);
    l += __builtin_amdgcn_exp2f(c.in[I_SINK][hq] * LOG2E - m);
    const float il = 1.0f / l;
    bf16_t* orow = MIX + (size_t)(b * SEQ + qpos) * D + hq * 64;
#pragma unroll
    for (int d = 0; d < 2; ++d)
#pragma unroll
        for (int gq = 0; gq < 4; ++gq) { const int dv = 32 * d + 8 * gq + 4 * hh;
            u32x2 w; w.x = pk_bf16(O[d][4 * gq] * il, O[d][4 * gq + 1] * il); w.y = pk_bf16(O[d][4 * gq + 2] * il, O[d][4 * gq + 3] * il);
            *(u32x2*)(orow + dv) = w; }
}

DI float ret_lg(const Ctx& c, int dir, int h) { return log1pf(-exp2f(-c.in[I_RDEC][dir * 8 + h])); }
DI int ret_row0(int b, int cidx) { return cidx < 2 ? TL + b * CTXL + cidx * 128 : b * SEQ + (cidx - 2) * 128; }
constexpr int TK_LD = 136, TV_LD = 264;
constexpr int RT_LD = 136;
DI void stage_chunk_T(const Ctx& c, const bf16_t* src, int ld_src, int ncols, LAS unsigned short* T) {
    const int tid = c.tid, row = tid >> 2, part = tid & 3, cpt = ncols / 4;
    const bf16_t* p = src + (size_t)row * ld_src + part * cpt;
    for (int e = 0; e < cpt / 8; ++e) { const u32x4 w = *(const u32x4*)(p + e * 8);
#pragma unroll
        for (int j = 0; j < 4; ++j) { T[(part * cpt + e * 8 + 2 * j) * RT_LD + row] = (unsigned short)(w[j] & 0xffffu); T[(part * cpt + e * 8 + 2 * j + 1) * RT_LD + row] = (unsigned short)(w[j] >> 16); } }
}
__device__ __forceinline__ void p_ret_local(const Ctx& c) {
    const bf16_t* P1 = (const bf16_t*)(c.ar + AR_P1); h16* RU = (h16*)(c.ar + AR_RU);
    LAS unsigned short* TK = (LAS unsigned short*)c.lds; LAS unsigned short* TV = TK + 128 * RT_LD;
    const int lane = c.lane, r = lane & 31, hh = lane >> 5, w = c.wave;
    for (int item = blockIdx.x; item < NB * 8 * 34; item += gridDim.x) {
        const int cidx = item % 34, h = (item / 34) & 7, b = item / (34 * 8);
        const int row0 = ret_row0(b, cidx);
        stage_chunk_T(c, P1 + (size_t)row0 * NO + P1_DK + h * 128, NO, 128, TK);
        stage_chunk_T(c, P1 + (size_t)row0 * NO + P1_DV + h * 256, NO, 256, TV);
        __syncthreads();
        for (int dir = 0; dir < 2; ++dir) {
            const float lg = ret_lg(c, dir, h);
            f32x16 af[4];
#pragma unroll
            for (int dt = 0; dt < 4; ++dt)
#pragma unroll
                for (int i = 0; i < 16; ++i) af[dt][i] = 0.f;
#pragma unroll 1
            for (int ks = 0; ks < 8; ++ks) {
                const int i0 = ks * 16 + hh * 8;
                float vf[8]; unpack8(*(const LAS u32x4*)(TV + (32 * w + r) * RT_LD + i0), vf);
#pragma unroll
                for (int j = 0; j < 8; ++j) vf[j] *= __expf(lg * (float)(dir ? (i0 + j) : (127 - (i0 + j))));
                const bf16x8 fa = __builtin_bit_cast(bf16x8, pack8_bf16(vf));
#pragma unroll
                for (int dt = 0; dt < 4; ++dt) af[dt] = MFMA32(*(const LAS bf16x8*)(TK + (32 * dt + r) * RT_LD + i0), fa, af[dt]);
            }
            h16* U = RU + ((((size_t)b * 8 + h) * 2 + dir) * 34 + cidx) * 32768;
#pragma unroll
            for (int dt = 0; dt < 4; ++dt)
#pragma unroll
                for (int g = 0; g < 4; ++g) { f32x4 v4 = {af[dt][4 * g], af[dt][4 * g + 1], af[dt][4 * g + 2], af[dt][4 * g + 3]}; st4(U + (32 * w + r) * 128 + 32 * dt + 8 * g + 4 * hh, v4); }
        }
        __syncthreads();
    }
}
__device__ __forceinline__ void p_ret_prefix(const Ctx& c) {
    const h16* RU = (const h16*)(c.ar + AR_RU); bf16_t* RS = (bf16_t*)(c.ar + AR_RS);
    const size_t gtid = (size_t)blockIdx.x * NTHREADS + c.tid, gn = (size_t)gridDim.x * NTHREADS;
    for (size_t idx = gtid; idx < (size_t)NB * 8 * 2 * 8192; idx += gn) {
        const int el = (int)(idx & 8191) * 4, bhd = (int)(idx >> 13), dir = bhd & 1, h = (bhd >> 1) & 7;
        const float cd = __expf(ret_lg(c, dir, h) * 128.0f);
        const h16* U = RU + (size_t)bhd * 34 * 32768 + el; bf16_t* S = RS + (size_t)bhd * 32 * 32768 + el;
        u32x2 u[34];
#pragma unroll
        for (int ci = 0; ci < 34; ++ci) u[ci] = __builtin_nontemporal_load((const u32x2*)(U + (size_t)ci * 32768));
#define RP_U(ci) ((f32x4){h16lo(u[ci].x), h16hi(u[ci].x), h16lo(u[ci].y), h16hi(u[ci].y)})
        f32x4 s = {0.f, 0.f, 0.f, 0.f};
        if (dir == 0) {
#pragma unroll
            for (int ci = 0; ci < 34; ++ci) { if (ci >= 2) { u32x2 w = {pk_bf16(s[0], s[1]), pk_bf16(s[2], s[3])}; *(u32x2*)(S + (size_t)(ci - 2) * 32768) = w; } s = s * cd + RP_U(ci); } }
        else { s = s * cd + RP_U(1); s = s * cd + RP_U(0);
#pragma unroll
            for (int ci = 33; ci >= 2; --ci) { u32x2 w = {pk_bf16(s[0], s[1]), pk_bf16(s[2], s[3])}; *(u32x2*)(S + (size_t)(ci - 2) * 32768) = w; s = s * cd + RP_U(ci); } }
#undef RP_U
    }
}
__device__ __forceinline__ void p_ret_out(const Ctx& c) {
    const bf16_t* P1 = (const bf16_t*)(c.ar + AR_P1); const bf16_t* RS = (const bf16_t*)(c.ar + AR_RS); bf16_t* MIX = (bf16_t*)(c.ws + WS_XN);
    LAS unsigned short* TV = (LAS unsigned short*)c.lds;
    LAS float* XS = (LAS float*)(c.lds + 256 * RT_LD * 2);
    const int lane = c.lane, r = lane & 31, hh = lane >> 5, w = c.wave, qt = w & 3, eh = w >> 2;
    LAS unsigned char* SB = c.lds + 71680;
#define RO_SLOAD(Sg) do { _Pragma("unroll") for (int i = 0; i < 8; ++i) { const int srow = (8 * w + i) * 4 + (lane >> 4), schunk = (lane & 15) ^ (srow & 15); \
        __builtin_amdgcn_global_load_lds((const unsigned*)((Sg) + (size_t)srow * 128 + schunk * 8), (LAS unsigned*)(SB + (8 * w + i) * 1024), 16, 0, 0); } } while (0)
#define RO_SFRAG(e, ks) (*(const LAS bf16x8*)(SB + (e) * 256 + (((((ks) * 2 + hh)) ^ ((e) & 15)) << 4)))
    for (int item = blockIdx.x; item < NB * 8 * 32; item += gridDim.x) {
        const int lc = item & 31, h = (item >> 5) & 7, b = item >> 8;
        const int row0 = b * SEQ + lc * 128;
        const bf16_t* Sf = RS + ((((size_t)b * 8 + h) * 2 + 0) * 32 + lc) * 32768; const bf16_t* Sb = RS + ((((size_t)b * 8 + h) * 2 + 1) * 32 + lc) * 32768;
        RO_SLOAD(Sf);
        stage_chunk_T(c, P1 + (size_t)row0 * NO + P1_DV + h * 256, NO, 256, TV);
        asm volatile("s_waitcnt vmcnt(0)" ::: "memory");
        __syncthreads();
        const float lgf = ret_lg(c, 0, h), lgb = ret_lg(c, 1, h);
        const int qi = qt * 32 + r;
        const bf16_t* qp = P1 + (size_t)(row0 + qi) * NO + P1_DQ + h * 128 + hh * 8;
        f32x16 Y[4];
#pragma unroll
        for (int et = 0; et < 4; ++et)
#pragma unroll
            for (int i = 0; i < 16; ++i) Y[et][i] = 0.f;
        const float qdf = __expf(lgf * (float)(qi + 1)), qdb = __expf(lgb * (float)(128 - qi));
        {
#pragma unroll 1
            for (int ks = 0; ks < 8; ++ks) {
                float x[8]; unpack8(*(const u32x4*)(qp + ks * 16), x);
#pragma unroll
                for (int j = 0; j < 8; ++j) x[j] *= qdf;
                const bf16x8 qf = __builtin_bit_cast(bf16x8, pack8_bf16(x));
#pragma unroll
                for (int et = 0; et < 4; ++et) { const int e = eh * 128 + et * 32 + r; Y[et] = MFMA32(RO_SFRAG(e, ks), qf, Y[et]); }
            }
        }
        __syncthreads();
        RO_SLOAD(Sb);
#pragma unroll 1
        for (int kt = 0; kt < 4; ++kt) {
            f32x16 st;
#pragma unroll
            for (int i = 0; i < 16; ++i) st[i] = 0.f;
            const bf16_t* kp = P1 + (size_t)(row0 + kt * 32 + r) * NO + P1_DK + h * 128 + hh * 8;
#pragma unroll
            for (int ks = 0; ks < 8; ++ks) st = MFMA32(ld_frag(kp + ks * 16), ld_frag(qp + ks * 16), st);
#pragma unroll
            for (int i = 0; i < 16; ++i) { const int ki = kt * 32 + (i & 3) + 8 * (i >> 2) + 4 * hh; const int dl = qi - ki;
                const float f = dl > 0 ? __expf(lgf * (float)dl) : (dl < 0 ? __expf(lgb * (float)(-dl)) : 2.0f); st[i] *= f; }
            const bf16x8 p0 = pack_p(st, 0), p1 = pack_p(st, 1);
#pragma unroll
            for (int et = 0; et < 4; ++et) { const int e = eh * 128 + et * 32 + r;
#pragma unroll
                for (int s = 0; s < 2; ++s) { const u32x2 lo = *(const LAS u32x2*)(TV + e * RT_LD + kt * 32 + 16 * s + 4 * hh), hi = *(const LAS u32x2*)(TV + e * RT_LD + kt * 32 + 16 * s + 8 + 4 * hh);
                    u32x4 vw = {lo.x, lo.y, hi.x, hi.y};
                    Y[et] = MFMA32(__builtin_bit_cast(bf16x8, vw), s == 0 ? p0 : p1, Y[et]); } }
        }
        asm volatile("s_waitcnt vmcnt(0)" ::: "memory");
        __syncthreads();
        {
#pragma unroll 1
            for (int ks = 0; ks < 8; ++ks) {
                float x[8]; unpack8(*(const u32x4*)(qp + ks * 16), x);
#pragma unroll
                for (int j = 0; j < 8; ++j) x[j] *= qdb;
                const bf16x8 qb = __builtin_bit_cast(bf16x8, pack8_bf16(x));
#pragma unroll
                for (int et = 0; et < 4; ++et) { const int e = eh * 128 + et * 32 + r; Y[et] = MFMA32(RO_SFRAG(e, ks), qb, Y[et]); }
            }
        }
        float ss = 0.f;
#pragma unroll
        for (int et = 0; et < 4; ++et)
#pragma unroll
            for (int i = 0; i < 16; ++i) ss += Y[et][i] * Y[et][i];
        ss += __shfl_xor(ss, 32);
        if (hh == 0) XS[(eh * 4 + qt) * 32 + r] = ss;
        __syncthreads();
        const float tot = XS[(0 * 4 + qt) * 32 + r] + XS[(1 * 4 + qt) * 32 + r];
        const float rs = rsqrtf(tot * (1.0f / 256.0f) + 1e-6f);
        const bf16_t* gp = P1 + (size_t)(row0 + qi) * NO + P1_DG + h * 256; bf16_t* op = MIX + (size_t)(row0 + qi) * D + 2048 + h * 256;
#pragma unroll
        for (int et = 0; et < 4; ++et)
#pragma unroll
            for (int gq = 0; gq < 4; ++gq) { const int e = eh * 128 + et * 32 + 8 * gq + 4 * hh;
                const u32x2 gw = *(const u32x2*)(gp + e);
                const float g0 = bflo(gw.x), g1 = bfhi(gw.x), g2 = bflo(gw.y), g3 = bfhi(gw.y);
                u32x2 o; o.x = pk_bf16(Y[et][4 * gq] * rs * silu_f(g0), Y[et][4 * gq + 1] * rs * silu_f(g1)); o.y = pk_bf16(Y[et][4 * gq + 2] * rs * silu_f(g2), Y[et][4 * gq + 3] * rs * silu_f(g3));
                *(u32x2*)(op + e) = o; }
        __syncthreads();
    }
#undef RO_SLOAD
#undef RO_SFRAG
}

#define MK_PER_PHASE 0
#ifndef MK_PER_PHASE
#define MK_PER_PHASE 0
#endif
constexpr int N_PHASES = 25;
constexpr int LDS_STAGE = 4 * K1_WAVE_LDS;
constexpr int LDS_BYTES = LDS_STAGE + 256;

__global__ void __launch_bounds__(NTHREADS, 2) mk_fwd(Args a) {
    extern __shared__ __attribute__((aligned(16))) unsigned char smem[];
    Ctx c;
#pragma unroll
    for (int i = 0; i < 29; ++i) c.in[i] = a.in[i];
    c.out = a.out; c.ws = a.ws; c.ar = a.ws + WS_ARENA; c.lds = (LAS unsigned char*)smem;
    c.tid = threadIdx.x; c.lane = c.tid & 63; c.wave = __builtin_amdgcn_readfirstlane(c.tid >> 6);
    volatile LAS unsigned* xbw = (volatile LAS unsigned*)(c.lds + LDS_STAGE);
    if (c.tid < 4) xbw[c.tid] = 0u;
    __syncthreads();
    XcdBarrier bar; bar.bar = (unsigned*)(a.ws + WS_CTL); bar.x = 0; bar.st = xbw;
    if (!MK_PER_PHASE) bar = xcd_barrier_post((unsigned*)(a.ws + WS_CTL), xbw);
    const int lo = a.ph_lo, hi = a.ph_hi;
#ifndef PH_MASK
#define PH_MASK 0x1ffffffu
#endif
#define IN(k) (((PH_MASK >> (k)) & 1u) && lo <= (k) && (k) < hi)
#define SEAM(k) do { if (IN(k) && IN((k) + 1)) { xcd_barrier(bar); } } while (0)
    res_t* H = (res_t*)(c.ws + WS_H); const float* MOD = (const float*)(c.ws + WS_MOD);
    const bf16_t* XN = (const bf16_t*)(c.ws + WS_XN); unsigned char* W = c.ws + WS_W;
    LAS unsigned char* gl = c.lds; float* SLAB = (float*)(c.ar + AR_SLAB); unsigned char* W1 = c.ws + WS_W1;

    if (IN(0)) { p_mod(c); p_weights_layer0(c); p_wcolmax(c, CmxDeal{(int)blockIdx.x, (int)gridDim.x, 0, cmx_p0(gridDim.x)}); }
    SEAM(0);
    if (IN(1)) { p_mod_finalize(c); p_norm_mod<4>(c, c.in[I_X], c.in[I_CTX], TT, (const float*)(c.ar + AR_MODP), 0, 1); }
    SEAM(1);
    if (IN(2)) { const int ns = cmx_ns(gridDim.x), gg = (int)gridDim.x - ns;
        if ((int)blockIdx.x < gg) { pg8::Gemm g{XN, (const bf16_t*)(W + W_IN), TT, NE, D}; LatThenCtxOrder S; S.init2(NE, gg, blockIdx.x, D);
            EpiInEven E{(bf16_t*)(c.ar + AR_PA), (bf16_t*)(c.ar + AR_PB), (const float*)(c.ws + WS_AXC), (const float*)(c.ws + WS_AXS)};
            pg8::gemm_phase(gl, g, S, E); }
        else p_wcolmax(c, CmxDeal{(int)blockIdx.x - gg, ns, cmx_p0(gridDim.x), CMX_TOTAL}); }
    SEAM(2);
    if (IN(3)) { p_rwkv_prepA(c); p_build_vt<128, 16>(c, (const bf16_t*)(c.ar + AR_PB), COLS_B, 4096, (bf16_t*)(c.ar + AR_VT)); }
    SEAM(3);
    if (IN(4)) { pg8::Gemm g{(const bf16_t*)(c.ar + AR_LA), (const bf16_t*)(W + W_LORA), TT, LORA_N, LORA_K}; LoraOrder S; S.init2(LORA_N, gridDim.x, blockIdx.x, LORA_KU);
        EpiLora E{c.in[I_W0], c.in[I_A0], c.in[I_KA], (const bf16_t*)(c.ar + AR_K), (const h16*)(c.ar + AR_KK), (h16*)(c.ar + AR_OMW), (h16*)(c.ar + AR_BB), (h16*)(c.ar + AR_KD), (bf16_t*)(c.ar + AR_G)};
        pg8::gemm_phase(gl, g, S, E); }
    SEAM(4);
    if (IN(5)) {
#ifndef NO_DATTN
        p_dattn_block(c, true); __syncthreads();
#endif
#ifndef NO_K1
        p_rwkv_k1_and_conv(c);
#endif
    }
    SEAM(5);
    if (IN(6)) p_rwkv_seq_and_conv(c);
    SEAM(6);
    if (IN(7)) p_rwkv_out(c, TT);
    SEAM(7);
    if (IN(8)) { constexpr int KE = MIX_I8 ? D / 2 : D; const float* SAq = (const float*)(c.ar + AR_XQS);
        pg8::Gemm g{MIX_I8 ? (const bf16_t*)(c.ar + AR_XQ) : XN, (const bf16_t*)(W + W_MIX), TT, D, KE}; pg8::StaticOrder S; S.init(TL, D, gridDim.x, blockIdx.x, KE);
        EpiResModT<MIX_I8 != 0, float> E{c.in[I_X], c.in[I_CTX], H, MOD + 2 * 4096, SAq, i8_cs(c, CM_MIX)};
        pg8::gemm_phase(gl, g, S, E);
        CtxSplitOrder S2; S2.init(D, gridDim.x, blockIdx.x, KE); EpiSlabT<MIX_I8 != 0> E2{SLAB, SAq, i8_cs(c, CM_MIX)};
        pg8::gemm_phase(gl, g, S2, E2); }
    SEAM(8);
    if (IN(9)) { p_ctx_fix(c, c.in[I_CTX], MOD + 4 * 24576 + 2 * 4096, SLAB, H); p_norm_mod<1, FFN_I8 != 0, res_t>(c, H, H + (size_t)TL * D, TT, MOD, 3, 4); }
    SEAM(9);
    if (IN(10)) { constexpr int KE = FFN_I8 ? D / 2 : D;
        pg8::Gemm g{XN, (const bf16_t*)(W + W_FFI), TT, 2 * DFF, KE}; LatThenCtxOrder S; S.init2(2 * DFF, gridDim.x, blockIdx.x, KE);
        EpiConvGlu E{(bf16_t*)(c.ar + AR_HID), (bf16_t*)(c.ar + AR_SG), (bf16_t*)(c.ar + AR_SU), c.in[I_CONVW], c.in[I_CONVB], (const float*)(c.ws + WS_XN + (size_t)TT * D), i8_cs(c, CM_FFI)};
        pg8::gemm_phase(gl, g, S, E); }
    SEAM(10);
    if (IN(11)) { p_conv_fix(c, 0, TT); if (FFO0_I8 && IN(12)) { xcd_barrier(bar); p_quant_hid(c, TT); } }
    SEAM(11);
    if (IN(12)) { constexpr int KE = FFO0_I8 ? DFF / 2 : DFF; const float* SAq = (const float*)(c.ar + AR_HQS);
        pg8::Gemm g{(const bf16_t*)(c.ar + (FFO0_I8 ? AR_HQ : AR_HID)), (const bf16_t*)(W + W_FFO), TT, D, KE}; pg8::StaticOrder S; S.init(TL, D, gridDim.x, blockIdx.x, KE);
        EpiResModT<FFO0_I8 != 0> E{H, H + (size_t)TL * D, H, MOD + 5 * 4096, SAq, i8_cs(c, CM_FFO0)};
        pg8::gemm_phase(gl, g, S, E);
        CtxSplitOrder S2; S2.init(D, gridDim.x, blockIdx.x, KE); EpiSlabT<FFO0_I8 != 0> E2{SLAB, SAq, i8_cs(c, CM_FFO0)};
        pg8::gemm_phase(gl, g, S2, E2); }
    SEAM(12);
    const float* MOD1 = MOD + 5 * 24576;
    if (IN(13)) { p_ctx_fix(c, H + (size_t)TL * D, MOD + 4 * 24576 + 5 * 4096, SLAB, H); p_norm_mod<1, INO_I8 != 0, res_t>(c, H, H + (size_t)TL * D, TT, MOD1, 0, 1); }
    SEAM(13);
    if (IN(14)) { constexpr int KE = INO_I8 ? D / 2 : D;
        pg8::Gemm g{XN, (const bf16_t*)(W + W_IN), TT, NO, KE}; OddInOrder S; S.init2(gridDim.x, blockIdx.x, KE);
        EpiInOdd E{(bf16_t*)(c.ar + AR_P1), (const float*)(c.ws + WS_AXC), (const float*)(c.ws + WS_AXS), (const float*)(c.ws + WS_RTC), (const float*)(c.ws + WS_RTS), (const float*)(c.ws + WS_XN + (size_t)TT * D), i8_cs(c, CM_INO)};
        pg8::gemm_phase(gl, g, S, E); }
    SEAM(14);
    if (IN(15)) { p_build_vt<64, 4>(c, (const bf16_t*)(c.ar + AR_P1), NO, P1_CV, (bf16_t*)(c.ar + AR_VTC)); }
    SEAM(15);
    if (IN(16)) { p_ret_local(c); for (int item = blockIdx.x; item < NB * 4 * 128; item += gridDim.x) swa_block_item(c, item); }
    SEAM(16);
    if (IN(17)) p_ret_prefix(c);
    SEAM(17);
    if (IN(18)) p_ret_out(c);
    SEAM(18);
    if (MIX_I8 && IN(18) && IN(19)) { p_quant_mix(c, TL); xcd_barrier(bar); }
    if (IN(19)) { constexpr int KE = MIX_I8 ? D / 2 : D;
        pg8::Gemm g{MIX_I8 ? (const bf16_t*)(c.ar + AR_XQ) : XN, (const bf16_t*)(W1 + W1_MIX), TL, D, KE}; pg8::StaticOrder S; S.init(TL, D, gridDim.x, blockIdx.x, KE);
        EpiResModT<MIX_I8 != 0> E{H, H + (size_t)TL * D, H, MOD1 + 2 * 4096, (const float*)(c.ar + AR_XQS), i8_cs(c, CM_MIX + D)};
        pg8::gemm_phase(gl, g, S, E); }
    SEAM(19);
    if (IN(20)) p_norm_mod<1, FFN_I8 != 0, res_t>(c, H, H + (size_t)TL * D, TL, MOD1, 3, 4);
    SEAM(20);
    if (IN(21)) { constexpr int KE = FFN_I8 ? D / 2 : D;
        pg8::Gemm g{XN, (const bf16_t*)(W1 + W1_FFI), TL, 2 * DFF, KE}; pg8::StaticOrder S; S.init(TL, 2 * DFF, gridDim.x, blockIdx.x, KE);
        EpiConvGlu E{(bf16_t*)(c.ar + AR_HID), (bf16_t*)(c.ar + AR_SG), (bf16_t*)(c.ar + AR_SU), c.in[I_CONVW] + (size_t)3 * DFF, c.in[I_CONVB] + DFF, (const float*)(c.ws + WS_XN + (size_t)TT * D), i8_cs(c, CM_FFI + 2 * DFF)};
        pg8::gemm_phase(gl, g, S, E); }
    SEAM(21);
    if (IN(22)) { p_conv_fix(c, 1, TL); if (FFO1_I8 && IN(23)) { xcd_barrier(bar); p_quant_hid(c, TL); } }
    SEAM(22);
    if (IN(23)) { constexpr int KE = FFO1_I8 ? DFF / 2 : DFF;
        pg8::Gemm g{(const bf16_t*)(c.ar + (FFO1_I8 ? AR_HQ : AR_HID)), (const bf16_t*)(W1 + W1_FFO), TL, D, KE}; pg8::StaticOrder S; S.init(TL, D, gridDim.x, blockIdx.x, KE);
        EpiResModT<FFO1_I8 != 0> E{H, H + (size_t)TL * D, H, MOD1 + 5 * 4096, (const float*)(c.ar + AR_HQS), i8_cs(c, CM_FFO1)};
        pg8::gemm_phase(gl, g, S, E); }
    SEAM(23);
    if (IN(24)) p_final_norm(c);
#undef IN
#undef SEAM
}

extern "C" void kernel_launch(void* const* d_in, const int* in_sizes, int n_in, void* d_out, int out_size, void* d_ws, size_t ws_size, hipStream_t stream) {
    static int grid = 0;
    if (grid == 0) {
        if (n_in != 29 || ws_size < WS_END) { fprintf(stderr, "kernel_launch: need 29 inputs and >= %zu bytes of workspace; got n_in %d, ws %zu; nothing launched\n", (size_t)WS_END, n_in, ws_size); grid = -1; return; }
        int dev = 0, cus = 0, per_cu = 0;
        if (hipGetDevice(&dev) != hipSuccess || hipDeviceGetAttribute(&cus, hipDeviceAttributeMultiprocessorCount, dev) != hipSuccess) { grid = -1; return; }
        if (hipFuncSetAttribute((const void*)mk_fwd, hipFuncAttributeMaxDynamicSharedMemorySize, LDS_BYTES) != hipSuccess) { fprintf(stderr, "kernel_launch: hipFuncSetAttribute failed\n"); grid = -1; return; }
        if (hipOccupancyMaxActiveBlocksPerMultiprocessor(&per_cu, (const void*)mk_fwd, NTHREADS, LDS_BYTES) != hipSuccess || per_cu < 1) { fprintf(stderr, "kernel_launch: occupancy query says %d blocks per CU\n", per_cu); per_cu = 1; }
        (void)hipGetLastError();
        grid = cus;
    }
    if (grid < 0) return;
    (void)hipMemsetAsync((char*)d_ws + WS_CTL, 0, CTL_BYTES, stream);
    Args a{};
    for (int i = 0; i < 29; ++i) a.in[i] = (const float*)d_in[i];
    a.out = (float*)d_out; a.ws = (unsigned char*)d_ws;
#if MK_PER_PHASE
    for (int p = 0; p < N_PHASES; ++p) { a.ph_lo = p; a.ph_hi = p + 1; hipLaunchKernelGGL(mk_fwd, dim3(grid), dim3(NTHREADS), LDS_BYTES, stream, a); }
#else
    a.ph_lo = 0; a.ph_hi = N_PHASES;
    hipLaunchKernelGGL(mk_fwd, dim3(grid), dim3(NTHREADS), LDS_BYTES, stream, a);
#endif
    (void)in_sizes; (void)out_size;
}
```
